# Optimizing an MI355X kernel written in HIP

```python
import math
import jax, jax.numpy as jnp
from jax import lax
import numpy as np

D_MODEL = 1024
BATCH = 16
SEQ = 256
DEPTH = 4
DEC_BATCH = 2
DEC_SEQ = 1024
PAST_LEN = 512

GRID_W = 64
HEAD_DIM = 64
NA_HEADS = 4
NA_KH = 8
NA_KW = 16
DIFF_HEADS = 4
DIFF_QK_DIM = 32
DIFF_V_DIM = 2 * DIFF_QK_DIM
FNET_GROUPS = 4
FNET_GROUP_DIM = 64
SWA_HEADS = 4
SWA_KV_HEADS = 2
SWA_WINDOW = 128
D_FF = 4 * D_MODEL
Q_BLOCK = 128
ROPE_BASE = 10000.0
NORM_EPS = 1e-6
NEG_INF = -1e30

NA_WIDTH = NA_HEADS * HEAD_DIM
DIFF_QK_WIDTH = DIFF_HEADS * 2 * DIFF_QK_DIM
DIFF_WIDTH = DIFF_HEADS * DIFF_V_DIM
FNET_WIDTH = FNET_GROUPS * FNET_GROUP_DIM
SWA_WIDTH = SWA_HEADS * HEAD_DIM
SWA_KV_WIDTH = SWA_KV_HEADS * HEAD_DIM
MIX_WIDTH = NA_WIDTH + DIFF_WIDTH + FNET_WIDTH + SWA_WIDTH
IN_WIDTH = 3 * NA_WIDTH + 2 * DIFF_QK_WIDTH + DIFF_WIDTH + FNET_WIDTH + SWA_WIDTH + 2 * SWA_KV_WIDTH

kernel_name = 'hybrid_diffusion_prefix_trunk_step'


def rmsnorm(x, g):
    xf = x.astype(jnp.float32)
    y = xf * lax.rsqrt(jnp.mean(xf * xf, axis=-1, keepdims=True) + NORM_EPS)
    return (y * g.astype(jnp.float32)).astype(x.dtype)


def modulate(h, shift, scale):
    return h * (1.0 + scale) + shift


def adaln(cond, w, b):
    m = jax.nn.silu(cond) @ w + b
    return jnp.split(m, 6, axis=-1)


def rope_1d(x, pos):
    half = x.shape[-1] // 2
    inv = ROPE_BASE ** (-jnp.arange(half, dtype=jnp.float32) / half)
    ang = pos.astype(jnp.float32)[:, None] * inv[None, :]
    cos = jnp.cos(ang)[:, None, :]
    sin = jnp.sin(ang)[:, None, :]
    xf = x.astype(jnp.float32)
    x1, x2 = xf[..., :half], xf[..., half:]
    return jnp.concatenate([x1 * cos - x2 * sin, x2 * cos + x1 * sin], axis=-1).astype(x.dtype)


def rope_2d(x):
    t = jnp.arange(x.shape[1])
    n = x.shape[-1] // 2
    return jnp.concatenate([rope_1d(x[..., :n], t // GRID_W), rope_1d(x[..., n:], t % GRID_W)], axis=-1)


def split_proj(z):
    B, L = z.shape[:2]
    sizes = (NA_WIDTH, NA_WIDTH, NA_WIDTH, DIFF_QK_WIDTH, DIFF_QK_WIDTH, DIFF_WIDTH,
             FNET_WIDTH, SWA_WIDTH, SWA_KV_WIDTH, SWA_KV_WIDTH)
    cuts = [int(c) for c in np.cumsum(sizes)[:-1]]
    na_q, na_k, na_v, dq, dk, dv, fc, sq, sk, sv = jnp.split(z, cuts, axis=-1)
    return (na_q.reshape(B, L, NA_HEADS, HEAD_DIM), na_k.reshape(B, L, NA_HEADS, HEAD_DIM),
            na_v.reshape(B, L, NA_HEADS, HEAD_DIM),
            dq.reshape(B, L, DIFF_HEADS, 2 * DIFF_QK_DIM), dk.reshape(B, L, DIFF_HEADS, 2 * DIFF_QK_DIM),
            dv.reshape(B, L, DIFF_HEADS, DIFF_V_DIM), fc,
            sq.reshape(B, L, SWA_HEADS, HEAD_DIM), sk.reshape(B, L, SWA_KV_HEADS, HEAD_DIM),
            sv.reshape(B, L, SWA_KV_HEADS, HEAD_DIM))


def dense_attn(q, k, v, sink):
    B, Lq, Hq, d = q.shape
    Hkv = k.shape[2]
    G = Hq // Hkv
    nb = Lq // Q_BLOCK
    scale = d ** -0.5
    qb = q.reshape(B, nb, Q_BLOCK, Hkv, G, d).transpose(1, 0, 2, 3, 4, 5)

    def one(qblk):
        s = jnp.einsum('bqhgd,bkhd->bhgqk', qblk, k).astype(jnp.float32) * scale
        if sink is not None:
            s_sink = jnp.broadcast_to(sink.astype(jnp.float32).reshape(1, Hkv, G, 1, 1), s.shape[:-1] + (1,))
            s = jnp.concatenate([s, s_sink], axis=-1)
        p = jax.nn.softmax(s, axis=-1)
        if sink is not None:
            p = p[..., :-1]
        return jnp.einsum('bhgqk,bkhd->bqhgd', p.astype(v.dtype), v)

    out = lax.map(one, qb)
    return out.transpose(1, 0, 2, 3, 4, 5).reshape(B, Lq, Hq, v.shape[-1])


def diff_lambda(lq1, lk1, lq2, lk2, lambda_init):
    f = jnp.float32
    return (jnp.exp(jnp.sum(lq1.astype(f) * lk1.astype(f)))
            - jnp.exp(jnp.sum(lq2.astype(f) * lk2.astype(f))) + lambda_init)


def diff_attn(q1, q2, k1, k2, v, lam):
    B, L, H, d = q1.shape
    nb = L // Q_BLOCK
    scale = d ** -0.5

    def to_blocks(t):
        return t.reshape(B, nb, Q_BLOCK, H, d).transpose(1, 0, 2, 3, 4)

    def one(qs):
        a, b = qs
        p1 = jax.nn.softmax(jnp.einsum('bqhd,bkhd->bhqk', a, k1).astype(jnp.float32) * scale, axis=-1)
        p2 = jax.nn.softmax(jnp.einsum('bqhd,bkhd->bhqk', b, k2).astype(jnp.float32) * scale, axis=-1)
        p = p1 - lam * p2
        return jnp.einsum('bhqk,bkhe->bqhe', p.astype(v.dtype), v)

    out = lax.map(one, (to_blocks(q1), to_blocks(q2)))
    return out.transpose(1, 0, 2, 3, 4).reshape(B, L, H, v.shape[-1])


def fourier_mix(h, w):
    B, L, _ = h.shape
    hf = h.astype(jnp.float32).reshape(B, L, FNET_GROUPS, FNET_GROUP_DIM)
    y = jnp.fft.fft2(hf, axes=(1, 3), norm='ortho').real.astype(h.dtype)
    return y.reshape(B, L, FNET_WIDTH) @ w


def na_latent(q, k, v, kc, vc, rpb):
    B, N, H, d = q.shape
    rows = N // GRID_W
    kh = min(NA_KH, rows)
    scale = d ** -0.5
    qg = q.reshape(B, rows, GRID_W, H, d)
    kg = k.reshape(B, rows, GRID_W, H, d)
    vg = v.reshape(B, rows, GRID_W, H, d)
    r = jnp.arange(rows)
    rstart = jnp.clip(r - kh // 2, 0, rows - kh)
    ridx = rstart[:, None] + jnp.arange(kh)[None, :]
    kr = kg[:, ridx]
    vr = vg[:, ridx]
    col = jnp.arange(GRID_W)
    cstart = jnp.clip(col - NA_KW // 2, 0, GRID_W - NA_KW)
    cmask = (col[None, :] >= cstart[:, None]) & (col[None, :] < cstart[:, None] + NA_KW)
    dr_i = ridx - r[:, None] + (NA_KH - 1)
    dc_i = jnp.clip(col[None, :] - col[:, None] + (NA_KW - 1), 0, 2 * NA_KW - 2)
    bias = rpb.astype(jnp.float32)[:, dr_i[:, None, :, None], dc_i[None, :, None, :]]
    s_loc = jnp.einsum('brchd,brkwhd->bhrckw', qg, kr).astype(jnp.float32) * scale + bias[None]
    n_loc = kh * GRID_W
    s_loc = jnp.where(cmask[:, None, :], s_loc, NEG_INF).reshape(B, H, rows, GRID_W, n_loc)
    s_ctx = jnp.einsum('brchd,bjhd->bhrcj', qg, kc).astype(jnp.float32) * scale
    p = jax.nn.softmax(jnp.concatenate([s_loc, s_ctx], axis=-1), axis=-1)
    p_loc = p[..., :n_loc].reshape(B, H, rows, GRID_W, kh, GRID_W).astype(v.dtype)
    p_ctx = p[..., n_loc:].astype(v.dtype)
    out = (jnp.einsum('bhrckw,brkwhd->brchd', p_loc, vr)
           + jnp.einsum('bhrcj,bjhd->brchd', p_ctx, vc))
    return out.reshape(B, N, H, d)


def swa_latent(q, k, v, kc, vc, sink):
    B, N, Hq, d = q.shape
    Hkv = k.shape[2]
    G = Hq // Hkv
    W = SWA_WINDOW
    nb = N // W
    Lc = kc.shape[1]
    scale = d ** -0.5
    qb = q.reshape(B, nb, W, Hkv, G, d)
    pad = ((0, 0), (W, W), (0, 0), (0, 0))
    kp = jnp.pad(k, pad)
    vp = jnp.pad(v, pad)
    idx = jnp.arange(nb)[:, None] * W + jnp.arange(3 * W)[None, :]
    kb = kp[:, idx]
    vb = vp[:, idx]
    qpos = jnp.arange(nb)[:, None] * W + jnp.arange(W)[None, :]
    kpos = idx - W
    rel = qpos[:, :, None] - kpos[:, None, :]
    valid = (jnp.abs(rel) <= W) & (kpos[:, None, :] >= 0) & (kpos[:, None, :] < N)
    s_loc = jnp.einsum('bnqhgd,bnkhd->bnhgqk', qb, kb).astype(jnp.float32) * scale
    s_loc = jnp.where(valid[None, :, None, None], s_loc, NEG_INF)
    s_ctx = jnp.einsum('bnqhgd,bjhd->bnhgqj', qb, kc).astype(jnp.float32) * scale
    s_sink = jnp.broadcast_to(sink.astype(jnp.float32).reshape(1, 1, Hkv, G, 1, 1), s_loc.shape[:-1] + (1,))
    p = jax.nn.softmax(jnp.concatenate([s_loc, s_ctx, s_sink], axis=-1), axis=-1)
    p_loc = p[..., :3 * W].astype(v.dtype)
    p_ctx = p[..., 3 * W:3 * W + Lc].astype(v.dtype)
    out = (jnp.einsum('bnhgqk,bnkhd->bnqhgd', p_loc, vb)
           + jnp.einsum('bnhgqj,bjhd->bnqhgd', p_ctx, vc))
    return out.reshape(B, N, Hq, d)


def merge_heads(o_a, o_b, o_c, o_d, w_out):
    B, L = o_c.shape[:2]
    cat = jnp.concatenate([o_a.reshape(B, L, NA_WIDTH), o_b.reshape(B, L, DIFF_WIDTH), o_c,
                           o_d.reshape(B, L, SWA_WIDTH)], axis=-1)
    return cat @ w_out


def mix_context(h, lw):
    na_q, na_k, na_v, dq, dk, dv, fc, sq, sk, sv = split_proj(h @ lw['w_in'])
    o_a = dense_attn(na_q, na_k, na_v, None)
    o_b = diff_attn(dq[..., :DIFF_QK_DIM], dq[..., DIFF_QK_DIM:], dk[..., :DIFF_QK_DIM], dk[..., DIFF_QK_DIM:],
                    dv, lw['lam'])
    o_b = rmsnorm(o_b, lw['subln_g']) * (1.0 - lw['lam_init'])
    o_c = fourier_mix(fc, lw['w_fourier'])
    o_d = dense_attn(sq, sk, sv, lw['sink'])
    return merge_heads(o_a, o_b, o_c, o_d, lw['w_out']), (na_k, na_v, dk, dv, sk, sv)


def mix_latent(h, lw, ck):
    c_na_k, c_na_v, c_diff_k, c_diff_v, c_swa_k, c_swa_v = ck
    na_q, na_k, na_v, dq, dk, dv, fc, sq, sk, sv = split_proj(h @ lw['w_in'])
    o_a = na_latent(na_q, na_k, na_v, c_na_k, c_na_v, lw['rpb'])
    q1 = rope_2d(dq[..., :DIFF_QK_DIM])
    q2 = rope_2d(dq[..., DIFF_QK_DIM:])
    k1 = jnp.concatenate([rope_2d(dk[..., :DIFF_QK_DIM]), c_diff_k[..., :DIFF_QK_DIM]], axis=1)
    k2 = jnp.concatenate([rope_2d(dk[..., DIFF_QK_DIM:]), c_diff_k[..., DIFF_QK_DIM:]], axis=1)
    va = jnp.concatenate([dv, c_diff_v], axis=1)
    o_b = diff_attn(q1, q2, k1, k2, va, lw['lam'])
    o_b = rmsnorm(o_b, lw['subln_g']) * (1.0 - lw['lam_init'])
    o_c = fourier_mix(fc, lw['w_fourier'])
    o_d = swa_latent(rope_2d(sq), rope_2d(sk), sv, c_swa_k, c_swa_v, lw['sink'])
    return merge_heads(o_a, o_b, o_c, o_d, lw['w_out']), ()


def trunk_block(x, mods, g1, g2, w1, w2, mixer):
    sh1, sc1, gt1, sh2, sc2, gt2 = mods
    mixed, ctx_tensors = mixer(modulate(rmsnorm(x, g1), sh1, sc1))
    x = x + gt1 * mixed
    hh = modulate(rmsnorm(x, g2), sh2, sc2)
    x = x + gt2 * (jnp.square(jax.nn.relu(hh @ w1)) @ w2)
    return x, ctx_tensors


def setup_inputs(seed: int = 0) -> dict:
    key = jax.random.key(seed)
    ks = jax.random.split(key, 32)
    D = D_MODEL

    def nrm(k, shape, scale=1.0):
        return jax.random.normal(k, shape, jnp.float32) * scale

    return {
        'x_prompt': nrm(ks[0], (BATCH, SEQ, D)),
        'x_sample': nrm(ks[1], (DEC_BATCH, DEC_SEQ, D)),
        'cache_na_k': nrm(ks[2], (DEC_BATCH, DEPTH, PAST_LEN, NA_HEADS, HEAD_DIM)),
        'cache_na_v': nrm(ks[3], (DEC_BATCH, DEPTH, PAST_LEN, NA_HEADS, HEAD_DIM)),
        'cache_diff_k': nrm(ks[4], (DEC_BATCH, DEPTH, PAST_LEN, DIFF_HEADS, 2 * DIFF_QK_DIM)),
        'cache_diff_v': nrm(ks[5], (DEC_BATCH, DEPTH, PAST_LEN, DIFF_HEADS, DIFF_V_DIM)),
        'cache_swa_k': nrm(ks[6], (DEC_BATCH, DEPTH, PAST_LEN, SWA_KV_HEADS, HEAD_DIM)),
        'cache_swa_v': nrm(ks[7], (DEC_BATCH, DEPTH, PAST_LEN, SWA_KV_HEADS, HEAD_DIM)),
        'c': nrm(ks[8], (DEC_BATCH, D)),
        'c_ctx': nrm(ks[9], (D,)),
        'w_ada': nrm(ks[10], (DEPTH, D, 6 * D), D ** -0.5),
        'b_ada': nrm(ks[11], (DEPTH, 6 * D), 0.02),
        'norm1_g': 1.0 + nrm(ks[12], (DEPTH, D), 0.02),
        'norm2_g': 1.0 + nrm(ks[13], (DEPTH, D), 0.02),
        'w_in': nrm(ks[14], (DEPTH, D, IN_WIDTH), D ** -0.5),
        'na_rpb': nrm(ks[15], (DEPTH, NA_HEADS, 2 * NA_KH - 1, 2 * NA_KW - 1), 0.1),
        'diff_lq1': nrm(ks[16], (DEPTH, DIFF_QK_DIM), 0.1),
        'diff_lk1': nrm(ks[17], (DEPTH, DIFF_QK_DIM), 0.1),
        'diff_lq2': nrm(ks[18], (DEPTH, DIFF_QK_DIM), 0.1),
        'diff_lk2': nrm(ks[19], (DEPTH, DIFF_QK_DIM), 0.1),
        'diff_subln_g': 1.0 + nrm(ks[20], (DEPTH, DIFF_V_DIM), 0.02),
        'w_fourier': nrm(ks[21], (DEPTH, FNET_WIDTH, FNET_WIDTH), FNET_WIDTH ** -0.5),
        'swa_sink': nrm(ks[22], (DEPTH, SWA_HEADS), 0.5),
        'w_out': nrm(ks[23], (DEPTH, MIX_WIDTH, D), MIX_WIDTH ** -0.5),
        'w_mlp1': nrm(ks[24], (DEPTH, D, D_FF), D ** -0.5),
        'w_mlp2': nrm(ks[25], (DEPTH, D_FF, D), D_FF ** -0.5),
        'final_g': 1.0 + nrm(ks[26], (D,), 0.02),
    }


def reference(x_prompt, x_sample, cache_na_k, cache_na_v, cache_diff_k, cache_diff_v, cache_swa_k, cache_swa_v,
              c, c_ctx, w_ada, b_ada, norm1_g, norm2_g, w_in, na_rpb, diff_lq1, diff_lk1, diff_lq2, diff_lk2,
              diff_subln_g, w_fourier, swa_sink, w_out, w_mlp1, w_mlp2, final_g):
    xp = x_prompt
    xs = x_sample
    ctx_out = []
    for l in range(DEPTH):
        lam_init = 0.8 - 0.6 * math.exp(-0.3 * l)
        lw = {
            'w_in': w_in[l], 'rpb': na_rpb[l],
            'lam': diff_lambda(diff_lq1[l], diff_lk1[l], diff_lq2[l], diff_lk2[l], lam_init),
            'lam_init': lam_init, 'subln_g': diff_subln_g[l], 'w_fourier': w_fourier[l],
            'sink': swa_sink[l], 'w_out': w_out[l],
        }
        mods_p = adaln(c_ctx, w_ada[l], b_ada[l])
        xp, kv = trunk_block(xp, mods_p, norm1_g[l], norm2_g[l], w_mlp1[l], w_mlp2[l],
                             lambda h: mix_context(h, lw))
        ctx_out.append(kv)
        mods_s = [m[:, None, :] for m in adaln(c, w_ada[l], b_ada[l])]
        ck = (cache_na_k[:, l], cache_na_v[:, l], cache_diff_k[:, l], cache_diff_v[:, l],
              cache_swa_k[:, l], cache_swa_v[:, l])
        xs, _ = trunk_block(xs, mods_s, norm1_g[l], norm2_g[l], w_mlp1[l], w_mlp2[l],
                            lambda h: mix_latent(h, lw, ck))
    y_prompt = rmsnorm(xp, final_g)
    y_sample = rmsnorm(xs, final_g)
    new_na_k = jnp.stack([t[0] for t in ctx_out], axis=1)
    new_na_v = jnp.stack([t[1] for t in ctx_out], axis=1)
    new_diff_k = jnp.stack([t[2] for t in ctx_out], axis=1)
    new_diff_v = jnp.stack([t[3] for t in ctx_out], axis=1)
    new_swa_k = jnp.stack([t[4] for t in ctx_out], axis=1)
    new_swa_v = jnp.stack([t[5] for t in ctx_out], axis=1)
    return (y_prompt, y_sample, new_na_k, new_na_v, new_diff_k, new_diff_v, new_swa_k, new_swa_v)
```

```cpp
#include <hip/hip_runtime.h>
#include <hip/hip_cooperative_groups.h>
#include <stdint.h>
#include <stdio.h>
namespace cg = cooperative_groups;

typedef unsigned short u16;
typedef __attribute__((ext_vector_type(8))) short bf16x8;
typedef __attribute__((ext_vector_type(4))) float f32x4;

#define NTOK 6144
#define NPTOK 4096
#define INW 2304
#define LOG2E 1.4426950408889634f
#define LDS_BYTES 73728
#define LSTR 72

#define O_NAK 6291456
#define O_NAV 10485760
#define O_DK 14680064
#define O_DV 18874368
#define O_SK 23068672
#define O_SV 25165824

struct Params {
  const float *x_prompt, *x_sample, *c_na_k, *c_na_v, *c_diff_k, *c_diff_v, *c_swa_k, *c_swa_v, *c, *c_ctx;
  const float *w_ada, *b_ada, *norm1_g, *norm2_g, *w_in, *na_rpb, *lq1, *lk1, *lq2, *lk2, *subln_g, *w_fourier, *swa_sink;
  const float *w_out, *w1, *w2, *final_g;
  float* out;
  float* xres;
  float* mods;
  u16 *h, *z, *vt, *cat, *u, *uv, *w_inT, *w_outT, *w1T, *w2T, *pqt, *dft256, *dft1024;
  u16 *ck_na, *cvt_na, *ck_diff, *cvt_diff, *ck_swa, *cvt_swa;
  float *ropeD, *ropeS;
};

__device__ __forceinline__ u16 f2bf(float f) {
  unsigned u = __float_as_uint(f);
  u += 0x7fffu + ((u >> 16) & 1u);
  return (u16)(u >> 16);
}
__device__ __forceinline__ int otid() { int t = threadIdx.x; asm volatile("" : "+v"(t)); return t; }
__device__ __forceinline__ float bf2f(u16 h) { return __uint_as_float(((unsigned)h) << 16); }
__device__ __forceinline__ unsigned pack2(float a, float b) { return (unsigned)f2bf(a) | ((unsigned)f2bf(b) << 16); }

__device__ __forceinline__ void transpose_tile(const float* __restrict__ src, int lds_, u16* __restrict__ dst, int ldd,
                                               int k0, int n0, float* sm) {
  const int tid = otid();
  const int c4 = (tid & 15) * 4, r0 = tid >> 4;
#pragma unroll
  for (int i = 0; i < 4; ++i) {
    const int k = r0 + 16 * i;
    const float4 v = *(const float4*)(src + (size_t)(k0 + k) * lds_ + n0 + c4);
    sm[k * 65 + c4 + 0] = v.x; sm[k * 65 + c4 + 1] = v.y; sm[k * 65 + c4 + 2] = v.z; sm[k * 65 + c4 + 3] = v.w;
  }
  __syncthreads();
  const int k8 = (tid & 7) * 8, nn = tid >> 3;
#pragma unroll
  for (int i = 0; i < 2; ++i) {
    const int n = nn + 32 * i;
    uint4 w;
    w.x = pack2(sm[(k8 + 0) * 65 + n], sm[(k8 + 1) * 65 + n]);
    w.y = pack2(sm[(k8 + 2) * 65 + n], sm[(k8 + 3) * 65 + n]);
    w.z = pack2(sm[(k8 + 4) * 65 + n], sm[(k8 + 5) * 65 + n]);
    w.w = pack2(sm[(k8 + 6) * 65 + n], sm[(k8 + 7) * 65 + n]);
    *(uint4*)(dst + (size_t)(n0 + n) * ldd + k0 + k8) = w;
  }
  __syncthreads();
}

__device__ __forceinline__ void adaln_item(const Params& p, int it, float* sm) {
  const int l = it / 96, c0 = (it % 96) * 64;
  float* ssil = sm;
  float* red = sm + 3072;
  const int tid = otid();
  for (int i = tid; i < 3072; i += 256) {
    const int cnd = i >> 10, k = i & 1023;
    const float v = cnd == 0 ? p.c_ctx[k] : p.c[(cnd - 1) * 1024 + k];
    ssil[i] = v / (1.f + expf(-v));
  }
  __syncthreads();
  const int cg4 = (tid & 15) * 4, ks = tid >> 4;
  const float* w = p.w_ada + (size_t)l * 1024 * 6144 + c0 + cg4;
  float a0[4] = {0.f, 0.f, 0.f, 0.f}, a1[4] = {0.f, 0.f, 0.f, 0.f}, a2[4] = {0.f, 0.f, 0.f, 0.f};
#pragma unroll 4
  for (int kk = 0; kk < 64; ++kk) {
    const int k = kk * 16 + ks;
    const float4 v = *(const float4*)(w + (size_t)k * 6144);
    const float s0 = ssil[k], s1 = ssil[1024 + k], s2 = ssil[2048 + k];
    a0[0] += s0 * v.x; a0[1] += s0 * v.y; a0[2] += s0 * v.z; a0[3] += s0 * v.w;
    a1[0] += s1 * v.x; a1[1] += s1 * v.y; a1[2] += s1 * v.z; a1[3] += s1 * v.w;
    a2[0] += s2 * v.x; a2[1] += s2 * v.y; a2[2] += s2 * v.z; a2[3] += s2 * v.w;
  }
#pragma unroll
  for (int j = 0; j < 4; ++j) {
    red[(ks * 3 + 0) * 64 + cg4 + j] = a0[j];
    red[(ks * 3 + 1) * 64 + cg4 + j] = a1[j];
    red[(ks * 3 + 2) * 64 + cg4 + j] = a2[j];
  }
  __syncthreads();
  if (tid < 192) {
    const int cnd = tid >> 6, j = tid & 63;
    float s = p.b_ada[l * 6144 + c0 + j];
    for (int q = 0; q < 16; ++q) s += red[(q * 3 + cnd) * 64 + j];
    p.mods[(l * 3 + cnd) * 6144 + c0 + j] = s;
  }
  __syncthreads();
}

__device__ __forceinline__ void cvt_item(const float* __restrict__ src, u16* __restrict__ dst, int it) {
  const size_t base = (size_t)it * 8192 + otid() * 4;
#pragma unroll
  for (int i = 0; i < 8; ++i) {
    const float4 v = *(const float4*)(src + base + i * 1024);
    uint2 w; w.x = pack2(v.x, v.y); w.y = pack2(v.z, v.w);
    *(uint2*)(dst + base + i * 1024) = w;
  }
}

__device__ __forceinline__ void pq_item(const Params& p, int it, float* sm) {
  const int l = it >> 3, which = (it >> 2) & 1, g = it & 3;
  const int n = otid();
  if (n < 64) sm[n] = which ? sinpif(2.f * (float)n / 64.f) : cospif(2.f * (float)n / 64.f);
  __syncthreads();
  float w[64];
#pragma unroll
  for (int m = 0; m < 64; ++m) w[m] = p.w_fourier[(size_t)l * 65536 + (g * 64 + m) * 256 + n];
  u16* dst = p.pqt + (size_t)l * 512 * 256 + (size_t)(which * 256 + n) * 256 + g * 64;
  for (int c = 0; c < 64; ++c) {
    float s = 0.f;
#pragma unroll
    for (int m = 0; m < 64; ++m) s += sm[(c * m) & 63] * w[m];
    dst[c] = f2bf(s);
  }
  __syncthreads();
}

__device__ __forceinline__ void dft_item(u16* dst, int L, int it) {
  const int twoL = 2 * L;
  for (int e = otid(); e < 8192; e += 256) {
    const int idx = it * 8192 + e;
    const int k = idx / twoL, j = idx % twoL;
    const int jj = j & (L - 1);
    const int ph = (k * jj) & (L - 1);
    const float a = 2.f * (float)ph / (float)L;
    const float v = (j >= L) ? -sinpif(a) : cospif(a);
    dst[idx] = f2bf(v);
  }
}

#define P0_WT 11520
#define P0_ADA 384
#define P0_XC 384
#define P0_CK 320
#define P0_CVT 640
#define P0_PQ 32
#define P0_DFT 272
#define P0_ITEMS (P0_ADA + P0_WT + P0_XC + P0_CK + P0_CVT + P0_PQ + P0_DFT + 1)

__device__ void p0_item(const Params& p, int it, unsigned char* smem) {
  float* sm = (float*)smem;
  if (it < P0_ADA) { adaln_item(p, it, sm); return; }
  it -= P0_ADA;
  if (it < P0_WT) {
    const int l = it / 2880; int r = it % 2880;
    if (r < 576) { transpose_tile(p.w_in + (size_t)l * 1024 * 2304, 2304, p.w_inT + (size_t)l * 2304 * 1024, 1024, (r / 36) * 64, (r % 36) * 64, sm); return; }
    r -= 576;
    if (r < 256) { transpose_tile(p.w_out + (size_t)l * 1024 * 1024, 1024, p.w_outT + (size_t)l * 1024 * 1024, 1024, (r / 16) * 64, (r % 16) * 64, sm); return; }
    r -= 256;
    if (r < 1024) { transpose_tile(p.w1 + (size_t)l * 1024 * 4096, 4096, p.w1T + (size_t)l * 4096 * 1024, 1024, (r / 64) * 64, (r % 64) * 64, sm); return; }
    r -= 1024;
    transpose_tile(p.w2 + (size_t)l * 4096 * 1024, 1024, p.w2T + (size_t)l * 1024 * 4096, 4096, (r / 16) * 64, (r % 16) * 64, sm);
    return;
  }
  it -= P0_WT;
  if (it < P0_XC) {
    const int row0 = it * 16;
    const float* src = row0 < NPTOK ? p.x_prompt + (size_t)row0 * 1024 : p.x_sample + (size_t)(row0 - NPTOK) * 1024;
    float* dst = p.xres + (size_t)row0 * 1024;
#pragma unroll
    for (int i = 0; i < 16; ++i) {
      const int o = (i * 256 + otid()) * 4;
      *(float4*)(dst + o) = *(const float4*)(src + o);
    }
    return;
  }
  it -= P0_XC;
  if (it < P0_CK) {
    if (it < 128) { cvt_item(p.c_na_k, p.ck_na, it); return; }
    it -= 128;
    if (it < 128) { cvt_item(p.c_diff_k, p.ck_diff, it); return; }
    it -= 128;
    cvt_item(p.c_swa_k, p.ck_swa, it);
    return;
  }
  it -= P0_CK;
  if (it < P0_CVT) {
    if (it < 256) { const int bl = it >> 5, r = it & 31; transpose_tile(p.c_na_v + (size_t)bl * 512 * 256, 256, p.cvt_na + (size_t)bl * 256 * 512, 512, (r >> 2) * 64, (r & 3) * 64, sm); return; }
    it -= 256;
    if (it < 256) { const int bl = it >> 5, r = it & 31; transpose_tile(p.c_diff_v + (size_t)bl * 512 * 256, 256, p.cvt_diff + (size_t)bl * 256 * 512, 512, (r >> 2) * 64, (r & 3) * 64, sm); return; }
    it -= 256;
    { const int bl = it >> 4, r = it & 15; transpose_tile(p.c_swa_v + (size_t)bl * 512 * 128, 128, p.cvt_swa + (size_t)bl * 128 * 512, 512, (r >> 1) * 64, (r & 1) * 64, sm); return; }
  }
  it -= P0_CVT;
  if (it < P0_PQ) { pq_item(p, it, sm); return; }
  it -= P0_PQ;
  if (it < 16) { dft_item(p.dft256, 256, it); return; }
  it -= 16;
  if (it < 256) { dft_item(p.dft1024, 1024, it); return; }
  for (int e = otid(); e < 512 + 1024; e += 256) {
    const bool isD = e < 512;
    const int ee = isD ? e : e - 512;
    const int nf = isD ? 8 : 16;
    const int pos = ee / nf, fi = ee % nf;
    const float inv = exp2f(-(float)fi * (13.287712379549449f / (float)nf));
    float tt = (float)pos * inv * 0.15915494309189535f;
    tt -= rintf(tt);
    float sn, cs;
    sincospif(2.f * tt, &sn, &cs);
    if (isD) { p.ropeD[ee] = cs; p.ropeD[512 + ee] = sn; }
    else { p.ropeS[ee] = cs; p.ropeS[1024 + ee] = sn; }
  }
}

__device__ __forceinline__ void norm_item(const Params& p, int l, int which, int it) {
  const int lane = otid() & 63, wave = otid() >> 6;
#pragma unroll 1
  for (int j = 0; j < 4; ++j) {
    const int row = it * 16 + wave * 4 + j;
    const float* xr = p.xres + (size_t)row * 1024;
    float4 v[4];
    float ss = 0.f;
#pragma unroll
    for (int k = 0; k < 4; ++k) {
      v[k] = *(const float4*)(xr + (k * 64 + lane) * 4);
      ss += v[k].x * v[k].x + v[k].y * v[k].y + v[k].z * v[k].z + v[k].w * v[k].w;
    }
#pragma unroll
    for (int o = 32; o >= 1; o >>= 1) ss += __shfl_xor(ss, o);
    const float rs = rsqrtf(ss * (1.f / 1024.f) + 1e-6f);
    if (which < 2) {
      const int cond = row < NPTOK ? 0 : 1 + ((row - NPTOK) >> 10);
      const float* gp = (which == 0 ? p.norm1_g : p.norm2_g) + l * 1024;
      const float* shp = p.mods + (size_t)(l * 3 + cond) * 6144 + (which * 3 + 0) * 1024;
      const float* scp = shp + 1024;
#pragma unroll
      for (int k = 0; k < 4; ++k) {
        const int col = (k * 64 + lane) * 4;
        const float4 gg = *(const float4*)(gp + col);
        const float4 sh = *(const float4*)(shp + col);
        const float4 sc = *(const float4*)(scp + col);
        uint2 w;
        w.x = pack2(v[k].x * rs * gg.x * (1.f + sc.x) + sh.x, v[k].y * rs * gg.y * (1.f + sc.y) + sh.y);
        w.y = pack2(v[k].z * rs * gg.z * (1.f + sc.z) + sh.z, v[k].w * rs * gg.w * (1.f + sc.w) + sh.w);
        *(uint2*)(p.h + (size_t)row * 1024 + col) = w;
      }
    } else {
#pragma unroll
      for (int k = 0; k < 4; ++k) {
        const int col = (k * 64 + lane) * 4;
        const float4 gg = *(const float4*)(p.final_g + col);
        float4 o;
        o.x = v[k].x * rs * gg.x; o.y = v[k].y * rs * gg.y; o.z = v[k].z * rs * gg.z; o.w = v[k].w * rs * gg.w;
        *(float4*)(p.out + (size_t)row * 1024 + col) = o;
      }
    }
  }
}

__device__ __forceinline__ void gemm_main(const u16* __restrict__ X, int ldx, const u16* __restrict__ Y, int ldy, int K,
                                          u16* smem, f32x4 (&acc)[4][4]) {
  const int tid = otid(), lane = tid & 63, wave = tid >> 6, wx = wave & 1, wy = wave >> 1, r = lane & 15, g = lane >> 4;
  u16* sX = smem;
  u16* sY = smem + 2 * 128 * LSTR;
  const int lrow = tid >> 3, lkc = tid & 7;
  const u16* gx = X + (size_t)lrow * ldx + lkc * 8;
  const u16* gy = Y + (size_t)lrow * ldy + lkc * 8;
  uint4 rx[4], ry[4];
#pragma unroll
  for (int i = 0; i < 4; ++i) {
    rx[i] = *(const uint4*)(gx + (size_t)(32 * i) * ldx);
    ry[i] = *(const uint4*)(gy + (size_t)(32 * i) * ldy);
  }
#pragma unroll
  for (int a = 0; a < 4; ++a)
#pragma unroll
    for (int b = 0; b < 4; ++b) acc[a][b] = (f32x4){0.f, 0.f, 0.f, 0.f};
#pragma unroll
  for (int i = 0; i < 4; ++i) {
    *(uint4*)(sX + (lrow + 32 * i) * LSTR + lkc * 8) = rx[i];
    *(uint4*)(sY + (lrow + 32 * i) * LSTR + lkc * 8) = ry[i];
  }
  __syncthreads();
  const int nk = K >> 6;
  for (int kt = 0; kt < nk; ++kt) {
    const int cur = kt & 1;
    const bool more = (kt + 1) < nk;
    if (more) {
#pragma unroll
      for (int i = 0; i < 4; ++i) {
        rx[i] = *(const uint4*)(gx + (size_t)(32 * i) * ldx + (kt + 1) * 64);
        ry[i] = *(const uint4*)(gy + (size_t)(32 * i) * ldy + (kt + 1) * 64);
      }
    }
    const u16* cx = sX + cur * 128 * LSTR + (wx * 64 + r) * LSTR + g * 8;
    const u16* cy = sY + cur * 128 * LSTR + (wy * 64 + r) * LSTR + g * 8;
#pragma unroll
    for (int kk = 0; kk < 2; ++kk) {
      bf16x8 a[4], b[4];
#pragma unroll
      for (int i = 0; i < 4; ++i) {
        a[i] = *(const bf16x8*)(cx + i * 16 * LSTR + kk * 32);
        b[i] = *(const bf16x8*)(cy + i * 16 * LSTR + kk * 32);
      }
#pragma unroll
      for (int xi = 0; xi < 4; ++xi)
#pragma unroll
        for (int yi = 0; yi < 4; ++yi)
          acc[xi][yi] = __builtin_amdgcn_mfma_f32_16x16x32_bf16(a[xi], b[yi], acc[xi][yi], 0, 0, 0);
    }
    if (more) {
      u16* dX = sX + (cur ^ 1) * 128 * LSTR;
      u16* dY = sY + (cur ^ 1) * 128 * LSTR;
#pragma unroll
      for (int i = 0; i < 4; ++i) {
        *(uint4*)(dX + (lrow + 32 * i) * LSTR + lkc * 8) = rx[i];
        *(uint4*)(dY + (lrow + 32 * i) * LSTR + lkc * 8) = ry[i];
      }
    }
    __syncthreads();
  }
}

__device__ void gin_tile(const Params& p, int l, int it, u16* smem) {
  const int ty = it % 48, tx = it / 48;
  const int n0 = tx * 128, m0 = ty * 128;
  f32x4 acc[4][4];
  gemm_main(p.w_inT + (size_t)l * 2304 * 1024 + (size_t)n0 * 1024, 1024, p.h + (size_t)m0 * 1024, 1024, 1024, smem, acc);
  const int lane = otid() & 63, wave = otid() >> 6, wx = wave & 1, wy = wave >> 1, r = lane & 15, g = lane >> 4;
  const int nw = n0 + wx * 64;
  const bool isS = m0 >= NPTOK;
  int ropeMode = 0;
  if (isS) {
    if (nw >= 768 && nw < 1280) ropeMode = 1;
    else if (nw >= 1792 && nw < 2176) ropeMode = 2;
  }
  float* okv = nullptr; int okv_w = 0, okv_c = 0;
  if (!isS) {
    if (nw >= 256 && nw < 512) { okv = p.out + O_NAK; okv_w = 256; okv_c = nw - 256; }
    else if (nw >= 512 && nw < 768) { okv = p.out + O_NAV; okv_w = 256; okv_c = nw - 512; }
    else if (nw >= 1024 && nw < 1280) { okv = p.out + O_DK; okv_w = 256; okv_c = nw - 1024; }
    else if (nw >= 1280 && nw < 1536) { okv = p.out + O_DV; okv_w = 256; okv_c = nw - 1280; }
    else if (nw >= 2048 && nw < 2176) { okv = p.out + O_SK; okv_w = 128; okv_c = nw - 2048; }
    else if (nw >= 2176) { okv = p.out + O_SV; okv_w = 128; okv_c = nw - 2176; }
  }
  int vrow = -1;
  if (nw >= 512 && nw < 768) vrow = nw - 512;
  else if (nw >= 1280 && nw < 1536) vrow = 256 + nw - 1280;
  else if (nw >= 2176) vrow = 512 + nw - 2176;
#pragma unroll
  for (int yi = 0; yi < 4; ++yi) {
    const int m = m0 + wy * 64 + yi * 16 + r;
    const int t = (m - NPTOK) & 1023;
    const int prow = t >> 6, pcol = t & 63;
#pragma unroll
    for (int xi = 0; xi < 4; ++xi) {
      f32x4 v = acc[xi][yi];
      if (ropeMode == 1) {
        const int pos = (xi & 1) ? pcol : prow;
        const float4 cs = *(const float4*)(p.ropeD + pos * 8 + 4 * (g & 1));
        const float4 sn = *(const float4*)(p.ropeD + 512 + pos * 8 + 4 * (g & 1));
        const float sg = (g >= 2) ? 1.f : -1.f;
        const float o0 = __shfl_xor(v[0], 32), o1 = __shfl_xor(v[1], 32), o2 = __shfl_xor(v[2], 32), o3 = __shfl_xor(v[3], 32);
        v[0] = v[0] * cs.x + sg * o0 * sn.x; v[1] = v[1] * cs.y + sg * o1 * sn.y;
        v[2] = v[2] * cs.z + sg * o2 * sn.z; v[3] = v[3] * cs.w + sg * o3 * sn.w;
      } else if (ropeMode == 2) {
        const int pos = (xi >> 1) ? pcol : prow;
        const float4 cs = *(const float4*)(p.ropeS + pos * 16 + 4 * g);
        const float4 sn = *(const float4*)(p.ropeS + 1024 + pos * 16 + 4 * g);
        const f32x4 o = acc[xi ^ 1][yi];
        const float sg = (xi & 1) ? 1.f : -1.f;
        v[0] = v[0] * cs.x + sg * o[0] * sn.x; v[1] = v[1] * cs.y + sg * o[1] * sn.y;
        v[2] = v[2] * cs.z + sg * o[2] * sn.z; v[3] = v[3] * cs.w + sg * o[3] * sn.w;
      }
      const int nloc = xi * 16 + 4 * g;
      if (okv) {
        const int b = m >> 8, pos = m & 255;
        float4 o4; o4.x = v[0]; o4.y = v[1]; o4.z = v[2]; o4.w = v[3];
        *(float4*)(okv + ((size_t)((b * 4 + l) * 256 + pos)) * okv_w + okv_c + nloc) = o4;
      }
      if (vrow >= 0) {
#pragma unroll
        for (int i = 0; i < 4; ++i) p.vt[(size_t)(vrow + nloc + i) * NTOK + m] = f2bf(v[i]);
      } else {
        uint2 w; w.x = pack2(v[0], v[1]); w.y = pack2(v[2], v[3]);
        *(uint2*)(p.z + (size_t)m * INW + nw + nloc) = w;
      }
    }
  }
}

__device__ void res_tile(const Params& p, int l, int it, const u16* A, const u16* WT, int K, int gi, u16* smem) {
  const int ty = it % 48, tx = it / 48;
  const int n0 = tx * 128, m0 = ty * 128;
  f32x4 acc[4][4];
  gemm_main(WT + (size_t)n0 * K, K, A + (size_t)m0 * K, K, K, smem, acc);
  const int lane = otid() & 63, wave = otid() >> 6, wx = wave & 1, wy = wave >> 1, r = lane & 15, g = lane >> 4;
  const int cond = m0 < NPTOK ? 0 : 1 + ((m0 - NPTOK) >> 10);
  const float* gate = p.mods + (size_t)(l * 3 + cond) * 6144 + gi * 1024;
#pragma unroll
  for (int xi = 0; xi < 4; ++xi) {
    const int n = n0 + wx * 64 + xi * 16 + 4 * g;
    const float4 gt = *(const float4*)(gate + n);
#pragma unroll
    for (int yi = 0; yi < 4; ++yi) {
      const int m = m0 + wy * 64 + yi * 16 + r;
      float* xp = p.xres + (size_t)m * 1024 + n;
      float4 xv = *(const float4*)xp;
      const f32x4 v = acc[xi][yi];
      xv.x += gt.x * v[0]; xv.y += gt.y * v[1]; xv.z += gt.z * v[2]; xv.w += gt.w * v[3];
      *(float4*)xp = xv;
    }
  }
}

__device__ void m1_tile(const Params& p, int l, int it, u16* smem) {
  const int ty = it % 48, tx = it / 48;
  const int n0 = tx * 128, m0 = ty * 128;
  f32x4 acc[4][4];
  gemm_main(p.w1T + (size_t)l * 4096 * 1024 + (size_t)n0 * 1024, 1024, p.h + (size_t)m0 * 1024, 1024, 1024, smem, acc);
  const int lane = otid() & 63, wave = otid() >> 6, wx = wave & 1, wy = wave >> 1, r = lane & 15, g = lane >> 4;
#pragma unroll
  for (int xi = 0; xi < 4; ++xi) {
    const int n = n0 + wx * 64 + xi * 16 + 4 * g;
#pragma unroll
    for (int yi = 0; yi < 4; ++yi) {
      const int m = m0 + wy * 64 + yi * 16 + r;
      const f32x4 v = acc[xi][yi];
      float a0 = fmaxf(v[0], 0.f), a1 = fmaxf(v[1], 0.f), a2 = fmaxf(v[2], 0.f), a3 = fmaxf(v[3], 0.f);
      uint2 w; w.x = pack2(a0 * a0, a1 * a1); w.y = pack2(a2 * a2, a3 * a3);
      *(uint2*)(p.u + (size_t)m * 4096 + n) = w;
    }
  }
}

__device__ void f1_tile(const Params& p, int l, int it, u16* smem) {
  const int tx = it % 48, ty = it / 48;
  const int x0 = tx * 128, y0 = ty * 128;
  f32x4 acc[4][4];
  gemm_main(p.z + (size_t)x0 * INW + 1536, INW, p.pqt + (size_t)l * 512 * 256 + (size_t)y0 * 256, 256, 256, smem, acc);
  const int lane = otid() & 63, wave = otid() >> 6, wx = wave & 1, wy = wave >> 1, r = lane & 15, g = lane >> 4;
#pragma unroll
  for (int yi = 0; yi < 4; ++yi) {
    const int y = y0 + wy * 64 + yi * 16 + r;
    const int col = y & 255, which = y >> 8;
#pragma unroll
    for (int xi = 0; xi < 4; ++xi) {
      const int tok = x0 + wx * 64 + xi * 16 + 4 * g;
      size_t addr;
      if (tok < NPTOK) {
        const int b = tok >> 8, pos = tok & 255;
        addr = (size_t)b * (256 * 512) + (size_t)col * 512 + which * 256 + pos;
      } else {
        const int b = (tok - NPTOK) >> 10, pos = (tok - NPTOK) & 1023;
        addr = (size_t)16 * 256 * 512 + (size_t)b * (256 * 2048) + (size_t)col * 2048 + which * 1024 + pos;
      }
      const f32x4 v = acc[xi][yi];
      uint2 w; w.x = pack2(v[0], v[1]); w.y = pack2(v[2], v[3]);
      *(uint2*)(p.uv + addr) = w;
    }
  }
}

__device__ void f2_tile(const Params& p, int it, u16* smem) {
  int L, b, tx, ty, tokbase;
  const u16* uvb; const u16* dft;
  if (it < 32) { L = 1024; b = it >> 4; tx = (it >> 3) & 1; ty = it & 7; uvb = p.uv + (size_t)16 * 256 * 512 + (size_t)b * (256 * 2048); dft = p.dft1024; tokbase = NPTOK + b * 1024; }
  else { it -= 32; L = 256; b = it >> 2; tx = (it >> 1) & 1; ty = it & 1; uvb = p.uv + (size_t)b * (256 * 512); dft = p.dft256; tokbase = b * 256; }
  const int x0 = tx * 128, y0 = ty * 128, K = 2 * L;
  f32x4 acc[4][4];
  gemm_main(uvb + (size_t)x0 * K, K, dft + (size_t)y0 * K, K, K, smem, acc);
  const int lane = otid() & 63, wave = otid() >> 6, wx = wave & 1, wy = wave >> 1, r = lane & 15, g = lane >> 4;
  const float scale = rsqrtf(64.f * (float)L);
#pragma unroll
  for (int yi = 0; yi < 4; ++yi) {
    const int pos = y0 + wy * 64 + yi * 16 + r;
#pragma unroll
    for (int xi = 0; xi < 4; ++xi) {
      const int col = x0 + wx * 64 + xi * 16 + 4 * g;
      const f32x4 v = acc[xi][yi];
      uint2 w; w.x = pack2(v[0] * scale, v[1] * scale); w.y = pack2(v[2] * scale, v[3] * scale);
      *(uint2*)(p.cat + (size_t)(tokbase + pos) * 1024 + 512 + col) = w;
    }
  }
}

struct Seg { const u16* K; const u16* Vt; int ldk, ldv, nblk, pos0, stride; };
template <int QT> struct AState { float m[QT]; float ls[QT]; f32x4 o[QT][4]; };

template <int DC>
__device__ __forceinline__ void load_blk(const Seg& s0, const Seg& s1, int b, int r, int g, bf16x8 (&kf)[2][DC], bf16x8 (&vf)[4]) {
  const bool in0 = b < s0.nblk;
  const u16* Kp = in0 ? s0.K : s1.K;
  const u16* Vp = in0 ? s0.Vt : s1.Vt;
  const int ldk = in0 ? s0.ldk : s1.ldk, ldv = in0 ? s0.ldv : s1.ldv;
  const int pos = in0 ? (s0.pos0 + b * s0.stride) : (s1.pos0 + (b - s0.nblk) * s1.stride);
  const int krow = pos + 8 * (r >> 2) + (r & 3);
#pragma unroll
  for (int t = 0; t < 2; ++t) {
    const u16* kp = Kp + (size_t)(krow + 4 * t) * ldk + g * 8;
#pragma unroll
    for (int dc = 0; dc < DC; ++dc) kf[t][dc] = *(const bf16x8*)(kp + dc * 32);
  }
#pragma unroll
  for (int dv = 0; dv < 4; ++dv) vf[dv] = *(const bf16x8*)(Vp + (size_t)(dv * 16 + r) * ldv + pos + 8 * g);
}

template <int D, int QT, int MODE>
__device__ __forceinline__ void attn_run(const Seg& s0, const Seg& s1, const bf16x8 (&qf)[QT][D / 32], const float sc,
                                         AState<QT>& st, const int qpos0, const float* __restrict__ rpb_h) {
  constexpr int DC = D / 32;
  const int lane = otid() & 63, r = lane & 15, g = lane >> 4;
  const int nb = s0.nblk + s1.nblk;
  bf16x8 kc[2][DC], vc[4];
  load_blk<DC>(s0, s1, 0, r, g, kc, vc);
  for (int b = 0; b < nb; ++b) {
    bf16x8 kn[2][DC], vn[4];
    load_blk<DC>(s0, s1, (b + 1 < nb) ? b + 1 : b, r, g, kn, vn);
    const bool in0 = b < s0.nblk;
    const int pos = in0 ? (s0.pos0 + b * s0.stride) : (s1.pos0 + (b - s0.nblk) * s1.stride);
#pragma unroll
    for (int q = 0; q < QT; ++q) {
      f32x4 s_[2];
      s_[0] = (f32x4){0.f, 0.f, 0.f, 0.f};
      s_[1] = (f32x4){0.f, 0.f, 0.f, 0.f};
#pragma unroll
      for (int t = 0; t < 2; ++t)
#pragma unroll
        for (int dc = 0; dc < DC; ++dc) s_[t] = __builtin_amdgcn_mfma_f32_16x16x32_bf16(kc[t][dc], qf[q][dc], s_[t], 0, 0, 0);
      float sv[8];
#pragma unroll
      for (int t = 0; t < 2; ++t)
#pragma unroll
        for (int i = 0; i < 4; ++i) {
          float x = s_[t][i] * sc;
          if (MODE == 1) {
            if (!in0) {
              const int qpos = qpos0 + q * 16 + r;
              const int qrow = qpos >> 6, cq = qpos & 63;
              const int kpos = pos + 8 * g + 4 * t + i;
              const int krow = kpos >> 6, ck = kpos & 63;
              const int cs = min(max(cq - 8, 0), 48);
              const bool valid = (ck >= cs) && (ck < cs + 16);
              const int bi = (krow - qrow + 7) * 31 + (ck - cq + 15);
              const float bias = valid ? rpb_h[bi] : 0.f;
              x = valid ? (x + bias * LOG2E) : -1e30f;
            }
          } else if (MODE == 2) {
            if (!in0) {
              const int qpos = qpos0 + q * 16 + r;
              const int kpos = pos + 8 * g + 4 * t + i;
              const int d = qpos - kpos;
              x = (d <= 128 && d >= -128) ? x : -1e30f;
            }
          }
          sv[4 * t + i] = x;
        }
      float mx = fmaxf(fmaxf(fmaxf(sv[0], sv[1]), fmaxf(sv[2], sv[3])), fmaxf(fmaxf(sv[4], sv[5]), fmaxf(sv[6], sv[7])));
      mx = fmaxf(mx, __shfl_xor(mx, 16));
      mx = fmaxf(mx, __shfl_xor(mx, 32));
      const float mnew = fmaxf(st.m[q], mx);
      const float alpha = exp2f(st.m[q] - mnew);
      st.m[q] = mnew;
      float ps = 0.f;
#pragma unroll
      for (int j = 0; j < 8; ++j) { sv[j] = exp2f(sv[j] - mnew); ps += sv[j]; }
      st.ls[q] = st.ls[q] * alpha + ps;
      union { bf16x8 v; unsigned w[4]; } pf;
      pf.w[0] = pack2(sv[0], sv[1]); pf.w[1] = pack2(sv[2], sv[3]); pf.w[2] = pack2(sv[4], sv[5]); pf.w[3] = pack2(sv[6], sv[7]);
#pragma unroll
      for (int dv = 0; dv < 4; ++dv) {
        f32x4 o = st.o[q][dv];
        o[0] *= alpha; o[1] *= alpha; o[2] *= alpha; o[3] *= alpha;
        st.o[q][dv] = __builtin_amdgcn_mfma_f32_16x16x32_bf16(vc[dv], pf.v, o, 0, 0, 0);
      }
    }
#pragma unroll
    for (int t = 0; t < 2; ++t)
#pragma unroll
      for (int dc = 0; dc < DC; ++dc) kc[t][dc] = kn[t][dc];
#pragma unroll
    for (int dv = 0; dv < 4; ++dv) vc[dv] = vn[dv];
  }
}

template <int QT>
__device__ __forceinline__ void astate_init(AState<QT>& st, float m0, float l0) {
#pragma unroll
  for (int q = 0; q < QT; ++q) {
    st.m[q] = m0; st.ls[q] = l0;
#pragma unroll
    for (int dv = 0; dv < 4; ++dv) st.o[q][dv] = (f32x4){0.f, 0.f, 0.f, 0.f};
  }
}
template <int QT>
__device__ __forceinline__ void astate_finalize(AState<QT>& st) {
#pragma unroll
  for (int q = 0; q < QT; ++q) {
    float l = st.ls[q];
    l += __shfl_xor(l, 16);
    l += __shfl_xor(l, 32);
    const float inv = 1.f / l;
#pragma unroll
    for (int dv = 0; dv < 4; ++dv) { st.o[q][dv][0] *= inv; st.o[q][dv][1] *= inv; st.o[q][dv][2] *= inv; st.o[q][dv][3] *= inv; }
  }
}
template <int DC, int QT>
__device__ __forceinline__ void load_q(const u16* zq  , bf16x8 (&qf)[QT][DC]) {
  const int lane = otid() & 63, r = lane & 15, g = lane >> 4;
#pragma unroll
  for (int q = 0; q < QT; ++q)
#pragma unroll
    for (int dc = 0; dc < DC; ++dc) qf[q][dc] = *(const bf16x8*)(zq + (size_t)(q * 16 + r) * INW + dc * 32 + g * 8);
}
template <int QT>
__device__ __forceinline__ void write_o(const Params& p, const AState<QT>& st, int tok0, int col0) {
  const int lane = otid() & 63, r = lane & 15, g = lane >> 4;
#pragma unroll
  for (int q = 0; q < QT; ++q)
#pragma unroll
    for (int dv = 0; dv < 4; ++dv) {
      const f32x4 v = st.o[q][dv];
      uint2 w; w.x = pack2(v[0], v[1]); w.y = pack2(v[2], v[3]);
      *(uint2*)(p.cat + (size_t)(tok0 + q * 16 + r) * 1024 + col0 + dv * 16 + 4 * g) = w;
    }
}

__device__ __forceinline__ float diff_lambda(const Params& p, int l, float lam_init) {
  const int lane = otid() & 63;
  float a = 0.f, b = 0.f;
  if (lane < 32) { a = p.lq1[l * 32 + lane] * p.lk1[l * 32 + lane]; b = p.lq2[l * 32 + lane] * p.lk2[l * 32 + lane]; }
#pragma unroll
  for (int o = 32; o >= 1; o >>= 1) { a += __shfl_xor(a, o); b += __shfl_xor(b, o); }
  return expf(a) - expf(b) + lam_init;
}

template <int QT>
__device__ __forceinline__ void diff_finish(const Params& p, int l, AState<QT>& s1, const AState<QT>& s2, int tok0, int col0) {
  const int lane = otid() & 63, g = lane >> 4;
  const float lam_init = 0.8f - 0.6f * expf(-0.3f * (float)l);
  const float lam = diff_lambda(p, l, lam_init);
  const float* sg = p.subln_g + l * 64;
#pragma unroll
  for (int q = 0; q < QT; ++q) {
    float ss = 0.f;
#pragma unroll
    for (int dv = 0; dv < 4; ++dv)
#pragma unroll
      for (int i = 0; i < 4; ++i) {
        const float v = s1.o[q][dv][i] - lam * s2.o[q][dv][i];
        s1.o[q][dv][i] = v;
        ss += v * v;
      }
    ss += __shfl_xor(ss, 16);
    ss += __shfl_xor(ss, 32);
    const float rs = rsqrtf(ss * (1.f / 64.f) + 1e-6f) * (1.f - lam_init);
#pragma unroll
    for (int dv = 0; dv < 4; ++dv) {
      const float4 gg = *(const float4*)(sg + dv * 16 + 4 * g);
      s1.o[q][dv][0] *= rs * gg.x; s1.o[q][dv][1] *= rs * gg.y; s1.o[q][dv][2] *= rs * gg.z; s1.o[q][dv][3] *= rs * gg.w;
    }
  }
  write_o<QT>(p, s1, tok0, col0);
}

__device__ void attn_ctx_item(const Params& p, int l, int bi) {
  const int wave = otid() >> 6, lane = otid() & 63, g = lane >> 4;
  const int w = bi * 4 + wave;
  const int type = w >> 10, rem = w & 1023;
  const int b = rem >> 6, h = (rem >> 4) & 3, qt = rem & 15;
  const int tokb = b * 256, tok0 = tokb + qt * 16;
  const u16* zb = p.z + (size_t)tokb * INW;
  Seg sN; sN.K = nullptr; sN.Vt = nullptr; sN.ldk = 0; sN.ldv = 0; sN.nblk = 0; sN.pos0 = 0; sN.stride = 0;
  if (type < 2) {
    const int kvh = h >> 1;
    const int qcol = type == 0 ? h * 64 : 1792 + h * 64;
    const int kcol = type == 0 ? 256 + h * 64 : 2048 + kvh * 64;
    const int vrow = type == 0 ? h * 64 : 512 + kvh * 64;
    const int ocol = type == 0 ? h * 64 : 768 + h * 64;
    bf16x8 qf[1][2];
    load_q<2, 1>(p.z + (size_t)tok0 * INW + qcol, qf);
    Seg s0; s0.K = zb + kcol; s0.Vt = p.vt + (size_t)vrow * NTOK + tokb; s0.ldk = INW; s0.ldv = NTOK; s0.nblk = 8; s0.pos0 = 0; s0.stride = 32;
    AState<1> st;
    const float sk = type == 0 ? -1e30f : p.swa_sink[l * 4 + h] * LOG2E;
    astate_init<1>(st, sk, (type == 1 && g == 0) ? 1.f : 0.f);
    attn_run<64, 1, 0>(s0, sN, qf, 0.125f * LOG2E, st, 0, nullptr);
    astate_finalize<1>(st);
    write_o<1>(p, st, tok0, ocol);
  } else {
    AState<1> st1, st2;
#pragma unroll 1
    for (int ps = 0; ps < 2; ++ps) {
      bf16x8 qf[1][1];
      load_q<1, 1>(p.z + (size_t)tok0 * INW + 768 + h * 64 + ps * 32, qf);
      Seg s0; s0.K = zb + 1024 + h * 64 + ps * 32; s0.Vt = p.vt + (size_t)(256 + h * 64) * NTOK + tokb; s0.ldk = INW; s0.ldv = NTOK; s0.nblk = 8; s0.pos0 = 0; s0.stride = 32;
      AState<1> st;
      astate_init<1>(st, -1e30f, 0.f);
      attn_run<32, 1, 0>(s0, sN, qf, 0.17677669529663687f * LOG2E, st, 0, nullptr);
      astate_finalize<1>(st);
      if (ps == 0) st1 = st; else st2 = st;
    }
    diff_finish<1>(p, l, st1, st2, tok0, 256 + h * 64);
  }
}

__device__ void attn_lat_item(const Params& p, int l, int bi) {
  const int wave = otid() >> 6, lane = otid() & 63, g = lane >> 4;
  const int w = bi * 4 + wave;
  const int type = w >> 9, rem = w & 511;
  const int b = rem >> 8, h = (rem >> 6) & 3, qt = rem & 63;
  const int q0 = qt * 16;
  const int tokb = NPTOK + b * 1024, tok0 = tokb + q0;
  const u16* zb = p.z + (size_t)tokb * INW;
  const int bl = b * 4 + l;
  if (type == 0) {
    AState<1> st1, st2;
#pragma unroll 1
    for (int ps = 0; ps < 2; ++ps) {
      bf16x8 qf[1][1];
      load_q<1, 1>(p.z + (size_t)tok0 * INW + 768 + h * 64 + ps * 32, qf);
      Seg s0; s0.K = p.ck_diff + (size_t)bl * 512 * 256 + h * 64 + ps * 32; s0.Vt = p.cvt_diff + (size_t)(bl * 256 + h * 64) * 512; s0.ldk = 256; s0.ldv = 512; s0.nblk = 16; s0.pos0 = 0; s0.stride = 32;
      Seg s1; s1.K = zb + 1024 + h * 64 + ps * 32; s1.Vt = p.vt + (size_t)(256 + h * 64) * NTOK + tokb; s1.ldk = INW; s1.ldv = NTOK; s1.nblk = 32; s1.pos0 = 0; s1.stride = 32;
      AState<1> st;
      astate_init<1>(st, -1e30f, 0.f);
      attn_run<32, 1, 0>(s0, s1, qf, 0.17677669529663687f * LOG2E, st, 0, nullptr);
      astate_finalize<1>(st);
      if (ps == 0) st1 = st; else st2 = st;
    }
    diff_finish<1>(p, l, st1, st2, tok0, 256 + h * 64);
  } else if (type == 1) {
    const int kvh = h >> 1;
    bf16x8 qf[1][2];
    load_q<2, 1>(p.z + (size_t)tok0 * INW + 1792 + h * 64, qf);
    Seg s0; s0.K = p.ck_swa + (size_t)bl * 512 * 128 + kvh * 64; s0.Vt = p.cvt_swa + (size_t)(bl * 128 + kvh * 64) * 512; s0.ldk = 128; s0.ldv = 512; s0.nblk = 16; s0.pos0 = 0; s0.stride = 32;
    const int lo = max(0, q0 - 128) & ~31;
    const int hi = min(1024, (q0 + 15 + 128 + 1 + 31) & ~31);
    Seg s1; s1.K = zb + 2048 + kvh * 64; s1.Vt = p.vt + (size_t)(512 + kvh * 64) * NTOK + tokb; s1.ldk = INW; s1.ldv = NTOK; s1.nblk = (hi - lo) >> 5; s1.pos0 = lo; s1.stride = 32;
    AState<1> st;
    astate_init<1>(st, p.swa_sink[l * 4 + h] * LOG2E, g == 0 ? 1.f : 0.f);
    attn_run<64, 1, 2>(s0, s1, qf, 0.125f * LOG2E, st, q0, nullptr);
    astate_finalize<1>(st);
    write_o<1>(p, st, tok0, 768 + h * 64);
  } else {
    bf16x8 qf[1][2];
    load_q<2, 1>(p.z + (size_t)tok0 * INW + h * 64, qf);
    Seg s0; s0.K = p.ck_na + (size_t)bl * 512 * 256 + h * 64; s0.Vt = p.cvt_na + (size_t)(bl * 256 + h * 64) * 512; s0.ldk = 256; s0.ldv = 512; s0.nblk = 16; s0.pos0 = 0; s0.stride = 32;
    const int qrow = q0 >> 6, c0 = q0 & 63;
    const int rstart = min(max(qrow - 4, 0), 8);
    const int kc0 = min(max(c0 - 8, 0), 32);
    Seg s1; s1.K = zb + 256 + h * 64; s1.Vt = p.vt + (size_t)(h * 64) * NTOK + tokb; s1.ldk = INW; s1.ldv = NTOK; s1.nblk = 8; s1.pos0 = rstart * 64 + kc0; s1.stride = 64;
    AState<1> st;
    astate_init<1>(st, -1e30f, 0.f);
    attn_run<64, 1, 1>(s0, s1, qf, 0.125f * LOG2E, st, q0, p.na_rpb + (size_t)(l * 4 + h) * 15 * 31);
    astate_finalize<1>(st);
    write_o<1>(p, st, tok0, h * 64);
  }
}

__global__ void __launch_bounds__(256, 2) mega(Params p) {
  extern __shared__ __attribute__((aligned(16))) unsigned char smem[];
  cg::grid_group grid = cg::this_grid();
  const int nblk = gridDim.x, bid = blockIdx.x;
  u16* sm16 = (u16*)smem;

  for (int it = bid; it < P0_ITEMS; it += nblk) p0_item(p, it, smem);
  grid.sync();

#pragma unroll 1
  for (int l = 0; l < 4; ++l) {
    for (int it = bid; it < 384; it += nblk) norm_item(p, l, 0, it);
    grid.sync();
    for (int it = bid; it < 18 * 48; it += nblk) gin_tile(p, l, it, sm16);
    grid.sync();
    for (int it = bid; it < 192 + 768; it += nblk) {
      if (it < 192) f1_tile(p, l, it, sm16);
      else attn_ctx_item(p, l, it - 192);
    }
    grid.sync();
    for (int it = bid; it < 96 + 384; it += nblk) {
      if (it < 96) f2_tile(p, it, sm16);
      else attn_lat_item(p, l, it - 96);
    }
    grid.sync();
    for (int it = bid; it < 8 * 48; it += nblk) res_tile(p, l, it, p.cat, p.w_outT + (size_t)l * 1024 * 1024, 1024, 2, sm16);
    grid.sync();
    for (int it = bid; it < 384; it += nblk) norm_item(p, l, 1, it);
    grid.sync();
    for (int it = bid; it < 32 * 48; it += nblk) m1_tile(p, l, it, sm16);
    grid.sync();
    for (int it = bid; it < 8 * 48; it += nblk) res_tile(p, l, it, p.u, p.w2T + (size_t)l * 1024 * 4096, 4096, 5, sm16);
    grid.sync();
  }
  for (int it = bid; it < 384; it += nblk) norm_item(p, 0, 2, it);
}

extern "C" void kernel_launch(void* const* d_in, const int* in_sizes, int n_in, void* d_out, int out_size, void* d_ws,
                              size_t ws_size, hipStream_t stream) {
  static int grid_blocks = 0;
  if (grid_blocks == 0) {
    int dev = 0, cus = 0, per_cu = 0;
    hipGetDevice(&dev);
    hipDeviceGetAttribute(&cus, hipDeviceAttributeMultiprocessorCount, dev);
    if (hipFuncSetAttribute((const void*)mega, hipFuncAttributeMaxDynamicSharedMemorySize, LDS_BYTES) != hipSuccess) {
      fprintf(stderr, "hipFuncSetAttribute failed\n");
    }
    if (hipOccupancyMaxActiveBlocksPerMultiprocessor(&per_cu, (const void*)mega, 256, LDS_BYTES) != hipSuccess || per_cu < 1) {
      fprintf(stderr, "occupancy query failed (%d)\n", per_cu);
      per_cu = 1;
    }
    if (per_cu > 2) per_cu = 2;
    grid_blocks = cus * per_cu;
    fprintf(stderr, "mega: cus=%d per_cu=%d grid=%d ws=%zu\n", cus, per_cu, grid_blocks, ws_size);
  }
  Params p{};
  const float** pin = (const float**)&p;
  for (int i = 0; i < 27; ++i) pin[i] = (const float*)d_in[i];
  p.out = (float*)d_out;
  unsigned char* ws = (unsigned char*)d_ws;
  size_t off = 0;
  auto take = [&](size_t bytes) { unsigned char* q = ws + off; off += (bytes + 255) & ~(size_t)255; return q; };
  p.xres = (float*)take((size_t)NTOK * 1024 * 4);
  p.mods = (float*)take((size_t)4 * 3 * 6144 * 4);
  p.h = (u16*)take((size_t)NTOK * 1024 * 2);
  p.z = (u16*)take((size_t)NTOK * INW * 2);
  p.vt = (u16*)take((size_t)640 * NTOK * 2);
  p.cat = (u16*)take((size_t)NTOK * 1024 * 2);
  p.u = (u16*)take((size_t)NTOK * 4096 * 2);
  p.uv = (u16*)take((size_t)(16 * 256 * 512 + 2 * 256 * 2048) * 2);
  p.w_inT = (u16*)take((size_t)4 * 2304 * 1024 * 2);
  p.w_outT = (u16*)take((size_t)4 * 1024 * 1024 * 2);
  p.w1T = (u16*)take((size_t)4 * 4096 * 1024 * 2);
  p.w2T = (u16*)take((size_t)4 * 4096 * 1024 * 2);
  p.pqt = (u16*)take((size_t)4 * 512 * 256 * 2);
  p.dft256 = (u16*)take((size_t)256 * 512 * 2);
  p.dft1024 = (u16*)take((size_t)1024 * 2048 * 2);
  p.ck_na = (u16*)take((size_t)2 * 4 * 512 * 256 * 2);
  p.cvt_na = (u16*)take((size_t)2 * 4 * 512 * 256 * 2);
  p.ck_diff = (u16*)take((size_t)2 * 4 * 512 * 256 * 2);
  p.cvt_diff = (u16*)take((size_t)2 * 4 * 512 * 256 * 2);
  p.ck_swa = (u16*)take((size_t)2 * 4 * 512 * 128 * 2);
  p.cvt_swa = (u16*)take((size_t)2 * 4 * 512 * 128 * 2);
  p.ropeD = (float*)take(1024 * 4);
  p.ropeS = (float*)take(2048 * 4);
  if (off > ws_size) { fprintf(stderr, "workspace too small: need %zu have %zu\n", off, ws_size); return; }
  void* args[] = {&p};
  hipError_t e = hipLaunchCooperativeKernel((const void*)mega, dim3(grid_blocks), dim3(256), args, LDS_BYTES, stream);
  if (e != hipSuccess) fprintf(stderr, "cooperative launch failed: %s (grid %d)\n", hipGetErrorString(e), grid_blocks);
}
```

```cpp
#include <hip/hip_runtime.h>
#include <hip/hip_cooperative_groups.h>
#include <stdint.h>
#include <stdio.h>
namespace cg = cooperative_groups;

typedef unsigned short u16;
typedef __attribute__((ext_vector_type(8))) short bf16x8;
typedef __attribute__((ext_vector_type(4))) float f32x4;

#define NTOK 6144
#define NPTOK 4096
#define INW 2304
#define LOG2E 1.4426950408889634f
#define LDS_BYTES 73728
#define LSTR 72

#define O_NAK 6291456
#define O_NAV 10485760
#define O_DK 14680064
#define O_DV 18874368
#define O_SK 23068672
#define O_SV 25165824

struct Params {
  const float *x_prompt, *x_sample, *c_na_k, *c_na_v, *c_diff_k, *c_diff_v, *c_swa_k, *c_swa_v, *c, *c_ctx;
  const float *w_ada, *b_ada, *norm1_g, *norm2_g, *w_in, *na_rpb, *lq1, *lk1, *lq2, *lk2, *subln_g, *w_fourier, *swa_sink;
  const float *w_out, *w1, *w2, *final_g;
  float* out;
  float* xres;
  float* mods;
  u16 *h, *z, *vt, *cat, *u, *uv, *w_inT, *w_outT, *w1T, *w2T, *pqt, *dft256, *dft1024;
  u16 *ck_na, *cvt_na, *ck_diff, *cvt_diff, *ck_swa, *cvt_swa;
  float *ropeD, *ropeS;
  unsigned* bar;
};

__device__ __forceinline__ u16 f2bf(float f) {
  unsigned u = __float_as_uint(f);
  u += 0x7fffu + ((u >> 16) & 1u);
  return (u16)(u >> 16);
}
__device__ __forceinline__ int otid() { int t = threadIdx.x; asm volatile("" : "+v"(t)); return t; }
__device__ __forceinline__ float bf2f(u16 h) { return __uint_as_float(((unsigned)h) << 16); }
__device__ __forceinline__ unsigned pack2(float a, float b) { return (unsigned)f2bf(a) | ((unsigned)f2bf(b) << 16); }

__device__ __forceinline__ void transpose_tile(const float* __restrict__ src, int lds_, u16* __restrict__ dst, int ldd,
                                               int k0, int n0, float* sm) {
  const int tid = otid();
  const int c4 = (tid & 15) * 4, r0 = tid >> 4;
#pragma unroll
  for (int i = 0; i < 4; ++i) {
    const int k = r0 + 16 * i;
    const float4 v = *(const float4*)(src + (size_t)(k0 + k) * lds_ + n0 + c4);
    sm[k * 65 + c4 + 0] = v.x; sm[k * 65 + c4 + 1] = v.y; sm[k * 65 + c4 + 2] = v.z; sm[k * 65 + c4 + 3] = v.w;
  }
  __syncthreads();
  const int k8 = (tid & 7) * 8, nn = tid >> 3;
#pragma unroll
  for (int i = 0; i < 2; ++i) {
    const int n = nn + 32 * i;
    uint4 w;
    w.x = pack2(sm[(k8 + 0) * 65 + n], sm[(k8 + 1) * 65 + n]);
    w.y = pack2(sm[(k8 + 2) * 65 + n], sm[(k8 + 3) * 65 + n]);
    w.z = pack2(sm[(k8 + 4) * 65 + n], sm[(k8 + 5) * 65 + n]);
    w.w = pack2(sm[(k8 + 6) * 65 + n], sm[(k8 + 7) * 65 + n]);
    *(uint4*)(dst + (size_t)(n0 + n) * ldd + k0 + k8) = w;
  }
  __syncthreads();
}

__device__ __forceinline__ void adaln_item(const Params& p, int it, float* sm) {
  const int l = it / 96, c0 = (it % 96) * 64;
  float* ssil = sm;
  float* red = sm + 3072;
  const int tid = otid();
  for (int i = tid; i < 3072; i += 256) {
    const int cnd = i >> 10, k = i & 1023;
    const float v = cnd == 0 ? p.c_ctx[k] : p.c[(cnd - 1) * 1024 + k];
    ssil[i] = v / (1.f + expf(-v));
  }
  __syncthreads();
  const int cg4 = (tid & 15) * 4, ks = tid >> 4;
  const float* w = p.w_ada + (size_t)l * 1024 * 6144 + c0 + cg4;
  float a0[4] = {0.f, 0.f, 0.f, 0.f}, a1[4] = {0.f, 0.f, 0.f, 0.f}, a2[4] = {0.f, 0.f, 0.f, 0.f};
#pragma unroll 4
  for (int kk = 0; kk < 64; ++kk) {
    const int k = kk * 16 + ks;
    const float4 v = *(const float4*)(w + (size_t)k * 6144);
    const float s0 = ssil[k], s1 = ssil[1024 + k], s2 = ssil[2048 + k];
    a0[0] += s0 * v.x; a0[1] += s0 * v.y; a0[2] += s0 * v.z; a0[3] += s0 * v.w;
    a1[0] += s1 * v.x; a1[1] += s1 * v.y; a1[2] += s1 * v.z; a1[3] += s1 * v.w;
    a2[0] += s2 * v.x; a2[1] += s2 * v.y; a2[2] += s2 * v.z; a2[3] += s2 * v.w;
  }
#pragma unroll
  for (int j = 0; j < 4; ++j) {
    red[(ks * 3 + 0) * 64 + cg4 + j] = a0[j];
    red[(ks * 3 + 1) * 64 + cg4 + j] = a1[j];
    red[(ks * 3 + 2) * 64 + cg4 + j] = a2[j];
  }
  __syncthreads();
  if (tid < 192) {
    const int cnd = tid >> 6, j = tid & 63;
    float s = p.b_ada[l * 6144 + c0 + j];
    for (int q = 0; q < 16; ++q) s += red[(q * 3 + cnd) * 64 + j];
    p.mods[(l * 3 + cnd) * 6144 + c0 + j] = s;
  }
  __syncthreads();
}

__device__ __forceinline__ void cvt_item(const float* __restrict__ src, u16* __restrict__ dst, int it) {
  const size_t base = (size_t)it * 8192 + otid() * 4;
#pragma unroll
  for (int i = 0; i < 8; ++i) {
    const float4 v = *(const float4*)(src + base + i * 1024);
    uint2 w; w.x = pack2(v.x, v.y); w.y = pack2(v.z, v.w);
    *(uint2*)(dst + base + i * 1024) = w;
  }
}

__device__ __forceinline__ void pq_item(const Params& p, int it, float* sm) {
  const int l = it >> 3, which = (it >> 2) & 1, g = it & 3;
  const int n = otid();
  if (n < 64) sm[n] = which ? sinpif(2.f * (float)n / 64.f) : cospif(2.f * (float)n / 64.f);
  __syncthreads();
  float w[64];
#pragma unroll
  for (int m = 0; m < 64; ++m) w[m] = p.w_fourier[(size_t)l * 65536 + (g * 64 + m) * 256 + n];
  u16* dst = p.pqt + (size_t)l * 512 * 256 + (size_t)(which * 256 + n) * 256 + g * 64;
  for (int c = 0; c < 64; ++c) {
    float s = 0.f;
#pragma unroll
    for (int m = 0; m < 64; ++m) s += sm[(c * m) & 63] * w[m];
    dst[c] = f2bf(s);
  }
  __syncthreads();
}

__device__ __forceinline__ void dft_item(u16* dst, int L, int it) {
  const int twoL = 2 * L;
  for (int e = otid(); e < 8192; e += 256) {
    const int idx = it * 8192 + e;
    const int k = idx / twoL, j = idx % twoL;
    const int jj = j & (L - 1);
    const int ph = (k * jj) & (L - 1);
    const float a = 2.f * (float)ph / (float)L;
    const float v = (j >= L) ? -sinpif(a) : cospif(a);
    dst[idx] = f2bf(v);
  }
}

#define P0_WT 11520
#define P0_ADA 384
#define P0_XC 384
#define P0_CK 320
#define P0_CVT 640
#define P0_PQ 32
#define P0_DFT 272
#define P0_ITEMS (P0_ADA + P0_WT + P0_XC + P0_CK + P0_CVT + P0_PQ + P0_DFT + 1)

__device__ void p0_item(const Params& p, int it, unsigned char* smem) {
  float* sm = (float*)smem;
  if (it < P0_ADA) { adaln_item(p, it, sm); return; }
  it -= P0_ADA;
  if (it < P0_WT) {
    const int l = it / 2880; int r = it % 2880;
    if (r < 576) { transpose_tile(p.w_in + (size_t)l * 1024 * 2304, 2304, p.w_inT + (size_t)l * 2304 * 1024, 1024, (r / 36) * 64, (r % 36) * 64, sm); return; }
    r -= 576;
    if (r < 256) { transpose_tile(p.w_out + (size_t)l * 1024 * 1024, 1024, p.w_outT + (size_t)l * 1024 * 1024, 1024, (r / 16) * 64, (r % 16) * 64, sm); return; }
    r -= 256;
    if (r < 1024) { transpose_tile(p.w1 + (size_t)l * 1024 * 4096, 4096, p.w1T + (size_t)l * 4096 * 1024, 1024, (r / 64) * 64, (r % 64) * 64, sm); return; }
    r -= 1024;
    transpose_tile(p.w2 + (size_t)l * 4096 * 1024, 1024, p.w2T + (size_t)l * 1024 * 4096, 4096, (r / 16) * 64, (r % 16) * 64, sm);
    return;
  }
  it -= P0_WT;
  if (it < P0_XC) {
    const int row0 = it * 16;
    const float* src = row0 < NPTOK ? p.x_prompt + (size_t)row0 * 1024 : p.x_sample + (size_t)(row0 - NPTOK) * 1024;
    float* dst = p.xres + (size_t)row0 * 1024;
#pragma unroll
    for (int i = 0; i < 16; ++i) {
      const int o = (i * 256 + otid()) * 4;
      *(float4*)(dst + o) = *(const float4*)(src + o);
    }
    return;
  }
  it -= P0_XC;
  if (it < P0_CK) {
    if (it < 128) { cvt_item(p.c_na_k, p.ck_na, it); return; }
    it -= 128;
    if (it < 128) { cvt_item(p.c_diff_k, p.ck_diff, it); return; }
    it -= 128;
    cvt_item(p.c_swa_k, p.ck_swa, it);
    return;
  }
  it -= P0_CK;
  if (it < P0_CVT) {
    if (it < 256) { const int bl = it >> 5, r = it & 31; transpose_tile(p.c_na_v + (size_t)bl * 512 * 256, 256, p.cvt_na + (size_t)bl * 256 * 512, 512, (r >> 2) * 64, (r & 3) * 64, sm); return; }
    it -= 256;
    if (it < 256) { const int bl = it >> 5, r = it & 31; transpose_tile(p.c_diff_v + (size_t)bl * 512 * 256, 256, p.cvt_diff + (size_t)bl * 256 * 512, 512, (r >> 2) * 64, (r & 3) * 64, sm); return; }
    it -= 256;
    { const int bl = it >> 4, r = it & 15; transpose_tile(p.c_swa_v + (size_t)bl * 512 * 128, 128, p.cvt_swa + (size_t)bl * 128 * 512, 512, (r >> 1) * 64, (r & 1) * 64, sm); return; }
  }
  it -= P0_CVT;
  if (it < P0_PQ) { pq_item(p, it, sm); return; }
  it -= P0_PQ;
  if (it < 16) { dft_item(p.dft256, 256, it); return; }
  it -= 16;
  if (it < 256) { dft_item(p.dft1024, 1024, it); return; }
  for (int e = otid(); e < 512 + 1024; e += 256) {
    const bool isD = e < 512;
    const int ee = isD ? e : e - 512;
    const int nf = isD ? 8 : 16;
    const int pos = ee / nf, fi = ee % nf;
    const float inv = exp2f(-(float)fi * (13.287712379549449f / (float)nf));
    float tt = (float)pos * inv * 0.15915494309189535f;
    tt -= rintf(tt);
    float sn, cs;
    sincospif(2.f * tt, &sn, &cs);
    if (isD) { p.ropeD[ee] = cs; p.ropeD[512 + ee] = sn; }
    else { p.ropeS[ee] = cs; p.ropeS[1024 + ee] = sn; }
  }
}

__device__ __forceinline__ void norm_item(const Params& p, int l, int which, int it) {
  const int lane = otid() & 63, wave = otid() >> 6;
#pragma unroll 1
  for (int j = 0; j < 4; ++j) {
    const int row = it * 16 + wave * 4 + j;
    const float* xr = p.xres + (size_t)row * 1024;
    float4 v[4];
    float ss = 0.f;
#pragma unroll
    for (int k = 0; k < 4; ++k) {
      v[k] = *(const float4*)(xr + (k * 64 + lane) * 4);
      ss += v[k].x * v[k].x + v[k].y * v[k].y + v[k].z * v[k].z + v[k].w * v[k].w;
    }
#pragma unroll
    for (int o = 32; o >= 1; o >>= 1) ss += __shfl_xor(ss, o);
    const float rs = rsqrtf(ss * (1.f / 1024.f) + 1e-6f);
    if (which < 2) {
      const int cond = row < NPTOK ? 0 : 1 + ((row - NPTOK) >> 10);
      const float* gp = (which == 0 ? p.norm1_g : p.norm2_g) + l * 1024;
      const float* shp = p.mods + (size_t)(l * 3 + cond) * 6144 + (which * 3 + 0) * 1024;
      const float* scp = shp + 1024;
#pragma unroll
      for (int k = 0; k < 4; ++k) {
        const int col = (k * 64 + lane) * 4;
        const float4 gg = *(const float4*)(gp + col);
        const float4 sh = *(const float4*)(shp + col);
        const float4 sc = *(const float4*)(scp + col);
        uint2 w;
        w.x = pack2(v[k].x * rs * gg.x * (1.f + sc.x) + sh.x, v[k].y * rs * gg.y * (1.f + sc.y) + sh.y);
        w.y = pack2(v[k].z * rs * gg.z * (1.f + sc.z) + sh.z, v[k].w * rs * gg.w * (1.f + sc.w) + sh.w);
        *(uint2*)(p.h + (size_t)row * 1024 + col) = w;
      }
    } else {
#pragma unroll
      for (int k = 0; k < 4; ++k) {
        const int col = (k * 64 + lane) * 4;
        const float4 gg = *(const float4*)(p.final_g + col);
        float4 o;
        o.x = v[k].x * rs * gg.x; o.y = v[k].y * rs * gg.y; o.z = v[k].z * rs * gg.z; o.w = v[k].w * rs * gg.w;
        *(float4*)(p.out + (size_t)row * 1024 + col) = o;
      }
    }
  }
}

template <bool ZERO>
__device__ __forceinline__ void gemm_main_t(const u16* __restrict__ X, int ldx, const u16* __restrict__ Y, int ldy, int K,
                                          u16* smem, f32x4 (&acc)[4][4]) {
  const int tid = otid(), lane = tid & 63, wave = tid >> 6, wx = wave & 1, wy = wave >> 1, r = lane & 15, g = lane >> 4;
  u16* sX = smem;
  u16* sY = smem + 2 * 128 * LSTR;
  const int lrow = tid >> 3, lkc = tid & 7;
  const u16* gx = X + (size_t)lrow * ldx + lkc * 8;
  const u16* gy = Y + (size_t)lrow * ldy + lkc * 8;
  uint4 rx[4], ry[4];
#pragma unroll
  for (int i = 0; i < 4; ++i) {
    rx[i] = *(const uint4*)(gx + (size_t)(32 * i) * ldx);
    ry[i] = *(const uint4*)(gy + (size_t)(32 * i) * ldy);
  }
  if (ZERO) {
#pragma unroll
    for (int a = 0; a < 4; ++a)
#pragma unroll
      for (int b = 0; b < 4; ++b) acc[a][b] = (f32x4){0.f, 0.f, 0.f, 0.f};
  }
#pragma unroll
  for (int i = 0; i < 4; ++i) {
    *(uint4*)(sX + (lrow + 32 * i) * LSTR + lkc * 8) = rx[i];
    *(uint4*)(sY + (lrow + 32 * i) * LSTR + lkc * 8) = ry[i];
  }
  __syncthreads();
  const int nk = K >> 6;
  for (int kt = 0; kt < nk; ++kt) {
    const int cur = kt & 1;
    const bool more = (kt + 1) < nk;
    if (more) {
#pragma unroll
      for (int i = 0; i < 4; ++i) {
        rx[i] = *(const uint4*)(gx + (size_t)(32 * i) * ldx + (kt + 1) * 64);
        ry[i] = *(const uint4*)(gy + (size_t)(32 * i) * ldy + (kt + 1) * 64);
      }
    }
    const u16* cx = sX + cur * 128 * LSTR + (wx * 64 + r) * LSTR + g * 8;
    const u16* cy = sY + cur * 128 * LSTR + (wy * 64 + r) * LSTR + g * 8;
#pragma unroll
    for (int kk = 0; kk < 2; ++kk) {
      bf16x8 a[4], b[4];
#pragma unroll
      for (int i = 0; i < 4; ++i) {
        a[i] = *(const bf16x8*)(cx + i * 16 * LSTR + kk * 32);
        b[i] = *(const bf16x8*)(cy + i * 16 * LSTR + kk * 32);
      }
#pragma unroll
      for (int xi = 0; xi < 4; ++xi)
#pragma unroll
        for (int yi = 0; yi < 4; ++yi)
          acc[xi][yi] = __builtin_amdgcn_mfma_f32_16x16x32_bf16(a[xi], b[yi], acc[xi][yi], 0, 0, 0);
    }
    if (more) {
      u16* dX = sX + (cur ^ 1) * 128 * LSTR;
      u16* dY = sY + (cur ^ 1) * 128 * LSTR;
#pragma unroll
      for (int i = 0; i < 4; ++i) {
        *(uint4*)(dX + (lrow + 32 * i) * LSTR + lkc * 8) = rx[i];
        *(uint4*)(dY + (lrow + 32 * i) * LSTR + lkc * 8) = ry[i];
      }
    }
    __syncthreads();
  }
}

#ifndef REP_GEMM
#define REP_GEMM 0
#endif
#ifndef REP_MIX
#define REP_MIX 0
#endif
#ifndef REP_SYNC
#define REP_SYNC 0
#endif
#ifndef REP_P0
#define REP_P0 0
#endif
__device__ __forceinline__ void gemm_main(const u16* __restrict__ X, int ldx, const u16* __restrict__ Y, int ldy, int K,
                                          u16* smem, f32x4 (&acc)[4][4]) {
  gemm_main_t<true>(X, ldx, Y, ldy, K, smem, acc);
#if REP_GEMM
  gemm_main_t<false>(X, ldx, Y, ldy, K, smem, acc);
#pragma unroll
  for (int a = 0; a < 4; ++a)
#pragma unroll
    for (int b = 0; b < 4; ++b) acc[a][b] *= 0.5f;
#endif
}

__device__ void gin_tile(const Params& p, int l, int it, u16* smem) {
  const int ty = it % 48, tx = it / 48;
  const int n0 = tx * 128, m0 = ty * 128;
  f32x4 acc[4][4];
  gemm_main(p.w_inT + (size_t)l * 2304 * 1024 + (size_t)n0 * 1024, 1024, p.h + (size_t)m0 * 1024, 1024, 1024, smem, acc);
  const int lane = otid() & 63, wave = otid() >> 6, wx = wave & 1, wy = wave >> 1, r = lane & 15, g = lane >> 4;
  const int nw = n0 + wx * 64;
  const bool isS = m0 >= NPTOK;
  int ropeMode = 0;
  if (isS) {
    if (nw >= 768 && nw < 1280) ropeMode = 1;
    else if (nw >= 1792 && nw < 2176) ropeMode = 2;
  }
  float* okv = nullptr; int okv_w = 0, okv_c = 0;
  if (!isS) {
    if (nw >= 256 && nw < 512) { okv = p.out + O_NAK; okv_w = 256; okv_c = nw - 256; }
    else if (nw >= 512 && nw < 768) { okv = p.out + O_NAV; okv_w = 256; okv_c = nw - 512; }
    else if (nw >= 1024 && nw < 1280) { okv = p.out + O_DK; okv_w = 256; okv_c = nw - 1024; }
    else if (nw >= 1280 && nw < 1536) { okv = p.out + O_DV; okv_w = 256; okv_c = nw - 1280; }
    else if (nw >= 2048 && nw < 2176) { okv = p.out + O_SK; okv_w = 128; okv_c = nw - 2048; }
    else if (nw >= 2176) { okv = p.out + O_SV; okv_w = 128; okv_c = nw - 2176; }
  }
  int vrow = -1;
  if (nw >= 512 && nw < 768) vrow = nw - 512;
  else if (nw >= 1280 && nw < 1536) vrow = 256 + nw - 1280;
  else if (nw >= 2176) vrow = 512 + nw - 2176;
#pragma unroll
  for (int yi = 0; yi < 4; ++yi) {
    const int m = m0 + wy * 64 + yi * 16 + r;
    const int t = (m - NPTOK) & 1023;
    const int prow = t >> 6, pcol = t & 63;
#pragma unroll
    for (int xi = 0; xi < 4; ++xi) {
      f32x4 v = acc[xi][yi];
      if (ropeMode == 1) {
        const int pos = (xi & 1) ? pcol : prow;
        const float4 cs = *(const float4*)(p.ropeD + pos * 8 + 4 * (g & 1));
        const float4 sn = *(const float4*)(p.ropeD + 512 + pos * 8 + 4 * (g & 1));
        const float sg = (g >= 2) ? 1.f : -1.f;
        const float o0 = __shfl_xor(v[0], 32), o1 = __shfl_xor(v[1], 32), o2 = __shfl_xor(v[2], 32), o3 = __shfl_xor(v[3], 32);
        v[0] = v[0] * cs.x + sg * o0 * sn.x; v[1] = v[1] * cs.y + sg * o1 * sn.y;
        v[2] = v[2] * cs.z + sg * o2 * sn.z; v[3] = v[3] * cs.w + sg * o3 * sn.w;
      } else if (ropeMode == 2) {
        const int pos = (xi >> 1) ? pcol : prow;
        const float4 cs = *(const float4*)(p.ropeS + pos * 16 + 4 * g);
        const float4 sn = *(const float4*)(p.ropeS + 1024 + pos * 16 + 4 * g);
        const f32x4 o = acc[xi ^ 1][yi];
        const float sg = (xi & 1) ? 1.f : -1.f;
        v[0] = v[0] * cs.x + sg * o[0] * sn.x; v[1] = v[1] * cs.y + sg * o[1] * sn.y;
        v[2] = v[2] * cs.z + sg * o[2] * sn.z; v[3] = v[3] * cs.w + sg * o[3] * sn.w;
      }
      const int nloc = xi * 16 + 4 * g;
      if (okv) {
        const int b = m >> 8, pos = m & 255;
        float4 o4; o4.x = v[0]; o4.y = v[1]; o4.z = v[2]; o4.w = v[3];
        *(float4*)(okv + ((size_t)((b * 4 + l) * 256 + pos)) * okv_w + okv_c + nloc) = o4;
      }
      if (vrow >= 0) {
#pragma unroll
        for (int i = 0; i < 4; ++i) p.vt[(size_t)(vrow + nloc + i) * NTOK + m] = f2bf(v[i]);
      } else {
        uint2 w; w.x = pack2(v[0], v[1]); w.y = pack2(v[2], v[3]);
        *(uint2*)(p.z + (size_t)m * INW + nw + nloc) = w;
      }
    }
  }
}

__device__ void res_tile(const Params& p, int l, int it, const u16* A, const u16* WT, int K, int gi, u16* smem) {
  const int ty = it % 48, tx = it / 48;
  const int n0 = tx * 128, m0 = ty * 128;
  f32x4 acc[4][4];
  gemm_main(WT + (size_t)n0 * K, K, A + (size_t)m0 * K, K, K, smem, acc);
  const int lane = otid() & 63, wave = otid() >> 6, wx = wave & 1, wy = wave >> 1, r = lane & 15, g = lane >> 4;
  const int cond = m0 < NPTOK ? 0 : 1 + ((m0 - NPTOK) >> 10);
  const float* gate = p.mods + (size_t)(l * 3 + cond) * 6144 + gi * 1024;
#pragma unroll
  for (int xi = 0; xi < 4; ++xi) {
    const int n = n0 + wx * 64 + xi * 16 + 4 * g;
    const float4 gt = *(const float4*)(gate + n);
#pragma unroll
    for (int yi = 0; yi < 4; ++yi) {
      const int m = m0 + wy * 64 + yi * 16 + r;
      float* xp = p.xres + (size_t)m * 1024 + n;
      float4 xv = *(const float4*)xp;
      const f32x4 v = acc[xi][yi];
      xv.x += gt.x * v[0]; xv.y += gt.y * v[1]; xv.z += gt.z * v[2]; xv.w += gt.w * v[3];
      *(float4*)xp = xv;
    }
  }
}

__device__ void m1_tile(const Params& p, int l, int it, u16* smem) {
  const int ty = it % 48, tx = it / 48;
  const int n0 = tx * 128, m0 = ty * 128;
  f32x4 acc[4][4];
  gemm_main(p.w1T + (size_t)l * 4096 * 1024 + (size_t)n0 * 1024, 1024, p.h + (size_t)m0 * 1024, 1024, 1024, smem, acc);
  const int lane = otid() & 63, wave = otid() >> 6, wx = wave & 1, wy = wave >> 1, r = lane & 15, g = lane >> 4;
#pragma unroll
  for (int xi = 0; xi < 4; ++xi) {
    const int n = n0 + wx * 64 + xi * 16 + 4 * g;
#pragma unroll
    for (int yi = 0; yi < 4; ++yi) {
      const int m = m0 + wy * 64 + yi * 16 + r;
      const f32x4 v = acc[xi][yi];
      float a0 = fmaxf(v[0], 0.f), a1 = fmaxf(v[1], 0.f), a2 = fmaxf(v[2], 0.f), a3 = fmaxf(v[3], 0.f);
      uint2 w; w.x = pack2(a0 * a0, a1 * a1); w.y = pack2(a2 * a2, a3 * a3);
      *(uint2*)(p.u + (size_t)m * 4096 + n) = w;
    }
  }
}

__device__ void f1_tile(const Params& p, int l, int it, u16* smem) {
  const int tx = it % 48, ty = it / 48;
  const int x0 = tx * 128, y0 = ty * 128;
  f32x4 acc[4][4];
  gemm_main(p.z + (size_t)x0 * INW + 1536, INW, p.pqt + (size_t)l * 512 * 256 + (size_t)y0 * 256, 256, 256, smem, acc);
  const int lane = otid() & 63, wave = otid() >> 6, wx = wave & 1, wy = wave >> 1, r = lane & 15, g = lane >> 4;
#pragma unroll
  for (int yi = 0; yi < 4; ++yi) {
    const int y = y0 + wy * 64 + yi * 16 + r;
    const int col = y & 255, which = y >> 8;
#pragma unroll
    for (int xi = 0; xi < 4; ++xi) {
      const int tok = x0 + wx * 64 + xi * 16 + 4 * g;
      size_t addr;
      if (tok < NPTOK) {
        const int b = tok >> 8, pos = tok & 255;
        addr = (size_t)b * (256 * 512) + (size_t)col * 512 + which * 256 + pos;
      } else {
        const int b = (tok - NPTOK) >> 10, pos = (tok - NPTOK) & 1023;
        addr = (size_t)16 * 256 * 512 + (size_t)b * (256 * 2048) + (size_t)col * 2048 + which * 1024 + pos;
      }
      const f32x4 v = acc[xi][yi];
      uint2 w; w.x = pack2(v[0], v[1]); w.y = pack2(v[2], v[3]);
      *(uint2*)(p.uv + addr) = w;
    }
  }
}

__device__ void f2_tile(const Params& p, int it, u16* smem) {
  int L, b, tx, ty, tokbase;
  const u16* uvb; const u16* dft;
  if (it < 32) { L = 1024; b = it >> 4; tx = (it >> 3) & 1; ty = it & 7; uvb = p.uv + (size_t)16 * 256 * 512 + (size_t)b * (256 * 2048); dft = p.dft1024; tokbase = NPTOK + b * 1024; }
  else { it -= 32; L = 256; b = it >> 2; tx = (it >> 1) & 1; ty = it & 1; uvb = p.uv + (size_t)b * (256 * 512); dft = p.dft256; tokbase = b * 256; }
  const int x0 = tx * 128, y0 = ty * 128, K = 2 * L;
  f32x4 acc[4][4];
  gemm_main(uvb + (size_t)x0 * K, K, dft + (size_t)y0 * K, K, K, smem, acc);
  const int lane = otid() & 63, wave = otid() >> 6, wx = wave & 1, wy = wave >> 1, r = lane & 15, g = lane >> 4;
  const float scale = rsqrtf(64.f * (float)L);
#pragma unroll
  for (int yi = 0; yi < 4; ++yi) {
    const int pos = y0 + wy * 64 + yi * 16 + r;
#pragma unroll
    for (int xi = 0; xi < 4; ++xi) {
      const int col = x0 + wx * 64 + xi * 16 + 4 * g;
      const f32x4 v = acc[xi][yi];
      uint2 w; w.x = pack2(v[0] * scale, v[1] * scale); w.y = pack2(v[2] * scale, v[3] * scale);
      *(uint2*)(p.cat + (size_t)(tokbase + pos) * 1024 + 512 + col) = w;
    }
  }
}

struct Seg { const u16* K; const u16* Vt; int ldk, ldv, nblk, pos0, stride; };
template <int QT> struct AState { float m[QT]; float ls[QT]; f32x4 o[QT][4]; };

template <int DC>
__device__ __forceinline__ void load_blk(const Seg& s0, const Seg& s1, int b, int r, int g, bf16x8 (&kf)[2][DC], bf16x8 (&vf)[4]) {
  const bool in0 = b < s0.nblk;
  const u16* Kp = in0 ? s0.K : s1.K;
  const u16* Vp = in0 ? s0.Vt : s1.Vt;
  const int ldk = in0 ? s0.ldk : s1.ldk, ldv = in0 ? s0.ldv : s1.ldv;
  const int pos = in0 ? (s0.pos0 + b * s0.stride) : (s1.pos0 + (b - s0.nblk) * s1.stride);
  const int krow = pos + 8 * (r >> 2) + (r & 3);
#pragma unroll
  for (int t = 0; t < 2; ++t) {
    const u16* kp = Kp + (size_t)(krow + 4 * t) * ldk + g * 8;
#pragma unroll
    for (int dc = 0; dc < DC; ++dc) kf[t][dc] = *(const bf16x8*)(kp + dc * 32);
  }
#pragma unroll
  for (int dv = 0; dv < 4; ++dv) vf[dv] = *(const bf16x8*)(Vp + (size_t)(dv * 16 + r) * ldv + pos + 8 * g);
}

template <int D, int QT, int MODE>
__device__ __forceinline__ void attn_run(const Seg& s0, const Seg& s1, const bf16x8 (&qf)[QT][D / 32], const float sc,
                                         AState<QT>& st, const int qpos0, const float* __restrict__ rpb_h) {
  constexpr int DC = D / 32;
  const int lane = otid() & 63, r = lane & 15, g = lane >> 4;
  const int nb = s0.nblk + s1.nblk;
  bf16x8 kc[2][DC], vc[4];
  load_blk<DC>(s0, s1, 0, r, g, kc, vc);
  for (int b = 0; b < nb; ++b) {
    bf16x8 kn[2][DC], vn[4];
    load_blk<DC>(s0, s1, (b + 1 < nb) ? b + 1 : b, r, g, kn, vn);
    const bool in0 = b < s0.nblk;
    const int pos = in0 ? (s0.pos0 + b * s0.stride) : (s1.pos0 + (b - s0.nblk) * s1.stride);
#pragma unroll
    for (int q = 0; q < QT; ++q) {
      f32x4 s_[2];
      s_[0] = (f32x4){0.f, 0.f, 0.f, 0.f};
      s_[1] = (f32x4){0.f, 0.f, 0.f, 0.f};
#pragma unroll
      for (int t = 0; t < 2; ++t)
#pragma unroll
        for (int dc = 0; dc < DC; ++dc) s_[t] = __builtin_amdgcn_mfma_f32_16x16x32_bf16(kc[t][dc], qf[q][dc], s_[t], 0, 0, 0);
      float sv[8];
#pragma unroll
      for (int t = 0; t < 2; ++t)
#pragma unroll
        for (int i = 0; i < 4; ++i) {
          float x = s_[t][i] * sc;
          if (MODE == 1) {
            if (!in0) {
              const int qpos = qpos0 + q * 16 + r;
              const int qrow = qpos >> 6, cq = qpos & 63;
              const int kpos = pos + 8 * g + 4 * t + i;
              const int krow = kpos >> 6, ck = kpos & 63;
              const int cs = min(max(cq - 8, 0), 48);
              const bool valid = (ck >= cs) && (ck < cs + 16);
              const int bi = (krow - qrow + 7) * 31 + (ck - cq + 15);
              const float bias = valid ? rpb_h[bi] : 0.f;
              x = valid ? (x + bias * LOG2E) : -1e30f;
            }
          } else if (MODE == 2) {
            if (!in0) {
              const int qpos = qpos0 + q * 16 + r;
              const int kpos = pos + 8 * g + 4 * t + i;
              const int d = qpos - kpos;
              x = (d <= 128 && d >= -128) ? x : -1e30f;
            }
          }
          sv[4 * t + i] = x;
        }
      float mx = fmaxf(fmaxf(fmaxf(sv[0], sv[1]), fmaxf(sv[2], sv[3])), fmaxf(fmaxf(sv[4], sv[5]), fmaxf(sv[6], sv[7])));
      mx = fmaxf(mx, __shfl_xor(mx, 16));
      mx = fmaxf(mx, __shfl_xor(mx, 32));
      const float mnew = fmaxf(st.m[q], mx);
      const float alpha = exp2f(st.m[q] - mnew);
      st.m[q] = mnew;
      float ps = 0.f;
#pragma unroll
      for (int j = 0; j < 8; ++j) { sv[j] = exp2f(sv[j] - mnew); ps += sv[j]; }
      st.ls[q] = st.ls[q] * alpha + ps;
      union { bf16x8 v; unsigned w[4]; } pf;
      pf.w[0] = pack2(sv[0], sv[1]); pf.w[1] = pack2(sv[2], sv[3]); pf.w[2] = pack2(sv[4], sv[5]); pf.w[3] = pack2(sv[6], sv[7]);
#pragma unroll
      for (int dv = 0; dv < 4; ++dv) {
        f32x4 o = st.o[q][dv];
        o[0] *= alpha; o[1] *= alpha; o[2] *= alpha; o[3] *= alpha;
        st.o[q][dv] = __builtin_amdgcn_mfma_f32_16x16x32_bf16(vc[dv], pf.v, o, 0, 0, 0);
      }
    }
#pragma unroll
    for (int t = 0; t < 2; ++t)
#pragma unroll
      for (int dc = 0; dc < DC; ++dc) kc[t][dc] = kn[t][dc];
#pragma unroll
    for (int dv = 0; dv < 4; ++dv) vc[dv] = vn[dv];
  }
}

template <int QT>
__device__ __forceinline__ void astate_init(AState<QT>& st, float m0, float l0) {
#pragma unroll
  for (int q = 0; q < QT; ++q) {
    st.m[q] = m0; st.ls[q] = l0;
#pragma unroll
    for (int dv = 0; dv < 4; ++dv) st.o[q][dv] = (f32x4){0.f, 0.f, 0.f, 0.f};
  }
}
template <int QT>
__device__ __forceinline__ void astate_finalize(AState<QT>& st) {
#pragma unroll
  for (int q = 0; q < QT; ++q) {
    float l = st.ls[q];
    l += __shfl_xor(l, 16);
    l += __shfl_xor(l, 32);
    const float inv = 1.f / l;
#pragma unroll
    for (int dv = 0; dv < 4; ++dv) { st.o[q][dv][0] *= inv; st.o[q][dv][1] *= inv; st.o[q][dv][2] *= inv; st.o[q][dv][3] *= inv; }
  }
}
template <int DC, int QT>
__device__ __forceinline__ void load_q(const u16* zq  , bf16x8 (&qf)[QT][DC]) {
  const int lane = otid() & 63, r = lane & 15, g = lane >> 4;
#pragma unroll
  for (int q = 0; q < QT; ++q)
#pragma unroll
    for (int dc = 0; dc < DC; ++dc) qf[q][dc] = *(const bf16x8*)(zq + (size_t)(q * 16 + r) * INW + dc * 32 + g * 8);
}
template <int QT>
__device__ __forceinline__ void write_o(const Params& p, const AState<QT>& st, int tok0, int col0) {
  const int lane = otid() & 63, r = lane & 15, g = lane >> 4;
#pragma unroll
  for (int q = 0; q < QT; ++q)
#pragma unroll
    for (int dv = 0; dv < 4; ++dv) {
      const f32x4 v = st.o[q][dv];
      uint2 w; w.x = pack2(v[0], v[1]); w.y = pack2(v[2], v[3]);
      *(uint2*)(p.cat + (size_t)(tok0 + q * 16 + r) * 1024 + col0 + dv * 16 + 4 * g) = w;
    }
}

__device__ __forceinline__ float diff_lambda(const Params& p, int l, float lam_init) {
  const int lane = otid() & 63;
  float a = 0.f, b = 0.f;
  if (lane < 32) { a = p.lq1[l * 32 + lane] * p.lk1[l * 32 + lane]; b = p.lq2[l * 32 + lane] * p.lk2[l * 32 + lane]; }
#pragma unroll
  for (int o = 32; o >= 1; o >>= 1) { a += __shfl_xor(a, o); b += __shfl_xor(b, o); }
  return expf(a) - expf(b) + lam_init;
}

template <int QT>
__device__ __forceinline__ void diff_finish(const Params& p, int l, AState<QT>& s1, const AState<QT>& s2, int tok0, int col0) {
  const int lane = otid() & 63, g = lane >> 4;
  const float lam_init = 0.8f - 0.6f * expf(-0.3f * (float)l);
  const float lam = diff_lambda(p, l, lam_init);
  const float* sg = p.subln_g + l * 64;
#pragma unroll
  for (int q = 0; q < QT; ++q) {
    float ss = 0.f;
#pragma unroll
    for (int dv = 0; dv < 4; ++dv)
#pragma unroll
      for (int i = 0; i < 4; ++i) {
        const float v = s1.o[q][dv][i] - lam * s2.o[q][dv][i];
        s1.o[q][dv][i] = v;
        ss += v * v;
      }
    ss += __shfl_xor(ss, 16);
    ss += __shfl_xor(ss, 32);
    const float rs = rsqrtf(ss * (1.f / 64.f) + 1e-6f) * (1.f - lam_init);
#pragma unroll
    for (int dv = 0; dv < 4; ++dv) {
      const float4 gg = *(const float4*)(sg + dv * 16 + 4 * g);
      s1.o[q][dv][0] *= rs * gg.x; s1.o[q][dv][1] *= rs * gg.y; s1.o[q][dv][2] *= rs * gg.z; s1.o[q][dv][3] *= rs * gg.w;
    }
  }
  write_o<QT>(p, s1, tok0, col0);
}

__device__ void attn_ctx_item(const Params& p, int l, int bi) {
  const int wave = otid() >> 6, lane = otid() & 63, g = lane >> 4;
  const int w = bi * 4 + wave;
  const int type = w >> 10, rem = w & 1023;
  const int b = rem >> 6, h = (rem >> 4) & 3, qt = rem & 15;
  const int tokb = b * 256, tok0 = tokb + qt * 16;
  const u16* zb = p.z + (size_t)tokb * INW;
  Seg sN; sN.K = nullptr; sN.Vt = nullptr; sN.ldk = 0; sN.ldv = 0; sN.nblk = 0; sN.pos0 = 0; sN.stride = 0;
  if (type < 2) {
    const int kvh = h >> 1;
    const int qcol = type == 0 ? h * 64 : 1792 + h * 64;
    const int kcol = type == 0 ? 256 + h * 64 : 2048 + kvh * 64;
    const int vrow = type == 0 ? h * 64 : 512 + kvh * 64;
    const int ocol = type == 0 ? h * 64 : 768 + h * 64;
    bf16x8 qf[1][2];
    load_q<2, 1>(p.z + (size_t)tok0 * INW + qcol, qf);
    Seg s0; s0.K = zb + kcol; s0.Vt = p.vt + (size_t)vrow * NTOK + tokb; s0.ldk = INW; s0.ldv = NTOK; s0.nblk = 8; s0.pos0 = 0; s0.stride = 32;
    AState<1> st;
    const float sk = type == 0 ? -1e30f : p.swa_sink[l * 4 + h] * LOG2E;
    astate_init<1>(st, sk, (type == 1 && g == 0) ? 1.f : 0.f);
    attn_run<64, 1, 0>(s0, sN, qf, 0.125f * LOG2E, st, 0, nullptr);
    astate_finalize<1>(st);
    write_o<1>(p, st, tok0, ocol);
  } else {
    AState<1> st1, st2;
#pragma unroll 1
    for (int ps = 0; ps < 2; ++ps) {
      bf16x8 qf[1][1];
      load_q<1, 1>(p.z + (size_t)tok0 * INW + 768 + h * 64 + ps * 32, qf);
      Seg s0; s0.K = zb + 1024 + h * 64 + ps * 32; s0.Vt = p.vt + (size_t)(256 + h * 64) * NTOK + tokb; s0.ldk = INW; s0.ldv = NTOK; s0.nblk = 8; s0.pos0 = 0; s0.stride = 32;
      AState<1> st;
      astate_init<1>(st, -1e30f, 0.f);
      attn_run<32, 1, 0>(s0, sN, qf, 0.17677669529663687f * LOG2E, st, 0, nullptr);
      astate_finalize<1>(st);
      if (ps == 0) st1 = st; else st2 = st;
    }
    diff_finish<1>(p, l, st1, st2, tok0, 256 + h * 64);
  }
}

__device__ void attn_lat_item(const Params& p, int l, int bi) {
  const int wave = otid() >> 6, lane = otid() & 63, g = lane >> 4;
  const int w = bi * 4 + wave;
  const int type = w >> 9, rem = w & 511;
  const int b = rem >> 8, h = (rem >> 6) & 3, qt = rem & 63;
  const int q0 = qt * 16;
  const int tokb = NPTOK + b * 1024, tok0 = tokb + q0;
  const u16* zb = p.z + (size_t)tokb * INW;
  const int bl = b * 4 + l;
  if (type == 0) {
    AState<1> st1, st2;
#pragma unroll 1
    for (int ps = 0; ps < 2; ++ps) {
      bf16x8 qf[1][1];
      load_q<1, 1>(p.z + (size_t)tok0 * INW + 768 + h * 64 + ps * 32, qf);
      Seg s0; s0.K = p.ck_diff + (size_t)bl * 512 * 256 + h * 64 + ps * 32; s0.Vt = p.cvt_diff + (size_t)(bl * 256 + h * 64) * 512; s0.ldk = 256; s0.ldv = 512; s0.nblk = 16; s0.pos0 = 0; s0.stride = 32;
      Seg s1; s1.K = zb + 1024 + h * 64 + ps * 32; s1.Vt = p.vt + (size_t)(256 + h * 64) * NTOK + tokb; s1.ldk = INW; s1.ldv = NTOK; s1.nblk = 32; s1.pos0 = 0; s1.stride = 32;
      AState<1> st;
      astate_init<1>(st, -1e30f, 0.f);
      attn_run<32, 1, 0>(s0, s1, qf, 0.17677669529663687f * LOG2E, st, 0, nullptr);
      astate_finalize<1>(st);
      if (ps == 0) st1 = st; else st2 = st;
    }
    diff_finish<1>(p, l, st1, st2, tok0, 256 + h * 64);
  } else if (type == 1) {
    const int kvh = h >> 1;
    bf16x8 qf[1][2];
    load_q<2, 1>(p.z + (size_t)tok0 * INW + 1792 + h * 64, qf);
    Seg s0; s0.K = p.ck_swa + (size_t)bl * 512 * 128 + kvh * 64; s0.Vt = p.cvt_swa + (size_t)(bl * 128 + kvh * 64) * 512; s0.ldk = 128; s0.ldv = 512; s0.nblk = 16; s0.pos0 = 0; s0.stride = 32;
    const int lo = max(0, q0 - 128) & ~31;
    const int hi = min(1024, (q0 + 15 + 128 + 1 + 31) & ~31);
    Seg s1; s1.K = zb + 2048 + kvh * 64; s1.Vt = p.vt + (size_t)(512 + kvh * 64) * NTOK + tokb; s1.ldk = INW; s1.ldv = NTOK; s1.nblk = (hi - lo) >> 5; s1.pos0 = lo; s1.stride = 32;
    AState<1> st;
    astate_init<1>(st, p.swa_sink[l * 4 + h] * LOG2E, g == 0 ? 1.f : 0.f);
    attn_run<64, 1, 2>(s0, s1, qf, 0.125f * LOG2E, st, q0, nullptr);
    astate_finalize<1>(st);
    write_o<1>(p, st, tok0, 768 + h * 64);
  } else {
    bf16x8 qf[1][2];
    load_q<2, 1>(p.z + (size_t)tok0 * INW + h * 64, qf);
    Seg s0; s0.K = p.ck_na + (size_t)bl * 512 * 256 + h * 64; s0.Vt = p.cvt_na + (size_t)(bl * 256 + h * 64) * 512; s0.ldk = 256; s0.ldv = 512; s0.nblk = 16; s0.pos0 = 0; s0.stride = 32;
    const int qrow = q0 >> 6, c0 = q0 & 63;
    const int rstart = min(max(qrow - 4, 0), 8);
    const int kc0 = min(max(c0 - 8, 0), 32);
    Seg s1; s1.K = zb + 256 + h * 64; s1.Vt = p.vt + (size_t)(h * 64) * NTOK + tokb; s1.ldk = INW; s1.ldv = NTOK; s1.nblk = 8; s1.pos0 = rstart * 64 + kc0; s1.stride = 64;
    AState<1> st;
    astate_init<1>(st, -1e30f, 0.f);
    attn_run<64, 1, 1>(s0, s1, qf, 0.125f * LOG2E, st, q0, p.na_rpb + (size_t)(l * 4 + h) * 15 * 31);
    astate_finalize<1>(st);
    write_o<1>(p, st, tok0, h * 64);
  }
}


#define XB_TMO      128
#define XB_XCNT(j)  (256  + 64 * (j))
#define XB_XSUB(j)  (1280 + 64 * (j))
#define XB_XGEN(j)  (2304 + 64 * (j))
#define XB_TOP      3328
#define XB_TOPGEN   3392
#define XCD_BAR_WORDS 3456
#define XB_SPIN_CAP (1u << 22)
#define LAS __attribute__((address_space(3)))
__device__ __forceinline__ unsigned xb_ld(unsigned* p)              { return __hip_atomic_load(p, __ATOMIC_RELAXED, __HIP_MEMORY_SCOPE_AGENT); }
__device__ __forceinline__ unsigned xb_add(unsigned* p, unsigned v) { return __hip_atomic_fetch_add(p, v, __ATOMIC_RELAXED, __HIP_MEMORY_SCOPE_AGENT); }
__device__ __forceinline__ unsigned xb_xcc_id() { return (unsigned)__builtin_amdgcn_s_getreg((3 << 11) | 20) & 0xFu; }
#define XB_SPIN(cond, bar) do { unsigned _sp = 0; while (cond) { __builtin_amdgcn_s_sleep(1); \
    if ((++_sp & 255u) == 0u) { if (xb_ld(&(bar)[XB_TMO])) break; if (_sp > XB_SPIN_CAP) { atomicAdd(&(bar)[XB_TMO], 1u); break; } } } } while (0)
struct XcdBarrier { unsigned* bar; unsigned x; volatile LAS unsigned* st; };
__device__ __forceinline__ XcdBarrier xcd_barrier_post(unsigned* bar, volatile LAS unsigned* st) {
  XcdBarrier b; b.bar = bar; b.x = xb_xcc_id(); b.st = st;
  if (threadIdx.x == 0) (void)xb_add(&bar[XB_XCNT(b.x)], 1u);
  return b;
}
__device__ __forceinline__ void xcd_barrier_complete(unsigned* bar, unsigned x, unsigned& nloc, unsigned& nx) {
  const unsigned G = gridDim.x * gridDim.y * gridDim.z;
  unsigned sum, cnt, mine, sp = 0u;
  for (;;) {
    sum = 0u; cnt = 0u; mine = 0u;
#pragma unroll
    for (unsigned j = 0; j < 16; ++j) { const unsigned c = xb_ld(&bar[XB_XCNT(j)]); sum += c; cnt += (c > 0u) ? 1u : 0u; mine = (j == x) ? c : mine; }
    if (sum == G) break;
    __builtin_amdgcn_s_sleep(1);
    if ((++sp & 255u) == 0u) { if (xb_ld(&bar[XB_TMO])) break; if (sp > XB_SPIN_CAP) { atomicAdd(&bar[XB_TMO], 1u); break; } }
  }
  nloc = mine > 0u ? mine : 1u; nx = cnt > 0u ? cnt : 1u;
}
__device__ __forceinline__ void xcd_barrier(const XcdBarrier& b) {
  asm volatile("s_waitcnt vmcnt(0)" ::: "memory");
  __syncthreads();
  if (threadIdx.x == 0) {
    unsigned* bar = b.bar;
    __builtin_amdgcn_s_waitcnt(0);
    unsigned nloc = b.st[0], nx = b.st[1];
    if (nloc == 0u) { xcd_barrier_complete(bar, b.x, nloc, nx); b.st[0] = nloc; b.st[1] = nx; }
    const unsigned old = xb_add(&bar[XB_XSUB(b.x)], 1u);
    const unsigned gen = old / nloc;
    if (old + 1u == (gen + 1u) * nloc) {
      __builtin_amdgcn_fence(__ATOMIC_RELEASE, "agent");
      asm volatile("s_waitcnt vmcnt(0)" ::: "memory");
      const unsigned og = xb_add(&bar[XB_TOP], 1u);
      const unsigned tg = og / nx;
      if (og + 1u == (tg + 1u) * nx) xb_add(&bar[XB_TOPGEN], 1u);
      else XB_SPIN(xb_ld(&bar[XB_TOPGEN]) == tg, bar);
      __builtin_amdgcn_fence(__ATOMIC_ACQUIRE, "agent");
      xb_add(&bar[XB_XGEN(b.x)], 1u);
      asm volatile("s_waitcnt vmcnt(0)" ::: "memory");
    } else {
      XB_SPIN(xb_ld(&bar[XB_XGEN(b.x)]) == gen, bar);
      __builtin_amdgcn_fence(__ATOMIC_ACQUIRE, "agent");
      asm volatile("s_waitcnt vmcnt(0)" ::: "memory");
    }
  }
  __syncthreads();
}

#if REP_SYNC
#define GSYNC() do { xcd_barrier(xb); xcd_barrier(xb); } while (0)
#else
#define GSYNC() xcd_barrier(xb)
#endif
__global__ void __launch_bounds__(256, 2) mega(Params p) {
  extern __shared__ __attribute__((aligned(16))) unsigned char smem[];
  cg::grid_group grid = cg::this_grid();
  const int nblk = gridDim.x, bid = blockIdx.x;
  u16* sm16 = (u16*)smem;
  __shared__ uint4 xb_words;
  if (threadIdx.x == 0) xb_words = make_uint4(0u, 0u, 0u, 0u);
  __syncthreads();
  XcdBarrier xb = xcd_barrier_post(p.bar, (volatile LAS unsigned*)&xb_words);

  for (int rep = 0; rep <= REP_P0; ++rep)
    for (int it = bid; it < P0_ITEMS; it += nblk) p0_item(p, it, smem);
  grid.sync();

#pragma unroll 1
  for (int l = 0; l < 4; ++l) {
    for (int it = bid; it < 384; it += nblk) norm_item(p, l, 0, it);
    GSYNC();
    for (int it = bid; it < 18 * 48; it += nblk) gin_tile(p, l, it, sm16);
    GSYNC();
    for (int rep = 0; rep <= REP_MIX; ++rep)
    for (int it = bid; it < 192 + 768; it += nblk) {
      if (it < 192) f1_tile(p, l, it, sm16);
      else attn_ctx_item(p, l, it - 192);
    }
    GSYNC();
    for (int rep = 0; rep <= REP_MIX; ++rep)
    for (int it = bid; it < 96 + 384; it += nblk) {
      if (it < 96) f2_tile(p, it, sm16);
      else attn_lat_item(p, l, it - 96);
    }
    GSYNC();
    for (int it = bid; it < 8 * 48; it += nblk) res_tile(p, l, it, p.cat, p.w_outT + (size_t)l * 1024 * 1024, 1024, 2, sm16);
    GSYNC();
    for (int it = bid; it < 384; it += nblk) norm_item(p, l, 1, it);
    GSYNC();
    for (int it = bid; it < 32 * 48; it += nblk) m1_tile(p, l, it, sm16);
    GSYNC();
    for (int it = bid; it < 8 * 48; it += nblk) res_tile(p, l, it, p.u, p.w2T + (size_t)l * 1024 * 4096, 4096, 5, sm16);
    GSYNC();
  }
  for (int it = bid; it < 384; it += nblk) norm_item(p, 0, 2, it);
}

extern "C" void kernel_launch(void* const* d_in, const int* in_sizes, int n_in, void* d_out, int out_size, void* d_ws,
                              size_t ws_size, hipStream_t stream) {
  static int grid_blocks = 0;
  if (grid_blocks == 0) {
    int dev = 0, cus = 0, per_cu = 0;
    (void)hipGetDevice(&dev);
    (void)hipDeviceGetAttribute(&cus, hipDeviceAttributeMultiprocessorCount, dev);
    if (hipFuncSetAttribute((const void*)mega, hipFuncAttributeMaxDynamicSharedMemorySize, LDS_BYTES) != hipSuccess) {
      fprintf(stderr, "hipFuncSetAttribute failed\n");
    }
    if (hipOccupancyMaxActiveBlocksPerMultiprocessor(&per_cu, (const void*)mega, 256, LDS_BYTES) != hipSuccess || per_cu < 1) {
      fprintf(stderr, "occupancy query failed (%d)\n", per_cu);
      per_cu = 1;
    }
    if (per_cu > 2) per_cu = 2;
    grid_blocks = cus * per_cu;
    fprintf(stderr, "mega: cus=%d per_cu=%d grid=%d ws=%zu\n", cus, per_cu, grid_blocks, ws_size);
  }
  Params p{};
  const float** pin = (const float**)&p;
  for (int i = 0; i < 27; ++i) pin[i] = (const float*)d_in[i];
  p.out = (float*)d_out;
  unsigned char* ws = (unsigned char*)d_ws;
  size_t off = 0;
  auto take = [&](size_t bytes) { unsigned char* q = ws + off; off += (bytes + 255) & ~(size_t)255; return q; };
  p.xres = (float*)take((size_t)NTOK * 1024 * 4);
  p.mods = (float*)take((size_t)4 * 3 * 6144 * 4);
  p.h = (u16*)take((size_t)NTOK * 1024 * 2);
  p.z = (u16*)take((size_t)NTOK * INW * 2);
  p.vt = (u16*)take((size_t)640 * NTOK * 2);
  p.cat = (u16*)take((size_t)NTOK * 1024 * 2);
  p.u = (u16*)take((size_t)NTOK * 4096 * 2);
  p.uv = (u16*)take((size_t)(16 * 256 * 512 + 2 * 256 * 2048) * 2);
  p.w_inT = (u16*)take((size_t)4 * 2304 * 1024 * 2);
  p.w_outT = (u16*)take((size_t)4 * 1024 * 1024 * 2);
  p.w1T = (u16*)take((size_t)4 * 4096 * 1024 * 2);
  p.w2T = (u16*)take((size_t)4 * 4096 * 1024 * 2);
  p.pqt = (u16*)take((size_t)4 * 512 * 256 * 2);
  p.dft256 = (u16*)take((size_t)256 * 512 * 2);
  p.dft1024 = (u16*)take((size_t)1024 * 2048 * 2);
  p.ck_na = (u16*)take((size_t)2 * 4 * 512 * 256 * 2);
  p.cvt_na = (u16*)take((size_t)2 * 4 * 512 * 256 * 2);
  p.ck_diff = (u16*)take((size_t)2 * 4 * 512 * 256 * 2);
  p.cvt_diff = (u16*)take((size_t)2 * 4 * 512 * 256 * 2);
  p.ck_swa = (u16*)take((size_t)2 * 4 * 512 * 128 * 2);
  p.cvt_swa = (u16*)take((size_t)2 * 4 * 512 * 128 * 2);
  p.ropeD = (float*)take(1024 * 4);
  p.ropeS = (float*)take(2048 * 4);
  p.bar = (unsigned*)take(XCD_BAR_WORDS * 4);
  if (off > ws_size) { fprintf(stderr, "workspace too small: need %zu have %zu\n", off, ws_size); return; }
  if (hipMemsetAsync(p.bar, 0, XCD_BAR_WORDS * 4, stream) != hipSuccess) fprintf(stderr, "memset failed\n");
  void* args[] = {&p};
  hipError_t e = hipLaunchCooperativeKernel((const void*)mega, dim3(grid_blocks), dim3(256), args, LDS_BYTES, stream);
  if (e != hipSuccess) fprintf(stderr, "cooperative launch failed: %s (grid %d)\n", hipGetErrorString(e), grid_blocks);
}
```

```cpp
#include <hip/hip_runtime.h>
#include <hip/hip_cooperative_groups.h>
#include <stdint.h>
#include <stdio.h>
namespace cg = cooperative_groups;

typedef unsigned short u16;
typedef __attribute__((ext_vector_type(8))) short bf16x8;
typedef __attribute__((ext_vector_type(4))) float f32x4;
typedef __attribute__((ext_vector_type(4))) unsigned u32x4;
__device__ __forceinline__ void gload16(u32x4& dst, const void* ptr) {
  asm volatile("global_load_dwordx4 %0, %1, off" : "=v"(dst) : "v"(ptr) : "memory");
}

#define NTOK 6144
#define NPTOK 4096
#define INW 2304
#define LOG2E 1.4426950408889634f
#define LDS_BYTES 73728
#define LSTR 72

#define O_NAK 6291456
#define O_NAV 10485760
#define O_DK 14680064
#define O_DV 18874368
#define O_SK 23068672
#define O_SV 25165824

struct Params {
  const float *x_prompt, *x_sample, *c_na_k, *c_na_v, *c_diff_k, *c_diff_v, *c_swa_k, *c_swa_v, *c, *c_ctx;
  const float *w_ada, *b_ada, *norm1_g, *norm2_g, *w_in, *na_rpb, *lq1, *lk1, *lq2, *lk2, *subln_g, *w_fourier, *swa_sink;
  const float *w_out, *w1, *w2, *final_g;
  float* out;
  float* xres;
  float* mods;
  u16 *h, *z, *vt, *cat, *u, *uv, *w_inT, *w_outT, *w1T, *w2T, *pqt, *dft256, *dft1024;
  u16 *ck_na, *cvt_na, *ck_diff, *cvt_diff, *ck_swa, *cvt_swa;
  float *ropeD, *ropeS;
  unsigned* bar;
};

__device__ __forceinline__ u16 f2bf(float f) {
  unsigned u = __float_as_uint(f);
  u += 0x7fffu + ((u >> 16) & 1u);
  return (u16)(u >> 16);
}
__device__ __forceinline__ int otid() { int t = threadIdx.x; asm volatile("" : "+v"(t)); return t; }
__device__ __forceinline__ float bf2f(u16 h) { return __uint_as_float(((unsigned)h) << 16); }
__device__ __forceinline__ unsigned pack2(float a, float b) { return (unsigned)f2bf(a) | ((unsigned)f2bf(b) << 16); }

__device__ __forceinline__ void transpose_tile(const float* __restrict__ src, int lds_, u16* __restrict__ dst, int ldd,
                                               int k0, int n0, float* sm) {
  const int tid = otid();
  const int c4 = (tid & 15) * 4, r0 = tid >> 4;
#pragma unroll
  for (int i = 0; i < 4; ++i) {
    const int k = r0 + 16 * i;
    const float4 v = *(const float4*)(src + (size_t)(k0 + k) * lds_ + n0 + c4);
    sm[k * 65 + c4 + 0] = v.x; sm[k * 65 + c4 + 1] = v.y; sm[k * 65 + c4 + 2] = v.z; sm[k * 65 + c4 + 3] = v.w;
  }
  __syncthreads();
  const int k8 = (tid & 7) * 8, nn = tid >> 3;
#pragma unroll
  for (int i = 0; i < 2; ++i) {
    const int n = nn + 32 * i;
    uint4 w;
    w.x = pack2(sm[(k8 + 0) * 65 + n], sm[(k8 + 1) * 65 + n]);
    w.y = pack2(sm[(k8 + 2) * 65 + n], sm[(k8 + 3) * 65 + n]);
    w.z = pack2(sm[(k8 + 4) * 65 + n], sm[(k8 + 5) * 65 + n]);
    w.w = pack2(sm[(k8 + 6) * 65 + n], sm[(k8 + 7) * 65 + n]);
    *(uint4*)(dst + (size_t)(n0 + n) * ldd + k0 + k8) = w;
  }
  __syncthreads();
}

__device__ __forceinline__ void adaln_item(const Params& p, int it, float* sm) {
  const int l = it / 96, c0 = (it % 96) * 64;
  float* ssil = sm;
  float* red = sm + 3072;
  const int tid = otid();
  for (int i = tid; i < 3072; i += 256) {
    const int cnd = i >> 10, k = i & 1023;
    const float v = cnd == 0 ? p.c_ctx[k] : p.c[(cnd - 1) * 1024 + k];
    ssil[i] = v / (1.f + expf(-v));
  }
  __syncthreads();
  const int cg4 = (tid & 15) * 4, ks = tid >> 4;
  const float* w = p.w_ada + (size_t)l * 1024 * 6144 + c0 + cg4;
  float a0[4] = {0.f, 0.f, 0.f, 0.f}, a1[4] = {0.f, 0.f, 0.f, 0.f}, a2[4] = {0.f, 0.f, 0.f, 0.f};
#pragma unroll 4
  for (int kk = 0; kk < 64; ++kk) {
    const int k = kk * 16 + ks;
    const float4 v = *(const float4*)(w + (size_t)k * 6144);
    const float s0 = ssil[k], s1 = ssil[1024 + k], s2 = ssil[2048 + k];
    a0[0] += s0 * v.x; a0[1] += s0 * v.y; a0[2] += s0 * v.z; a0[3] += s0 * v.w;
    a1[0] += s1 * v.x; a1[1] += s1 * v.y; a1[2] += s1 * v.z; a1[3] += s1 * v.w;
    a2[0] += s2 * v.x; a2[1] += s2 * v.y; a2[2] += s2 * v.z; a2[3] += s2 * v.w;
  }
#pragma unroll
  for (int j = 0; j < 4; ++j) {
    red[(ks * 3 + 0) * 64 + cg4 + j] = a0[j];
    red[(ks * 3 + 1) * 64 + cg4 + j] = a1[j];
    red[(ks * 3 + 2) * 64 + cg4 + j] = a2[j];
  }
  __syncthreads();
  if (tid < 192) {
    const int cnd = tid >> 6, j = tid & 63;
    float s = p.b_ada[l * 6144 + c0 + j];
    for (int q = 0; q < 16; ++q) s += red[(q * 3 + cnd) * 64 + j];
    p.mods[(l * 3 + cnd) * 6144 + c0 + j] = s;
  }
  __syncthreads();
}

__device__ __forceinline__ void cvt_item(const float* __restrict__ src, u16* __restrict__ dst, int it) {
  const size_t base = (size_t)it * 8192 + otid() * 4;
#pragma unroll
  for (int i = 0; i < 8; ++i) {
    const float4 v = *(const float4*)(src + base + i * 1024);
    uint2 w; w.x = pack2(v.x, v.y); w.y = pack2(v.z, v.w);
    *(uint2*)(dst + base + i * 1024) = w;
  }
}

__device__ __forceinline__ void pq_item(const Params& p, int it, float* sm) {
  const int l = it >> 3, which = (it >> 2) & 1, g = it & 3;
  const int n = otid();
  if (n < 64) sm[n] = which ? sinpif(2.f * (float)n / 64.f) : cospif(2.f * (float)n / 64.f);
  __syncthreads();
  float w[64];
#pragma unroll
  for (int m = 0; m < 64; ++m) w[m] = p.w_fourier[(size_t)l * 65536 + (g * 64 + m) * 256 + n];
  u16* dst = p.pqt + (size_t)l * 512 * 256 + (size_t)(which * 256 + n) * 256 + g * 64;
  for (int c = 0; c < 64; ++c) {
    float s = 0.f;
#pragma unroll
    for (int m = 0; m < 64; ++m) s += sm[(c * m) & 63] * w[m];
    dst[c] = f2bf(s);
  }
  __syncthreads();
}

__device__ __forceinline__ void dft_item(u16* dst, int L, int it) {
  const int twoL = 2 * L;
  for (int e = otid(); e < 8192; e += 256) {
    const int idx = it * 8192 + e;
    const int k = idx / twoL, j = idx % twoL;
    const int jj = j & (L - 1);
    const int ph = (k * jj) & (L - 1);
    const float a = 2.f * (float)ph / (float)L;
    const float v = (j >= L) ? -sinpif(a) : cospif(a);
    dst[idx] = f2bf(v);
  }
}

#define P0_WT 11520
#define P0_ADA 384
#define P0_XC 384
#define P0_CK 320
#define P0_CVT 640
#define P0_PQ 32
#define P0_DFT 272
#define P0_ITEMS (P0_ADA + P0_WT + P0_XC + P0_CK + P0_CVT + P0_PQ + P0_DFT + 1)

__device__ void p0_item(const Params& p, int it, unsigned char* smem) {
  float* sm = (float*)smem;
  if (it < P0_ADA) { adaln_item(p, it, sm); return; }
  it -= P0_ADA;
  if (it < P0_WT) {
    const int l = it / 2880; int r = it % 2880;
    if (r < 576) { transpose_tile(p.w_in + (size_t)l * 1024 * 2304, 2304, p.w_inT + (size_t)l * 2304 * 1024, 1024, (r / 36) * 64, (r % 36) * 64, sm); return; }
    r -= 576;
    if (r < 256) { transpose_tile(p.w_out + (size_t)l * 1024 * 1024, 1024, p.w_outT + (size_t)l * 1024 * 1024, 1024, (r / 16) * 64, (r % 16) * 64, sm); return; }
    r -= 256;
    if (r < 1024) { transpose_tile(p.w1 + (size_t)l * 1024 * 4096, 4096, p.w1T + (size_t)l * 4096 * 1024, 1024, (r / 64) * 64, (r % 64) * 64, sm); return; }
    r -= 1024;
    transpose_tile(p.w2 + (size_t)l * 4096 * 1024, 1024, p.w2T + (size_t)l * 1024 * 4096, 4096, (r / 16) * 64, (r % 16) * 64, sm);
    return;
  }
  it -= P0_WT;
  if (it < P0_XC) {
    const int row0 = it * 16;
    const float* src = row0 < NPTOK ? p.x_prompt + (size_t)row0 * 1024 : p.x_sample + (size_t)(row0 - NPTOK) * 1024;
    float* dst = p.xres + (size_t)row0 * 1024;
#pragma unroll
    for (int i = 0; i < 16; ++i) {
      const int o = (i * 256 + otid()) * 4;
      *(float4*)(dst + o) = *(const float4*)(src + o);
    }
    return;
  }
  it -= P0_XC;
  if (it < P0_CK) {
    if (it < 128) { cvt_item(p.c_na_k, p.ck_na, it); return; }
    it -= 128;
    if (it < 128) { cvt_item(p.c_diff_k, p.ck_diff, it); return; }
    it -= 128;
    cvt_item(p.c_swa_k, p.ck_swa, it);
    return;
  }
  it -= P0_CK;
  if (it < P0_CVT) {
    if (it < 256) { const int bl = it >> 5, r = it & 31; transpose_tile(p.c_na_v + (size_t)bl * 512 * 256, 256, p.cvt_na + (size_t)bl * 256 * 512, 512, (r >> 2) * 64, (r & 3) * 64, sm); return; }
    it -= 256;
    if (it < 256) { const int bl = it >> 5, r = it & 31; transpose_tile(p.c_diff_v + (size_t)bl * 512 * 256, 256, p.cvt_diff + (size_t)bl * 256 * 512, 512, (r >> 2) * 64, (r & 3) * 64, sm); return; }
    it -= 256;
    { const int bl = it >> 4, r = it & 15; transpose_tile(p.c_swa_v + (size_t)bl * 512 * 128, 128, p.cvt_swa + (size_t)bl * 128 * 512, 512, (r >> 1) * 64, (r & 1) * 64, sm); return; }
  }
  it -= P0_CVT;
  if (it < P0_PQ) { pq_item(p, it, sm); return; }
  it -= P0_PQ;
  if (it < 16) { dft_item(p.dft256, 256, it); return; }
  it -= 16;
  if (it < 256) { dft_item(p.dft1024, 1024, it); return; }
  for (int e = otid(); e < 512 + 1024; e += 256) {
    const bool isD = e < 512;
    const int ee = isD ? e : e - 512;
    const int nf = isD ? 8 : 16;
    const int pos = ee / nf, fi = ee % nf;
    const float inv = exp2f(-(float)fi * (13.287712379549449f / (float)nf));
    float tt = (float)pos * inv * 0.15915494309189535f;
    tt -= rintf(tt);
    float sn, cs;
    sincospif(2.f * tt, &sn, &cs);
    if (isD) { p.ropeD[ee] = cs; p.ropeD[512 + ee] = sn; }
    else { p.ropeS[ee] = cs; p.ropeS[1024 + ee] = sn; }
  }
}

__device__ __forceinline__ void norm_item(const Params& p, int l, int which, int it) {
  const int lane = otid() & 63, wave = otid() >> 6;
#pragma unroll 1
  for (int j = 0; j < 4; ++j) {
    const int row = it * 16 + wave * 4 + j;
    const float* xr = p.xres + (size_t)row * 1024;
    float4 v[4];
    float ss = 0.f;
#pragma unroll
    for (int k = 0; k < 4; ++k) {
      v[k] = *(const float4*)(xr + (k * 64 + lane) * 4);
      ss += v[k].x * v[k].x + v[k].y * v[k].y + v[k].z * v[k].z + v[k].w * v[k].w;
    }
#pragma unroll
    for (int o = 32; o >= 1; o >>= 1) ss += __shfl_xor(ss, o);
    const float rs = rsqrtf(ss * (1.f / 1024.f) + 1e-6f);
    if (which < 2) {
      const int cond = row < NPTOK ? 0 : 1 + ((row - NPTOK) >> 10);
      const float* gp = (which == 0 ? p.norm1_g : p.norm2_g) + l * 1024;
      const float* shp = p.mods + (size_t)(l * 3 + cond) * 6144 + (which * 3 + 0) * 1024;
      const float* scp = shp + 1024;
#pragma unroll
      for (int k = 0; k < 4; ++k) {
        const int col = (k * 64 + lane) * 4;
        const float4 gg = *(const float4*)(gp + col);
        const float4 sh = *(const float4*)(shp + col);
        const float4 sc = *(const float4*)(scp + col);
        uint2 w;
        w.x = pack2(v[k].x * rs * gg.x * (1.f + sc.x) + sh.x, v[k].y * rs * gg.y * (1.f + sc.y) + sh.y);
        w.y = pack2(v[k].z * rs * gg.z * (1.f + sc.z) + sh.z, v[k].w * rs * gg.w * (1.f + sc.w) + sh.w);
        *(uint2*)(p.h + (size_t)row * 1024 + col) = w;
      }
    } else {
#pragma unroll
      for (int k = 0; k < 4; ++k) {
        const int col = (k * 64 + lane) * 4;
        const float4 gg = *(const float4*)(p.final_g + col);
        float4 o;
        o.x = v[k].x * rs * gg.x; o.y = v[k].y * rs * gg.y; o.z = v[k].z * rs * gg.z; o.w = v[k].w * rs * gg.w;
        *(float4*)(p.out + (size_t)row * 1024 + col) = o;
      }
    }
  }
}

template <bool ZERO>
__device__ __forceinline__ void gemm_main_t(const u16* __restrict__ X, int ldx, const u16* __restrict__ Y, int ldy, int K,
                                          u16* smem, f32x4 (&acc)[4][4]) {
  const int tid = otid(), lane = tid & 63, wave = tid >> 6, wx = wave & 1, wy = wave >> 1, r = lane & 15, g = lane >> 4;
  u16* sX = smem;
  u16* sY = smem + 2 * 128 * LSTR;
  const int lrow = tid >> 3, lkc = tid & 7;
  const u16* gx = X + (size_t)lrow * ldx + lkc * 8;
  const u16* gy = Y + (size_t)lrow * ldy + lkc * 8;
  u32x4 rx[4], ry[4];
#pragma unroll
  for (int i = 0; i < 4; ++i) {
    rx[i] = *(const u32x4*)(gx + (size_t)(32 * i) * ldx);
    ry[i] = *(const u32x4*)(gy + (size_t)(32 * i) * ldy);
  }
  if (ZERO) {
#pragma unroll
    for (int a = 0; a < 4; ++a)
#pragma unroll
      for (int b = 0; b < 4; ++b) acc[a][b] = (f32x4){0.f, 0.f, 0.f, 0.f};
  }
#pragma unroll
  for (int i = 0; i < 4; ++i) {
    *(u32x4*)(sX + (lrow + 32 * i) * LSTR + lkc * 8) = rx[i];
    *(u32x4*)(sY + (lrow + 32 * i) * LSTR + lkc * 8) = ry[i];
  }
  __syncthreads();
  const int nk = K >> 6;
  const u16* cx0 = sX + (wx * 64 + r) * LSTR + g * 8;
  const u16* cy0 = sY + (wy * 64 + r) * LSTR + g * 8;
#define GEMM_COMPUTE(cur)                                                                            \
  {                                                                                                  \
    const u16* cx = cx0 + (cur) * 128 * LSTR;                                                        \
    const u16* cy = cy0 + (cur) * 128 * LSTR;                                                        \
    _Pragma("unroll") for (int kk = 0; kk < 2; ++kk) {                                               \
      bf16x8 a[4], b[4];                                                                             \
      _Pragma("unroll") for (int i = 0; i < 4; ++i) {                                                \
        a[i] = *(const bf16x8*)(cx + i * 16 * LSTR + kk * 32);                                       \
        b[i] = *(const bf16x8*)(cy + i * 16 * LSTR + kk * 32);                                       \
      }                                                                                              \
      _Pragma("unroll") for (int xi = 0; xi < 4; ++xi)                                               \
        _Pragma("unroll") for (int yi = 0; yi < 4; ++yi)                                             \
          acc[xi][yi] = __builtin_amdgcn_mfma_f32_16x16x32_bf16(a[xi], b[yi], acc[xi][yi], 0, 0, 0); \
    }                                                                                                \
  }
  for (int kt = 0; kt < nk - 1; ++kt) {
    const int cur = kt & 1;
#pragma unroll
    for (int i = 0; i < 4; ++i) {
      gload16(rx[i], gx + (size_t)(32 * i) * ldx + (kt + 1) * 64);
      gload16(ry[i], gy + (size_t)(32 * i) * ldy + (kt + 1) * 64);
    }
    GEMM_COMPUTE(cur);
    asm volatile("s_waitcnt vmcnt(0)" ::: "memory");
    u16* dX = sX + (cur ^ 1) * 128 * LSTR;
    u16* dY = sY + (cur ^ 1) * 128 * LSTR;
#pragma unroll
    for (int i = 0; i < 4; ++i) {
      *(u32x4*)(dX + (lrow + 32 * i) * LSTR + lkc * 8) = rx[i];
      *(u32x4*)(dY + (lrow + 32 * i) * LSTR + lkc * 8) = ry[i];
    }
    __syncthreads();
  }
  GEMM_COMPUTE((nk - 1) & 1);
  __syncthreads();
#undef GEMM_COMPUTE
}

#ifndef REP_GEMM
#define REP_GEMM 0
#endif
#ifndef REP_MIX
#define REP_MIX 0
#endif
#ifndef REP_SYNC
#define REP_SYNC 0
#endif
#ifndef REP_P0
#define REP_P0 0
#endif
__device__ __forceinline__ void gemm_main(const u16* __restrict__ X, int ldx, const u16* __restrict__ Y, int ldy, int K,
                                          u16* smem, f32x4 (&acc)[4][4]) {
  gemm_main_t<true>(X, ldx, Y, ldy, K, smem, acc);
#if REP_GEMM
  gemm_main_t<false>(X, ldx, Y, ldy, K, smem, acc);
#pragma unroll
  for (int a = 0; a < 4; ++a)
#pragma unroll
    for (int b = 0; b < 4; ++b) acc[a][b] *= 0.5f;
#endif
}

__device__ void gin_tile(const Params& p, int l, int it, u16* smem) {
  const int ty = it % 48, tx = it / 48;
  const int n0 = tx * 128, m0 = ty * 128;
  f32x4 acc[4][4];
  gemm_main(p.w_inT + (size_t)l * 2304 * 1024 + (size_t)n0 * 1024, 1024, p.h + (size_t)m0 * 1024, 1024, 1024, smem, acc);
  const int lane = otid() & 63, wave = otid() >> 6, wx = wave & 1, wy = wave >> 1, r = lane & 15, g = lane >> 4;
  const int nw = n0 + wx * 64;
  const bool isS = m0 >= NPTOK;
  int ropeMode = 0;
  if (isS) {
    if (nw >= 768 && nw < 1280) ropeMode = 1;
    else if (nw >= 1792 && nw < 2176) ropeMode = 2;
  }
  float* okv = nullptr; int okv_w = 0, okv_c = 0;
  if (!isS) {
    if (nw >= 256 && nw < 512) { okv = p.out + O_NAK; okv_w = 256; okv_c = nw - 256; }
    else if (nw >= 512 && nw < 768) { okv = p.out + O_NAV; okv_w = 256; okv_c = nw - 512; }
    else if (nw >= 1024 && nw < 1280) { okv = p.out + O_DK; okv_w = 256; okv_c = nw - 1024; }
    else if (nw >= 1280 && nw < 1536) { okv = p.out + O_DV; okv_w = 256; okv_c = nw - 1280; }
    else if (nw >= 2048 && nw < 2176) { okv = p.out + O_SK; okv_w = 128; okv_c = nw - 2048; }
    else if (nw >= 2176) { okv = p.out + O_SV; okv_w = 128; okv_c = nw - 2176; }
  }
  int vrow = -1;
  if (nw >= 512 && nw < 768) vrow = nw - 512;
  else if (nw >= 1280 && nw < 1536) vrow = 256 + nw - 1280;
  else if (nw >= 2176) vrow = 512 + nw - 2176;
#pragma unroll
  for (int yi = 0; yi < 4; ++yi) {
    const int m = m0 + wy * 64 + yi * 16 + r;
    const int t = (m - NPTOK) & 1023;
    const int prow = t >> 6, pcol = t & 63;
#pragma unroll
    for (int xi = 0; xi < 4; ++xi) {
      f32x4 v = acc[xi][yi];
      if (ropeMode == 1) {
        const int pos = (xi & 1) ? pcol : prow;
        const float4 cs = *(const float4*)(p.ropeD + pos * 8 + 4 * (g & 1));
        const float4 sn = *(const float4*)(p.ropeD + 512 + pos * 8 + 4 * (g & 1));
        const float sg = (g >= 2) ? 1.f : -1.f;
        const float o0 = __shfl_xor(v[0], 32), o1 = __shfl_xor(v[1], 32), o2 = __shfl_xor(v[2], 32), o3 = __shfl_xor(v[3], 32);
        v[0] = v[0] * cs.x + sg * o0 * sn.x; v[1] = v[1] * cs.y + sg * o1 * sn.y;
        v[2] = v[2] * cs.z + sg * o2 * sn.z; v[3] = v[3] * cs.w + sg * o3 * sn.w;
      } else if (ropeMode == 2) {
        const int pos = (xi >> 1) ? pcol : prow;
        const float4 cs = *(const float4*)(p.ropeS + pos * 16 + 4 * g);
        const float4 sn = *(const float4*)(p.ropeS + 1024 + pos * 16 + 4 * g);
        const f32x4 o = acc[xi ^ 1][yi];
        const float sg = (xi & 1) ? 1.f : -1.f;
        v[0] = v[0] * cs.x + sg * o[0] * sn.x; v[1] = v[1] * cs.y + sg * o[1] * sn.y;
        v[2] = v[2] * cs.z + sg * o[2] * sn.z; v[3] = v[3] * cs.w + sg * o[3] * sn.w;
      }
      const int nloc = xi * 16 + 4 * g;
      if (okv) {
        const int b = m >> 8, pos = m & 255;
        float4 o4; o4.x = v[0]; o4.y = v[1]; o4.z = v[2]; o4.w = v[3];
        *(float4*)(okv + ((size_t)((b * 4 + l) * 256 + pos)) * okv_w + okv_c + nloc) = o4;
      }
      if (vrow >= 0) {
#pragma unroll
        for (int i = 0; i < 4; ++i) p.vt[(size_t)(vrow + nloc + i) * NTOK + m] = f2bf(v[i]);
      } else {
        uint2 w; w.x = pack2(v[0], v[1]); w.y = pack2(v[2], v[3]);
        *(uint2*)(p.z + (size_t)m * INW + nw + nloc) = w;
      }
    }
  }
}

__device__ void res_tile(const Params& p, int l, int it, const u16* A, const u16* WT, int K, int gi, u16* smem) {
  const int ty = it % 48, tx = it / 48;
  const int n0 = tx * 128, m0 = ty * 128;
  f32x4 acc[4][4];
  gemm_main(WT + (size_t)n0 * K, K, A + (size_t)m0 * K, K, K, smem, acc);
  const int lane = otid() & 63, wave = otid() >> 6, wx = wave & 1, wy = wave >> 1, r = lane & 15, g = lane >> 4;
  const int cond = m0 < NPTOK ? 0 : 1 + ((m0 - NPTOK) >> 10);
  const float* gate = p.mods + (size_t)(l * 3 + cond) * 6144 + gi * 1024;
  float4 xv[4][4];
#pragma unroll
  for (int xi = 0; xi < 4; ++xi)
#pragma unroll
    for (int yi = 0; yi < 4; ++yi)
      xv[xi][yi] = *(const float4*)(p.xres + (size_t)(m0 + wy * 64 + yi * 16 + r) * 1024 + n0 + wx * 64 + xi * 16 + 4 * g);
#pragma unroll
  for (int xi = 0; xi < 4; ++xi) {
    const int n = n0 + wx * 64 + xi * 16 + 4 * g;
    const float4 gt = *(const float4*)(gate + n);
#pragma unroll
    for (int yi = 0; yi < 4; ++yi) {
      const int m = m0 + wy * 64 + yi * 16 + r;
      const f32x4 v = acc[xi][yi];
      float4 o = xv[xi][yi];
      o.x += gt.x * v[0]; o.y += gt.y * v[1]; o.z += gt.z * v[2]; o.w += gt.w * v[3];
      *(float4*)(p.xres + (size_t)m * 1024 + n) = o;
    }
  }
}

__device__ void m1_tile(const Params& p, int l, int it, u16* smem) {
  const int ty = it % 48, tx = it / 48;
  const int n0 = tx * 128, m0 = ty * 128;
  f32x4 acc[4][4];
  gemm_main(p.w1T + (size_t)l * 4096 * 1024 + (size_t)n0 * 1024, 1024, p.h + (size_t)m0 * 1024, 1024, 1024, smem, acc);
  const int lane = otid() & 63, wave = otid() >> 6, wx = wave & 1, wy = wave >> 1, r = lane & 15, g = lane >> 4;
#pragma unroll
  for (int xi = 0; xi < 4; ++xi) {
    const int n = n0 + wx * 64 + xi * 16 + 4 * g;
#pragma unroll
    for (int yi = 0; yi < 4; ++yi) {
      const int m = m0 + wy * 64 + yi * 16 + r;
      const f32x4 v = acc[xi][yi];
      float a0 = fmaxf(v[0], 0.f), a1 = fmaxf(v[1], 0.f), a2 = fmaxf(v[2], 0.f), a3 = fmaxf(v[3], 0.f);
      uint2 w; w.x = pack2(a0 * a0, a1 * a1); w.y = pack2(a2 * a2, a3 * a3);
      *(uint2*)(p.u + (size_t)m * 4096 + n) = w;
    }
  }
}

__device__ void f1_tile(const Params& p, int l, int it, u16* smem) {
  const int tx = it % 48, ty = it / 48;
  const int x0 = tx * 128, y0 = ty * 128;
  f32x4 acc[4][4];
  gemm_main(p.z + (size_t)x0 * INW + 1536, INW, p.pqt + (size_t)l * 512 * 256 + (size_t)y0 * 256, 256, 256, smem, acc);
  const int lane = otid() & 63, wave = otid() >> 6, wx = wave & 1, wy = wave >> 1, r = lane & 15, g = lane >> 4;
#pragma unroll
  for (int yi = 0; yi < 4; ++yi) {
    const int y = y0 + wy * 64 + yi * 16 + r;
    const int col = y & 255, which = y >> 8;
#pragma unroll
    for (int xi = 0; xi < 4; ++xi) {
      const int tok = x0 + wx * 64 + xi * 16 + 4 * g;
      size_t addr;
      if (tok < NPTOK) {
        const int b = tok >> 8, pos = tok & 255;
        addr = (size_t)b * (256 * 512) + (size_t)col * 512 + which * 256 + pos;
      } else {
        const int b = (tok - NPTOK) >> 10, pos = (tok - NPTOK) & 1023;
        addr = (size_t)16 * 256 * 512 + (size_t)b * (256 * 2048) + (size_t)col * 2048 + which * 1024 + pos;
      }
      const f32x4 v = acc[xi][yi];
      uint2 w; w.x = pack2(v[0], v[1]); w.y = pack2(v[2], v[3]);
      *(uint2*)(p.uv + addr) = w;
    }
  }
}

__device__ void f2_tile(const Params& p, int it, u16* smem) {
  int L, b, tx, ty, tokbase;
  const u16* uvb; const u16* dft;
  if (it < 32) { L = 1024; b = it >> 4; tx = (it >> 3) & 1; ty = it & 7; uvb = p.uv + (size_t)16 * 256 * 512 + (size_t)b * (256 * 2048); dft = p.dft1024; tokbase = NPTOK + b * 1024; }
  else { it -= 32; L = 256; b = it >> 2; tx = (it >> 1) & 1; ty = it & 1; uvb = p.uv + (size_t)b * (256 * 512); dft = p.dft256; tokbase = b * 256; }
  const int x0 = tx * 128, y0 = ty * 128, K = 2 * L;
  f32x4 acc[4][4];
  gemm_main(uvb + (size_t)x0 * K, K, dft + (size_t)y0 * K, K, K, smem, acc);
  const int lane = otid() & 63, wave = otid() >> 6, wx = wave & 1, wy = wave >> 1, r = lane & 15, g = lane >> 4;
  const float scale = rsqrtf(64.f * (float)L);
#pragma unroll
  for (int yi = 0; yi < 4; ++yi) {
    const int pos = y0 + wy * 64 + yi * 16 + r;
#pragma unroll
    for (int xi = 0; xi < 4; ++xi) {
      const int col = x0 + wx * 64 + xi * 16 + 4 * g;
      const f32x4 v = acc[xi][yi];
      uint2 w; w.x = pack2(v[0] * scale, v[1] * scale); w.y = pack2(v[2] * scale, v[3] * scale);
      *(uint2*)(p.cat + (size_t)(tokbase + pos) * 1024 + 512 + col) = w;
    }
  }
}

struct Seg { const u16* K; const u16* Vt; int ldk, ldv, nblk, pos0, stride; };
template <int QT> struct AState { float m[QT]; float ls[QT]; f32x4 o[QT][4]; };

template <int DC>
__device__ __forceinline__ void load_blk(const Seg& s0, const Seg& s1, int b, int r, int g, bf16x8 (&kf)[2][DC], bf16x8 (&vf)[4]) {
  const bool in0 = b < s0.nblk;
  const u16* Kp = in0 ? s0.K : s1.K;
  const u16* Vp = in0 ? s0.Vt : s1.Vt;
  const int ldk = in0 ? s0.ldk : s1.ldk, ldv = in0 ? s0.ldv : s1.ldv;
  const int pos = in0 ? (s0.pos0 + b * s0.stride) : (s1.pos0 + (b - s0.nblk) * s1.stride);
  const int krow = pos + 8 * (r >> 2) + (r & 3);
#pragma unroll
  for (int t = 0; t < 2; ++t) {
    const u16* kp = Kp + (size_t)(krow + 4 * t) * ldk + g * 8;
#pragma unroll
    for (int dc = 0; dc < DC; ++dc) kf[t][dc] = *(const bf16x8*)(kp + dc * 32);
  }
#pragma unroll
  for (int dv = 0; dv < 4; ++dv) vf[dv] = *(const bf16x8*)(Vp + (size_t)(dv * 16 + r) * ldv + pos + 8 * g);
}

template <int D, int QT, int MODE>
__device__ __forceinline__ void attn_run(const Seg& s0, const Seg& s1, const bf16x8 (&qf)[QT][D / 32], const float sc,
                                         AState<QT>& st, const int qpos0, const float* __restrict__ rpb_h) {
  constexpr int DC = D / 32;
  const int lane = otid() & 63, r = lane & 15, g = lane >> 4;
  const int nb = s0.nblk + s1.nblk;
  bf16x8 kc[2][DC], vc[4];
  load_blk<DC>(s0, s1, 0, r, g, kc, vc);
  for (int b = 0; b < nb; ++b) {
    bf16x8 kn[2][DC], vn[4];
    load_blk<DC>(s0, s1, (b + 1 < nb) ? b + 1 : b, r, g, kn, vn);
    const bool in0 = b < s0.nblk;
    const int pos = in0 ? (s0.pos0 + b * s0.stride) : (s1.pos0 + (b - s0.nblk) * s1.stride);
#pragma unroll
    for (int q = 0; q < QT; ++q) {
      f32x4 s_[2];
      s_[0] = (f32x4){0.f, 0.f, 0.f, 0.f};
      s_[1] = (f32x4){0.f, 0.f, 0.f, 0.f};
#pragma unroll
      for (int t = 0; t < 2; ++t)
#pragma unroll
        for (int dc = 0; dc < DC; ++dc) s_[t] = __builtin_amdgcn_mfma_f32_16x16x32_bf16(kc[t][dc], qf[q][dc], s_[t], 0, 0, 0);
      float sv[8];
#pragma unroll
      for (int t = 0; t < 2; ++t)
#pragma unroll
        for (int i = 0; i < 4; ++i) {
          float x = s_[t][i] * sc;
          if (MODE == 1) {
            if (!in0) {
              const int qpos = qpos0 + q * 16 + r;
              const int qrow = qpos >> 6, cq = qpos & 63;
              const int kpos = pos + 8 * g + 4 * t + i;
              const int krow = kpos >> 6, ck = kpos & 63;
              const int cs = min(max(cq - 8, 0), 48);
              const bool valid = (ck >= cs) && (ck < cs + 16);
              const int bi = (krow - qrow + 7) * 31 + (ck - cq + 15);
              const float bias = valid ? rpb_h[bi] : 0.f;
              x = valid ? (x + bias * LOG2E) : -1e30f;
            }
          } else if (MODE == 2) {
            if (!in0) {
              const int qpos = qpos0 + q * 16 + r;
              const int kpos = pos + 8 * g + 4 * t + i;
              const int d = qpos - kpos;
              x = (d <= 128 && d >= -128) ? x : -1e30f;
            }
          }
          sv[4 * t + i] = x;
        }
      float mx = fmaxf(fmaxf(fmaxf(sv[0], sv[1]), fmaxf(sv[2], sv[3])), fmaxf(fmaxf(sv[4], sv[5]), fmaxf(sv[6], sv[7])));
      mx = fmaxf(mx, __shfl_xor(mx, 16));
      mx = fmaxf(mx, __shfl_xor(mx, 32));
      const float mnew = fmaxf(st.m[q], mx);
      const float alpha = exp2f(st.m[q] - mnew);
      st.m[q] = mnew;
      float ps = 0.f;
#pragma unroll
      for (int j = 0; j < 8; ++j) { sv[j] = exp2f(sv[j] - mnew); ps += sv[j]; }
      st.ls[q] = st.ls[q] * alpha + ps;
      union { bf16x8 v; unsigned w[4]; } pf;
      pf.w[0] = pack2(sv[0], sv[1]); pf.w[1] = pack2(sv[2], sv[3]); pf.w[2] = pack2(sv[4], sv[5]); pf.w[3] = pack2(sv[6], sv[7]);
#pragma unroll
      for (int dv = 0; dv < 4; ++dv) {
        f32x4 o = st.o[q][dv];
        o[0] *= alpha; o[1] *= alpha; o[2] *= alpha; o[3] *= alpha;
        st.o[q][dv] = __builtin_amdgcn_mfma_f32_16x16x32_bf16(vc[dv], pf.v, o, 0, 0, 0);
      }
    }
#pragma unroll
    for (int t = 0; t < 2; ++t)
#pragma unroll
      for (int dc = 0; dc < DC; ++dc) kc[t][dc] = kn[t][dc];
#pragma unroll
    for (int dv = 0; dv < 4; ++dv) vc[dv] = vn[dv];
  }
}

template <int QT>
__device__ __forceinline__ void astate_init(AState<QT>& st, float m0, float l0) {
#pragma unroll
  for (int q = 0; q < QT; ++q) {
    st.m[q] = m0; st.ls[q] = l0;
#pragma unroll
    for (int dv = 0; dv < 4; ++dv) st.o[q][dv] = (f32x4){0.f, 0.f, 0.f, 0.f};
  }
}
template <int QT>
__device__ __forceinline__ void astate_finalize(AState<QT>& st) {
#pragma unroll
  for (int q = 0; q < QT; ++q) {
    float l = st.ls[q];
    l += __shfl_xor(l, 16);
    l += __shfl_xor(l, 32);
    const float inv = 1.f / l;
#pragma unroll
    for (int dv = 0; dv < 4; ++dv) { st.o[q][dv][0] *= inv; st.o[q][dv][1] *= inv; st.o[q][dv][2] *= inv; st.o[q][dv][3] *= inv; }
  }
}
template <int DC, int QT>
__device__ __forceinline__ void load_q(const u16* zq  , bf16x8 (&qf)[QT][DC]) {
  const int lane = otid() & 63, r = lane & 15, g = lane >> 4;
#pragma unroll
  for (int q = 0; q < QT; ++q)
#pragma unroll
    for (int dc = 0; dc < DC; ++dc) qf[q][dc] = *(const bf16x8*)(zq + (size_t)(q * 16 + r) * INW + dc * 32 + g * 8);
}
template <int QT>
__device__ __forceinline__ void write_o(const Params& p, const AState<QT>& st, int tok0, int col0) {
  const int lane = otid() & 63, r = lane & 15, g = lane >> 4;
#pragma unroll
  for (int q = 0; q < QT; ++q)
#pragma unroll
    for (int dv = 0; dv < 4; ++dv) {
      const f32x4 v = st.o[q][dv];
      uint2 w; w.x = pack2(v[0], v[1]); w.y = pack2(v[2], v[3]);
      *(uint2*)(p.cat + (size_t)(tok0 + q * 16 + r) * 1024 + col0 + dv * 16 + 4 * g) = w;
    }
}

__device__ __forceinline__ float diff_lambda(const Params& p, int l, float lam_init) {
  const int lane = otid() & 63;
  float a = 0.f, b = 0.f;
  if (lane < 32) { a = p.lq1[l * 32 + lane] * p.lk1[l * 32 + lane]; b = p.lq2[l * 32 + lane] * p.lk2[l * 32 + lane]; }
#pragma unroll
  for (int o = 32; o >= 1; o >>= 1) { a += __shfl_xor(a, o); b += __shfl_xor(b, o); }
  return expf(a) - expf(b) + lam_init;
}

template <int QT>
__device__ __forceinline__ void diff_finish(const Params& p, int l, AState<QT>& s1, const AState<QT>& s2, int tok0, int col0) {
  const int lane = otid() & 63, g = lane >> 4;
  const float lam_init = 0.8f - 0.6f * expf(-0.3f * (float)l);
  const float lam = diff_lambda(p, l, lam_init);
  const float* sg = p.subln_g + l * 64;
#pragma unroll
  for (int q = 0; q < QT; ++q) {
    float ss = 0.f;
#pragma unroll
    for (int dv = 0; dv < 4; ++dv)
#pragma unroll
      for (int i = 0; i < 4; ++i) {
        const float v = s1.o[q][dv][i] - lam * s2.o[q][dv][i];
        s1.o[q][dv][i] = v;
        ss += v * v;
      }
    ss += __shfl_xor(ss, 16);
    ss += __shfl_xor(ss, 32);
    const float rs = rsqrtf(ss * (1.f / 64.f) + 1e-6f) * (1.f - lam_init);
#pragma unroll
    for (int dv = 0; dv < 4; ++dv) {
      const float4 gg = *(const float4*)(sg + dv * 16 + 4 * g);
      s1.o[q][dv][0] *= rs * gg.x; s1.o[q][dv][1] *= rs * gg.y; s1.o[q][dv][2] *= rs * gg.z; s1.o[q][dv][3] *= rs * gg.w;
    }
  }
  write_o<QT>(p, s1, tok0, col0);
}

__device__ void attn_ctx_item(const Params& p, int l, int bi) {
  const int wave = otid() >> 6, lane = otid() & 63, g = lane >> 4;
  const int w = bi * 4 + wave;
  const int type = w >> 10, rem = w & 1023;
  const int b = rem >> 6, h = (rem >> 4) & 3, qt = rem & 15;
  const int tokb = b * 256, tok0 = tokb + qt * 16;
  const u16* zb = p.z + (size_t)tokb * INW;
  Seg sN; sN.K = nullptr; sN.Vt = nullptr; sN.ldk = 0; sN.ldv = 0; sN.nblk = 0; sN.pos0 = 0; sN.stride = 0;
  if (type < 2) {
    const int kvh = h >> 1;
    const int qcol = type == 0 ? h * 64 : 1792 + h * 64;
    const int kcol = type == 0 ? 256 + h * 64 : 2048 + kvh * 64;
    const int vrow = type == 0 ? h * 64 : 512 + kvh * 64;
    const int ocol = type == 0 ? h * 64 : 768 + h * 64;
    bf16x8 qf[1][2];
    load_q<2, 1>(p.z + (size_t)tok0 * INW + qcol, qf);
    Seg s0; s0.K = zb + kcol; s0.Vt = p.vt + (size_t)vrow * NTOK + tokb; s0.ldk = INW; s0.ldv = NTOK; s0.nblk = 8; s0.pos0 = 0; s0.stride = 32;
    AState<1> st;
    const float sk = type == 0 ? -1e30f : p.swa_sink[l * 4 + h] * LOG2E;
    astate_init<1>(st, sk, (type == 1 && g == 0) ? 1.f : 0.f);
    attn_run<64, 1, 0>(s0, sN, qf, 0.125f * LOG2E, st, 0, nullptr);
    astate_finalize<1>(st);
    write_o<1>(p, st, tok0, ocol);
  } else {
    AState<1> st1, st2;
#pragma unroll 1
    for (int ps = 0; ps < 2; ++ps) {
      bf16x8 qf[1][1];
      load_q<1, 1>(p.z + (size_t)tok0 * INW + 768 + h * 64 + ps * 32, qf);
      Seg s0; s0.K = zb + 1024 + h * 64 + ps * 32; s0.Vt = p.vt + (size_t)(256 + h * 64) * NTOK + tokb; s0.ldk = INW; s0.ldv = NTOK; s0.nblk = 8; s0.pos0 = 0; s0.stride = 32;
      AState<1> st;
      astate_init<1>(st, -1e30f, 0.f);
      attn_run<32, 1, 0>(s0, sN, qf, 0.17677669529663687f * LOG2E, st, 0, nullptr);
      astate_finalize<1>(st);
      if (ps == 0) st1 = st; else st2 = st;
    }
    diff_finish<1>(p, l, st1, st2, tok0, 256 + h * 64);
  }
}

__device__ void attn_lat_item(const Params& p, int l, int bi) {
  const int wave = otid() >> 6, lane = otid() & 63, g = lane >> 4;
  const int w = bi * 4 + wave;
  const int type = w >> 9, rem = w & 511;
  const int b = rem >> 8, h = (rem >> 6) & 3, qt = rem & 63;
  const int q0 = qt * 16;
  const int tokb = NPTOK + b * 1024, tok0 = tokb + q0;
  const u16* zb = p.z + (size_t)tokb * INW;
  const int bl = b * 4 + l;
  if (type == 0) {
    AState<1> st1, st2;
#pragma unroll 1
    for (int ps = 0; ps < 2; ++ps) {
      bf16x8 qf[1][1];
      load_q<1, 1>(p.z + (size_t)tok0 * INW + 768 + h * 64 + ps * 32, qf);
      Seg s0; s0.K = p.ck_diff + (size_t)bl * 512 * 256 + h * 64 + ps * 32; s0.Vt = p.cvt_diff + (size_t)(bl * 256 + h * 64) * 512; s0.ldk = 256; s0.ldv = 512; s0.nblk = 16; s0.pos0 = 0; s0.stride = 32;
      Seg s1; s1.K = zb + 1024 + h * 64 + ps * 32; s1.Vt = p.vt + (size_t)(256 + h * 64) * NTOK + tokb; s1.ldk = INW; s1.ldv = NTOK; s1.nblk = 32; s1.pos0 = 0; s1.stride = 32;
      AState<1> st;
      astate_init<1>(st, -1e30f, 0.f);
      attn_run<32, 1, 0>(s0, s1, qf, 0.17677669529663687f * LOG2E, st, 0, nullptr);
      astate_finalize<1>(st);
      if (ps == 0) st1 = st; else st2 = st;
    }
    diff_finish<1>(p, l, st1, st2, tok0, 256 + h * 64);
  } else if (type == 1) {
    const int kvh = h >> 1;
    bf16x8 qf[1][2];
    load_q<2, 1>(p.z + (size_t)tok0 * INW + 1792 + h * 64, qf);
    Seg s0; s0.K = p.ck_swa + (size_t)bl * 512 * 128 + kvh * 64; s0.Vt = p.cvt_swa + (size_t)(bl * 128 + kvh * 64) * 512; s0.ldk = 128; s0.ldv = 512; s0.nblk = 16; s0.pos0 = 0; s0.stride = 32;
    const int lo = max(0, q0 - 128) & ~31;
    const int hi = min(1024, (q0 + 15 + 128 + 1 + 31) & ~31);
    Seg s1; s1.K = zb + 2048 + kvh * 64; s1.Vt = p.vt + (size_t)(512 + kvh * 64) * NTOK + tokb; s1.ldk = INW; s1.ldv = NTOK; s1.nblk = (hi - lo) >> 5; s1.pos0 = lo; s1.stride = 32;
    AState<1> st;
    astate_init<1>(st, p.swa_sink[l * 4 + h] * LOG2E, g == 0 ? 1.f : 0.f);
    attn_run<64, 1, 2>(s0, s1, qf, 0.125f * LOG2E, st, q0, nullptr);
    astate_finalize<1>(st);
    write_o<1>(p, st, tok0, 768 + h * 64);
  } else {
    bf16x8 qf[1][2];
    load_q<2, 1>(p.z + (size_t)tok0 * INW + h * 64, qf);
    Seg s0; s0.K = p.ck_na + (size_t)bl * 512 * 256 + h * 64; s0.Vt = p.cvt_na + (size_t)(bl * 256 + h * 64) * 512; s0.ldk = 256; s0.ldv = 512; s0.nblk = 16; s0.pos0 = 0; s0.stride = 32;
    const int qrow = q0 >> 6, c0 = q0 & 63;
    const int rstart = min(max(qrow - 4, 0), 8);
    const int kc0 = min(max(c0 - 8, 0), 32);
    Seg s1; s1.K = zb + 256 + h * 64; s1.Vt = p.vt + (size_t)(h * 64) * NTOK + tokb; s1.ldk = INW; s1.ldv = NTOK; s1.nblk = 8; s1.pos0 = rstart * 64 + kc0; s1.stride = 64;
    AState<1> st;
    astate_init<1>(st, -1e30f, 0.f);
    attn_run<64, 1, 1>(s0, s1, qf, 0.125f * LOG2E, st, q0, p.na_rpb + (size_t)(l * 4 + h) * 15 * 31);
    astate_finalize<1>(st);
    write_o<1>(p, st, tok0, h * 64);
  }
}


#define XB_TMO      128
#define XB_XCNT(j)  (256  + 64 * (j))
#define XB_XSUB(j)  (1280 + 64 * (j))
#define XB_XGEN(j)  (2304 + 64 * (j))
#define XB_TOP      3328
#define XB_TOPGEN   3392
#define XCD_BAR_WORDS 3456
#define XB_SPIN_CAP (1u << 22)
#define LAS __attribute__((address_space(3)))
__device__ __forceinline__ unsigned xb_ld(unsigned* p)              { return __hip_atomic_load(p, __ATOMIC_RELAXED, __HIP_MEMORY_SCOPE_AGENT); }
__device__ __forceinline__ unsigned xb_add(unsigned* p, unsigned v) { return __hip_atomic_fetch_add(p, v, __ATOMIC_RELAXED, __HIP_MEMORY_SCOPE_AGENT); }
__device__ __forceinline__ unsigned xb_xcc_id() { return (unsigned)__builtin_amdgcn_s_getreg((3 << 11) | 20) & 0xFu; }
#define XB_SPIN(cond, bar) do { unsigned _sp = 0; while (cond) { __builtin_amdgcn_s_sleep(1); \
    if ((++_sp & 255u) == 0u) { if (xb_ld(&(bar)[XB_TMO])) break; if (_sp > XB_SPIN_CAP) { atomicAdd(&(bar)[XB_TMO], 1u); break; } } } } while (0)
struct XcdBarrier { unsigned* bar; unsigned x; volatile LAS unsigned* st; };
__device__ __forceinline__ XcdBarrier xcd_barrier_post(unsigned* bar, volatile LAS unsigned* st) {
  XcdBarrier b; b.bar = bar; b.x = xb_xcc_id(); b.st = st;
  if (threadIdx.x == 0) (void)xb_add(&bar[XB_XCNT(b.x)], 1u);
  return b;
}
__device__ __forceinline__ void xcd_barrier_complete(unsigned* bar, unsigned x, unsigned& nloc, unsigned& nx) {
  const unsigned G = gridDim.x * gridDim.y * gridDim.z;
  unsigned sum, cnt, mine, sp = 0u;
  for (;;) {
    sum = 0u; cnt = 0u; mine = 0u;
#pragma unroll
    for (unsigned j = 0; j < 16; ++j) { const unsigned c = xb_ld(&bar[XB_XCNT(j)]); sum += c; cnt += (c > 0u) ? 1u : 0u; mine = (j == x) ? c : mine; }
    if (sum == G) break;
    __builtin_amdgcn_s_sleep(1);
    if ((++sp & 255u) == 0u) { if (xb_ld(&bar[XB_TMO])) break; if (sp > XB_SPIN_CAP) { atomicAdd(&bar[XB_TMO], 1u); break; } }
  }
  nloc = mine > 0u ? mine : 1u; nx = cnt > 0u ? cnt : 1u;
}
__device__ __forceinline__ void xcd_barrier(const XcdBarrier& b) {
  asm volatile("s_waitcnt vmcnt(0)" ::: "memory");
  __syncthreads();
  if (threadIdx.x == 0) {
    unsigned* bar = b.bar;
    __builtin_amdgcn_s_waitcnt(0);
    unsigned nloc = b.st[0], nx = b.st[1];
    if (nloc == 0u) { xcd_barrier_complete(bar, b.x, nloc, nx); b.st[0] = nloc; b.st[1] = nx; }
    const unsigned old = xb_add(&bar[XB_XSUB(b.x)], 1u);
    const unsigned gen = old / nloc;
    if (old + 1u == (gen + 1u) * nloc) {
      __builtin_amdgcn_fence(__ATOMIC_RELEASE, "agent");
      asm volatile("s_waitcnt vmcnt(0)" ::: "memory");
      const unsigned og = xb_add(&bar[XB_TOP], 1u);
      const unsigned tg = og / nx;
      if (og + 1u == (tg + 1u) * nx) xb_add(&bar[XB_TOPGEN], 1u);
      else XB_SPIN(xb_ld(&bar[XB_TOPGEN]) == tg, bar);
      __builtin_amdgcn_fence(__ATOMIC_ACQUIRE, "agent");
      xb_add(&bar[XB_XGEN(b.x)], 1u);
      asm volatile("s_waitcnt vmcnt(0)" ::: "memory");
    } else {
      XB_SPIN(xb_ld(&bar[XB_XGEN(b.x)]) == gen, bar);
      __builtin_amdgcn_fence(__ATOMIC_ACQUIRE, "agent");
      asm volatile("s_waitcnt vmcnt(0)" ::: "memory");
    }
  }
  __syncthreads();
}

#if REP_SYNC
#define GSYNC() do { xcd_barrier(xb); xcd_barrier(xb); } while (0)
#else
#define GSYNC() xcd_barrier(xb)
#endif
__global__ void __launch_bounds__(256, 2) mega(Params p) {
  extern __shared__ __attribute__((aligned(16))) unsigned char smem[];
  cg::grid_group grid = cg::this_grid();
  const int nblk = gridDim.x, bid = blockIdx.x;
  u16* sm16 = (u16*)smem;
  __shared__ uint4 xb_words;
  if (threadIdx.x == 0) xb_words = make_uint4(0u, 0u, 0u, 0u);
  __syncthreads();
  XcdBarrier xb = xcd_barrier_post(p.bar, (volatile LAS unsigned*)&xb_words);

  for (int rep = 0; rep <= REP_P0; ++rep)
    for (int it = bid; it < P0_ITEMS; it += nblk) p0_item(p, it, smem);
  grid.sync();

#pragma unroll 1
  for (int l = 0; l < 4; ++l) {
    for (int it = bid; it < 384; it += nblk) norm_item(p, l, 0, it);
    GSYNC();
    for (int it = bid; it < 18 * 48; it += nblk) gin_tile(p, l, it, sm16);
    GSYNC();
    for (int rep = 0; rep <= REP_MIX; ++rep)
    for (int it = bid; it < 192 + 768; it += nblk) {
      if (it < 192) f1_tile(p, l, it, sm16);
      else attn_ctx_item(p, l, it - 192);
    }
    GSYNC();
    for (int rep = 0; rep <= REP_MIX; ++rep)
    for (int it = bid; it < 96 + 384; it += nblk) {
      if (it < 96) f2_tile(p, it, sm16);
      else attn_lat_item(p, l, it - 96);
    }
    GSYNC();
    for (int it = bid; it < 8 * 48; it += nblk) res_tile(p, l, it, p.cat, p.w_outT + (size_t)l * 1024 * 1024, 1024, 2, sm16);
    GSYNC();
    for (int it = bid; it < 384; it += nblk) norm_item(p, l, 1, it);
    GSYNC();
    for (int it = bid; it < 32 * 48; it += nblk) m1_tile(p, l, it, sm16);
    GSYNC();
    for (int it = bid; it < 8 * 48; it += nblk) res_tile(p, l, it, p.u, p.w2T + (size_t)l * 1024 * 4096, 4096, 5, sm16);
    GSYNC();
  }
  for (int it = bid; it < 384; it += nblk) norm_item(p, 0, 2, it);
}

extern "C" void kernel_launch(void* const* d_in, const int* in_sizes, int n_in, void* d_out, int out_size, void* d_ws,
                              size_t ws_size, hipStream_t stream) {
  static int grid_blocks = 0;
  if (grid_blocks == 0) {
    int dev = 0, cus = 0, per_cu = 0;
    (void)hipGetDevice(&dev);
    (void)hipDeviceGetAttribute(&cus, hipDeviceAttributeMultiprocessorCount, dev);
    if (hipFuncSetAttribute((const void*)mega, hipFuncAttributeMaxDynamicSharedMemorySize, LDS_BYTES) != hipSuccess) {
      fprintf(stderr, "hipFuncSetAttribute failed\n");
    }
    if (hipOccupancyMaxActiveBlocksPerMultiprocessor(&per_cu, (const void*)mega, 256, LDS_BYTES) != hipSuccess || per_cu < 1) {
      fprintf(stderr, "occupancy query failed (%d)\n", per_cu);
      per_cu = 1;
    }
    if (per_cu > 2) per_cu = 2;
    grid_blocks = cus * per_cu;
    fprintf(stderr, "mega: cus=%d per_cu=%d grid=%d ws=%zu\n", cus, per_cu, grid_blocks, ws_size);
  }
  Params p{};
  const float** pin = (const float**)&p;
  for (int i = 0; i < 27; ++i) pin[i] = (const float*)d_in[i];
  p.out = (float*)d_out;
  unsigned char* ws = (unsigned char*)d_ws;
  size_t off = 0;
  auto take = [&](size_t bytes) { unsigned char* q = ws + off; off += (bytes + 255) & ~(size_t)255; return q; };
  p.xres = (float*)take((size_t)NTOK * 1024 * 4);
  p.mods = (float*)take((size_t)4 * 3 * 6144 * 4);
  p.h = (u16*)take((size_t)NTOK * 1024 * 2);
  p.z = (u16*)take((size_t)NTOK * INW * 2);
  p.vt = (u16*)take((size_t)640 * NTOK * 2);
  p.cat = (u16*)take((size_t)NTOK * 1024 * 2);
  p.u = (u16*)take((size_t)NTOK * 4096 * 2);
  p.uv = (u16*)take((size_t)(16 * 256 * 512 + 2 * 256 * 2048) * 2);
  p.w_inT = (u16*)take((size_t)4 * 2304 * 1024 * 2);
  p.w_outT = (u16*)take((size_t)4 * 1024 * 1024 * 2);
  p.w1T = (u16*)take((size_t)4 * 4096 * 1024 * 2);
  p.w2T = (u16*)take((size_t)4 * 4096 * 1024 * 2);
  p.pqt = (u16*)take((size_t)4 * 512 * 256 * 2);
  p.dft256 = (u16*)take((size_t)256 * 512 * 2);
  p.dft1024 = (u16*)take((size_t)1024 * 2048 * 2);
  p.ck_na = (u16*)take((size_t)2 * 4 * 512 * 256 * 2);
  p.cvt_na = (u16*)take((size_t)2 * 4 * 512 * 256 * 2);
  p.ck_diff = (u16*)take((size_t)2 * 4 * 512 * 256 * 2);
  p.cvt_diff = (u16*)take((size_t)2 * 4 * 512 * 256 * 2);
  p.ck_swa = (u16*)take((size_t)2 * 4 * 512 * 128 * 2);
  p.cvt_swa = (u16*)take((size_t)2 * 4 * 512 * 128 * 2);
  p.ropeD = (float*)take(1024 * 4);
  p.ropeS = (float*)take(2048 * 4);
  p.bar = (unsigned*)take(XCD_BAR_WORDS * 4);
  if (off > ws_size) { fprintf(stderr, "workspace too small: need %zu have %zu\n", off, ws_size); return; }
  if (hipMemsetAsync(p.bar, 0, XCD_BAR_WORDS * 4, stream) != hipSuccess) fprintf(stderr, "memset failed\n");
  void* args[] = {&p};
  hipError_t e = hipLaunchCooperativeKernel((const void*)mega, dim3(grid_blocks), dim3(256), args, LDS_BYTES, stream);
  if (e != hipSuccess) fprintf(stderr, "cooperative launch failed: %s (grid %d)\n", hipGetErrorString(e), grid_blocks);
}
```

```cpp
#include <hip/hip_runtime.h>
#include <hip/hip_cooperative_groups.h>
#include <stdint.h>
#include <stdio.h>
namespace cg = cooperative_groups;

typedef unsigned short u16;
typedef __attribute__((ext_vector_type(8))) short bf16x8;
typedef __attribute__((ext_vector_type(4))) float f32x4;
typedef __attribute__((ext_vector_type(4))) unsigned u32x4;
__device__ __forceinline__ void gload16(u32x4& dst, const void* ptr) {
  asm volatile("global_load_dwordx4 %0, %1, off" : "=v"(dst) : "v"(ptr) : "memory");
}

#define NTOK 6144
#define NPTOK 4096
#define INW 2304
#define LOG2E 1.4426950408889634f
#define LDS_BYTES 73728
#define LSTR 72

#define O_NAK 6291456
#define O_NAV 10485760
#define O_DK 14680064
#define O_DV 18874368
#define O_SK 23068672
#define O_SV 25165824

struct Params {
  const float *x_prompt, *x_sample, *c_na_k, *c_na_v, *c_diff_k, *c_diff_v, *c_swa_k, *c_swa_v, *c, *c_ctx;
  const float *w_ada, *b_ada, *norm1_g, *norm2_g, *w_in, *na_rpb, *lq1, *lk1, *lq2, *lk2, *subln_g, *w_fourier, *swa_sink;
  const float *w_out, *w1, *w2, *final_g;
  float* out;
  float* xres;
  float* mods;
  u16 *h, *z, *vt, *cat, *u, *uv, *w_inT, *w_outT, *w1T, *w2T, *pqt, *dft256, *dft1024;
  u16 *ck_na, *cvt_na, *ck_diff, *cvt_diff, *ck_swa, *cvt_swa;
  float *ropeD, *ropeS;
  unsigned* bar;
};

__device__ __forceinline__ u16 f2bf(float f) {
  unsigned u = __float_as_uint(f);
  u += 0x7fffu + ((u >> 16) & 1u);
  return (u16)(u >> 16);
}
__device__ __forceinline__ int otid() { int t = threadIdx.x; asm volatile("" : "+v"(t)); return t; }
__device__ __forceinline__ float bf2f(u16 h) { return __uint_as_float(((unsigned)h) << 16); }
typedef __attribute__((ext_vector_type(2))) __bf16 hbf16x2;
typedef __attribute__((ext_vector_type(2))) float f32x2;
__device__ __forceinline__ unsigned pack2(float a, float b) {
  f32x2 v = {a, b};
  union { hbf16x2 h; unsigned u; } x;
  x.h = __builtin_convertvector(v, hbf16x2);
  return x.u;
}

__device__ __forceinline__ void transpose_tile(const float* __restrict__ src, int lds_, u16* __restrict__ dst, int ldd,
                                               int k0, int n0, float* sm) {
  const int tid = otid();
  const int c4 = (tid & 15) * 4, r0 = tid >> 4;
#pragma unroll
  for (int i = 0; i < 4; ++i) {
    const int k = r0 + 16 * i;
    const float4 v = *(const float4*)(src + (size_t)(k0 + k) * lds_ + n0 + c4);
    sm[k * 65 + c4 + 0] = v.x; sm[k * 65 + c4 + 1] = v.y; sm[k * 65 + c4 + 2] = v.z; sm[k * 65 + c4 + 3] = v.w;
  }
  __syncthreads();
  const int k8 = (tid & 7) * 8, nn = tid >> 3;
#pragma unroll
  for (int i = 0; i < 2; ++i) {
    const int n = nn + 32 * i;
    uint4 w;
    w.x = pack2(sm[(k8 + 0) * 65 + n], sm[(k8 + 1) * 65 + n]);
    w.y = pack2(sm[(k8 + 2) * 65 + n], sm[(k8 + 3) * 65 + n]);
    w.z = pack2(sm[(k8 + 4) * 65 + n], sm[(k8 + 5) * 65 + n]);
    w.w = pack2(sm[(k8 + 6) * 65 + n], sm[(k8 + 7) * 65 + n]);
    *(uint4*)(dst + (size_t)(n0 + n) * ldd + k0 + k8) = w;
  }
  __syncthreads();
}

__device__ __forceinline__ void adaln_item(const Params& p, int it, float* sm) {
  const int l = it / 96, c0 = (it % 96) * 64;
  float* ssil = sm;
  float* red = sm + 3072;
  const int tid = otid();
  for (int i = tid; i < 3072; i += 256) {
    const int cnd = i >> 10, k = i & 1023;
    const float v = cnd == 0 ? p.c_ctx[k] : p.c[(cnd - 1) * 1024 + k];
    ssil[i] = v / (1.f + expf(-v));
  }
  __syncthreads();
  const int cg4 = (tid & 15) * 4, ks = tid >> 4;
  const float* w = p.w_ada + (size_t)l * 1024 * 6144 + c0 + cg4;
  float a0[4] = {0.f, 0.f, 0.f, 0.f}, a1[4] = {0.f, 0.f, 0.f, 0.f}, a2[4] = {0.f, 0.f, 0.f, 0.f};
#pragma unroll 4
  for (int kk = 0; kk < 64; ++kk) {
    const int k = kk * 16 + ks;
    const float4 v = *(const float4*)(w + (size_t)k * 6144);
    const float s0 = ssil[k], s1 = ssil[1024 + k], s2 = ssil[2048 + k];
    a0[0] += s0 * v.x; a0[1] += s0 * v.y; a0[2] += s0 * v.z; a0[3] += s0 * v.w;
    a1[0] += s1 * v.x; a1[1] += s1 * v.y; a1[2] += s1 * v.z; a1[3] += s1 * v.w;
    a2[0] += s2 * v.x; a2[1] += s2 * v.y; a2[2] += s2 * v.z; a2[3] += s2 * v.w;
  }
#pragma unroll
  for (int j = 0; j < 4; ++j) {
    red[(ks * 3 + 0) * 64 + cg4 + j] = a0[j];
    red[(ks * 3 + 1) * 64 + cg4 + j] = a1[j];
    red[(ks * 3 + 2) * 64 + cg4 + j] = a2[j];
  }
  __syncthreads();
  if (tid < 192) {
    const int cnd = tid >> 6, j = tid & 63;
    float s = p.b_ada[l * 6144 + c0 + j];
    for (int q = 0; q < 16; ++q) s += red[(q * 3 + cnd) * 64 + j];
    p.mods[(l * 3 + cnd) * 6144 + c0 + j] = s;
  }
  __syncthreads();
}

__device__ __forceinline__ void cvt_item(const float* __restrict__ src, u16* __restrict__ dst, int it) {
  const size_t base = (size_t)it * 8192 + otid() * 4;
#pragma unroll
  for (int i = 0; i < 8; ++i) {
    const float4 v = *(const float4*)(src + base + i * 1024);
    uint2 w; w.x = pack2(v.x, v.y); w.y = pack2(v.z, v.w);
    *(uint2*)(dst + base + i * 1024) = w;
  }
}

__device__ __forceinline__ void pq_item(const Params& p, int it, float* sm) {
  const int l = it >> 3, which = (it >> 2) & 1, g = it & 3;
  const int n = otid();
  if (n < 64) sm[n] = which ? sinpif(2.f * (float)n / 64.f) : cospif(2.f * (float)n / 64.f);
  __syncthreads();
  float w[64];
#pragma unroll
  for (int m = 0; m < 64; ++m) w[m] = p.w_fourier[(size_t)l * 65536 + (g * 64 + m) * 256 + n];
  u16* dst = p.pqt + (size_t)l * 512 * 256 + (size_t)(which * 256 + n) * 256 + g * 64;
  for (int c = 0; c < 64; ++c) {
    float s = 0.f;
#pragma unroll
    for (int m = 0; m < 64; ++m) s += sm[(c * m) & 63] * w[m];
    dst[c] = f2bf(s);
  }
  __syncthreads();
}

__device__ __forceinline__ void dft_item(u16* dst, int L, int it) {
  const int twoL = 2 * L;
  for (int e = otid(); e < 8192; e += 256) {
    const int idx = it * 8192 + e;
    const int k = idx / twoL, j = idx % twoL;
    const int jj = j & (L - 1);
    const int ph = (k * jj) & (L - 1);
    const float a = 2.f * (float)ph / (float)L;
    const float v = (j >= L) ? -sinpif(a) : cospif(a);
    dst[idx] = f2bf(v);
  }
}

#define P0_WT 11520
#define P0_ADA 384
#define P0_XC 384
#define P0_CK 320
#define P0_CVT 640
#define P0_PQ 32
#define P0_DFT 272
#define P0_ITEMS (P0_ADA + P0_WT + P0_XC + P0_CK + P0_CVT + P0_PQ + P0_DFT + 1)

__device__ void p0_item(const Params& p, int it, unsigned char* smem) {
  float* sm = (float*)smem;
  if (it < P0_ADA) { adaln_item(p, it, sm); return; }
  it -= P0_ADA;
  if (it < P0_WT) {
    const int l = it / 2880; int r = it % 2880;
    if (r < 576) { transpose_tile(p.w_in + (size_t)l * 1024 * 2304, 2304, p.w_inT + (size_t)l * 2304 * 1024, 1024, (r / 36) * 64, (r % 36) * 64, sm); return; }
    r -= 576;
    if (r < 256) { transpose_tile(p.w_out + (size_t)l * 1024 * 1024, 1024, p.w_outT + (size_t)l * 1024 * 1024, 1024, (r / 16) * 64, (r % 16) * 64, sm); return; }
    r -= 256;
    if (r < 1024) { transpose_tile(p.w1 + (size_t)l * 1024 * 4096, 4096, p.w1T + (size_t)l * 4096 * 1024, 1024, (r / 64) * 64, (r % 64) * 64, sm); return; }
    r -= 1024;
    transpose_tile(p.w2 + (size_t)l * 4096 * 1024, 1024, p.w2T + (size_t)l * 1024 * 4096, 4096, (r / 16) * 64, (r % 16) * 64, sm);
    return;
  }
  it -= P0_WT;
  if (it < P0_XC) {
    const int row0 = it * 16;
    const float* src = row0 < NPTOK ? p.x_prompt + (size_t)row0 * 1024 : p.x_sample + (size_t)(row0 - NPTOK) * 1024;
    float* dst = p.xres + (size_t)row0 * 1024;
#pragma unroll
    for (int i = 0; i < 16; ++i) {
      const int o = (i * 256 + otid()) * 4;
      *(float4*)(dst + o) = *(const float4*)(src + o);
    }
    return;
  }
  it -= P0_XC;
  if (it < P0_CK) {
    if (it < 128) { cvt_item(p.c_na_k, p.ck_na, it); return; }
    it -= 128;
    if (it < 128) { cvt_item(p.c_diff_k, p.ck_diff, it); return; }
    it -= 128;
    cvt_item(p.c_swa_k, p.ck_swa, it);
    return;
  }
  it -= P0_CK;
  if (it < P0_CVT) {
    if (it < 256) { const int bl = it >> 5, r = it & 31; transpose_tile(p.c_na_v + (size_t)bl * 512 * 256, 256, p.cvt_na + (size_t)bl * 256 * 512, 512, (r >> 2) * 64, (r & 3) * 64, sm); return; }
    it -= 256;
    if (it < 256) { const int bl = it >> 5, r = it & 31; transpose_tile(p.c_diff_v + (size_t)bl * 512 * 256, 256, p.cvt_diff + (size_t)bl * 256 * 512, 512, (r >> 2) * 64, (r & 3) * 64, sm); return; }
    it -= 256;
    { const int bl = it >> 4, r = it & 15; transpose_tile(p.c_swa_v + (size_t)bl * 512 * 128, 128, p.cvt_swa + (size_t)bl * 128 * 512, 512, (r >> 1) * 64, (r & 1) * 64, sm); return; }
  }
  it -= P0_CVT;
  if (it < P0_PQ) { pq_item(p, it, sm); return; }
  it -= P0_PQ;
  if (it < 16) { dft_item(p.dft256, 256, it); return; }
  it -= 16;
  if (it < 256) { dft_item(p.dft1024, 1024, it); return; }
  for (int e = otid(); e < 512 + 1024; e += 256) {
    const bool isD = e < 512;
    const int ee = isD ? e : e - 512;
    const int nf = isD ? 8 : 16;
    const int pos = ee / nf, fi = ee % nf;
    const float inv = exp2f(-(float)fi * (13.287712379549449f / (float)nf));
    float tt = (float)pos * inv * 0.15915494309189535f;
    tt -= rintf(tt);
    float sn, cs;
    sincospif(2.f * tt, &sn, &cs);
    if (isD) { p.ropeD[ee] = cs; p.ropeD[512 + ee] = sn; }
    else { p.ropeS[ee] = cs; p.ropeS[1024 + ee] = sn; }
  }
}

__device__ __forceinline__ void norm_item(const Params& p, int l, int which, int it) {
  const int lane = otid() & 63, wave = otid() >> 6;
#pragma unroll 1
  for (int j = 0; j < 4; ++j) {
    const int row = it * 16 + wave * 4 + j;
    const float* xr = p.xres + (size_t)row * 1024;
    float4 v[4];
    float ss = 0.f;
#pragma unroll
    for (int k = 0; k < 4; ++k) {
      v[k] = *(const float4*)(xr + (k * 64 + lane) * 4);
      ss += v[k].x * v[k].x + v[k].y * v[k].y + v[k].z * v[k].z + v[k].w * v[k].w;
    }
#pragma unroll
    for (int o = 32; o >= 1; o >>= 1) ss += __shfl_xor(ss, o);
    const float rs = rsqrtf(ss * (1.f / 1024.f) + 1e-6f);
    if (which < 2) {
      const int cond = row < NPTOK ? 0 : 1 + ((row - NPTOK) >> 10);
      const float* gp = (which == 0 ? p.norm1_g : p.norm2_g) + l * 1024;
      const float* shp = p.mods + (size_t)(l * 3 + cond) * 6144 + (which * 3 + 0) * 1024;
      const float* scp = shp + 1024;
#pragma unroll
      for (int k = 0; k < 4; ++k) {
        const int col = (k * 64 + lane) * 4;
        const float4 gg = *(const float4*)(gp + col);
        const float4 sh = *(const float4*)(shp + col);
        const float4 sc = *(const float4*)(scp + col);
        uint2 w;
        w.x = pack2(v[k].x * rs * gg.x * (1.f + sc.x) + sh.x, v[k].y * rs * gg.y * (1.f + sc.y) + sh.y);
        w.y = pack2(v[k].z * rs * gg.z * (1.f + sc.z) + sh.z, v[k].w * rs * gg.w * (1.f + sc.w) + sh.w);
        *(uint2*)(p.h + (size_t)row * 1024 + col) = w;
      }
    } else {
#pragma unroll
      for (int k = 0; k < 4; ++k) {
        const int col = (k * 64 + lane) * 4;
        const float4 gg = *(const float4*)(p.final_g + col);
        float4 o;
        o.x = v[k].x * rs * gg.x; o.y = v[k].y * rs * gg.y; o.z = v[k].z * rs * gg.z; o.w = v[k].w * rs * gg.w;
        *(float4*)(p.out + (size_t)row * 1024 + col) = o;
      }
    }
  }
}

template <bool ZERO>
__device__ __forceinline__ void gemm_main_t(const u16* __restrict__ X, int ldx, const u16* __restrict__ Y, int ldy, int K,
                                          u16* smem, f32x4 (&acc)[4][4]) {
  const int tid = otid(), lane = tid & 63, wave = tid >> 6, wx = wave & 1, wy = wave >> 1, r = lane & 15, g = lane >> 4;
  u16* sX = smem;
  u16* sY = smem + 2 * 128 * LSTR;
  const int lrow = tid >> 3, lkc = tid & 7;
  const u16* gx = X + (size_t)lrow * ldx + lkc * 8;
  const u16* gy = Y + (size_t)lrow * ldy + lkc * 8;
  u32x4 rx[4], ry[4];
#pragma unroll
  for (int i = 0; i < 4; ++i) {
    rx[i] = *(const u32x4*)(gx + (size_t)(32 * i) * ldx);
    ry[i] = *(const u32x4*)(gy + (size_t)(32 * i) * ldy);
  }
  if (ZERO) {
#pragma unroll
    for (int a = 0; a < 4; ++a)
#pragma unroll
      for (int b = 0; b < 4; ++b) acc[a][b] = (f32x4){0.f, 0.f, 0.f, 0.f};
  }
#pragma unroll
  for (int i = 0; i < 4; ++i) {
    *(u32x4*)(sX + (lrow + 32 * i) * LSTR + lkc * 8) = rx[i];
    *(u32x4*)(sY + (lrow + 32 * i) * LSTR + lkc * 8) = ry[i];
  }
  __syncthreads();
  const int nk = K >> 6;
  const u16* cx0 = sX + (wx * 64 + r) * LSTR + g * 8;
  const u16* cy0 = sY + (wy * 64 + r) * LSTR + g * 8;
#define GEMM_COMPUTE(cur)                                                                            \
  {                                                                                                  \
    const u16* cx = cx0 + (cur) * 128 * LSTR;                                                        \
    const u16* cy = cy0 + (cur) * 128 * LSTR;                                                        \
    _Pragma("unroll") for (int kk = 0; kk < 2; ++kk) {                                               \
      bf16x8 a[4], b[4];                                                                             \
      _Pragma("unroll") for (int i = 0; i < 4; ++i) {                                                \
        a[i] = *(const bf16x8*)(cx + i * 16 * LSTR + kk * 32);                                       \
        b[i] = *(const bf16x8*)(cy + i * 16 * LSTR + kk * 32);                                       \
      }                                                                                              \
      _Pragma("unroll") for (int xi = 0; xi < 4; ++xi)                                               \
        _Pragma("unroll") for (int yi = 0; yi < 4; ++yi)                                             \
          acc[xi][yi] = __builtin_amdgcn_mfma_f32_16x16x32_bf16(a[xi], b[yi], acc[xi][yi], 0, 0, 0); \
    }                                                                                                \
  }
  for (int kt = 0; kt < nk - 1; ++kt) {
    const int cur = kt & 1;
#pragma unroll
    for (int i = 0; i < 4; ++i) {
      gload16(rx[i], gx + (size_t)(32 * i) * ldx + (kt + 1) * 64);
      gload16(ry[i], gy + (size_t)(32 * i) * ldy + (kt + 1) * 64);
    }
    GEMM_COMPUTE(cur);
    asm volatile("s_waitcnt vmcnt(0)" ::: "memory");
    u16* dX = sX + (cur ^ 1) * 128 * LSTR;
    u16* dY = sY + (cur ^ 1) * 128 * LSTR;
#pragma unroll
    for (int i = 0; i < 4; ++i) {
      *(u32x4*)(dX + (lrow + 32 * i) * LSTR + lkc * 8) = rx[i];
      *(u32x4*)(dY + (lrow + 32 * i) * LSTR + lkc * 8) = ry[i];
    }
    __syncthreads();
  }
  GEMM_COMPUTE((nk - 1) & 1);
  __syncthreads();
#undef GEMM_COMPUTE
}

#ifndef REP_GEMM
#define REP_GEMM 0
#endif
#ifndef REP_MIX
#define REP_MIX 0
#endif
#ifndef REP_SYNC
#define REP_SYNC 0
#endif
#ifndef REP_P0
#define REP_P0 0
#endif
__device__ __forceinline__ void gemm_main(const u16* __restrict__ X, int ldx, const u16* __restrict__ Y, int ldy, int K,
                                          u16* smem, f32x4 (&acc)[4][4]) {
  gemm_main_t<true>(X, ldx, Y, ldy, K, smem, acc);
#if REP_GEMM
  gemm_main_t<false>(X, ldx, Y, ldy, K, smem, acc);
#pragma unroll
  for (int a = 0; a < 4; ++a)
#pragma unroll
    for (int b = 0; b < 4; ++b) acc[a][b] *= 0.5f;
#endif
}


__device__ __forceinline__ bool tile_map(int j, int ntx, int& tx, int& ty) {
  const int nblk = gridDim.x, bid = blockIdx.x;
  if ((nblk & 7) == 0) {
    const int v = (bid >> 3) + j * (nblk >> 3);
    if (v >= 6 * ntx) return false;
    tx = v / 6; ty = 6 * (bid & 7) + v % 6;
    return true;
  } else {
    const int it = bid + j * nblk;
    if (it >= 48 * ntx) return false;
    tx = it / 48; ty = it % 48;
    return true;
  }
}

__device__ void gin_tile(const Params& p, int l, int tx, int ty, u16* smem) {
  const int n0 = tx * 128, m0 = ty * 128;
  f32x4 acc[4][4];
  gemm_main(p.w_inT + (size_t)l * 2304 * 1024 + (size_t)n0 * 1024, 1024, p.h + (size_t)m0 * 1024, 1024, 1024, smem, acc);
  const int lane = otid() & 63, wave = otid() >> 6, wx = wave & 1, wy = wave >> 1, r = lane & 15, g = lane >> 4;
  const int nw = n0 + wx * 64;
  const bool isS = m0 >= NPTOK;
  int ropeMode = 0;
  if (isS) {
    if (nw >= 768 && nw < 1280) ropeMode = 1;
    else if (nw >= 1792 && nw < 2176) ropeMode = 2;
  }
  float* okv = nullptr; int okv_w = 0, okv_c = 0;
  if (!isS) {
    if (nw >= 256 && nw < 512) { okv = p.out + O_NAK; okv_w = 256; okv_c = nw - 256; }
    else if (nw >= 512 && nw < 768) { okv = p.out + O_NAV; okv_w = 256; okv_c = nw - 512; }
    else if (nw >= 1024 && nw < 1280) { okv = p.out + O_DK; okv_w = 256; okv_c = nw - 1024; }
    else if (nw >= 1280 && nw < 1536) { okv = p.out + O_DV; okv_w = 256; okv_c = nw - 1280; }
    else if (nw >= 2048 && nw < 2176) { okv = p.out + O_SK; okv_w = 128; okv_c = nw - 2048; }
    else if (nw >= 2176) { okv = p.out + O_SV; okv_w = 128; okv_c = nw - 2176; }
  }
  int vrow = -1;
  if (nw >= 512 && nw < 768) vrow = nw - 512;
  else if (nw >= 1280 && nw < 1536) vrow = 256 + nw - 1280;
  else if (nw >= 2176) vrow = 512 + nw - 2176;
#pragma unroll
  for (int yi = 0; yi < 4; ++yi) {
    const int m = m0 + wy * 64 + yi * 16 + r;
    const int t = (m - NPTOK) & 1023;
    const int prow = t >> 6, pcol = t & 63;
#pragma unroll
    for (int xi = 0; xi < 4; ++xi) {
      f32x4 v = acc[xi][yi];
      if (ropeMode == 1) {
        const int pos = (xi & 1) ? pcol : prow;
        const float4 cs = *(const float4*)(p.ropeD + pos * 8 + 4 * (g & 1));
        const float4 sn = *(const float4*)(p.ropeD + 512 + pos * 8 + 4 * (g & 1));
        const float sg = (g >= 2) ? 1.f : -1.f;
        const float o0 = __shfl_xor(v[0], 32), o1 = __shfl_xor(v[1], 32), o2 = __shfl_xor(v[2], 32), o3 = __shfl_xor(v[3], 32);
        v[0] = v[0] * cs.x + sg * o0 * sn.x; v[1] = v[1] * cs.y + sg * o1 * sn.y;
        v[2] = v[2] * cs.z + sg * o2 * sn.z; v[3] = v[3] * cs.w + sg * o3 * sn.w;
      } else if (ropeMode == 2) {
        const int pos = (xi >> 1) ? pcol : prow;
        const float4 cs = *(const float4*)(p.ropeS + pos * 16 + 4 * g);
        const float4 sn = *(const float4*)(p.ropeS + 1024 + pos * 16 + 4 * g);
        const f32x4 o = acc[xi ^ 1][yi];
        const float sg = (xi & 1) ? 1.f : -1.f;
        v[0] = v[0] * cs.x + sg * o[0] * sn.x; v[1] = v[1] * cs.y + sg * o[1] * sn.y;
        v[2] = v[2] * cs.z + sg * o[2] * sn.z; v[3] = v[3] * cs.w + sg * o[3] * sn.w;
      }
      const int nloc = xi * 16 + 4 * g;
      if (okv) {
        const int b = m >> 8, pos = m & 255;
        float4 o4; o4.x = v[0]; o4.y = v[1]; o4.z = v[2]; o4.w = v[3];
        *(float4*)(okv + ((size_t)((b * 4 + l) * 256 + pos)) * okv_w + okv_c + nloc) = o4;
      }
      if (vrow >= 0) {
#pragma unroll
        for (int i = 0; i < 4; ++i) p.vt[(size_t)(vrow + nloc + i) * NTOK + m] = f2bf(v[i]);
      } else {
        uint2 w; w.x = pack2(v[0], v[1]); w.y = pack2(v[2], v[3]);
        *(uint2*)(p.z + (size_t)m * INW + nw + nloc) = w;
      }
    }
  }
}

__device__ void res_tile(const Params& p, int l, int tx, int ty, const u16* A, const u16* WT, int K, int gi, u16* smem) {
  const int n0 = tx * 128, m0 = ty * 128;
  f32x4 acc[4][4];
  gemm_main(WT + (size_t)n0 * K, K, A + (size_t)m0 * K, K, K, smem, acc);
  const int lane = otid() & 63, wave = otid() >> 6, wx = wave & 1, wy = wave >> 1, r = lane & 15, g = lane >> 4;
  const int cond = m0 < NPTOK ? 0 : 1 + ((m0 - NPTOK) >> 10);
  const float* gate = p.mods + (size_t)(l * 3 + cond) * 6144 + gi * 1024;
#pragma unroll
  for (int xi = 0; xi < 4; ++xi) {
    const int n = n0 + wx * 64 + xi * 16 + 4 * g;
    const float4 gt = *(const float4*)(gate + n);
    float4 xv[4];
#pragma unroll
    for (int yi = 0; yi < 4; ++yi) xv[yi] = *(const float4*)(p.xres + (size_t)(m0 + wy * 64 + yi * 16 + r) * 1024 + n);
#pragma unroll
    for (int yi = 0; yi < 4; ++yi) {
      const int m = m0 + wy * 64 + yi * 16 + r;
      const f32x4 v = acc[xi][yi];
      float4 o = xv[yi];
      o.x += gt.x * v[0]; o.y += gt.y * v[1]; o.z += gt.z * v[2]; o.w += gt.w * v[3];
      *(float4*)(p.xres + (size_t)m * 1024 + n) = o;
    }
  }
}

__device__ void m1_tile(const Params& p, int l, int tx, int ty, u16* smem) {
  const int n0 = tx * 128, m0 = ty * 128;
  f32x4 acc[4][4];
  gemm_main(p.w1T + (size_t)l * 4096 * 1024 + (size_t)n0 * 1024, 1024, p.h + (size_t)m0 * 1024, 1024, 1024, smem, acc);
  const int lane = otid() & 63, wave = otid() >> 6, wx = wave & 1, wy = wave >> 1, r = lane & 15, g = lane >> 4;
#pragma unroll
  for (int xi = 0; xi < 4; ++xi) {
    const int n = n0 + wx * 64 + xi * 16 + 4 * g;
#pragma unroll
    for (int yi = 0; yi < 4; ++yi) {
      const int m = m0 + wy * 64 + yi * 16 + r;
      const f32x4 v = acc[xi][yi];
      float a0 = fmaxf(v[0], 0.f), a1 = fmaxf(v[1], 0.f), a2 = fmaxf(v[2], 0.f), a3 = fmaxf(v[3], 0.f);
      uint2 w; w.x = pack2(a0 * a0, a1 * a1); w.y = pack2(a2 * a2, a3 * a3);
      *(uint2*)(p.u + (size_t)m * 4096 + n) = w;
    }
  }
}

__device__ void f1_tile(const Params& p, int l, int it, u16* smem) {
  const int tx = it % 48, ty = it / 48;
  const int x0 = tx * 128, y0 = ty * 128;
  f32x4 acc[4][4];
  gemm_main(p.z + (size_t)x0 * INW + 1536, INW, p.pqt + (size_t)l * 512 * 256 + (size_t)y0 * 256, 256, 256, smem, acc);
  const int lane = otid() & 63, wave = otid() >> 6, wx = wave & 1, wy = wave >> 1, r = lane & 15, g = lane >> 4;
#pragma unroll
  for (int yi = 0; yi < 4; ++yi) {
    const int y = y0 + wy * 64 + yi * 16 + r;
    const int col = y & 255, which = y >> 8;
#pragma unroll
    for (int xi = 0; xi < 4; ++xi) {
      const int tok = x0 + wx * 64 + xi * 16 + 4 * g;
      size_t addr;
      if (tok < NPTOK) {
        const int b = tok >> 8, pos = tok & 255;
        addr = (size_t)b * (256 * 512) + (size_t)col * 512 + which * 256 + pos;
      } else {
        const int b = (tok - NPTOK) >> 10, pos = (tok - NPTOK) & 1023;
        addr = (size_t)16 * 256 * 512 + (size_t)b * (256 * 2048) + (size_t)col * 2048 + which * 1024 + pos;
      }
      const f32x4 v = acc[xi][yi];
      uint2 w; w.x = pack2(v[0], v[1]); w.y = pack2(v[2], v[3]);
      *(uint2*)(p.uv + addr) = w;
    }
  }
}

__device__ void f2_tile(const Params& p, int it, u16* smem) {
  int L, b, tx, ty, tokbase;
  const u16* uvb; const u16* dft;
  if (it < 32) { L = 1024; b = it >> 4; tx = (it >> 3) & 1; ty = it & 7; uvb = p.uv + (size_t)16 * 256 * 512 + (size_t)b * (256 * 2048); dft = p.dft1024; tokbase = NPTOK + b * 1024; }
  else { it -= 32; L = 256; b = it >> 2; tx = (it >> 1) & 1; ty = it & 1; uvb = p.uv + (size_t)b * (256 * 512); dft = p.dft256; tokbase = b * 256; }
  const int x0 = tx * 128, y0 = ty * 128, K = 2 * L;
  f32x4 acc[4][4];
  gemm_main(uvb + (size_t)x0 * K, K, dft + (size_t)y0 * K, K, K, smem, acc);
  const int lane = otid() & 63, wave = otid() >> 6, wx = wave & 1, wy = wave >> 1, r = lane & 15, g = lane >> 4;
  const float scale = rsqrtf(64.f * (float)L);
#pragma unroll
  for (int yi = 0; yi < 4; ++yi) {
    const int pos = y0 + wy * 64 + yi * 16 + r;
#pragma unroll
    for (int xi = 0; xi < 4; ++xi) {
      const int col = x0 + wx * 64 + xi * 16 + 4 * g;
      const f32x4 v = acc[xi][yi];
      uint2 w; w.x = pack2(v[0] * scale, v[1] * scale); w.y = pack2(v[2] * scale, v[3] * scale);
      *(uint2*)(p.cat + (size_t)(tokbase + pos) * 1024 + 512 + col) = w;
    }
  }
}

struct Seg { const u16* K; const u16* Vt; int ldk, ldv, nblk, pos0, stride; };
template <int QT> struct AState { float m[QT]; float ls[QT]; f32x4 o[QT][4]; };

__device__ __forceinline__ bf16x8 as_bf(u32x4 v) { union { u32x4 u; bf16x8 b; } x; x.u = v; return x.b; }

template <int DC>
__device__ __forceinline__ void issue_blk(const Seg& s0, const Seg& s1, int b, int r, int g, u32x4 (&kf)[2][DC], u32x4 (&vf)[4]) {
  const bool in0 = b < s0.nblk;
  const u16* Kp = in0 ? s0.K : s1.K;
  const u16* Vp = in0 ? s0.Vt : s1.Vt;
  const int ldk = in0 ? s0.ldk : s1.ldk, ldv = in0 ? s0.ldv : s1.ldv;
  const int pos = in0 ? (s0.pos0 + b * s0.stride) : (s1.pos0 + (b - s0.nblk) * s1.stride);
  const int krow = pos + 8 * (r >> 2) + (r & 3);
#pragma unroll
  for (int t = 0; t < 2; ++t) {
    const u16* kp = Kp + (size_t)(krow + 4 * t) * ldk + g * 8;
#pragma unroll
    for (int dc = 0; dc < DC; ++dc) gload16(kf[t][dc], kp + dc * 32);
  }
#pragma unroll
  for (int dv = 0; dv < 4; ++dv) gload16(vf[dv], Vp + (size_t)(dv * 16 + r) * ldv + pos + 8 * g);
}
template <int N>
__device__ __forceinline__ void wait_blk(u32x4 (&kf)[2][1], u32x4 (&vf)[4]) {
  asm volatile("s_waitcnt vmcnt(%6)" : "+v"(kf[0][0]), "+v"(kf[1][0]), "+v"(vf[0]), "+v"(vf[1]), "+v"(vf[2]), "+v"(vf[3]) : "n"(N) : "memory");
}
template <int N>
__device__ __forceinline__ void wait_blk(u32x4 (&kf)[2][2], u32x4 (&vf)[4]) {
  asm volatile("s_waitcnt vmcnt(%8)" : "+v"(kf[0][0]), "+v"(kf[0][1]), "+v"(kf[1][0]), "+v"(kf[1][1]), "+v"(vf[0]), "+v"(vf[1]), "+v"(vf[2]), "+v"(vf[3]) : "n"(N) : "memory");
}

template <int D, int QT, int MODE>
__device__ __forceinline__ void attn_compute(const u32x4 (&kc)[2][D / 32], const u32x4 (&vc)[4], const bf16x8 (&qf)[QT][D / 32], const float sc,
                                             AState<QT>& st, const bool in0, const int pos, const int qpos0, const float* __restrict__ rpb_h,
                                             const int r, const int g) {
  constexpr int DC = D / 32;
#pragma unroll
  for (int q = 0; q < QT; ++q) {
    f32x4 s_[2];
    s_[0] = (f32x4){0.f, 0.f, 0.f, 0.f};
    s_[1] = (f32x4){0.f, 0.f, 0.f, 0.f};
#pragma unroll
    for (int t = 0; t < 2; ++t)
#pragma unroll
      for (int dc = 0; dc < DC; ++dc) s_[t] = __builtin_amdgcn_mfma_f32_16x16x32_bf16(as_bf(kc[t][dc]), qf[q][dc], s_[t], 0, 0, 0);
    float sv[8];
#pragma unroll
    for (int t = 0; t < 2; ++t)
#pragma unroll
      for (int i = 0; i < 4; ++i) {
        float x = s_[t][i] * sc;
        if (MODE == 1) {
          if (!in0) {
            const int qpos = qpos0 + q * 16 + r;
            const int qrow = qpos >> 6, cq = qpos & 63;
            const int kpos = pos + 8 * g + 4 * t + i;
            const int krow = kpos >> 6, ck = kpos & 63;
            const int cs = min(max(cq - 8, 0), 48);
            const bool valid = (ck >= cs) && (ck < cs + 16);
            const int bi = (krow - qrow + 7) * 31 + (ck - cq + 15);
            const float bias = valid ? rpb_h[bi] : 0.f;
            x = valid ? (x + bias * LOG2E) : -1e30f;
          }
        } else if (MODE == 2) {
          if (!in0) {
            const int qpos = qpos0 + q * 16 + r;
            const int kpos = pos + 8 * g + 4 * t + i;
            const int d = qpos - kpos;
            x = (d <= 128 && d >= -128) ? x : -1e30f;
          }
        }
        sv[4 * t + i] = x;
      }
    float mx = fmaxf(fmaxf(fmaxf(sv[0], sv[1]), fmaxf(sv[2], sv[3])), fmaxf(fmaxf(sv[4], sv[5]), fmaxf(sv[6], sv[7])));
    mx = fmaxf(mx, __shfl_xor(mx, 16));
    mx = fmaxf(mx, __shfl_xor(mx, 32));
    const float mnew = fmaxf(st.m[q], mx);
    const float alpha = __builtin_amdgcn_exp2f(st.m[q] - mnew);
    st.m[q] = mnew;
    float ps = 0.f;
#pragma unroll
    for (int j = 0; j < 8; ++j) { sv[j] = __builtin_amdgcn_exp2f(sv[j] - mnew); ps += sv[j]; }
    st.ls[q] = st.ls[q] * alpha + ps;
    union { bf16x8 v; unsigned w[4]; } pf;
    pf.w[0] = pack2(sv[0], sv[1]); pf.w[1] = pack2(sv[2], sv[3]); pf.w[2] = pack2(sv[4], sv[5]); pf.w[3] = pack2(sv[6], sv[7]);
#pragma unroll
    for (int dv = 0; dv < 4; ++dv) {
      f32x4 o = st.o[q][dv];
      o[0] *= alpha; o[1] *= alpha; o[2] *= alpha; o[3] *= alpha;
      st.o[q][dv] = __builtin_amdgcn_mfma_f32_16x16x32_bf16(as_bf(vc[dv]), pf.v, o, 0, 0, 0);
    }
  }
}

template <int D, int QT, int MODE>
__device__ __forceinline__ void attn_run(const Seg& s0, const Seg& s1, const bf16x8 (&qf)[QT][D / 32], const float sc,
                                         AState<QT>& st, const int qpos0, const float* __restrict__ rpb_h) {
  constexpr int DC = D / 32;
  constexpr int NL = 2 * DC + 4;
  const int lane = otid() & 63, r = lane & 15, g = lane >> 4;
  const int nb = s0.nblk + s1.nblk;
  u32x4 ka[2][DC], va[4], kb[2][DC], vb[4];
#pragma unroll
  for (int q = 0; q < QT; ++q)
#pragma unroll
    for (int dc = 0; dc < DC; ++dc) asm volatile("" ::"v"(qf[q][dc]));
  asm volatile("s_waitcnt vmcnt(0)" ::: "memory");
#pragma unroll 1
  for (int b = 0; b < nb; b += 2) {
    issue_blk<DC>(s0, s1, b, r, g, ka, va);
    issue_blk<DC>(s0, s1, b + 1, r, g, kb, vb);
    wait_blk<NL>(ka, va);
    {
      const bool in0 = b < s0.nblk;
      const int pos = in0 ? (s0.pos0 + b * s0.stride) : (s1.pos0 + (b - s0.nblk) * s1.stride);
      attn_compute<D, QT, MODE>(ka, va, qf, sc, st, in0, pos, qpos0, rpb_h, r, g);
    }
    wait_blk<0>(kb, vb);
    {
      const int b1 = b + 1;
      const bool in0 = b1 < s0.nblk;
      const int pos = in0 ? (s0.pos0 + b1 * s0.stride) : (s1.pos0 + (b1 - s0.nblk) * s1.stride);
      attn_compute<D, QT, MODE>(kb, vb, qf, sc, st, in0, pos, qpos0, rpb_h, r, g);
    }
  }
}

template <int QT>
__device__ __forceinline__ void astate_init(AState<QT>& st, float m0, float l0) {
#pragma unroll
  for (int q = 0; q < QT; ++q) {
    st.m[q] = m0; st.ls[q] = l0;
#pragma unroll
    for (int dv = 0; dv < 4; ++dv) st.o[q][dv] = (f32x4){0.f, 0.f, 0.f, 0.f};
  }
}
template <int QT>
__device__ __forceinline__ void astate_finalize(AState<QT>& st) {
#pragma unroll
  for (int q = 0; q < QT; ++q) {
    float l = st.ls[q];
    l += __shfl_xor(l, 16);
    l += __shfl_xor(l, 32);
    const float inv = 1.f / l;
#pragma unroll
    for (int dv = 0; dv < 4; ++dv) { st.o[q][dv][0] *= inv; st.o[q][dv][1] *= inv; st.o[q][dv][2] *= inv; st.o[q][dv][3] *= inv; }
  }
}
template <int DC, int QT>
__device__ __forceinline__ void load_q(const u16* zq  , bf16x8 (&qf)[QT][DC]) {
  const int lane = otid() & 63, r = lane & 15, g = lane >> 4;
#pragma unroll
  for (int q = 0; q < QT; ++q)
#pragma unroll
    for (int dc = 0; dc < DC; ++dc) qf[q][dc] = *(const bf16x8*)(zq + (size_t)(q * 16 + r) * INW + dc * 32 + g * 8);
}
template <int QT>
__device__ __forceinline__ void write_o(const Params& p, const AState<QT>& st, int tok0, int col0) {
  const int lane = otid() & 63, r = lane & 15, g = lane >> 4;
#pragma unroll
  for (int q = 0; q < QT; ++q)
#pragma unroll
    for (int dv = 0; dv < 4; ++dv) {
      const f32x4 v = st.o[q][dv];
      uint2 w; w.x = pack2(v[0], v[1]); w.y = pack2(v[2], v[3]);
      *(uint2*)(p.cat + (size_t)(tok0 + q * 16 + r) * 1024 + col0 + dv * 16 + 4 * g) = w;
    }
}

__device__ __forceinline__ float diff_lambda(const Params& p, int l, float lam_init) {
  const int lane = otid() & 63;
  float a = 0.f, b = 0.f;
  if (lane < 32) { a = p.lq1[l * 32 + lane] * p.lk1[l * 32 + lane]; b = p.lq2[l * 32 + lane] * p.lk2[l * 32 + lane]; }
#pragma unroll
  for (int o = 32; o >= 1; o >>= 1) { a += __shfl_xor(a, o); b += __shfl_xor(b, o); }
  return expf(a) - expf(b) + lam_init;
}

__device__ __forceinline__ void diff_finish_q(const Params& p, int l, float lam, float lam_init, f32x4 (&A)[4], const f32x4 (&B)[4], int tokrow0, int col0) {
  const int lane = otid() & 63, r = lane & 15, g = lane >> 4;
  const float* sg = p.subln_g + l * 64;
  float ss = 0.f;
#pragma unroll
  for (int dv = 0; dv < 4; ++dv)
#pragma unroll
    for (int i = 0; i < 4; ++i) {
      const float v = A[dv][i] - lam * B[dv][i];
      A[dv][i] = v;
      ss += v * v;
    }
  ss += __shfl_xor(ss, 16);
  ss += __shfl_xor(ss, 32);
  const float rs = rsqrtf(ss * (1.f / 64.f) + 1e-6f) * (1.f - lam_init);
#pragma unroll
  for (int dv = 0; dv < 4; ++dv) {
    const float4 gg = *(const float4*)(sg + dv * 16 + 4 * g);
    uint2 w;
    w.x = pack2(A[dv][0] * rs * gg.x, A[dv][1] * rs * gg.y);
    w.y = pack2(A[dv][2] * rs * gg.z, A[dv][3] * rs * gg.w);
    *(uint2*)(p.cat + (size_t)(tokrow0 + r) * 1024 + col0 + dv * 16 + 4 * g) = w;
  }
}

#ifndef AQT
#define AQT 2
#endif
#define QW (16 * AQT)
#define NQG_CTX (256 / QW)
#define NQG_LAT (1024 / QW)
__device__ void attn_diff_item(const Params& p, int l, bool lat, int bi, float* sm) {
  const int wave = otid() >> 6, lane = otid() & 63, r = lane & 15, g = lane >> 4;
  const int ps = wave >> 1, half = wave & 1;
  int b, h, qg, tokb;
  if (lat) { b = bi / (4 * NQG_LAT); h = (bi / NQG_LAT) & 3; qg = bi % NQG_LAT; tokb = NPTOK + b * 1024; }
  else { b = bi / (4 * NQG_CTX); h = (bi / NQG_CTX) & 3; qg = bi % NQG_CTX; tokb = b * 256; }
  const int tok0 = tokb + qg * QW;
  const u16* zb = p.z + (size_t)tokb * INW;
  Seg s0, s1;
  if (lat) {
    const int bl = b * 4 + l;
    s0.K = p.ck_diff + (size_t)bl * 512 * 256 + h * 64 + ps * 32; s0.Vt = p.cvt_diff + (size_t)(bl * 256 + h * 64) * 512;
    s0.ldk = 256; s0.ldv = 512; s0.nblk = half ? 0 : 16; s0.pos0 = 0; s0.stride = 32;
    s1.K = zb + 1024 + h * 64 + ps * 32; s1.Vt = p.vt + (size_t)(256 + h * 64) * NTOK + tokb;
    s1.ldk = INW; s1.ldv = NTOK; s1.nblk = half ? 24 : 8; s1.pos0 = half ? 256 : 0; s1.stride = 32;
  } else {
    s0.K = zb + 1024 + h * 64 + ps * 32; s0.Vt = p.vt + (size_t)(256 + h * 64) * NTOK + tokb;
    s0.ldk = INW; s0.ldv = NTOK; s0.nblk = 4; s0.pos0 = half ? 128 : 0; s0.stride = 32;
    s1 = s0; s1.nblk = 0;
  }
  bf16x8 qf[AQT][1];
  load_q<1, AQT>(p.z + (size_t)tok0 * INW + 768 + h * 64 + ps * 32, qf);
  AState<AQT> st;
  astate_init<AQT>(st, -1e30f, 0.f);
  attn_run<32, AQT, 0>(s0, s1, qf, 0.17677669529663687f * LOG2E, st, 0, nullptr);
  float lt[AQT];
#pragma unroll
  for (int q = 0; q < AQT; ++q) {
    lt[q] = st.ls[q];
    lt[q] += __shfl_xor(lt[q], 16);
    lt[q] += __shfl_xor(lt[q], 32);
  }
  constexpr int WS = 64 * 16 * AQT;
  float* pm = sm + 4 * WS;
  if (wave != 0) {
    float* po = sm + wave * WS + lane * (16 * AQT);
#pragma unroll
    for (int q = 0; q < AQT; ++q) {
#pragma unroll
      for (int dv = 0; dv < 4; ++dv) *(f32x4*)(po + q * 16 + dv * 4) = st.o[q][dv];
      if (g == 0) { pm[wave * QW + q * 16 + r] = st.m[q]; pm[4 * QW + wave * QW + q * 16 + r] = lt[q]; }
    }
  }
  __syncthreads();
  if (wave == 0) {
    const float lam_init = 0.8f - 0.6f * expf(-0.3f * (float)l);
    const float lam = diff_lambda(p, l, lam_init);
#pragma unroll
    for (int q = 0; q < AQT; ++q) {
      f32x4 A[4], B[4];
      {
        const float m1 = pm[QW + q * 16 + r], l1 = pm[4 * QW + QW + q * 16 + r];
        const float M = fmaxf(st.m[q], m1);
        const float a0 = exp2f(st.m[q] - M), a1 = exp2f(m1 - M);
        const float inv = 1.f / (lt[q] * a0 + l1 * a1);
#pragma unroll
        for (int dv = 0; dv < 4; ++dv) {
          const f32x4 o1 = *(const f32x4*)(sm + 1 * WS + lane * (16 * AQT) + q * 16 + dv * 4);
          A[dv] = (st.o[q][dv] * a0 + o1 * a1) * inv;
        }
      }
      {
        const float m2 = pm[2 * QW + q * 16 + r], l2 = pm[4 * QW + 2 * QW + q * 16 + r], m3 = pm[3 * QW + q * 16 + r], l3 = pm[4 * QW + 3 * QW + q * 16 + r];
        const float M = fmaxf(m2, m3);
        const float a2 = exp2f(m2 - M), a3 = exp2f(m3 - M);
        const float inv = 1.f / (l2 * a2 + l3 * a3);
#pragma unroll
        for (int dv = 0; dv < 4; ++dv) {
          const f32x4 o2 = *(const f32x4*)(sm + 2 * WS + lane * (16 * AQT) + q * 16 + dv * 4);
          const f32x4 o3 = *(const f32x4*)(sm + 3 * WS + lane * (16 * AQT) + q * 16 + dv * 4);
          B[dv] = (o2 * a2 + o3 * a3) * inv;
        }
      }
      diff_finish_q(p, l, lam, lam_init, A, B, tok0 + q * 16, 256 + h * 64);
    }
  }
  __syncthreads();
}

__device__ void attn_ctx_item(const Params& p, int l, int bi) {
  const int wave = otid() >> 6, lane = otid() & 63, g = lane >> 4;
  const int w = bi * 4 + wave;
  const int type = w / (64 * NQG_CTX), rem = w % (64 * NQG_CTX);
  const int b = rem / (4 * NQG_CTX), h = (rem / NQG_CTX) & 3, qg = rem % NQG_CTX;
  const int tokb = b * 256, tok0 = tokb + qg * QW;
  const u16* zb = p.z + (size_t)tokb * INW;
  const int kvh = h >> 1;
  const int qcol = type == 0 ? h * 64 : 1792 + h * 64;
  const int kcol = type == 0 ? 256 + h * 64 : 2048 + kvh * 64;
  const int vrow = type == 0 ? h * 64 : 512 + kvh * 64;
  const int ocol = type == 0 ? h * 64 : 768 + h * 64;
  bf16x8 qf[AQT][2];
  load_q<2, AQT>(p.z + (size_t)tok0 * INW + qcol, qf);
  Seg s0; s0.K = zb + kcol; s0.Vt = p.vt + (size_t)vrow * NTOK + tokb; s0.ldk = INW; s0.ldv = NTOK; s0.nblk = 8; s0.pos0 = 0; s0.stride = 32;
  Seg sN = s0; sN.nblk = 0;
  AState<AQT> st;
  const float sk = type == 0 ? -1e30f : p.swa_sink[l * 4 + h] * LOG2E;
  astate_init<AQT>(st, sk, (type == 1 && g == 0) ? 1.f : 0.f);
  attn_run<64, AQT, 0>(s0, sN, qf, 0.125f * LOG2E, st, 0, nullptr);
  astate_finalize<AQT>(st);
  write_o<AQT>(p, st, tok0, ocol);
}

__device__ void attn_lat_item(const Params& p, int l, int bi) {
  const int wave = otid() >> 6, lane = otid() & 63, g = lane >> 4;
  const int w = bi * 4 + wave;
  const int type = w / (8 * NQG_LAT), rem = w % (8 * NQG_LAT);
  const int b = rem / (4 * NQG_LAT), h = (rem / NQG_LAT) & 3, qg = rem % NQG_LAT;
  const int q0 = qg * QW;
  const int tokb = NPTOK + b * 1024, tok0 = tokb + q0;
  const u16* zb = p.z + (size_t)tokb * INW;
  const int bl = b * 4 + l;
  if (type == 0) {
    const int kvh = h >> 1;
    bf16x8 qf[AQT][2];
    load_q<2, AQT>(p.z + (size_t)tok0 * INW + 1792 + h * 64, qf);
    Seg s0; s0.K = p.ck_swa + (size_t)bl * 512 * 128 + kvh * 64; s0.Vt = p.cvt_swa + (size_t)(bl * 128 + kvh * 64) * 512; s0.ldk = 128; s0.ldv = 512; s0.nblk = 16; s0.pos0 = 0; s0.stride = 32;
    const int lo = max(0, q0 - 128) & ~31;
    const int hi = min(1024, ((q0 + QW + 128) + 31) & ~31);
    int lo2 = lo, cnt = (hi - lo) >> 5;
    if (cnt & 1) { if (lo2 > 0) lo2 -= 32; ++cnt; }
    if (((hi - lo2) >> 5) != cnt) {   }
    const int hi2 = lo2 + cnt * 32;
    Seg s1; s1.K = zb + 2048 + kvh * 64; s1.Vt = p.vt + (size_t)(512 + kvh * 64) * NTOK + tokb; s1.ldk = INW; s1.ldv = NTOK; s1.nblk = cnt; s1.pos0 = lo2; s1.stride = 32;
    (void)hi2;
    AState<AQT> st;
    astate_init<AQT>(st, p.swa_sink[l * 4 + h] * LOG2E, g == 0 ? 1.f : 0.f);
    attn_run<64, AQT, 2>(s0, s1, qf, 0.125f * LOG2E, st, q0, nullptr);
    astate_finalize<AQT>(st);
    write_o<AQT>(p, st, tok0, 768 + h * 64);
  } else {
    bf16x8 qf[AQT][2];
    load_q<2, AQT>(p.z + (size_t)tok0 * INW + h * 64, qf);
    Seg s0; s0.K = p.ck_na + (size_t)bl * 512 * 256 + h * 64; s0.Vt = p.cvt_na + (size_t)(bl * 256 + h * 64) * 512; s0.ldk = 256; s0.ldv = 512; s0.nblk = 16; s0.pos0 = 0; s0.stride = 32;
    const int qrow = q0 >> 6;
    const int rstart = min(max(qrow - 4, 0), 8);
    Seg s1; s1.K = zb + 256 + h * 64; s1.Vt = p.vt + (size_t)(h * 64) * NTOK + tokb; s1.ldk = INW; s1.ldv = NTOK; s1.nblk = 16; s1.pos0 = rstart * 64; s1.stride = 32;
    AState<AQT> st;
    astate_init<AQT>(st, -1e30f, 0.f);
    attn_run<64, AQT, 1>(s0, s1, qf, 0.125f * LOG2E, st, q0, p.na_rpb + (size_t)(l * 4 + h) * 15 * 31);
    astate_finalize<AQT>(st);
    write_o<AQT>(p, st, tok0, h * 64);
  }
}

#define XB_TMO      128
#define XB_XCNT(j)  (256  + 64 * (j))
#define XB_XSUB(j)  (1280 + 64 * (j))
#define XB_XGEN(j)  (2304 + 64 * (j))
#define XB_TOP      3328
#define XB_TOPGEN   3392
#define XCD_BAR_WORDS 3456
#define XB_SPIN_CAP (1u << 22)
#define LAS __attribute__((address_space(3)))
__device__ __forceinline__ unsigned xb_ld(unsigned* p)              { return __hip_atomic_load(p, __ATOMIC_RELAXED, __HIP_MEMORY_SCOPE_AGENT); }
__device__ __forceinline__ unsigned xb_add(unsigned* p, unsigned v) { return __hip_atomic_fetch_add(p, v, __ATOMIC_RELAXED, __HIP_MEMORY_SCOPE_AGENT); }
__device__ __forceinline__ unsigned xb_xcc_id() { return (unsigned)__builtin_amdgcn_s_getreg((3 << 11) | 20) & 0xFu; }
#define XB_SPIN(cond, bar) do { unsigned _sp = 0; while (cond) { __builtin_amdgcn_s_sleep(1); \
    if ((++_sp & 255u) == 0u) { if (xb_ld(&(bar)[XB_TMO])) break; if (_sp > XB_SPIN_CAP) { atomicAdd(&(bar)[XB_TMO], 1u); break; } } } } while (0)
struct XcdBarrier { unsigned* bar; unsigned x; volatile LAS unsigned* st; };
__device__ __forceinline__ XcdBarrier xcd_barrier_post(unsigned* bar, volatile LAS unsigned* st) {
  XcdBarrier b; b.bar = bar; b.x = xb_xcc_id(); b.st = st;
  if (threadIdx.x == 0) (void)xb_add(&bar[XB_XCNT(b.x)], 1u);
  return b;
}
__device__ __forceinline__ void xcd_barrier_complete(unsigned* bar, unsigned x, unsigned& nloc, unsigned& nx) {
  const unsigned G = gridDim.x * gridDim.y * gridDim.z;
  unsigned sum, cnt, mine, sp = 0u;
  for (;;) {
    sum = 0u; cnt = 0u; mine = 0u;
#pragma unroll
    for (unsigned j = 0; j < 16; ++j) { const unsigned c = xb_ld(&bar[XB_XCNT(j)]); sum += c; cnt += (c > 0u) ? 1u : 0u; mine = (j == x) ? c : mine; }
    if (sum == G) break;
    __builtin_amdgcn_s_sleep(1);
    if ((++sp & 255u) == 0u) { if (xb_ld(&bar[XB_TMO])) break; if (sp > XB_SPIN_CAP) { atomicAdd(&bar[XB_TMO], 1u); break; } }
  }
  nloc = mine > 0u ? mine : 1u; nx = cnt > 0u ? cnt : 1u;
}
__device__ __forceinline__ void xcd_barrier(const XcdBarrier& b) {
  asm volatile("s_waitcnt vmcnt(0)" ::: "memory");
  __syncthreads();
  if (threadIdx.x == 0) {
    unsigned* bar = b.bar;
    __builtin_amdgcn_s_waitcnt(0);
    unsigned nloc = b.st[0], nx = b.st[1];
    if (nloc == 0u) { xcd_barrier_complete(bar, b.x, nloc, nx); b.st[0] = nloc; b.st[1] = nx; }
    const unsigned old = xb_add(&bar[XB_XSUB(b.x)], 1u);
    const unsigned gen = old / nloc;
    if (old + 1u == (gen + 1u) * nloc) {
      __builtin_amdgcn_fence(__ATOMIC_RELEASE, "agent");
      asm volatile("s_waitcnt vmcnt(0)" ::: "memory");
      const unsigned og = xb_add(&bar[XB_TOP], 1u);
      const unsigned tg = og / nx;
      if (og + 1u == (tg + 1u) * nx) xb_add(&bar[XB_TOPGEN], 1u);
      else XB_SPIN(xb_ld(&bar[XB_TOPGEN]) == tg, bar);
      __builtin_amdgcn_fence(__ATOMIC_ACQUIRE, "agent");
      xb_add(&bar[XB_XGEN(b.x)], 1u);
      asm volatile("s_waitcnt vmcnt(0)" ::: "memory");
    } else {
      XB_SPIN(xb_ld(&bar[XB_XGEN(b.x)]) == gen, bar);
      __builtin_amdgcn_fence(__ATOMIC_ACQUIRE, "agent");
      asm volatile("s_waitcnt vmcnt(0)" ::: "memory");
    }
  }
  __syncthreads();
}

#if REP_SYNC
#define GSYNC() do { xcd_barrier(xb); xcd_barrier(xb); } while (0)
#else
#define GSYNC() xcd_barrier(xb)
#endif
__global__ void __launch_bounds__(256, 2) mega(Params p) {
  extern __shared__ __attribute__((aligned(16))) unsigned char smem[];
  cg::grid_group grid = cg::this_grid();
  const int nblk = gridDim.x, bid = blockIdx.x;
  u16* sm16 = (u16*)smem;
  __shared__ uint4 xb_words;
  if (threadIdx.x == 0) xb_words = make_uint4(0u, 0u, 0u, 0u);
  __syncthreads();
  XcdBarrier xb = xcd_barrier_post(p.bar, (volatile LAS unsigned*)&xb_words);

  for (int rep = 0; rep <= REP_P0; ++rep)
    for (int it = bid; it < P0_ITEMS; it += nblk) p0_item(p, it, smem);
  grid.sync();

#pragma unroll 1
  for (int l = 0; l < 4; ++l) {
    for (int it = bid; it < 384; it += nblk) norm_item(p, l, 0, it);
    GSYNC();
    { int tx, ty; for (int j = 0; tile_map(j, 18, tx, ty); ++j) gin_tile(p, l, tx, ty, sm16); }
    GSYNC();
    {
      constexpr int ND = 64 * NQG_CTX, NC = 2 * 64 * NQG_CTX / 4;
      for (int rep = 0; rep <= (REP_MIX & 1); ++rep)
      for (int it = bid; it < ND + NC + 192; it += nblk) {
        if (it < ND) attn_diff_item(p, l, false, it, (float*)smem);
        else if (it < ND + NC) attn_ctx_item(p, l, it - ND);
        else f1_tile(p, l, it - ND - NC, sm16);
      }
    }
    GSYNC();
    {
      constexpr int ND = 8 * NQG_LAT, NC = 2 * 8 * NQG_LAT / 4;
      for (int rep = 0; rep <= (REP_MIX >> 1); ++rep)
      for (int it = bid; it < 32 + ND + NC + 64; it += nblk) {
        if (it < 32) f2_tile(p, it, sm16);
        else if (it < 32 + ND) attn_diff_item(p, l, true, it - 32, (float*)smem);
        else if (it < 32 + ND + NC) attn_lat_item(p, l, it - 32 - ND);
        else f2_tile(p, it - (32 + ND + NC) + 32, sm16);
      }
    }
    GSYNC();
    { int tx, ty; for (int j = 0; tile_map(j, 8, tx, ty); ++j) res_tile(p, l, tx, ty, p.cat, p.w_outT + (size_t)l * 1024 * 1024, 1024, 2, sm16); }
    GSYNC();
    for (int it = bid; it < 384; it += nblk) norm_item(p, l, 1, it);
    GSYNC();
    { int tx, ty; for (int j = 0; tile_map(j, 32, tx, ty); ++j) m1_tile(p, l, tx, ty, sm16); }
    GSYNC();
    { int tx, ty; for (int j = 0; tile_map(j, 8, tx, ty); ++j) res_tile(p, l, tx, ty, p.u, p.w2T + (size_t)l * 1024 * 4096, 4096, 5, sm16); }
    GSYNC();
  }
  for (int it = bid; it < 384; it += nblk) norm_item(p, 0, 2, it);
}

extern "C" void kernel_launch(void* const* d_in, const int* in_sizes, int n_in, void* d_out, int out_size, void* d_ws,
                              size_t ws_size, hipStream_t stream) {
  static int grid_blocks = 0;
  if (grid_blocks == 0) {
    int dev = 0, cus = 0, per_cu = 0;
    (void)hipGetDevice(&dev);
    (void)hipDeviceGetAttribute(&cus, hipDeviceAttributeMultiprocessorCount, dev);
    if (hipFuncSetAttribute((const void*)mega, hipFuncAttributeMaxDynamicSharedMemorySize, LDS_BYTES) != hipSuccess) {
      fprintf(stderr, "hipFuncSetAttribute failed\n");
    }
    if (hipOccupancyMaxActiveBlocksPerMultiprocessor(&per_cu, (const void*)mega, 256, LDS_BYTES) != hipSuccess || per_cu < 1) {
      fprintf(stderr, "occupancy query failed (%d)\n", per_cu);
      per_cu = 1;
    }
    if (per_cu > 2) per_cu = 2;
    grid_blocks = cus * per_cu;
    fprintf(stderr, "mega: cus=%d per_cu=%d grid=%d ws=%zu\n", cus, per_cu, grid_blocks, ws_size);
  }
  Params p{};
  const float** pin = (const float**)&p;
  for (int i = 0; i < 27; ++i) pin[i] = (const float*)d_in[i];
  p.out = (float*)d_out;
  unsigned char* ws = (unsigned char*)d_ws;
  size_t off = 0;
  auto take = [&](size_t bytes) { unsigned char* q = ws + off; off += (bytes + 255) & ~(size_t)255; return q; };
  p.xres = (float*)take((size_t)NTOK * 1024 * 4);
  p.mods = (float*)take((size_t)4 * 3 * 6144 * 4);
  p.h = (u16*)take((size_t)NTOK * 1024 * 2);
  p.z = (u16*)take((size_t)NTOK * INW * 2);
  p.vt = (u16*)take((size_t)640 * NTOK * 2);
  p.cat = (u16*)take((size_t)NTOK * 1024 * 2);
  p.u = (u16*)take((size_t)NTOK * 4096 * 2);
  p.uv = (u16*)take((size_t)(16 * 256 * 512 + 2 * 256 * 2048) * 2);
  p.w_inT = (u16*)take((size_t)4 * 2304 * 1024 * 2);
  p.w_outT = (u16*)take((size_t)4 * 1024 * 1024 * 2);
  p.w1T = (u16*)take((size_t)4 * 4096 * 1024 * 2);
  p.w2T = (u16*)take((size_t)4 * 4096 * 1024 * 2);
  p.pqt = (u16*)take((size_t)4 * 512 * 256 * 2);
  p.dft256 = (u16*)take((size_t)256 * 512 * 2);
  p.dft1024 = (u16*)take((size_t)1024 * 2048 * 2);
  p.ck_na = (u16*)take((size_t)2 * 4 * 512 * 256 * 2);
  p.cvt_na = (u16*)take((size_t)2 * 4 * 512 * 256 * 2);
  p.ck_diff = (u16*)take((size_t)2 * 4 * 512 * 256 * 2);
  p.cvt_diff = (u16*)take((size_t)2 * 4 * 512 * 256 * 2);
  p.ck_swa = (u16*)take((size_t)2 * 4 * 512 * 128 * 2);
  p.cvt_swa = (u16*)take((size_t)2 * 4 * 512 * 128 * 2);
  p.ropeD = (float*)take(1024 * 4);
  p.ropeS = (float*)take(2048 * 4);
  p.bar = (unsigned*)take(XCD_BAR_WORDS * 4);
  if (off > ws_size) { fprintf(stderr, "workspace too small: need %zu have %zu\n", off, ws_size); return; }
  if (hipMemsetAsync(p.bar, 0, XCD_BAR_WORDS * 4, stream) != hipSuccess) fprintf(stderr, "memset failed\n");
  void* args[] = {&p};
  hipError_t e = hipLaunchCooperativeKernel((const void*)mega, dim3(grid_blocks), dim3(256), args, LDS_BYTES, stream);
  if (e != hipSuccess) fprintf(stderr, "cooperative launch failed: %s (grid %d)\n", hipGetErrorString(e), grid_blocks);
}
```

```cpp
#include <hip/hip_runtime.h>
#include <hip/hip_cooperative_groups.h>
#include <stdint.h>
#include <stdio.h>
namespace cg = cooperative_groups;

typedef unsigned short u16;
typedef __attribute__((ext_vector_type(8))) short bf16x8;
typedef __attribute__((ext_vector_type(4))) float f32x4;
typedef __attribute__((ext_vector_type(4))) unsigned u32x4;
__device__ __forceinline__ void gload16(u32x4& dst, const void* ptr) {
  asm volatile("global_load_dwordx4 %0, %1, off" : "=v"(dst) : "v"(ptr) : "memory");
}

#define NTOK 6144
#define NPTOK 4096
#define INW 2304
#define LOG2E 1.4426950408889634f
#define LDS_BYTES 73728
#define LSTR 72

#define O_NAK 6291456
#define O_NAV 10485760
#define O_DK 14680064
#define O_DV 18874368
#define O_SK 23068672
#define O_SV 25165824

struct Params {
  const float *x_prompt, *x_sample, *c_na_k, *c_na_v, *c_diff_k, *c_diff_v, *c_swa_k, *c_swa_v, *c, *c_ctx;
  const float *w_ada, *b_ada, *norm1_g, *norm2_g, *w_in, *na_rpb, *lq1, *lk1, *lq2, *lk2, *subln_g, *w_fourier, *swa_sink;
  const float *w_out, *w1, *w2, *final_g;
  float* out;
  float* xres;
  float* mods;
  u16 *h, *z, *vt, *cat, *u, *uv, *w_inT, *w_outT, *w1T, *w2T, *pqt, *dft256, *dft1024;
  u16 *ck_na, *cvt_na, *ck_diff, *cvt_diff, *ck_swa, *cvt_swa;
  float *ropeD, *ropeS;
  unsigned* bar;
  int use_cg_sync;
  int pad_;
};

__device__ __forceinline__ u16 f2bf(float f) {
  unsigned u = __float_as_uint(f);
  u += 0x7fffu + ((u >> 16) & 1u);
  return (u16)(u >> 16);
}
__device__ __forceinline__ int otid() { int t = threadIdx.x; asm volatile("" : "+v"(t)); return t; }
__device__ __forceinline__ float bf2f(u16 h) { return __uint_as_float(((unsigned)h) << 16); }
typedef __attribute__((ext_vector_type(2))) __bf16 hbf16x2;
typedef __attribute__((ext_vector_type(2))) float f32x2;
__device__ __forceinline__ unsigned pack2(float a, float b) {
  f32x2 v = {a, b};
  union { hbf16x2 h; unsigned u; } x;
  x.h = __builtin_convertvector(v, hbf16x2);
  return x.u;
}

__device__ __forceinline__ void transpose_tile(const float* __restrict__ src, int lds_, u16* __restrict__ dst, int ldd,
                                               int k0, int n0, float* sm) {
  const int tid = otid();
  const int c4 = (tid & 15) * 4, r0 = tid >> 4;
#pragma unroll
  for (int i = 0; i < 4; ++i) {
    const int k = r0 + 16 * i;
    const float4 v = *(const float4*)(src + (size_t)(k0 + k) * lds_ + n0 + c4);
    sm[k * 65 + c4 + 0] = v.x; sm[k * 65 + c4 + 1] = v.y; sm[k * 65 + c4 + 2] = v.z; sm[k * 65 + c4 + 3] = v.w;
  }
  __syncthreads();
  const int k8 = (tid & 7) * 8, nn = tid >> 3;
#pragma unroll
  for (int i = 0; i < 2; ++i) {
    const int n = nn + 32 * i;
    uint4 w;
    w.x = pack2(sm[(k8 + 0) * 65 + n], sm[(k8 + 1) * 65 + n]);
    w.y = pack2(sm[(k8 + 2) * 65 + n], sm[(k8 + 3) * 65 + n]);
    w.z = pack2(sm[(k8 + 4) * 65 + n], sm[(k8 + 5) * 65 + n]);
    w.w = pack2(sm[(k8 + 6) * 65 + n], sm[(k8 + 7) * 65 + n]);
    *(uint4*)(dst + (size_t)(n0 + n) * ldd + k0 + k8) = w;
  }
  __syncthreads();
}

__device__ __forceinline__ void adaln_item(const Params& p, int it, float* sm) {
  const int l = it / 96, c0 = (it % 96) * 64;
  float* ssil = sm;
  float* red = sm + 3072;
  const int tid = otid();
  for (int i = tid; i < 3072; i += 256) {
    const int cnd = i >> 10, k = i & 1023;
    const float v = cnd == 0 ? p.c_ctx[k] : p.c[(cnd - 1) * 1024 + k];
    ssil[i] = v / (1.f + expf(-v));
  }
  __syncthreads();
  const int cg4 = (tid & 15) * 4, ks = tid >> 4;
  const float* w = p.w_ada + (size_t)l * 1024 * 6144 + c0 + cg4;
  float a0[4] = {0.f, 0.f, 0.f, 0.f}, a1[4] = {0.f, 0.f, 0.f, 0.f}, a2[4] = {0.f, 0.f, 0.f, 0.f};
#pragma unroll 4
  for (int kk = 0; kk < 64; ++kk) {
    const int k = kk * 16 + ks;
    const float4 v = *(const float4*)(w + (size_t)k * 6144);
    const float s0 = ssil[k], s1 = ssil[1024 + k], s2 = ssil[2048 + k];
    a0[0] += s0 * v.x; a0[1] += s0 * v.y; a0[2] += s0 * v.z; a0[3] += s0 * v.w;
    a1[0] += s1 * v.x; a1[1] += s1 * v.y; a1[2] += s1 * v.z; a1[3] += s1 * v.w;
    a2[0] += s2 * v.x; a2[1] += s2 * v.y; a2[2] += s2 * v.z; a2[3] += s2 * v.w;
  }
#pragma unroll
  for (int j = 0; j < 4; ++j) {
    red[(ks * 3 + 0) * 64 + cg4 + j] = a0[j];
    red[(ks * 3 + 1) * 64 + cg4 + j] = a1[j];
    red[(ks * 3 + 2) * 64 + cg4 + j] = a2[j];
  }
  __syncthreads();
  if (tid < 192) {
    const int cnd = tid >> 6, j = tid & 63;
    float s = p.b_ada[l * 6144 + c0 + j];
    for (int q = 0; q < 16; ++q) s += red[(q * 3 + cnd) * 64 + j];
    p.mods[(l * 3 + cnd) * 6144 + c0 + j] = s;
  }
  __syncthreads();
}

__device__ __forceinline__ void cvt_item(const float* __restrict__ src, u16* __restrict__ dst, int it) {
  const size_t base = (size_t)it * 8192 + otid() * 4;
#pragma unroll
  for (int i = 0; i < 8; ++i) {
    const float4 v = *(const float4*)(src + base + i * 1024);
    uint2 w; w.x = pack2(v.x, v.y); w.y = pack2(v.z, v.w);
    *(uint2*)(dst + base + i * 1024) = w;
  }
}

__device__ __forceinline__ void pq_item(const Params& p, int it, float* sm) {
  const int l = it >> 3, which = (it >> 2) & 1, g = it & 3;
  const int n = otid();
  if (n < 64) sm[n] = which ? sinpif(2.f * (float)n / 64.f) : cospif(2.f * (float)n / 64.f);
  __syncthreads();
  float w[64];
#pragma unroll
  for (int m = 0; m < 64; ++m) w[m] = p.w_fourier[(size_t)l * 65536 + (g * 64 + m) * 256 + n];
  u16* dst = p.pqt + (size_t)l * 512 * 256 + (size_t)(which * 256 + n) * 256 + g * 64;
  for (int c = 0; c < 64; ++c) {
    float s = 0.f;
#pragma unroll
    for (int m = 0; m < 64; ++m) s += sm[(c * m) & 63] * w[m];
    dst[c] = f2bf(s);
  }
  __syncthreads();
}

__device__ __forceinline__ void dft_item(u16* dst, int L, int it) {
  const int twoL = 2 * L;
  for (int e = otid(); e < 8192; e += 256) {
    const int idx = it * 8192 + e;
    const int k = idx / twoL, j = idx % twoL;
    const int jj = j & (L - 1);
    const int ph = (k * jj) & (L - 1);
    const float a = 2.f * (float)ph / (float)L;
    const float v = (j >= L) ? -sinpif(a) : cospif(a);
    dst[idx] = f2bf(v);
  }
}

#define P0_WT 11520
#define P0_ADA 384
#define P0_XC 384
#define P0_CK 320
#define P0_CVT 640
#define P0_PQ 32
#define P0_DFT 272
#define P0_ITEMS (P0_ADA + P0_WT + P0_XC + P0_CK + P0_CVT + P0_PQ + P0_DFT + 1)

__device__ void p0_item(const Params& p, int it, unsigned char* smem) {
  float* sm = (float*)smem;
  if (it < P0_ADA) { adaln_item(p, it, sm); return; }
  it -= P0_ADA;
  if (it < P0_WT) {
    const int l = it / 2880; int r = it % 2880;
    if (r < 576) { transpose_tile(p.w_in + (size_t)l * 1024 * 2304, 2304, p.w_inT + (size_t)l * 2304 * 1024, 1024, (r / 36) * 64, (r % 36) * 64, sm); return; }
    r -= 576;
    if (r < 256) { transpose_tile(p.w_out + (size_t)l * 1024 * 1024, 1024, p.w_outT + (size_t)l * 1024 * 1024, 1024, (r / 16) * 64, (r % 16) * 64, sm); return; }
    r -= 256;
    if (r < 1024) { transpose_tile(p.w1 + (size_t)l * 1024 * 4096, 4096, p.w1T + (size_t)l * 4096 * 1024, 1024, (r / 64) * 64, (r % 64) * 64, sm); return; }
    r -= 1024;
    transpose_tile(p.w2 + (size_t)l * 4096 * 1024, 1024, p.w2T + (size_t)l * 1024 * 4096, 4096, (r / 16) * 64, (r % 16) * 64, sm);
    return;
  }
  it -= P0_WT;
  if (it < P0_XC) {
    const int row0 = it * 16;
    const float* src = row0 < NPTOK ? p.x_prompt + (size_t)row0 * 1024 : p.x_sample + (size_t)(row0 - NPTOK) * 1024;
    float* dst = p.xres + (size_t)row0 * 1024;
#pragma unroll
    for (int i = 0; i < 16; ++i) {
      const int o = (i * 256 + otid()) * 4;
      *(float4*)(dst + o) = *(const float4*)(src + o);
    }
    return;
  }
  it -= P0_XC;
  if (it < P0_CK) {
    if (it < 128) { cvt_item(p.c_na_k, p.ck_na, it); return; }
    it -= 128;
    if (it < 128) { cvt_item(p.c_diff_k, p.ck_diff, it); return; }
    it -= 128;
    cvt_item(p.c_swa_k, p.ck_swa, it);
    return;
  }
  it -= P0_CK;
  if (it < P0_CVT) {
    if (it < 256) { const int bl = it >> 5, r = it & 31; transpose_tile(p.c_na_v + (size_t)bl * 512 * 256, 256, p.cvt_na + (size_t)bl * 256 * 512, 512, (r >> 2) * 64, (r & 3) * 64, sm); return; }
    it -= 256;
    if (it < 256) { const int bl = it >> 5, r = it & 31; transpose_tile(p.c_diff_v + (size_t)bl * 512 * 256, 256, p.cvt_diff + (size_t)bl * 256 * 512, 512, (r >> 2) * 64, (r & 3) * 64, sm); return; }
    it -= 256;
    { const int bl = it >> 4, r = it & 15; transpose_tile(p.c_swa_v + (size_t)bl * 512 * 128, 128, p.cvt_swa + (size_t)bl * 128 * 512, 512, (r >> 1) * 64, (r & 1) * 64, sm); return; }
  }
  it -= P0_CVT;
  if (it < P0_PQ) { pq_item(p, it, sm); return; }
  it -= P0_PQ;
  if (it < 16) { dft_item(p.dft256, 256, it); return; }
  it -= 16;
  if (it < 256) { dft_item(p.dft1024, 1024, it); return; }
  for (int e = otid(); e < 512 + 1024; e += 256) {
    const bool isD = e < 512;
    const int ee = isD ? e : e - 512;
    const int nf = isD ? 8 : 16;
    const int pos = ee / nf, fi = ee % nf;
    const float inv = exp2f(-(float)fi * (13.287712379549449f / (float)nf));
    float tt = (float)pos * inv * 0.15915494309189535f;
    tt -= rintf(tt);
    float sn, cs;
    sincospif(2.f * tt, &sn, &cs);
    if (isD) { p.ropeD[ee] = cs; p.ropeD[512 + ee] = sn; }
    else { p.ropeS[ee] = cs; p.ropeS[1024 + ee] = sn; }
  }
}

__device__ __forceinline__ void norm_item(const Params& p, int l, int which, int it) {
  const int lane = otid() & 63, wave = otid() >> 6;
  const int row0 = it * 16 + wave * 4;
  float4 v[4][4];
#pragma unroll
  for (int j = 0; j < 4; ++j)
#pragma unroll
    for (int k = 0; k < 4; ++k) v[j][k] = *(const float4*)(p.xres + (size_t)(row0 + j) * 1024 + (k * 64 + lane) * 4);
  float rs[4];
#pragma unroll
  for (int j = 0; j < 4; ++j) {
    float ss = 0.f;
#pragma unroll
    for (int k = 0; k < 4; ++k) ss += v[j][k].x * v[j][k].x + v[j][k].y * v[j][k].y + v[j][k].z * v[j][k].z + v[j][k].w * v[j][k].w;
#pragma unroll
    for (int o = 32; o >= 1; o >>= 1) ss += __shfl_xor(ss, o);
    rs[j] = rsqrtf(ss * (1.f / 1024.f) + 1e-6f);
  }
  if (which < 2) {
    const int cond = row0 < NPTOK ? 0 : 1 + ((row0 - NPTOK) >> 10);
    const float* gp = (which == 0 ? p.norm1_g : p.norm2_g) + l * 1024;
    const float* shp = p.mods + (size_t)(l * 3 + cond) * 6144 + (which * 3 + 0) * 1024;
    const float* scp = shp + 1024;
#pragma unroll
    for (int k = 0; k < 4; ++k) {
      const int col = (k * 64 + lane) * 4;
      const float4 gg = *(const float4*)(gp + col);
      const float4 sh = *(const float4*)(shp + col);
      const float4 sc = *(const float4*)(scp + col);
      const float mx = gg.x * (1.f + sc.x), my = gg.y * (1.f + sc.y), mz = gg.z * (1.f + sc.z), mw = gg.w * (1.f + sc.w);
#pragma unroll
      for (int j = 0; j < 4; ++j) {
        uint2 w;
        w.x = pack2(v[j][k].x * rs[j] * mx + sh.x, v[j][k].y * rs[j] * my + sh.y);
        w.y = pack2(v[j][k].z * rs[j] * mz + sh.z, v[j][k].w * rs[j] * mw + sh.w);
        *(uint2*)(p.h + (size_t)(row0 + j) * 1024 + col) = w;
      }
    }
  } else {
#pragma unroll
    for (int k = 0; k < 4; ++k) {
      const int col = (k * 64 + lane) * 4;
      const float4 gg = *(const float4*)(p.final_g + col);
#pragma unroll
      for (int j = 0; j < 4; ++j) {
        float4 o;
        o.x = v[j][k].x * rs[j] * gg.x; o.y = v[j][k].y * rs[j] * gg.y; o.z = v[j][k].z * rs[j] * gg.z; o.w = v[j][k].w * rs[j] * gg.w;
        *(float4*)(p.out + (size_t)(row0 + j) * 1024 + col) = o;
      }
    }
  }
}

template <bool ZERO, int YT>
__device__ __forceinline__ void gemm_main_t(const u16* __restrict__ X, int ldx, const u16* __restrict__ Y, int ldy, int K,
                                          u16* smem, f32x4 (&acc)[4][YT]) {
  const int tid = otid(), lane = tid & 63, wave = tid >> 6, wx = wave & 1, wy = wave >> 1, r = lane & 15, g = lane >> 4;
  u16* sX = smem;
  u16* sY = smem + 2 * 128 * LSTR;
  const int lrow = tid >> 3, lkc = tid & 7;
  const u16* gx = X + (size_t)lrow * ldx + lkc * 8;
  const u16* gy = Y + (size_t)lrow * ldy + lkc * 8;
  u32x4 rx[4], ry[YT];
#pragma unroll
  for (int i = 0; i < 4; ++i) rx[i] = *(const u32x4*)(gx + (size_t)(32 * i) * ldx);
#pragma unroll
  for (int i = 0; i < YT; ++i) ry[i] = *(const u32x4*)(gy + (size_t)(32 * i) * ldy);
  if (ZERO) {
#pragma unroll
    for (int a = 0; a < 4; ++a)
#pragma unroll
      for (int b = 0; b < YT; ++b) acc[a][b] = (f32x4){0.f, 0.f, 0.f, 0.f};
  }
#pragma unroll
  for (int i = 0; i < 4; ++i) *(u32x4*)(sX + (lrow + 32 * i) * LSTR + lkc * 8) = rx[i];
#pragma unroll
  for (int i = 0; i < YT; ++i) *(u32x4*)(sY + (lrow + 32 * i) * LSTR + lkc * 8) = ry[i];
  __syncthreads();
  const int nk = K >> 6;
  const u16* cx0 = sX + (wx * 64 + r) * LSTR + g * 8;
  const u16* cy0 = sY + (wy * (16 * YT) + r) * LSTR + g * 8;
#define GEMM_COMPUTE(cur)                                                                            \
  {                                                                                                  \
    const u16* cx = cx0 + (cur) * 128 * LSTR;                                                        \
    const u16* cy = cy0 + (cur) * 128 * LSTR;                                                        \
    _Pragma("unroll") for (int kk = 0; kk < 2; ++kk) {                                               \
      bf16x8 a[4], b[YT];                                                                            \
      _Pragma("unroll") for (int i = 0; i < 4; ++i) a[i] = *(const bf16x8*)(cx + i * 16 * LSTR + kk * 32); \
      _Pragma("unroll") for (int i = 0; i < YT; ++i) b[i] = *(const bf16x8*)(cy + i * 16 * LSTR + kk * 32); \
      _Pragma("unroll") for (int xi = 0; xi < 4; ++xi)                                               \
        _Pragma("unroll") for (int yi = 0; yi < YT; ++yi)                                            \
          acc[xi][yi] = __builtin_amdgcn_mfma_f32_16x16x32_bf16(a[xi], b[yi], acc[xi][yi], 0, 0, 0); \
    }                                                                                                \
  }
  for (int kt = 0; kt < nk - 1; ++kt) {
    const int cur = kt & 1;
#pragma unroll
    for (int i = 0; i < 4; ++i) gload16(rx[i], gx + (size_t)(32 * i) * ldx + (kt + 1) * 64);
#pragma unroll
    for (int i = 0; i < YT; ++i) gload16(ry[i], gy + (size_t)(32 * i) * ldy + (kt + 1) * 64);
    GEMM_COMPUTE(cur);
    asm volatile("s_waitcnt vmcnt(0)" ::: "memory");
    u16* dX = sX + (cur ^ 1) * 128 * LSTR;
    u16* dY = sY + (cur ^ 1) * 128 * LSTR;
#pragma unroll
    for (int i = 0; i < 4; ++i) *(u32x4*)(dX + (lrow + 32 * i) * LSTR + lkc * 8) = rx[i];
#pragma unroll
    for (int i = 0; i < YT; ++i) *(u32x4*)(dY + (lrow + 32 * i) * LSTR + lkc * 8) = ry[i];
    __syncthreads();
  }
  GEMM_COMPUTE((nk - 1) & 1);
  __syncthreads();
#undef GEMM_COMPUTE
}

#ifndef REP_GEMM
#define REP_GEMM 0
#endif
#ifndef REP_MIX
#define REP_MIX 0
#endif
#ifndef REP_SYNC
#define REP_SYNC 0
#endif
#ifndef REP_P0
#define REP_P0 0
#endif
template <int YT>
__device__ __forceinline__ void gemm_main(const u16* __restrict__ X, int ldx, const u16* __restrict__ Y, int ldy, int K,
                                          u16* smem, f32x4 (&acc)[4][YT]) {
  gemm_main_t<true, YT>(X, ldx, Y, ldy, K, smem, acc);
#if REP_GEMM
  gemm_main_t<false, YT>(X, ldx, Y, ldy, K, smem, acc);
#pragma unroll
  for (int a = 0; a < 4; ++a)
#pragma unroll
    for (int b = 0; b < YT; ++b) acc[a][b] *= 0.5f;
#endif
}

__device__ __forceinline__ bool tile_map(int j, int ntx, int& tx, int& ty, int nty = 48) {
  const int nblk = gridDim.x, bid = blockIdx.x;
  if ((nblk & 7) == 0) {
    const int per = nty >> 3;
    const int v = (bid >> 3) + j * (nblk >> 3);
    if (v >= per * ntx) return false;
    tx = v / per; ty = per * (bid & 7) + v % per;
    return true;
  } else {
    const int it = bid + j * nblk;
    if (it >= nty * ntx) return false;
    tx = it / nty; ty = it % nty;
    return true;
  }
}

__device__ void gin_tile(const Params& p, int l, int tx, int ty, u16* smem) {
  const int n0 = tx * 128, m0 = ty * 128;
  f32x4 acc[4][4];
  gemm_main<4>(p.w_inT + (size_t)l * 2304 * 1024 + (size_t)n0 * 1024, 1024, p.h + (size_t)m0 * 1024, 1024, 1024, smem, acc);
  const int lane = otid() & 63, wave = otid() >> 6, wx = wave & 1, wy = wave >> 1, r = lane & 15, g = lane >> 4;
  const int nw = n0 + wx * 64;
  const bool isS = m0 >= NPTOK;
  int ropeMode = 0;
  if (isS) {
    if (nw >= 768 && nw < 1280) ropeMode = 1;
    else if (nw >= 1792 && nw < 2176) ropeMode = 2;
  }
  float* okv = nullptr; int okv_w = 0, okv_c = 0;
  if (!isS) {
    if (nw >= 256 && nw < 512) { okv = p.out + O_NAK; okv_w = 256; okv_c = nw - 256; }
    else if (nw >= 512 && nw < 768) { okv = p.out + O_NAV; okv_w = 256; okv_c = nw - 512; }
    else if (nw >= 1024 && nw < 1280) { okv = p.out + O_DK; okv_w = 256; okv_c = nw - 1024; }
    else if (nw >= 1280 && nw < 1536) { okv = p.out + O_DV; okv_w = 256; okv_c = nw - 1280; }
    else if (nw >= 2048 && nw < 2176) { okv = p.out + O_SK; okv_w = 128; okv_c = nw - 2048; }
    else if (nw >= 2176) { okv = p.out + O_SV; okv_w = 128; okv_c = nw - 2176; }
  }
  int vrow = -1;
  if (nw >= 512 && nw < 768) vrow = nw - 512;
  else if (nw >= 1280 && nw < 1536) vrow = 256 + nw - 1280;
  else if (nw >= 2176) vrow = 512 + nw - 2176;
#pragma unroll
  for (int yi = 0; yi < 4; ++yi) {
    const int m = m0 + wy * 64 + yi * 16 + r;
    const int t = (m - NPTOK) & 1023;
    const int prow = t >> 6, pcol = t & 63;
#pragma unroll
    for (int xi = 0; xi < 4; ++xi) {
      f32x4 v = acc[xi][yi];
      if (ropeMode == 1) {
        const int pos = (xi & 1) ? pcol : prow;
        const float4 cs = *(const float4*)(p.ropeD + pos * 8 + 4 * (g & 1));
        const float4 sn = *(const float4*)(p.ropeD + 512 + pos * 8 + 4 * (g & 1));
        const float sg = (g >= 2) ? 1.f : -1.f;
        const float o0 = __shfl_xor(v[0], 32), o1 = __shfl_xor(v[1], 32), o2 = __shfl_xor(v[2], 32), o3 = __shfl_xor(v[3], 32);
        v[0] = v[0] * cs.x + sg * o0 * sn.x; v[1] = v[1] * cs.y + sg * o1 * sn.y;
        v[2] = v[2] * cs.z + sg * o2 * sn.z; v[3] = v[3] * cs.w + sg * o3 * sn.w;
      } else if (ropeMode == 2) {
        const int pos = (xi >> 1) ? pcol : prow;
        const float4 cs = *(const float4*)(p.ropeS + pos * 16 + 4 * g);
        const float4 sn = *(const float4*)(p.ropeS + 1024 + pos * 16 + 4 * g);
        const f32x4 o = acc[xi ^ 1][yi];
        const float sg = (xi & 1) ? 1.f : -1.f;
        v[0] = v[0] * cs.x + sg * o[0] * sn.x; v[1] = v[1] * cs.y + sg * o[1] * sn.y;
        v[2] = v[2] * cs.z + sg * o[2] * sn.z; v[3] = v[3] * cs.w + sg * o[3] * sn.w;
      }
      const int nloc = xi * 16 + 4 * g;
      if (okv) {
        const int b = m >> 8, pos = m & 255;
        float4 o4; o4.x = v[0]; o4.y = v[1]; o4.z = v[2]; o4.w = v[3];
        *(float4*)(okv + ((size_t)((b * 4 + l) * 256 + pos)) * okv_w + okv_c + nloc) = o4;
      }
      if (vrow >= 0) {
#pragma unroll
        for (int i = 0; i < 4; ++i) p.vt[(size_t)(vrow + nloc + i) * NTOK + m] = f2bf(v[i]);
      } else {
        uint2 w; w.x = pack2(v[0], v[1]); w.y = pack2(v[2], v[3]);
        *(uint2*)(p.z + (size_t)m * INW + nw + nloc) = w;
      }
    }
  }
}

__device__ void res_tile(const Params& p, int l, int tx, int ty, const u16* A, const u16* WT, int K, int gi, u16* smem) {
  const int n0 = tx * 128, m0 = ty * 96;
  f32x4 acc[4][3];
  gemm_main<3>(WT + (size_t)n0 * K, K, A + (size_t)m0 * K, K, K, smem, acc);
  const int lane = otid() & 63, wave = otid() >> 6, wx = wave & 1, wy = wave >> 1, r = lane & 15, g = lane >> 4;
#pragma unroll
  for (int yi = 0; yi < 3; ++yi) {
    const int m = m0 + wy * 48 + yi * 16 + r;
    const int cond = m < NPTOK ? 0 : 1 + ((m - NPTOK) >> 10);
    const float* gate = p.mods + (size_t)(l * 3 + cond) * 6144 + gi * 1024;
    float* xrow = p.xres + (size_t)m * 1024;
    float4 xv[4], gt[4];
#pragma unroll
    for (int xi = 0; xi < 4; ++xi) {
      const int n = n0 + wx * 64 + xi * 16 + 4 * g;
      xv[xi] = *(const float4*)(xrow + n);
      gt[xi] = *(const float4*)(gate + n);
    }
#pragma unroll
    for (int xi = 0; xi < 4; ++xi) {
      const int n = n0 + wx * 64 + xi * 16 + 4 * g;
      const f32x4 v = acc[xi][yi];
      float4 o = xv[xi];
      o.x += gt[xi].x * v[0]; o.y += gt[xi].y * v[1]; o.z += gt[xi].z * v[2]; o.w += gt[xi].w * v[3];
      *(float4*)(xrow + n) = o;
    }
  }
}

__device__ void m1_tile(const Params& p, int l, int tx, int ty, u16* smem) {
  const int n0 = tx * 128, m0 = ty * 128;
  f32x4 acc[4][4];
  gemm_main<4>(p.w1T + (size_t)l * 4096 * 1024 + (size_t)n0 * 1024, 1024, p.h + (size_t)m0 * 1024, 1024, 1024, smem, acc);
  const int lane = otid() & 63, wave = otid() >> 6, wx = wave & 1, wy = wave >> 1, r = lane & 15, g = lane >> 4;
#pragma unroll
  for (int xi = 0; xi < 4; ++xi) {
    const int n = n0 + wx * 64 + xi * 16 + 4 * g;
#pragma unroll
    for (int yi = 0; yi < 4; ++yi) {
      const int m = m0 + wy * 64 + yi * 16 + r;
      const f32x4 v = acc[xi][yi];
      float a0 = fmaxf(v[0], 0.f), a1 = fmaxf(v[1], 0.f), a2 = fmaxf(v[2], 0.f), a3 = fmaxf(v[3], 0.f);
      uint2 w; w.x = pack2(a0 * a0, a1 * a1); w.y = pack2(a2 * a2, a3 * a3);
      *(uint2*)(p.u + (size_t)m * 4096 + n) = w;
    }
  }
}

__device__ void f1_tile(const Params& p, int l, int it, u16* smem) {
  const int tx = it % 48, ty = it / 48;
  const int x0 = tx * 128, y0 = ty * 128;
  f32x4 acc[4][4];
  gemm_main<4>(p.z + (size_t)x0 * INW + 1536, INW, p.pqt + (size_t)l * 512 * 256 + (size_t)y0 * 256, 256, 256, smem, acc);
  const int lane = otid() & 63, wave = otid() >> 6, wx = wave & 1, wy = wave >> 1, r = lane & 15, g = lane >> 4;
#pragma unroll
  for (int yi = 0; yi < 4; ++yi) {
    const int y = y0 + wy * 64 + yi * 16 + r;
    const int col = y & 255, which = y >> 8;
#pragma unroll
    for (int xi = 0; xi < 4; ++xi) {
      const int tok = x0 + wx * 64 + xi * 16 + 4 * g;
      size_t addr;
      if (tok < NPTOK) {
        const int b = tok >> 8, pos = tok & 255;
        addr = (size_t)b * (256 * 512) + (size_t)col * 512 + which * 256 + pos;
      } else {
        const int b = (tok - NPTOK) >> 10, pos = (tok - NPTOK) & 1023;
        addr = (size_t)16 * 256 * 512 + (size_t)b * (256 * 2048) + (size_t)col * 2048 + which * 1024 + pos;
      }
      const f32x4 v = acc[xi][yi];
      uint2 w; w.x = pack2(v[0], v[1]); w.y = pack2(v[2], v[3]);
      *(uint2*)(p.uv + addr) = w;
    }
  }
}

__device__ void f2_tile(const Params& p, int it, u16* smem) {
  int L, b, tx, ty, tokbase;
  const u16* uvb; const u16* dft;
  if (it < 32) { L = 1024; b = it >> 4; tx = (it >> 3) & 1; ty = it & 7; uvb = p.uv + (size_t)16 * 256 * 512 + (size_t)b * (256 * 2048); dft = p.dft1024; tokbase = NPTOK + b * 1024; }
  else { it -= 32; L = 256; b = it >> 2; tx = (it >> 1) & 1; ty = it & 1; uvb = p.uv + (size_t)b * (256 * 512); dft = p.dft256; tokbase = b * 256; }
  const int x0 = tx * 128, y0 = ty * 128, K = 2 * L;
  f32x4 acc[4][4];
  gemm_main<4>(uvb + (size_t)x0 * K, K, dft + (size_t)y0 * K, K, K, smem, acc);
  const int lane = otid() & 63, wave = otid() >> 6, wx = wave & 1, wy = wave >> 1, r = lane & 15, g = lane >> 4;
  const float scale = rsqrtf(64.f * (float)L);
#pragma unroll
  for (int yi = 0; yi < 4; ++yi) {
    const int pos = y0 + wy * 64 + yi * 16 + r;
#pragma unroll
    for (int xi = 0; xi < 4; ++xi) {
      const int col = x0 + wx * 64 + xi * 16 + 4 * g;
      const f32x4 v = acc[xi][yi];
      uint2 w; w.x = pack2(v[0] * scale, v[1] * scale); w.y = pack2(v[2] * scale, v[3] * scale);
      *(uint2*)(p.cat + (size_t)(tokbase + pos) * 1024 + 512 + col) = w;
    }
  }
}

struct Seg { const u16* K; const u16* Vt; int ldk, ldv, nblk, pos0, stride; };
template <int QT> struct AState { float m[QT]; float ls[QT]; f32x4 o[QT][4]; };

__device__ __forceinline__ bf16x8 as_bf(u32x4 v) { union { u32x4 u; bf16x8 b; } x; x.u = v; return x.b; }

template <int DC>
__device__ __forceinline__ void issue_blk(const Seg& s0, const Seg& s1, int b, int r, int g, u32x4 (&kf)[2][DC], u32x4 (&vf)[4]) {
  const bool in0 = b < s0.nblk;
  const u16* Kp = in0 ? s0.K : s1.K;
  const u16* Vp = in0 ? s0.Vt : s1.Vt;
  const int ldk = in0 ? s0.ldk : s1.ldk, ldv = in0 ? s0.ldv : s1.ldv;
  const int pos = in0 ? (s0.pos0 + b * s0.stride) : (s1.pos0 + (b - s0.nblk) * s1.stride);
  const int krow = pos + 8 * (r >> 2) + (r & 3);
#pragma unroll
  for (int t = 0; t < 2; ++t) {
    const u16* kp = Kp + (size_t)(krow + 4 * t) * ldk + g * 8;
#pragma unroll
    for (int dc = 0; dc < DC; ++dc) gload16(kf[t][dc], kp + dc * 32);
  }
#pragma unroll
  for (int dv = 0; dv < 4; ++dv) gload16(vf[dv], Vp + (size_t)(dv * 16 + r) * ldv + pos + 8 * g);
}
template <int N>
__device__ __forceinline__ void wait_blk(u32x4 (&kf)[2][1], u32x4 (&vf)[4]) {
  asm volatile("s_waitcnt vmcnt(%6)" : "+v"(kf[0][0]), "+v"(kf[1][0]), "+v"(vf[0]), "+v"(vf[1]), "+v"(vf[2]), "+v"(vf[3]) : "n"(N) : "memory");
}
template <int N>
__device__ __forceinline__ void wait_blk(u32x4 (&kf)[2][2], u32x4 (&vf)[4]) {
  asm volatile("s_waitcnt vmcnt(%8)" : "+v"(kf[0][0]), "+v"(kf[0][1]), "+v"(kf[1][0]), "+v"(kf[1][1]), "+v"(vf[0]), "+v"(vf[1]), "+v"(vf[2]), "+v"(vf[3]) : "n"(N) : "memory");
}

template <int D, int QT, int MODE>
__device__ __forceinline__ void attn_compute(const u32x4 (&kc)[2][D / 32], const u32x4 (&vc)[4], const bf16x8 (&qf)[QT][D / 32], const float sc,
                                             AState<QT>& st, const bool in0, const int pos, const int qpos0, const float* __restrict__ rpb_h,
                                             const int r, const int g) {
  constexpr int DC = D / 32;
#pragma unroll
  for (int q = 0; q < QT; ++q) {
    f32x4 s_[2];
    s_[0] = (f32x4){0.f, 0.f, 0.f, 0.f};
    s_[1] = (f32x4){0.f, 0.f, 0.f, 0.f};
#pragma unroll
    for (int t = 0; t < 2; ++t)
#pragma unroll
      for (int dc = 0; dc < DC; ++dc) s_[t] = __builtin_amdgcn_mfma_f32_16x16x32_bf16(as_bf(kc[t][dc]), qf[q][dc], s_[t], 0, 0, 0);
    float sv[8];
#pragma unroll
    for (int t = 0; t < 2; ++t)
#pragma unroll
      for (int i = 0; i < 4; ++i) {
        float x = s_[t][i] * sc;
        if (MODE == 1) {
          if (!in0) {
            const int qpos = qpos0 + q * 16 + r;
            const int qrow = qpos >> 6, cq = qpos & 63;
            const int kpos = pos + 8 * g + 4 * t + i;
            const int krow = kpos >> 6, ck = kpos & 63;
            const int cs = min(max(cq - 8, 0), 48);
            const bool valid = (ck >= cs) && (ck < cs + 16);
            const int bi = (krow - qrow + 7) * 31 + (ck - cq + 15);
            const float bias = valid ? rpb_h[bi] : 0.f;
            x = valid ? (x + bias * LOG2E) : -1e30f;
          }
        } else if (MODE == 2) {
          if (!in0) {
            const int qpos = qpos0 + q * 16 + r;
            const int kpos = pos + 8 * g + 4 * t + i;
            const int d = qpos - kpos;
            x = (d <= 128 && d >= -128) ? x : -1e30f;
          }
        }
        sv[4 * t + i] = x;
      }
    float mx = fmaxf(fmaxf(fmaxf(sv[0], sv[1]), fmaxf(sv[2], sv[3])), fmaxf(fmaxf(sv[4], sv[5]), fmaxf(sv[6], sv[7])));
    mx = fmaxf(mx, __shfl_xor(mx, 16));
    mx = fmaxf(mx, __shfl_xor(mx, 32));
    const float mnew = fmaxf(st.m[q], mx);
    const float alpha = __builtin_amdgcn_exp2f(st.m[q] - mnew);
    st.m[q] = mnew;
    float ps = 0.f;
#pragma unroll
    for (int j = 0; j < 8; ++j) { sv[j] = __builtin_amdgcn_exp2f(sv[j] - mnew); ps += sv[j]; }
    st.ls[q] = st.ls[q] * alpha + ps;
    union { bf16x8 v; unsigned w[4]; } pf;
    pf.w[0] = pack2(sv[0], sv[1]); pf.w[1] = pack2(sv[2], sv[3]); pf.w[2] = pack2(sv[4], sv[5]); pf.w[3] = pack2(sv[6], sv[7]);
#pragma unroll
    for (int dv = 0; dv < 4; ++dv) {
      f32x4 o = st.o[q][dv];
      o[0] *= alpha; o[1] *= alpha; o[2] *= alpha; o[3] *= alpha;
      st.o[q][dv] = __builtin_amdgcn_mfma_f32_16x16x32_bf16(as_bf(vc[dv]), pf.v, o, 0, 0, 0);
    }
  }
}

template <int D, int QT, int MODE>
__device__ __forceinline__ void attn_run(const Seg& s0, const Seg& s1, const bf16x8 (&qf)[QT][D / 32], const float sc,
                                         AState<QT>& st, const int qpos0, const float* __restrict__ rpb_h, const int bb = 0, const int be = -1) {
  constexpr int DC = D / 32;
  constexpr int NL = 2 * DC + 4;
  const int lane = otid() & 63, r = lane & 15, g = lane >> 4;
  const int nb = be < 0 ? s0.nblk + s1.nblk : be;
  u32x4 ka[2][DC], va[4], kb[2][DC], vb[4];
#pragma unroll
  for (int q = 0; q < QT; ++q)
#pragma unroll
    for (int dc = 0; dc < DC; ++dc) asm volatile("" ::"v"(qf[q][dc]));
  asm volatile("s_waitcnt vmcnt(0)" ::: "memory");
#pragma unroll 1
  for (int b = bb; b < nb; b += 2) {
    issue_blk<DC>(s0, s1, b, r, g, ka, va);
    issue_blk<DC>(s0, s1, b + 1, r, g, kb, vb);
    wait_blk<NL>(ka, va);
    {
      const bool in0 = b < s0.nblk;
      const int pos = in0 ? (s0.pos0 + b * s0.stride) : (s1.pos0 + (b - s0.nblk) * s1.stride);
      attn_compute<D, QT, MODE>(ka, va, qf, sc, st, in0, pos, qpos0, rpb_h, r, g);
    }
    wait_blk<0>(kb, vb);
    {
      const int b1 = b + 1;
      const bool in0 = b1 < s0.nblk;
      const int pos = in0 ? (s0.pos0 + b1 * s0.stride) : (s1.pos0 + (b1 - s0.nblk) * s1.stride);
      attn_compute<D, QT, MODE>(kb, vb, qf, sc, st, in0, pos, qpos0, rpb_h, r, g);
    }
  }
}

template <int QT>
__device__ __forceinline__ void astate_init(AState<QT>& st, float m0, float l0) {
#pragma unroll
  for (int q = 0; q < QT; ++q) {
    st.m[q] = m0; st.ls[q] = l0;
#pragma unroll
    for (int dv = 0; dv < 4; ++dv) st.o[q][dv] = (f32x4){0.f, 0.f, 0.f, 0.f};
  }
}
template <int QT>
__device__ __forceinline__ void astate_finalize(AState<QT>& st) {
#pragma unroll
  for (int q = 0; q < QT; ++q) {
    float l = st.ls[q];
    l += __shfl_xor(l, 16);
    l += __shfl_xor(l, 32);
    const float inv = 1.f / l;
#pragma unroll
    for (int dv = 0; dv < 4; ++dv) { st.o[q][dv][0] *= inv; st.o[q][dv][1] *= inv; st.o[q][dv][2] *= inv; st.o[q][dv][3] *= inv; }
  }
}
template <int DC, int QT>
__device__ __forceinline__ void load_q(const u16* zq  , bf16x8 (&qf)[QT][DC]) {
  const int lane = otid() & 63, r = lane & 15, g = lane >> 4;
#pragma unroll
  for (int q = 0; q < QT; ++q)
#pragma unroll
    for (int dc = 0; dc < DC; ++dc) qf[q][dc] = *(const bf16x8*)(zq + (size_t)(q * 16 + r) * INW + dc * 32 + g * 8);
}
template <int QT>
__device__ __forceinline__ void write_o(const Params& p, const AState<QT>& st, int tok0, int col0) {
  const int lane = otid() & 63, r = lane & 15, g = lane >> 4;
#pragma unroll
  for (int q = 0; q < QT; ++q)
#pragma unroll
    for (int dv = 0; dv < 4; ++dv) {
      const f32x4 v = st.o[q][dv];
      uint2 w; w.x = pack2(v[0], v[1]); w.y = pack2(v[2], v[3]);
      *(uint2*)(p.cat + (size_t)(tok0 + q * 16 + r) * 1024 + col0 + dv * 16 + 4 * g) = w;
    }
}

__device__ __forceinline__ float diff_lambda(const Params& p, int l, float lam_init) {
  const int lane = otid() & 63;
  float a = 0.f, b = 0.f;
  if (lane < 32) { a = p.lq1[l * 32 + lane] * p.lk1[l * 32 + lane]; b = p.lq2[l * 32 + lane] * p.lk2[l * 32 + lane]; }
#pragma unroll
  for (int o = 32; o >= 1; o >>= 1) { a += __shfl_xor(a, o); b += __shfl_xor(b, o); }
  return expf(a) - expf(b) + lam_init;
}

__device__ __forceinline__ void diff_finish_q(const Params& p, int l, float lam, float lam_init, f32x4 (&A)[4], const f32x4 (&B)[4], int tokrow0, int col0) {
  const int lane = otid() & 63, r = lane & 15, g = lane >> 4;
  const float* sg = p.subln_g + l * 64;
  float ss = 0.f;
#pragma unroll
  for (int dv = 0; dv < 4; ++dv)
#pragma unroll
    for (int i = 0; i < 4; ++i) {
      const float v = A[dv][i] - lam * B[dv][i];
      A[dv][i] = v;
      ss += v * v;
    }
  ss += __shfl_xor(ss, 16);
  ss += __shfl_xor(ss, 32);
  const float rs = rsqrtf(ss * (1.f / 64.f) + 1e-6f) * (1.f - lam_init);
#pragma unroll
  for (int dv = 0; dv < 4; ++dv) {
    const float4 gg = *(const float4*)(sg + dv * 16 + 4 * g);
    uint2 w;
    w.x = pack2(A[dv][0] * rs * gg.x, A[dv][1] * rs * gg.y);
    w.y = pack2(A[dv][2] * rs * gg.z, A[dv][3] * rs * gg.w);
    *(uint2*)(p.cat + (size_t)(tokrow0 + r) * 1024 + col0 + dv * 16 + 4 * g) = w;
  }
}

#ifndef AQT
#define AQT 2
#endif
#define QW (16 * AQT)
#define NQG_CTX (256 / QW)
#define NQG_LAT (1024 / QW)
__device__ void attn_diff_item(const Params& p, int l, bool lat, int bi, float* sm) {
  const int wave = otid() >> 6, lane = otid() & 63, r = lane & 15, g = lane >> 4;
  const int ps = wave >> 1, half = wave & 1;
  int b, h, qg, tokb;
  if (lat) { b = bi / (4 * NQG_LAT); h = (bi / NQG_LAT) & 3; qg = bi % NQG_LAT; tokb = NPTOK + b * 1024; }
  else { b = bi / (4 * NQG_CTX); h = (bi / NQG_CTX) & 3; qg = bi % NQG_CTX; tokb = b * 256; }
  const int tok0 = tokb + qg * QW;
  const u16* zb = p.z + (size_t)tokb * INW;
  Seg s0, s1;
  if (lat) {
    const int bl = b * 4 + l;
    s0.K = p.ck_diff + (size_t)bl * 512 * 256 + h * 64 + ps * 32; s0.Vt = p.cvt_diff + (size_t)(bl * 256 + h * 64) * 512;
    s0.ldk = 256; s0.ldv = 512; s0.nblk = half ? 0 : 16; s0.pos0 = 0; s0.stride = 32;
    s1.K = zb + 1024 + h * 64 + ps * 32; s1.Vt = p.vt + (size_t)(256 + h * 64) * NTOK + tokb;
    s1.ldk = INW; s1.ldv = NTOK; s1.nblk = half ? 24 : 8; s1.pos0 = half ? 256 : 0; s1.stride = 32;
  } else {
    s0.K = zb + 1024 + h * 64 + ps * 32; s0.Vt = p.vt + (size_t)(256 + h * 64) * NTOK + tokb;
    s0.ldk = INW; s0.ldv = NTOK; s0.nblk = 4; s0.pos0 = half ? 128 : 0; s0.stride = 32;
    s1 = s0; s1.nblk = 0;
  }
  bf16x8 qf[AQT][1];
  load_q<1, AQT>(p.z + (size_t)tok0 * INW + 768 + h * 64 + ps * 32, qf);
  AState<AQT> st;
  astate_init<AQT>(st, -1e30f, 0.f);
  attn_run<32, AQT, 0>(s0, s1, qf, 0.17677669529663687f * LOG2E, st, 0, nullptr);
  float lt[AQT];
#pragma unroll
  for (int q = 0; q < AQT; ++q) {
    lt[q] = st.ls[q];
    lt[q] += __shfl_xor(lt[q], 16);
    lt[q] += __shfl_xor(lt[q], 32);
  }
  constexpr int WS = 64 * 16 * AQT;
  float* pm = sm + 4 * WS;
  if (wave != 0) {
    float* po = sm + wave * WS + lane * (16 * AQT);
#pragma unroll
    for (int q = 0; q < AQT; ++q) {
#pragma unroll
      for (int dv = 0; dv < 4; ++dv) *(f32x4*)(po + q * 16 + dv * 4) = st.o[q][dv];
      if (g == 0) { pm[wave * QW + q * 16 + r] = st.m[q]; pm[4 * QW + wave * QW + q * 16 + r] = lt[q]; }
    }
  }
  __syncthreads();
  if (wave == 0) {
    const float lam_init = 0.8f - 0.6f * expf(-0.3f * (float)l);
    const float lam = diff_lambda(p, l, lam_init);
#pragma unroll
    for (int q = 0; q < AQT; ++q) {
      f32x4 A[4], B[4];
      {
        const float m1 = pm[QW + q * 16 + r], l1 = pm[4 * QW + QW + q * 16 + r];
        const float M = fmaxf(st.m[q], m1);
        const float a0 = exp2f(st.m[q] - M), a1 = exp2f(m1 - M);
        const float inv = 1.f / (lt[q] * a0 + l1 * a1);
#pragma unroll
        for (int dv = 0; dv < 4; ++dv) {
          const f32x4 o1 = *(const f32x4*)(sm + 1 * WS + lane * (16 * AQT) + q * 16 + dv * 4);
          A[dv] = (st.o[q][dv] * a0 + o1 * a1) * inv;
        }
      }
      {
        const float m2 = pm[2 * QW + q * 16 + r], l2 = pm[4 * QW + 2 * QW + q * 16 + r], m3 = pm[3 * QW + q * 16 + r], l3 = pm[4 * QW + 3 * QW + q * 16 + r];
        const float M = fmaxf(m2, m3);
        const float a2 = exp2f(m2 - M), a3 = exp2f(m3 - M);
        const float inv = 1.f / (l2 * a2 + l3 * a3);
#pragma unroll
        for (int dv = 0; dv < 4; ++dv) {
          const f32x4 o2 = *(const f32x4*)(sm + 2 * WS + lane * (16 * AQT) + q * 16 + dv * 4);
          const f32x4 o3 = *(const f32x4*)(sm + 3 * WS + lane * (16 * AQT) + q * 16 + dv * 4);
          B[dv] = (o2 * a2 + o3 * a3) * inv;
        }
      }
      diff_finish_q(p, l, lam, lam_init, A, B, tok0 + q * 16, 256 + h * 64);
    }
  }
  __syncthreads();
}

__device__ void attn_ctx_item(const Params& p, int l, int bi) {
  const int wave = otid() >> 6, lane = otid() & 63, g = lane >> 4;
  const int w = bi * 4 + wave;
  const int type = w / (64 * NQG_CTX), rem = w % (64 * NQG_CTX);
  const int b = rem / (4 * NQG_CTX), h = (rem / NQG_CTX) & 3, qg = rem % NQG_CTX;
  const int tokb = b * 256, tok0 = tokb + qg * QW;
  const u16* zb = p.z + (size_t)tokb * INW;
  const int kvh = h >> 1;
  const int qcol = type == 0 ? h * 64 : 1792 + h * 64;
  const int kcol = type == 0 ? 256 + h * 64 : 2048 + kvh * 64;
  const int vrow = type == 0 ? h * 64 : 512 + kvh * 64;
  const int ocol = type == 0 ? h * 64 : 768 + h * 64;
  bf16x8 qf[AQT][2];
  load_q<2, AQT>(p.z + (size_t)tok0 * INW + qcol, qf);
  Seg s0; s0.K = zb + kcol; s0.Vt = p.vt + (size_t)vrow * NTOK + tokb; s0.ldk = INW; s0.ldv = NTOK; s0.nblk = 8; s0.pos0 = 0; s0.stride = 32;
  Seg sN = s0; sN.nblk = 0;
  AState<AQT> st;
  const float sk = type == 0 ? -1e30f : p.swa_sink[l * 4 + h] * LOG2E;
  astate_init<AQT>(st, sk, (type == 1 && g == 0) ? 1.f : 0.f);
  attn_run<64, AQT, 0>(s0, sN, qf, 0.125f * LOG2E, st, 0, nullptr);
  astate_finalize<AQT>(st);
  write_o<AQT>(p, st, tok0, ocol);
}

__device__ void attn_lat_item(const Params& p, int l, int bi, float* sm) {
  const int wave = otid() >> 6, lane = otid() & 63, r = lane & 15, g = lane >> 4;
  const int type = bi / (8 * NQG_LAT), rem = bi % (8 * NQG_LAT);
  const int b = rem / (4 * NQG_LAT), h = (rem / NQG_LAT) & 3, qg = rem % NQG_LAT;
  const int q0 = qg * QW;
  const int tokb = NPTOK + b * 1024, tok0 = tokb + q0;
  const u16* zb = p.z + (size_t)tokb * INW;
  const int bl = b * 4 + l;
  AState<AQT> st;
  int ocol;
  if (type == 0) {
    const int kvh = h >> 1;
    bf16x8 qf[AQT][2];
    load_q<2, AQT>(p.z + (size_t)tok0 * INW + 1792 + h * 64, qf);
    Seg s0; s0.K = p.ck_swa + (size_t)bl * 512 * 128 + kvh * 64; s0.Vt = p.cvt_swa + (size_t)(bl * 128 + kvh * 64) * 512; s0.ldk = 128; s0.ldv = 512; s0.nblk = 16; s0.pos0 = 0; s0.stride = 32;
    const int lo = max(0, q0 - 128) & ~31;
    const int hi = min(1024, ((q0 + QW + 128) + 31) & ~31);
    int lo2 = lo, cnt = (hi - lo) >> 5;
    if (cnt & 1) { if (lo2 > 0) lo2 -= 32; ++cnt; }
    Seg s1; s1.K = zb + 2048 + kvh * 64; s1.Vt = p.vt + (size_t)(512 + kvh * 64) * NTOK + tokb; s1.ldk = INW; s1.ldv = NTOK; s1.nblk = cnt; s1.pos0 = lo2; s1.stride = 32;
    const int P = (16 + cnt) >> 1;
    const int pb = (wave * P) >> 2, pe = ((wave + 1) * P) >> 2;
    astate_init<AQT>(st, wave == 0 ? p.swa_sink[l * 4 + h] * LOG2E : -1e30f, (wave == 0 && g == 0) ? 1.f : 0.f);
    attn_run<64, AQT, 2>(s0, s1, qf, 0.125f * LOG2E, st, q0, nullptr, 2 * pb, 2 * pe);
    ocol = 768 + h * 64;
  } else {
    bf16x8 qf[AQT][2];
    load_q<2, AQT>(p.z + (size_t)tok0 * INW + h * 64, qf);
    Seg s0; s0.K = p.ck_na + (size_t)bl * 512 * 256 + h * 64; s0.Vt = p.cvt_na + (size_t)(bl * 256 + h * 64) * 512; s0.ldk = 256; s0.ldv = 512; s0.nblk = 16; s0.pos0 = 0; s0.stride = 32;
    const int qrow = q0 >> 6;
    const int rstart = min(max(qrow - 4, 0), 8);
    Seg s1; s1.K = zb + 256 + h * 64; s1.Vt = p.vt + (size_t)(h * 64) * NTOK + tokb; s1.ldk = INW; s1.ldv = NTOK; s1.nblk = 16; s1.pos0 = rstart * 64; s1.stride = 32;
    astate_init<AQT>(st, -1e30f, 0.f);
    attn_run<64, AQT, 1>(s0, s1, qf, 0.125f * LOG2E, st, q0, p.na_rpb + (size_t)(l * 4 + h) * 15 * 31, 8 * wave, 8 * wave + 8);
    ocol = h * 64;
  }
  float lt[AQT];
#pragma unroll
  for (int q = 0; q < AQT; ++q) {
    lt[q] = st.ls[q];
    lt[q] += __shfl_xor(lt[q], 16);
    lt[q] += __shfl_xor(lt[q], 32);
  }
  constexpr int WS = 64 * 16 * AQT;
  float* pm = sm + 4 * WS;
  if (wave != 0) {
    float* po = sm + wave * WS + lane * (16 * AQT);
#pragma unroll
    for (int q = 0; q < AQT; ++q) {
#pragma unroll
      for (int dv = 0; dv < 4; ++dv) *(f32x4*)(po + q * 16 + dv * 4) = st.o[q][dv];
      if (g == 0) { pm[wave * QW + q * 16 + r] = st.m[q]; pm[4 * QW + wave * QW + q * 16 + r] = lt[q]; }
    }
  }
  __syncthreads();
  if (wave == 0) {
#pragma unroll
    for (int q = 0; q < AQT; ++q) {
      const float m1 = pm[1 * QW + q * 16 + r], m2 = pm[2 * QW + q * 16 + r], m3 = pm[3 * QW + q * 16 + r];
      const float l1 = pm[4 * QW + 1 * QW + q * 16 + r], l2 = pm[4 * QW + 2 * QW + q * 16 + r], l3 = pm[4 * QW + 3 * QW + q * 16 + r];
      const float M = fmaxf(fmaxf(st.m[q], m1), fmaxf(m2, m3));
      const float a0 = __builtin_amdgcn_exp2f(st.m[q] - M), a1 = __builtin_amdgcn_exp2f(m1 - M), a2 = __builtin_amdgcn_exp2f(m2 - M), a3 = __builtin_amdgcn_exp2f(m3 - M);
      const float inv = 1.f / (lt[q] * a0 + l1 * a1 + l2 * a2 + l3 * a3);
#pragma unroll
      for (int dv = 0; dv < 4; ++dv) {
        const f32x4 o1 = *(const f32x4*)(sm + 1 * WS + lane * (16 * AQT) + q * 16 + dv * 4);
        const f32x4 o2 = *(const f32x4*)(sm + 2 * WS + lane * (16 * AQT) + q * 16 + dv * 4);
        const f32x4 o3 = *(const f32x4*)(sm + 3 * WS + lane * (16 * AQT) + q * 16 + dv * 4);
        st.o[q][dv] = (st.o[q][dv] * a0 + o1 * a1 + o2 * a2 + o3 * a3) * inv;
      }
    }
    write_o<AQT>(p, st, tok0, ocol);
  }
  __syncthreads();
}

#define XB_TMO      128
#define XB_XCNT(j)  (256  + 64 * (j))
#define XB_XSUB(j)  (1280 + 64 * (j))
#define XB_XGEN(j)  (2304 + 64 * (j))
#define XB_TOP      3328
#define XB_TOPGEN   3392
#define XCD_BAR_WORDS 3456
#define XB_SPIN_CAP (1u << 22)
#define LAS __attribute__((address_space(3)))
__device__ __forceinline__ unsigned xb_ld(unsigned* p)              { return __hip_atomic_load(p, __ATOMIC_RELAXED, __HIP_MEMORY_SCOPE_AGENT); }
__device__ __forceinline__ unsigned xb_add(unsigned* p, unsigned v) { return __hip_atomic_fetch_add(p, v, __ATOMIC_RELAXED, __HIP_MEMORY_SCOPE_AGENT); }
__device__ __forceinline__ unsigned xb_xcc_id() { return (unsigned)__builtin_amdgcn_s_getreg((3 << 11) | 20) & 0xFu; }
#define XB_SPIN(cond, bar) do { unsigned _sp = 0; while (cond) { __builtin_amdgcn_s_sleep(1); \
    if ((++_sp & 255u) == 0u) { if (xb_ld(&(bar)[XB_TMO])) break; if (_sp > XB_SPIN_CAP) { atomicAdd(&(bar)[XB_TMO], 1u); break; } } } } while (0)
struct XcdBarrier { unsigned* bar; unsigned x; volatile LAS unsigned* st; };
__device__ __forceinline__ XcdBarrier xcd_barrier_post(unsigned* bar, volatile LAS unsigned* st) {
  XcdBarrier b; b.bar = bar; b.x = xb_xcc_id(); b.st = st;
  if (threadIdx.x == 0) (void)xb_add(&bar[XB_XCNT(b.x)], 1u);
  return b;
}
__device__ __forceinline__ void xcd_barrier_complete(unsigned* bar, unsigned x, unsigned& nloc, unsigned& nx) {
  const unsigned G = gridDim.x * gridDim.y * gridDim.z;
  unsigned sum, cnt, mine, sp = 0u;
  for (;;) {
    sum = 0u; cnt = 0u; mine = 0u;
#pragma unroll
    for (unsigned j = 0; j < 16; ++j) { const unsigned c = xb_ld(&bar[XB_XCNT(j)]); sum += c; cnt += (c > 0u) ? 1u : 0u; mine = (j == x) ? c : mine; }
    if (sum == G) break;
    __builtin_amdgcn_s_sleep(1);
    if ((++sp & 255u) == 0u) { if (xb_ld(&bar[XB_TMO])) break; if (sp > XB_SPIN_CAP) { atomicAdd(&bar[XB_TMO], 1u); break; } }
  }
  nloc = mine > 0u ? mine : 1u; nx = cnt > 0u ? cnt : 1u;
}
__device__ __forceinline__ void xcd_barrier(const XcdBarrier& b) {
  asm volatile("s_waitcnt vmcnt(0)" ::: "memory");
  __syncthreads();
  if (threadIdx.x == 0) {
    unsigned* bar = b.bar;
    __builtin_amdgcn_s_waitcnt(0);
    unsigned nloc = b.st[0], nx = b.st[1];
    if (nloc == 0u) { xcd_barrier_complete(bar, b.x, nloc, nx); b.st[0] = nloc; b.st[1] = nx; }
    const unsigned old = xb_add(&bar[XB_XSUB(b.x)], 1u);
    const unsigned gen = old / nloc;
    if (old + 1u == (gen + 1u) * nloc) {
      __builtin_amdgcn_fence(__ATOMIC_RELEASE, "agent");
      asm volatile("s_waitcnt vmcnt(0)" ::: "memory");
      const unsigned og = xb_add(&bar[XB_TOP], 1u);
      const unsigned tg = og / nx;
      if (og + 1u == (tg + 1u) * nx) xb_add(&bar[XB_TOPGEN], 1u);
      else XB_SPIN(xb_ld(&bar[XB_TOPGEN]) == tg, bar);
      __builtin_amdgcn_fence(__ATOMIC_ACQUIRE, "agent");
      xb_add(&bar[XB_XGEN(b.x)], 1u);
      asm volatile("s_waitcnt vmcnt(0)" ::: "memory");
    } else {
      XB_SPIN(xb_ld(&bar[XB_XGEN(b.x)]) == gen, bar);
      __builtin_amdgcn_fence(__ATOMIC_ACQUIRE, "agent");
      asm volatile("s_waitcnt vmcnt(0)" ::: "memory");
    }
  }
  __syncthreads();
}

#if REP_SYNC
#define GSYNC() do { xcd_barrier(xb); xcd_barrier(xb); } while (0)
#else
#define GSYNC() xcd_barrier(xb)
#endif
__global__ void __launch_bounds__(256, 2) mega(Params p) {
  extern __shared__ __attribute__((aligned(16))) unsigned char smem[];
  cg::grid_group grid = cg::this_grid();
  const int nblk = gridDim.x, bid = blockIdx.x;
  u16* sm16 = (u16*)smem;
  __shared__ uint4 xb_words;
  if (threadIdx.x == 0) xb_words = make_uint4(0u, 0u, 0u, 0u);
  __syncthreads();
  XcdBarrier xb = xcd_barrier_post(p.bar, (volatile LAS unsigned*)&xb_words);

  for (int rep = 0; rep <= REP_P0; ++rep)
    for (int it = bid; it < P0_ITEMS; it += nblk) p0_item(p, it, smem);
  if (p.use_cg_sync) grid.sync();
  GSYNC();

#pragma unroll 1
  for (int l = 0; l < 4; ++l) {
    for (int it = bid; it < 384; it += nblk) norm_item(p, l, 0, it);
    GSYNC();
    { int tx, ty; for (int j = 0; tile_map(j, 18, tx, ty); ++j) gin_tile(p, l, tx, ty, sm16); }
    GSYNC();
    {
      constexpr int ND = 64 * NQG_CTX, NC = 2 * 64 * NQG_CTX / 4;
      for (int rep = 0; rep <= (REP_MIX & 1); ++rep)
      for (int it = bid; it < ND + NC + 192; it += nblk) {
        if (it < ND) attn_diff_item(p, l, false, it, (float*)smem);
        else if (it < ND + NC) attn_ctx_item(p, l, it - ND);
        else f1_tile(p, l, it - ND - NC, sm16);
      }
    }
    GSYNC();
    {
      constexpr int ND = 8 * NQG_LAT, NC = 2 * 8 * NQG_LAT;
      for (int rep = 0; rep <= (REP_MIX >> 1); ++rep)
      for (int it = bid; it < 32 + ND + NC + 64; it += nblk) {
        if (it < 32) f2_tile(p, it, sm16);
        else if (it < 32 + NC) attn_lat_item(p, l, it - 32, (float*)smem);
        else if (it < 32 + NC + ND) attn_diff_item(p, l, true, it - 32 - NC, (float*)smem);
        else f2_tile(p, it - (32 + ND + NC) + 32, sm16);
      }
    }
    GSYNC();
    { int tx, ty; for (int j = 0; tile_map(j, 8, tx, ty, 64); ++j) res_tile(p, l, tx, ty, p.cat, p.w_outT + (size_t)l * 1024 * 1024, 1024, 2, sm16); }
    GSYNC();
    for (int it = bid; it < 384; it += nblk) norm_item(p, l, 1, it);
    GSYNC();
    { int tx, ty; for (int j = 0; tile_map(j, 32, tx, ty); ++j) m1_tile(p, l, tx, ty, sm16); }
    GSYNC();
    { int tx, ty; for (int j = 0; tile_map(j, 8, tx, ty, 64); ++j) res_tile(p, l, tx, ty, p.u, p.w2T + (size_t)l * 1024 * 4096, 4096, 5, sm16); }
    GSYNC();
  }
  for (int it = bid; it < 384; it += nblk) norm_item(p, 0, 2, it);
}

extern "C" void kernel_launch(void* const* d_in, const int* in_sizes, int n_in, void* d_out, int out_size, void* d_ws,
                              size_t ws_size, hipStream_t stream) {
  static int grid_blocks = 0;
  if (grid_blocks == 0) {
    int dev = 0, cus = 0, per_cu = 0;
    (void)hipGetDevice(&dev);
    (void)hipDeviceGetAttribute(&cus, hipDeviceAttributeMultiprocessorCount, dev);
    if (hipFuncSetAttribute((const void*)mega, hipFuncAttributeMaxDynamicSharedMemorySize, LDS_BYTES) != hipSuccess) {
      fprintf(stderr, "hipFuncSetAttribute failed\n");
    }
    if (hipOccupancyMaxActiveBlocksPerMultiprocessor(&per_cu, (const void*)mega, 256, LDS_BYTES) != hipSuccess || per_cu < 1) {
      fprintf(stderr, "occupancy query failed (%d)\n", per_cu);
      per_cu = 1;
    }
    if (per_cu > 2) per_cu = 2;
    grid_blocks = cus * per_cu;
    fprintf(stderr, "mega: cus=%d per_cu=%d grid=%d ws=%zu\n", cus, per_cu, grid_blocks, ws_size);
  }
  Params p{};
  const float** pin = (const float**)&p;
  for (int i = 0; i < 27; ++i) pin[i] = (const float*)d_in[i];
  p.out = (float*)d_out;
  unsigned char* ws = (unsigned char*)d_ws;
  size_t off = 0;
  auto take = [&](size_t bytes) { unsigned char* q = ws + off; off += (bytes + 255) & ~(size_t)255; return q; };
  p.xres = (float*)take((size_t)NTOK * 1024 * 4);
  p.mods = (float*)take((size_t)4 * 3 * 6144 * 4);
  p.h = (u16*)take((size_t)NTOK * 1024 * 2);
  p.z = (u16*)take((size_t)NTOK * INW * 2);
  p.vt = (u16*)take((size_t)640 * NTOK * 2);
  p.cat = (u16*)take((size_t)NTOK * 1024 * 2);
  p.u = (u16*)take((size_t)NTOK * 4096 * 2);
  p.uv = (u16*)take((size_t)(16 * 256 * 512 + 2 * 256 * 2048) * 2);
  p.w_inT = (u16*)take((size_t)4 * 2304 * 1024 * 2);
  p.w_outT = (u16*)take((size_t)4 * 1024 * 1024 * 2);
  p.w1T = (u16*)take((size_t)4 * 4096 * 1024 * 2);
  p.w2T = (u16*)take((size_t)4 * 4096 * 1024 * 2);
  p.pqt = (u16*)take((size_t)4 * 512 * 256 * 2);
  p.dft256 = (u16*)take((size_t)256 * 512 * 2);
  p.dft1024 = (u16*)take((size_t)1024 * 2048 * 2);
  p.ck_na = (u16*)take((size_t)2 * 4 * 512 * 256 * 2);
  p.cvt_na = (u16*)take((size_t)2 * 4 * 512 * 256 * 2);
  p.ck_diff = (u16*)take((size_t)2 * 4 * 512 * 256 * 2);
  p.cvt_diff = (u16*)take((size_t)2 * 4 * 512 * 256 * 2);
  p.ck_swa = (u16*)take((size_t)2 * 4 * 512 * 128 * 2);
  p.cvt_swa = (u16*)take((size_t)2 * 4 * 512 * 128 * 2);
  p.ropeD = (float*)take(1024 * 4);
  p.ropeS = (float*)take(2048 * 4);
  p.bar = (unsigned*)take(XCD_BAR_WORDS * 4);
  if (off > ws_size) { fprintf(stderr, "workspace too small: need %zu have %zu\n", off, ws_size); return; }
  if (hipMemsetAsync(p.bar, 0, XCD_BAR_WORDS * 4, stream) != hipSuccess) fprintf(stderr, "memset failed\n");
  void* args[] = {&p};
  hipError_t e = hipLaunchCooperativeKernel((const void*)mega, dim3(grid_blocks), dim3(256), args, LDS_BYTES, stream);
  if (e != hipSuccess) fprintf(stderr, "cooperative launch failed: %s (grid %d)\n", hipGetErrorString(e), grid_blocks);
}
```

```cpp
#include <hip/hip_runtime.h>
#include <hip/hip_cooperative_groups.h>
#include <stdint.h>
#include <stdio.h>
namespace cg = cooperative_groups;

typedef unsigned short u16;
typedef __attribute__((ext_vector_type(8))) short bf16x8;
typedef __attribute__((ext_vector_type(4))) float f32x4;
typedef __attribute__((ext_vector_type(4))) unsigned u32x4;
__device__ __forceinline__ void gload16(u32x4& dst, const void* ptr) {
  asm volatile("global_load_dwordx4 %0, %1, off" : "=v"(dst) : "v"(ptr) : "memory");
}

#define NTOK 6144
#define NPTOK 4096
#define INW 2304
#define LOG2E 1.4426950408889634f
#define LDS_BYTES 73728
#define LSTR 72

#define O_NAK 6291456
#define O_NAV 10485760
#define O_DK 14680064
#define O_DV 18874368
#define O_SK 23068672
#define O_SV 25165824

struct Params {
  const float *x_prompt, *x_sample, *c_na_k, *c_na_v, *c_diff_k, *c_diff_v, *c_swa_k, *c_swa_v, *c, *c_ctx;
  const float *w_ada, *b_ada, *norm1_g, *norm2_g, *w_in, *na_rpb, *lq1, *lk1, *lq2, *lk2, *subln_g, *w_fourier, *swa_sink;
  const float *w_out, *w1, *w2, *final_g;
  float* out;
  float* xres;
  float* mods;
  u16 *h, *z, *vt, *cat, *u, *uv, *w_inT, *w_outT, *w1T, *w2T, *pqt, *dft256, *dft1024;
  u16 *ck_na, *cvt_na, *ck_diff, *cvt_diff, *ck_swa, *cvt_swa;
  float *ropeD, *ropeS;
  u16 *kfr, *vfr;
  unsigned* bar;
  int use_cg_sync;
  int pad_;
};

__device__ __forceinline__ u16 f2bf(float f) {
  unsigned u = __float_as_uint(f);
  u += 0x7fffu + ((u >> 16) & 1u);
  return (u16)(u >> 16);
}
__device__ __forceinline__ int otid() { int t = threadIdx.x; asm volatile("" : "+v"(t)); return t; }
__device__ __forceinline__ float bf2f(u16 h) { return __uint_as_float(((unsigned)h) << 16); }
typedef __attribute__((ext_vector_type(2))) __bf16 hbf16x2;
typedef __attribute__((ext_vector_type(2))) float f32x2;
__device__ __forceinline__ unsigned pack2(float a, float b) {
  f32x2 v = {a, b};
  union { hbf16x2 h; unsigned u; } x;
  x.h = __builtin_convertvector(v, hbf16x2);
  return x.u;
}

__device__ __forceinline__ int kfrag_off(int kk, int d) {
  const int t = (kk >> 2) & 1, r = ((kk >> 3) << 2) | (kk & 3), dc = d >> 5, g = (d >> 3) & 3;
  return ((t * 2 + dc) * 64 + g * 16 + r) * 8 + (d & 7);
}
__device__ __forceinline__ int vfrag_off(int kk, int dv) {
  return (((dv >> 4) * 64) + (kk >> 3) * 16 + (dv & 15)) * 8 + (kk & 7);
}

__device__ __forceinline__ void transpose_tile(const float* __restrict__ src, int lds_, u16* __restrict__ dst, int ldd,
                                               int k0, int n0, float* sm, bool fragv = false) {
  const int tid = otid();
  const int c4 = (tid & 15) * 4, r0 = tid >> 4;
  float4 v[8];
#pragma unroll
  for (int i = 0; i < 8; ++i) v[i] = *(const float4*)(src + (size_t)(k0 + r0 + 16 * i) * lds_ + n0 + c4);
#pragma unroll
  for (int i = 0; i < 8; ++i) {
    const int k = r0 + 16 * i;
    sm[(c4 + 0) * 129 + k] = v[i].x; sm[(c4 + 1) * 129 + k] = v[i].y; sm[(c4 + 2) * 129 + k] = v[i].z; sm[(c4 + 3) * 129 + k] = v[i].w;
  }
  __syncthreads();
  const int k8 = (tid & 15) * 8, nn = tid >> 4;
#pragma unroll
  for (int i = 0; i < 4; ++i) {
    const int n = nn + 16 * i;
    const float* row = sm + n * 129 + k8;
    uint4 w;
    w.x = pack2(row[0], row[1]); w.y = pack2(row[2], row[3]); w.z = pack2(row[4], row[5]); w.w = pack2(row[6], row[7]);
    if (fragv) {
      const int col = n0 + n, pos = k0 + k8;
      *(uint4*)(dst + ((size_t)((col >> 6) * 16 + (pos >> 5))) * 2048 + vfrag_off(pos & 31, col & 63)) = w;
    } else {
      *(uint4*)(dst + (size_t)(n0 + n) * ldd + k0 + k8) = w;
    }
  }
  __syncthreads();
}

__device__ __forceinline__ void adaln_item(const Params& p, int it, float* sm) {
  const int l = it / 96, c0 = (it % 96) * 64;
  float* ssil = sm;
  float* red = sm + 3072;
  const int tid = otid();
  for (int i = tid; i < 3072; i += 256) {
    const int cnd = i >> 10, k = i & 1023;
    const float v = cnd == 0 ? p.c_ctx[k] : p.c[(cnd - 1) * 1024 + k];
    ssil[i] = v / (1.f + expf(-v));
  }
  __syncthreads();
  const int cg4 = (tid & 15) * 4, ks = tid >> 4;
  const float* w = p.w_ada + (size_t)l * 1024 * 6144 + c0 + cg4;
  float a0[4] = {0.f, 0.f, 0.f, 0.f}, a1[4] = {0.f, 0.f, 0.f, 0.f}, a2[4] = {0.f, 0.f, 0.f, 0.f};
#pragma unroll 16
  for (int kk = 0; kk < 64; ++kk) {
    const int k = kk * 16 + ks;
    const float4 v = *(const float4*)(w + (size_t)k * 6144);
    const float s0 = ssil[k], s1 = ssil[1024 + k], s2 = ssil[2048 + k];
    a0[0] += s0 * v.x; a0[1] += s0 * v.y; a0[2] += s0 * v.z; a0[3] += s0 * v.w;
    a1[0] += s1 * v.x; a1[1] += s1 * v.y; a1[2] += s1 * v.z; a1[3] += s1 * v.w;
    a2[0] += s2 * v.x; a2[1] += s2 * v.y; a2[2] += s2 * v.z; a2[3] += s2 * v.w;
  }
#pragma unroll
  for (int j = 0; j < 4; ++j) {
    red[(ks * 3 + 0) * 64 + cg4 + j] = a0[j];
    red[(ks * 3 + 1) * 64 + cg4 + j] = a1[j];
    red[(ks * 3 + 2) * 64 + cg4 + j] = a2[j];
  }
  __syncthreads();
  if (tid < 192) {
    const int cnd = tid >> 6, j = tid & 63;
    float s = p.b_ada[l * 6144 + c0 + j];
    for (int q = 0; q < 16; ++q) s += red[(q * 3 + cnd) * 64 + j];
    p.mods[(l * 3 + cnd) * 6144 + c0 + j] = s;
  }
  __syncthreads();
}

__device__ __forceinline__ void cvt_item(const float* __restrict__ src, u16* __restrict__ dst, int it, int W) {
  const int w8 = W >> 3;
#pragma unroll
  for (int i = 0; i < 4; ++i) {
    const int u = it * 1024 + i * 256 + otid();
    const int d8 = u % w8, pos = (u / w8) & 511, bl = u / (w8 * 512);
    const float* sp = src + ((size_t)(bl * 512 + pos) * W + d8 * 8);
    const float4 v0 = *(const float4*)sp, v1 = *(const float4*)(sp + 4);
    uint4 w; w.x = pack2(v0.x, v0.y); w.y = pack2(v0.z, v0.w); w.z = pack2(v1.x, v1.y); w.w = pack2(v1.z, v1.w);
    const int h = d8 >> 3, d = (d8 & 7) * 8;
    *(uint4*)(dst + ((size_t)((bl * (W >> 6) + h) * 16 + (pos >> 5))) * 2048 + kfrag_off(pos & 31, d)) = w;
  }
}

__device__ __forceinline__ void pq_item(const Params& p, int it, float* sm) {
  const int l = it >> 3, which = (it >> 2) & 1, g = it & 3;
  const int n = otid();
  if (n < 64) sm[n] = which ? sinpif(2.f * (float)n / 64.f) : cospif(2.f * (float)n / 64.f);
  __syncthreads();
  float w[64];
#pragma unroll
  for (int m = 0; m < 64; ++m) w[m] = p.w_fourier[(size_t)l * 65536 + (g * 64 + m) * 256 + n];
  u16* dst = p.pqt + (size_t)l * 512 * 256 + (size_t)(which * 256 + n) * 256 + g * 64;
  for (int c = 0; c < 64; ++c) {
    float s = 0.f;
#pragma unroll
    for (int m = 0; m < 64; ++m) s += sm[(c * m) & 63] * w[m];
    dst[c] = f2bf(s);
  }
  __syncthreads();
}

__device__ __forceinline__ void dft_item(u16* dst, int L, int it) {
  const int twoL = 2 * L;
  for (int e = otid(); e < 8192; e += 256) {
    const int idx = it * 8192 + e;
    const int k = idx / twoL, j = idx % twoL;
    const int jj = j & (L - 1);
    const int ph = (k * jj) & (L - 1);
    const float a = 2.f * (float)ph / (float)L;
    const float v = (j >= L) ? -sinpif(a) : cospif(a);
    dst[idx] = f2bf(v);
  }
}

#define P0_WT 5760
#define P0_ADA 384
#define P0_XC 384
#define P0_CK 320
#define P0_CVT 320
#define P0_PQ 32
#define P0_DFT 272
#define P0_ITEMS (P0_ADA + P0_WT + P0_XC + P0_CK + P0_CVT + P0_PQ + P0_DFT + 1)

__device__ void p0_item(const Params& p, int it, unsigned char* smem) {
  float* sm = (float*)smem;
  if (it < P0_ADA) { adaln_item(p, it, sm); return; }
  it -= P0_ADA;
  if (it < P0_WT) {
    const int l = it / 1440; int r = it % 1440;
    if (r < 288) { transpose_tile(p.w_in + (size_t)l * 1024 * 2304, 2304, p.w_inT + (size_t)l * 2304 * 1024, 1024, (r / 36) * 128, (r % 36) * 64, sm); return; }
    r -= 288;
    if (r < 128) { transpose_tile(p.w_out + (size_t)l * 1024 * 1024, 1024, p.w_outT + (size_t)l * 1024 * 1024, 1024, (r / 16) * 128, (r % 16) * 64, sm); return; }
    r -= 128;
    if (r < 512) { transpose_tile(p.w1 + (size_t)l * 1024 * 4096, 4096, p.w1T + (size_t)l * 4096 * 1024, 1024, (r / 64) * 128, (r % 64) * 64, sm); return; }
    r -= 512;
    transpose_tile(p.w2 + (size_t)l * 4096 * 1024, 1024, p.w2T + (size_t)l * 1024 * 4096, 4096, (r / 16) * 128, (r % 16) * 64, sm);
    return;
  }
  it -= P0_WT;
  if (it < P0_XC) {
    const int row0 = it * 16;
    const float* src = row0 < NPTOK ? p.x_prompt + (size_t)row0 * 1024 : p.x_sample + (size_t)(row0 - NPTOK) * 1024;
    float* dst = p.xres + (size_t)row0 * 1024;
#pragma unroll
    for (int i = 0; i < 16; ++i) {
      const int o = (i * 256 + otid()) * 4;
      *(float4*)(dst + o) = *(const float4*)(src + o);
    }
    return;
  }
  it -= P0_XC;
  if (it < P0_CK) {
    if (it < 128) { cvt_item(p.c_na_k, p.ck_na, it, 256); return; }
    it -= 128;
    if (it < 128) { cvt_item(p.c_diff_k, p.ck_diff, it, 256); return; }
    it -= 128;
    cvt_item(p.c_swa_k, p.ck_swa, it, 128);
    return;
  }
  it -= P0_CK;
  if (it < P0_CVT) {
    if (it < 128) { const int bl = it >> 4, r = it & 15; transpose_tile(p.c_na_v + (size_t)bl * 512 * 256, 256, p.cvt_na + (size_t)bl * 256 * 512, 512, (r >> 2) * 128, (r & 3) * 64, sm, true); return; }
    it -= 128;
    if (it < 128) { const int bl = it >> 4, r = it & 15; transpose_tile(p.c_diff_v + (size_t)bl * 512 * 256, 256, p.cvt_diff + (size_t)bl * 256 * 512, 512, (r >> 2) * 128, (r & 3) * 64, sm, true); return; }
    it -= 128;
    { const int bl = it >> 3, r = it & 7; transpose_tile(p.c_swa_v + (size_t)bl * 512 * 128, 128, p.cvt_swa + (size_t)bl * 128 * 512, 512, (r >> 1) * 128, (r & 1) * 64, sm, true); return; }
  }
  it -= P0_CVT;
  if (it < P0_PQ) { pq_item(p, it, sm); return; }
  it -= P0_PQ;
  if (it < 16) { dft_item(p.dft256, 256, it); return; }
  it -= 16;
  if (it < 256) { dft_item(p.dft1024, 1024, it); return; }
  for (int e = otid(); e < 512 + 1024; e += 256) {
    const bool isD = e < 512;
    const int ee = isD ? e : e - 512;
    const int nf = isD ? 8 : 16;
    const int pos = ee / nf, fi = ee % nf;
    const float inv = exp2f(-(float)fi * (13.287712379549449f / (float)nf));
    float tt = (float)pos * inv * 0.15915494309189535f;
    tt -= rintf(tt);
    float sn, cs;
    sincospif(2.f * tt, &sn, &cs);
    if (isD) { p.ropeD[ee] = cs; p.ropeD[512 + ee] = sn; }
    else { p.ropeS[ee] = cs; p.ropeS[1024 + ee] = sn; }
  }
}

__device__ __forceinline__ void norm_item(const Params& p, int l, int which, int it) {
  const int lane = otid() & 63, wave = otid() >> 6;
  const int row0 = it * 16 + wave * 4;
  float4 v[4][4];
#pragma unroll
  for (int j = 0; j < 4; ++j)
#pragma unroll
    for (int k = 0; k < 4; ++k) v[j][k] = *(const float4*)(p.xres + (size_t)(row0 + j) * 1024 + (k * 64 + lane) * 4);
  float rs[4];
#pragma unroll
  for (int j = 0; j < 4; ++j) {
    float ss = 0.f;
#pragma unroll
    for (int k = 0; k < 4; ++k) ss += v[j][k].x * v[j][k].x + v[j][k].y * v[j][k].y + v[j][k].z * v[j][k].z + v[j][k].w * v[j][k].w;
#pragma unroll
    for (int o = 32; o >= 1; o >>= 1) ss += __shfl_xor(ss, o);
    rs[j] = rsqrtf(ss * (1.f / 1024.f) + 1e-6f);
  }
  if (which < 2) {
    const int cond = row0 < NPTOK ? 0 : 1 + ((row0 - NPTOK) >> 10);
    const float* gp = (which == 0 ? p.norm1_g : p.norm2_g) + l * 1024;
    const float* shp = p.mods + (size_t)(l * 3 + cond) * 6144 + (which * 3 + 0) * 1024;
    const float* scp = shp + 1024;
#pragma unroll
    for (int k = 0; k < 4; ++k) {
      const int col = (k * 64 + lane) * 4;
      const float4 gg = *(const float4*)(gp + col);
      const float4 sh = *(const float4*)(shp + col);
      const float4 sc = *(const float4*)(scp + col);
      const float mx = gg.x * (1.f + sc.x), my = gg.y * (1.f + sc.y), mz = gg.z * (1.f + sc.z), mw = gg.w * (1.f + sc.w);
#pragma unroll
      for (int j = 0; j < 4; ++j) {
        uint2 w;
        w.x = pack2(v[j][k].x * rs[j] * mx + sh.x, v[j][k].y * rs[j] * my + sh.y);
        w.y = pack2(v[j][k].z * rs[j] * mz + sh.z, v[j][k].w * rs[j] * mw + sh.w);
        *(uint2*)(p.h + (size_t)(row0 + j) * 1024 + col) = w;
      }
    }
  } else {
#pragma unroll
    for (int k = 0; k < 4; ++k) {
      const int col = (k * 64 + lane) * 4;
      const float4 gg = *(const float4*)(p.final_g + col);
#pragma unroll
      for (int j = 0; j < 4; ++j) {
        float4 o;
        o.x = v[j][k].x * rs[j] * gg.x; o.y = v[j][k].y * rs[j] * gg.y; o.z = v[j][k].z * rs[j] * gg.z; o.w = v[j][k].w * rs[j] * gg.w;
        *(float4*)(p.out + (size_t)(row0 + j) * 1024 + col) = o;
      }
    }
  }
}

template <bool ZERO, int YT>
__device__ __forceinline__ void gemm_main_t(const u16* __restrict__ X, int ldx, const u16* __restrict__ Y, int ldy, int K,
                                          u16* smem, f32x4 (&acc)[4][YT]) {
  const int tid = otid(), lane = tid & 63, wave = tid >> 6, wx = wave & 1, wy = wave >> 1, r = lane & 15, g = lane >> 4;
  u16* sX = smem;
  u16* sY = smem + 2 * 128 * LSTR;
  const int lrow = tid >> 3, lkc = tid & 7;
  const u16* gx = X + (size_t)lrow * ldx + lkc * 8;
  const u16* gy = Y + (size_t)lrow * ldy + lkc * 8;
  u32x4 rx[4], ry[YT];
#pragma unroll
  for (int i = 0; i < 4; ++i) rx[i] = *(const u32x4*)(gx + (size_t)(32 * i) * ldx);
#pragma unroll
  for (int i = 0; i < YT; ++i) ry[i] = *(const u32x4*)(gy + (size_t)(32 * i) * ldy);
  if (ZERO) {
#pragma unroll
    for (int a = 0; a < 4; ++a)
#pragma unroll
      for (int b = 0; b < YT; ++b) acc[a][b] = (f32x4){0.f, 0.f, 0.f, 0.f};
  }
#pragma unroll
  for (int i = 0; i < 4; ++i) *(u32x4*)(sX + (lrow + 32 * i) * LSTR + lkc * 8) = rx[i];
#pragma unroll
  for (int i = 0; i < YT; ++i) *(u32x4*)(sY + (lrow + 32 * i) * LSTR + lkc * 8) = ry[i];
  __syncthreads();
  const int nk = K >> 6;
  const u16* cx0 = sX + (wx * 64 + r) * LSTR + g * 8;
  const u16* cy0 = sY + (wy * (16 * YT) + r) * LSTR + g * 8;
#define GEMM_COMPUTE(cur)                                                                            \
  {                                                                                                  \
    const u16* cx = cx0 + (cur) * 128 * LSTR;                                                        \
    const u16* cy = cy0 + (cur) * 128 * LSTR;                                                        \
    _Pragma("unroll") for (int kk = 0; kk < 2; ++kk) {                                               \
      bf16x8 a[4], b[YT];                                                                            \
      _Pragma("unroll") for (int i = 0; i < 4; ++i) a[i] = *(const bf16x8*)(cx + i * 16 * LSTR + kk * 32); \
      _Pragma("unroll") for (int i = 0; i < YT; ++i) b[i] = *(const bf16x8*)(cy + i * 16 * LSTR + kk * 32); \
      _Pragma("unroll") for (int xi = 0; xi < 4; ++xi)                                               \
        _Pragma("unroll") for (int yi = 0; yi < YT; ++yi)                                            \
          acc[xi][yi] = __builtin_amdgcn_mfma_f32_16x16x32_bf16(a[xi], b[yi], acc[xi][yi], 0, 0, 0); \
    }                                                                                                \
  }
  u32x4 bx[4], by[YT];
  u16* const w1X = sX + 128 * LSTR + lrow * LSTR + lkc * 8;
  u16* const w1Y = sY + 128 * LSTR + lrow * LSTR + lkc * 8;
  u16* const w0X = sX + lrow * LSTR + lkc * 8;
  u16* const w0Y = sY + lrow * LSTR + lkc * 8;
#pragma unroll 1
  for (int kt = 0; kt + 2 < nk; kt += 2) {
#pragma unroll
    for (int i = 0; i < 4; ++i) gload16(rx[i], gx + (size_t)(32 * i) * ldx + (kt + 1) * 64);
#pragma unroll
    for (int i = 0; i < YT; ++i) gload16(ry[i], gy + (size_t)(32 * i) * ldy + (kt + 1) * 64);
#pragma unroll
    for (int i = 0; i < 4; ++i) gload16(bx[i], gx + (size_t)(32 * i) * ldx + (kt + 2) * 64);
#pragma unroll
    for (int i = 0; i < YT; ++i) gload16(by[i], gy + (size_t)(32 * i) * ldy + (kt + 2) * 64);
    GEMM_COMPUTE(0);
    if (YT == 4) asm volatile("s_waitcnt vmcnt(8)" ::: "memory"); else asm volatile("s_waitcnt vmcnt(7)" ::: "memory");
#pragma unroll
    for (int i = 0; i < 4; ++i) *(u32x4*)(w1X + 32 * i * LSTR) = rx[i];
#pragma unroll
    for (int i = 0; i < YT; ++i) *(u32x4*)(w1Y + 32 * i * LSTR) = ry[i];
    __syncthreads();
    GEMM_COMPUTE(1);
    asm volatile("s_waitcnt vmcnt(0)" ::: "memory");
#pragma unroll
    for (int i = 0; i < 4; ++i) *(u32x4*)(w0X + 32 * i * LSTR) = bx[i];
#pragma unroll
    for (int i = 0; i < YT; ++i) *(u32x4*)(w0Y + 32 * i * LSTR) = by[i];
    __syncthreads();
  }
  {
#pragma unroll
    for (int i = 0; i < 4; ++i) gload16(rx[i], gx + (size_t)(32 * i) * ldx + (nk - 1) * 64);
#pragma unroll
    for (int i = 0; i < YT; ++i) gload16(ry[i], gy + (size_t)(32 * i) * ldy + (nk - 1) * 64);
    GEMM_COMPUTE(0);
    asm volatile("s_waitcnt vmcnt(0)" ::: "memory");
#pragma unroll
    for (int i = 0; i < 4; ++i) *(u32x4*)(w1X + 32 * i * LSTR) = rx[i];
#pragma unroll
    for (int i = 0; i < YT; ++i) *(u32x4*)(w1Y + 32 * i * LSTR) = ry[i];
    __syncthreads();
  }
  GEMM_COMPUTE(1);
  __syncthreads();
#undef GEMM_COMPUTE
}

#ifndef REP_GEMM
#define REP_GEMM 0
#endif
#ifndef REP_MIX
#define REP_MIX 0
#endif
#ifndef REP_SYNC
#define REP_SYNC 0
#endif
#ifndef REP_P0
#define REP_P0 0
#endif
template <int YT>
__device__ __forceinline__ void gemm_main(const u16* __restrict__ X, int ldx, const u16* __restrict__ Y, int ldy, int K,
                                          u16* smem, f32x4 (&acc)[4][YT]) {
  gemm_main_t<true, YT>(X, ldx, Y, ldy, K, smem, acc);
#if REP_GEMM
  gemm_main_t<false, YT>(X, ldx, Y, ldy, K, smem, acc);
#pragma unroll
  for (int a = 0; a < 4; ++a)
#pragma unroll
    for (int b = 0; b < YT; ++b) acc[a][b] *= 0.5f;
#endif
}

__device__ __forceinline__ bool tile_map(int j, int ntx, int& tx, int& ty, int nty = 48) {
  const int nblk = gridDim.x, bid = blockIdx.x;
  if ((nblk & 7) == 0) {
    const int per = nty >> 3;
    const int v = (bid >> 3) + j * (nblk >> 3);
    if (v >= per * ntx) return false;
    tx = v / per; ty = per * (bid & 7) + v % per;
    return true;
  } else {
    const int it = bid + j * nblk;
    if (it >= nty * ntx) return false;
    tx = it / nty; ty = it % nty;
    return true;
  }
}

__device__ void gin_tile(const Params& p, int l, int tx, int ty, u16* smem) {
  const int n0 = tx * 128, m0 = ty * 128;
  f32x4 acc[4][4];
  gemm_main<4>(p.w_inT + (size_t)l * 2304 * 1024 + (size_t)n0 * 1024, 1024, p.h + (size_t)m0 * 1024, 1024, 1024, smem, acc);
  const int lane = otid() & 63, wave = otid() >> 6, wx = wave & 1, wy = wave >> 1, r = lane & 15, g = lane >> 4;
  const int nw = n0 + wx * 64;
  const bool isS = m0 >= NPTOK;
  int ropeMode = 0;
  if (isS) {
    if (nw >= 768 && nw < 1280) ropeMode = 1;
    else if (nw >= 1792 && nw < 2176) ropeMode = 2;
  }
  float* okv = nullptr; int okv_w = 0, okv_c = 0;
  if (!isS) {
    if (nw >= 256 && nw < 512) { okv = p.out + O_NAK; okv_w = 256; okv_c = nw - 256; }
    else if (nw >= 512 && nw < 768) { okv = p.out + O_NAV; okv_w = 256; okv_c = nw - 512; }
    else if (nw >= 1024 && nw < 1280) { okv = p.out + O_DK; okv_w = 256; okv_c = nw - 1024; }
    else if (nw >= 1280 && nw < 1536) { okv = p.out + O_DV; okv_w = 256; okv_c = nw - 1280; }
    else if (nw >= 2048 && nw < 2176) { okv = p.out + O_SK; okv_w = 128; okv_c = nw - 2048; }
    else if (nw >= 2176) { okv = p.out + O_SV; okv_w = 128; okv_c = nw - 2176; }
  }
  int khh = -1;
  if (nw >= 256 && nw < 512) khh = (nw - 256) >> 6;
  else if (nw >= 1024 && nw < 1280) khh = 4 + ((nw - 1024) >> 6);
  else if (nw >= 2048 && nw < 2176) khh = 8 + ((nw - 2048) >> 6);
  int vrow = -1;
  if (nw >= 512 && nw < 768) vrow = nw - 512;
  else if (nw >= 1280 && nw < 1536) vrow = 256 + nw - 1280;
  else if (nw >= 2176) vrow = 512 + nw - 2176;
#pragma unroll
  for (int yi = 0; yi < 4; ++yi) {
    const int m = m0 + wy * 64 + yi * 16 + r;
    const int t = (m - NPTOK) & 1023;
    const int prow = t >> 6, pcol = t & 63;
#pragma unroll
    for (int xi = 0; xi < 4; ++xi) {
      f32x4 v = acc[xi][yi];
      if (ropeMode == 1) {
        const int pos = (xi & 1) ? pcol : prow;
        const float4 cs = *(const float4*)(p.ropeD + pos * 8 + 4 * (g & 1));
        const float4 sn = *(const float4*)(p.ropeD + 512 + pos * 8 + 4 * (g & 1));
        const float sg = (g >= 2) ? 1.f : -1.f;
        const float o0 = __shfl_xor(v[0], 32), o1 = __shfl_xor(v[1], 32), o2 = __shfl_xor(v[2], 32), o3 = __shfl_xor(v[3], 32);
        v[0] = v[0] * cs.x + sg * o0 * sn.x; v[1] = v[1] * cs.y + sg * o1 * sn.y;
        v[2] = v[2] * cs.z + sg * o2 * sn.z; v[3] = v[3] * cs.w + sg * o3 * sn.w;
      } else if (ropeMode == 2) {
        const int pos = (xi >> 1) ? pcol : prow;
        const float4 cs = *(const float4*)(p.ropeS + pos * 16 + 4 * g);
        const float4 sn = *(const float4*)(p.ropeS + 1024 + pos * 16 + 4 * g);
        const f32x4 o = acc[xi ^ 1][yi];
        const float sg = (xi & 1) ? 1.f : -1.f;
        v[0] = v[0] * cs.x + sg * o[0] * sn.x; v[1] = v[1] * cs.y + sg * o[1] * sn.y;
        v[2] = v[2] * cs.z + sg * o[2] * sn.z; v[3] = v[3] * cs.w + sg * o[3] * sn.w;
      }
      const int nloc = xi * 16 + 4 * g;
      if (okv) {
        const int b = m >> 8, pos = m & 255;
        float4 o4; o4.x = v[0]; o4.y = v[1]; o4.z = v[2]; o4.w = v[3];
        *(float4*)(okv + ((size_t)((b * 4 + l) * 256 + pos)) * okv_w + okv_c + nloc) = o4;
      }
      if (vrow >= 0) {
        u16* vb = p.vfr + ((size_t)((vrow >> 6) * 192 + (m >> 5))) * 2048;
#pragma unroll
        for (int i = 0; i < 4; ++i) vb[vfrag_off(m & 31, nloc + i)] = f2bf(v[i]);
      } else if (khh >= 0) {
        uint2 w; w.x = pack2(v[0], v[1]); w.y = pack2(v[2], v[3]);
        *(uint2*)(p.kfr + ((size_t)(khh * 192 + (m >> 5))) * 2048 + kfrag_off(m & 31, nloc)) = w;
      } else {
        uint2 w; w.x = pack2(v[0], v[1]); w.y = pack2(v[2], v[3]);
        *(uint2*)(p.z + (size_t)m * INW + nw + nloc) = w;
      }
    }
  }
}

__device__ void res_tile(const Params& p, int l, int tx, int ty, const u16* A, const u16* WT, int K, int gi, u16* smem) {
  const int n0 = tx * 128, m0 = ty * 96;
  f32x4 acc[4][3];
  gemm_main<3>(WT + (size_t)n0 * K, K, A + (size_t)m0 * K, K, K, smem, acc);
  const int lane = otid() & 63, wave = otid() >> 6, wx = wave & 1, wy = wave >> 1, r = lane & 15, g = lane >> 4;
#pragma unroll
  for (int yi = 0; yi < 3; ++yi) {
    const int m = m0 + wy * 48 + yi * 16 + r;
    const int cond = m < NPTOK ? 0 : 1 + ((m - NPTOK) >> 10);
    const float* gate = p.mods + (size_t)(l * 3 + cond) * 6144 + gi * 1024;
    float* xrow = p.xres + (size_t)m * 1024;
    float4 xv[4], gt[4];
#pragma unroll
    for (int xi = 0; xi < 4; ++xi) {
      const int n = n0 + wx * 64 + xi * 16 + 4 * g;
      xv[xi] = *(const float4*)(xrow + n);
      gt[xi] = *(const float4*)(gate + n);
    }
#pragma unroll
    for (int xi = 0; xi < 4; ++xi) {
      const int n = n0 + wx * 64 + xi * 16 + 4 * g;
      const f32x4 v = acc[xi][yi];
      float4 o = xv[xi];
      o.x += gt[xi].x * v[0]; o.y += gt[xi].y * v[1]; o.z += gt[xi].z * v[2]; o.w += gt[xi].w * v[3];
      *(float4*)(xrow + n) = o;
    }
  }
}

__device__ void m1_tile(const Params& p, int l, int tx, int ty, u16* smem) {
  const int n0 = tx * 128, m0 = ty * 128;
  f32x4 acc[4][4];
  gemm_main<4>(p.w1T + (size_t)l * 4096 * 1024 + (size_t)n0 * 1024, 1024, p.h + (size_t)m0 * 1024, 1024, 1024, smem, acc);
  const int lane = otid() & 63, wave = otid() >> 6, wx = wave & 1, wy = wave >> 1, r = lane & 15, g = lane >> 4;
#pragma unroll
  for (int xi = 0; xi < 4; ++xi) {
    const int n = n0 + wx * 64 + xi * 16 + 4 * g;
#pragma unroll
    for (int yi = 0; yi < 4; ++yi) {
      const int m = m0 + wy * 64 + yi * 16 + r;
      const f32x4 v = acc[xi][yi];
      float a0 = fmaxf(v[0], 0.f), a1 = fmaxf(v[1], 0.f), a2 = fmaxf(v[2], 0.f), a3 = fmaxf(v[3], 0.f);
      uint2 w; w.x = pack2(a0 * a0, a1 * a1); w.y = pack2(a2 * a2, a3 * a3);
      *(uint2*)(p.u + (size_t)m * 4096 + n) = w;
    }
  }
}

__device__ void f1_tile(const Params& p, int l, int it, u16* smem) {
  const int tx = it % 48, ty = it / 48;
  const int x0 = tx * 128, y0 = ty * 128;
  f32x4 acc[4][4];
  gemm_main<4>(p.z + (size_t)x0 * INW + 1536, INW, p.pqt + (size_t)l * 512 * 256 + (size_t)y0 * 256, 256, 256, smem, acc);
  const int lane = otid() & 63, wave = otid() >> 6, wx = wave & 1, wy = wave >> 1, r = lane & 15, g = lane >> 4;
#pragma unroll
  for (int yi = 0; yi < 4; ++yi) {
    const int y = y0 + wy * 64 + yi * 16 + r;
    const int col = y & 255, which = y >> 8;
#pragma unroll
    for (int xi = 0; xi < 4; ++xi) {
      const int tok = x0 + wx * 64 + xi * 16 + 4 * g;
      size_t addr;
      if (tok < NPTOK) {
        const int b = tok >> 8, pos = tok & 255;
        addr = (size_t)b * (256 * 512) + (size_t)col * 512 + which * 256 + pos;
      } else {
        const int b = (tok - NPTOK) >> 10, pos = (tok - NPTOK) & 1023;
        addr = (size_t)16 * 256 * 512 + (size_t)b * (256 * 2048) + (size_t)col * 2048 + which * 1024 + pos;
      }
      const f32x4 v = acc[xi][yi];
      uint2 w; w.x = pack2(v[0], v[1]); w.y = pack2(v[2], v[3]);
      *(uint2*)(p.uv + addr) = w;
    }
  }
}

__device__ void f2_tile(const Params& p, int it, u16* smem) {
  int L, b, tx, ty, tokbase;
  const u16* uvb; const u16* dft;
  if (it < 32) { L = 1024; b = it >> 4; tx = (it >> 3) & 1; ty = it & 7; uvb = p.uv + (size_t)16 * 256 * 512 + (size_t)b * (256 * 2048); dft = p.dft1024; tokbase = NPTOK + b * 1024; }
  else { it -= 32; L = 256; b = it >> 2; tx = (it >> 1) & 1; ty = it & 1; uvb = p.uv + (size_t)b * (256 * 512); dft = p.dft256; tokbase = b * 256; }
  const int x0 = tx * 128, y0 = ty * 128, K = 2 * L;
  f32x4 acc[4][4];
  gemm_main<4>(uvb + (size_t)x0 * K, K, dft + (size_t)y0 * K, K, K, smem, acc);
  const int lane = otid() & 63, wave = otid() >> 6, wx = wave & 1, wy = wave >> 1, r = lane & 15, g = lane >> 4;
  const float scale = rsqrtf(64.f * (float)L);
#pragma unroll
  for (int yi = 0; yi < 4; ++yi) {
    const int pos = y0 + wy * 64 + yi * 16 + r;
#pragma unroll
    for (int xi = 0; xi < 4; ++xi) {
      const int col = x0 + wx * 64 + xi * 16 + 4 * g;
      const f32x4 v = acc[xi][yi];
      uint2 w; w.x = pack2(v[0] * scale, v[1] * scale); w.y = pack2(v[2] * scale, v[3] * scale);
      *(uint2*)(p.cat + (size_t)(tokbase + pos) * 1024 + 512 + col) = w;
    }
  }
}

struct Seg { const u16* K; const u16* Vt; int ldk, ldv, nblk, pos0, stride; };
#define KLOC(hh, tokb) (p.kfr + ((size_t)((hh) * 192 + ((tokb) >> 5))) * 2048)
#define VLOC(hh, tokb) (p.vfr + ((size_t)((hh) * 192 + ((tokb) >> 5))) * 2048)
template <int QT> struct AState { float m[QT]; float ls[QT]; f32x4 o[QT][4]; };

__device__ __forceinline__ bf16x8 as_bf(u32x4 v) { union { u32x4 u; bf16x8 b; } x; x.u = v; return x.b; }

template <int DC>
__device__ __forceinline__ void issue_blk(const Seg& s0, const Seg& s1, int b, int r, int g, u32x4 (&kf)[2][DC], u32x4 (&vf)[4]) {
  const bool in0 = b < s0.nblk;
  const u16* Kp = in0 ? s0.K : s1.K;
  const u16* Vp = in0 ? s0.Vt : s1.Vt;
  const int pos = in0 ? (s0.pos0 + b * s0.stride) : (s1.pos0 + (b - s0.nblk) * s1.stride);
  const int lane8 = (g * 16 + r) * 8;
  const u16* kp = Kp + (size_t)(pos >> 5) * 2048 + lane8;
  const u16* vp = Vp + (size_t)(pos >> 5) * 2048 + lane8;
#pragma unroll
  for (int t = 0; t < 2; ++t)
#pragma unroll
    for (int dc = 0; dc < DC; ++dc) gload16(kf[t][dc], kp + (t * 2 + dc) * 512);
#pragma unroll
  for (int dv = 0; dv < 4; ++dv) gload16(vf[dv], vp + dv * 512);
}
template <int N>
__device__ __forceinline__ void wait_blk(u32x4 (&kf)[2][1], u32x4 (&vf)[4]) {
  asm volatile("s_waitcnt vmcnt(%6)" : "+v"(kf[0][0]), "+v"(kf[1][0]), "+v"(vf[0]), "+v"(vf[1]), "+v"(vf[2]), "+v"(vf[3]) : "n"(N) : "memory");
}
template <int N>
__device__ __forceinline__ void wait_blk(u32x4 (&kf)[2][2], u32x4 (&vf)[4]) {
  asm volatile("s_waitcnt vmcnt(%8)" : "+v"(kf[0][0]), "+v"(kf[0][1]), "+v"(kf[1][0]), "+v"(kf[1][1]), "+v"(vf[0]), "+v"(vf[1]), "+v"(vf[2]), "+v"(vf[3]) : "n"(N) : "memory");
}

template <int D, int QT, int MODE>
__device__ __forceinline__ void attn_compute(const u32x4 (&kc)[2][D / 32], const u32x4 (&vc)[4], const bf16x8 (&qf)[QT][D / 32], const float sc,
                                             AState<QT>& st, const bool in0, const int pos, const int qpos0, const float* __restrict__ rpb_h,
                                             const int r, const int g) {
  constexpr int DC = D / 32;
#pragma unroll
  for (int q = 0; q < QT; ++q) {
    f32x4 s_[2];
    s_[0] = (f32x4){0.f, 0.f, 0.f, 0.f};
    s_[1] = (f32x4){0.f, 0.f, 0.f, 0.f};
#pragma unroll
    for (int t = 0; t < 2; ++t)
#pragma unroll
      for (int dc = 0; dc < DC; ++dc) s_[t] = __builtin_amdgcn_mfma_f32_16x16x32_bf16(as_bf(kc[t][dc]), qf[q][dc], s_[t], 0, 0, 0);
    float sv[8];
#pragma unroll
    for (int t = 0; t < 2; ++t)
#pragma unroll
      for (int i = 0; i < 4; ++i) {
        float x = s_[t][i] * sc;
        if (MODE == 1) {
          if (!in0) {
            const int qpos = qpos0 + q * 16 + r;
            const int qrow = qpos >> 6, cq = qpos & 63;
            const int kpos = pos + 8 * g + 4 * t + i;
            const int krow = kpos >> 6, ck = kpos & 63;
            const int cs = min(max(cq - 8, 0), 48);
            const bool valid = (ck >= cs) && (ck < cs + 16);
            const int bi = (krow - qrow + 7) * 31 + (ck - cq + 15);
            const float bias = valid ? rpb_h[bi] : 0.f;
            x = valid ? (x + bias * LOG2E) : -1e30f;
          }
        } else if (MODE == 2) {
          if (!in0) {
            const int qpos = qpos0 + q * 16 + r;
            const int kpos = pos + 8 * g + 4 * t + i;
            const int d = qpos - kpos;
            x = (d <= 128 && d >= -128) ? x : -1e30f;
          }
        }
        sv[4 * t + i] = x;
      }
    float mx = fmaxf(fmaxf(fmaxf(sv[0], sv[1]), fmaxf(sv[2], sv[3])), fmaxf(fmaxf(sv[4], sv[5]), fmaxf(sv[6], sv[7])));
    mx = fmaxf(mx, __shfl_xor(mx, 16));
    mx = fmaxf(mx, __shfl_xor(mx, 32));
    const float mnew = fmaxf(st.m[q], mx);
    const float alpha = __builtin_amdgcn_exp2f(st.m[q] - mnew);
    st.m[q] = mnew;
    float ps = 0.f;
#pragma unroll
    for (int j = 0; j < 8; ++j) { sv[j] = __builtin_amdgcn_exp2f(sv[j] - mnew); ps += sv[j]; }
    st.ls[q] = st.ls[q] * alpha + ps;
    union { bf16x8 v; unsigned w[4]; } pf;
    pf.w[0] = pack2(sv[0], sv[1]); pf.w[1] = pack2(sv[2], sv[3]); pf.w[2] = pack2(sv[4], sv[5]); pf.w[3] = pack2(sv[6], sv[7]);
#pragma unroll
    for (int dv = 0; dv < 4; ++dv) {
      f32x4 o = st.o[q][dv];
      o[0] *= alpha; o[1] *= alpha; o[2] *= alpha; o[3] *= alpha;
      st.o[q][dv] = __builtin_amdgcn_mfma_f32_16x16x32_bf16(as_bf(vc[dv]), pf.v, o, 0, 0, 0);
    }
  }
}

template <int D, int QT, int MODE, int NQ = 2>
__device__ __forceinline__ void attn_run(const Seg& s0, const Seg& s1, const bf16x8 (&qf)[QT][D / 32], const float sc,
                                         AState<QT>& st, const int qpos0, const float* __restrict__ rpb_h, const int bb = 0, const int be = -1) {
  constexpr int DC = D / 32;
  constexpr int NL = 2 * DC + 4;
  const int lane = otid() & 63, r = lane & 15, g = lane >> 4;
  const int nb = be < 0 ? s0.nblk + s1.nblk : be;
  u32x4 kq[NQ][2][DC], vq[NQ][4];
#pragma unroll
  for (int q = 0; q < QT; ++q)
#pragma unroll
    for (int dc = 0; dc < DC; ++dc) asm volatile("" ::"v"(qf[q][dc]));
  asm volatile("s_waitcnt vmcnt(0)" ::: "memory");
#pragma unroll 1
  for (int b = bb; b < nb; b += NQ) {
#pragma unroll
    for (int j = 0; j < NQ; ++j) issue_blk<DC>(s0, s1, b + j, r, g, kq[j], vq[j]);
#pragma unroll
    for (int j = 0; j < NQ; ++j) {
      if (j == 0) wait_blk<(NQ - 1) * NL>(kq[j], vq[j]);
      else if (j == 1) wait_blk<(NQ - 2) * NL>(kq[j], vq[j]);
      else if (j == 2) wait_blk<(NQ > 3 ? (NQ - 3) * NL : 0)>(kq[j], vq[j]);
      else wait_blk<0>(kq[j], vq[j]);
      const int bj = b + j;
      const bool in0 = bj < s0.nblk;
      const int pos = in0 ? (s0.pos0 + bj * s0.stride) : (s1.pos0 + (bj - s0.nblk) * s1.stride);
      attn_compute<D, QT, MODE>(kq[j], vq[j], qf, sc, st, in0, pos, qpos0, rpb_h, r, g);
    }
  }
}

template <int QT>
__device__ __forceinline__ void astate_init(AState<QT>& st, float m0, float l0) {
#pragma unroll
  for (int q = 0; q < QT; ++q) {
    st.m[q] = m0; st.ls[q] = l0;
#pragma unroll
    for (int dv = 0; dv < 4; ++dv) st.o[q][dv] = (f32x4){0.f, 0.f, 0.f, 0.f};
  }
}
template <int QT>
__device__ __forceinline__ void astate_finalize(AState<QT>& st) {
#pragma unroll
  for (int q = 0; q < QT; ++q) {
    float l = st.ls[q];
    l += __shfl_xor(l, 16);
    l += __shfl_xor(l, 32);
    const float inv = 1.f / l;
#pragma unroll
    for (int dv = 0; dv < 4; ++dv) { st.o[q][dv][0] *= inv; st.o[q][dv][1] *= inv; st.o[q][dv][2] *= inv; st.o[q][dv][3] *= inv; }
  }
}
template <int DC, int QT>
__device__ __forceinline__ void load_q(const u16* zq  , bf16x8 (&qf)[QT][DC]) {
  const int lane = otid() & 63, r = lane & 15, g = lane >> 4;
#pragma unroll
  for (int q = 0; q < QT; ++q)
#pragma unroll
    for (int dc = 0; dc < DC; ++dc) qf[q][dc] = *(const bf16x8*)(zq + (size_t)(q * 16 + r) * INW + dc * 32 + g * 8);
}
template <int QT>
__device__ __forceinline__ void write_o(const Params& p, const AState<QT>& st, int tok0, int col0) {
  const int lane = otid() & 63, r = lane & 15, g = lane >> 4;
#pragma unroll
  for (int q = 0; q < QT; ++q)
#pragma unroll
    for (int dv = 0; dv < 4; ++dv) {
      const f32x4 v = st.o[q][dv];
      uint2 w; w.x = pack2(v[0], v[1]); w.y = pack2(v[2], v[3]);
      *(uint2*)(p.cat + (size_t)(tok0 + q * 16 + r) * 1024 + col0 + dv * 16 + 4 * g) = w;
    }
}

__device__ __forceinline__ float diff_lambda(const Params& p, int l, float lam_init) {
  const int lane = otid() & 63;
  float a = 0.f, b = 0.f;
  if (lane < 32) { a = p.lq1[l * 32 + lane] * p.lk1[l * 32 + lane]; b = p.lq2[l * 32 + lane] * p.lk2[l * 32 + lane]; }
#pragma unroll
  for (int o = 32; o >= 1; o >>= 1) { a += __shfl_xor(a, o); b += __shfl_xor(b, o); }
  return expf(a) - expf(b) + lam_init;
}

__device__ __forceinline__ void diff_finish_q(const Params& p, int l, float lam, float lam_init, f32x4 (&A)[4], const f32x4 (&B)[4], int tokrow0, int col0) {
  const int lane = otid() & 63, r = lane & 15, g = lane >> 4;
  const float* sg = p.subln_g + l * 64;
  float ss = 0.f;
#pragma unroll
  for (int dv = 0; dv < 4; ++dv)
#pragma unroll
    for (int i = 0; i < 4; ++i) {
      const float v = A[dv][i] - lam * B[dv][i];
      A[dv][i] = v;
      ss += v * v;
    }
  ss += __shfl_xor(ss, 16);
  ss += __shfl_xor(ss, 32);
  const float rs = rsqrtf(ss * (1.f / 64.f) + 1e-6f) * (1.f - lam_init);
#pragma unroll
  for (int dv = 0; dv < 4; ++dv) {
    const float4 gg = *(const float4*)(sg + dv * 16 + 4 * g);
    uint2 w;
    w.x = pack2(A[dv][0] * rs * gg.x, A[dv][1] * rs * gg.y);
    w.y = pack2(A[dv][2] * rs * gg.z, A[dv][3] * rs * gg.w);
    *(uint2*)(p.cat + (size_t)(tokrow0 + r) * 1024 + col0 + dv * 16 + 4 * g) = w;
  }
}

#ifndef AQT
#define AQT 2
#endif
#define QW (16 * AQT)
#define NQG_CTX (256 / QW)
#define NQG_LAT (1024 / QW)
__device__ void attn_diff_item(const Params& p, int l, bool lat, int bi, float* sm) {
  const int wave = otid() >> 6, lane = otid() & 63, r = lane & 15, g = lane >> 4;
  const int ps = wave >> 1, half = wave & 1;
  int b, h, qg, tokb;
  if (lat) { b = bi / (4 * NQG_LAT); h = (bi / NQG_LAT) & 3; qg = bi % NQG_LAT; tokb = NPTOK + b * 1024; }
  else { b = bi / (4 * NQG_CTX); h = (bi / NQG_CTX) & 3; qg = bi % NQG_CTX; tokb = b * 256; }
  const int tok0 = tokb + qg * QW;
  const u16* zb = p.z + (size_t)tokb * INW;
  Seg s0, s1;
  if (lat) {
    const int bl = b * 4 + l;
    s0.K = p.ck_diff + (size_t)((bl * 4 + h) * 16) * 2048 + ps * 512; s0.Vt = p.cvt_diff + (size_t)((bl * 4 + h) * 16) * 2048;
    s0.ldk = 0; s0.ldv = 0; s0.nblk = half ? 0 : 16; s0.pos0 = 0; s0.stride = 32;
    s1.K = KLOC(4 + h, tokb) + ps * 512; s1.Vt = VLOC(4 + h, tokb);
    s1.ldk = 0; s1.ldv = 0; s1.nblk = half ? 24 : 8; s1.pos0 = half ? 256 : 0; s1.stride = 32;
  } else {
    s0.K = KLOC(4 + h, tokb) + ps * 512; s0.Vt = VLOC(4 + h, tokb);
    s0.ldk = 0; s0.ldv = 0; s0.nblk = 4; s0.pos0 = half ? 128 : 0; s0.stride = 32;
    s1 = s0; s1.nblk = 0;
  }
  bf16x8 qf[AQT][1];
  load_q<1, AQT>(p.z + (size_t)tok0 * INW + 768 + h * 64 + ps * 32, qf);
  AState<AQT> st;
  astate_init<AQT>(st, -1e30f, 0.f);
  attn_run<32, AQT, 0, 4>(s0, s1, qf, 0.17677669529663687f * LOG2E, st, 0, nullptr);
  float lt[AQT];
#pragma unroll
  for (int q = 0; q < AQT; ++q) {
    lt[q] = st.ls[q];
    lt[q] += __shfl_xor(lt[q], 16);
    lt[q] += __shfl_xor(lt[q], 32);
  }
  constexpr int WS = 64 * 16 * AQT;
  float* pm = sm + 4 * WS;
  if (wave != 0) {
    float* po = sm + wave * WS + lane * (16 * AQT);
#pragma unroll
    for (int q = 0; q < AQT; ++q) {
#pragma unroll
      for (int dv = 0; dv < 4; ++dv) *(f32x4*)(po + q * 16 + dv * 4) = st.o[q][dv];
      if (g == 0) { pm[wave * QW + q * 16 + r] = st.m[q]; pm[4 * QW + wave * QW + q * 16 + r] = lt[q]; }
    }
  }
  __syncthreads();
  if (wave == 0) {
    const float lam_init = 0.8f - 0.6f * expf(-0.3f * (float)l);
    const float lam = diff_lambda(p, l, lam_init);
#pragma unroll
    for (int q = 0; q < AQT; ++q) {
      f32x4 A[4], B[4];
      {
        const float m1 = pm[QW + q * 16 + r], l1 = pm[4 * QW + QW + q * 16 + r];
        const float M = fmaxf(st.m[q], m1);
        const float a0 = exp2f(st.m[q] - M), a1 = exp2f(m1 - M);
        const float inv = 1.f / (lt[q] * a0 + l1 * a1);
#pragma unroll
        for (int dv = 0; dv < 4; ++dv) {
          const f32x4 o1 = *(const f32x4*)(sm + 1 * WS + lane * (16 * AQT) + q * 16 + dv * 4);
          A[dv] = (st.o[q][dv] * a0 + o1 * a1) * inv;
        }
      }
      {
        const float m2 = pm[2 * QW + q * 16 + r], l2 = pm[4 * QW + 2 * QW + q * 16 + r], m3 = pm[3 * QW + q * 16 + r], l3 = pm[4 * QW + 3 * QW + q * 16 + r];
        const float M = fmaxf(m2, m3);
        const float a2 = exp2f(m2 - M), a3 = exp2f(m3 - M);
        const float inv = 1.f / (l2 * a2 + l3 * a3);
#pragma unroll
        for (int dv = 0; dv < 4; ++dv) {
          const f32x4 o2 = *(const f32x4*)(sm + 2 * WS + lane * (16 * AQT) + q * 16 + dv * 4);
          const f32x4 o3 = *(const f32x4*)(sm + 3 * WS + lane * (16 * AQT) + q * 16 + dv * 4);
          B[dv] = (o2 * a2 + o3 * a3) * inv;
        }
      }
      diff_finish_q(p, l, lam, lam_init, A, B, tok0 + q * 16, 256 + h * 64);
    }
  }
  __syncthreads();
}

__device__ void attn_ctx_item(const Params& p, int l, int bi) {
  const int wave = otid() >> 6, lane = otid() & 63, g = lane >> 4;
  const int w = bi * 4 + wave;
  const int type = w / (64 * NQG_CTX), rem = w % (64 * NQG_CTX);
  const int b = rem / (4 * NQG_CTX), h = (rem / NQG_CTX) & 3, qg = rem % NQG_CTX;
  const int tokb = b * 256, tok0 = tokb + qg * QW;
  const u16* zb = p.z + (size_t)tokb * INW;
  const int kvh = h >> 1;
  const int qcol = type == 0 ? h * 64 : 1792 + h * 64;
  const int kcol = type == 0 ? 256 + h * 64 : 2048 + kvh * 64;
  const int vrow = type == 0 ? h * 64 : 512 + kvh * 64;
  const int ocol = type == 0 ? h * 64 : 768 + h * 64;
  bf16x8 qf[AQT][2];
  load_q<2, AQT>(p.z + (size_t)tok0 * INW + qcol, qf);
  const int hslot = type == 0 ? h : 8 + kvh;
  Seg s0; s0.K = KLOC(hslot, tokb); s0.Vt = VLOC(hslot, tokb); s0.ldk = 0; s0.ldv = 0; s0.nblk = 8; s0.pos0 = 0; s0.stride = 32;
  Seg sN = s0; sN.nblk = 0;
  AState<AQT> st;
  const float sk = type == 0 ? -1e30f : p.swa_sink[l * 4 + h] * LOG2E;
  astate_init<AQT>(st, sk, (type == 1 && g == 0) ? 1.f : 0.f);
  attn_run<64, AQT, 0, 2>(s0, sN, qf, 0.125f * LOG2E, st, 0, nullptr);
  astate_finalize<AQT>(st);
  write_o<AQT>(p, st, tok0, ocol);
}

__device__ void attn_lat_item(const Params& p, int l, int bi, float* sm) {
  const int wave = otid() >> 6, lane = otid() & 63, r = lane & 15, g = lane >> 4;
  const int type = bi / (8 * NQG_LAT), rem = bi % (8 * NQG_LAT);
  const int b = rem / (4 * NQG_LAT), h = (rem / NQG_LAT) & 3, qg = rem % NQG_LAT;
  const int q0 = qg * QW;
  const int tokb = NPTOK + b * 1024, tok0 = tokb + q0;
  const u16* zb = p.z + (size_t)tokb * INW;
  const int bl = b * 4 + l;
  AState<AQT> st;
  int ocol;
  if (type == 0) {
    const int kvh = h >> 1;
    bf16x8 qf[AQT][2];
    load_q<2, AQT>(p.z + (size_t)tok0 * INW + 1792 + h * 64, qf);
    Seg s0; s0.K = p.ck_swa + (size_t)((bl * 2 + kvh) * 16) * 2048; s0.Vt = p.cvt_swa + (size_t)((bl * 2 + kvh) * 16) * 2048; s0.ldk = 0; s0.ldv = 0; s0.nblk = 16; s0.pos0 = 0; s0.stride = 32;
    const int lo = max(0, q0 - 128) & ~31;
    const int hi = min(1024, ((q0 + QW + 128) + 31) & ~31);
    int lo2 = lo, cnt = (hi - lo) >> 5;
    if (cnt & 1) { if (lo2 > 0) lo2 -= 32; ++cnt; }
    Seg s1; s1.K = KLOC(8 + kvh, tokb); s1.Vt = VLOC(8 + kvh, tokb); s1.ldk = 0; s1.ldv = 0; s1.nblk = cnt; s1.pos0 = lo2; s1.stride = 32;
    const int P = (16 + cnt) >> 1;
    const int pb = (wave * P) >> 2, pe = ((wave + 1) * P) >> 2;
    astate_init<AQT>(st, wave == 0 ? p.swa_sink[l * 4 + h] * LOG2E : -1e30f, (wave == 0 && g == 0) ? 1.f : 0.f);
    attn_run<64, AQT, 2>(s0, s1, qf, 0.125f * LOG2E, st, q0, nullptr, 2 * pb, 2 * pe);
    ocol = 768 + h * 64;
  } else {
    bf16x8 qf[AQT][2];
    load_q<2, AQT>(p.z + (size_t)tok0 * INW + h * 64, qf);
    Seg s0; s0.K = p.ck_na + (size_t)((bl * 4 + h) * 16) * 2048; s0.Vt = p.cvt_na + (size_t)((bl * 4 + h) * 16) * 2048; s0.ldk = 0; s0.ldv = 0; s0.nblk = 16; s0.pos0 = 0; s0.stride = 32;
    const int qrow = q0 >> 6;
    const int rstart = min(max(qrow - 4, 0), 8);
    Seg s1; s1.K = KLOC(h, tokb); s1.Vt = VLOC(h, tokb); s1.ldk = 0; s1.ldv = 0; s1.nblk = 16; s1.pos0 = rstart * 64; s1.stride = 32;
    astate_init<AQT>(st, -1e30f, 0.f);
    attn_run<64, AQT, 1, 2>(s0, s1, qf, 0.125f * LOG2E, st, q0, p.na_rpb + (size_t)(l * 4 + h) * 15 * 31, 8 * wave, 8 * wave + 8);
    ocol = h * 64;
  }
  float lt[AQT];
#pragma unroll
  for (int q = 0; q < AQT; ++q) {
    lt[q] = st.ls[q];
    lt[q] += __shfl_xor(lt[q], 16);
    lt[q] += __shfl_xor(lt[q], 32);
  }
  constexpr int WS = 64 * 16 * AQT;
  float* pm = sm + 4 * WS;
  if (wave != 0) {
    float* po = sm + wave * WS + lane * (16 * AQT);
#pragma unroll
    for (int q = 0; q < AQT; ++q) {
#pragma unroll
      for (int dv = 0; dv < 4; ++dv) *(f32x4*)(po + q * 16 + dv * 4) = st.o[q][dv];
      if (g == 0) { pm[wave * QW + q * 16 + r] = st.m[q]; pm[4 * QW + wave * QW + q * 16 + r] = lt[q]; }
    }
  }
  __syncthreads();
  if (wave == 0) {
#pragma unroll
    for (int q = 0; q < AQT; ++q) {
      const float m1 = pm[1 * QW + q * 16 + r], m2 = pm[2 * QW + q * 16 + r], m3 = pm[3 * QW + q * 16 + r];
      const float l1 = pm[4 * QW + 1 * QW + q * 16 + r], l2 = pm[4 * QW + 2 * QW + q * 16 + r], l3 = pm[4 * QW + 3 * QW + q * 16 + r];
      const float M = fmaxf(fmaxf(st.m[q], m1), fmaxf(m2, m3));
      const float a0 = __builtin_amdgcn_exp2f(st.m[q] - M), a1 = __builtin_amdgcn_exp2f(m1 - M), a2 = __builtin_amdgcn_exp2f(m2 - M), a3 = __builtin_amdgcn_exp2f(m3 - M);
      const float inv = 1.f / (lt[q] * a0 + l1 * a1 + l2 * a2 + l3 * a3);
#pragma unroll
      for (int dv = 0; dv < 4; ++dv) {
        const f32x4 o1 = *(const f32x4*)(sm + 1 * WS + lane * (16 * AQT) + q * 16 + dv * 4);
        const f32x4 o2 = *(const f32x4*)(sm + 2 * WS + lane * (16 * AQT) + q * 16 + dv * 4);
        const f32x4 o3 = *(const f32x4*)(sm + 3 * WS + lane * (16 * AQT) + q * 16 + dv * 4);
        st.o[q][dv] = (st.o[q][dv] * a0 + o1 * a1 + o2 * a2 + o3 * a3) * inv;
      }
    }
    write_o<AQT>(p, st, tok0, ocol);
  }
  __syncthreads();
}

#define XB_TMO      128
#define XB_XCNT(j)  (256  + 64 * (j))
#define XB_XSUB(j)  (1280 + 64 * (j))
#define XB_XGEN(j)  (2304 + 64 * (j))
#define XB_TOP      3328
#define XB_TOPGEN   3392
#define XCD_BAR_WORDS 3456
#define XB_SPIN_CAP (1u << 22)
#define LAS __attribute__((address_space(3)))
__device__ __forceinline__ unsigned xb_ld(unsigned* p)              { return __hip_atomic_load(p, __ATOMIC_RELAXED, __HIP_MEMORY_SCOPE_AGENT); }
__device__ __forceinline__ unsigned xb_add(unsigned* p, unsigned v) { return __hip_atomic_fetch_add(p, v, __ATOMIC_RELAXED, __HIP_MEMORY_SCOPE_AGENT); }
__device__ __forceinline__ unsigned xb_xcc_id() { return (unsigned)__builtin_amdgcn_s_getreg((3 << 11) | 20) & 0xFu; }
#define XB_SPIN(cond, bar) do { unsigned _sp = 0; while (cond) { __builtin_amdgcn_s_sleep(1); \
    if ((++_sp & 255u) == 0u) { if (xb_ld(&(bar)[XB_TMO])) break; if (_sp > XB_SPIN_CAP) { atomicAdd(&(bar)[XB_TMO], 1u); break; } } } } while (0)
struct XcdBarrier { unsigned* bar; unsigned x; volatile LAS unsigned* st; };
__device__ __forceinline__ XcdBarrier xcd_barrier_post(unsigned* bar, volatile LAS unsigned* st) {
  XcdBarrier b; b.bar = bar; b.x = xb_xcc_id(); b.st = st;
  if (threadIdx.x == 0) (void)xb_add(&bar[XB_XCNT(b.x)], 1u);
  return b;
}
__device__ __forceinline__ void xcd_barrier_complete(unsigned* bar, unsigned x, unsigned& nloc, unsigned& nx) {
  const unsigned G = gridDim.x * gridDim.y * gridDim.z;
  unsigned sum, cnt, mine, sp = 0u;
  for (;;) {
    sum = 0u; cnt = 0u; mine = 0u;
#pragma unroll
    for (unsigned j = 0; j < 16; ++j) { const unsigned c = xb_ld(&bar[XB_XCNT(j)]); sum += c; cnt += (c > 0u) ? 1u : 0u; mine = (j == x) ? c : mine; }
    if (sum == G) break;
    __builtin_amdgcn_s_sleep(1);
    if ((++sp & 255u) == 0u) { if (xb_ld(&bar[XB_TMO])) break; if (sp > XB_SPIN_CAP) { atomicAdd(&bar[XB_TMO], 1u); break; } }
  }
  nloc = mine > 0u ? mine : 1u; nx = cnt > 0u ? cnt : 1u;
}
__device__ __forceinline__ void xcd_barrier(const XcdBarrier& b) {
  asm volatile("s_waitcnt vmcnt(0)" ::: "memory");
  __syncthreads();
  if (threadIdx.x == 0) {
    unsigned* bar = b.bar;
    __builtin_amdgcn_s_waitcnt(0);
    unsigned nloc = b.st[0], nx = b.st[1];
    if (nloc == 0u) { xcd_barrier_complete(bar, b.x, nloc, nx); b.st[0] = nloc; b.st[1] = nx; }
    const unsigned old = xb_add(&bar[XB_XSUB(b.x)], 1u);
    const unsigned gen = old / nloc;
    if (old + 1u == (gen + 1u) * nloc) {
      __builtin_amdgcn_fence(__ATOMIC_RELEASE, "agent");
      asm volatile("s_waitcnt vmcnt(0)" ::: "memory");
      const unsigned og = xb_add(&bar[XB_TOP], 1u);
      const unsigned tg = og / nx;
      if (og + 1u == (tg + 1u) * nx) xb_add(&bar[XB_TOPGEN], 1u);
      else XB_SPIN(xb_ld(&bar[XB_TOPGEN]) == tg, bar);
      __builtin_amdgcn_fence(__ATOMIC_ACQUIRE, "agent");
      xb_add(&bar[XB_XGEN(b.x)], 1u);
      asm volatile("s_waitcnt vmcnt(0)" ::: "memory");
    } else {
      XB_SPIN(xb_ld(&bar[XB_XGEN(b.x)]) == gen, bar);
      __builtin_amdgcn_fence(__ATOMIC_ACQUIRE, "agent");
      asm volatile("s_waitcnt vmcnt(0)" ::: "memory");
    }
  }
  __syncthreads();
}

__device__ __forceinline__ int q_next(unsigned* cnt, volatile LAS unsigned* slot) {
  __syncthreads();
  if (threadIdx.x == 0) *slot = xb_add(cnt, 1u);
  __syncthreads();
  return (int)*slot;
}

#if REP_SYNC
#define GSYNC() do { xcd_barrier(xb); xcd_barrier(xb); } while (0)
#else
#define GSYNC() xcd_barrier(xb)
#endif
__global__ void __launch_bounds__(256, 2) mega(Params p) {
  extern __shared__ __attribute__((aligned(16))) unsigned char smem[];
  cg::grid_group grid = cg::this_grid();
  const int nblk = gridDim.x, bid = blockIdx.x;
  u16* sm16 = (u16*)smem;
  __shared__ uint4 xb_words;
  if (threadIdx.x == 0) xb_words = make_uint4(0u, 0u, 0u, 0u);
  __syncthreads();
  XcdBarrier xb = xcd_barrier_post(p.bar, (volatile LAS unsigned*)&xb_words);

  for (int rep = 0; rep <= REP_P0; ++rep)
    for (int it = bid; it < P0_ITEMS; it += nblk) p0_item(p, it, smem);
  if (p.use_cg_sync) grid.sync();
  GSYNC();

#pragma unroll 1
  for (int l = 0; l < 4; ++l) {
    for (int it = bid; it < 384; it += nblk) norm_item(p, l, 0, it);
    GSYNC();
    { int tx, ty; for (int j = 0; tile_map(j, 18, tx, ty); ++j) gin_tile(p, l, tx, ty, sm16); }
    GSYNC();
    {
      constexpr int ND = 64 * NQG_CTX, NC = 2 * 64 * NQG_CTX / 4;
      unsigned* qc = p.bar + XCD_BAR_WORDS + (l * 2 + 0) * 64;
      for (int it = bid; it < NC + ND + 192; it = nblk + q_next(qc, &xb.st[2])) {
        if (it < NC) attn_ctx_item(p, l, it);
        else if (it < NC + ND) attn_diff_item(p, l, false, it - NC, (float*)smem);
        else { f1_tile(p, l, it - NC - ND, sm16);
#ifdef REP_F1
          f1_tile(p, l, it - NC - ND, sm16);
#endif
        }
      }
    }
    GSYNC();
    {
      constexpr int ND = 8 * NQG_LAT, NC = 2 * 8 * NQG_LAT;
      unsigned* qc = p.bar + XCD_BAR_WORDS + (l * 2 + 1) * 64;
      for (int it = bid; it < ND + 32 + NC + 64; it = nblk + q_next(qc, &xb.st[2])) {
        if (it < ND) attn_diff_item(p, l, true, it, (float*)smem);
        else if (it < ND + 32) { f2_tile(p, it - ND, sm16);
#ifdef REP_F2S
          f2_tile(p, it - ND, sm16);
#endif
        }
        else if (it < ND + 32 + NC) attn_lat_item(p, l, it - ND - 32, (float*)smem);
        else f2_tile(p, it - (ND + 32 + NC) + 32, sm16);
      }
    }
    GSYNC();
    { int tx, ty; for (int j = 0; tile_map(j, 8, tx, ty, 64); ++j) res_tile(p, l, tx, ty, p.cat, p.w_outT + (size_t)l * 1024 * 1024, 1024, 2, sm16); }
    GSYNC();
    for (int it = bid; it < 384; it += nblk) norm_item(p, l, 1, it);
    GSYNC();
    { int tx, ty; for (int j = 0; tile_map(j, 32, tx, ty); ++j) m1_tile(p, l, tx, ty, sm16); }
    GSYNC();
    { int tx, ty; for (int j = 0; tile_map(j, 8, tx, ty, 64); ++j) res_tile(p, l, tx, ty, p.u, p.w2T + (size_t)l * 1024 * 4096, 4096, 5, sm16); }
    GSYNC();
  }
  for (int it = bid; it < 384; it += nblk) norm_item(p, 0, 2, it);
}

extern "C" void kernel_launch(void* const* d_in, const int* in_sizes, int n_in, void* d_out, int out_size, void* d_ws,
                              size_t ws_size, hipStream_t stream) {
  static int grid_blocks = 0;
  if (grid_blocks == 0) {
    int dev = 0, cus = 0, per_cu = 0;
    (void)hipGetDevice(&dev);
    (void)hipDeviceGetAttribute(&cus, hipDeviceAttributeMultiprocessorCount, dev);
    if (hipFuncSetAttribute((const void*)mega, hipFuncAttributeMaxDynamicSharedMemorySize, LDS_BYTES) != hipSuccess) {
      fprintf(stderr, "hipFuncSetAttribute failed\n");
    }
    if (hipOccupancyMaxActiveBlocksPerMultiprocessor(&per_cu, (const void*)mega, 256, LDS_BYTES) != hipSuccess || per_cu < 1) {
      fprintf(stderr, "occupancy query failed (%d)\n", per_cu);
      per_cu = 1;
    }
    if (per_cu > 2) per_cu = 2;
    grid_blocks = cus * per_cu;
    fprintf(stderr, "mega: cus=%d per_cu=%d grid=%d ws=%zu\n", cus, per_cu, grid_blocks, ws_size);
  }
  Params p{};
  const float** pin = (const float**)&p;
  for (int i = 0; i < 27; ++i) pin[i] = (const float*)d_in[i];
  p.out = (float*)d_out;
  unsigned char* ws = (unsigned char*)d_ws;
  size_t off = 0;
  auto take = [&](size_t bytes) { unsigned char* q = ws + off; off += (bytes + 255) & ~(size_t)255; return q; };
  p.xres = (float*)take((size_t)NTOK * 1024 * 4);
  p.mods = (float*)take((size_t)4 * 3 * 6144 * 4);
  p.h = (u16*)take((size_t)NTOK * 1024 * 2);
  p.z = (u16*)take((size_t)NTOK * INW * 2);
  p.vt = (u16*)take((size_t)640 * NTOK * 2);
  p.cat = (u16*)take((size_t)NTOK * 1024 * 2);
  p.u = (u16*)take((size_t)NTOK * 4096 * 2);
  p.uv = (u16*)take((size_t)(16 * 256 * 512 + 2 * 256 * 2048) * 2);
  p.w_inT = (u16*)take((size_t)4 * 2304 * 1024 * 2);
  p.w_outT = (u16*)take((size_t)4 * 1024 * 1024 * 2);
  p.w1T = (u16*)take((size_t)4 * 4096 * 1024 * 2);
  p.w2T = (u16*)take((size_t)4 * 4096 * 1024 * 2);
  p.pqt = (u16*)take((size_t)4 * 512 * 256 * 2);
  p.dft256 = (u16*)take((size_t)256 * 512 * 2);
  p.dft1024 = (u16*)take((size_t)1024 * 2048 * 2);
  p.ck_na = (u16*)take((size_t)2 * 4 * 512 * 256 * 2);
  p.cvt_na = (u16*)take((size_t)2 * 4 * 512 * 256 * 2);
  p.ck_diff = (u16*)take((size_t)2 * 4 * 512 * 256 * 2);
  p.cvt_diff = (u16*)take((size_t)2 * 4 * 512 * 256 * 2);
  p.ck_swa = (u16*)take((size_t)2 * 4 * 512 * 128 * 2);
  p.cvt_swa = (u16*)take((size_t)2 * 4 * 512 * 128 * 2);
  p.kfr = (u16*)take((size_t)10 * 192 * 2048 * 2);
  p.vfr = (u16*)take((size_t)10 * 192 * 2048 * 2);
  p.ropeD = (float*)take(1024 * 4);
  p.ropeS = (float*)take(2048 * 4);
  p.bar = (unsigned*)take((XCD_BAR_WORDS + 8 * 64) * 4);
  if (off > ws_size) { fprintf(stderr, "workspace too small: need %zu have %zu\n", off, ws_size); return; }
  if (hipMemsetAsync(p.bar, 0, (XCD_BAR_WORDS + 8 * 64) * 4, stream) != hipSuccess) fprintf(stderr, "memset failed\n");
  void* args[] = {&p};
  hipError_t e = hipLaunchCooperativeKernel((const void*)mega, dim3(grid_blocks), dim3(256), args, LDS_BYTES, stream);
  if (e != hipSuccess) fprintf(stderr, "cooperative launch failed: %s (grid %d)\n", hipGetErrorString(e), grid_blocks);
}
```

```cpp
#include <hip/hip_runtime.h>
#include <hip/hip_cooperative_groups.h>
#include <stdint.h>
#include <stdio.h>
namespace cg = cooperative_groups;

typedef unsigned short u16;
typedef __attribute__((ext_vector_type(8))) short bf16x8;
typedef __attribute__((ext_vector_type(4))) float f32x4;
typedef __attribute__((ext_vector_type(4))) unsigned u32x4;
__device__ __forceinline__ void gload16(u32x4& dst, const void* ptr) {
  asm volatile("global_load_dwordx4 %0, %1, off" : "=v"(dst) : "v"(ptr) : "memory");
}

#define NTOK 6144
#define NPTOK 4096
#define INW 2304
#define LOG2E 1.4426950408889634f
#define LDS_BYTES 73728
#define LSTR 72

#define O_NAK 6291456
#define O_NAV 10485760
#define O_DK 14680064
#define O_DV 18874368
#define O_SK 23068672
#define O_SV 25165824

struct Params {
  const float *x_prompt, *x_sample, *c_na_k, *c_na_v, *c_diff_k, *c_diff_v, *c_swa_k, *c_swa_v, *c, *c_ctx;
  const float *w_ada, *b_ada, *norm1_g, *norm2_g, *w_in, *na_rpb, *lq1, *lk1, *lq2, *lk2, *subln_g, *w_fourier, *swa_sink;
  const float *w_out, *w1, *w2, *final_g;
  float* out;
  float* xres;
  float* mods;
  u16 *h, *z, *vt, *cat, *u, *uv, *w_inT, *w_outT, *w1T, *w2T, *pqt, *dft256, *dft1024;
  u16 *ck_na, *cvt_na, *ck_diff, *cvt_diff, *ck_swa, *cvt_swa;
  float *ropeD, *ropeS;
  u16 *kfr, *vfr;
  unsigned* bar;
  int use_cg_sync;
  int pad_;
};

__device__ __forceinline__ u16 f2bf(float f) {
  unsigned u = __float_as_uint(f);
  u += 0x7fffu + ((u >> 16) & 1u);
  return (u16)(u >> 16);
}
__device__ __forceinline__ int otid() { int t = threadIdx.x; asm volatile("" : "+v"(t)); return t; }
__device__ __forceinline__ float bf2f(u16 h) { return __uint_as_float(((unsigned)h) << 16); }
typedef __attribute__((ext_vector_type(2))) __bf16 hbf16x2;
typedef __attribute__((ext_vector_type(2))) float f32x2;
__device__ __forceinline__ unsigned pack2(float a, float b) {
  f32x2 v = {a, b};
  union { hbf16x2 h; unsigned u; } x;
  x.h = __builtin_convertvector(v, hbf16x2);
  return x.u;
}

__device__ __forceinline__ int kfrag_off(int kk, int d) {
  const int t = (kk >> 2) & 1, r = ((kk >> 3) << 2) | (kk & 3), dc = d >> 5, g = (d >> 3) & 3;
  return ((t * 2 + dc) * 64 + g * 16 + r) * 8 + (d & 7);
}
__device__ __forceinline__ int vfrag_off(int kk, int dv) {
  return (((dv >> 4) * 64) + (kk >> 3) * 16 + (dv & 15)) * 8 + (kk & 7);
}

#define XB_TMO      128
#define XB_XCNT(j)  (256  + 64 * (j))
#define XB_XSUB(j)  (1280 + 64 * (j))
#define XB_XGEN(j)  (2304 + 64 * (j))
#define XB_TOP      3328
#define XB_TOPGEN   3392
#define XCD_BAR_WORDS 3456
#define XB_SPIN_CAP (1u << 22)
#define LAS __attribute__((address_space(3)))
__device__ __forceinline__ unsigned xb_ld(unsigned* p)              { return __hip_atomic_load(p, __ATOMIC_RELAXED, __HIP_MEMORY_SCOPE_AGENT); }
__device__ __forceinline__ unsigned xb_add(unsigned* p, unsigned v) { return __hip_atomic_fetch_add(p, v, __ATOMIC_RELAXED, __HIP_MEMORY_SCOPE_AGENT); }
__device__ __forceinline__ unsigned xb_xcc_id() { return (unsigned)__builtin_amdgcn_s_getreg((3 << 11) | 20) & 0xFu; }
#define XB_SPIN(cond, bar) do { unsigned _sp = 0; while (cond) { __builtin_amdgcn_s_sleep(1); \
    if ((++_sp & 255u) == 0u) { if (xb_ld(&(bar)[XB_TMO])) break; if (_sp > XB_SPIN_CAP) { atomicAdd(&(bar)[XB_TMO], 1u); break; } } } } while (0)
struct XcdBarrier { unsigned* bar; unsigned x; volatile LAS unsigned* st; };
__device__ __forceinline__ XcdBarrier xcd_barrier_post(unsigned* bar, volatile LAS unsigned* st) {
  XcdBarrier b; b.bar = bar; b.x = xb_xcc_id(); b.st = st;
  if (threadIdx.x == 0) (void)xb_add(&bar[XB_XCNT(b.x)], 1u);
  return b;
}
__device__ __forceinline__ void xcd_barrier_complete(unsigned* bar, unsigned x, unsigned& nloc, unsigned& nx) {
  const unsigned G = gridDim.x * gridDim.y * gridDim.z;
  unsigned sum, cnt, mine, sp = 0u;
  for (;;) {
    sum = 0u; cnt = 0u; mine = 0u;
#pragma unroll
    for (unsigned j = 0; j < 16; ++j) { const unsigned c = xb_ld(&bar[XB_XCNT(j)]); sum += c; cnt += (c > 0u) ? 1u : 0u; mine = (j == x) ? c : mine; }
    if (sum == G) break;
    __builtin_amdgcn_s_sleep(1);
    if ((++sp & 255u) == 0u) { if (xb_ld(&bar[XB_TMO])) break; if (sp > XB_SPIN_CAP) { atomicAdd(&bar[XB_TMO], 1u); break; } }
  }
  nloc = mine > 0u ? mine : 1u; nx = cnt > 0u ? cnt : 1u;
}
__device__ __forceinline__ void xcd_barrier(const XcdBarrier& b) {
  asm volatile("s_waitcnt vmcnt(0)" ::: "memory");
  __syncthreads();
  if (threadIdx.x == 0) {
    unsigned* bar = b.bar;
    __builtin_amdgcn_s_waitcnt(0);
    unsigned nloc = b.st[0], nx = b.st[1];
    if (nloc == 0u) { xcd_barrier_complete(bar, b.x, nloc, nx); b.st[0] = nloc; b.st[1] = nx; }
    const unsigned old = xb_add(&bar[XB_XSUB(b.x)], 1u);
    const unsigned gen = old / nloc;
    if (old + 1u == (gen + 1u) * nloc) {
      __builtin_amdgcn_fence(__ATOMIC_RELEASE, "agent");
      asm volatile("s_waitcnt vmcnt(0)" ::: "memory");
      const unsigned og = xb_add(&bar[XB_TOP], 1u);
      const unsigned tg = og / nx;
      if (og + 1u == (tg + 1u) * nx) xb_add(&bar[XB_TOPGEN], 1u);
      else XB_SPIN(xb_ld(&bar[XB_TOPGEN]) == tg, bar);
      __builtin_amdgcn_fence(__ATOMIC_ACQUIRE, "agent");
      xb_add(&bar[XB_XGEN(b.x)], 1u);
      asm volatile("s_waitcnt vmcnt(0)" ::: "memory");
    } else {
      XB_SPIN(xb_ld(&bar[XB_XGEN(b.x)]) == gen, bar);
      __builtin_amdgcn_fence(__ATOMIC_ACQUIRE, "agent");
      asm volatile("s_waitcnt vmcnt(0)" ::: "memory");
    }
  }
  __syncthreads();
}

__device__ __forceinline__ void transpose_tile(const float* __restrict__ src, int lds_, u16* __restrict__ dst, int ldd,
                                               int k0, int n0, float* sm, bool fragv = false) {
  const int tid = otid();
  const int c4 = (tid & 15) * 4, r0 = tid >> 4;
  float4 v[8];
#pragma unroll
  for (int i = 0; i < 8; ++i) v[i] = *(const float4*)(src + (size_t)(k0 + r0 + 16 * i) * lds_ + n0 + c4);
#pragma unroll
  for (int i = 0; i < 8; ++i) {
    const int k = r0 + 16 * i;
    sm[(c4 + 0) * 129 + k] = v[i].x; sm[(c4 + 1) * 129 + k] = v[i].y; sm[(c4 + 2) * 129 + k] = v[i].z; sm[(c4 + 3) * 129 + k] = v[i].w;
  }
  __syncthreads();
  const int k8 = (tid & 15) * 8, nn = tid >> 4;
#pragma unroll
  for (int i = 0; i < 4; ++i) {
    const int n = nn + 16 * i;
    const float* row = sm + n * 129 + k8;
    uint4 w;
    w.x = pack2(row[0], row[1]); w.y = pack2(row[2], row[3]); w.z = pack2(row[4], row[5]); w.w = pack2(row[6], row[7]);
    if (fragv) {
      const int col = n0 + n, pos = k0 + k8;
      *(uint4*)(dst + ((size_t)((col >> 6) * 16 + (pos >> 5))) * 2048 + vfrag_off(pos & 31, col & 63)) = w;
    } else {
      *(uint4*)(dst + (size_t)(n0 + n) * ldd + k0 + k8) = w;
    }
  }
  __syncthreads();
}

__device__ __forceinline__ void adaln_item(const Params& p, int it, float* sm) {
  const int l = it / 96, c0 = (it % 96) * 64;
  float* ssil = sm;
  float* red = sm + 3072;
  const int tid = otid();
  for (int i = tid; i < 3072; i += 256) {
    const int cnd = i >> 10, k = i & 1023;
    const float v = cnd == 0 ? p.c_ctx[k] : p.c[(cnd - 1) * 1024 + k];
    ssil[i] = v / (1.f + expf(-v));
  }
  __syncthreads();
  const int cg4 = (tid & 15) * 4, ks = tid >> 4;
  const float* w = p.w_ada + (size_t)l * 1024 * 6144 + c0 + cg4;
  float a0[4] = {0.f, 0.f, 0.f, 0.f}, a1[4] = {0.f, 0.f, 0.f, 0.f}, a2[4] = {0.f, 0.f, 0.f, 0.f};
#pragma unroll 16
  for (int kk = 0; kk < 64; ++kk) {
    const int k = kk * 16 + ks;
    const float4 v = *(const float4*)(w + (size_t)k * 6144);
    const float s0 = ssil[k], s1 = ssil[1024 + k], s2 = ssil[2048 + k];
    a0[0] += s0 * v.x; a0[1] += s0 * v.y; a0[2] += s0 * v.z; a0[3] += s0 * v.w;
    a1[0] += s1 * v.x; a1[1] += s1 * v.y; a1[2] += s1 * v.z; a1[3] += s1 * v.w;
    a2[0] += s2 * v.x; a2[1] += s2 * v.y; a2[2] += s2 * v.z; a2[3] += s2 * v.w;
  }
#pragma unroll
  for (int j = 0; j < 4; ++j) {
    red[(ks * 3 + 0) * 64 + cg4 + j] = a0[j];
    red[(ks * 3 + 1) * 64 + cg4 + j] = a1[j];
    red[(ks * 3 + 2) * 64 + cg4 + j] = a2[j];
  }
  __syncthreads();
  if (tid < 192) {
    const int cnd = tid >> 6, j = tid & 63;
    float s = p.b_ada[l * 6144 + c0 + j];
    for (int q = 0; q < 16; ++q) s += red[(q * 3 + cnd) * 64 + j];
    p.mods[(l * 3 + cnd) * 6144 + c0 + j] = s;
  }
  __syncthreads();
}

__device__ __forceinline__ void cvt_item(const float* __restrict__ src, u16* __restrict__ dst, int it, int W) {
  const int w8 = W >> 3;
#pragma unroll
  for (int i = 0; i < 4; ++i) {
    const int u = it * 1024 + i * 256 + otid();
    const int d8 = u % w8, pos = (u / w8) & 511, bl = u / (w8 * 512);
    const float* sp = src + ((size_t)(bl * 512 + pos) * W + d8 * 8);
    const float4 v0 = *(const float4*)sp, v1 = *(const float4*)(sp + 4);
    uint4 w; w.x = pack2(v0.x, v0.y); w.y = pack2(v0.z, v0.w); w.z = pack2(v1.x, v1.y); w.w = pack2(v1.z, v1.w);
    const int h = d8 >> 3, d = (d8 & 7) * 8;
    *(uint4*)(dst + ((size_t)((bl * (W >> 6) + h) * 16 + (pos >> 5))) * 2048 + kfrag_off(pos & 31, d)) = w;
  }
}

__device__ __forceinline__ void pq_item(const Params& p, int it, float* sm) {
  const int l = it >> 3, which = (it >> 2) & 1, g = it & 3;
  const int n = otid();
  if (n < 64) sm[n] = which ? sinpif(2.f * (float)n / 64.f) : cospif(2.f * (float)n / 64.f);
  __syncthreads();
  float w[64];
#pragma unroll
  for (int m = 0; m < 64; ++m) w[m] = p.w_fourier[(size_t)l * 65536 + (g * 64 + m) * 256 + n];
  u16* dst = p.pqt + (size_t)l * 512 * 256 + (size_t)(which * 256 + n) * 256 + g * 64;
  for (int c = 0; c < 64; ++c) {
    float s = 0.f;
#pragma unroll
    for (int m = 0; m < 64; ++m) s += sm[(c * m) & 63] * w[m];
    dst[c] = f2bf(s);
  }
  __syncthreads();
}

__device__ __forceinline__ void dft_item(u16* dst, int L, int it) {
  const int twoL = 2 * L;
  for (int e = otid(); e < 8192; e += 256) {
    const int idx = it * 8192 + e;
    const int k = idx / twoL, j = idx % twoL;
    const int jj = j & (L - 1);
    const int ph = (k * jj) & (L - 1);
    const float a = 2.f * (float)ph / (float)L;
    const float v = (j >= L) ? -sinpif(a) : cospif(a);
    dst[idx] = f2bf(v);
  }
}

#define P0_WT 5760
#define P0_ADA 384
#define P0_XC 384
#define P0_CK 320
#define P0_CVT 320
#define P0_PQ 32
#define P0_DFT 272
#define P0_ITEMS (P0_ADA + P0_WT + P0_XC + P0_CK + P0_CVT + P0_PQ + P0_DFT + 1)

__device__ void p0_item(const Params& p, int it, unsigned char* smem) {
  float* sm = (float*)smem;
  if (it < P0_ADA) { adaln_item(p, it, sm); return; }
  it -= P0_ADA;
  if (it < P0_WT) {
    const int l = it / 1440; int r = it % 1440;
    if (r < 288) { transpose_tile(p.w_in + (size_t)l * 1024 * 2304, 2304, p.w_inT + (size_t)l * 2304 * 1024, 1024, (r / 36) * 128, (r % 36) * 64, sm); return; }
    r -= 288;
    if (r < 128) { transpose_tile(p.w_out + (size_t)l * 1024 * 1024, 1024, p.w_outT + (size_t)l * 1024 * 1024, 1024, (r / 16) * 128, (r % 16) * 64, sm); return; }
    r -= 128;
    if (r < 512) { transpose_tile(p.w1 + (size_t)l * 1024 * 4096, 4096, p.w1T + (size_t)l * 4096 * 1024, 1024, (r / 64) * 128, (r % 64) * 64, sm); return; }
    r -= 512;
    transpose_tile(p.w2 + (size_t)l * 4096 * 1024, 1024, p.w2T + (size_t)l * 1024 * 4096, 4096, (r / 16) * 128, (r % 16) * 64, sm);
    return;
  }
  it -= P0_WT;
  if (it < P0_XC) {
    const int row0 = it * 16;
    const float* src = row0 < NPTOK ? p.x_prompt + (size_t)row0 * 1024 : p.x_sample + (size_t)(row0 - NPTOK) * 1024;
    float* dst = p.xres + (size_t)row0 * 1024;
#pragma unroll
    for (int i = 0; i < 16; ++i) {
      const int o = (i * 256 + otid()) * 4;
      *(float4*)(dst + o) = *(const float4*)(src + o);
    }
    return;
  }
  it -= P0_XC;
  if (it < P0_CK) {
    if (it < 128) { cvt_item(p.c_na_k, p.ck_na, it, 256); return; }
    it -= 128;
    if (it < 128) { cvt_item(p.c_diff_k, p.ck_diff, it, 256); return; }
    it -= 128;
    cvt_item(p.c_swa_k, p.ck_swa, it, 128);
    return;
  }
  it -= P0_CK;
  if (it < P0_CVT) {
    if (it < 128) { const int bl = it >> 4, r = it & 15; transpose_tile(p.c_na_v + (size_t)bl * 512 * 256, 256, p.cvt_na + (size_t)bl * 256 * 512, 512, (r >> 2) * 128, (r & 3) * 64, sm, true); return; }
    it -= 128;
    if (it < 128) { const int bl = it >> 4, r = it & 15; transpose_tile(p.c_diff_v + (size_t)bl * 512 * 256, 256, p.cvt_diff + (size_t)bl * 256 * 512, 512, (r >> 2) * 128, (r & 3) * 64, sm, true); return; }
    it -= 128;
    { const int bl = it >> 3, r = it & 7; transpose_tile(p.c_swa_v + (size_t)bl * 512 * 128, 128, p.cvt_swa + (size_t)bl * 128 * 512, 512, (r >> 1) * 128, (r & 1) * 64, sm, true); return; }
  }
  it -= P0_CVT;
  if (it < P0_PQ) { pq_item(p, it, sm); return; }
  it -= P0_PQ;
  if (it < 16) { dft_item(p.dft256, 256, it); return; }
  it -= 16;
  if (it < 256) { dft_item(p.dft1024, 1024, it); return; }
  for (int e = otid(); e < 512 + 1024; e += 256) {
    const bool isD = e < 512;
    const int ee = isD ? e : e - 512;
    const int nf = isD ? 8 : 16;
    const int pos = ee / nf, fi = ee % nf;
    const float inv = exp2f(-(float)fi * (13.287712379549449f / (float)nf));
    float tt = (float)pos * inv * 0.15915494309189535f;
    tt -= rintf(tt);
    float sn, cs;
    sincospif(2.f * tt, &sn, &cs);
    if (isD) { p.ropeD[ee] = cs; p.ropeD[512 + ee] = sn; }
    else { p.ropeS[ee] = cs; p.ropeS[1024 + ee] = sn; }
  }
}

__device__ __forceinline__ void norm_item(const Params& p, int l, int which, int it) {
  const int lane = otid() & 63, wave = otid() >> 6;
  const int row0 = it * 16 + wave * 4;
  float4 v[4][4];
#pragma unroll
  for (int j = 0; j < 4; ++j)
#pragma unroll
    for (int k = 0; k < 4; ++k) v[j][k] = *(const float4*)(p.xres + (size_t)(row0 + j) * 1024 + (k * 64 + lane) * 4);
  float rs[4];
#pragma unroll
  for (int j = 0; j < 4; ++j) {
    float ss = 0.f;
#pragma unroll
    for (int k = 0; k < 4; ++k) ss += v[j][k].x * v[j][k].x + v[j][k].y * v[j][k].y + v[j][k].z * v[j][k].z + v[j][k].w * v[j][k].w;
#pragma unroll
    for (int o = 32; o >= 1; o >>= 1) ss += __shfl_xor(ss, o);
    rs[j] = rsqrtf(ss * (1.f / 1024.f) + 1e-6f);
  }
  if (which < 2) {
    const int cond = row0 < NPTOK ? 0 : 1 + ((row0 - NPTOK) >> 10);
    const float* gp = (which == 0 ? p.norm1_g : p.norm2_g) + l * 1024;
    const float* shp = p.mods + (size_t)(l * 3 + cond) * 6144 + (which * 3 + 0) * 1024;
    const float* scp = shp + 1024;
#pragma unroll
    for (int k = 0; k < 4; ++k) {
      const int col = (k * 64 + lane) * 4;
      const float4 gg = *(const float4*)(gp + col);
      const float4 sh = *(const float4*)(shp + col);
      const float4 sc = *(const float4*)(scp + col);
      const float mx = gg.x * (1.f + sc.x), my = gg.y * (1.f + sc.y), mz = gg.z * (1.f + sc.z), mw = gg.w * (1.f + sc.w);
#pragma unroll
      for (int j = 0; j < 4; ++j) {
        uint2 w;
        w.x = pack2(v[j][k].x * rs[j] * mx + sh.x, v[j][k].y * rs[j] * my + sh.y);
        w.y = pack2(v[j][k].z * rs[j] * mz + sh.z, v[j][k].w * rs[j] * mw + sh.w);
        *(uint2*)(p.h + (size_t)(row0 + j) * 1024 + col) = w;
      }
    }
  } else {
#pragma unroll
    for (int k = 0; k < 4; ++k) {
      const int col = (k * 64 + lane) * 4;
      const float4 gg = *(const float4*)(p.final_g + col);
#pragma unroll
      for (int j = 0; j < 4; ++j) {
        float4 o;
        o.x = v[j][k].x * rs[j] * gg.x; o.y = v[j][k].y * rs[j] * gg.y; o.z = v[j][k].z * rs[j] * gg.z; o.w = v[j][k].w * rs[j] * gg.w;
        *(float4*)(p.out + (size_t)(row0 + j) * 1024 + col) = o;
      }
    }
  }
}

template <bool ZERO, int YT>
__device__ __forceinline__ void gemm_main_t(const u16* __restrict__ X, int ldx, const u16* __restrict__ Y, int ldy, int K,
                                          u16* smem, f32x4 (&acc)[4][YT]) {
  const int tid = otid(), lane = tid & 63, wave = tid >> 6, wx = wave & 1, wy = wave >> 1, r = lane & 15, g = lane >> 4;
  u16* sX = smem;
  u16* sY = smem + 2 * 128 * LSTR;
  const int lrow = tid >> 3, lkc = tid & 7;
  const u16* gx = X + (size_t)lrow * ldx + lkc * 8;
  const u16* gy = Y + (size_t)lrow * ldy + lkc * 8;
  u32x4 rx[4], ry[YT];
#pragma unroll
  for (int i = 0; i < 4; ++i) rx[i] = *(const u32x4*)(gx + (size_t)(32 * i) * ldx);
#pragma unroll
  for (int i = 0; i < YT; ++i) ry[i] = *(const u32x4*)(gy + (size_t)(32 * i) * ldy);
  if (ZERO) {
#pragma unroll
    for (int a = 0; a < 4; ++a)
#pragma unroll
      for (int b = 0; b < YT; ++b) acc[a][b] = (f32x4){0.f, 0.f, 0.f, 0.f};
  }
#pragma unroll
  for (int i = 0; i < 4; ++i) *(u32x4*)(sX + (lrow + 32 * i) * LSTR + lkc * 8) = rx[i];
#pragma unroll
  for (int i = 0; i < YT; ++i) *(u32x4*)(sY + (lrow + 32 * i) * LSTR + lkc * 8) = ry[i];
  __syncthreads();
  const int nk = K >> 6;
  const u16* cx0 = sX + (wx * 64 + r) * LSTR + g * 8;
  const u16* cy0 = sY + (wy * (16 * YT) + r) * LSTR + g * 8;
#define GEMM_COMPUTE(cur)                                                                            \
  {                                                                                                  \
    const u16* cx = cx0 + (cur) * 128 * LSTR;                                                        \
    const u16* cy = cy0 + (cur) * 128 * LSTR;                                                        \
    _Pragma("unroll") for (int kk = 0; kk < 2; ++kk) {                                               \
      bf16x8 a[4], b[YT];                                                                            \
      _Pragma("unroll") for (int i = 0; i < 4; ++i) a[i] = *(const bf16x8*)(cx + i * 16 * LSTR + kk * 32); \
      _Pragma("unroll") for (int i = 0; i < YT; ++i) b[i] = *(const bf16x8*)(cy + i * 16 * LSTR + kk * 32); \
      _Pragma("unroll") for (int xi = 0; xi < 4; ++xi)                                               \
        _Pragma("unroll") for (int yi = 0; yi < YT; ++yi)                                            \
          acc[xi][yi] = __builtin_amdgcn_mfma_f32_16x16x32_bf16(a[xi], b[yi], acc[xi][yi], 0, 0, 0); \
    }                                                                                                \
  }
  u32x4 bx[4], by[YT];
  u16* const w1X = sX + 128 * LSTR + lrow * LSTR + lkc * 8;
  u16* const w1Y = sY + 128 * LSTR + lrow * LSTR + lkc * 8;
  u16* const w0X = sX + lrow * LSTR + lkc * 8;
  u16* const w0Y = sY + lrow * LSTR + lkc * 8;
#pragma unroll 1
  for (int kt = 0; kt + 2 < nk; kt += 2) {
#pragma unroll
    for (int i = 0; i < 4; ++i) gload16(rx[i], gx + (size_t)(32 * i) * ldx + (kt + 1) * 64);
#pragma unroll
    for (int i = 0; i < YT; ++i) gload16(ry[i], gy + (size_t)(32 * i) * ldy + (kt + 1) * 64);
#pragma unroll
    for (int i = 0; i < 4; ++i) gload16(bx[i], gx + (size_t)(32 * i) * ldx + (kt + 2) * 64);
#pragma unroll
    for (int i = 0; i < YT; ++i) gload16(by[i], gy + (size_t)(32 * i) * ldy + (kt + 2) * 64);
    GEMM_COMPUTE(0);
    if (YT == 4) asm volatile("s_waitcnt vmcnt(8)" ::: "memory"); else asm volatile("s_waitcnt vmcnt(7)" ::: "memory");
#pragma unroll
    for (int i = 0; i < 4; ++i) *(u32x4*)(w1X + 32 * i * LSTR) = rx[i];
#pragma unroll
    for (int i = 0; i < YT; ++i) *(u32x4*)(w1Y + 32 * i * LSTR) = ry[i];
    __syncthreads();
    GEMM_COMPUTE(1);
    asm volatile("s_waitcnt vmcnt(0)" ::: "memory");
#pragma unroll
    for (int i = 0; i < 4; ++i) *(u32x4*)(w0X + 32 * i * LSTR) = bx[i];
#pragma unroll
    for (int i = 0; i < YT; ++i) *(u32x4*)(w0Y + 32 * i * LSTR) = by[i];
    __syncthreads();
  }
  {
#pragma unroll
    for (int i = 0; i < 4; ++i) gload16(rx[i], gx + (size_t)(32 * i) * ldx + (nk - 1) * 64);
#pragma unroll
    for (int i = 0; i < YT; ++i) gload16(ry[i], gy + (size_t)(32 * i) * ldy + (nk - 1) * 64);
    GEMM_COMPUTE(0);
    asm volatile("s_waitcnt vmcnt(0)" ::: "memory");
#pragma unroll
    for (int i = 0; i < 4; ++i) *(u32x4*)(w1X + 32 * i * LSTR) = rx[i];
#pragma unroll
    for (int i = 0; i < YT; ++i) *(u32x4*)(w1Y + 32 * i * LSTR) = ry[i];
    __syncthreads();
  }
  GEMM_COMPUTE(1);
  __syncthreads();
#undef GEMM_COMPUTE
}

#ifndef REP_GEMM
#define REP_GEMM 0
#endif
#ifndef REP_MIX
#define REP_MIX 0
#endif
#ifndef REP_SYNC
#define REP_SYNC 0
#endif
#ifndef REP_P0
#define REP_P0 0
#endif
template <int YT>
__device__ __forceinline__ void gemm_main(const u16* __restrict__ X, int ldx, const u16* __restrict__ Y, int ldy, int K,
                                          u16* smem, f32x4 (&acc)[4][YT]) {
  gemm_main_t<true, YT>(X, ldx, Y, ldy, K, smem, acc);
#if REP_GEMM
  gemm_main_t<false, YT>(X, ldx, Y, ldy, K, smem, acc);
#pragma unroll
  for (int a = 0; a < 4; ++a)
#pragma unroll
    for (int b = 0; b < YT; ++b) acc[a][b] *= 0.5f;
#endif
}

__device__ __forceinline__ bool tile_map(int j, int ntx, int& tx, int& ty, int nty = 48) {
  const int nblk = gridDim.x, bid = blockIdx.x;
  if ((nblk & 7) == 0) {
    const int per = nty >> 3;
    const int v = (bid >> 3) + j * (nblk >> 3);
    if (v >= per * ntx) return false;
    tx = v / per; ty = per * (bid & 7) + v % per;
    return true;
  } else {
    const int it = bid + j * nblk;
    if (it >= nty * ntx) return false;
    tx = it / nty; ty = it % nty;
    return true;
  }
}

__device__ void gin_tile(const Params& p, int l, int tx, int ty, u16* smem) {
  const int n0 = tx * 128, m0 = ty * 128;
  f32x4 acc[4][4];
  gemm_main<4>(p.w_inT + (size_t)l * 2304 * 1024 + (size_t)n0 * 1024, 1024, p.h + (size_t)m0 * 1024, 1024, 1024, smem, acc);
  const int lane = otid() & 63, wave = otid() >> 6, wx = wave & 1, wy = wave >> 1, r = lane & 15, g = lane >> 4;
  const int nw = n0 + wx * 64;
  const bool isS = m0 >= NPTOK;
  int ropeMode = 0;
  if (isS) {
    if (nw >= 768 && nw < 1280) ropeMode = 1;
    else if (nw >= 1792 && nw < 2176) ropeMode = 2;
  }
  float* okv = nullptr; int okv_w = 0, okv_c = 0;
  if (!isS) {
    if (nw >= 256 && nw < 512) { okv = p.out + O_NAK; okv_w = 256; okv_c = nw - 256; }
    else if (nw >= 512 && nw < 768) { okv = p.out + O_NAV; okv_w = 256; okv_c = nw - 512; }
    else if (nw >= 1024 && nw < 1280) { okv = p.out + O_DK; okv_w = 256; okv_c = nw - 1024; }
    else if (nw >= 1280 && nw < 1536) { okv = p.out + O_DV; okv_w = 256; okv_c = nw - 1280; }
    else if (nw >= 2048 && nw < 2176) { okv = p.out + O_SK; okv_w = 128; okv_c = nw - 2048; }
    else if (nw >= 2176) { okv = p.out + O_SV; okv_w = 128; okv_c = nw - 2176; }
  }
  int khh = -1;
  if (nw >= 256 && nw < 512) khh = (nw - 256) >> 6;
  else if (nw >= 1024 && nw < 1280) khh = 4 + ((nw - 1024) >> 6);
  else if (nw >= 2048 && nw < 2176) khh = 8 + ((nw - 2048) >> 6);
  int vrow = -1;
  if (nw >= 512 && nw < 768) vrow = nw - 512;
  else if (nw >= 1280 && nw < 1536) vrow = 256 + nw - 1280;
  else if (nw >= 2176) vrow = 512 + nw - 2176;
#pragma unroll
  for (int yi = 0; yi < 4; ++yi) {
    const int m = m0 + wy * 64 + yi * 16 + r;
    const int t = (m - NPTOK) & 1023;
    const int prow = t >> 6, pcol = t & 63;
#pragma unroll
    for (int xi = 0; xi < 4; ++xi) {
      f32x4 v = acc[xi][yi];
      if (ropeMode == 1) {
        const int pos = (xi & 1) ? pcol : prow;
        const float4 cs = *(const float4*)(p.ropeD + pos * 8 + 4 * (g & 1));
        const float4 sn = *(const float4*)(p.ropeD + 512 + pos * 8 + 4 * (g & 1));
        const float sg = (g >= 2) ? 1.f : -1.f;
        const float o0 = __shfl_xor(v[0], 32), o1 = __shfl_xor(v[1], 32), o2 = __shfl_xor(v[2], 32), o3 = __shfl_xor(v[3], 32);
        v[0] = v[0] * cs.x + sg * o0 * sn.x; v[1] = v[1] * cs.y + sg * o1 * sn.y;
        v[2] = v[2] * cs.z + sg * o2 * sn.z; v[3] = v[3] * cs.w + sg * o3 * sn.w;
      } else if (ropeMode == 2) {
        const int pos = (xi >> 1) ? pcol : prow;
        const float4 cs = *(const float4*)(p.ropeS + pos * 16 + 4 * g);
        const float4 sn = *(const float4*)(p.ropeS + 1024 + pos * 16 + 4 * g);
        const f32x4 o = acc[xi ^ 1][yi];
        const float sg = (xi & 1) ? 1.f : -1.f;
        v[0] = v[0] * cs.x + sg * o[0] * sn.x; v[1] = v[1] * cs.y + sg * o[1] * sn.y;
        v[2] = v[2] * cs.z + sg * o[2] * sn.z; v[3] = v[3] * cs.w + sg * o[3] * sn.w;
      }
      const int nloc = xi * 16 + 4 * g;
      if (okv) {
        const int b = m >> 8, pos = m & 255;
        float4 o4; o4.x = v[0]; o4.y = v[1]; o4.z = v[2]; o4.w = v[3];
        *(float4*)(okv + ((size_t)((b * 4 + l) * 256 + pos)) * okv_w + okv_c + nloc) = o4;
      }
      if (vrow >= 0) {
        u16* vb = p.vfr + ((size_t)((vrow >> 6) * 192 + (m >> 5))) * 2048;
#pragma unroll
        for (int i = 0; i < 4; ++i) vb[vfrag_off(m & 31, nloc + i)] = f2bf(v[i]);
      } else if (khh >= 0) {
        uint2 w; w.x = pack2(v[0], v[1]); w.y = pack2(v[2], v[3]);
        *(uint2*)(p.kfr + ((size_t)(khh * 192 + (m >> 5))) * 2048 + kfrag_off(m & 31, nloc)) = w;
      } else {
        uint2 w; w.x = pack2(v[0], v[1]); w.y = pack2(v[2], v[3]);
        *(uint2*)(p.z + (size_t)m * INW + nw + nloc) = w;
      }
    }
  }
}

__device__ void res_tile(const Params& p, int l, int tx, int ty, const u16* A, const u16* WT, int K, int gi, u16* smem) {
  const int n0 = tx * 128, m0 = ty * 96;
  f32x4 acc[4][3];
  gemm_main<3>(WT + (size_t)n0 * K, K, A + (size_t)m0 * K, K, K, smem, acc);
  const int lane = otid() & 63, wave = otid() >> 6, wx = wave & 1, wy = wave >> 1, r = lane & 15, g = lane >> 4;
#pragma unroll
  for (int yi = 0; yi < 3; ++yi) {
    const int m = m0 + wy * 48 + yi * 16 + r;
    const int cond = m < NPTOK ? 0 : 1 + ((m - NPTOK) >> 10);
    const float* gate = p.mods + (size_t)(l * 3 + cond) * 6144 + gi * 1024;
    float* xrow = p.xres + (size_t)m * 1024;
    float4 xv[4], gt[4];
#pragma unroll
    for (int xi = 0; xi < 4; ++xi) {
      const int n = n0 + wx * 64 + xi * 16 + 4 * g;
      xv[xi] = *(const float4*)(xrow + n);
      gt[xi] = *(const float4*)(gate + n);
    }
#pragma unroll
    for (int xi = 0; xi < 4; ++xi) {
      const int n = n0 + wx * 64 + xi * 16 + 4 * g;
      const f32x4 v = acc[xi][yi];
      float4 o = xv[xi];
      o.x += gt[xi].x * v[0]; o.y += gt[xi].y * v[1]; o.z += gt[xi].z * v[2]; o.w += gt[xi].w * v[3];
      *(float4*)(xrow + n) = o;
    }
  }
}

__device__ void m1_tile(const Params& p, int l, int tx, int ty, u16* smem) {
  const int n0 = tx * 128, m0 = ty * 128;
  f32x4 acc[4][4];
  gemm_main<4>(p.w1T + (size_t)l * 4096 * 1024 + (size_t)n0 * 1024, 1024, p.h + (size_t)m0 * 1024, 1024, 1024, smem, acc);
  const int lane = otid() & 63, wave = otid() >> 6, wx = wave & 1, wy = wave >> 1, r = lane & 15, g = lane >> 4;
#pragma unroll
  for (int xi = 0; xi < 4; ++xi) {
    const int n = n0 + wx * 64 + xi * 16 + 4 * g;
#pragma unroll
    for (int yi = 0; yi < 4; ++yi) {
      const int m = m0 + wy * 64 + yi * 16 + r;
      const f32x4 v = acc[xi][yi];
      float a0 = fmaxf(v[0], 0.f), a1 = fmaxf(v[1], 0.f), a2 = fmaxf(v[2], 0.f), a3 = fmaxf(v[3], 0.f);
      uint2 w; w.x = pack2(a0 * a0, a1 * a1); w.y = pack2(a2 * a2, a3 * a3);
      *(uint2*)(p.u + (size_t)m * 4096 + n) = w;
    }
  }
}

__device__ void f1_tile(const Params& p, int l, int it, u16* smem) {
  const int tx = it % 48, ty = it / 48;
  const int x0 = tx * 128, y0 = ty * 128;
  f32x4 acc[4][4];
  gemm_main<4>(p.z + (size_t)x0 * INW + 1536, INW, p.pqt + (size_t)l * 512 * 256 + (size_t)y0 * 256, 256, 256, smem, acc);
  const int lane = otid() & 63, wave = otid() >> 6, wx = wave & 1, wy = wave >> 1, r = lane & 15, g = lane >> 4;
#pragma unroll
  for (int yi = 0; yi < 4; ++yi) {
    const int y = y0 + wy * 64 + yi * 16 + r;
    const int col = y & 255, which = y >> 8;
#pragma unroll
    for (int xi = 0; xi < 4; ++xi) {
      const int tok = x0 + wx * 64 + xi * 16 + 4 * g;
      size_t addr;
      if (tok < NPTOK) {
        const int b = tok >> 8, pos = tok & 255;
        addr = (size_t)b * (256 * 512) + (size_t)col * 512 + which * 256 + pos;
      } else {
        const int b = (tok - NPTOK) >> 10, pos = (tok - NPTOK) & 1023;
        addr = (size_t)16 * 256 * 512 + (size_t)b * (256 * 2048) + (size_t)col * 2048 + which * 1024 + pos;
      }
      const f32x4 v = acc[xi][yi];
      uint2 w; w.x = pack2(v[0], v[1]); w.y = pack2(v[2], v[3]);
      *(uint2*)(p.uv + addr) = w;
    }
  }
  asm volatile("s_waitcnt vmcnt(0)" ::: "memory");
  __syncthreads();
  if (threadIdx.x == 0) {
    __builtin_amdgcn_fence(__ATOMIC_RELEASE, "agent");
    asm volatile("s_waitcnt vmcnt(0)" ::: "memory");
    xb_add(p.bar + XCD_BAR_WORDS + (8 + l) * 64, 1u);
  }
}

__device__ void f2_tile(const Params& p, int l, int it, u16* smem) {
  if (threadIdx.x == 0) {
    unsigned* c = p.bar + XCD_BAR_WORDS + (8 + l) * 64;
    unsigned sp = 0;
    while (xb_ld(c) < 192u) { __builtin_amdgcn_s_sleep(2); if (++sp > (1u << 24)) break; }
    __builtin_amdgcn_fence(__ATOMIC_ACQUIRE, "agent");
    asm volatile("s_waitcnt vmcnt(0)" ::: "memory");
  }
  __syncthreads();
  int L, b, tx, ty, tokbase;
  const u16* uvb; const u16* dft;
  if (it < 32) { L = 1024; b = it >> 4; tx = (it >> 3) & 1; ty = it & 7; uvb = p.uv + (size_t)16 * 256 * 512 + (size_t)b * (256 * 2048); dft = p.dft1024; tokbase = NPTOK + b * 1024; }
  else { it -= 32; L = 256; b = it >> 2; tx = (it >> 1) & 1; ty = it & 1; uvb = p.uv + (size_t)b * (256 * 512); dft = p.dft256; tokbase = b * 256; }
  const int x0 = tx * 128, y0 = ty * 128, K = 2 * L;
  f32x4 acc[4][4];
  gemm_main<4>(uvb + (size_t)x0 * K, K, dft + (size_t)y0 * K, K, K, smem, acc);
  const int lane = otid() & 63, wave = otid() >> 6, wx = wave & 1, wy = wave >> 1, r = lane & 15, g = lane >> 4;
  const float scale = rsqrtf(64.f * (float)L);
#pragma unroll
  for (int yi = 0; yi < 4; ++yi) {
    const int pos = y0 + wy * 64 + yi * 16 + r;
#pragma unroll
    for (int xi = 0; xi < 4; ++xi) {
      const int col = x0 + wx * 64 + xi * 16 + 4 * g;
      const f32x4 v = acc[xi][yi];
      uint2 w; w.x = pack2(v[0] * scale, v[1] * scale); w.y = pack2(v[2] * scale, v[3] * scale);
      *(uint2*)(p.cat + (size_t)(tokbase + pos) * 1024 + 512 + col) = w;
    }
  }
}

struct Seg { const u16* K; const u16* Vt; int ldk, ldv, nblk, pos0, stride; };
#define KLOC(hh, tokb) (p.kfr + ((size_t)((hh) * 192 + ((tokb) >> 5))) * 2048)
#define VLOC(hh, tokb) (p.vfr + ((size_t)((hh) * 192 + ((tokb) >> 5))) * 2048)
template <int QT> struct AState { float m[QT]; float ls[QT]; f32x4 o[QT][4]; };

__device__ __forceinline__ bf16x8 as_bf(u32x4 v) { union { u32x4 u; bf16x8 b; } x; x.u = v; return x.b; }

template <int DC>
__device__ __forceinline__ void issue_blk(const Seg& s0, const Seg& s1, int b, int r, int g, u32x4 (&kf)[2][DC], u32x4 (&vf)[4]) {
  const bool in0 = b < s0.nblk;
  const u16* Kp = in0 ? s0.K : s1.K;
  const u16* Vp = in0 ? s0.Vt : s1.Vt;
  const int pos = in0 ? (s0.pos0 + b * s0.stride) : (s1.pos0 + (b - s0.nblk) * s1.stride);
  const int lane8 = (g * 16 + r) * 8;
  const u16* kp = Kp + (size_t)(pos >> 5) * 2048 + lane8;
  const u16* vp = Vp + (size_t)(pos >> 5) * 2048 + lane8;
#pragma unroll
  for (int t = 0; t < 2; ++t)
#pragma unroll
    for (int dc = 0; dc < DC; ++dc) gload16(kf[t][dc], kp + (t * 2 + dc) * 512);
#pragma unroll
  for (int dv = 0; dv < 4; ++dv) gload16(vf[dv], vp + dv * 512);
}
template <int N>
__device__ __forceinline__ void wait_blk(u32x4 (&kf)[2][1], u32x4 (&vf)[4]) {
  asm volatile("s_waitcnt vmcnt(%6)" : "+v"(kf[0][0]), "+v"(kf[1][0]), "+v"(vf[0]), "+v"(vf[1]), "+v"(vf[2]), "+v"(vf[3]) : "n"(N) : "memory");
}
template <int N>
__device__ __forceinline__ void wait_blk(u32x4 (&kf)[2][2], u32x4 (&vf)[4]) {
  asm volatile("s_waitcnt vmcnt(%8)" : "+v"(kf[0][0]), "+v"(kf[0][1]), "+v"(kf[1][0]), "+v"(kf[1][1]), "+v"(vf[0]), "+v"(vf[1]), "+v"(vf[2]), "+v"(vf[3]) : "n"(N) : "memory");
}

template <int D, int QT, int MODE>
__device__ __forceinline__ void attn_compute(const u32x4 (&kc)[2][D / 32], const u32x4 (&vc)[4], const bf16x8 (&qf)[QT][D / 32], const float sc,
                                             AState<QT>& st, const bool in0, const int pos, const int qpos0, const float* __restrict__ rpb_h,
                                             const int r, const int g) {
  constexpr int DC = D / 32;
#pragma unroll
  for (int q = 0; q < QT; ++q) {
    f32x4 s_[2];
    s_[0] = (f32x4){0.f, 0.f, 0.f, 0.f};
    s_[1] = (f32x4){0.f, 0.f, 0.f, 0.f};
#pragma unroll
    for (int t = 0; t < 2; ++t)
#pragma unroll
      for (int dc = 0; dc < DC; ++dc) s_[t] = __builtin_amdgcn_mfma_f32_16x16x32_bf16(as_bf(kc[t][dc]), qf[q][dc], s_[t], 0, 0, 0);
    float sv[8];
#pragma unroll
    for (int t = 0; t < 2; ++t)
#pragma unroll
      for (int i = 0; i < 4; ++i) {
        float x = s_[t][i] * sc;
        if (MODE == 1) {
          if (!in0) {
            const int qpos = qpos0 + q * 16 + r;
            const int qrow = qpos >> 6, cq = qpos & 63;
            const int kpos = pos + 8 * g + 4 * t + i;
            const int krow = kpos >> 6, ck = kpos & 63;
            const int cs = min(max(cq - 8, 0), 48);
            const bool valid = (ck >= cs) && (ck < cs + 16);
            const int bi = (krow - qrow + 7) * 31 + (ck - cq + 15);
            const float bias = rpb_h[valid ? bi : 0];
            x = valid ? (x + bias) : -1e30f;
          }
        } else if (MODE == 2) {
          if (!in0) {
            const int qpos = qpos0 + q * 16 + r;
            const int kpos = pos + 8 * g + 4 * t + i;
            const int d = qpos - kpos;
            x = (d <= 128 && d >= -128) ? x : -1e30f;
          }
        }
        sv[4 * t + i] = x;
      }
    float mx = fmaxf(fmaxf(fmaxf(sv[0], sv[1]), fmaxf(sv[2], sv[3])), fmaxf(fmaxf(sv[4], sv[5]), fmaxf(sv[6], sv[7])));
    mx = fmaxf(mx, __shfl_xor(mx, 16));
    mx = fmaxf(mx, __shfl_xor(mx, 32));
    const float mnew = fmaxf(st.m[q], mx);
    const float alpha = __builtin_amdgcn_exp2f(st.m[q] - mnew);
    st.m[q] = mnew;
    float ps = 0.f;
#pragma unroll
    for (int j = 0; j < 8; ++j) { sv[j] = __builtin_amdgcn_exp2f(sv[j] - mnew); ps += sv[j]; }
    st.ls[q] = st.ls[q] * alpha + ps;
    union { bf16x8 v; unsigned w[4]; } pf;
    pf.w[0] = pack2(sv[0], sv[1]); pf.w[1] = pack2(sv[2], sv[3]); pf.w[2] = pack2(sv[4], sv[5]); pf.w[3] = pack2(sv[6], sv[7]);
#pragma unroll
    for (int dv = 0; dv < 4; ++dv) {
      f32x4 o = st.o[q][dv];
      o[0] *= alpha; o[1] *= alpha; o[2] *= alpha; o[3] *= alpha;
      st.o[q][dv] = __builtin_amdgcn_mfma_f32_16x16x32_bf16(as_bf(vc[dv]), pf.v, o, 0, 0, 0);
    }
  }
}

template <int D, int QT, int MODE, int NQ = 2>
__device__ __forceinline__ void attn_run(const Seg& s0, const Seg& s1, const bf16x8 (&qf)[QT][D / 32], const float sc,
                                         AState<QT>& st, const int qpos0, const float* __restrict__ rpb_h, const int bb = 0, const int be = -1) {
  constexpr int DC = D / 32;
  constexpr int NL = 2 * DC + 4;
  const int lane = otid() & 63, r = lane & 15, g = lane >> 4;
  const int nb = be < 0 ? s0.nblk + s1.nblk : be;
  u32x4 kq[NQ][2][DC], vq[NQ][4];
#pragma unroll
  for (int q = 0; q < QT; ++q)
#pragma unroll
    for (int dc = 0; dc < DC; ++dc) asm volatile("" ::"v"(qf[q][dc]));
  asm volatile("s_waitcnt vmcnt(0)" ::: "memory");
#pragma unroll 1
  for (int b = bb; b < nb; b += NQ) {
#pragma unroll
    for (int j = 0; j < NQ; ++j) issue_blk<DC>(s0, s1, b + j, r, g, kq[j], vq[j]);
#pragma unroll
    for (int j = 0; j < NQ; ++j) {
      if (j == 0) wait_blk<(NQ - 1) * NL>(kq[j], vq[j]);
      else if (j == 1) wait_blk<(NQ - 2) * NL>(kq[j], vq[j]);
      else if (j == 2) wait_blk<(NQ > 3 ? (NQ - 3) * NL : 0)>(kq[j], vq[j]);
      else wait_blk<0>(kq[j], vq[j]);
      const int bj = b + j;
      const bool in0 = bj < s0.nblk;
      const int pos = in0 ? (s0.pos0 + bj * s0.stride) : (s1.pos0 + (bj - s0.nblk) * s1.stride);
      attn_compute<D, QT, MODE>(kq[j], vq[j], qf, sc, st, in0, pos, qpos0, rpb_h, r, g);
    }
  }
}

template <int QT>
__device__ __forceinline__ void astate_init(AState<QT>& st, float m0, float l0) {
#pragma unroll
  for (int q = 0; q < QT; ++q) {
    st.m[q] = m0; st.ls[q] = l0;
#pragma unroll
    for (int dv = 0; dv < 4; ++dv) st.o[q][dv] = (f32x4){0.f, 0.f, 0.f, 0.f};
  }
}
template <int QT>
__device__ __forceinline__ void astate_finalize(AState<QT>& st) {
#pragma unroll
  for (int q = 0; q < QT; ++q) {
    float l = st.ls[q];
    l += __shfl_xor(l, 16);
    l += __shfl_xor(l, 32);
    const float inv = 1.f / l;
#pragma unroll
    for (int dv = 0; dv < 4; ++dv) { st.o[q][dv][0] *= inv; st.o[q][dv][1] *= inv; st.o[q][dv][2] *= inv; st.o[q][dv][3] *= inv; }
  }
}
template <int DC, int QT>
__device__ __forceinline__ void load_q(const u16* zq  , bf16x8 (&qf)[QT][DC]) {
  const int lane = otid() & 63, r = lane & 15, g = lane >> 4;
#pragma unroll
  for (int q = 0; q < QT; ++q)
#pragma unroll
    for (int dc = 0; dc < DC; ++dc) qf[q][dc] = *(const bf16x8*)(zq + (size_t)(q * 16 + r) * INW + dc * 32 + g * 8);
}
template <int QT>
__device__ __forceinline__ void write_o(const Params& p, const AState<QT>& st, int tok0, int col0) {
  const int lane = otid() & 63, r = lane & 15, g = lane >> 4;
#pragma unroll
  for (int q = 0; q < QT; ++q)
#pragma unroll
    for (int dv = 0; dv < 4; ++dv) {
      const f32x4 v = st.o[q][dv];
      uint2 w; w.x = pack2(v[0], v[1]); w.y = pack2(v[2], v[3]);
      *(uint2*)(p.cat + (size_t)(tok0 + q * 16 + r) * 1024 + col0 + dv * 16 + 4 * g) = w;
    }
}

__device__ __forceinline__ float diff_lambda(const Params& p, int l, float lam_init) {
  const int lane = otid() & 63;
  float a = 0.f, b = 0.f;
  if (lane < 32) { a = p.lq1[l * 32 + lane] * p.lk1[l * 32 + lane]; b = p.lq2[l * 32 + lane] * p.lk2[l * 32 + lane]; }
#pragma unroll
  for (int o = 32; o >= 1; o >>= 1) { a += __shfl_xor(a, o); b += __shfl_xor(b, o); }
  return expf(a) - expf(b) + lam_init;
}

__device__ __forceinline__ void diff_finish_q(const Params& p, int l, float lam, float lam_init, f32x4 (&A)[4], const f32x4 (&B)[4], int tokrow0, int col0) {
  const int lane = otid() & 63, r = lane & 15, g = lane >> 4;
  const float* sg = p.subln_g + l * 64;
  float ss = 0.f;
#pragma unroll
  for (int dv = 0; dv < 4; ++dv)
#pragma unroll
    for (int i = 0; i < 4; ++i) {
      const float v = A[dv][i] - lam * B[dv][i];
      A[dv][i] = v;
      ss += v * v;
    }
  ss += __shfl_xor(ss, 16);
  ss += __shfl_xor(ss, 32);
  const float rs = rsqrtf(ss * (1.f / 64.f) + 1e-6f) * (1.f - lam_init);
#pragma unroll
  for (int dv = 0; dv < 4; ++dv) {
    const float4 gg = *(const float4*)(sg + dv * 16 + 4 * g);
    uint2 w;
    w.x = pack2(A[dv][0] * rs * gg.x, A[dv][1] * rs * gg.y);
    w.y = pack2(A[dv][2] * rs * gg.z, A[dv][3] * rs * gg.w);
    *(uint2*)(p.cat + (size_t)(tokrow0 + r) * 1024 + col0 + dv * 16 + 4 * g) = w;
  }
}

#ifndef AQT
#define AQT 2
#endif
#define QW (16 * AQT)
#define NQG_CTX (256 / QW)
#define NQG_LAT (1024 / QW)
__device__ void attn_diff_item(const Params& p, int l, bool lat, int bi, float* sm) {
  const int wave = otid() >> 6, lane = otid() & 63, r = lane & 15, g = lane >> 4;
  const int ps = wave >> 1, half = wave & 1;
  int b, h, qg, tokb;
  if (lat) { b = bi / (4 * NQG_LAT); h = (bi / NQG_LAT) & 3; qg = bi % NQG_LAT; tokb = NPTOK + b * 1024; }
  else { b = bi / (4 * NQG_CTX); h = (bi / NQG_CTX) & 3; qg = bi % NQG_CTX; tokb = b * 256; }
  const int tok0 = tokb + qg * QW;
  const u16* zb = p.z + (size_t)tokb * INW;
  Seg s0, s1;
  if (lat) {
    const int bl = b * 4 + l;
    s0.K = p.ck_diff + (size_t)((bl * 4 + h) * 16) * 2048 + ps * 512; s0.Vt = p.cvt_diff + (size_t)((bl * 4 + h) * 16) * 2048;
    s0.ldk = 0; s0.ldv = 0; s0.nblk = half ? 0 : 16; s0.pos0 = 0; s0.stride = 32;
    s1.K = KLOC(4 + h, tokb) + ps * 512; s1.Vt = VLOC(4 + h, tokb);
    s1.ldk = 0; s1.ldv = 0; s1.nblk = half ? 24 : 8; s1.pos0 = half ? 256 : 0; s1.stride = 32;
  } else {
    s0.K = KLOC(4 + h, tokb) + ps * 512; s0.Vt = VLOC(4 + h, tokb);
    s0.ldk = 0; s0.ldv = 0; s0.nblk = 4; s0.pos0 = half ? 128 : 0; s0.stride = 32;
    s1 = s0; s1.nblk = 0;
  }
  bf16x8 qf[AQT][1];
  load_q<1, AQT>(p.z + (size_t)tok0 * INW + 768 + h * 64 + ps * 32, qf);
  AState<AQT> st;
  astate_init<AQT>(st, -1e30f, 0.f);
  attn_run<32, AQT, 0, 4>(s0, s1, qf, 0.17677669529663687f * LOG2E, st, 0, nullptr);
  float lt[AQT];
#pragma unroll
  for (int q = 0; q < AQT; ++q) {
    lt[q] = st.ls[q];
    lt[q] += __shfl_xor(lt[q], 16);
    lt[q] += __shfl_xor(lt[q], 32);
  }
  constexpr int WS = 64 * 16 * AQT;
  float* pm = sm + 4 * WS;
  if (wave != 0) {
    float* po = sm + wave * WS + lane * (16 * AQT);
#pragma unroll
    for (int q = 0; q < AQT; ++q) {
#pragma unroll
      for (int dv = 0; dv < 4; ++dv) *(f32x4*)(po + q * 16 + dv * 4) = st.o[q][dv];
      if (g == 0) { pm[wave * QW + q * 16 + r] = st.m[q]; pm[4 * QW + wave * QW + q * 16 + r] = lt[q]; }
    }
  }
  __syncthreads();
  if (wave == 0) {
    const float lam_init = 0.8f - 0.6f * expf(-0.3f * (float)l);
    const float lam = diff_lambda(p, l, lam_init);
#pragma unroll
    for (int q = 0; q < AQT; ++q) {
      f32x4 A[4], B[4];
      {
        const float m1 = pm[QW + q * 16 + r], l1 = pm[4 * QW + QW + q * 16 + r];
        const float M = fmaxf(st.m[q], m1);
        const float a0 = exp2f(st.m[q] - M), a1 = exp2f(m1 - M);
        const float inv = 1.f / (lt[q] * a0 + l1 * a1);
#pragma unroll
        for (int dv = 0; dv < 4; ++dv) {
          const f32x4 o1 = *(const f32x4*)(sm + 1 * WS + lane * (16 * AQT) + q * 16 + dv * 4);
          A[dv] = (st.o[q][dv] * a0 + o1 * a1) * inv;
        }
      }
      {
        const float m2 = pm[2 * QW + q * 16 + r], l2 = pm[4 * QW + 2 * QW + q * 16 + r], m3 = pm[3 * QW + q * 16 + r], l3 = pm[4 * QW + 3 * QW + q * 16 + r];
        const float M = fmaxf(m2, m3);
        const float a2 = exp2f(m2 - M), a3 = exp2f(m3 - M);
        const float inv = 1.f / (l2 * a2 + l3 * a3);
#pragma unroll
        for (int dv = 0; dv < 4; ++dv) {
          const f32x4 o2 = *(const f32x4*)(sm + 2 * WS + lane * (16 * AQT) + q * 16 + dv * 4);
          const f32x4 o3 = *(const f32x4*)(sm + 3 * WS + lane * (16 * AQT) + q * 16 + dv * 4);
          B[dv] = (o2 * a2 + o3 * a3) * inv;
        }
      }
      diff_finish_q(p, l, lam, lam_init, A, B, tok0 + q * 16, 256 + h * 64);
    }
  }
  __syncthreads();
}

__device__ void attn_ctx_item(const Params& p, int l, int bi) {
  const int wave = otid() >> 6, lane = otid() & 63, g = lane >> 4;
  const int w = bi * 4 + wave;
  const int type = w / (64 * NQG_CTX), rem = w % (64 * NQG_CTX);
  const int b = rem / (4 * NQG_CTX), h = (rem / NQG_CTX) & 3, qg = rem % NQG_CTX;
  const int tokb = b * 256, tok0 = tokb + qg * QW;
  const u16* zb = p.z + (size_t)tokb * INW;
  const int kvh = h >> 1;
  const int qcol = type == 0 ? h * 64 : 1792 + h * 64;
  const int kcol = type == 0 ? 256 + h * 64 : 2048 + kvh * 64;
  const int vrow = type == 0 ? h * 64 : 512 + kvh * 64;
  const int ocol = type == 0 ? h * 64 : 768 + h * 64;
  bf16x8 qf[AQT][2];
  load_q<2, AQT>(p.z + (size_t)tok0 * INW + qcol, qf);
  const int hslot = type == 0 ? h : 8 + kvh;
  Seg s0; s0.K = KLOC(hslot, tokb); s0.Vt = VLOC(hslot, tokb); s0.ldk = 0; s0.ldv = 0; s0.nblk = 8; s0.pos0 = 0; s0.stride = 32;
  Seg sN = s0; sN.nblk = 0;
  AState<AQT> st;
  const float sk = type == 0 ? -1e30f : p.swa_sink[l * 4 + h] * LOG2E;
  astate_init<AQT>(st, sk, (type == 1 && g == 0) ? 1.f : 0.f);
  attn_run<64, AQT, 0, 2>(s0, sN, qf, 0.125f * LOG2E, st, 0, nullptr);
  astate_finalize<AQT>(st);
  write_o<AQT>(p, st, tok0, ocol);
}

__device__ void attn_lat_item(const Params& p, int l, int bi, float* sm) {
  const int wave = otid() >> 6, lane = otid() & 63, r = lane & 15, g = lane >> 4;
  const int type = bi / (8 * NQG_LAT), rem = bi % (8 * NQG_LAT);
  const int b = rem / (4 * NQG_LAT), h = (rem / NQG_LAT) & 3, qg = rem % NQG_LAT;
  const int q0 = qg * QW;
  const int tokb = NPTOK + b * 1024, tok0 = tokb + q0;
  const u16* zb = p.z + (size_t)tokb * INW;
  const int bl = b * 4 + l;
  AState<AQT> st;
  int ocol;
  if (type != 0) {
    const float* rp = p.na_rpb + (size_t)(l * 4 + h) * 15 * 31;
    for (int e = otid(); e < 465; e += 256) sm[9000 + e] = rp[e] * LOG2E;
    __syncthreads();
  }
  if (type == 0) {
    const int kvh = h >> 1;
    bf16x8 qf[AQT][2];
    load_q<2, AQT>(p.z + (size_t)tok0 * INW + 1792 + h * 64, qf);
    Seg s0; s0.K = p.ck_swa + (size_t)((bl * 2 + kvh) * 16) * 2048; s0.Vt = p.cvt_swa + (size_t)((bl * 2 + kvh) * 16) * 2048; s0.ldk = 0; s0.ldv = 0; s0.nblk = 16; s0.pos0 = 0; s0.stride = 32;
    const int lo = max(0, q0 - 128) & ~31;
    const int hi = min(1024, ((q0 + QW + 128) + 31) & ~31);
    int lo2 = lo, cnt = (hi - lo) >> 5;
    if (cnt & 1) { if (lo2 > 0) lo2 -= 32; ++cnt; }
    Seg s1; s1.K = KLOC(8 + kvh, tokb); s1.Vt = VLOC(8 + kvh, tokb); s1.ldk = 0; s1.ldv = 0; s1.nblk = cnt; s1.pos0 = lo2; s1.stride = 32;
    const int P = (16 + cnt) >> 1;
    const int pb = (wave * P) >> 2, pe = ((wave + 1) * P) >> 2;
    astate_init<AQT>(st, wave == 0 ? p.swa_sink[l * 4 + h] * LOG2E : -1e30f, (wave == 0 && g == 0) ? 1.f : 0.f);
    attn_run<64, AQT, 2>(s0, s1, qf, 0.125f * LOG2E, st, q0, nullptr, 2 * pb, 2 * pe);
    ocol = 768 + h * 64;
  } else {
    bf16x8 qf[AQT][2];
    load_q<2, AQT>(p.z + (size_t)tok0 * INW + h * 64, qf);
    Seg s0; s0.K = p.ck_na + (size_t)((bl * 4 + h) * 16) * 2048; s0.Vt = p.cvt_na + (size_t)((bl * 4 + h) * 16) * 2048; s0.ldk = 0; s0.ldv = 0; s0.nblk = 16; s0.pos0 = 0; s0.stride = 32;
    const int qrow = q0 >> 6;
    const int rstart = min(max(qrow - 4, 0), 8);
    Seg s1; s1.K = KLOC(h, tokb); s1.Vt = VLOC(h, tokb); s1.ldk = 0; s1.ldv = 0; s1.nblk = 16; s1.pos0 = rstart * 64; s1.stride = 32;
    astate_init<AQT>(st, -1e30f, 0.f);
    attn_run<64, AQT, 1, 2>(s0, s1, qf, 0.125f * LOG2E, st, q0, sm + 9000, 8 * wave, 8 * wave + 8);
    ocol = h * 64;
  }
  float lt[AQT];
#pragma unroll
  for (int q = 0; q < AQT; ++q) {
    lt[q] = st.ls[q];
    lt[q] += __shfl_xor(lt[q], 16);
    lt[q] += __shfl_xor(lt[q], 32);
  }
  constexpr int WS = 64 * 16 * AQT;
  float* pm = sm + 4 * WS;
  if (wave != 0) {
    float* po = sm + wave * WS + lane * (16 * AQT);
#pragma unroll
    for (int q = 0; q < AQT; ++q) {
#pragma unroll
      for (int dv = 0; dv < 4; ++dv) *(f32x4*)(po + q * 16 + dv * 4) = st.o[q][dv];
      if (g == 0) { pm[wave * QW + q * 16 + r] = st.m[q]; pm[4 * QW + wave * QW + q * 16 + r] = lt[q]; }
    }
  }
  __syncthreads();
  if (wave == 0) {
#pragma unroll
    for (int q = 0; q < AQT; ++q) {
      const float m1 = pm[1 * QW + q * 16 + r], m2 = pm[2 * QW + q * 16 + r], m3 = pm[3 * QW + q * 16 + r];
      const float l1 = pm[4 * QW + 1 * QW + q * 16 + r], l2 = pm[4 * QW + 2 * QW + q * 16 + r], l3 = pm[4 * QW + 3 * QW + q * 16 + r];
      const float M = fmaxf(fmaxf(st.m[q], m1), fmaxf(m2, m3));
      const float a0 = __builtin_amdgcn_exp2f(st.m[q] - M), a1 = __builtin_amdgcn_exp2f(m1 - M), a2 = __builtin_amdgcn_exp2f(m2 - M), a3 = __builtin_amdgcn_exp2f(m3 - M);
      const float inv = 1.f / (lt[q] * a0 + l1 * a1 + l2 * a2 + l3 * a3);
#pragma unroll
      for (int dv = 0; dv < 4; ++dv) {
        const f32x4 o1 = *(const f32x4*)(sm + 1 * WS + lane * (16 * AQT) + q * 16 + dv * 4);
        const f32x4 o2 = *(const f32x4*)(sm + 2 * WS + lane * (16 * AQT) + q * 16 + dv * 4);
        const f32x4 o3 = *(const f32x4*)(sm + 3 * WS + lane * (16 * AQT) + q * 16 + dv * 4);
        st.o[q][dv] = (st.o[q][dv] * a0 + o1 * a1 + o2 * a2 + o3 * a3) * inv;
      }
    }
    write_o<AQT>(p, st, tok0, ocol);
  }
  __syncthreads();
}

__device__ __forceinline__ int q_next(unsigned* cnt, volatile LAS unsigned* slot) {
  __syncthreads();
  if (threadIdx.x == 0) *slot = xb_add(cnt, 1u);
  __syncthreads();
  return (int)*slot;
}

#if REP_SYNC
#define GSYNC() do { xcd_barrier(xb); xcd_barrier(xb); } while (0)
#else
#define GSYNC() xcd_barrier(xb)
#endif
__global__ void __launch_bounds__(256, 2) mega(Params p) {
  extern __shared__ __attribute__((aligned(16))) unsigned char smem[];
  cg::grid_group grid = cg::this_grid();
  const int nblk = gridDim.x, bid = blockIdx.x;
  u16* sm16 = (u16*)smem;
  __shared__ uint4 xb_words;
  if (threadIdx.x == 0) xb_words = make_uint4(0u, 0u, 0u, 0u);
  __syncthreads();
  XcdBarrier xb = xcd_barrier_post(p.bar, (volatile LAS unsigned*)&xb_words);

  for (int rep = 0; rep <= REP_P0; ++rep)
    for (int it = bid; it < P0_ITEMS; it += nblk) p0_item(p, it, smem);
  if (p.use_cg_sync) grid.sync();
  GSYNC();

#pragma unroll 1
  for (int l = 0; l < 4; ++l) {
    for (int it = bid; it < 384; it += nblk) norm_item(p, l, 0, it);
    GSYNC();
    { int tx, ty; for (int j = 0; tile_map(j, 18, tx, ty); ++j) gin_tile(p, l, tx, ty, sm16); }
    GSYNC();
    {
      constexpr int CD = 64 * NQG_CTX, CC = 2 * 64 * NQG_CTX / 4;
      constexpr int LD = 8 * NQG_LAT, LC = 2 * 8 * NQG_LAT;
      constexpr int E0 = 192, E1 = E0 + LD, E2 = E1 + LC, E3 = E2 + 32, E4 = E3 + CC, E5 = E4 + CD, E6 = E5 + 64;
      unsigned* qc = p.bar + XCD_BAR_WORDS + l * 64;
      for (int it = bid; it < E6; it = nblk + q_next(qc, &xb.st[2])) {
        if (it < E0) f1_tile(p, l, it, sm16);
        else if (it < E1) attn_diff_item(p, l, true, it - E0, (float*)smem);
        else if (it < E2) attn_lat_item(p, l, it - E1, (float*)smem);
        else if (it < E3) f2_tile(p, l, it - E2, sm16);
        else if (it < E4) attn_ctx_item(p, l, it - E3);
        else if (it < E5) attn_diff_item(p, l, false, it - E4, (float*)smem);
        else f2_tile(p, l, it - E5 + 32, sm16);
      }
    }
    GSYNC();
    { int tx, ty; for (int j = 0; tile_map(j, 8, tx, ty, 64); ++j) res_tile(p, l, tx, ty, p.cat, p.w_outT + (size_t)l * 1024 * 1024, 1024, 2, sm16); }
    GSYNC();
    for (int it = bid; it < 384; it += nblk) norm_item(p, l, 1, it);
    GSYNC();
    { int tx, ty; for (int j = 0; tile_map(j, 32, tx, ty); ++j) m1_tile(p, l, tx, ty, sm16); }
    GSYNC();
    { int tx, ty; for (int j = 0; tile_map(j, 8, tx, ty, 64); ++j) res_tile(p, l, tx, ty, p.u, p.w2T + (size_t)l * 1024 * 4096, 4096, 5, sm16); }
    GSYNC();
  }
  for (int it = bid; it < 384; it += nblk) norm_item(p, 0, 2, it);
}

extern "C" void kernel_launch(void* const* d_in, const int* in_sizes, int n_in, void* d_out, int out_size, void* d_ws,
                              size_t ws_size, hipStream_t stream) {
  static int grid_blocks = 0;
  if (grid_blocks == 0) {
    int dev = 0, cus = 0, per_cu = 0;
    (void)hipGetDevice(&dev);
    (void)hipDeviceGetAttribute(&cus, hipDeviceAttributeMultiprocessorCount, dev);
    if (hipFuncSetAttribute((const void*)mega, hipFuncAttributeMaxDynamicSharedMemorySize, LDS_BYTES) != hipSuccess) {
      fprintf(stderr, "hipFuncSetAttribute failed\n");
    }
    if (hipOccupancyMaxActiveBlocksPerMultiprocessor(&per_cu, (const void*)mega, 256, LDS_BYTES) != hipSuccess || per_cu < 1) {
      fprintf(stderr, "occupancy query failed (%d)\n", per_cu);
      per_cu = 1;
    }
    if (per_cu > 2) per_cu = 2;
    grid_blocks = cus * per_cu;
    fprintf(stderr, "mega: cus=%d per_cu=%d grid=%d ws=%zu\n", cus, per_cu, grid_blocks, ws_size);
  }
  Params p{};
  const float** pin = (const float**)&p;
  for (int i = 0; i < 27; ++i) pin[i] = (const float*)d_in[i];
  p.out = (float*)d_out;
  unsigned char* ws = (unsigned char*)d_ws;
  size_t off = 0;
  auto take = [&](size_t bytes) { unsigned char* q = ws + off; off += (bytes + 255) & ~(size_t)255; return q; };
  p.xres = (float*)take((size_t)NTOK * 1024 * 4);
  p.mods = (float*)take((size_t)4 * 3 * 6144 * 4);
  p.h = (u16*)take((size_t)NTOK * 1024 * 2);
  p.z = (u16*)take((size_t)NTOK * INW * 2);
  p.vt = (u16*)take((size_t)640 * NTOK * 2);
  p.cat = (u16*)take((size_t)NTOK * 1024 * 2);
  p.u = (u16*)take((size_t)NTOK * 4096 * 2);
  p.uv = (u16*)take((size_t)(16 * 256 * 512 + 2 * 256 * 2048) * 2);
  p.w_inT = (u16*)take((size_t)4 * 2304 * 1024 * 2);
  p.w_outT = (u16*)take((size_t)4 * 1024 * 1024 * 2);
  p.w1T = (u16*)take((size_t)4 * 4096 * 1024 * 2);
  p.w2T = (u16*)take((size_t)4 * 4096 * 1024 * 2);
  p.pqt = (u16*)take((size_t)4 * 512 * 256 * 2);
  p.dft256 = (u16*)take((size_t)256 * 512 * 2);
  p.dft1024 = (u16*)take((size_t)1024 * 2048 * 2);
  p.ck_na = (u16*)take((size_t)2 * 4 * 512 * 256 * 2);
  p.cvt_na = (u16*)take((size_t)2 * 4 * 512 * 256 * 2);
  p.ck_diff = (u16*)take((size_t)2 * 4 * 512 * 256 * 2);
  p.cvt_diff = (u16*)take((size_t)2 * 4 * 512 * 256 * 2);
  p.ck_swa = (u16*)take((size_t)2 * 4 * 512 * 128 * 2);
  p.cvt_swa = (u16*)take((size_t)2 * 4 * 512 * 128 * 2);
  p.kfr = (u16*)take((size_t)10 * 192 * 2048 * 2);
  p.vfr = (u16*)take((size_t)10 * 192 * 2048 * 2);
  p.ropeD = (float*)take(1024 * 4);
  p.ropeS = (float*)take(2048 * 4);
  p.bar = (unsigned*)take((XCD_BAR_WORDS + 12 * 64) * 4);
  if (off > ws_size) { fprintf(stderr, "workspace too small: need %zu have %zu\n", off, ws_size); return; }
  if (hipMemsetAsync(p.bar, 0, (XCD_BAR_WORDS + 12 * 64) * 4, stream) != hipSuccess) fprintf(stderr, "memset failed\n");
  void* args[] = {&p};
  hipError_t e = hipLaunchCooperativeKernel((const void*)mega, dim3(grid_blocks), dim3(256), args, LDS_BYTES, stream);
  if (e != hipSuccess) fprintf(stderr, "cooperative launch failed: %s (grid %d)\n", hipGetErrorString(e), grid_blocks);
}
```

```cpp
#include <hip/hip_runtime.h>
#include <hip/hip_cooperative_groups.h>
#include <stdint.h>
#include <stdio.h>
namespace cg = cooperative_groups;

typedef unsigned short u16;
typedef __attribute__((ext_vector_type(8))) short bf16x8;
typedef __attribute__((ext_vector_type(4))) float f32x4;
typedef __attribute__((ext_vector_type(4))) unsigned u32x4;
__device__ __forceinline__ void gload16(u32x4& dst, const void* ptr) {
  asm volatile("global_load_dwordx4 %0, %1, off" : "=v"(dst) : "v"(ptr) : "memory");
}

#define NTOK 6144
#define NPTOK 4096
#define INW 2304
#define LOG2E 1.4426950408889634f
#define LDS_BYTES 73728
#define LSTR 72

#define O_NAK 6291456
#define O_NAV 10485760
#define O_DK 14680064
#define O_DV 18874368
#define O_SK 23068672
#define O_SV 25165824

struct Params {
  const float *x_prompt, *x_sample, *c_na_k, *c_na_v, *c_diff_k, *c_diff_v, *c_swa_k, *c_swa_v, *c, *c_ctx;
  const float *w_ada, *b_ada, *norm1_g, *norm2_g, *w_in, *na_rpb, *lq1, *lk1, *lq2, *lk2, *subln_g, *w_fourier, *swa_sink;
  const float *w_out, *w1, *w2, *final_g;
  float* out;
  float* xres;
  float* mods;
  u16 *h, *z, *vt, *cat, *u, *uv, *w_inT, *w_outT, *w1T, *w2T, *pqt, *dft256, *dft1024;
  u16 *ck_na, *cvt_na, *ck_diff, *cvt_diff, *ck_swa, *cvt_swa;
  float *ropeD, *ropeS;
  u16 *kfr, *vfr;
  unsigned* bar;
  int use_cg_sync;
  int pad_;
};

__device__ __forceinline__ u16 f2bf(float f) {
  unsigned u = __float_as_uint(f);
  u += 0x7fffu + ((u >> 16) & 1u);
  return (u16)(u >> 16);
}
__device__ __forceinline__ int otid() { int t = threadIdx.x; asm volatile("" : "+v"(t)); return t; }
__device__ __forceinline__ float bf2f(u16 h) { return __uint_as_float(((unsigned)h) << 16); }
typedef __attribute__((ext_vector_type(2))) __bf16 hbf16x2;
typedef __attribute__((ext_vector_type(2))) float f32x2;
__device__ __forceinline__ unsigned pack2(float a, float b) {
  f32x2 v = {a, b};
  union { hbf16x2 h; unsigned u; } x;
  x.h = __builtin_convertvector(v, hbf16x2);
  return x.u;
}

__device__ __forceinline__ int kfrag_off(int kk, int d) {
  const int t = (kk >> 2) & 1, r = ((kk >> 3) << 2) | (kk & 3), dc = d >> 5, g = (d >> 3) & 3;
  return ((t * 2 + dc) * 64 + g * 16 + r) * 8 + (d & 7);
}
__device__ __forceinline__ int vfrag_off(int kk, int dv) {
  return (((dv >> 4) * 64) + (kk >> 3) * 16 + (dv & 15)) * 8 + (kk & 7);
}

#define XB_TMO      128
#define XB_XCNT(j)  (256  + 64 * (j))
#define XB_XSUB(j)  (1280 + 64 * (j))
#define XB_XGEN(j)  (2304 + 64 * (j))
#define XB_TOP      3328
#define XB_TOPGEN   3392
#define XCD_BAR_WORDS 3456
#define XB_SPIN_CAP (1u << 22)
#define LAS __attribute__((address_space(3)))
__device__ __forceinline__ unsigned xb_ld(unsigned* p)              { return __hip_atomic_load(p, __ATOMIC_RELAXED, __HIP_MEMORY_SCOPE_AGENT); }
__device__ __forceinline__ unsigned xb_add(unsigned* p, unsigned v) { return __hip_atomic_fetch_add(p, v, __ATOMIC_RELAXED, __HIP_MEMORY_SCOPE_AGENT); }
__device__ __forceinline__ unsigned xb_xcc_id() { return (unsigned)__builtin_amdgcn_s_getreg((3 << 11) | 20) & 0xFu; }
#define XB_SPIN(cond, bar) do { unsigned _sp = 0; while (cond) { __builtin_amdgcn_s_sleep(1); \
    if ((++_sp & 255u) == 0u) { if (xb_ld(&(bar)[XB_TMO])) break; if (_sp > XB_SPIN_CAP) { atomicAdd(&(bar)[XB_TMO], 1u); break; } } } } while (0)
struct XcdBarrier { unsigned* bar; unsigned x; volatile LAS unsigned* st; };
__device__ __forceinline__ XcdBarrier xcd_barrier_post(unsigned* bar, volatile LAS unsigned* st) {
  XcdBarrier b; b.bar = bar; b.x = xb_xcc_id(); b.st = st;
  if (threadIdx.x == 0) (void)xb_add(&bar[XB_XCNT(b.x)], 1u);
  return b;
}
__device__ __forceinline__ void xcd_barrier_complete(unsigned* bar, unsigned x, unsigned& nloc, unsigned& nx) {
  const unsigned G = gridDim.x * gridDim.y * gridDim.z;
  unsigned sum, cnt, mine, sp = 0u;
  for (;;) {
    sum = 0u; cnt = 0u; mine = 0u;
#pragma unroll
    for (unsigned j = 0; j < 16; ++j) { const unsigned c = xb_ld(&bar[XB_XCNT(j)]); sum += c; cnt += (c > 0u) ? 1u : 0u; mine = (j == x) ? c : mine; }
    if (sum == G) break;
    __builtin_amdgcn_s_sleep(1);
    if ((++sp & 255u) == 0u) { if (xb_ld(&bar[XB_TMO])) break; if (sp > XB_SPIN_CAP) { atomicAdd(&bar[XB_TMO], 1u); break; } }
  }
  nloc = mine > 0u ? mine : 1u; nx = cnt > 0u ? cnt : 1u;
}
__device__ __forceinline__ void xcd_barrier(const XcdBarrier& b) {
  asm volatile("s_waitcnt vmcnt(0)" ::: "memory");
  __syncthreads();
  if (threadIdx.x == 0) {
    unsigned* bar = b.bar;
    __builtin_amdgcn_s_waitcnt(0);
    unsigned nloc = b.st[0], nx = b.st[1];
    if (nloc == 0u) { xcd_barrier_complete(bar, b.x, nloc, nx); b.st[0] = nloc; b.st[1] = nx; }
    const unsigned old = xb_add(&bar[XB_XSUB(b.x)], 1u);
    const unsigned gen = old / nloc;
    if (old + 1u == (gen + 1u) * nloc) {
      __builtin_amdgcn_fence(__ATOMIC_RELEASE, "agent");
      asm volatile("s_waitcnt vmcnt(0)" ::: "memory");
      const unsigned og = xb_add(&bar[XB_TOP], 1u);
      const unsigned tg = og / nx;
      if (og + 1u == (tg + 1u) * nx) xb_add(&bar[XB_TOPGEN], 1u);
      else XB_SPIN(xb_ld(&bar[XB_TOPGEN]) == tg, bar);
      __builtin_amdgcn_fence(__ATOMIC_ACQUIRE, "agent");
      xb_add(&bar[XB_XGEN(b.x)], 1u);
      asm volatile("s_waitcnt vmcnt(0)" ::: "memory");
    } else {
      XB_SPIN(xb_ld(&bar[XB_XGEN(b.x)]) == gen, bar);
      __builtin_amdgcn_fence(__ATOMIC_ACQUIRE, "agent");
      asm volatile("s_waitcnt vmcnt(0)" ::: "memory");
    }
  }
  __syncthreads();
}

__device__ __forceinline__ void transpose_tile(const float* __restrict__ src, int lds_, u16* __restrict__ dst, int ldd,
                                               int k0, int n0, float* sm, bool fragv = false) {
  const int tid = otid();
  const int c4 = (tid & 15) * 4, r0 = tid >> 4;
  float4 v[8];
#pragma unroll
  for (int i = 0; i < 8; ++i) v[i] = *(const float4*)(src + (size_t)(k0 + r0 + 16 * i) * lds_ + n0 + c4);
#pragma unroll
  for (int i = 0; i < 8; ++i) {
    const int k = r0 + 16 * i;
    sm[(c4 + 0) * 129 + k] = v[i].x; sm[(c4 + 1) * 129 + k] = v[i].y; sm[(c4 + 2) * 129 + k] = v[i].z; sm[(c4 + 3) * 129 + k] = v[i].w;
  }
  __syncthreads();
  const int k8 = (tid & 15) * 8, nn = tid >> 4;
#pragma unroll
  for (int i = 0; i < 4; ++i) {
    const int n = nn + 16 * i;
    const float* row = sm + n * 129 + k8;
    uint4 w;
    w.x = pack2(row[0], row[1]); w.y = pack2(row[2], row[3]); w.z = pack2(row[4], row[5]); w.w = pack2(row[6], row[7]);
    if (fragv) {
      const int col = n0 + n, pos = k0 + k8;
      *(uint4*)(dst + ((size_t)((col >> 6) * 16 + (pos >> 5))) * 2048 + vfrag_off(pos & 31, col & 63)) = w;
    } else {
      *(uint4*)(dst + (size_t)(n0 + n) * ldd + k0 + k8) = w;
    }
  }
  __syncthreads();
}

__device__ __forceinline__ void adaln_item(const Params& p, int it, float* sm) {
  const int l = it / 96, c0 = (it % 96) * 64;
  float* ssil = sm;
  float* red = sm + 3072;
  const int tid = otid();
  for (int i = tid; i < 3072; i += 256) {
    const int cnd = i >> 10, k = i & 1023;
    const float v = cnd == 0 ? p.c_ctx[k] : p.c[(cnd - 1) * 1024 + k];
    ssil[i] = v / (1.f + expf(-v));
  }
  __syncthreads();
  const int cg4 = (tid & 15) * 4, ks = tid >> 4;
  const float* w = p.w_ada + (size_t)l * 1024 * 6144 + c0 + cg4;
  float a0[4] = {0.f, 0.f, 0.f, 0.f}, a1[4] = {0.f, 0.f, 0.f, 0.f}, a2[4] = {0.f, 0.f, 0.f, 0.f};
#pragma unroll 16
  for (int kk = 0; kk < 64; ++kk) {
    const int k = kk * 16 + ks;
    const float4 v = *(const float4*)(w + (size_t)k * 6144);
    const float s0 = ssil[k], s1 = ssil[1024 + k], s2 = ssil[2048 + k];
    a0[0] += s0 * v.x; a0[1] += s0 * v.y; a0[2] += s0 * v.z; a0[3] += s0 * v.w;
    a1[0] += s1 * v.x; a1[1] += s1 * v.y; a1[2] += s1 * v.z; a1[3] += s1 * v.w;
    a2[0] += s2 * v.x; a2[1] += s2 * v.y; a2[2] += s2 * v.z; a2[3] += s2 * v.w;
  }
#pragma unroll
  for (int j = 0; j < 4; ++j) {
    red[(ks * 3 + 0) * 64 + cg4 + j] = a0[j];
    red[(ks * 3 + 1) * 64 + cg4 + j] = a1[j];
    red[(ks * 3 + 2) * 64 + cg4 + j] = a2[j];
  }
  __syncthreads();
  if (tid < 192) {
    const int cnd = tid >> 6, j = tid & 63;
    float s = p.b_ada[l * 6144 + c0 + j];
    for (int q = 0; q < 16; ++q) s += red[(q * 3 + cnd) * 64 + j];
    p.mods[(l * 3 + cnd) * 6144 + c0 + j] = s;
  }
  __syncthreads();
}

__device__ __forceinline__ void cvt_item(const float* __restrict__ src, u16* __restrict__ dst, int it, int W) {
  const int w8 = W >> 3;
#pragma unroll
  for (int i = 0; i < 4; ++i) {
    const int u = it * 1024 + i * 256 + otid();
    const int d8 = u % w8, pos = (u / w8) & 511, bl = u / (w8 * 512);
    const float* sp = src + ((size_t)(bl * 512 + pos) * W + d8 * 8);
    const float4 v0 = *(const float4*)sp, v1 = *(const float4*)(sp + 4);
    uint4 w; w.x = pack2(v0.x, v0.y); w.y = pack2(v0.z, v0.w); w.z = pack2(v1.x, v1.y); w.w = pack2(v1.z, v1.w);
    const int h = d8 >> 3, d = (d8 & 7) * 8;
    *(uint4*)(dst + ((size_t)((bl * (W >> 6) + h) * 16 + (pos >> 5))) * 2048 + kfrag_off(pos & 31, d)) = w;
  }
}

__device__ __forceinline__ void pq_item(const Params& p, int it, float* sm) {
  const int l = it >> 3, which = (it >> 2) & 1, g = it & 3;
  const int n = otid();
  if (n < 64) sm[n] = which ? sinpif(2.f * (float)n / 64.f) : cospif(2.f * (float)n / 64.f);
  __syncthreads();
  float w[64];
#pragma unroll
  for (int m = 0; m < 64; ++m) w[m] = p.w_fourier[(size_t)l * 65536 + (g * 64 + m) * 256 + n];
  u16* dst = p.pqt + (size_t)l * 512 * 256 + (size_t)(which * 256 + n) * 256 + g * 64;
  for (int c = 0; c < 64; ++c) {
    float s = 0.f;
#pragma unroll
    for (int m = 0; m < 64; ++m) s += sm[(c * m) & 63] * w[m];
    dst[c] = f2bf(s);
  }
  __syncthreads();
}

__device__ __forceinline__ void dft_item(u16* dst, int L, int it) {
  const int twoL = 2 * L;
  for (int e = otid(); e < 8192; e += 256) {
    const int idx = it * 8192 + e;
    const int k = idx / twoL, j = idx % twoL;
    const int jj = j & (L - 1);
    const int ph = (k * jj) & (L - 1);
    const float a = 2.f * (float)ph / (float)L;
    const float v = (j >= L) ? -sinpif(a) : cospif(a);
    dst[idx] = f2bf(v);
  }
}

#define P0_WT 1440
#define P0_ADA 384
#define P0_XC 384
#define P0_CK 320
#define P0_CVT 320
#define P0_PQ 32
#define P0_DFT 272
#define P0_ITEMS (P0_ADA + P0_WT + P0_XC + P0_CK + P0_CVT + P0_PQ + P0_DFT + 1)

__device__ void wt_item(const Params& p, int l, int r, float* sm) {
  if (r < 288) { transpose_tile(p.w_in + (size_t)l * 1024 * 2304, 2304, p.w_inT + (size_t)l * 2304 * 1024, 1024, (r / 36) * 128, (r % 36) * 64, sm); return; }
  r -= 288;
  if (r < 128) { transpose_tile(p.w_out + (size_t)l * 1024 * 1024, 1024, p.w_outT + (size_t)l * 1024 * 1024, 1024, (r / 16) * 128, (r % 16) * 64, sm); return; }
  r -= 128;
  if (r < 512) { transpose_tile(p.w1 + (size_t)l * 1024 * 4096, 4096, p.w1T + (size_t)l * 4096 * 1024, 1024, (r / 64) * 128, (r % 64) * 64, sm); return; }
  r -= 512;
  transpose_tile(p.w2 + (size_t)l * 4096 * 1024, 1024, p.w2T + (size_t)l * 1024 * 4096, 4096, (r / 16) * 128, (r % 16) * 64, sm);
}

__device__ void p0_item(const Params& p, int it, unsigned char* smem) {
  float* sm = (float*)smem;
  if (it < P0_ADA) { adaln_item(p, it, sm); return; }
  it -= P0_ADA;
  if (it < P0_WT) { wt_item(p, 0, it, sm); return; }
  it -= P0_WT;
  if (it < P0_XC) {
    const int row0 = it * 16;
    const float* src = row0 < NPTOK ? p.x_prompt + (size_t)row0 * 1024 : p.x_sample + (size_t)(row0 - NPTOK) * 1024;
    float* dst = p.xres + (size_t)row0 * 1024;
#pragma unroll
    for (int i = 0; i < 16; ++i) {
      const int o = (i * 256 + otid()) * 4;
      *(float4*)(dst + o) = *(const float4*)(src + o);
    }
    return;
  }
  it -= P0_XC;
  if (it < P0_CK) {
    if (it < 128) { cvt_item(p.c_na_k, p.ck_na, it, 256); return; }
    it -= 128;
    if (it < 128) { cvt_item(p.c_diff_k, p.ck_diff, it, 256); return; }
    it -= 128;
    cvt_item(p.c_swa_k, p.ck_swa, it, 128);
    return;
  }
  it -= P0_CK;
  if (it < P0_CVT) {
    if (it < 128) { const int bl = it >> 4, r = it & 15; transpose_tile(p.c_na_v + (size_t)bl * 512 * 256, 256, p.cvt_na + (size_t)bl * 256 * 512, 512, (r >> 2) * 128, (r & 3) * 64, sm, true); return; }
    it -= 128;
    if (it < 128) { const int bl = it >> 4, r = it & 15; transpose_tile(p.c_diff_v + (size_t)bl * 512 * 256, 256, p.cvt_diff + (size_t)bl * 256 * 512, 512, (r >> 2) * 128, (r & 3) * 64, sm, true); return; }
    it -= 128;
    { const int bl = it >> 3, r = it & 7; transpose_tile(p.c_swa_v + (size_t)bl * 512 * 128, 128, p.cvt_swa + (size_t)bl * 128 * 512, 512, (r >> 1) * 128, (r & 1) * 64, sm, true); return; }
  }
  it -= P0_CVT;
  if (it < P0_PQ) { pq_item(p, it, sm); return; }
  it -= P0_PQ;
  if (it < 16) { dft_item(p.dft256, 256, it); return; }
  it -= 16;
  if (it < 256) { dft_item(p.dft1024, 1024, it); return; }
  for (int e = otid(); e < 512 + 1024; e += 256) {
    const bool isD = e < 512;
    const int ee = isD ? e : e - 512;
    const int nf = isD ? 8 : 16;
    const int pos = ee / nf, fi = ee % nf;
    const float inv = exp2f(-(float)fi * (13.287712379549449f / (float)nf));
    float tt = (float)pos * inv * 0.15915494309189535f;
    tt -= rintf(tt);
    float sn, cs;
    sincospif(2.f * tt, &sn, &cs);
    if (isD) { p.ropeD[ee] = cs; p.ropeD[512 + ee] = sn; }
    else { p.ropeS[ee] = cs; p.ropeS[1024 + ee] = sn; }
  }
}

__device__ __forceinline__ void norm_item(const Params& p, int l, int which, int it) {
  const int lane = otid() & 63, wave = otid() >> 6;
  const int row0 = it * 16 + wave * 4;
  float4 v[4][4];
#pragma unroll
  for (int j = 0; j < 4; ++j)
#pragma unroll
    for (int k = 0; k < 4; ++k) v[j][k] = *(const float4*)(p.xres + (size_t)(row0 + j) * 1024 + (k * 64 + lane) * 4);
  float rs[4];
#pragma unroll
  for (int j = 0; j < 4; ++j) {
    float ss = 0.f;
#pragma unroll
    for (int k = 0; k < 4; ++k) ss += v[j][k].x * v[j][k].x + v[j][k].y * v[j][k].y + v[j][k].z * v[j][k].z + v[j][k].w * v[j][k].w;
#pragma unroll
    for (int o = 32; o >= 1; o >>= 1) ss += __shfl_xor(ss, o);
    rs[j] = rsqrtf(ss * (1.f / 1024.f) + 1e-6f);
  }
  if (which < 2) {
    const int cond = row0 < NPTOK ? 0 : 1 + ((row0 - NPTOK) >> 10);
    const float* gp = (which == 0 ? p.norm1_g : p.norm2_g) + l * 1024;
    const float* shp = p.mods + (size_t)(l * 3 + cond) * 6144 + (which * 3 + 0) * 1024;
    const float* scp = shp + 1024;
#pragma unroll
    for (int k = 0; k < 4; ++k) {
      const int col = (k * 64 + lane) * 4;
      const float4 gg = *(const float4*)(gp + col);
      const float4 sh = *(const float4*)(shp + col);
      const float4 sc = *(const float4*)(scp + col);
      const float mx = gg.x * (1.f + sc.x), my = gg.y * (1.f + sc.y), mz = gg.z * (1.f + sc.z), mw = gg.w * (1.f + sc.w);
#pragma unroll
      for (int j = 0; j < 4; ++j) {
        uint2 w;
        w.x = pack2(v[j][k].x * rs[j] * mx + sh.x, v[j][k].y * rs[j] * my + sh.y);
        w.y = pack2(v[j][k].z * rs[j] * mz + sh.z, v[j][k].w * rs[j] * mw + sh.w);
        *(uint2*)(p.h + (size_t)(row0 + j) * 1024 + col) = w;
      }
    }
  } else {
#pragma unroll
    for (int k = 0; k < 4; ++k) {
      const int col = (k * 64 + lane) * 4;
      const float4 gg = *(const float4*)(p.final_g + col);
#pragma unroll
      for (int j = 0; j < 4; ++j) {
        float4 o;
        o.x = v[j][k].x * rs[j] * gg.x; o.y = v[j][k].y * rs[j] * gg.y; o.z = v[j][k].z * rs[j] * gg.z; o.w = v[j][k].w * rs[j] * gg.w;
        *(float4*)(p.out + (size_t)(row0 + j) * 1024 + col) = o;
      }
    }
  }
}

template <bool ZERO, int YT>
__device__ __forceinline__ void gemm_main_t(const u16* __restrict__ X, int ldx, const u16* __restrict__ Y, int ldy, int K,
                                          u16* smem, f32x4 (&acc)[4][YT]) {
  const int tid = otid(), lane = tid & 63, wave = tid >> 6, wx = wave & 1, wy = wave >> 1, r = lane & 15, g = lane >> 4;
  u16* sX = smem;
  u16* sY = smem + 2 * 128 * LSTR;
  const int lrow = tid >> 3, lkc = tid & 7;
  const u16* gx = X + (size_t)lrow * ldx + lkc * 8;
  const u16* gy = Y + (size_t)lrow * ldy + lkc * 8;
  u32x4 rx[4], ry[YT];
#pragma unroll
  for (int i = 0; i < 4; ++i) rx[i] = *(const u32x4*)(gx + (size_t)(32 * i) * ldx);
#pragma unroll
  for (int i = 0; i < YT; ++i) ry[i] = *(const u32x4*)(gy + (size_t)(32 * i) * ldy);
  if (ZERO) {
#pragma unroll
    for (int a = 0; a < 4; ++a)
#pragma unroll
      for (int b = 0; b < YT; ++b) acc[a][b] = (f32x4){0.f, 0.f, 0.f, 0.f};
  }
#pragma unroll
  for (int i = 0; i < 4; ++i) *(u32x4*)(sX + (lrow + 32 * i) * LSTR + lkc * 8) = rx[i];
#pragma unroll
  for (int i = 0; i < YT; ++i) *(u32x4*)(sY + (lrow + 32 * i) * LSTR + lkc * 8) = ry[i];
  __syncthreads();
  const int nk = K >> 6;
  const u16* cx0 = sX + (wx * 64 + r) * LSTR + g * 8;
  const u16* cy0 = sY + (wy * (16 * YT) + r) * LSTR + g * 8;
#define GEMM_COMPUTE(cur)                                                                            \
  {                                                                                                  \
    const u16* cx = cx0 + (cur) * 128 * LSTR;                                                        \
    const u16* cy = cy0 + (cur) * 128 * LSTR;                                                        \
    _Pragma("unroll") for (int kk = 0; kk < 2; ++kk) {                                               \
      bf16x8 a[4], b[YT];                                                                            \
      _Pragma("unroll") for (int i = 0; i < 4; ++i) a[i] = *(const bf16x8*)(cx + i * 16 * LSTR + kk * 32); \
      _Pragma("unroll") for (int i = 0; i < YT; ++i) b[i] = *(const bf16x8*)(cy + i * 16 * LSTR + kk * 32); \
      _Pragma("unroll") for (int xi = 0; xi < 4; ++xi)                                               \
        _Pragma("unroll") for (int yi = 0; yi < YT; ++yi)                                            \
          acc[xi][yi] = __builtin_amdgcn_mfma_f32_16x16x32_bf16(a[xi], b[yi], acc[xi][yi], 0, 0, 0); \
    }                                                                                                \
  }
  u32x4 bx[4], by[YT];
  u16* const w1X = sX + 128 * LSTR + lrow * LSTR + lkc * 8;
  u16* const w1Y = sY + 128 * LSTR + lrow * LSTR + lkc * 8;
  u16* const w0X = sX + lrow * LSTR + lkc * 8;
  u16* const w0Y = sY + lrow * LSTR + lkc * 8;
#pragma unroll 1
  for (int kt = 0; kt + 2 < nk; kt += 2) {
#pragma unroll
    for (int i = 0; i < 4; ++i) gload16(rx[i], gx + (size_t)(32 * i) * ldx + (kt + 1) * 64);
#pragma unroll
    for (int i = 0; i < YT; ++i) gload16(ry[i], gy + (size_t)(32 * i) * ldy + (kt + 1) * 64);
#pragma unroll
    for (int i = 0; i < 4; ++i) gload16(bx[i], gx + (size_t)(32 * i) * ldx + (kt + 2) * 64);
#pragma unroll
    for (int i = 0; i < YT; ++i) gload16(by[i], gy + (size_t)(32 * i) * ldy + (kt + 2) * 64);
    GEMM_COMPUTE(0);
    if (YT == 4) asm volatile("s_waitcnt vmcnt(8)" ::: "memory"); else asm volatile("s_waitcnt vmcnt(7)" ::: "memory");
#pragma unroll
    for (int i = 0; i < 4; ++i) *(u32x4*)(w1X + 32 * i * LSTR) = rx[i];
#pragma unroll
    for (int i = 0; i < YT; ++i) *(u32x4*)(w1Y + 32 * i * LSTR) = ry[i];
    __syncthreads();
    GEMM_COMPUTE(1);
    asm volatile("s_waitcnt vmcnt(0)" ::: "memory");
#pragma unroll
    for (int i = 0; i < 4; ++i) *(u32x4*)(w0X + 32 * i * LSTR) = bx[i];
#pragma unroll
    for (int i = 0; i < YT; ++i) *(u32x4*)(w0Y + 32 * i * LSTR) = by[i];
    __syncthreads();
  }
  {
#pragma unroll
    for (int i = 0; i < 4; ++i) gload16(rx[i], gx + (size_t)(32 * i) * ldx + (nk - 1) * 64);
#pragma unroll
    for (int i = 0; i < YT; ++i) gload16(ry[i], gy + (size_t)(32 * i) * ldy + (nk - 1) * 64);
    GEMM_COMPUTE(0);
    asm volatile("s_waitcnt vmcnt(0)" ::: "memory");
#pragma unroll
    for (int i = 0; i < 4; ++i) *(u32x4*)(w1X + 32 * i * LSTR) = rx[i];
#pragma unroll
    for (int i = 0; i < YT; ++i) *(u32x4*)(w1Y + 32 * i * LSTR) = ry[i];
    __syncthreads();
  }
  GEMM_COMPUTE(1);
  __syncthreads();
#undef GEMM_COMPUTE
}

#ifndef REP_GEMM
#define REP_GEMM 0
#endif
#ifndef REP_MIX
#define REP_MIX 0
#endif
#ifndef REP_SYNC
#define REP_SYNC 0
#endif
#ifndef REP_P0
#define REP_P0 0
#endif
template <int YT>
__device__ __forceinline__ void gemm_main(const u16* __restrict__ X, int ldx, const u16* __restrict__ Y, int ldy, int K,
                                          u16* smem, f32x4 (&acc)[4][YT]) {
  gemm_main_t<true, YT>(X, ldx, Y, ldy, K, smem, acc);
#if REP_GEMM
  gemm_main_t<false, YT>(X, ldx, Y, ldy, K, smem, acc);
#pragma unroll
  for (int a = 0; a < 4; ++a)
#pragma unroll
    for (int b = 0; b < YT; ++b) acc[a][b] *= 0.5f;
#endif
}

__device__ __forceinline__ bool tile_map(int j, int ntx, int& tx, int& ty, int nty = 48) {
  const int nblk = gridDim.x, bid = blockIdx.x;
  if (nblk == 512) {
    const int per = nty >> 3, hp = per >> 1;
    const int rank = bid >> 3, q = (rank & 31) + j * 32, mem = rank >> 5;
    if (q >= hp * ntx) return false;
    tx = q / hp; ty = per * (bid & 7) + 2 * (q % hp) + mem;
    return true;
  } else {
    const int it = bid + j * nblk;
    if (it >= nty * ntx) return false;
    tx = it / nty; ty = it % nty;
    return true;
  }
}

__device__ void gin_tile(const Params& p, int l, int tx, int ty, u16* smem) {
  const int n0 = tx * 128, m0 = ty * 128;
  f32x4 acc[4][4];
  gemm_main<4>(p.w_inT + (size_t)l * 2304 * 1024 + (size_t)n0 * 1024, 1024, p.h + (size_t)m0 * 1024, 1024, 1024, smem, acc);
  const int lane = otid() & 63, wave = otid() >> 6, wx = wave & 1, wy = wave >> 1, r = lane & 15, g = lane >> 4;
  const int nw = n0 + wx * 64;
  const bool isS = m0 >= NPTOK;
  int ropeMode = 0;
  if (isS) {
    if (nw >= 768 && nw < 1280) ropeMode = 1;
    else if (nw >= 1792 && nw < 2176) ropeMode = 2;
  }
  float* okv = nullptr; int okv_w = 0, okv_c = 0;
  if (!isS) {
    if (nw >= 256 && nw < 512) { okv = p.out + O_NAK; okv_w = 256; okv_c = nw - 256; }
    else if (nw >= 512 && nw < 768) { okv = p.out + O_NAV; okv_w = 256; okv_c = nw - 512; }
    else if (nw >= 1024 && nw < 1280) { okv = p.out + O_DK; okv_w = 256; okv_c = nw - 1024; }
    else if (nw >= 1280 && nw < 1536) { okv = p.out + O_DV; okv_w = 256; okv_c = nw - 1280; }
    else if (nw >= 2048 && nw < 2176) { okv = p.out + O_SK; okv_w = 128; okv_c = nw - 2048; }
    else if (nw >= 2176) { okv = p.out + O_SV; okv_w = 128; okv_c = nw - 2176; }
  }
  int khh = -1;
  if (nw >= 256 && nw < 512) khh = (nw - 256) >> 6;
  else if (nw >= 1024 && nw < 1280) khh = 4 + ((nw - 1024) >> 6);
  else if (nw >= 2048 && nw < 2176) khh = 8 + ((nw - 2048) >> 6);
  int vrow = -1;
  if (nw >= 512 && nw < 768) vrow = nw - 512;
  else if (nw >= 1280 && nw < 1536) vrow = 256 + nw - 1280;
  else if (nw >= 2176) vrow = 512 + nw - 2176;
#pragma unroll
  for (int yi = 0; yi < 4; ++yi) {
    const int m = m0 + wy * 64 + yi * 16 + r;
    const int t = (m - NPTOK) & 1023;
    const int prow = t >> 6, pcol = t & 63;
#pragma unroll
    for (int xi = 0; xi < 4; ++xi) {
      f32x4 v = acc[xi][yi];
      if (ropeMode == 1) {
        const int pos = (xi & 1) ? pcol : prow;
        const float4 cs = *(const float4*)(p.ropeD + pos * 8 + 4 * (g & 1));
        const float4 sn = *(const float4*)(p.ropeD + 512 + pos * 8 + 4 * (g & 1));
        const float sg = (g >= 2) ? 1.f : -1.f;
        const float o0 = __shfl_xor(v[0], 32), o1 = __shfl_xor(v[1], 32), o2 = __shfl_xor(v[2], 32), o3 = __shfl_xor(v[3], 32);
        v[0] = v[0] * cs.x + sg * o0 * sn.x; v[1] = v[1] * cs.y + sg * o1 * sn.y;
        v[2] = v[2] * cs.z + sg * o2 * sn.z; v[3] = v[3] * cs.w + sg * o3 * sn.w;
      } else if (ropeMode == 2) {
        const int pos = (xi >> 1) ? pcol : prow;
        const float4 cs = *(const float4*)(p.ropeS + pos * 16 + 4 * g);
        const float4 sn = *(const float4*)(p.ropeS + 1024 + pos * 16 + 4 * g);
        const f32x4 o = acc[xi ^ 1][yi];
        const float sg = (xi & 1) ? 1.f : -1.f;
        v[0] = v[0] * cs.x + sg * o[0] * sn.x; v[1] = v[1] * cs.y + sg * o[1] * sn.y;
        v[2] = v[2] * cs.z + sg * o[2] * sn.z; v[3] = v[3] * cs.w + sg * o[3] * sn.w;
      }
      const int nloc = xi * 16 + 4 * g;
      if (okv) {
        const int b = m >> 8, pos = m & 255;
        float4 o4; o4.x = v[0]; o4.y = v[1]; o4.z = v[2]; o4.w = v[3];
        *(float4*)(okv + ((size_t)((b * 4 + l) * 256 + pos)) * okv_w + okv_c + nloc) = o4;
      }
      if (vrow >= 0) {
        u16* vb = p.vfr + ((size_t)((vrow >> 6) * 192 + (m >> 5))) * 2048;
#pragma unroll
        for (int i = 0; i < 4; ++i) vb[vfrag_off(m & 31, nloc + i)] = f2bf(v[i]);
      } else if (khh >= 0) {
        uint2 w; w.x = pack2(v[0], v[1]); w.y = pack2(v[2], v[3]);
        *(uint2*)(p.kfr + ((size_t)(khh * 192 + (m >> 5))) * 2048 + kfrag_off(m & 31, nloc)) = w;
      } else {
        uint2 w; w.x = pack2(v[0], v[1]); w.y = pack2(v[2], v[3]);
        *(uint2*)(p.z + (size_t)m * INW + nw + nloc) = w;
      }
    }
  }
}

__device__ void res_tile(const Params& p, int l, int tx, int ty, const u16* A, const u16* WT, int K, int gi, u16* smem) {
  const int n0 = tx * 128, m0 = ty * 96;
  f32x4 acc[4][3];
  gemm_main<3>(WT + (size_t)n0 * K, K, A + (size_t)m0 * K, K, K, smem, acc);
  const int lane = otid() & 63, wave = otid() >> 6, wx = wave & 1, wy = wave >> 1, r = lane & 15, g = lane >> 4;
#pragma unroll
  for (int yi = 0; yi < 3; ++yi) {
    const int m = m0 + wy * 48 + yi * 16 + r;
    const int cond = m < NPTOK ? 0 : 1 + ((m - NPTOK) >> 10);
    const float* gate = p.mods + (size_t)(l * 3 + cond) * 6144 + gi * 1024;
    float* xrow = p.xres + (size_t)m * 1024;
    float4 xv[4], gt[4];
#pragma unroll
    for (int xi = 0; xi < 4; ++xi) {
      const int n = n0 + wx * 64 + xi * 16 + 4 * g;
      xv[xi] = *(const float4*)(xrow + n);
      gt[xi] = *(const float4*)(gate + n);
    }
#pragma unroll
    for (int xi = 0; xi < 4; ++xi) {
      const int n = n0 + wx * 64 + xi * 16 + 4 * g;
      const f32x4 v = acc[xi][yi];
      float4 o = xv[xi];
      o.x += gt[xi].x * v[0]; o.y += gt[xi].y * v[1]; o.z += gt[xi].z * v[2]; o.w += gt[xi].w * v[3];
      *(float4*)(xrow + n) = o;
    }
  }
}

__device__ void m1_tile(const Params& p, int l, int tx, int ty, u16* smem) {
  const int n0 = tx * 128, m0 = ty * 128;
  f32x4 acc[4][4];
  gemm_main<4>(p.w1T + (size_t)l * 4096 * 1024 + (size_t)n0 * 1024, 1024, p.h + (size_t)m0 * 1024, 1024, 1024, smem, acc);
  const int lane = otid() & 63, wave = otid() >> 6, wx = wave & 1, wy = wave >> 1, r = lane & 15, g = lane >> 4;
#pragma unroll
  for (int xi = 0; xi < 4; ++xi) {
    const int n = n0 + wx * 64 + xi * 16 + 4 * g;
#pragma unroll
    for (int yi = 0; yi < 4; ++yi) {
      const int m = m0 + wy * 64 + yi * 16 + r;
      const f32x4 v = acc[xi][yi];
      float a0 = fmaxf(v[0], 0.f), a1 = fmaxf(v[1], 0.f), a2 = fmaxf(v[2], 0.f), a3 = fmaxf(v[3], 0.f);
      uint2 w; w.x = pack2(a0 * a0, a1 * a1); w.y = pack2(a2 * a2, a3 * a3);
      *(uint2*)(p.u + (size_t)m * 4096 + n) = w;
    }
  }
}

__device__ void f1_tile(const Params& p, int l, int it, u16* smem) {
  const int tx = it % 48, ty = it / 48;
  const int x0 = tx * 128, y0 = ty * 128;
  f32x4 acc[4][4];
  gemm_main<4>(p.z + (size_t)x0 * INW + 1536, INW, p.pqt + (size_t)l * 512 * 256 + (size_t)y0 * 256, 256, 256, smem, acc);
  const int lane = otid() & 63, wave = otid() >> 6, wx = wave & 1, wy = wave >> 1, r = lane & 15, g = lane >> 4;
#pragma unroll
  for (int yi = 0; yi < 4; ++yi) {
    const int y = y0 + wy * 64 + yi * 16 + r;
    const int col = y & 255, which = y >> 8;
#pragma unroll
    for (int xi = 0; xi < 4; ++xi) {
      const int tok = x0 + wx * 64 + xi * 16 + 4 * g;
      size_t addr;
      if (tok < NPTOK) {
        const int b = tok >> 8, pos = tok & 255;
        addr = (size_t)b * (256 * 512) + (size_t)col * 512 + which * 256 + pos;
      } else {
        const int b = (tok - NPTOK) >> 10, pos = (tok - NPTOK) & 1023;
        addr = (size_t)16 * 256 * 512 + (size_t)b * (256 * 2048) + (size_t)col * 2048 + which * 1024 + pos;
      }
      const f32x4 v = acc[xi][yi];
      uint2 w; w.x = pack2(v[0], v[1]); w.y = pack2(v[2], v[3]);
      *(uint2*)(p.uv + addr) = w;
    }
  }
  asm volatile("s_waitcnt vmcnt(0)" ::: "memory");
  __syncthreads();
  if (threadIdx.x == 0) {
    __builtin_amdgcn_fence(__ATOMIC_RELEASE, "agent");
    asm volatile("s_waitcnt vmcnt(0)" ::: "memory");
    xb_add(p.bar + XCD_BAR_WORDS + (8 + l) * 64, 1u);
  }
}

__device__ void f2_tile(const Params& p, int l, int it, u16* smem) {
  if (threadIdx.x == 0) {
    unsigned* c = p.bar + XCD_BAR_WORDS + (8 + l) * 64;
    unsigned sp = 0;
    while (xb_ld(c) < 192u) { __builtin_amdgcn_s_sleep(2); if (++sp > (1u << 24)) break; }
    __builtin_amdgcn_fence(__ATOMIC_ACQUIRE, "agent");
    asm volatile("s_waitcnt vmcnt(0)" ::: "memory");
  }
  __syncthreads();
  int L, b, tx, ty, tokbase;
  const u16* uvb; const u16* dft;
  if (it < 32) { L = 1024; b = it >> 4; tx = (it >> 3) & 1; ty = it & 7; uvb = p.uv + (size_t)16 * 256 * 512 + (size_t)b * (256 * 2048); dft = p.dft1024; tokbase = NPTOK + b * 1024; }
  else { it -= 32; L = 256; b = it >> 2; tx = (it >> 1) & 1; ty = it & 1; uvb = p.uv + (size_t)b * (256 * 512); dft = p.dft256; tokbase = b * 256; }
  const int x0 = tx * 128, y0 = ty * 128, K = 2 * L;
  f32x4 acc[4][4];
  gemm_main<4>(uvb + (size_t)x0 * K, K, dft + (size_t)y0 * K, K, K, smem, acc);
  const int lane = otid() & 63, wave = otid() >> 6, wx = wave & 1, wy = wave >> 1, r = lane & 15, g = lane >> 4;
  const float scale = rsqrtf(64.f * (float)L);
#pragma unroll
  for (int yi = 0; yi < 4; ++yi) {
    const int pos = y0 + wy * 64 + yi * 16 + r;
#pragma unroll
    for (int xi = 0; xi < 4; ++xi) {
      const int col = x0 + wx * 64 + xi * 16 + 4 * g;
      const f32x4 v = acc[xi][yi];
      uint2 w; w.x = pack2(v[0] * scale, v[1] * scale); w.y = pack2(v[2] * scale, v[3] * scale);
      *(uint2*)(p.cat + (size_t)(tokbase + pos) * 1024 + 512 + col) = w;
    }
  }
}

struct Seg { const u16* K; const u16* Vt; int ldk, ldv, nblk, pos0, stride; };
#define KLOC(hh, tokb) (p.kfr + ((size_t)((hh) * 192 + ((tokb) >> 5))) * 2048)
#define VLOC(hh, tokb) (p.vfr + ((size_t)((hh) * 192 + ((tokb) >> 5))) * 2048)
template <int QT> struct AState { float m[QT]; float ls[QT]; f32x4 o[QT][4]; };

__device__ __forceinline__ bf16x8 as_bf(u32x4 v) { union { u32x4 u; bf16x8 b; } x; x.u = v; return x.b; }

template <int DC>
__device__ __forceinline__ void issue_blk(const Seg& s0, const Seg& s1, int b, int r, int g, u32x4 (&kf)[2][DC], u32x4 (&vf)[4]) {
  const bool in0 = b < s0.nblk;
  const u16* Kp = in0 ? s0.K : s1.K;
  const u16* Vp = in0 ? s0.Vt : s1.Vt;
  const int pos = in0 ? (s0.pos0 + b * s0.stride) : (s1.pos0 + (b - s0.nblk) * s1.stride);
  const int lane8 = (g * 16 + r) * 8;
  const u16* kp = Kp + (size_t)(pos >> 5) * 2048 + lane8;
  const u16* vp = Vp + (size_t)(pos >> 5) * 2048 + lane8;
#pragma unroll
  for (int t = 0; t < 2; ++t)
#pragma unroll
    for (int dc = 0; dc < DC; ++dc) gload16(kf[t][dc], kp + (t * 2 + dc) * 512);
#pragma unroll
  for (int dv = 0; dv < 4; ++dv) gload16(vf[dv], vp + dv * 512);
}
template <int N>
__device__ __forceinline__ void wait_blk(u32x4 (&kf)[2][1], u32x4 (&vf)[4]) {
  asm volatile("s_waitcnt vmcnt(%6)" : "+v"(kf[0][0]), "+v"(kf[1][0]), "+v"(vf[0]), "+v"(vf[1]), "+v"(vf[2]), "+v"(vf[3]) : "n"(N) : "memory");
}
template <int N>
__device__ __forceinline__ void wait_blk(u32x4 (&kf)[2][2], u32x4 (&vf)[4]) {
  asm volatile("s_waitcnt vmcnt(%8)" : "+v"(kf[0][0]), "+v"(kf[0][1]), "+v"(kf[1][0]), "+v"(kf[1][1]), "+v"(vf[0]), "+v"(vf[1]), "+v"(vf[2]), "+v"(vf[3]) : "n"(N) : "memory");
}

template <int D, int QT, int MODE>
__device__ __forceinline__ void attn_compute(const u32x4 (&kc)[2][D / 32], const u32x4 (&vc)[4], const bf16x8 (&qf)[QT][D / 32], const float sc,
                                             AState<QT>& st, const bool in0, const int pos, const int qpos0, const float* __restrict__ rpb_h,
                                             const int r, const int g) {
  constexpr int DC = D / 32;
#pragma unroll
  for (int q = 0; q < QT; ++q) {
    f32x4 s_[2];
    s_[0] = (f32x4){0.f, 0.f, 0.f, 0.f};
    s_[1] = (f32x4){0.f, 0.f, 0.f, 0.f};
#pragma unroll
    for (int t = 0; t < 2; ++t)
#pragma unroll
      for (int dc = 0; dc < DC; ++dc) s_[t] = __builtin_amdgcn_mfma_f32_16x16x32_bf16(as_bf(kc[t][dc]), qf[q][dc], s_[t], 0, 0, 0);
    float sv[8];
#pragma unroll
    for (int t = 0; t < 2; ++t)
#pragma unroll
      for (int i = 0; i < 4; ++i) {
        float x = s_[t][i] * sc;
        if (MODE == 1) {
          if (!in0) {
            const int qpos = qpos0 + q * 16 + r;
            const int qrow = qpos >> 6, cq = qpos & 63;
            const int kpos = pos + 8 * g + 4 * t + i;
            const int krow = kpos >> 6, ck = kpos & 63;
            const int cs = min(max(cq - 8, 0), 48);
            const bool valid = (ck >= cs) && (ck < cs + 16);
            const int bi = (krow - qrow + 7) * 31 + (ck - cq + 15);
            const float bias = rpb_h[valid ? bi : 0];
            x = valid ? (x + bias) : -1e30f;
          }
        } else if (MODE == 2) {
          if (!in0) {
            const int qpos = qpos0 + q * 16 + r;
            const int kpos = pos + 8 * g + 4 * t + i;
            const int d = qpos - kpos;
            x = (d <= 128 && d >= -128) ? x : -1e30f;
          }
        }
        sv[4 * t + i] = x;
      }
    float mx = fmaxf(fmaxf(fmaxf(sv[0], sv[1]), fmaxf(sv[2], sv[3])), fmaxf(fmaxf(sv[4], sv[5]), fmaxf(sv[6], sv[7])));
    mx = fmaxf(mx, __shfl_xor(mx, 16));
    mx = fmaxf(mx, __shfl_xor(mx, 32));
    const float mnew = fmaxf(st.m[q], mx);
    const float alpha = __builtin_amdgcn_exp2f(st.m[q] - mnew);
    st.m[q] = mnew;
    float ps = 0.f;
#pragma unroll
    for (int j = 0; j < 8; ++j) { sv[j] = __builtin_amdgcn_exp2f(sv[j] - mnew); ps += sv[j]; }
    st.ls[q] = st.ls[q] * alpha + ps;
    union { bf16x8 v; unsigned w[4]; } pf;
    pf.w[0] = pack2(sv[0], sv[1]); pf.w[1] = pack2(sv[2], sv[3]); pf.w[2] = pack2(sv[4], sv[5]); pf.w[3] = pack2(sv[6], sv[7]);
#pragma unroll
    for (int dv = 0; dv < 4; ++dv) {
      f32x4 o = st.o[q][dv];
      o[0] *= alpha; o[1] *= alpha; o[2] *= alpha; o[3] *= alpha;
      st.o[q][dv] = __builtin_amdgcn_mfma_f32_16x16x32_bf16(as_bf(vc[dv]), pf.v, o, 0, 0, 0);
    }
  }
}

template <int D, int QT, int MODE, int NQ = 2>
__device__ __forceinline__ void attn_run(const Seg& s0, const Seg& s1, const bf16x8 (&qf)[QT][D / 32], const float sc,
                                         AState<QT>& st, const int qpos0, const float* __restrict__ rpb_h, const int bb = 0, const int be = -1) {
  constexpr int DC = D / 32;
  constexpr int NL = 2 * DC + 4;
  const int lane = otid() & 63, r = lane & 15, g = lane >> 4;
  const int nb = be < 0 ? s0.nblk + s1.nblk : be;
  u32x4 kq[NQ][2][DC], vq[NQ][4];
#pragma unroll
  for (int q = 0; q < QT; ++q)
#pragma unroll
    for (int dc = 0; dc < DC; ++dc) asm volatile("" ::"v"(qf[q][dc]));
  asm volatile("s_waitcnt vmcnt(0)" ::: "memory");
#pragma unroll 1
  for (int b = bb; b < nb; b += NQ) {
#pragma unroll
    for (int j = 0; j < NQ; ++j) issue_blk<DC>(s0, s1, b + j, r, g, kq[j], vq[j]);
#pragma unroll
    for (int j = 0; j < NQ; ++j) {
      if (j == 0) wait_blk<(NQ - 1) * NL>(kq[j], vq[j]);
      else if (j == 1) wait_blk<(NQ - 2) * NL>(kq[j], vq[j]);
      else if (j == 2) wait_blk<(NQ > 3 ? (NQ - 3) * NL : 0)>(kq[j], vq[j]);
      else wait_blk<0>(kq[j], vq[j]);
      const int bj = b + j;
      const bool in0 = bj < s0.nblk;
      const int pos = in0 ? (s0.pos0 + bj * s0.stride) : (s1.pos0 + (bj - s0.nblk) * s1.stride);
      attn_compute<D, QT, MODE>(kq[j], vq[j], qf, sc, st, in0, pos, qpos0, rpb_h, r, g);
    }
  }
}

template <int QT>
__device__ __forceinline__ void astate_init(AState<QT>& st, float m0, float l0) {
#pragma unroll
  for (int q = 0; q < QT; ++q) {
    st.m[q] = m0; st.ls[q] = l0;
#pragma unroll
    for (int dv = 0; dv < 4; ++dv) st.o[q][dv] = (f32x4){0.f, 0.f, 0.f, 0.f};
  }
}
template <int QT>
__device__ __forceinline__ void astate_finalize(AState<QT>& st) {
#pragma unroll
  for (int q = 0; q < QT; ++q) {
    float l = st.ls[q];
    l += __shfl_xor(l, 16);
    l += __shfl_xor(l, 32);
    const float inv = 1.f / l;
#pragma unroll
    for (int dv = 0; dv < 4; ++dv) { st.o[q][dv][0] *= inv; st.o[q][dv][1] *= inv; st.o[q][dv][2] *= inv; st.o[q][dv][3] *= inv; }
  }
}
template <int DC, int QT>
__device__ __forceinline__ void load_q(const u16* zq  , bf16x8 (&qf)[QT][DC]) {
  const int lane = otid() & 63, r = lane & 15, g = lane >> 4;
#pragma unroll
  for (int q = 0; q < QT; ++q)
#pragma unroll
    for (int dc = 0; dc < DC; ++dc) qf[q][dc] = *(const bf16x8*)(zq + (size_t)(q * 16 + r) * INW + dc * 32 + g * 8);
}
template <int QT>
__device__ __forceinline__ void write_o(const Params& p, const AState<QT>& st, int tok0, int col0) {
  const int lane = otid() & 63, r = lane & 15, g = lane >> 4;
#pragma unroll
  for (int q = 0; q < QT; ++q)
#pragma unroll
    for (int dv = 0; dv < 4; ++dv) {
      const f32x4 v = st.o[q][dv];
      uint2 w; w.x = pack2(v[0], v[1]); w.y = pack2(v[2], v[3]);
      *(uint2*)(p.cat + (size_t)(tok0 + q * 16 + r) * 1024 + col0 + dv * 16 + 4 * g) = w;
    }
}

__device__ __forceinline__ float diff_lambda(const Params& p, int l, float lam_init) {
  const int lane = otid() & 63;
  float a = 0.f, b = 0.f;
  if (lane < 32) { a = p.lq1[l * 32 + lane] * p.lk1[l * 32 + lane]; b = p.lq2[l * 32 + lane] * p.lk2[l * 32 + lane]; }
#pragma unroll
  for (int o = 32; o >= 1; o >>= 1) { a += __shfl_xor(a, o); b += __shfl_xor(b, o); }
  return expf(a) - expf(b) + lam_init;
}

__device__ __forceinline__ void diff_finish_q(const Params& p, int l, float lam, float lam_init, f32x4 (&A)[4], const f32x4 (&B)[4], int tokrow0, int col0) {
  const int lane = otid() & 63, r = lane & 15, g = lane >> 4;
  const float* sg = p.subln_g + l * 64;
  float ss = 0.f;
#pragma unroll
  for (int dv = 0; dv < 4; ++dv)
#pragma unroll
    for (int i = 0; i < 4; ++i) {
      const float v = A[dv][i] - lam * B[dv][i];
      A[dv][i] = v;
      ss += v * v;
    }
  ss += __shfl_xor(ss, 16);
  ss += __shfl_xor(ss, 32);
  const float rs = rsqrtf(ss * (1.f / 64.f) + 1e-6f) * (1.f - lam_init);
#pragma unroll
  for (int dv = 0; dv < 4; ++dv) {
    const float4 gg = *(const float4*)(sg + dv * 16 + 4 * g);
    uint2 w;
    w.x = pack2(A[dv][0] * rs * gg.x, A[dv][1] * rs * gg.y);
    w.y = pack2(A[dv][2] * rs * gg.z, A[dv][3] * rs * gg.w);
    *(uint2*)(p.cat + (size_t)(tokrow0 + r) * 1024 + col0 + dv * 16 + 4 * g) = w;
  }
}

#ifndef AQT
#define AQT 2
#endif
#define QW (16 * AQT)
#define NQG_CTX (256 / QW)
#define NQG_LAT (1024 / QW)
__device__ void attn_diff_item(const Params& p, int l, bool lat, int bi, float* sm) {
  const int wave = otid() >> 6, lane = otid() & 63, r = lane & 15, g = lane >> 4;
  const int ps = wave >> 1, half = wave & 1;
  int b, h, qg, tokb;
  if (lat) { b = bi / (4 * NQG_LAT); h = (bi / NQG_LAT) & 3; qg = bi % NQG_LAT; tokb = NPTOK + b * 1024; }
  else { b = bi / (4 * NQG_CTX); h = (bi / NQG_CTX) & 3; qg = bi % NQG_CTX; tokb = b * 256; }
  const int tok0 = tokb + qg * QW;
  const u16* zb = p.z + (size_t)tokb * INW;
  Seg s0, s1;
  if (lat) {
    const int bl = b * 4 + l;
    s0.K = p.ck_diff + (size_t)((bl * 4 + h) * 16) * 2048 + ps * 512; s0.Vt = p.cvt_diff + (size_t)((bl * 4 + h) * 16) * 2048;
    s0.ldk = 0; s0.ldv = 0; s0.nblk = half ? 0 : 16; s0.pos0 = 0; s0.stride = 32;
    s1.K = KLOC(4 + h, tokb) + ps * 512; s1.Vt = VLOC(4 + h, tokb);
    s1.ldk = 0; s1.ldv = 0; s1.nblk = half ? 24 : 8; s1.pos0 = half ? 256 : 0; s1.stride = 32;
  } else {
    s0.K = KLOC(4 + h, tokb) + ps * 512; s0.Vt = VLOC(4 + h, tokb);
    s0.ldk = 0; s0.ldv = 0; s0.nblk = 4; s0.pos0 = half ? 128 : 0; s0.stride = 32;
    s1 = s0; s1.nblk = 0;
  }
  bf16x8 qf[AQT][1];
  load_q<1, AQT>(p.z + (size_t)tok0 * INW + 768 + h * 64 + ps * 32, qf);
  AState<AQT> st;
  astate_init<AQT>(st, -1e30f, 0.f);
  attn_run<32, AQT, 0, 4>(s0, s1, qf, 0.17677669529663687f * LOG2E, st, 0, nullptr);
  float lt[AQT];
#pragma unroll
  for (int q = 0; q < AQT; ++q) {
    lt[q] = st.ls[q];
    lt[q] += __shfl_xor(lt[q], 16);
    lt[q] += __shfl_xor(lt[q], 32);
  }
  constexpr int WS = 64 * 16 * AQT;
  float* pm = sm + 4 * WS;
  if (wave != 0) {
    float* po = sm + wave * WS + lane * (16 * AQT);
#pragma unroll
    for (int q = 0; q < AQT; ++q) {
#pragma unroll
      for (int dv = 0; dv < 4; ++dv) *(f32x4*)(po + q * 16 + dv * 4) = st.o[q][dv];
      if (g == 0) { pm[wave * QW + q * 16 + r] = st.m[q]; pm[4 * QW + wave * QW + q * 16 + r] = lt[q]; }
    }
  }
  __syncthreads();
  if (wave == 0) {
    const float lam_init = 0.8f - 0.6f * expf(-0.3f * (float)l);
    const float lam = diff_lambda(p, l, lam_init);
#pragma unroll
    for (int q = 0; q < AQT; ++q) {
      f32x4 A[4], B[4];
      {
        const float m1 = pm[QW + q * 16 + r], l1 = pm[4 * QW + QW + q * 16 + r];
        const float M = fmaxf(st.m[q], m1);
        const float a0 = exp2f(st.m[q] - M), a1 = exp2f(m1 - M);
        const float inv = 1.f / (lt[q] * a0 + l1 * a1);
#pragma unroll
        for (int dv = 0; dv < 4; ++dv) {
          const f32x4 o1 = *(const f32x4*)(sm + 1 * WS + lane * (16 * AQT) + q * 16 + dv * 4);
          A[dv] = (st.o[q][dv] * a0 + o1 * a1) * inv;
        }
      }
      {
        const float m2 = pm[2 * QW + q * 16 + r], l2 = pm[4 * QW + 2 * QW + q * 16 + r], m3 = pm[3 * QW + q * 16 + r], l3 = pm[4 * QW + 3 * QW + q * 16 + r];
        const float M = fmaxf(m2, m3);
        const float a2 = exp2f(m2 - M), a3 = exp2f(m3 - M);
        const float inv = 1.f / (l2 * a2 + l3 * a3);
#pragma unroll
        for (int dv = 0; dv < 4; ++dv) {
          const f32x4 o2 = *(const f32x4*)(sm + 2 * WS + lane * (16 * AQT) + q * 16 + dv * 4);
          const f32x4 o3 = *(const f32x4*)(sm + 3 * WS + lane * (16 * AQT) + q * 16 + dv * 4);
          B[dv] = (o2 * a2 + o3 * a3) * inv;
        }
      }
      diff_finish_q(p, l, lam, lam_init, A, B, tok0 + q * 16, 256 + h * 64);
    }
  }
  __syncthreads();
}

__device__ void attn_ctx_item(const Params& p, int l, int bi) {
  const int wave = otid() >> 6, lane = otid() & 63, g = lane >> 4;
  const int w = bi * 4 + wave;
  const int type = w / (64 * NQG_CTX), rem = w % (64 * NQG_CTX);
  const int b = rem / (4 * NQG_CTX), h = (rem / NQG_CTX) & 3, qg = rem % NQG_CTX;
  const int tokb = b * 256, tok0 = tokb + qg * QW;
  const u16* zb = p.z + (size_t)tokb * INW;
  const int kvh = h >> 1;
  const int qcol = type == 0 ? h * 64 : 1792 + h * 64;
  const int kcol = type == 0 ? 256 + h * 64 : 2048 + kvh * 64;
  const int vrow = type == 0 ? h * 64 : 512 + kvh * 64;
  const int ocol = type == 0 ? h * 64 : 768 + h * 64;
  bf16x8 qf[AQT][2];
  load_q<2, AQT>(p.z + (size_t)tok0 * INW + qcol, qf);
  const int hslot = type == 0 ? h : 8 + kvh;
  Seg s0; s0.K = KLOC(hslot, tokb); s0.Vt = VLOC(hslot, tokb); s0.ldk = 0; s0.ldv = 0; s0.nblk = 8; s0.pos0 = 0; s0.stride = 32;
  Seg sN = s0; sN.nblk = 0;
  AState<AQT> st;
  const float sk = type == 0 ? -1e30f : p.swa_sink[l * 4 + h] * LOG2E;
  astate_init<AQT>(st, sk, (type == 1 && g == 0) ? 1.f : 0.f);
  attn_run<64, AQT, 0, 2>(s0, sN, qf, 0.125f * LOG2E, st, 0, nullptr);
  astate_finalize<AQT>(st);
  write_o<AQT>(p, st, tok0, ocol);
}

__device__ void attn_lat_item(const Params& p, int l, int bi, float* sm) {
  const int wave = otid() >> 6, lane = otid() & 63, r = lane & 15, g = lane >> 4;
  const int type = bi / (8 * NQG_LAT), rem = bi % (8 * NQG_LAT);
  const int b = rem / (4 * NQG_LAT), h = (rem / NQG_LAT) & 3, qg = rem % NQG_LAT;
  const int q0 = qg * QW;
  const int tokb = NPTOK + b * 1024, tok0 = tokb + q0;
  const u16* zb = p.z + (size_t)tokb * INW;
  const int bl = b * 4 + l;
  AState<AQT> st;
  int ocol;
  if (type != 0) {
    const float* rp = p.na_rpb + (size_t)(l * 4 + h) * 15 * 31;
    for (int e = otid(); e < 465; e += 256) sm[9000 + e] = rp[e] * LOG2E;
    __syncthreads();
  }
  if (type == 0) {
    const int kvh = h >> 1;
    bf16x8 qf[AQT][2];
    load_q<2, AQT>(p.z + (size_t)tok0 * INW + 1792 + h * 64, qf);
    Seg s0; s0.K = p.ck_swa + (size_t)((bl * 2 + kvh) * 16) * 2048; s0.Vt = p.cvt_swa + (size_t)((bl * 2 + kvh) * 16) * 2048; s0.ldk = 0; s0.ldv = 0; s0.nblk = 16; s0.pos0 = 0; s0.stride = 32;
    const int lo = max(0, q0 - 128) & ~31;
    const int hi = min(1024, ((q0 + QW + 128) + 31) & ~31);
    int lo2 = lo, cnt = (hi - lo) >> 5;
    if (cnt & 1) { if (lo2 > 0) lo2 -= 32; ++cnt; }
    Seg s1; s1.K = KLOC(8 + kvh, tokb); s1.Vt = VLOC(8 + kvh, tokb); s1.ldk = 0; s1.ldv = 0; s1.nblk = cnt; s1.pos0 = lo2; s1.stride = 32;
    const int P = (16 + cnt) >> 1;
    const int pb = (wave * P) >> 2, pe = ((wave + 1) * P) >> 2;
    astate_init<AQT>(st, wave == 0 ? p.swa_sink[l * 4 + h] * LOG2E : -1e30f, (wave == 0 && g == 0) ? 1.f : 0.f);
    attn_run<64, AQT, 2>(s0, s1, qf, 0.125f * LOG2E, st, q0, nullptr, 2 * pb, 2 * pe);
    ocol = 768 + h * 64;
  } else {
    bf16x8 qf[AQT][2];
    load_q<2, AQT>(p.z + (size_t)tok0 * INW + h * 64, qf);
    Seg s0; s0.K = p.ck_na + (size_t)((bl * 4 + h) * 16) * 2048; s0.Vt = p.cvt_na + (size_t)((bl * 4 + h) * 16) * 2048; s0.ldk = 0; s0.ldv = 0; s0.nblk = 16; s0.pos0 = 0; s0.stride = 32;
    const int qrow = q0 >> 6;
    const int rstart = min(max(qrow - 4, 0), 8);
    Seg s1; s1.K = KLOC(h, tokb); s1.Vt = VLOC(h, tokb); s1.ldk = 0; s1.ldv = 0; s1.nblk = 16; s1.pos0 = rstart * 64; s1.stride = 32;
    astate_init<AQT>(st, -1e30f, 0.f);
    attn_run<64, AQT, 1, 2>(s0, s1, qf, 0.125f * LOG2E, st, q0, sm + 9000, 8 * wave, 8 * wave + 8);
    ocol = h * 64;
  }
  float lt[AQT];
#pragma unroll
  for (int q = 0; q < AQT; ++q) {
    lt[q] = st.ls[q];
    lt[q] += __shfl_xor(lt[q], 16);
    lt[q] += __shfl_xor(lt[q], 32);
  }
  constexpr int WS = 64 * 16 * AQT;
  float* pm = sm + 4 * WS;
  if (wave != 0) {
    float* po = sm + wave * WS + lane * (16 * AQT);
#pragma unroll
    for (int q = 0; q < AQT; ++q) {
#pragma unroll
      for (int dv = 0; dv < 4; ++dv) *(f32x4*)(po + q * 16 + dv * 4) = st.o[q][dv];
      if (g == 0) { pm[wave * QW + q * 16 + r] = st.m[q]; pm[4 * QW + wave * QW + q * 16 + r] = lt[q]; }
    }
  }
  __syncthreads();
  if (wave == 0) {
#pragma unroll
    for (int q = 0; q < AQT; ++q) {
      const float m1 = pm[1 * QW + q * 16 + r], m2 = pm[2 * QW + q * 16 + r], m3 = pm[3 * QW + q * 16 + r];
      const float l1 = pm[4 * QW + 1 * QW + q * 16 + r], l2 = pm[4 * QW + 2 * QW + q * 16 + r], l3 = pm[4 * QW + 3 * QW + q * 16 + r];
      const float M = fmaxf(fmaxf(st.m[q], m1), fmaxf(m2, m3));
      const float a0 = __builtin_amdgcn_exp2f(st.m[q] - M), a1 = __builtin_amdgcn_exp2f(m1 - M), a2 = __builtin_amdgcn_exp2f(m2 - M), a3 = __builtin_amdgcn_exp2f(m3 - M);
      const float inv = 1.f / (lt[q] * a0 + l1 * a1 + l2 * a2 + l3 * a3);
#pragma unroll
      for (int dv = 0; dv < 4; ++dv) {
        const f32x4 o1 = *(const f32x4*)(sm + 1 * WS + lane * (16 * AQT) + q * 16 + dv * 4);
        const f32x4 o2 = *(const f32x4*)(sm + 2 * WS + lane * (16 * AQT) + q * 16 + dv * 4);
        const f32x4 o3 = *(const f32x4*)(sm + 3 * WS + lane * (16 * AQT) + q * 16 + dv * 4);
        st.o[q][dv] = (st.o[q][dv] * a0 + o1 * a1 + o2 * a2 + o3 * a3) * inv;
      }
    }
    write_o<AQT>(p, st, tok0, ocol);
  }
  __syncthreads();
}

__device__ __forceinline__ int q_next(unsigned* cnt, volatile LAS unsigned* slot) {
  __syncthreads();
  if (threadIdx.x == 0) *slot = xb_add(cnt, 1u);
  __syncthreads();
  return (int)*slot;
}

#if REP_SYNC
#define GSYNC() do { xcd_barrier(xb); xcd_barrier(xb); } while (0)
#else
#define GSYNC() xcd_barrier(xb)
#endif
__global__ void __launch_bounds__(256, 2) mega(Params p) {
  extern __shared__ __attribute__((aligned(16))) unsigned char smem[];
  cg::grid_group grid = cg::this_grid();
  const int nblk = gridDim.x, bid = blockIdx.x;
  u16* sm16 = (u16*)smem;
  __shared__ uint4 xb_words;
  if (threadIdx.x == 0) xb_words = make_uint4(0u, 0u, 0u, 0u);
  __syncthreads();
  XcdBarrier xb = xcd_barrier_post(p.bar, (volatile LAS unsigned*)&xb_words);

  for (int rep = 0; rep <= REP_P0; ++rep)
    for (int it = bid; it < P0_ITEMS; it += nblk) p0_item(p, it, smem);
  if (p.use_cg_sync) grid.sync();
  GSYNC();

#pragma unroll 1
  for (int l = 0; l < 4; ++l) {
    for (int it = bid; it < 384; it += nblk) norm_item(p, l, 0, it);
    GSYNC();
    { int tx, ty; for (int j = 0; tile_map(j, 18, tx, ty); ++j) gin_tile(p, l, tx, ty, sm16); }
    if (nblk == 512 && l < 3) {
      const int rank = bid >> 3, r31 = rank & 31;
      if (r31 >= 22) {
        const int idle = (bid & 7) * 20 + (rank >> 5) * 10 + (r31 - 22);
        for (int it = idle; it < 720; it += 160) wt_item(p, l + 1, it, (float*)smem);
      }
    }
    GSYNC();
    {
      constexpr int CD = 64 * NQG_CTX, CC = 2 * 64 * NQG_CTX / 4;
      constexpr int LD = 8 * NQG_LAT, LC = 2 * 8 * NQG_LAT;
      constexpr int E0 = 192, E1 = E0 + LD, E2 = E1 + LC, E3 = E2 + 32, E4 = E3 + CC, E5 = E4 + CD, E6 = E5 + 64;
      unsigned* qc = p.bar + XCD_BAR_WORDS + l * 64;
      const int w0 = (nblk == 512) ? 720 : 0;
      const int EW = E6 + (l < 3 ? 1440 - w0 : 0);
      for (int it = bid; it < EW; it = nblk + q_next(qc, &xb.st[2])) {
        if (it >= E6) { wt_item(p, l + 1, it - E6 + w0, (float*)smem); continue; }
        if (it < E0) f1_tile(p, l, it, sm16);
        else if (it < E1) attn_diff_item(p, l, true, it - E0, (float*)smem);
        else if (it < E2) attn_lat_item(p, l, it - E1, (float*)smem);
        else if (it < E3) f2_tile(p, l, it - E2, sm16);
        else if (it < E4) attn_ctx_item(p, l, it - E3);
        else if (it < E5) attn_diff_item(p, l, false, it - E4, (float*)smem);
        else f2_tile(p, l, it - E5 + 32, sm16);
      }
    }
    GSYNC();
    { int tx, ty; for (int j = 0; tile_map(j, 8, tx, ty, 64); ++j) res_tile(p, l, tx, ty, p.cat, p.w_outT + (size_t)l * 1024 * 1024, 1024, 2, sm16); }
    GSYNC();
    for (int it = bid; it < 384; it += nblk) norm_item(p, l, 1, it);
    GSYNC();
    { int tx, ty; for (int j = 0; tile_map(j, 32, tx, ty); ++j) m1_tile(p, l, tx, ty, sm16); }
    GSYNC();
    { int tx, ty; for (int j = 0; tile_map(j, 8, tx, ty, 64); ++j) res_tile(p, l, tx, ty, p.u, p.w2T + (size_t)l * 1024 * 4096, 4096, 5, sm16); }
    GSYNC();
  }
  for (int it = bid; it < 384; it += nblk) norm_item(p, 0, 2, it);
}

extern "C" void kernel_launch(void* const* d_in, const int* in_sizes, int n_in, void* d_out, int out_size, void* d_ws,
                              size_t ws_size, hipStream_t stream) {
  static int grid_blocks = 0;
  if (grid_blocks == 0) {
    int dev = 0, cus = 0, per_cu = 0;
    (void)hipGetDevice(&dev);
    (void)hipDeviceGetAttribute(&cus, hipDeviceAttributeMultiprocessorCount, dev);
    if (hipFuncSetAttribute((const void*)mega, hipFuncAttributeMaxDynamicSharedMemorySize, LDS_BYTES) != hipSuccess) {
      fprintf(stderr, "hipFuncSetAttribute failed\n");
    }
    if (hipOccupancyMaxActiveBlocksPerMultiprocessor(&per_cu, (const void*)mega, 256, LDS_BYTES) != hipSuccess || per_cu < 1) {
      fprintf(stderr, "occupancy query failed (%d)\n", per_cu);
      per_cu = 1;
    }
    if (per_cu > 2) per_cu = 2;
    grid_blocks = cus * per_cu;
    fprintf(stderr, "mega: cus=%d per_cu=%d grid=%d ws=%zu\n", cus, per_cu, grid_blocks, ws_size);
  }
  Params p{};
  const float** pin = (const float**)&p;
  for (int i = 0; i < 27; ++i) pin[i] = (const float*)d_in[i];
  p.out = (float*)d_out;
  unsigned char* ws = (unsigned char*)d_ws;
  size_t off = 0;
  auto take = [&](size_t bytes) { unsigned char* q = ws + off; off += (bytes + 255) & ~(size_t)255; return q; };
  p.xres = (float*)take((size_t)NTOK * 1024 * 4);
  p.mods = (float*)take((size_t)4 * 3 * 6144 * 4);
  p.h = (u16*)take((size_t)NTOK * 1024 * 2);
  p.z = (u16*)take((size_t)NTOK * INW * 2);
  p.vt = (u16*)take((size_t)640 * NTOK * 2);
  p.cat = (u16*)take((size_t)NTOK * 1024 * 2);
  p.u = (u16*)take((size_t)NTOK * 4096 * 2);
  p.uv = (u16*)take((size_t)(16 * 256 * 512 + 2 * 256 * 2048) * 2);
  p.w_inT = (u16*)take((size_t)4 * 2304 * 1024 * 2);
  p.w_outT = (u16*)take((size_t)4 * 1024 * 1024 * 2);
  p.w1T = (u16*)take((size_t)4 * 4096 * 1024 * 2);
  p.w2T = (u16*)take((size_t)4 * 4096 * 1024 * 2);
  p.pqt = (u16*)take((size_t)4 * 512 * 256 * 2);
  p.dft256 = (u16*)take((size_t)256 * 512 * 2);
  p.dft1024 = (u16*)take((size_t)1024 * 2048 * 2);
  p.ck_na = (u16*)take((size_t)2 * 4 * 512 * 256 * 2);
  p.cvt_na = (u16*)take((size_t)2 * 4 * 512 * 256 * 2);
  p.ck_diff = (u16*)take((size_t)2 * 4 * 512 * 256 * 2);
  p.cvt_diff = (u16*)take((size_t)2 * 4 * 512 * 256 * 2);
  p.ck_swa = (u16*)take((size_t)2 * 4 * 512 * 128 * 2);
  p.cvt_swa = (u16*)take((size_t)2 * 4 * 512 * 128 * 2);
  p.kfr = (u16*)take((size_t)10 * 192 * 2048 * 2);
  p.vfr = (u16*)take((size_t)10 * 192 * 2048 * 2);
  p.ropeD = (float*)take(1024 * 4);
  p.ropeS = (float*)take(2048 * 4);
  p.bar = (unsigned*)take((XCD_BAR_WORDS + 12 * 64) * 4);
  if (off > ws_size) { fprintf(stderr, "workspace too small: need %zu have %zu\n", off, ws_size); return; }
  if (hipMemsetAsync(p.bar, 0, (XCD_BAR_WORDS + 12 * 64) * 4, stream) != hipSuccess) fprintf(stderr, "memset failed\n");
  void* args[] = {&p};
  hipError_t e = hipLaunchCooperativeKernel((const void*)mega, dim3(grid_blocks), dim3(256), args, LDS_BYTES, stream);
  if (e != hipSuccess) fprintf(stderr, "cooperative launch failed: %s (grid %d)\n", hipGetErrorString(e), grid_blocks);
}
```

```cpp
#include <hip/hip_runtime.h>
#include <hip/hip_cooperative_groups.h>
#include <stdint.h>
#include <stdio.h>
namespace cg = cooperative_groups;

typedef unsigned short u16;
typedef __attribute__((ext_vector_type(8))) short bf16x8;
typedef __attribute__((ext_vector_type(4))) float f32x4;
typedef __attribute__((ext_vector_type(4))) unsigned u32x4;
__device__ __forceinline__ void gload16(u32x4& dst, const void* ptr) {
  asm volatile("global_load_dwordx4 %0, %1, off" : "=v"(dst) : "v"(ptr) : "memory");
}

#define NTOK 6144
#define NPTOK 4096
#define INW 2304
#define LOG2E 1.4426950408889634f
#define LDS_BYTES 73728
#define LSTR 72

#define O_NAK 6291456
#define O_NAV 10485760
#define O_DK 14680064
#define O_DV 18874368
#define O_SK 23068672
#define O_SV 25165824

struct Params {
  const float *x_prompt, *x_sample, *c_na_k, *c_na_v, *c_diff_k, *c_diff_v, *c_swa_k, *c_swa_v, *c, *c_ctx;
  const float *w_ada, *b_ada, *norm1_g, *norm2_g, *w_in, *na_rpb, *lq1, *lk1, *lq2, *lk2, *subln_g, *w_fourier, *swa_sink;
  const float *w_out, *w1, *w2, *final_g;
  float* out;
  float* xres;
  float* mods;
  u16 *h, *z, *vt, *cat, *u, *uv, *w_inT, *w_outT, *w1T, *w2T, *pqt, *dft256, *dft1024;
  u16 *ck_na, *cvt_na, *ck_diff, *cvt_diff, *ck_swa, *cvt_swa;
  float *ropeD, *ropeS;
  u16 *kfr, *vfr;
  unsigned* bar;
  int use_cg_sync;
  int pad_;
};

__device__ __forceinline__ u16 f2bf(float f) {
  unsigned u = __float_as_uint(f);
  u += 0x7fffu + ((u >> 16) & 1u);
  return (u16)(u >> 16);
}
__device__ __forceinline__ int otid() { int t = threadIdx.x; asm volatile("" : "+v"(t)); return t; }
__device__ __forceinline__ float bf2f(u16 h) { return __uint_as_float(((unsigned)h) << 16); }
typedef __attribute__((ext_vector_type(2))) __bf16 hbf16x2;
typedef __attribute__((ext_vector_type(2))) float f32x2;
__device__ __forceinline__ unsigned pack2(float a, float b) {
  f32x2 v = {a, b};
  union { hbf16x2 h; unsigned u; } x;
  x.h = __builtin_convertvector(v, hbf16x2);
  return x.u;
}

__device__ __forceinline__ int kfrag_off(int kk, int d) {
  const int t = (kk >> 2) & 1, r = ((kk >> 3) << 2) | (kk & 3), dc = d >> 5, g = (d >> 3) & 3;
  return ((t * 2 + dc) * 64 + g * 16 + r) * 8 + (d & 7);
}
__device__ __forceinline__ int vfrag_off(int kk, int dv) {
  return (((dv >> 4) * 64) + (kk >> 3) * 16 + (dv & 15)) * 8 + (kk & 7);
}

#define XB_TMO      128
#define XB_XCNT(j)  (256  + 64 * (j))
#define XB_XSUB(j)  (1280 + 64 * (j))
#define XB_XGEN(j)  (2304 + 64 * (j))
#define XB_TOP      3328
#define XB_TOPGEN   3392
#define XCD_BAR_WORDS 3456
#define XB_SPIN_CAP (1u << 22)
#define LAS __attribute__((address_space(3)))
__device__ __forceinline__ unsigned xb_ld(unsigned* p)              { return __hip_atomic_load(p, __ATOMIC_RELAXED, __HIP_MEMORY_SCOPE_AGENT); }
__device__ __forceinline__ unsigned xb_add(unsigned* p, unsigned v) { return __hip_atomic_fetch_add(p, v, __ATOMIC_RELAXED, __HIP_MEMORY_SCOPE_AGENT); }
__device__ __forceinline__ unsigned xb_xcc_id() { return (unsigned)__builtin_amdgcn_s_getreg((3 << 11) | 20) & 0xFu; }
#define XB_SPIN(cond, bar) do { unsigned _sp = 0; while (cond) { __builtin_amdgcn_s_sleep(1); \
    if ((++_sp & 255u) == 0u) { if (xb_ld(&(bar)[XB_TMO])) break; if (_sp > XB_SPIN_CAP) { atomicAdd(&(bar)[XB_TMO], 1u); break; } } } } while (0)
struct XcdBarrier { unsigned* bar; unsigned x; volatile LAS unsigned* st; };
__device__ __forceinline__ XcdBarrier xcd_barrier_post(unsigned* bar, volatile LAS unsigned* st) {
  XcdBarrier b; b.bar = bar; b.x = xb_xcc_id(); b.st = st;
  if (threadIdx.x == 0) (void)xb_add(&bar[XB_XCNT(b.x)], 1u);
  return b;
}
__device__ __forceinline__ void xcd_barrier_complete(unsigned* bar, unsigned x, unsigned& nloc, unsigned& nx) {
  const unsigned G = gridDim.x * gridDim.y * gridDim.z;
  unsigned sum, cnt, mine, sp = 0u;
  for (;;) {
    sum = 0u; cnt = 0u; mine = 0u;
#pragma unroll
    for (unsigned j = 0; j < 16; ++j) { const unsigned c = xb_ld(&bar[XB_XCNT(j)]); sum += c; cnt += (c > 0u) ? 1u : 0u; mine = (j == x) ? c : mine; }
    if (sum == G) break;
    __builtin_amdgcn_s_sleep(1);
    if ((++sp & 255u) == 0u) { if (xb_ld(&bar[XB_TMO])) break; if (sp > XB_SPIN_CAP) { atomicAdd(&bar[XB_TMO], 1u); break; } }
  }
  nloc = mine > 0u ? mine : 1u; nx = cnt > 0u ? cnt : 1u;
}
__device__ __forceinline__ void xcd_barrier(const XcdBarrier& b) {
  asm volatile("s_waitcnt vmcnt(0)" ::: "memory");
  __syncthreads();
  if (threadIdx.x == 0) {
    unsigned* bar = b.bar;
    __builtin_amdgcn_s_waitcnt(0);
    unsigned nloc = b.st[0], nx = b.st[1];
    if (nloc == 0u) { xcd_barrier_complete(bar, b.x, nloc, nx); b.st[0] = nloc; b.st[1] = nx; }
    const unsigned old = xb_add(&bar[XB_XSUB(b.x)], 1u);
    const unsigned gen = old / nloc;
    if (old + 1u == (gen + 1u) * nloc) {
      __builtin_amdgcn_fence(__ATOMIC_RELEASE, "agent");
      asm volatile("s_waitcnt vmcnt(0)" ::: "memory");
      const unsigned og = xb_add(&bar[XB_TOP], 1u);
      const unsigned tg = og / nx;
      if (og + 1u == (tg + 1u) * nx) xb_add(&bar[XB_TOPGEN], 1u);
      else XB_SPIN(xb_ld(&bar[XB_TOPGEN]) == tg, bar);
      __builtin_amdgcn_fence(__ATOMIC_ACQUIRE, "agent");
      xb_add(&bar[XB_XGEN(b.x)], 1u);
      asm volatile("s_waitcnt vmcnt(0)" ::: "memory");
    } else {
      XB_SPIN(xb_ld(&bar[XB_XGEN(b.x)]) == gen, bar);
      __builtin_amdgcn_fence(__ATOMIC_ACQUIRE, "agent");
      asm volatile("s_waitcnt vmcnt(0)" ::: "memory");
    }
  }
  __syncthreads();
}

__device__ __forceinline__ void transpose_tile(const float* __restrict__ src, int lds_, u16* __restrict__ dst, int ldd,
                                               int k0, int n0, float* sm, bool fragv = false) {
  const int tid = otid();
  const int c4 = (tid & 15) * 4, r0 = tid >> 4;
  float4 v[8];
#pragma unroll
  for (int i = 0; i < 8; ++i) v[i] = *(const float4*)(src + (size_t)(k0 + r0 + 16 * i) * lds_ + n0 + c4);
#pragma unroll
  for (int i = 0; i < 8; ++i) {
    const int k = r0 + 16 * i;
    sm[(c4 + 0) * 129 + k] = v[i].x; sm[(c4 + 1) * 129 + k] = v[i].y; sm[(c4 + 2) * 129 + k] = v[i].z; sm[(c4 + 3) * 129 + k] = v[i].w;
  }
  __syncthreads();
  const int k8 = (tid & 15) * 8, nn = tid >> 4;
#pragma unroll
  for (int i = 0; i < 4; ++i) {
    const int n = nn + 16 * i;
    const float* row = sm + n * 129 + k8;
    uint4 w;
    w.x = pack2(row[0], row[1]); w.y = pack2(row[2], row[3]); w.z = pack2(row[4], row[5]); w.w = pack2(row[6], row[7]);
    if (fragv) {
      const int col = n0 + n, pos = k0 + k8;
      *(uint4*)(dst + ((size_t)((col >> 6) * 16 + (pos >> 5))) * 2048 + vfrag_off(pos & 31, col & 63)) = w;
    } else {
      *(uint4*)(dst + (size_t)(n0 + n) * ldd + k0 + k8) = w;
    }
  }
  __syncthreads();
}

__device__ __forceinline__ void adaln_item(const Params& p, int it, float* sm) {
  const int l = it / 96, c0 = (it % 96) * 64;
  float* ssil = sm;
  float* red = sm + 3072;
  const int tid = otid();
  for (int i = tid; i < 3072; i += 256) {
    const int cnd = i >> 10, k = i & 1023;
    const float v = cnd == 0 ? p.c_ctx[k] : p.c[(cnd - 1) * 1024 + k];
    ssil[i] = v / (1.f + expf(-v));
  }
  __syncthreads();
  const int cg4 = (tid & 15) * 4, ks = tid >> 4;
  const float* w = p.w_ada + (size_t)l * 1024 * 6144 + c0 + cg4;
  float a0[4] = {0.f, 0.f, 0.f, 0.f}, a1[4] = {0.f, 0.f, 0.f, 0.f}, a2[4] = {0.f, 0.f, 0.f, 0.f};
#pragma unroll 16
  for (int kk = 0; kk < 64; ++kk) {
    const int k = kk * 16 + ks;
    const float4 v = *(const float4*)(w + (size_t)k * 6144);
    const float s0 = ssil[k], s1 = ssil[1024 + k], s2 = ssil[2048 + k];
    a0[0] += s0 * v.x; a0[1] += s0 * v.y; a0[2] += s0 * v.z; a0[3] += s0 * v.w;
    a1[0] += s1 * v.x; a1[1] += s1 * v.y; a1[2] += s1 * v.z; a1[3] += s1 * v.w;
    a2[0] += s2 * v.x; a2[1] += s2 * v.y; a2[2] += s2 * v.z; a2[3] += s2 * v.w;
  }
#pragma unroll
  for (int j = 0; j < 4; ++j) {
    red[(ks * 3 + 0) * 64 + cg4 + j] = a0[j];
    red[(ks * 3 + 1) * 64 + cg4 + j] = a1[j];
    red[(ks * 3 + 2) * 64 + cg4 + j] = a2[j];
  }
  __syncthreads();
  if (tid < 192) {
    const int cnd = tid >> 6, j = tid & 63;
    float s = p.b_ada[l * 6144 + c0 + j];
    for (int q = 0; q < 16; ++q) s += red[(q * 3 + cnd) * 64 + j];
    p.mods[(l * 3 + cnd) * 6144 + c0 + j] = s;
  }
  __syncthreads();
}

__device__ __forceinline__ void cvt_item(const float* __restrict__ src, u16* __restrict__ dst, int it, int W) {
  const int w8 = W >> 3;
#pragma unroll
  for (int i = 0; i < 4; ++i) {
    const int u = it * 1024 + i * 256 + otid();
    const int d8 = u % w8, pos = (u / w8) & 511, bl = u / (w8 * 512);
    const float* sp = src + ((size_t)(bl * 512 + pos) * W + d8 * 8);
    const float4 v0 = *(const float4*)sp, v1 = *(const float4*)(sp + 4);
    uint4 w; w.x = pack2(v0.x, v0.y); w.y = pack2(v0.z, v0.w); w.z = pack2(v1.x, v1.y); w.w = pack2(v1.z, v1.w);
    const int h = d8 >> 3, d = (d8 & 7) * 8;
    *(uint4*)(dst + ((size_t)((bl * (W >> 6) + h) * 16 + (pos >> 5))) * 2048 + kfrag_off(pos & 31, d)) = w;
  }
}

__device__ __forceinline__ void pq_item(const Params& p, int it, float* sm) {
  const int cq = it & 3, it2 = it >> 2;
  const int l = it2 >> 3, which = (it2 >> 2) & 1, g = it2 & 3;
  const int n = otid();
  if (n < 64) sm[n] = which ? sinpif(2.f * (float)n / 64.f) : cospif(2.f * (float)n / 64.f);
  __syncthreads();
  float w[64];
#pragma unroll
  for (int m = 0; m < 64; ++m) w[m] = p.w_fourier[(size_t)l * 65536 + (g * 64 + m) * 256 + n];
  u16* dst = p.pqt + (size_t)l * 512 * 256 + (size_t)(which * 256 + n) * 256 + g * 64;
  for (int c = cq * 16; c < cq * 16 + 16; ++c) {
    float s = 0.f;
#pragma unroll
    for (int m = 0; m < 64; ++m) s += sm[(c * m) & 63] * w[m];
    dst[c] = f2bf(s);
  }
  __syncthreads();
}

__device__ __forceinline__ void dft_item(u16* dst, int L, int it) {
  const int twoL = 2 * L;
  for (int e = otid(); e < 8192; e += 256) {
    const int idx = it * 8192 + e;
    const int k = idx / twoL, j = idx % twoL;
    const int jj = j & (L - 1);
    const int ph = (k * jj) & (L - 1);
    const float a = 2.f * (float)ph / (float)L;
    const float v = (j >= L) ? -sinpif(a) : cospif(a);
    dst[idx] = f2bf(v);
  }
}

#define P0_WT 288
#define P0_ADA 384
#define P0_XC 0
#define P0_CK 320
#define P0_CVT 320
#define P0_PQ 128
#define P0_DFT 272
#define P0_ITEMS (P0_ADA + P0_WT + P0_XC + P0_CK + P0_CVT + P0_PQ + P0_DFT + 1)

__device__ void wt_item(const Params& p, int l, int r, float* sm) {
  if (r < 288) { transpose_tile(p.w_in + (size_t)l * 1024 * 2304, 2304, p.w_inT + (size_t)l * 2304 * 1024, 1024, (r / 36) * 128, (r % 36) * 64, sm); return; }
  r -= 288;
  if (r < 128) { transpose_tile(p.w_out + (size_t)l * 1024 * 1024, 1024, p.w_outT + (size_t)l * 1024 * 1024, 1024, (r / 16) * 128, (r % 16) * 64, sm); return; }
  r -= 128;
  if (r < 512) { transpose_tile(p.w1 + (size_t)l * 1024 * 4096, 4096, p.w1T + (size_t)l * 4096 * 1024, 1024, (r / 64) * 128, (r % 64) * 64, sm); return; }
  r -= 512;
  transpose_tile(p.w2 + (size_t)l * 4096 * 1024, 1024, p.w2T + (size_t)l * 1024 * 4096, 4096, (r / 16) * 128, (r % 16) * 64, sm);
}

__device__ void p0_item(const Params& p, int it, unsigned char* smem) {
  float* sm = (float*)smem;
  if (it < P0_ADA) { adaln_item(p, it, sm); return; }
  it -= P0_ADA;
  if (it < P0_WT) { wt_item(p, 0, it, sm); return; }
  it -= P0_WT;
  if (it < P0_XC) {
    const int row0 = it * 16;
    const float* src = row0 < NPTOK ? p.x_prompt + (size_t)row0 * 1024 : p.x_sample + (size_t)(row0 - NPTOK) * 1024;
    float* dst = p.xres + (size_t)row0 * 1024;
#pragma unroll
    for (int i = 0; i < 16; ++i) {
      const int o = (i * 256 + otid()) * 4;
      *(float4*)(dst + o) = *(const float4*)(src + o);
    }
    return;
  }
  it -= P0_XC;
  if (it < P0_CK) {
    if (it < 128) { cvt_item(p.c_na_k, p.ck_na, it, 256); return; }
    it -= 128;
    if (it < 128) { cvt_item(p.c_diff_k, p.ck_diff, it, 256); return; }
    it -= 128;
    cvt_item(p.c_swa_k, p.ck_swa, it, 128);
    return;
  }
  it -= P0_CK;
  if (it < P0_CVT) {
    if (it < 128) { const int bl = it >> 4, r = it & 15; transpose_tile(p.c_na_v + (size_t)bl * 512 * 256, 256, p.cvt_na + (size_t)bl * 256 * 512, 512, (r >> 2) * 128, (r & 3) * 64, sm, true); return; }
    it -= 128;
    if (it < 128) { const int bl = it >> 4, r = it & 15; transpose_tile(p.c_diff_v + (size_t)bl * 512 * 256, 256, p.cvt_diff + (size_t)bl * 256 * 512, 512, (r >> 2) * 128, (r & 3) * 64, sm, true); return; }
    it -= 128;
    { const int bl = it >> 3, r = it & 7; transpose_tile(p.c_swa_v + (size_t)bl * 512 * 128, 128, p.cvt_swa + (size_t)bl * 128 * 512, 512, (r >> 1) * 128, (r & 1) * 64, sm, true); return; }
  }
  it -= P0_CVT;
  if (it < P0_PQ) { pq_item(p, it, sm); return; }
  it -= P0_PQ;
  if (it < 16) { dft_item(p.dft256, 256, it); return; }
  it -= 16;
  if (it < 256) { dft_item(p.dft1024, 1024, it); return; }
  for (int e = otid(); e < 512 + 1024; e += 256) {
    const bool isD = e < 512;
    const int ee = isD ? e : e - 512;
    const int nf = isD ? 8 : 16;
    const int pos = ee / nf, fi = ee % nf;
    const float inv = exp2f(-(float)fi * (13.287712379549449f / (float)nf));
    float tt = (float)pos * inv * 0.15915494309189535f;
    tt -= rintf(tt);
    float sn, cs;
    sincospif(2.f * tt, &sn, &cs);
    if (isD) { p.ropeD[ee] = cs; p.ropeD[512 + ee] = sn; }
    else { p.ropeS[ee] = cs; p.ropeS[1024 + ee] = sn; }
  }
}

__device__ __forceinline__ void norm_item(const Params& p, int l, int which, int it) {
  const int lane = otid() & 63, wave = otid() >> 6;
  const int row0 = it * 16 + wave * 4;
  const float* xsrc = (which == 0 && l == 0) ? (row0 < NPTOK ? p.x_prompt + (size_t)row0 * 1024 : p.x_sample + (size_t)(row0 - NPTOK) * 1024)
                                             : p.xres + (size_t)row0 * 1024;
  float4 v[4][4];
#pragma unroll
  for (int j = 0; j < 4; ++j)
#pragma unroll
    for (int k = 0; k < 4; ++k) v[j][k] = *(const float4*)(xsrc + (size_t)j * 1024 + (k * 64 + lane) * 4);
  float rs[4];
#pragma unroll
  for (int j = 0; j < 4; ++j) {
    float ss = 0.f;
#pragma unroll
    for (int k = 0; k < 4; ++k) ss += v[j][k].x * v[j][k].x + v[j][k].y * v[j][k].y + v[j][k].z * v[j][k].z + v[j][k].w * v[j][k].w;
#pragma unroll
    for (int o = 32; o >= 1; o >>= 1) ss += __shfl_xor(ss, o);
    rs[j] = rsqrtf(ss * (1.f / 1024.f) + 1e-6f);
  }
  if (which < 2) {
    const int cond = row0 < NPTOK ? 0 : 1 + ((row0 - NPTOK) >> 10);
    const float* gp = (which == 0 ? p.norm1_g : p.norm2_g) + l * 1024;
    const float* shp = p.mods + (size_t)(l * 3 + cond) * 6144 + (which * 3 + 0) * 1024;
    const float* scp = shp + 1024;
#pragma unroll
    for (int k = 0; k < 4; ++k) {
      const int col = (k * 64 + lane) * 4;
      const float4 gg = *(const float4*)(gp + col);
      const float4 sh = *(const float4*)(shp + col);
      const float4 sc = *(const float4*)(scp + col);
      const float mx = gg.x * (1.f + sc.x), my = gg.y * (1.f + sc.y), mz = gg.z * (1.f + sc.z), mw = gg.w * (1.f + sc.w);
#pragma unroll
      for (int j = 0; j < 4; ++j) {
        uint2 w;
        w.x = pack2(v[j][k].x * rs[j] * mx + sh.x, v[j][k].y * rs[j] * my + sh.y);
        w.y = pack2(v[j][k].z * rs[j] * mz + sh.z, v[j][k].w * rs[j] * mw + sh.w);
        *(uint2*)(p.h + (size_t)(row0 + j) * 1024 + col) = w;
      }
    }
  } else {
#pragma unroll
    for (int k = 0; k < 4; ++k) {
      const int col = (k * 64 + lane) * 4;
      const float4 gg = *(const float4*)(p.final_g + col);
#pragma unroll
      for (int j = 0; j < 4; ++j) {
        float4 o;
        o.x = v[j][k].x * rs[j] * gg.x; o.y = v[j][k].y * rs[j] * gg.y; o.z = v[j][k].z * rs[j] * gg.z; o.w = v[j][k].w * rs[j] * gg.w;
        *(float4*)(p.out + (size_t)(row0 + j) * 1024 + col) = o;
      }
    }
  }
}

template <bool ZERO, int YT>
__device__ __forceinline__ void gemm_main_t(const u16* __restrict__ X, int ldx, const u16* __restrict__ Y, int ldy, int K,
                                          u16* smem, f32x4 (&acc)[4][YT]) {
  const int tid = otid(), lane = tid & 63, wave = tid >> 6, wx = wave & 1, wy = wave >> 1, r = lane & 15, g = lane >> 4;
  u16* sX = smem;
  u16* sY = smem + 2 * 128 * LSTR;
  const int lrow = tid >> 3, lkc = tid & 7;
  const u16* gx = X + (size_t)lrow * ldx + lkc * 8;
  const u16* gy = Y + (size_t)lrow * ldy + lkc * 8;
  u32x4 rx[4], ry[YT];
#pragma unroll
  for (int i = 0; i < 4; ++i) rx[i] = *(const u32x4*)(gx + (size_t)(32 * i) * ldx);
#pragma unroll
  for (int i = 0; i < YT; ++i) ry[i] = *(const u32x4*)(gy + (size_t)(32 * i) * ldy);
  if (ZERO) {
#pragma unroll
    for (int a = 0; a < 4; ++a)
#pragma unroll
      for (int b = 0; b < YT; ++b) acc[a][b] = (f32x4){0.f, 0.f, 0.f, 0.f};
  }
#pragma unroll
  for (int i = 0; i < 4; ++i) *(u32x4*)(sX + (lrow + 32 * i) * LSTR + lkc * 8) = rx[i];
#pragma unroll
  for (int i = 0; i < YT; ++i) *(u32x4*)(sY + (lrow + 32 * i) * LSTR + lkc * 8) = ry[i];
  __syncthreads();
  const int nk = K >> 6;
  const u16* cx0 = sX + (wx * 64 + r) * LSTR + g * 8;
  const u16* cy0 = sY + (wy * (16 * YT) + r) * LSTR + g * 8;
#define GEMM_COMPUTE(cur)                                                                            \
  {                                                                                                  \
    const u16* cx = cx0 + (cur) * 128 * LSTR;                                                        \
    const u16* cy = cy0 + (cur) * 128 * LSTR;                                                        \
    _Pragma("unroll") for (int kk = 0; kk < 2; ++kk) {                                               \
      bf16x8 a[4], b[YT];                                                                            \
      _Pragma("unroll") for (int i = 0; i < 4; ++i) a[i] = *(const bf16x8*)(cx + i * 16 * LSTR + kk * 32); \
      _Pragma("unroll") for (int i = 0; i < YT; ++i) b[i] = *(const bf16x8*)(cy + i * 16 * LSTR + kk * 32); \
      _Pragma("unroll") for (int xi = 0; xi < 4; ++xi)                                               \
        _Pragma("unroll") for (int yi = 0; yi < YT; ++yi)                                            \
          acc[xi][yi] = __builtin_amdgcn_mfma_f32_16x16x32_bf16(a[xi], b[yi], acc[xi][yi], 0, 0, 0); \
    }                                                                                                \
  }
  u32x4 bx[4], by[YT];
  u16* const w1X = sX + 128 * LSTR + lrow * LSTR + lkc * 8;
  u16* const w1Y = sY + 128 * LSTR + lrow * LSTR + lkc * 8;
  u16* const w0X = sX + lrow * LSTR + lkc * 8;
  u16* const w0Y = sY + lrow * LSTR + lkc * 8;
#pragma unroll 1
  for (int kt = 0; kt + 2 < nk; kt += 2) {
#pragma unroll
    for (int i = 0; i < 4; ++i) gload16(rx[i], gx + (size_t)(32 * i) * ldx + (kt + 1) * 64);
#pragma unroll
    for (int i = 0; i < YT; ++i) gload16(ry[i], gy + (size_t)(32 * i) * ldy + (kt + 1) * 64);
#pragma unroll
    for (int i = 0; i < 4; ++i) gload16(bx[i], gx + (size_t)(32 * i) * ldx + (kt + 2) * 64);
#pragma unroll
    for (int i = 0; i < YT; ++i) gload16(by[i], gy + (size_t)(32 * i) * ldy + (kt + 2) * 64);
    GEMM_COMPUTE(0);
    if (YT == 4) asm volatile("s_waitcnt vmcnt(8)" ::: "memory"); else asm volatile("s_waitcnt vmcnt(7)" ::: "memory");
#pragma unroll
    for (int i = 0; i < 4; ++i) *(u32x4*)(w1X + 32 * i * LSTR) = rx[i];
#pragma unroll
    for (int i = 0; i < YT; ++i) *(u32x4*)(w1Y + 32 * i * LSTR) = ry[i];
    __syncthreads();
    GEMM_COMPUTE(1);
    asm volatile("s_waitcnt vmcnt(0)" ::: "memory");
#pragma unroll
    for (int i = 0; i < 4; ++i) *(u32x4*)(w0X + 32 * i * LSTR) = bx[i];
#pragma unroll
    for (int i = 0; i < YT; ++i) *(u32x4*)(w0Y + 32 * i * LSTR) = by[i];
    __syncthreads();
  }
  {
#pragma unroll
    for (int i = 0; i < 4; ++i) gload16(rx[i], gx + (size_t)(32 * i) * ldx + (nk - 1) * 64);
#pragma unroll
    for (int i = 0; i < YT; ++i) gload16(ry[i], gy + (size_t)(32 * i) * ldy + (nk - 1) * 64);
    GEMM_COMPUTE(0);
    asm volatile("s_waitcnt vmcnt(0)" ::: "memory");
#pragma unroll
    for (int i = 0; i < 4; ++i) *(u32x4*)(w1X + 32 * i * LSTR) = rx[i];
#pragma unroll
    for (int i = 0; i < YT; ++i) *(u32x4*)(w1Y + 32 * i * LSTR) = ry[i];
    __syncthreads();
  }
  GEMM_COMPUTE(1);
  __syncthreads();
#undef GEMM_COMPUTE
}

#ifndef REP_GEMM
#define REP_GEMM 0
#endif
#ifndef REP_MIX
#define REP_MIX 0
#endif
#ifndef REP_SYNC
#define REP_SYNC 0
#endif
#ifndef REP_P0
#define REP_P0 0
#endif
template <int YT>
__device__ __forceinline__ void gemm_main(const u16* __restrict__ X, int ldx, const u16* __restrict__ Y, int ldy, int K,
                                          u16* smem, f32x4 (&acc)[4][YT]) {
  gemm_main_t<true, YT>(X, ldx, Y, ldy, K, smem, acc);
#if REP_GEMM
  gemm_main_t<false, YT>(X, ldx, Y, ldy, K, smem, acc);
#pragma unroll
  for (int a = 0; a < 4; ++a)
#pragma unroll
    for (int b = 0; b < YT; ++b) acc[a][b] *= 0.5f;
#endif
}

__device__ __forceinline__ bool tile_map(int j, int ntx, int& tx, int& ty, int nty = 48) {
  const int nblk = gridDim.x, bid = blockIdx.x;
  if (nblk == 512) {
    const int per = nty >> 3, hp = per >> 1;
    const int rank = bid >> 3, q = (rank & 31) + j * 32, mem = rank >> 5;
    if (q >= hp * ntx) return false;
    tx = q / hp; ty = per * (bid & 7) + 2 * (q % hp) + mem;
    return true;
  } else {
    const int it = bid + j * nblk;
    if (it >= nty * ntx) return false;
    tx = it / nty; ty = it % nty;
    return true;
  }
}

__device__ void gin_tile(const Params& p, int l, int tx, int ty, u16* smem) {
  const int n0 = tx * 128, m0 = ty * 128;
  f32x4 acc[4][4];
  gemm_main<4>(p.w_inT + (size_t)l * 2304 * 1024 + (size_t)n0 * 1024, 1024, p.h + (size_t)m0 * 1024, 1024, 1024, smem, acc);
  const int lane = otid() & 63, wave = otid() >> 6, wx = wave & 1, wy = wave >> 1, r = lane & 15, g = lane >> 4;
  const int nw = n0 + wx * 64;
  const bool isS = m0 >= NPTOK;
  int ropeMode = 0;
  if (isS) {
    if (nw >= 768 && nw < 1280) ropeMode = 1;
    else if (nw >= 1792 && nw < 2176) ropeMode = 2;
  }
  float* okv = nullptr; int okv_w = 0, okv_c = 0;
  if (!isS) {
    if (nw >= 256 && nw < 512) { okv = p.out + O_NAK; okv_w = 256; okv_c = nw - 256; }
    else if (nw >= 512 && nw < 768) { okv = p.out + O_NAV; okv_w = 256; okv_c = nw - 512; }
    else if (nw >= 1024 && nw < 1280) { okv = p.out + O_DK; okv_w = 256; okv_c = nw - 1024; }
    else if (nw >= 1280 && nw < 1536) { okv = p.out + O_DV; okv_w = 256; okv_c = nw - 1280; }
    else if (nw >= 2048 && nw < 2176) { okv = p.out + O_SK; okv_w = 128; okv_c = nw - 2048; }
    else if (nw >= 2176) { okv = p.out + O_SV; okv_w = 128; okv_c = nw - 2176; }
  }
  int khh = -1;
  if (nw >= 256 && nw < 512) khh = (nw - 256) >> 6;
  else if (nw >= 1024 && nw < 1280) khh = 4 + ((nw - 1024) >> 6);
  else if (nw >= 2048 && nw < 2176) khh = 8 + ((nw - 2048) >> 6);
  int vrow = -1;
  if (nw >= 512 && nw < 768) vrow = nw - 512;
  else if (nw >= 1280 && nw < 1536) vrow = 256 + nw - 1280;
  else if (nw >= 2176) vrow = 512 + nw - 2176;
#pragma unroll
  for (int yi = 0; yi < 4; ++yi) {
    const int m = m0 + wy * 64 + yi * 16 + r;
    const int t = (m - NPTOK) & 1023;
    const int prow = t >> 6, pcol = t & 63;
#pragma unroll
    for (int xi = 0; xi < 4; ++xi) {
      f32x4 v = acc[xi][yi];
      if (ropeMode == 1) {
        const int pos = (xi & 1) ? pcol : prow;
        const float4 cs = *(const float4*)(p.ropeD + pos * 8 + 4 * (g & 1));
        const float4 sn = *(const float4*)(p.ropeD + 512 + pos * 8 + 4 * (g & 1));
        const float sg = (g >= 2) ? 1.f : -1.f;
        const float o0 = __shfl_xor(v[0], 32), o1 = __shfl_xor(v[1], 32), o2 = __shfl_xor(v[2], 32), o3 = __shfl_xor(v[3], 32);
        v[0] = v[0] * cs.x + sg * o0 * sn.x; v[1] = v[1] * cs.y + sg * o1 * sn.y;
        v[2] = v[2] * cs.z + sg * o2 * sn.z; v[3] = v[3] * cs.w + sg * o3 * sn.w;
      } else if (ropeMode == 2) {
        const int pos = (xi >> 1) ? pcol : prow;
        const float4 cs = *(const float4*)(p.ropeS + pos * 16 + 4 * g);
        const float4 sn = *(const float4*)(p.ropeS + 1024 + pos * 16 + 4 * g);
        const f32x4 o = acc[xi ^ 1][yi];
        const float sg = (xi & 1) ? 1.f : -1.f;
        v[0] = v[0] * cs.x + sg * o[0] * sn.x; v[1] = v[1] * cs.y + sg * o[1] * sn.y;
        v[2] = v[2] * cs.z + sg * o[2] * sn.z; v[3] = v[3] * cs.w + sg * o[3] * sn.w;
      }
      const int nloc = xi * 16 + 4 * g;
      if (okv) {
        const int b = m >> 8, pos = m & 255;
        float4 o4; o4.x = v[0]; o4.y = v[1]; o4.z = v[2]; o4.w = v[3];
        *(float4*)(okv + ((size_t)((b * 4 + l) * 256 + pos)) * okv_w + okv_c + nloc) = o4;
      }
      if (vrow >= 0) {
        u16* vb = p.vfr + ((size_t)((vrow >> 6) * 192 + (m >> 5))) * 2048;
#pragma unroll
        for (int i = 0; i < 4; ++i) vb[vfrag_off(m & 31, nloc + i)] = f2bf(v[i]);
      } else if (khh >= 0) {
        uint2 w; w.x = pack2(v[0], v[1]); w.y = pack2(v[2], v[3]);
        *(uint2*)(p.kfr + ((size_t)(khh * 192 + (m >> 5))) * 2048 + kfrag_off(m & 31, nloc)) = w;
      } else {
        uint2 w; w.x = pack2(v[0], v[1]); w.y = pack2(v[2], v[3]);
        *(uint2*)(p.z + (size_t)m * INW + nw + nloc) = w;
      }
    }
  }
}

__device__ void res_tile(const Params& p, int l, int tx, int ty, const u16* A, const u16* WT, int K, int gi, u16* smem, bool first = false) {
  const int n0 = tx * 128, m0 = ty * 96;
  f32x4 acc[4][3];
  gemm_main<3>(WT + (size_t)n0 * K, K, A + (size_t)m0 * K, K, K, smem, acc);
  const int lane = otid() & 63, wave = otid() >> 6, wx = wave & 1, wy = wave >> 1, r = lane & 15, g = lane >> 4;
#pragma unroll
  for (int yi = 0; yi < 3; ++yi) {
    const int m = m0 + wy * 48 + yi * 16 + r;
    const int cond = m < NPTOK ? 0 : 1 + ((m - NPTOK) >> 10);
    const float* gate = p.mods + (size_t)(l * 3 + cond) * 6144 + gi * 1024;
    float* xrow = p.xres + (size_t)m * 1024;
    const float* xin = first ? (m < NPTOK ? p.x_prompt + (size_t)m * 1024 : p.x_sample + (size_t)(m - NPTOK) * 1024) : xrow;
    float4 xv[4], gt[4];
#pragma unroll
    for (int xi = 0; xi < 4; ++xi) {
      const int n = n0 + wx * 64 + xi * 16 + 4 * g;
      xv[xi] = *(const float4*)(xin + n);
      gt[xi] = *(const float4*)(gate + n);
    }
#pragma unroll
    for (int xi = 0; xi < 4; ++xi) {
      const int n = n0 + wx * 64 + xi * 16 + 4 * g;
      const f32x4 v = acc[xi][yi];
      float4 o = xv[xi];
      o.x += gt[xi].x * v[0]; o.y += gt[xi].y * v[1]; o.z += gt[xi].z * v[2]; o.w += gt[xi].w * v[3];
      *(float4*)(xrow + n) = o;
    }
  }
}

__device__ void m1_tile(const Params& p, int l, int tx, int ty, u16* smem) {
  const int n0 = tx * 128, m0 = ty * 128;
  f32x4 acc[4][4];
  gemm_main<4>(p.w1T + (size_t)l * 4096 * 1024 + (size_t)n0 * 1024, 1024, p.h + (size_t)m0 * 1024, 1024, 1024, smem, acc);
  const int lane = otid() & 63, wave = otid() >> 6, wx = wave & 1, wy = wave >> 1, r = lane & 15, g = lane >> 4;
#pragma unroll
  for (int xi = 0; xi < 4; ++xi) {
    const int n = n0 + wx * 64 + xi * 16 + 4 * g;
#pragma unroll
    for (int yi = 0; yi < 4; ++yi) {
      const int m = m0 + wy * 64 + yi * 16 + r;
      const f32x4 v = acc[xi][yi];
      float a0 = fmaxf(v[0], 0.f), a1 = fmaxf(v[1], 0.f), a2 = fmaxf(v[2], 0.f), a3 = fmaxf(v[3], 0.f);
      uint2 w; w.x = pack2(a0 * a0, a1 * a1); w.y = pack2(a2 * a2, a3 * a3);
      *(uint2*)(p.u + (size_t)m * 4096 + n) = w;
    }
  }
}

__device__ void f1_tile(const Params& p, int l, int it, u16* smem) {
  const int tx = it % 48, ty = it / 48;
  const int x0 = tx * 128, y0 = ty * 128;
  f32x4 acc[4][4];
  gemm_main<4>(p.z + (size_t)x0 * INW + 1536, INW, p.pqt + (size_t)l * 512 * 256 + (size_t)y0 * 256, 256, 256, smem, acc);
  const int lane = otid() & 63, wave = otid() >> 6, wx = wave & 1, wy = wave >> 1, r = lane & 15, g = lane >> 4;
#pragma unroll
  for (int yi = 0; yi < 4; ++yi) {
    const int y = y0 + wy * 64 + yi * 16 + r;
    const int col = y & 255, which = y >> 8;
#pragma unroll
    for (int xi = 0; xi < 4; ++xi) {
      const int tok = x0 + wx * 64 + xi * 16 + 4 * g;
      size_t addr;
      if (tok < NPTOK) {
        const int b = tok >> 8, pos = tok & 255;
        addr = (size_t)b * (256 * 512) + (size_t)col * 512 + which * 256 + pos;
      } else {
        const int b = (tok - NPTOK) >> 10, pos = (tok - NPTOK) & 1023;
        addr = (size_t)16 * 256 * 512 + (size_t)b * (256 * 2048) + (size_t)col * 2048 + which * 1024 + pos;
      }
      const f32x4 v = acc[xi][yi];
      uint2 w; w.x = pack2(v[0], v[1]); w.y = pack2(v[2], v[3]);
      *(uint2*)(p.uv + addr) = w;
    }
  }
  asm volatile("s_waitcnt vmcnt(0)" ::: "memory");
  __syncthreads();
  if (threadIdx.x == 0) {
    __builtin_amdgcn_fence(__ATOMIC_RELEASE, "agent");
    asm volatile("s_waitcnt vmcnt(0)" ::: "memory");
    xb_add(p.bar + XCD_BAR_WORDS + (8 + l) * 64, 1u);
  }
}

__device__ void f2_tile(const Params& p, int l, int it, u16* smem) {
  if (threadIdx.x == 0) {
    unsigned* c = p.bar + XCD_BAR_WORDS + (8 + l) * 64;
    unsigned sp = 0;
    while (xb_ld(c) < 192u) { __builtin_amdgcn_s_sleep(2); if (++sp > (1u << 24)) break; }
    __builtin_amdgcn_fence(__ATOMIC_ACQUIRE, "agent");
    asm volatile("s_waitcnt vmcnt(0)" ::: "memory");
  }
  __syncthreads();
  int L, b, tx, ty, tokbase;
  const u16* uvb; const u16* dft;
  if (it < 32) { L = 1024; b = it >> 4; tx = (it >> 3) & 1; ty = it & 7; uvb = p.uv + (size_t)16 * 256 * 512 + (size_t)b * (256 * 2048); dft = p.dft1024; tokbase = NPTOK + b * 1024; }
  else { it -= 32; L = 256; b = it >> 2; tx = (it >> 1) & 1; ty = it & 1; uvb = p.uv + (size_t)b * (256 * 512); dft = p.dft256; tokbase = b * 256; }
  const int x0 = tx * 128, y0 = ty * 128, K = 2 * L;
  f32x4 acc[4][4];
  gemm_main<4>(uvb + (size_t)x0 * K, K, dft + (size_t)y0 * K, K, K, smem, acc);
  const int lane = otid() & 63, wave = otid() >> 6, wx = wave & 1, wy = wave >> 1, r = lane & 15, g = lane >> 4;
  const float scale = rsqrtf(64.f * (float)L);
#pragma unroll
  for (int yi = 0; yi < 4; ++yi) {
    const int pos = y0 + wy * 64 + yi * 16 + r;
#pragma unroll
    for (int xi = 0; xi < 4; ++xi) {
      const int col = x0 + wx * 64 + xi * 16 + 4 * g;
      const f32x4 v = acc[xi][yi];
      uint2 w; w.x = pack2(v[0] * scale, v[1] * scale); w.y = pack2(v[2] * scale, v[3] * scale);
      *(uint2*)(p.cat + (size_t)(tokbase + pos) * 1024 + 512 + col) = w;
    }
  }
}

struct Seg { const u16* K; const u16* Vt; int ldk, ldv, nblk, pos0, stride; };
#define KLOC(hh, tokb) (p.kfr + ((size_t)((hh) * 192 + ((tokb) >> 5))) * 2048)
#define VLOC(hh, tokb) (p.vfr + ((size_t)((hh) * 192 + ((tokb) >> 5))) * 2048)
template <int QT> struct AState { float m[QT]; float ls[QT]; f32x4 o[QT][4]; };

__device__ __forceinline__ bf16x8 as_bf(u32x4 v) { union { u32x4 u; bf16x8 b; } x; x.u = v; return x.b; }

template <int DC>
__device__ __forceinline__ void issue_blk(const Seg& s0, const Seg& s1, int b, int r, int g, u32x4 (&kf)[2][DC], u32x4 (&vf)[4]) {
  const bool in0 = b < s0.nblk;
  const u16* Kp = in0 ? s0.K : s1.K;
  const u16* Vp = in0 ? s0.Vt : s1.Vt;
  const int pos = in0 ? (s0.pos0 + b * s0.stride) : (s1.pos0 + (b - s0.nblk) * s1.stride);
  const int lane8 = (g * 16 + r) * 8;
  const u16* kp = Kp + (size_t)(pos >> 5) * 2048 + lane8;
  const u16* vp = Vp + (size_t)(pos >> 5) * 2048 + lane8;
#pragma unroll
  for (int t = 0; t < 2; ++t)
#pragma unroll
    for (int dc = 0; dc < DC; ++dc) gload16(kf[t][dc], kp + (t * 2 + dc) * 512);
#pragma unroll
  for (int dv = 0; dv < 4; ++dv) gload16(vf[dv], vp + dv * 512);
}
template <int N>
__device__ __forceinline__ void wait_blk(u32x4 (&kf)[2][1], u32x4 (&vf)[4]) {
  asm volatile("s_waitcnt vmcnt(%6)" : "+v"(kf[0][0]), "+v"(kf[1][0]), "+v"(vf[0]), "+v"(vf[1]), "+v"(vf[2]), "+v"(vf[3]) : "n"(N) : "memory");
}
template <int N>
__device__ __forceinline__ void wait_blk(u32x4 (&kf)[2][2], u32x4 (&vf)[4]) {
  asm volatile("s_waitcnt vmcnt(%8)" : "+v"(kf[0][0]), "+v"(kf[0][1]), "+v"(kf[1][0]), "+v"(kf[1][1]), "+v"(vf[0]), "+v"(vf[1]), "+v"(vf[2]), "+v"(vf[3]) : "n"(N) : "memory");
}

template <int D, int QT, int MODE>
__device__ __forceinline__ void attn_compute(const u32x4 (&kc)[2][D / 32], const u32x4 (&vc)[4], const bf16x8 (&qf)[QT][D / 32], const float sc,
                                             AState<QT>& st, const bool in0, const int pos, const int qpos0, const float* __restrict__ rpb_h,
                                             const int r, const int g) {
  constexpr int DC = D / 32;
#pragma unroll
  for (int q = 0; q < QT; ++q) {
    f32x4 s_[2];
    s_[0] = (f32x4){0.f, 0.f, 0.f, 0.f};
    s_[1] = (f32x4){0.f, 0.f, 0.f, 0.f};
#pragma unroll
    for (int t = 0; t < 2; ++t)
#pragma unroll
      for (int dc = 0; dc < DC; ++dc) s_[t] = __builtin_amdgcn_mfma_f32_16x16x32_bf16(as_bf(kc[t][dc]), qf[q][dc], s_[t], 0, 0, 0);
    float sv[8];
#pragma unroll
    for (int t = 0; t < 2; ++t)
#pragma unroll
      for (int i = 0; i < 4; ++i) {
        float x = s_[t][i] * sc;
        if (MODE == 1) {
          if (!in0) {
            const int qpos = qpos0 + q * 16 + r;
            const int qrow = qpos >> 6, cq = qpos & 63;
            const int kpos = pos + 8 * g + 4 * t + i;
            const int krow = kpos >> 6, ck = kpos & 63;
            const int cs = min(max(cq - 8, 0), 48);
            const bool valid = (ck >= cs) && (ck < cs + 16);
            const int bi = (krow - qrow + 7) * 31 + (ck - cq + 15);
            const float bias = rpb_h[valid ? bi : 0];
            x = valid ? (x + bias) : -1e30f;
          }
        } else if (MODE == 2) {
          if (!in0) {
            const int qpos = qpos0 + q * 16 + r;
            const int kpos = pos + 8 * g + 4 * t + i;
            const int d = qpos - kpos;
            x = (d <= 128 && d >= -128) ? x : -1e30f;
          }
        }
        sv[4 * t + i] = x;
      }
    float mx = fmaxf(fmaxf(fmaxf(sv[0], sv[1]), fmaxf(sv[2], sv[3])), fmaxf(fmaxf(sv[4], sv[5]), fmaxf(sv[6], sv[7])));
    mx = fmaxf(mx, __shfl_xor(mx, 16));
    mx = fmaxf(mx, __shfl_xor(mx, 32));
    const float mnew = fmaxf(st.m[q], mx);
    const float alpha = __builtin_amdgcn_exp2f(st.m[q] - mnew);
    st.m[q] = mnew;
    float ps = 0.f;
#pragma unroll
    for (int j = 0; j < 8; ++j) { sv[j] = __builtin_amdgcn_exp2f(sv[j] - mnew); ps += sv[j]; }
    st.ls[q] = st.ls[q] * alpha + ps;
    union { bf16x8 v; unsigned w[4]; } pf;
    pf.w[0] = pack2(sv[0], sv[1]); pf.w[1] = pack2(sv[2], sv[3]); pf.w[2] = pack2(sv[4], sv[5]); pf.w[3] = pack2(sv[6], sv[7]);
#pragma unroll
    for (int dv = 0; dv < 4; ++dv) {
      f32x4 o = st.o[q][dv];
      o[0] *= alpha; o[1] *= alpha; o[2] *= alpha; o[3] *= alpha;
      st.o[q][dv] = __builtin_amdgcn_mfma_f32_16x16x32_bf16(as_bf(vc[dv]), pf.v, o, 0, 0, 0);
    }
  }
}

template <int D, int QT, int MODE, int NQ = 2>
__device__ __forceinline__ void attn_run(const Seg& s0, const Seg& s1, const bf16x8 (&qf)[QT][D / 32], const float sc,
                                         AState<QT>& st, const int qpos0, const float* __restrict__ rpb_h, const int bb = 0, const int be = -1) {
  constexpr int DC = D / 32;
  constexpr int NL = 2 * DC + 4;
  const int lane = otid() & 63, r = lane & 15, g = lane >> 4;
  const int nb = be < 0 ? s0.nblk + s1.nblk : be;
  u32x4 kq[NQ][2][DC], vq[NQ][4];
#pragma unroll
  for (int q = 0; q < QT; ++q)
#pragma unroll
    for (int dc = 0; dc < DC; ++dc) asm volatile("" ::"v"(qf[q][dc]));
  asm volatile("s_waitcnt vmcnt(0)" ::: "memory");
#pragma unroll 1
  for (int b = bb; b < nb; b += NQ) {
#pragma unroll
    for (int j = 0; j < NQ; ++j) issue_blk<DC>(s0, s1, b + j, r, g, kq[j], vq[j]);
#pragma unroll
    for (int j = 0; j < NQ; ++j) {
      if (j == 0) wait_blk<(NQ - 1) * NL>(kq[j], vq[j]);
      else if (j == 1) wait_blk<(NQ - 2) * NL>(kq[j], vq[j]);
      else if (j == 2) wait_blk<(NQ > 3 ? (NQ - 3) * NL : 0)>(kq[j], vq[j]);
      else wait_blk<0>(kq[j], vq[j]);
      const int bj = b + j;
      const bool in0 = bj < s0.nblk;
      const int pos = in0 ? (s0.pos0 + bj * s0.stride) : (s1.pos0 + (bj - s0.nblk) * s1.stride);
      attn_compute<D, QT, MODE>(kq[j], vq[j], qf, sc, st, in0, pos, qpos0, rpb_h, r, g);
    }
  }
}

template <int QT>
__device__ __forceinline__ void astate_init(AState<QT>& st, float m0, float l0) {
#pragma unroll
  for (int q = 0; q < QT; ++q) {
    st.m[q] = m0; st.ls[q] = l0;
#pragma unroll
    for (int dv = 0; dv < 4; ++dv) st.o[q][dv] = (f32x4){0.f, 0.f, 0.f, 0.f};
  }
}
template <int QT>
__device__ __forceinline__ void astate_finalize(AState<QT>& st) {
#pragma unroll
  for (int q = 0; q < QT; ++q) {
    float l = st.ls[q];
    l += __shfl_xor(l, 16);
    l += __shfl_xor(l, 32);
    const float inv = 1.f / l;
#pragma unroll
    for (int dv = 0; dv < 4; ++dv) { st.o[q][dv][0] *= inv; st.o[q][dv][1] *= inv; st.o[q][dv][2] *= inv; st.o[q][dv][3] *= inv; }
  }
}
template <int DC, int QT>
__device__ __forceinline__ void load_q(const u16* zq  , bf16x8 (&qf)[QT][DC]) {
  const int lane = otid() & 63, r = lane & 15, g = lane >> 4;
#pragma unroll
  for (int q = 0; q < QT; ++q)
#pragma unroll
    for (int dc = 0; dc < DC; ++dc) qf[q][dc] = *(const bf16x8*)(zq + (size_t)(q * 16 + r) * INW + dc * 32 + g * 8);
}
template <int QT>
__device__ __forceinline__ void write_o(const Params& p, const AState<QT>& st, int tok0, int col0) {
  const int lane = otid() & 63, r = lane & 15, g = lane >> 4;
#pragma unroll
  for (int q = 0; q < QT; ++q)
#pragma unroll
    for (int dv = 0; dv < 4; ++dv) {
      const f32x4 v = st.o[q][dv];
      uint2 w; w.x = pack2(v[0], v[1]); w.y = pack2(v[2], v[3]);
      *(uint2*)(p.cat + (size_t)(tok0 + q * 16 + r) * 1024 + col0 + dv * 16 + 4 * g) = w;
    }
}

__device__ __forceinline__ float diff_lambda(const Params& p, int l, float lam_init) {
  const int lane = otid() & 63;
  float a = 0.f, b = 0.f;
  if (lane < 32) { a = p.lq1[l * 32 + lane] * p.lk1[l * 32 + lane]; b = p.lq2[l * 32 + lane] * p.lk2[l * 32 + lane]; }
#pragma unroll
  for (int o = 32; o >= 1; o >>= 1) { a += __shfl_xor(a, o); b += __shfl_xor(b, o); }
  return expf(a) - expf(b) + lam_init;
}

__device__ __forceinline__ void diff_finish_q(const Params& p, int l, float lam, float lam_init, f32x4 (&A)[4], const f32x4 (&B)[4], int tokrow0, int col0) {
  const int lane = otid() & 63, r = lane & 15, g = lane >> 4;
  const float* sg = p.subln_g + l * 64;
  float ss = 0.f;
#pragma unroll
  for (int dv = 0; dv < 4; ++dv)
#pragma unroll
    for (int i = 0; i < 4; ++i) {
      const float v = A[dv][i] - lam * B[dv][i];
      A[dv][i] = v;
      ss += v * v;
    }
  ss += __shfl_xor(ss, 16);
  ss += __shfl_xor(ss, 32);
  const float rs = rsqrtf(ss * (1.f / 64.f) + 1e-6f) * (1.f - lam_init);
#pragma unroll
  for (int dv = 0; dv < 4; ++dv) {
    const float4 gg = *(const float4*)(sg + dv * 16 + 4 * g);
    uint2 w;
    w.x = pack2(A[dv][0] * rs * gg.x, A[dv][1] * rs * gg.y);
    w.y = pack2(A[dv][2] * rs * gg.z, A[dv][3] * rs * gg.w);
    *(uint2*)(p.cat + (size_t)(tokrow0 + r) * 1024 + col0 + dv * 16 + 4 * g) = w;
  }
}

#ifndef AQT
#define AQT 2
#endif
#define QW (16 * AQT)
#define NQG_CTX (256 / QW)
#define NQG_LAT (1024 / QW)
__device__ void attn_diff_item(const Params& p, int l, bool lat, int bi, float* sm) {
  const int wave = otid() >> 6, lane = otid() & 63, r = lane & 15, g = lane >> 4;
  const int ps = wave >> 1, half = wave & 1;
  int b, h, qg, tokb;
  if (lat) { b = bi / (4 * NQG_LAT); h = (bi / NQG_LAT) & 3; qg = bi % NQG_LAT; tokb = NPTOK + b * 1024; }
  else { b = bi / (4 * NQG_CTX); h = (bi / NQG_CTX) & 3; qg = bi % NQG_CTX; tokb = b * 256; }
  const int tok0 = tokb + qg * QW;
  const u16* zb = p.z + (size_t)tokb * INW;
  Seg s0, s1;
  if (lat) {
    const int bl = b * 4 + l;
    s0.K = p.ck_diff + (size_t)((bl * 4 + h) * 16) * 2048 + ps * 512; s0.Vt = p.cvt_diff + (size_t)((bl * 4 + h) * 16) * 2048;
    s0.ldk = 0; s0.ldv = 0; s0.nblk = half ? 0 : 16; s0.pos0 = 0; s0.stride = 32;
    s1.K = KLOC(4 + h, tokb) + ps * 512; s1.Vt = VLOC(4 + h, tokb);
    s1.ldk = 0; s1.ldv = 0; s1.nblk = half ? 24 : 8; s1.pos0 = half ? 256 : 0; s1.stride = 32;
  } else {
    s0.K = KLOC(4 + h, tokb) + ps * 512; s0.Vt = VLOC(4 + h, tokb);
    s0.ldk = 0; s0.ldv = 0; s0.nblk = 4; s0.pos0 = half ? 128 : 0; s0.stride = 32;
    s1 = s0; s1.nblk = 0;
  }
  bf16x8 qf[AQT][1];
  load_q<1, AQT>(p.z + (size_t)tok0 * INW + 768 + h * 64 + ps * 32, qf);
  AState<AQT> st;
  astate_init<AQT>(st, -1e30f, 0.f);
  attn_run<32, AQT, 0, 4>(s0, s1, qf, 0.17677669529663687f * LOG2E, st, 0, nullptr);
  float lt[AQT];
#pragma unroll
  for (int q = 0; q < AQT; ++q) {
    lt[q] = st.ls[q];
    lt[q] += __shfl_xor(lt[q], 16);
    lt[q] += __shfl_xor(lt[q], 32);
  }
  constexpr int WS = 64 * 16 * AQT;
  float* pm = sm + 4 * WS;
  if (wave != 0) {
    float* po = sm + wave * WS + lane * (16 * AQT);
#pragma unroll
    for (int q = 0; q < AQT; ++q) {
#pragma unroll
      for (int dv = 0; dv < 4; ++dv) *(f32x4*)(po + q * 16 + dv * 4) = st.o[q][dv];
      if (g == 0) { pm[wave * QW + q * 16 + r] = st.m[q]; pm[4 * QW + wave * QW + q * 16 + r] = lt[q]; }
    }
  }
  __syncthreads();
  if (wave == 0) {
    const float lam_init = 0.8f - 0.6f * expf(-0.3f * (float)l);
    const float lam = diff_lambda(p, l, lam_init);
#pragma unroll
    for (int q = 0; q < AQT; ++q) {
      f32x4 A[4], B[4];
      {
        const float m1 = pm[QW + q * 16 + r], l1 = pm[4 * QW + QW + q * 16 + r];
        const float M = fmaxf(st.m[q], m1);
        const float a0 = exp2f(st.m[q] - M), a1 = exp2f(m1 - M);
        const float inv = 1.f / (lt[q] * a0 + l1 * a1);
#pragma unroll
        for (int dv = 0; dv < 4; ++dv) {
          const f32x4 o1 = *(const f32x4*)(sm + 1 * WS + lane * (16 * AQT) + q * 16 + dv * 4);
          A[dv] = (st.o[q][dv] * a0 + o1 * a1) * inv;
        }
      }
      {
        const float m2 = pm[2 * QW + q * 16 + r], l2 = pm[4 * QW + 2 * QW + q * 16 + r], m3 = pm[3 * QW + q * 16 + r], l3 = pm[4 * QW + 3 * QW + q * 16 + r];
        const float M = fmaxf(m2, m3);
        const float a2 = exp2f(m2 - M), a3 = exp2f(m3 - M);
        const float inv = 1.f / (l2 * a2 + l3 * a3);
#pragma unroll
        for (int dv = 0; dv < 4; ++dv) {
          const f32x4 o2 = *(const f32x4*)(sm + 2 * WS + lane * (16 * AQT) + q * 16 + dv * 4);
          const f32x4 o3 = *(const f32x4*)(sm + 3 * WS + lane * (16 * AQT) + q * 16 + dv * 4);
          B[dv] = (o2 * a2 + o3 * a3) * inv;
        }
      }
      diff_finish_q(p, l, lam, lam_init, A, B, tok0 + q * 16, 256 + h * 64);
    }
  }
  __syncthreads();
}

__device__ void attn_ctx_item(const Params& p, int l, int bi) {
  const int wave = otid() >> 6, lane = otid() & 63, g = lane >> 4;
  const int w = bi * 4 + wave;
  const int type = w / (64 * NQG_CTX), rem = w % (64 * NQG_CTX);
  const int b = rem / (4 * NQG_CTX), h = (rem / NQG_CTX) & 3, qg = rem % NQG_CTX;
  const int tokb = b * 256, tok0 = tokb + qg * QW;
  const u16* zb = p.z + (size_t)tokb * INW;
  const int kvh = h >> 1;
  const int qcol = type == 0 ? h * 64 : 1792 + h * 64;
  const int kcol = type == 0 ? 256 + h * 64 : 2048 + kvh * 64;
  const int vrow = type == 0 ? h * 64 : 512 + kvh * 64;
  const int ocol = type == 0 ? h * 64 : 768 + h * 64;
  bf16x8 qf[AQT][2];
  load_q<2, AQT>(p.z + (size_t)tok0 * INW + qcol, qf);
  const int hslot = type == 0 ? h : 8 + kvh;
  Seg s0; s0.K = KLOC(hslot, tokb); s0.Vt = VLOC(hslot, tokb); s0.ldk = 0; s0.ldv = 0; s0.nblk = 8; s0.pos0 = 0; s0.stride = 32;
  Seg sN = s0; sN.nblk = 0;
  AState<AQT> st;
  const float sk = type == 0 ? -1e30f : p.swa_sink[l * 4 + h] * LOG2E;
  astate_init<AQT>(st, sk, (type == 1 && g == 0) ? 1.f : 0.f);
  attn_run<64, AQT, 0, 2>(s0, sN, qf, 0.125f * LOG2E, st, 0, nullptr);
  astate_finalize<AQT>(st);
  write_o<AQT>(p, st, tok0, ocol);
}

__device__ void attn_lat_item(const Params& p, int l, int bi, float* sm) {
  const int wave = otid() >> 6, lane = otid() & 63, r = lane & 15, g = lane >> 4;
  const int type = bi / (8 * NQG_LAT), rem = bi % (8 * NQG_LAT);
  const int b = rem / (4 * NQG_LAT), h = (rem / NQG_LAT) & 3, qg = rem % NQG_LAT;
  const int q0 = qg * QW;
  const int tokb = NPTOK + b * 1024, tok0 = tokb + q0;
  const u16* zb = p.z + (size_t)tokb * INW;
  const int bl = b * 4 + l;
  AState<AQT> st;
  int ocol;
  if (type != 0) {
    const float* rp = p.na_rpb + (size_t)(l * 4 + h) * 15 * 31;
    for (int e = otid(); e < 465; e += 256) sm[9000 + e] = rp[e] * LOG2E;
    __syncthreads();
  }
  if (type == 0) {
    const int kvh = h >> 1;
    bf16x8 qf[AQT][2];
    load_q<2, AQT>(p.z + (size_t)tok0 * INW + 1792 + h * 64, qf);
    Seg s0; s0.K = p.ck_swa + (size_t)((bl * 2 + kvh) * 16) * 2048; s0.Vt = p.cvt_swa + (size_t)((bl * 2 + kvh) * 16) * 2048; s0.ldk = 0; s0.ldv = 0; s0.nblk = 16; s0.pos0 = 0; s0.stride = 32;
    const int lo = max(0, q0 - 128) & ~31;
    const int hi = min(1024, ((q0 + QW + 128) + 31) & ~31);
    int lo2 = lo, cnt = (hi - lo) >> 5;
    if (cnt & 1) { if (lo2 > 0) lo2 -= 32; ++cnt; }
    Seg s1; s1.K = KLOC(8 + kvh, tokb); s1.Vt = VLOC(8 + kvh, tokb); s1.ldk = 0; s1.ldv = 0; s1.nblk = cnt; s1.pos0 = lo2; s1.stride = 32;
    const int P = (16 + cnt) >> 1;
    const int pb = (wave * P) >> 2, pe = ((wave + 1) * P) >> 2;
    astate_init<AQT>(st, wave == 0 ? p.swa_sink[l * 4 + h] * LOG2E : -1e30f, (wave == 0 && g == 0) ? 1.f : 0.f);
    attn_run<64, AQT, 2>(s0, s1, qf, 0.125f * LOG2E, st, q0, nullptr, 2 * pb, 2 * pe);
    ocol = 768 + h * 64;
  } else {
    bf16x8 qf[AQT][2];
    load_q<2, AQT>(p.z + (size_t)tok0 * INW + h * 64, qf);
    Seg s0; s0.K = p.ck_na + (size_t)((bl * 4 + h) * 16) * 2048; s0.Vt = p.cvt_na + (size_t)((bl * 4 + h) * 16) * 2048; s0.ldk = 0; s0.ldv = 0; s0.nblk = 16; s0.pos0 = 0; s0.stride = 32;
    const int qrow = q0 >> 6;
    const int rstart = min(max(qrow - 4, 0), 8);
    Seg s1; s1.K = KLOC(h, tokb); s1.Vt = VLOC(h, tokb); s1.ldk = 0; s1.ldv = 0; s1.nblk = 16; s1.pos0 = rstart * 64; s1.stride = 32;
    astate_init<AQT>(st, -1e30f, 0.f);
    attn_run<64, AQT, 1, 2>(s0, s1, qf, 0.125f * LOG2E, st, q0, sm + 9000, 8 * wave, 8 * wave + 8);
    ocol = h * 64;
  }
  float lt[AQT];
#pragma unroll
  for (int q = 0; q < AQT; ++q) {
    lt[q] = st.ls[q];
    lt[q] += __shfl_xor(lt[q], 16);
    lt[q] += __shfl_xor(lt[q], 32);
  }
  constexpr int WS = 64 * 16 * AQT;
  float* pm = sm + 4 * WS;
  if (wave != 0) {
    float* po = sm + wave * WS + lane * (16 * AQT);
#pragma unroll
    for (int q = 0; q < AQT; ++q) {
#pragma unroll
      for (int dv = 0; dv < 4; ++dv) *(f32x4*)(po + q * 16 + dv * 4) = st.o[q][dv];
      if (g == 0) { pm[wave * QW + q * 16 + r] = st.m[q]; pm[4 * QW + wave * QW + q * 16 + r] = lt[q]; }
    }
  }
  __syncthreads();
  if (wave == 0) {
#pragma unroll
    for (int q = 0; q < AQT; ++q) {
      const float m1 = pm[1 * QW + q * 16 + r], m2 = pm[2 * QW + q * 16 + r], m3 = pm[3 * QW + q * 16 + r];
      const float l1 = pm[4 * QW + 1 * QW + q * 16 + r], l2 = pm[4 * QW + 2 * QW + q * 16 + r], l3 = pm[4 * QW + 3 * QW + q * 16 + r];
      const float M = fmaxf(fmaxf(st.m[q], m1), fmaxf(m2, m3));
      const float a0 = __builtin_amdgcn_exp2f(st.m[q] - M), a1 = __builtin_amdgcn_exp2f(m1 - M), a2 = __builtin_amdgcn_exp2f(m2 - M), a3 = __builtin_amdgcn_exp2f(m3 - M);
      const float inv = 1.f / (lt[q] * a0 + l1 * a1 + l2 * a2 + l3 * a3);
#pragma unroll
      for (int dv = 0; dv < 4; ++dv) {
        const f32x4 o1 = *(const f32x4*)(sm + 1 * WS + lane * (16 * AQT) + q * 16 + dv * 4);
        const f32x4 o2 = *(const f32x4*)(sm + 2 * WS + lane * (16 * AQT) + q * 16 + dv * 4);
        const f32x4 o3 = *(const f32x4*)(sm + 3 * WS + lane * (16 * AQT) + q * 16 + dv * 4);
        st.o[q][dv] = (st.o[q][dv] * a0 + o1 * a1 + o2 * a2 + o3 * a3) * inv;
      }
    }
    write_o<AQT>(p, st, tok0, ocol);
  }
  __syncthreads();
}

__device__ __forceinline__ int q_next(unsigned* cnt, volatile LAS unsigned* slot) {
  __syncthreads();
  if (threadIdx.x == 0) *slot = xb_add(cnt, 1u);
  __syncthreads();
  return (int)*slot;
}

#if REP_SYNC
#define GSYNC() do { xcd_barrier(xb); xcd_barrier(xb); } while (0)
#else
#define GSYNC() xcd_barrier(xb)
#endif
__global__ void __launch_bounds__(256, 2) mega(Params p) {
  extern __shared__ __attribute__((aligned(16))) unsigned char smem[];
  cg::grid_group grid = cg::this_grid();
  const int nblk = gridDim.x, bid = blockIdx.x;
  u16* sm16 = (u16*)smem;
  __shared__ uint4 xb_words;
  if (threadIdx.x == 0) xb_words = make_uint4(0u, 0u, 0u, 0u);
  __syncthreads();
  XcdBarrier xb = xcd_barrier_post(p.bar, (volatile LAS unsigned*)&xb_words);

  for (int rep = 0; rep <= REP_P0; ++rep)
    for (int it = bid; it < P0_ITEMS; it += nblk) p0_item(p, it, smem);
  if (p.use_cg_sync) grid.sync();
  GSYNC();

#pragma unroll 1
  for (int l = 0; l < 4; ++l) {
    for (int it = bid; it < 384; it += nblk) norm_item(p, l, 0, it);
    GSYNC();
    { int tx, ty; for (int j = 0; tile_map(j, 18, tx, ty); ++j) gin_tile(p, l, tx, ty, sm16); }
    if (nblk == 512) {
      const int rank = bid >> 3, r31 = rank & 31;
      if (r31 >= 22) {
        const int idle = (bid & 7) * 20 + (rank >> 5) * 10 + (r31 - 22);
        for (int it = 288 + idle; it < 928; it += 160) wt_item(p, l, it, (float*)smem);
      }
    }
    GSYNC();
    {
      constexpr int CD = 64 * NQG_CTX, CC = 2 * 64 * NQG_CTX / 4;
      constexpr int LD = 8 * NQG_LAT, LC = 2 * 8 * NQG_LAT;
      constexpr int E0 = 192, E1 = E0 + LD, E2 = E1 + LC, E3 = E2 + 32, E4 = E3 + CC, E5 = E4 + CD, E6 = E5 + 64;
      unsigned* qc = p.bar + XCD_BAR_WORDS + l * 64;
      const int w0 = (nblk == 512) ? 928 : 288;
      const int EA = E6 + (1440 - w0), EB = EA + (l < 3 ? 288 : 0), EW = EB;
      for (int it = bid; it < EW; it = nblk + q_next(qc, &xb.st[2])) {
        if (it >= E6) {
          if (it < EA) wt_item(p, l, it - E6 + w0, (float*)smem);
          else if (it < EB) wt_item(p, l + 1, it - EA, (float*)smem);
          else adaln_item(p, (l + 1) * 96 + (it - EB), (float*)smem);
          continue;
        }
        if (it < E0) f1_tile(p, l, it, sm16);
        else if (it < E1) attn_diff_item(p, l, true, it - E0, (float*)smem);
        else if (it < E2) attn_lat_item(p, l, it - E1, (float*)smem);
        else if (it < E3) f2_tile(p, l, it - E2, sm16);
        else if (it < E4) attn_ctx_item(p, l, it - E3);
        else if (it < E5) attn_diff_item(p, l, false, it - E4, (float*)smem);
        else f2_tile(p, l, it - E5 + 32, sm16);
      }
    }
    GSYNC();
    { int tx, ty; for (int j = 0; tile_map(j, 8, tx, ty, 64); ++j) res_tile(p, l, tx, ty, p.cat, p.w_outT + (size_t)l * 1024 * 1024, 1024, 2, sm16, l == 0); }
    GSYNC();
    for (int it = bid; it < 384; it += nblk) norm_item(p, l, 1, it);
    GSYNC();
    { int tx, ty; for (int j = 0; tile_map(j, 32, tx, ty); ++j) m1_tile(p, l, tx, ty, sm16); }
    GSYNC();
    { int tx, ty; for (int j = 0; tile_map(j, 8, tx, ty, 64); ++j) res_tile(p, l, tx, ty, p.u, p.w2T + (size_t)l * 1024 * 4096, 4096, 5, sm16); }
    GSYNC();
  }
  for (int it = bid; it < 384; it += nblk) norm_item(p, 0, 2, it);
}

extern "C" void kernel_launch(void* const* d_in, const int* in_sizes, int n_in, void* d_out, int out_size, void* d_ws,
                              size_t ws_size, hipStream_t stream) {
  static int grid_blocks = 0;
  if (grid_blocks == 0) {
    int dev = 0, cus = 0, per_cu = 0;
    (void)hipGetDevice(&dev);
    (void)hipDeviceGetAttribute(&cus, hipDeviceAttributeMultiprocessorCount, dev);
    if (hipFuncSetAttribute((const void*)mega, hipFuncAttributeMaxDynamicSharedMemorySize, LDS_BYTES) != hipSuccess) {
      fprintf(stderr, "hipFuncSetAttribute failed\n");
    }
    if (hipOccupancyMaxActiveBlocksPerMultiprocessor(&per_cu, (const void*)mega, 256, LDS_BYTES) != hipSuccess || per_cu < 1) {
      fprintf(stderr, "occupancy query failed (%d)\n", per_cu);
      per_cu = 1;
    }
    if (per_cu > 2) per_cu = 2;
    grid_blocks = cus * per_cu;
    fprintf(stderr, "mega: cus=%d per_cu=%d grid=%d ws=%zu\n", cus, per_cu, grid_blocks, ws_size);
  }
  Params p{};
  const float** pin = (const float**)&p;
  for (int i = 0; i < 27; ++i) pin[i] = (const float*)d_in[i];
  p.out = (float*)d_out;
  unsigned char* ws = (unsigned char*)d_ws;
  size_t off = 0;
  auto take = [&](size_t bytes) { unsigned char* q = ws + off; off += (bytes + 255) & ~(size_t)255; return q; };
  p.xres = (float*)take((size_t)NTOK * 1024 * 4);
  p.mods = (float*)take((size_t)4 * 3 * 6144 * 4);
  p.h = (u16*)take((size_t)NTOK * 1024 * 2);
  p.z = (u16*)take((size_t)NTOK * INW * 2);
  p.vt = (u16*)take((size_t)640 * NTOK * 2);
  p.cat = (u16*)take((size_t)NTOK * 1024 * 2);
  p.u = (u16*)take((size_t)NTOK * 4096 * 2);
  p.uv = (u16*)take((size_t)(16 * 256 * 512 + 2 * 256 * 2048) * 2);
  p.w_inT = (u16*)take((size_t)4 * 2304 * 1024 * 2);
  p.w_outT = (u16*)take((size_t)4 * 1024 * 1024 * 2);
  p.w1T = (u16*)take((size_t)4 * 4096 * 1024 * 2);
  p.w2T = (u16*)take((size_t)4 * 4096 * 1024 * 2);
  p.pqt = (u16*)take((size_t)4 * 512 * 256 * 2);
  p.dft256 = (u16*)take((size_t)256 * 512 * 2);
  p.dft1024 = (u16*)take((size_t)1024 * 2048 * 2);
  p.ck_na = (u16*)take((size_t)2 * 4 * 512 * 256 * 2);
  p.cvt_na = (u16*)take((size_t)2 * 4 * 512 * 256 * 2);
  p.ck_diff = (u16*)take((size_t)2 * 4 * 512 * 256 * 2);
  p.cvt_diff = (u16*)take((size_t)2 * 4 * 512 * 256 * 2);
  p.ck_swa = (u16*)take((size_t)2 * 4 * 512 * 128 * 2);
  p.cvt_swa = (u16*)take((size_t)2 * 4 * 512 * 128 * 2);
  p.kfr = (u16*)take((size_t)10 * 192 * 2048 * 2);
  p.vfr = (u16*)take((size_t)10 * 192 * 2048 * 2);
  p.ropeD = (float*)take(1024 * 4);
  p.ropeS = (float*)take(2048 * 4);
  p.bar = (unsigned*)take((XCD_BAR_WORDS + 12 * 64) * 4);
  if (off > ws_size) { fprintf(stderr, "workspace too small: need %zu have %zu\n", off, ws_size); return; }
  if (hipMemsetAsync(p.bar, 0, (XCD_BAR_WORDS + 12 * 64) * 4, stream) != hipSuccess) fprintf(stderr, "memset failed\n");
  void* args[] = {&p};
  hipError_t e = hipLaunchCooperativeKernel((const void*)mega, dim3(grid_blocks), dim3(256), args, LDS_BYTES, stream);
  if (e != hipSuccess) fprintf(stderr, "cooperative launch failed: %s (grid %d)\n", hipGetErrorString(e), grid_blocks);
}
```

```cpp
#include <hip/hip_runtime.h>
#include <hip/hip_cooperative_groups.h>
#include <stdint.h>
#include <stdio.h>
namespace cg = cooperative_groups;

typedef unsigned short u16;
typedef __attribute__((ext_vector_type(8))) short bf16x8;
typedef __attribute__((ext_vector_type(4))) float f32x4;
typedef __attribute__((ext_vector_type(4))) unsigned u32x4;
__device__ __forceinline__ void gload16(u32x4& dst, const void* ptr) {
  asm volatile("global_load_dwordx4 %0, %1, off" : "=v"(dst) : "v"(ptr) : "memory");
}

#define NTOK 6144
#define NPTOK 4096
#define INW 2304
#define LOG2E 1.4426950408889634f
#define LDS_BYTES 73728
#define LSTR 72

#define O_NAK 6291456
#define O_NAV 10485760
#define O_DK 14680064
#define O_DV 18874368
#define O_SK 23068672
#define O_SV 25165824

struct Params {
  const float *x_prompt, *x_sample, *c_na_k, *c_na_v, *c_diff_k, *c_diff_v, *c_swa_k, *c_swa_v, *c, *c_ctx;
  const float *w_ada, *b_ada, *norm1_g, *norm2_g, *w_in, *na_rpb, *lq1, *lk1, *lq2, *lk2, *subln_g, *w_fourier, *swa_sink;
  const float *w_out, *w1, *w2, *final_g;
  float* out;
  float* xres;
  float* mods;
  u16 *h, *z, *vt, *cat, *u, *uv, *w_inT, *w_outT, *w1T, *w2T, *pqt, *dft256, *dft1024;
  u16 *ck_na, *cvt_na, *ck_diff, *cvt_diff, *ck_swa, *cvt_swa;
  float *ropeD, *ropeS;
  u16 *kfr, *vfr;
  unsigned* bar;
  int use_cg_sync;
  int pad_;
};

__device__ __forceinline__ u16 f2bf(float f) {
  unsigned u = __float_as_uint(f);
  u += 0x7fffu + ((u >> 16) & 1u);
  return (u16)(u >> 16);
}
__device__ __forceinline__ int otid() { int t = threadIdx.x; asm volatile("" : "+v"(t)); return t; }
__device__ __forceinline__ float bf2f(u16 h) { return __uint_as_float(((unsigned)h) << 16); }
typedef __attribute__((ext_vector_type(2))) __bf16 hbf16x2;
typedef __attribute__((ext_vector_type(2))) float f32x2;
__device__ __forceinline__ unsigned pack2(float a, float b) {
  f32x2 v = {a, b};
  union { hbf16x2 h; unsigned u; } x;
  x.h = __builtin_convertvector(v, hbf16x2);
  return x.u;
}

__device__ __forceinline__ int kfrag_off(int kk, int d) {
  const int t = (kk >> 2) & 1, r = ((kk >> 3) << 2) | (kk & 3), dc = d >> 5, g = (d >> 3) & 3;
  return ((t * 2 + dc) * 64 + g * 16 + r) * 8 + (d & 7);
}
__device__ __forceinline__ int vfrag_off(int kk, int dv) {
  return (((dv >> 4) * 64) + (kk >> 3) * 16 + (dv & 15)) * 8 + (kk & 7);
}

#define XB_TMO      128
#define XB_XCNT(j)  (256  + 64 * (j))
#define XB_XSUB(j)  (1280 + 64 * (j))
#define XB_XGEN(j)  (2304 + 64 * (j))
#define XB_TOP      3328
#define XB_TOPGEN   3392
#define XCD_BAR_WORDS 3456
#define XB_SPIN_CAP (1u << 22)
#define LAS __attribute__((address_space(3)))
__device__ __forceinline__ unsigned xb_ld(unsigned* p)              { return __hip_atomic_load(p, __ATOMIC_RELAXED, __HIP_MEMORY_SCOPE_AGENT); }
__device__ __forceinline__ unsigned xb_add(unsigned* p, unsigned v) { return __hip_atomic_fetch_add(p, v, __ATOMIC_RELAXED, __HIP_MEMORY_SCOPE_AGENT); }
__device__ __forceinline__ unsigned xb_xcc_id() { return (unsigned)__builtin_amdgcn_s_getreg((3 << 11) | 20) & 0xFu; }
#define XB_SPIN(cond, bar) do { unsigned _sp = 0; while (cond) { __builtin_amdgcn_s_sleep(1); \
    if ((++_sp & 255u) == 0u) { if (xb_ld(&(bar)[XB_TMO])) break; if (_sp > XB_SPIN_CAP) { atomicAdd(&(bar)[XB_TMO], 1u); break; } } } } while (0)
#define XB_LSUB(j)  (XCD_BAR_WORDS + 12 * 64 + 64 * (j))
#define XB_LGEN(j)  (XCD_BAR_WORDS + 12 * 64 + 64 * (16 + (j)))
#define XB_ALL_WORDS (XCD_BAR_WORDS + 12 * 64 + 32 * 64)
struct XcdBarrier { unsigned* bar; unsigned x; volatile LAS unsigned* st; };
__device__ __forceinline__ XcdBarrier xcd_barrier_post(unsigned* bar, volatile LAS unsigned* st) {
  XcdBarrier b; b.bar = bar; b.x = xb_xcc_id(); b.st = st;
  if (threadIdx.x == 0) st[4] = xb_add(&bar[XB_XCNT(b.x)], 1u);
  return b;
}
__device__ __forceinline__ void xcd_barrier_complete(unsigned* bar, unsigned x, unsigned& nloc, unsigned& nx) {
  const unsigned G = gridDim.x * gridDim.y * gridDim.z;
  unsigned sum, cnt, mine, sp = 0u;
  for (;;) {
    sum = 0u; cnt = 0u; mine = 0u;
#pragma unroll
    for (unsigned j = 0; j < 16; ++j) { const unsigned c = xb_ld(&bar[XB_XCNT(j)]); sum += c; cnt += (c > 0u) ? 1u : 0u; mine = (j == x) ? c : mine; }
    if (sum == G) break;
    __builtin_amdgcn_s_sleep(1);
    if ((++sp & 255u) == 0u) { if (xb_ld(&bar[XB_TMO])) break; if (sp > XB_SPIN_CAP) { atomicAdd(&bar[XB_TMO], 1u); break; } }
  }
  nloc = mine > 0u ? mine : 1u; nx = cnt > 0u ? cnt : 1u;
}
__device__ __forceinline__ unsigned xcd_topology(unsigned* bar) {
  const unsigned G = gridDim.x * gridDim.y * gridDim.z;
  unsigned sum8 = 0u, all = 1u, all64 = 1u;
#pragma unroll
  for (unsigned j = 0; j < 8; ++j) { const unsigned c = xb_ld(&bar[XB_XCNT(j)]); sum8 += c; all &= (c > 0u) ? 1u : 0u; all64 &= (c == 64u) ? 1u : 0u; }
  const unsigned ok = (all && sum8 == G) ? 1u : 0u;
  return ok | ((ok && all64) ? 2u : 0u);
}
__device__ __forceinline__ void xcd_barrier(const XcdBarrier& b) {
  asm volatile("s_waitcnt vmcnt(0)" ::: "memory");
  __syncthreads();
  if (threadIdx.x == 0) {
    unsigned* bar = b.bar;
    __builtin_amdgcn_s_waitcnt(0);
    unsigned nloc = b.st[0], nx = b.st[1];
    if (nloc == 0u) { xcd_barrier_complete(bar, b.x, nloc, nx); b.st[0] = nloc; b.st[1] = nx; b.st[5] = xcd_topology(bar); }
    const unsigned old = xb_add(&bar[XB_XSUB(b.x)], 1u);
    const unsigned gen = old / nloc;
    if (old + 1u == (gen + 1u) * nloc) {
      __builtin_amdgcn_fence(__ATOMIC_RELEASE, "agent");
      asm volatile("s_waitcnt vmcnt(0)" ::: "memory");
      const unsigned og = xb_add(&bar[XB_TOP], 1u);
      const unsigned tg = og / nx;
      if (og + 1u == (tg + 1u) * nx) xb_add(&bar[XB_TOPGEN], 1u);
      else XB_SPIN(xb_ld(&bar[XB_TOPGEN]) == tg, bar);
      __builtin_amdgcn_fence(__ATOMIC_ACQUIRE, "agent");
      xb_add(&bar[XB_XGEN(b.x)], 1u);
      asm volatile("s_waitcnt vmcnt(0)" ::: "memory");
    } else {
      XB_SPIN(xb_ld(&bar[XB_XGEN(b.x)]) == gen, bar);
      __builtin_amdgcn_fence(__ATOMIC_ACQUIRE, "agent");
      asm volatile("s_waitcnt vmcnt(0)" ::: "memory");
    }
  }
  __syncthreads();
}

__device__ __forceinline__ void xcd_barrier_local(const XcdBarrier& b) {
  asm volatile("s_waitcnt vmcnt(0)" ::: "memory");
  __syncthreads();
  if (threadIdx.x == 0) {
    unsigned* bar = b.bar;
    __builtin_amdgcn_s_waitcnt(0);
    const unsigned nloc = b.st[0];
    const unsigned old = xb_add(&bar[XB_LSUB(b.x)], 1u);
    const unsigned gen = old / nloc;
    if (old + 1u == (gen + 1u) * nloc) xb_add(&bar[XB_LGEN(b.x)], 1u);
    else XB_SPIN(xb_ld(&bar[XB_LGEN(b.x)]) == gen, bar);
    __builtin_amdgcn_fence(__ATOMIC_ACQUIRE, "agent");
    asm volatile("s_waitcnt vmcnt(0)" ::: "memory");
  }
  __syncthreads();
}

__device__ __forceinline__ void transpose_tile(const float* __restrict__ src, int lds_, u16* __restrict__ dst, int ldd,
                                               int k0, int n0, float* sm, bool fragv = false) {
  const int tid = otid();
  const int c4 = (tid & 15) * 4, r0 = tid >> 4;
  float4 v[8];
#pragma unroll
  for (int i = 0; i < 8; ++i) v[i] = *(const float4*)(src + (size_t)(k0 + r0 + 16 * i) * lds_ + n0 + c4);
#pragma unroll
  for (int i = 0; i < 8; ++i) {
    const int k = r0 + 16 * i;
    sm[(c4 + 0) * 129 + k] = v[i].x; sm[(c4 + 1) * 129 + k] = v[i].y; sm[(c4 + 2) * 129 + k] = v[i].z; sm[(c4 + 3) * 129 + k] = v[i].w;
  }
  __syncthreads();
  const int k8 = (tid & 15) * 8, nn = tid >> 4;
#pragma unroll
  for (int i = 0; i < 4; ++i) {
    const int n = nn + 16 * i;
    const float* row = sm + n * 129 + k8;
    uint4 w;
    w.x = pack2(row[0], row[1]); w.y = pack2(row[2], row[3]); w.z = pack2(row[4], row[5]); w.w = pack2(row[6], row[7]);
    if (fragv) {
      const int col = n0 + n, pos = k0 + k8;
      *(uint4*)(dst + ((size_t)((col >> 6) * 16 + (pos >> 5))) * 2048 + vfrag_off(pos & 31, col & 63)) = w;
    } else {
      *(uint4*)(dst + (size_t)(n0 + n) * ldd + k0 + k8) = w;
    }
  }
  __syncthreads();
}

__device__ __forceinline__ void adaln_item(const Params& p, int it, float* sm) {
  const int l = it / 192, c0 = (it % 192) * 32;
  float* ssil = sm;
  float* red = sm + 3072;
  const int tid = otid();
  for (int i = tid; i < 3072; i += 256) {
    const int cnd = i >> 10, k = i & 1023;
    const float v = cnd == 0 ? p.c_ctx[k] : p.c[(cnd - 1) * 1024 + k];
    ssil[i] = v / (1.f + expf(-v));
  }
  __syncthreads();
  const int cg4 = (tid & 7) * 4, ks = tid >> 3;
  const float* w = p.w_ada + (size_t)l * 1024 * 6144 + c0 + cg4;
  float a0[4] = {0.f, 0.f, 0.f, 0.f}, a1[4] = {0.f, 0.f, 0.f, 0.f}, a2[4] = {0.f, 0.f, 0.f, 0.f};
#pragma unroll 16
  for (int kk = 0; kk < 32; ++kk) {
    const int k = kk * 32 + ks;
    const float4 v = *(const float4*)(w + (size_t)k * 6144);
    const float s0 = ssil[k], s1 = ssil[1024 + k], s2 = ssil[2048 + k];
    a0[0] += s0 * v.x; a0[1] += s0 * v.y; a0[2] += s0 * v.z; a0[3] += s0 * v.w;
    a1[0] += s1 * v.x; a1[1] += s1 * v.y; a1[2] += s1 * v.z; a1[3] += s1 * v.w;
    a2[0] += s2 * v.x; a2[1] += s2 * v.y; a2[2] += s2 * v.z; a2[3] += s2 * v.w;
  }
#pragma unroll
  for (int j = 0; j < 4; ++j) {
    red[(ks * 3 + 0) * 32 + cg4 + j] = a0[j];
    red[(ks * 3 + 1) * 32 + cg4 + j] = a1[j];
    red[(ks * 3 + 2) * 32 + cg4 + j] = a2[j];
  }
  __syncthreads();
  if (tid < 96) {
    const int cnd = tid >> 5, j = tid & 31;
    float s = p.b_ada[l * 6144 + c0 + j];
    for (int q = 0; q < 32; ++q) s += red[(q * 3 + cnd) * 32 + j];
    p.mods[(l * 3 + cnd) * 6144 + c0 + j] = s;
  }
  __syncthreads();
}

__device__ __forceinline__ void cvt_item(const float* __restrict__ src, u16* __restrict__ dst, int it, int W) {
  const int w8 = W >> 3;
#pragma unroll
  for (int i = 0; i < 4; ++i) {
    const int u = it * 1024 + i * 256 + otid();
    const int d8 = u % w8, pos = (u / w8) & 511, bl = u / (w8 * 512);
    const float* sp = src + ((size_t)(bl * 512 + pos) * W + d8 * 8);
    const float4 v0 = *(const float4*)sp, v1 = *(const float4*)(sp + 4);
    uint4 w; w.x = pack2(v0.x, v0.y); w.y = pack2(v0.z, v0.w); w.z = pack2(v1.x, v1.y); w.w = pack2(v1.z, v1.w);
    const int h = d8 >> 3, d = (d8 & 7) * 8;
    *(uint4*)(dst + ((size_t)((bl * (W >> 6) + h) * 16 + (pos >> 5))) * 2048 + kfrag_off(pos & 31, d)) = w;
  }
}

__device__ __forceinline__ void pq_item(const Params& p, int it, float* sm) {
  const int cq = it & 3, it2 = it >> 2;
  const int l = it2 >> 3, which = (it2 >> 2) & 1, g = it2 & 3;
  const int n = otid();
  if (n < 64) sm[n] = which ? sinpif(2.f * (float)n / 64.f) : cospif(2.f * (float)n / 64.f);
  __syncthreads();
  float w[64];
#pragma unroll
  for (int m = 0; m < 64; ++m) w[m] = p.w_fourier[(size_t)l * 65536 + (g * 64 + m) * 256 + n];
  u16* dst = p.pqt + (size_t)l * 512 * 256 + (size_t)(which * 256 + n) * 256 + g * 64;
  for (int c = cq * 16; c < cq * 16 + 16; ++c) {
    float s = 0.f;
#pragma unroll
    for (int m = 0; m < 64; ++m) s += sm[(c * m) & 63] * w[m];
    dst[c] = f2bf(s);
  }
  __syncthreads();
}

__device__ __forceinline__ void dft_item(u16* dst, int L, int it) {
  const int twoL = 2 * L;
  for (int e = otid(); e < 8192; e += 256) {
    const int idx = it * 8192 + e;
    const int k = idx / twoL, j = idx % twoL;
    const int jj = j & (L - 1);
    const int ph = (k * jj) & (L - 1);
    const float a = 2.f * (float)ph / (float)L;
    const float v = (j >= L) ? -sinpif(a) : cospif(a);
    dst[idx] = f2bf(v);
  }
}

#define P0_WT 288
#define P0_ADA 768
#define P0_XC 0
#define P0_CK 320
#define P0_CVT 320
#define P0_PQ 128
#define P0_DFT 272
#define P0_ITEMS (P0_ADA + P0_WT + P0_XC + P0_CK + P0_CVT + P0_PQ + P0_DFT + 1)

__device__ void wt_item(const Params& p, int l, int r, float* sm) {
  if (r < 288) { transpose_tile(p.w_in + (size_t)l * 1024 * 2304, 2304, p.w_inT + (size_t)l * 2304 * 1024, 1024, (r / 36) * 128, (r % 36) * 64, sm); return; }
  r -= 288;
  if (r < 128) { transpose_tile(p.w_out + (size_t)l * 1024 * 1024, 1024, p.w_outT + (size_t)l * 1024 * 1024, 1024, (r / 16) * 128, (r % 16) * 64, sm); return; }
  r -= 128;
  if (r < 512) { transpose_tile(p.w1 + (size_t)l * 1024 * 4096, 4096, p.w1T + (size_t)l * 4096 * 1024, 1024, (r / 64) * 128, (r % 64) * 64, sm); return; }
  r -= 512;
  transpose_tile(p.w2 + (size_t)l * 4096 * 1024, 1024, p.w2T + (size_t)l * 1024 * 4096, 4096, (r / 16) * 128, (r % 16) * 64, sm);
}

__device__ void p0_item(const Params& p, int it, unsigned char* smem) {
  float* sm = (float*)smem;
  if (it < P0_ADA) { adaln_item(p, it, sm); return; }
  it -= P0_ADA;
  if (it < P0_WT) { wt_item(p, 0, it, sm); return; }
  it -= P0_WT;
  if (it < P0_XC) {
    const int row0 = it * 16;
    const float* src = row0 < NPTOK ? p.x_prompt + (size_t)row0 * 1024 : p.x_sample + (size_t)(row0 - NPTOK) * 1024;
    float* dst = p.xres + (size_t)row0 * 1024;
#pragma unroll
    for (int i = 0; i < 16; ++i) {
      const int o = (i * 256 + otid()) * 4;
      *(float4*)(dst + o) = *(const float4*)(src + o);
    }
    return;
  }
  it -= P0_XC;
  if (it < P0_CK) {
    if (it < 128) { cvt_item(p.c_na_k, p.ck_na, it, 256); return; }
    it -= 128;
    if (it < 128) { cvt_item(p.c_diff_k, p.ck_diff, it, 256); return; }
    it -= 128;
    cvt_item(p.c_swa_k, p.ck_swa, it, 128);
    return;
  }
  it -= P0_CK;
  if (it < P0_CVT) {
    if (it < 128) { const int bl = it >> 4, r = it & 15; transpose_tile(p.c_na_v + (size_t)bl * 512 * 256, 256, p.cvt_na + (size_t)bl * 256 * 512, 512, (r >> 2) * 128, (r & 3) * 64, sm, true); return; }
    it -= 128;
    if (it < 128) { const int bl = it >> 4, r = it & 15; transpose_tile(p.c_diff_v + (size_t)bl * 512 * 256, 256, p.cvt_diff + (size_t)bl * 256 * 512, 512, (r >> 2) * 128, (r & 3) * 64, sm, true); return; }
    it -= 128;
    { const int bl = it >> 3, r = it & 7; transpose_tile(p.c_swa_v + (size_t)bl * 512 * 128, 128, p.cvt_swa + (size_t)bl * 128 * 512, 512, (r >> 1) * 128, (r & 1) * 64, sm, true); return; }
  }
  it -= P0_CVT;
  if (it < P0_PQ) { pq_item(p, it, sm); return; }
  it -= P0_PQ;
  if (it < 16) { dft_item(p.dft256, 256, it); return; }
  it -= 16;
  if (it < 256) { dft_item(p.dft1024, 1024, it); return; }
  for (int e = otid(); e < 512 + 1024; e += 256) {
    const bool isD = e < 512;
    const int ee = isD ? e : e - 512;
    const int nf = isD ? 8 : 16;
    const int pos = ee / nf, fi = ee % nf;
    const float inv = exp2f(-(float)fi * (13.287712379549449f / (float)nf));
    float tt = (float)pos * inv * 0.15915494309189535f;
    tt -= rintf(tt);
    float sn, cs;
    sincospif(2.f * tt, &sn, &cs);
    if (isD) { p.ropeD[ee] = cs; p.ropeD[512 + ee] = sn; }
    else { p.ropeS[ee] = cs; p.ropeS[1024 + ee] = sn; }
  }
}

__device__ __forceinline__ void norm_item(const Params& p, int l, int which, int it) {
  const int lane = otid() & 63, wave = otid() >> 6;
  const int row0 = it * 16 + wave * 4;
  const float* xsrc = (which == 0 && l == 0) ? (row0 < NPTOK ? p.x_prompt + (size_t)row0 * 1024 : p.x_sample + (size_t)(row0 - NPTOK) * 1024)
                                             : p.xres + (size_t)row0 * 1024;
  float4 v[4][4];
#pragma unroll
  for (int j = 0; j < 4; ++j)
#pragma unroll
    for (int k = 0; k < 4; ++k) v[j][k] = *(const float4*)(xsrc + (size_t)j * 1024 + (k * 64 + lane) * 4);
  float rs[4];
#pragma unroll
  for (int j = 0; j < 4; ++j) {
    float ss = 0.f;
#pragma unroll
    for (int k = 0; k < 4; ++k) ss += v[j][k].x * v[j][k].x + v[j][k].y * v[j][k].y + v[j][k].z * v[j][k].z + v[j][k].w * v[j][k].w;
#pragma unroll
    for (int o = 32; o >= 1; o >>= 1) ss += __shfl_xor(ss, o);
    rs[j] = rsqrtf(ss * (1.f / 1024.f) + 1e-6f);
  }
  if (which < 2) {
    const int cond = row0 < NPTOK ? 0 : 1 + ((row0 - NPTOK) >> 10);
    const float* gp = (which == 0 ? p.norm1_g : p.norm2_g) + l * 1024;
    const float* shp = p.mods + (size_t)(l * 3 + cond) * 6144 + (which * 3 + 0) * 1024;
    const float* scp = shp + 1024;
#pragma unroll
    for (int k = 0; k < 4; ++k) {
      const int col = (k * 64 + lane) * 4;
      const float4 gg = *(const float4*)(gp + col);
      const float4 sh = *(const float4*)(shp + col);
      const float4 sc = *(const float4*)(scp + col);
      const float mx = gg.x * (1.f + sc.x), my = gg.y * (1.f + sc.y), mz = gg.z * (1.f + sc.z), mw = gg.w * (1.f + sc.w);
#pragma unroll
      for (int j = 0; j < 4; ++j) {
        uint2 w;
        w.x = pack2(v[j][k].x * rs[j] * mx + sh.x, v[j][k].y * rs[j] * my + sh.y);
        w.y = pack2(v[j][k].z * rs[j] * mz + sh.z, v[j][k].w * rs[j] * mw + sh.w);
        *(uint2*)(p.h + (size_t)(row0 + j) * 1024 + col) = w;
      }
    }
  } else {
#pragma unroll
    for (int k = 0; k < 4; ++k) {
      const int col = (k * 64 + lane) * 4;
      const float4 gg = *(const float4*)(p.final_g + col);
#pragma unroll
      for (int j = 0; j < 4; ++j) {
        float4 o;
        o.x = v[j][k].x * rs[j] * gg.x; o.y = v[j][k].y * rs[j] * gg.y; o.z = v[j][k].z * rs[j] * gg.z; o.w = v[j][k].w * rs[j] * gg.w;
        *(float4*)(p.out + (size_t)(row0 + j) * 1024 + col) = o;
      }
    }
  }
}

template <bool ZERO, int YT>
__device__ __forceinline__ void gemm_main_t(const u16* __restrict__ X, int ldx, const u16* __restrict__ Y, int ldy, int K,
                                          u16* smem, f32x4 (&acc)[4][YT]) {
  const int tid = otid(), lane = tid & 63, wave = tid >> 6, wx = wave & 1, wy = wave >> 1, r = lane & 15, g = lane >> 4;
  u16* sX = smem;
  u16* sY = smem + 2 * 128 * LSTR;
  const int lrow = tid >> 3, lkc = tid & 7;
  const u16* gx = X + (size_t)lrow * ldx + lkc * 8;
  const u16* gy = Y + (size_t)lrow * ldy + lkc * 8;
  u32x4 rx[4], ry[YT];
#pragma unroll
  for (int i = 0; i < 4; ++i) rx[i] = *(const u32x4*)(gx + (size_t)(32 * i) * ldx);
#pragma unroll
  for (int i = 0; i < YT; ++i) ry[i] = *(const u32x4*)(gy + (size_t)(32 * i) * ldy);
  if (ZERO) {
#pragma unroll
    for (int a = 0; a < 4; ++a)
#pragma unroll
      for (int b = 0; b < YT; ++b) acc[a][b] = (f32x4){0.f, 0.f, 0.f, 0.f};
  }
#pragma unroll
  for (int i = 0; i < 4; ++i) *(u32x4*)(sX + (lrow + 32 * i) * LSTR + lkc * 8) = rx[i];
#pragma unroll
  for (int i = 0; i < YT; ++i) *(u32x4*)(sY + (lrow + 32 * i) * LSTR + lkc * 8) = ry[i];
  __syncthreads();
  const int nk = K >> 6;
  const u16* cx0 = sX + (wx * 64 + r) * LSTR + g * 8;
  const u16* cy0 = sY + (wy * (16 * YT) + r) * LSTR + g * 8;
#define GEMM_COMPUTE(cur)                                                                            \
  {                                                                                                  \
    const u16* cx = cx0 + (cur) * 128 * LSTR;                                                        \
    const u16* cy = cy0 + (cur) * 128 * LSTR;                                                        \
    _Pragma("unroll") for (int kk = 0; kk < 2; ++kk) {                                               \
      bf16x8 a[4], b[YT];                                                                            \
      _Pragma("unroll") for (int i = 0; i < 4; ++i) a[i] = *(const bf16x8*)(cx + i * 16 * LSTR + kk * 32); \
      _Pragma("unroll") for (int i = 0; i < YT; ++i) b[i] = *(const bf16x8*)(cy + i * 16 * LSTR + kk * 32); \
      _Pragma("unroll") for (int xi = 0; xi < 4; ++xi)                                               \
        _Pragma("unroll") for (int yi = 0; yi < YT; ++yi)                                            \
          acc[xi][yi] = __builtin_amdgcn_mfma_f32_16x16x32_bf16(a[xi], b[yi], acc[xi][yi], 0, 0, 0); \
    }                                                                                                \
  }
  for (int kt = 0; kt < nk - 1; ++kt) {
    const int cur = kt & 1;
#pragma unroll
    for (int i = 0; i < 4; ++i) gload16(rx[i], gx + (size_t)(32 * i) * ldx + (kt + 1) * 64);
#pragma unroll
    for (int i = 0; i < YT; ++i) gload16(ry[i], gy + (size_t)(32 * i) * ldy + (kt + 1) * 64);
    GEMM_COMPUTE(cur);
    asm volatile("s_waitcnt vmcnt(0)" ::: "memory");
    u16* dX = sX + (cur ^ 1) * 128 * LSTR;
    u16* dY = sY + (cur ^ 1) * 128 * LSTR;
#pragma unroll
    for (int i = 0; i < 4; ++i) *(u32x4*)(dX + (lrow + 32 * i) * LSTR + lkc * 8) = rx[i];
#pragma unroll
    for (int i = 0; i < YT; ++i) *(u32x4*)(dY + (lrow + 32 * i) * LSTR + lkc * 8) = ry[i];
    __syncthreads();
  }
  GEMM_COMPUTE((nk - 1) & 1);
  __syncthreads();
#undef GEMM_COMPUTE
}

#ifndef REP_GEMM
#define REP_GEMM 0
#endif
#ifndef REP_MIX
#define REP_MIX 0
#endif
#ifndef REP_SYNC
#define REP_SYNC 0
#endif
#ifndef REP_P0
#define REP_P0 0
#endif
template <int YT>
__device__ __forceinline__ void gemm_main(const u16* __restrict__ X, int ldx, const u16* __restrict__ Y, int ldy, int K,
                                          u16* smem, f32x4 (&acc)[4][YT]) {
  gemm_main_t<true, YT>(X, ldx, Y, ldy, K, smem, acc);
#if REP_GEMM
  gemm_main_t<false, YT>(X, ldx, Y, ldy, K, smem, acc);
#pragma unroll
  for (int a = 0; a < 4; ++a)
#pragma unroll
    for (int b = 0; b < YT; ++b) acc[a][b] *= 0.5f;
#endif
}

__device__ __forceinline__ bool tile_map(int j, int ntx, int& tx, int& ty, int nty = 48) {
  const int nblk = gridDim.x, bid = blockIdx.x;
  if (nblk == 512) {
    const int per = nty >> 3, hp = per >> 1;
    const int rank = bid >> 3, q = (rank & 31) + j * 32, mem = rank >> 5;
    if (q >= hp * ntx) return false;
    tx = q / hp; ty = per * (bid & 7) + 2 * (q % hp) + mem;
    return true;
  } else {
    const int it = bid + j * nblk;
    if (it >= nty * ntx) return false;
    tx = it / nty; ty = it % nty;
    return true;
  }
}

__device__ void gin_tile(const Params& p, int l, int tx, int ty, u16* smem) {
  const int n0 = tx * 128, m0 = ty * 128;
  f32x4 acc[4][4];
  gemm_main<4>(p.w_inT + (size_t)l * 2304 * 1024 + (size_t)n0 * 1024, 1024, p.h + (size_t)m0 * 1024, 1024, 1024, smem, acc);
  const int lane = otid() & 63, wave = otid() >> 6, wx = wave & 1, wy = wave >> 1, r = lane & 15, g = lane >> 4;
  const int nw = n0 + wx * 64;
  const bool isS = m0 >= NPTOK;
  int ropeMode = 0;
  if (isS) {
    if (nw >= 768 && nw < 1280) ropeMode = 1;
    else if (nw >= 1792 && nw < 2176) ropeMode = 2;
  }
  float* okv = nullptr; int okv_w = 0, okv_c = 0;
  if (!isS) {
    if (nw >= 256 && nw < 512) { okv = p.out + O_NAK; okv_w = 256; okv_c = nw - 256; }
    else if (nw >= 512 && nw < 768) { okv = p.out + O_NAV; okv_w = 256; okv_c = nw - 512; }
    else if (nw >= 1024 && nw < 1280) { okv = p.out + O_DK; okv_w = 256; okv_c = nw - 1024; }
    else if (nw >= 1280 && nw < 1536) { okv = p.out + O_DV; okv_w = 256; okv_c = nw - 1280; }
    else if (nw >= 2048 && nw < 2176) { okv = p.out + O_SK; okv_w = 128; okv_c = nw - 2048; }
    else if (nw >= 2176) { okv = p.out + O_SV; okv_w = 128; okv_c = nw - 2176; }
  }
  int khh = -1;
  if (nw >= 256 && nw < 512) khh = (nw - 256) >> 6;
  else if (nw >= 1024 && nw < 1280) khh = 4 + ((nw - 1024) >> 6);
  else if (nw >= 2048 && nw < 2176) khh = 8 + ((nw - 2048) >> 6);
  int vrow = -1;
  if (nw >= 512 && nw < 768) vrow = nw - 512;
  else if (nw >= 1280 && nw < 1536) vrow = 256 + nw - 1280;
  else if (nw >= 2176) vrow = 512 + nw - 2176;
#pragma unroll
  for (int yi = 0; yi < 4; ++yi) {
    const int m = m0 + wy * 64 + yi * 16 + r;
    const int t = (m - NPTOK) & 1023;
    const int prow = t >> 6, pcol = t & 63;
#pragma unroll
    for (int xi = 0; xi < 4; ++xi) {
      f32x4 v = acc[xi][yi];
      if (ropeMode == 1) {
        const int pos = (xi & 1) ? pcol : prow;
        const float4 cs = *(const float4*)(p.ropeD + pos * 8 + 4 * (g & 1));
        const float4 sn = *(const float4*)(p.ropeD + 512 + pos * 8 + 4 * (g & 1));
        const float sg = (g >= 2) ? 1.f : -1.f;
        const float o0 = __shfl_xor(v[0], 32), o1 = __shfl_xor(v[1], 32), o2 = __shfl_xor(v[2], 32), o3 = __shfl_xor(v[3], 32);
        v[0] = v[0] * cs.x + sg * o0 * sn.x; v[1] = v[1] * cs.y + sg * o1 * sn.y;
        v[2] = v[2] * cs.z + sg * o2 * sn.z; v[3] = v[3] * cs.w + sg * o3 * sn.w;
      } else if (ropeMode == 2) {
        const int pos = (xi >> 1) ? pcol : prow;
        const float4 cs = *(const float4*)(p.ropeS + pos * 16 + 4 * g);
        const float4 sn = *(const float4*)(p.ropeS + 1024 + pos * 16 + 4 * g);
        const f32x4 o = acc[xi ^ 1][yi];
        const float sg = (xi & 1) ? 1.f : -1.f;
        v[0] = v[0] * cs.x + sg * o[0] * sn.x; v[1] = v[1] * cs.y + sg * o[1] * sn.y;
        v[2] = v[2] * cs.z + sg * o[2] * sn.z; v[3] = v[3] * cs.w + sg * o[3] * sn.w;
      }
      const int nloc = xi * 16 + 4 * g;
      if (okv) {
        const int b = m >> 8, pos = m & 255;
        float4 o4; o4.x = v[0]; o4.y = v[1]; o4.z = v[2]; o4.w = v[3];
        *(float4*)(okv + ((size_t)((b * 4 + l) * 256 + pos)) * okv_w + okv_c + nloc) = o4;
      }
      if (vrow >= 0) {
        u16* vb = p.vfr + ((size_t)((vrow >> 6) * 192 + (m >> 5))) * 2048;
#pragma unroll
        for (int i = 0; i < 4; ++i) vb[vfrag_off(m & 31, nloc + i)] = f2bf(v[i]);
      } else if (khh >= 0) {
        uint2 w; w.x = pack2(v[0], v[1]); w.y = pack2(v[2], v[3]);
        *(uint2*)(p.kfr + ((size_t)(khh * 192 + (m >> 5))) * 2048 + kfrag_off(m & 31, nloc)) = w;
      } else {
        uint2 w; w.x = pack2(v[0], v[1]); w.y = pack2(v[2], v[3]);
        *(uint2*)(p.z + (size_t)m * INW + nw + nloc) = w;
      }
    }
  }
}

__device__ void res_tile(const Params& p, int l, int tx, int ty, const u16* A, const u16* WT, int K, int gi, u16* smem, bool first = false) {
  const int n0 = tx * 128, m0 = ty * 96;
  f32x4 acc[4][3];
  gemm_main<3>(WT + (size_t)n0 * K, K, A + (size_t)m0 * K, K, K, smem, acc);
  const int lane = otid() & 63, wave = otid() >> 6, wx = wave & 1, wy = wave >> 1, r = lane & 15, g = lane >> 4;
#pragma unroll
  for (int yi = 0; yi < 3; ++yi) {
    const int m = m0 + wy * 48 + yi * 16 + r;
    const int cond = m < NPTOK ? 0 : 1 + ((m - NPTOK) >> 10);
    const float* gate = p.mods + (size_t)(l * 3 + cond) * 6144 + gi * 1024;
    float* xrow = p.xres + (size_t)m * 1024;
    const float* xin = first ? (m < NPTOK ? p.x_prompt + (size_t)m * 1024 : p.x_sample + (size_t)(m - NPTOK) * 1024) : xrow;
    float4 xv[4], gt[4];
#pragma unroll
    for (int xi = 0; xi < 4; ++xi) {
      const int n = n0 + wx * 64 + xi * 16 + 4 * g;
      xv[xi] = *(const float4*)(xin + n);
      gt[xi] = *(const float4*)(gate + n);
    }
#pragma unroll
    for (int xi = 0; xi < 4; ++xi) {
      const int n = n0 + wx * 64 + xi * 16 + 4 * g;
      const f32x4 v = acc[xi][yi];
      float4 o = xv[xi];
      o.x += gt[xi].x * v[0]; o.y += gt[xi].y * v[1]; o.z += gt[xi].z * v[2]; o.w += gt[xi].w * v[3];
      *(float4*)(xrow + n) = o;
    }
  }
}

__device__ void m1_tile(const Params& p, int l, int tx, int ty, u16* smem) {
  const int n0 = tx * 128, m0 = ty * 128;
  f32x4 acc[4][4];
  gemm_main<4>(p.w1T + (size_t)l * 4096 * 1024 + (size_t)n0 * 1024, 1024, p.h + (size_t)m0 * 1024, 1024, 1024, smem, acc);
  const int lane = otid() & 63, wave = otid() >> 6, wx = wave & 1, wy = wave >> 1, r = lane & 15, g = lane >> 4;
#pragma unroll
  for (int xi = 0; xi < 4; ++xi) {
    const int n = n0 + wx * 64 + xi * 16 + 4 * g;
#pragma unroll
    for (int yi = 0; yi < 4; ++yi) {
      const int m = m0 + wy * 64 + yi * 16 + r;
      const f32x4 v = acc[xi][yi];
      float a0 = fmaxf(v[0], 0.f), a1 = fmaxf(v[1], 0.f), a2 = fmaxf(v[2], 0.f), a3 = fmaxf(v[3], 0.f);
      uint2 w; w.x = pack2(a0 * a0, a1 * a1); w.y = pack2(a2 * a2, a3 * a3);
      *(uint2*)(p.u + (size_t)m * 4096 + n) = w;
    }
  }
}

__device__ void f1_tile(const Params& p, int l, int it, u16* smem) {
  const int tx = it % 48, ty = it / 48;
  const int x0 = tx * 128, y0 = ty * 128;
  f32x4 acc[4][4];
  gemm_main<4>(p.z + (size_t)x0 * INW + 1536, INW, p.pqt + (size_t)l * 512 * 256 + (size_t)y0 * 256, 256, 256, smem, acc);
  const int lane = otid() & 63, wave = otid() >> 6, wx = wave & 1, wy = wave >> 1, r = lane & 15, g = lane >> 4;
#pragma unroll
  for (int yi = 0; yi < 4; ++yi) {
    const int y = y0 + wy * 64 + yi * 16 + r;
    const int col = y & 255, which = y >> 8;
#pragma unroll
    for (int xi = 0; xi < 4; ++xi) {
      const int tok = x0 + wx * 64 + xi * 16 + 4 * g;
      size_t addr;
      if (tok < NPTOK) {
        const int b = tok >> 8, pos = tok & 255;
        addr = (size_t)b * (256 * 512) + (size_t)col * 512 + which * 256 + pos;
      } else {
        const int b = (tok - NPTOK) >> 10, pos = (tok - NPTOK) & 1023;
        addr = (size_t)16 * 256 * 512 + (size_t)b * (256 * 2048) + (size_t)col * 2048 + which * 1024 + pos;
      }
      const f32x4 v = acc[xi][yi];
      uint2 w; w.x = pack2(v[0], v[1]); w.y = pack2(v[2], v[3]);
      *(uint2*)(p.uv + addr) = w;
    }
  }
  asm volatile("s_waitcnt vmcnt(0)" ::: "memory");
  __syncthreads();
  if (threadIdx.x == 0) {
    __builtin_amdgcn_fence(__ATOMIC_RELEASE, "agent");
    asm volatile("s_waitcnt vmcnt(0)" ::: "memory");
    xb_add(p.bar + XCD_BAR_WORDS + (8 + l) * 64, 1u);
  }
}

__device__ void f2_tile(const Params& p, int l, int it, u16* smem) {
  if (threadIdx.x == 0) {
    unsigned* c = p.bar + XCD_BAR_WORDS + (8 + l) * 64;
    unsigned sp = 0;
    while (xb_ld(c) < 192u) { __builtin_amdgcn_s_sleep(2); if (++sp > (1u << 24)) break; }
    __builtin_amdgcn_fence(__ATOMIC_ACQUIRE, "agent");
    asm volatile("s_waitcnt vmcnt(0)" ::: "memory");
  }
  __syncthreads();
  int L, b, tx, ty, tokbase;
  const u16* uvb; const u16* dft;
  if (it < 32) { L = 1024; b = it >> 4; tx = (it >> 3) & 1; ty = it & 7; uvb = p.uv + (size_t)16 * 256 * 512 + (size_t)b * (256 * 2048); dft = p.dft1024; tokbase = NPTOK + b * 1024; }
  else { it -= 32; L = 256; b = it >> 2; tx = (it >> 1) & 1; ty = it & 1; uvb = p.uv + (size_t)b * (256 * 512); dft = p.dft256; tokbase = b * 256; }
  const int x0 = tx * 128, y0 = ty * 128, K = 2 * L;
  f32x4 acc[4][4];
  gemm_main<4>(uvb + (size_t)x0 * K, K, dft + (size_t)y0 * K, K, K, smem, acc);
  const int lane = otid() & 63, wave = otid() >> 6, wx = wave & 1, wy = wave >> 1, r = lane & 15, g = lane >> 4;
  const float scale = rsqrtf(64.f * (float)L);
#pragma unroll
  for (int yi = 0; yi < 4; ++yi) {
    const int pos = y0 + wy * 64 + yi * 16 + r;
#pragma unroll
    for (int xi = 0; xi < 4; ++xi) {
      const int col = x0 + wx * 64 + xi * 16 + 4 * g;
      const f32x4 v = acc[xi][yi];
      uint2 w; w.x = pack2(v[0] * scale, v[1] * scale); w.y = pack2(v[2] * scale, v[3] * scale);
      *(uint2*)(p.cat + (size_t)(tokbase + pos) * 1024 + 512 + col) = w;
    }
  }
}

struct Seg { const u16* K; const u16* Vt; int ldk, ldv, nblk, pos0, stride; };
#define KLOC(hh, tokb) (p.kfr + ((size_t)((hh) * 192 + ((tokb) >> 5))) * 2048)
#define VLOC(hh, tokb) (p.vfr + ((size_t)((hh) * 192 + ((tokb) >> 5))) * 2048)
template <int QT> struct AState { float m[QT]; float ls[QT]; f32x4 o[QT][4]; };

__device__ __forceinline__ bf16x8 as_bf(u32x4 v) { union { u32x4 u; bf16x8 b; } x; x.u = v; return x.b; }

template <int DC>
__device__ __forceinline__ void issue_blk(const Seg& s0, const Seg& s1, int b, int r, int g, u32x4 (&kf)[2][DC], u32x4 (&vf)[4]) {
  const bool in0 = b < s0.nblk;
  const u16* Kp = in0 ? s0.K : s1.K;
  const u16* Vp = in0 ? s0.Vt : s1.Vt;
  const int pos = in0 ? (s0.pos0 + b * s0.stride) : (s1.pos0 + (b - s0.nblk) * s1.stride);
  const int lane8 = (g * 16 + r) * 8;
  const u16* kp = Kp + (size_t)(pos >> 5) * 2048 + lane8;
  const u16* vp = Vp + (size_t)(pos >> 5) * 2048 + lane8;
#pragma unroll
  for (int t = 0; t < 2; ++t)
#pragma unroll
    for (int dc = 0; dc < DC; ++dc) gload16(kf[t][dc], kp + (t * 2 + dc) * 512);
#pragma unroll
  for (int dv = 0; dv < 4; ++dv) gload16(vf[dv], vp + dv * 512);
}
template <int N>
__device__ __forceinline__ void wait_blk(u32x4 (&kf)[2][1], u32x4 (&vf)[4]) {
  asm volatile("s_waitcnt vmcnt(%6)" : "+v"(kf[0][0]), "+v"(kf[1][0]), "+v"(vf[0]), "+v"(vf[1]), "+v"(vf[2]), "+v"(vf[3]) : "n"(N) : "memory");
}
template <int N>
__device__ __forceinline__ void wait_blk(u32x4 (&kf)[2][2], u32x4 (&vf)[4]) {
  asm volatile("s_waitcnt vmcnt(%8)" : "+v"(kf[0][0]), "+v"(kf[0][1]), "+v"(kf[1][0]), "+v"(kf[1][1]), "+v"(vf[0]), "+v"(vf[1]), "+v"(vf[2]), "+v"(vf[3]) : "n"(N) : "memory");
}

template <int D, int QT, int MODE>
__device__ __forceinline__ void attn_compute(const u32x4 (&kc)[2][D / 32], const u32x4 (&vc)[4], const bf16x8 (&qf)[QT][D / 32], const float sc,
                                             AState<QT>& st, const bool in0, const int pos, const int qpos0, const float* __restrict__ rpb_h,
                                             const int r, const int g) {
  constexpr int DC = D / 32;
#pragma unroll
  for (int q = 0; q < QT; ++q) {
    f32x4 s_[2];
    s_[0] = (f32x4){0.f, 0.f, 0.f, 0.f};
    s_[1] = (f32x4){0.f, 0.f, 0.f, 0.f};
#pragma unroll
    for (int t = 0; t < 2; ++t)
#pragma unroll
      for (int dc = 0; dc < DC; ++dc) s_[t] = __builtin_amdgcn_mfma_f32_16x16x32_bf16(as_bf(kc[t][dc]), qf[q][dc], s_[t], 0, 0, 0);
    float sv[8];
#pragma unroll
    for (int t = 0; t < 2; ++t)
#pragma unroll
      for (int i = 0; i < 4; ++i) {
        float x = s_[t][i] * sc;
        if (MODE == 1) {
          if (!in0) {
            const int qpos = qpos0 + q * 16 + r;
            const int qrow = qpos >> 6, cq = qpos & 63;
            const int kpos = pos + 8 * g + 4 * t + i;
            const int krow = kpos >> 6, ck = kpos & 63;
            const int cs = min(max(cq - 8, 0), 48);
            const bool valid = (ck >= cs) && (ck < cs + 16);
            const int bi = (krow - qrow + 7) * 31 + (ck - cq + 15);
            const float bias = rpb_h[valid ? bi : 0];
            x = valid ? (x + bias) : -1e30f;
          }
        } else if (MODE == 2) {
          if (!in0) {
            const int qpos = qpos0 + q * 16 + r;
            const int kpos = pos + 8 * g + 4 * t + i;
            const int d = qpos - kpos;
            x = (d <= 128 && d >= -128) ? x : -1e30f;
          }
        }
        sv[4 * t + i] = x;
      }
    float mx = fmaxf(fmaxf(fmaxf(sv[0], sv[1]), fmaxf(sv[2], sv[3])), fmaxf(fmaxf(sv[4], sv[5]), fmaxf(sv[6], sv[7])));
    mx = fmaxf(mx, __shfl_xor(mx, 16));
    mx = fmaxf(mx, __shfl_xor(mx, 32));
    const float mnew = fmaxf(st.m[q], mx);
    const float alpha = __builtin_amdgcn_exp2f(st.m[q] - mnew);
    st.m[q] = mnew;
    float ps = 0.f;
#pragma unroll
    for (int j = 0; j < 8; ++j) { sv[j] = __builtin_amdgcn_exp2f(sv[j] - mnew); ps += sv[j]; }
    st.ls[q] = st.ls[q] * alpha + ps;
    union { bf16x8 v; unsigned w[4]; } pf;
    pf.w[0] = pack2(sv[0], sv[1]); pf.w[1] = pack2(sv[2], sv[3]); pf.w[2] = pack2(sv[4], sv[5]); pf.w[3] = pack2(sv[6], sv[7]);
#pragma unroll
    for (int dv = 0; dv < 4; ++dv) {
      f32x4 o = st.o[q][dv];
      o[0] *= alpha; o[1] *= alpha; o[2] *= alpha; o[3] *= alpha;
      st.o[q][dv] = __builtin_amdgcn_mfma_f32_16x16x32_bf16(as_bf(vc[dv]), pf.v, o, 0, 0, 0);
    }
  }
}

template <int D, int QT, int MODE, int NQ = 2>
__device__ __forceinline__ void attn_run(const Seg& s0, const Seg& s1, const bf16x8 (&qf)[QT][D / 32], const float sc,
                                         AState<QT>& st, const int qpos0, const float* __restrict__ rpb_h, const int bb = 0, const int be = -1) {
  constexpr int DC = D / 32;
  constexpr int NL = 2 * DC + 4;
  const int lane = otid() & 63, r = lane & 15, g = lane >> 4;
  const int nb = be < 0 ? s0.nblk + s1.nblk : be;
  u32x4 kq[NQ][2][DC], vq[NQ][4];
#pragma unroll
  for (int q = 0; q < QT; ++q)
#pragma unroll
    for (int dc = 0; dc < DC; ++dc) asm volatile("" ::"v"(qf[q][dc]));
  asm volatile("s_waitcnt vmcnt(0)" ::: "memory");
#pragma unroll 1
  for (int b = bb; b < nb; b += NQ) {
#pragma unroll
    for (int j = 0; j < NQ; ++j) issue_blk<DC>(s0, s1, b + j, r, g, kq[j], vq[j]);
#pragma unroll
    for (int j = 0; j < NQ; ++j) {
      if (j == 0) wait_blk<(NQ - 1) * NL>(kq[j], vq[j]);
      else if (j == 1) wait_blk<(NQ - 2) * NL>(kq[j], vq[j]);
      else if (j == 2) wait_blk<(NQ > 3 ? (NQ - 3) * NL : 0)>(kq[j], vq[j]);
      else wait_blk<0>(kq[j], vq[j]);
      const int bj = b + j;
      const bool in0 = bj < s0.nblk;
      const int pos = in0 ? (s0.pos0 + bj * s0.stride) : (s1.pos0 + (bj - s0.nblk) * s1.stride);
      attn_compute<D, QT, MODE>(kq[j], vq[j], qf, sc, st, in0, pos, qpos0, rpb_h, r, g);
    }
  }
}

template <int QT>
__device__ __forceinline__ void astate_init(AState<QT>& st, float m0, float l0) {
#pragma unroll
  for (int q = 0; q < QT; ++q) {
    st.m[q] = m0; st.ls[q] = l0;
#pragma unroll
    for (int dv = 0; dv < 4; ++dv) st.o[q][dv] = (f32x4){0.f, 0.f, 0.f, 0.f};
  }
}
template <int QT>
__device__ __forceinline__ void astate_finalize(AState<QT>& st) {
#pragma unroll
  for (int q = 0; q < QT; ++q) {
    float l = st.ls[q];
    l += __shfl_xor(l, 16);
    l += __shfl_xor(l, 32);
    const float inv = 1.f / l;
#pragma unroll
    for (int dv = 0; dv < 4; ++dv) { st.o[q][dv][0] *= inv; st.o[q][dv][1] *= inv; st.o[q][dv][2] *= inv; st.o[q][dv][3] *= inv; }
  }
}
template <int DC, int QT>
__device__ __forceinline__ void load_q(const u16* zq  , bf16x8 (&qf)[QT][DC]) {
  const int lane = otid() & 63, r = lane & 15, g = lane >> 4;
#pragma unroll
  for (int q = 0; q < QT; ++q)
#pragma unroll
    for (int dc = 0; dc < DC; ++dc) qf[q][dc] = *(const bf16x8*)(zq + (size_t)(q * 16 + r) * INW + dc * 32 + g * 8);
}
template <int QT>
__device__ __forceinline__ void write_o(const Params& p, const AState<QT>& st, int tok0, int col0) {
  const int lane = otid() & 63, r = lane & 15, g = lane >> 4;
#pragma unroll
  for (int q = 0; q < QT; ++q)
#pragma unroll
    for (int dv = 0; dv < 4; ++dv) {
      const f32x4 v = st.o[q][dv];
      uint2 w; w.x = pack2(v[0], v[1]); w.y = pack2(v[2], v[3]);
      *(uint2*)(p.cat + (size_t)(tok0 + q * 16 + r) * 1024 + col0 + dv * 16 + 4 * g) = w;
    }
}

__device__ __forceinline__ float diff_lambda(const Params& p, int l, float lam_init) {
  const int lane = otid() & 63;
  float a = 0.f, b = 0.f;
  if (lane < 32) { a = p.lq1[l * 32 + lane] * p.lk1[l * 32 + lane]; b = p.lq2[l * 32 + lane] * p.lk2[l * 32 + lane]; }
#pragma unroll
  for (int o = 32; o >= 1; o >>= 1) { a += __shfl_xor(a, o); b += __shfl_xor(b, o); }
  return expf(a) - expf(b) + lam_init;
}

__device__ __forceinline__ void diff_finish_q(const Params& p, int l, float lam, float lam_init, f32x4 (&A)[4], const f32x4 (&B)[4], int tokrow0, int col0) {
  const int lane = otid() & 63, r = lane & 15, g = lane >> 4;
  const float* sg = p.subln_g + l * 64;
  float ss = 0.f;
#pragma unroll
  for (int dv = 0; dv < 4; ++dv)
#pragma unroll
    for (int i = 0; i < 4; ++i) {
      const float v = A[dv][i] - lam * B[dv][i];
      A[dv][i] = v;
      ss += v * v;
    }
  ss += __shfl_xor(ss, 16);
  ss += __shfl_xor(ss, 32);
  const float rs = rsqrtf(ss * (1.f / 64.f) + 1e-6f) * (1.f - lam_init);
#pragma unroll
  for (int dv = 0; dv < 4; ++dv) {
    const float4 gg = *(const float4*)(sg + dv * 16 + 4 * g);
    uint2 w;
    w.x = pack2(A[dv][0] * rs * gg.x, A[dv][1] * rs * gg.y);
    w.y = pack2(A[dv][2] * rs * gg.z, A[dv][3] * rs * gg.w);
    *(uint2*)(p.cat + (size_t)(tokrow0 + r) * 1024 + col0 + dv * 16 + 4 * g) = w;
  }
}

#ifndef AQT
#define AQT 2
#endif
#define QW (16 * AQT)
#define NQG_CTX (256 / QW)
#define NQG_LAT (1024 / QW)
__device__ void attn_diff_item(const Params& p, int l, bool lat, int bi, float* sm) {
  const int wave = otid() >> 6, lane = otid() & 63, r = lane & 15, g = lane >> 4;
  const int ps = wave >> 1, half = wave & 1;
  int b, h, qg, tokb;
  if (lat) { b = bi / (4 * NQG_LAT); h = (bi / NQG_LAT) & 3; qg = bi % NQG_LAT; tokb = NPTOK + b * 1024; }
  else { b = bi / (4 * NQG_CTX); h = (bi / NQG_CTX) & 3; qg = bi % NQG_CTX; tokb = b * 256; }
  const int tok0 = tokb + qg * QW;
  const u16* zb = p.z + (size_t)tokb * INW;
  Seg s0, s1;
  if (lat) {
    const int bl = b * 4 + l;
    s0.K = p.ck_diff + (size_t)((bl * 4 + h) * 16) * 2048 + ps * 512; s0.Vt = p.cvt_diff + (size_t)((bl * 4 + h) * 16) * 2048;
    s0.ldk = 0; s0.ldv = 0; s0.nblk = half ? 0 : 16; s0.pos0 = 0; s0.stride = 32;
    s1.K = KLOC(4 + h, tokb) + ps * 512; s1.Vt = VLOC(4 + h, tokb);
    s1.ldk = 0; s1.ldv = 0; s1.nblk = half ? 24 : 8; s1.pos0 = half ? 256 : 0; s1.stride = 32;
  } else {
    s0.K = KLOC(4 + h, tokb) + ps * 512; s0.Vt = VLOC(4 + h, tokb);
    s0.ldk = 0; s0.ldv = 0; s0.nblk = 4; s0.pos0 = half ? 128 : 0; s0.stride = 32;
    s1 = s0; s1.nblk = 0;
  }
  bf16x8 qf[AQT][1];
  load_q<1, AQT>(p.z + (size_t)tok0 * INW + 768 + h * 64 + ps * 32, qf);
  AState<AQT> st;
  astate_init<AQT>(st, -1e30f, 0.f);
  attn_run<32, AQT, 0, 2>(s0, s1, qf, 0.17677669529663687f * LOG2E, st, 0, nullptr);
  float lt[AQT];
#pragma unroll
  for (int q = 0; q < AQT; ++q) {
    lt[q] = st.ls[q];
    lt[q] += __shfl_xor(lt[q], 16);
    lt[q] += __shfl_xor(lt[q], 32);
  }
  constexpr int WS = 64 * 16 * AQT;
  float* pm = sm + 4 * WS;
  if (wave != 0) {
    float* po = sm + wave * WS + lane * (16 * AQT);
#pragma unroll
    for (int q = 0; q < AQT; ++q) {
#pragma unroll
      for (int dv = 0; dv < 4; ++dv) *(f32x4*)(po + q * 16 + dv * 4) = st.o[q][dv];
      if (g == 0) { pm[wave * QW + q * 16 + r] = st.m[q]; pm[4 * QW + wave * QW + q * 16 + r] = lt[q]; }
    }
  }
  __syncthreads();
  if (wave == 0) {
    const float lam_init = 0.8f - 0.6f * expf(-0.3f * (float)l);
    const float lam = diff_lambda(p, l, lam_init);
#pragma unroll
    for (int q = 0; q < AQT; ++q) {
      f32x4 A[4], B[4];
      {
        const float m1 = pm[QW + q * 16 + r], l1 = pm[4 * QW + QW + q * 16 + r];
        const float M = fmaxf(st.m[q], m1);
        const float a0 = exp2f(st.m[q] - M), a1 = exp2f(m1 - M);
        const float inv = 1.f / (lt[q] * a0 + l1 * a1);
#pragma unroll
        for (int dv = 0; dv < 4; ++dv) {
          const f32x4 o1 = *(const f32x4*)(sm + 1 * WS + lane * (16 * AQT) + q * 16 + dv * 4);
          A[dv] = (st.o[q][dv] * a0 + o1 * a1) * inv;
        }
      }
      {
        const float m2 = pm[2 * QW + q * 16 + r], l2 = pm[4 * QW + 2 * QW + q * 16 + r], m3 = pm[3 * QW + q * 16 + r], l3 = pm[4 * QW + 3 * QW + q * 16 + r];
        const float M = fmaxf(m2, m3);
        const float a2 = exp2f(m2 - M), a3 = exp2f(m3 - M);
        const float inv = 1.f / (l2 * a2 + l3 * a3);
#pragma unroll
        for (int dv = 0; dv < 4; ++dv) {
          const f32x4 o2 = *(const f32x4*)(sm + 2 * WS + lane * (16 * AQT) + q * 16 + dv * 4);
          const f32x4 o3 = *(const f32x4*)(sm + 3 * WS + lane * (16 * AQT) + q * 16 + dv * 4);
          B[dv] = (o2 * a2 + o3 * a3) * inv;
        }
      }
      diff_finish_q(p, l, lam, lam_init, A, B, tok0 + q * 16, 256 + h * 64);
    }
  }
  __syncthreads();
}

__device__ void attn_ctx_item(const Params& p, int l, int bi) {
  const int wave = otid() >> 6, lane = otid() & 63, g = lane >> 4;
  const int w = bi * 4 + wave;
  const int type = w / (64 * NQG_CTX), rem = w % (64 * NQG_CTX);
  const int b = rem / (4 * NQG_CTX), h = (rem / NQG_CTX) & 3, qg = rem % NQG_CTX;
  const int tokb = b * 256, tok0 = tokb + qg * QW;
  const u16* zb = p.z + (size_t)tokb * INW;
  const int kvh = h >> 1;
  const int qcol = type == 0 ? h * 64 : 1792 + h * 64;
  const int kcol = type == 0 ? 256 + h * 64 : 2048 + kvh * 64;
  const int vrow = type == 0 ? h * 64 : 512 + kvh * 64;
  const int ocol = type == 0 ? h * 64 : 768 + h * 64;
  bf16x8 qf[AQT][2];
  load_q<2, AQT>(p.z + (size_t)tok0 * INW + qcol, qf);
  const int hslot = type == 0 ? h : 8 + kvh;
  Seg s0; s0.K = KLOC(hslot, tokb); s0.Vt = VLOC(hslot, tokb); s0.ldk = 0; s0.ldv = 0; s0.nblk = 8; s0.pos0 = 0; s0.stride = 32;
  Seg sN = s0; sN.nblk = 0;
  AState<AQT> st;
  const float sk = type == 0 ? -1e30f : p.swa_sink[l * 4 + h] * LOG2E;
  astate_init<AQT>(st, sk, (type == 1 && g == 0) ? 1.f : 0.f);
  attn_run<64, AQT, 0, 2>(s0, sN, qf, 0.125f * LOG2E, st, 0, nullptr);
  astate_finalize<AQT>(st);
  write_o<AQT>(p, st, tok0, ocol);
}

__device__ void attn_lat_item(const Params& p, int l, int bi, float* sm) {
  const int wave = otid() >> 6, lane = otid() & 63, r = lane & 15, g = lane >> 4;
  const int type = bi / (8 * NQG_LAT), rem = bi % (8 * NQG_LAT);
  const int b = rem / (4 * NQG_LAT), h = (rem / NQG_LAT) & 3, qg = rem % NQG_LAT;
  const int q0 = qg * QW;
  const int tokb = NPTOK + b * 1024, tok0 = tokb + q0;
  const u16* zb = p.z + (size_t)tokb * INW;
  const int bl = b * 4 + l;
  AState<AQT> st;
  int ocol;
  if (type != 0) {
    const float* rp = p.na_rpb + (size_t)(l * 4 + h) * 15 * 31;
    for (int e = otid(); e < 465; e += 256) sm[9000 + e] = rp[e] * LOG2E;
    __syncthreads();
  }
  if (type == 0) {
    const int kvh = h >> 1;
    bf16x8 qf[AQT][2];
    load_q<2, AQT>(p.z + (size_t)tok0 * INW + 1792 + h * 64, qf);
    Seg s0; s0.K = p.ck_swa + (size_t)((bl * 2 + kvh) * 16) * 2048; s0.Vt = p.cvt_swa + (size_t)((bl * 2 + kvh) * 16) * 2048; s0.ldk = 0; s0.ldv = 0; s0.nblk = 16; s0.pos0 = 0; s0.stride = 32;
    const int lo = max(0, q0 - 128) & ~31;
    const int hi = min(1024, ((q0 + QW + 128) + 31) & ~31);
    int lo2 = lo, cnt = (hi - lo) >> 5;
    if (cnt & 1) { if (lo2 > 0) lo2 -= 32; ++cnt; }
    Seg s1; s1.K = KLOC(8 + kvh, tokb); s1.Vt = VLOC(8 + kvh, tokb); s1.ldk = 0; s1.ldv = 0; s1.nblk = cnt; s1.pos0 = lo2; s1.stride = 32;
    const int P = (16 + cnt) >> 1;
    const int pb = (wave * P) >> 2, pe = ((wave + 1) * P) >> 2;
    astate_init<AQT>(st, wave == 0 ? p.swa_sink[l * 4 + h] * LOG2E : -1e30f, (wave == 0 && g == 0) ? 1.f : 0.f);
    attn_run<64, AQT, 2>(s0, s1, qf, 0.125f * LOG2E, st, q0, nullptr, 2 * pb, 2 * pe);
    ocol = 768 + h * 64;
  } else {
    bf16x8 qf[AQT][2];
    load_q<2, AQT>(p.z + (size_t)tok0 * INW + h * 64, qf);
    Seg s0; s0.K = p.ck_na + (size_t)((bl * 4 + h) * 16) * 2048; s0.Vt = p.cvt_na + (size_t)((bl * 4 + h) * 16) * 2048; s0.ldk = 0; s0.ldv = 0; s0.nblk = 16; s0.pos0 = 0; s0.stride = 32;
    const int qrow = q0 >> 6;
    const int rstart = min(max(qrow - 4, 0), 8);
    Seg s1; s1.K = KLOC(h, tokb); s1.Vt = VLOC(h, tokb); s1.ldk = 0; s1.ldv = 0; s1.nblk = 16; s1.pos0 = rstart * 64; s1.stride = 32;
    astate_init<AQT>(st, -1e30f, 0.f);
    attn_run<64, AQT, 1, 2>(s0, s1, qf, 0.125f * LOG2E, st, q0, sm + 9000, 8 * wave, 8 * wave + 8);
    ocol = h * 64;
  }
  float lt[AQT];
#pragma unroll
  for (int q = 0; q < AQT; ++q) {
    lt[q] = st.ls[q];
    lt[q] += __shfl_xor(lt[q], 16);
    lt[q] += __shfl_xor(lt[q], 32);
  }
  constexpr int WS = 64 * 16 * AQT;
  float* pm = sm + 4 * WS;
  if (wave != 0) {
    float* po = sm + wave * WS + lane * (16 * AQT);
#pragma unroll
    for (int q = 0; q < AQT; ++q) {
#pragma unroll
      for (int dv = 0; dv < 4; ++dv) *(f32x4*)(po + q * 16 + dv * 4) = st.o[q][dv];
      if (g == 0) { pm[wave * QW + q * 16 + r] = st.m[q]; pm[4 * QW + wave * QW + q * 16 + r] = lt[q]; }
    }
  }
  __syncthreads();
  if (wave == 0) {
#pragma unroll
    for (int q = 0; q < AQT; ++q) {
      const float m1 = pm[1 * QW + q * 16 + r], m2 = pm[2 * QW + q * 16 + r], m3 = pm[3 * QW + q * 16 + r];
      const float l1 = pm[4 * QW + 1 * QW + q * 16 + r], l2 = pm[4 * QW + 2 * QW + q * 16 + r], l3 = pm[4 * QW + 3 * QW + q * 16 + r];
      const float M = fmaxf(fmaxf(st.m[q], m1), fmaxf(m2, m3));
      const float a0 = __builtin_amdgcn_exp2f(st.m[q] - M), a1 = __builtin_amdgcn_exp2f(m1 - M), a2 = __builtin_amdgcn_exp2f(m2 - M), a3 = __builtin_amdgcn_exp2f(m3 - M);
      const float inv = 1.f / (lt[q] * a0 + l1 * a1 + l2 * a2 + l3 * a3);
#pragma unroll
      for (int dv = 0; dv < 4; ++dv) {
        const f32x4 o1 = *(const f32x4*)(sm + 1 * WS + lane * (16 * AQT) + q * 16 + dv * 4);
        const f32x4 o2 = *(const f32x4*)(sm + 2 * WS + lane * (16 * AQT) + q * 16 + dv * 4);
        const f32x4 o3 = *(const f32x4*)(sm + 3 * WS + lane * (16 * AQT) + q * 16 + dv * 4);
        st.o[q][dv] = (st.o[q][dv] * a0 + o1 * a1 + o2 * a2 + o3 * a3) * inv;
      }
    }
    write_o<AQT>(p, st, tok0, ocol);
  }
  __syncthreads();
}

__device__ __forceinline__ int q_next(unsigned* cnt, volatile LAS unsigned* slot) {
  __syncthreads();
  if (threadIdx.x == 0) *slot = xb_add(cnt, 1u);
  __syncthreads();
  return (int)*slot;
}

#if REP_SYNC
#define GSYNC() do { xcd_barrier(xb); xcd_barrier(xb); } while (0)
#else
#define GSYNC() xcd_barrier(xb)
#endif
__global__ void __launch_bounds__(256, 2) mega(Params p) {
  extern __shared__ __attribute__((aligned(16))) unsigned char smem[];
  cg::grid_group grid = cg::this_grid();
  const int nblk = gridDim.x, bid = blockIdx.x;
  u16* sm16 = (u16*)smem;
  __shared__ uint4 xb_words[2];
  if (threadIdx.x == 0) { xb_words[0] = make_uint4(0u, 0u, 0u, 0u); xb_words[1] = make_uint4(0u, 0u, 0u, 0u); }
  __syncthreads();
  XcdBarrier xb = xcd_barrier_post(p.bar, (volatile LAS unsigned*)&xb_words[0]);

  for (int rep = 0; rep <= REP_P0; ++rep)
    for (int it = bid; it < P0_ITEMS; it += nblk) p0_item(p, it, smem);
  if (p.use_cg_sync) grid.sync();
  GSYNC();

  const int xcc = (int)xb.x;
  const int xrank = __builtin_amdgcn_readfirstlane((int)xb.st[4]), xnloc = __builtin_amdgcn_readfirstlane((int)xb.st[0]);
  const unsigned topo = (unsigned)__builtin_amdgcn_readfirstlane((int)xb.st[5]);
  const bool local = (topo & 1u) != 0u, full64 = (topo & 2u) != 0u;
#define LSYNC() do { if (local) xcd_barrier_local(xb); else GSYNC(); } while (0)
#define LMAP(j, count, total) (local ? ((xrank + (j) * xnloc) < (count) ? (xrank + (j) * xnloc) : -1) : ((bid + (j) * nblk) < (total) ? (bid + (j) * nblk) : -1))

#pragma unroll 1
  for (int l = 0; l < 4; ++l) {
    for (int j = 0;; ++j) { const int v = LMAP(j, 48, 384); if (v < 0) break; norm_item(p, l, 0, local ? 48 * xcc + v : v); }
    LSYNC();
    for (int j = 0;; ++j) {
      const int v = LMAP(j, 108, 864); if (v < 0) break;
      if (local) gin_tile(p, l, v / 6, 6 * xcc + v % 6, sm16); else gin_tile(p, l, v / 48, v % 48, sm16);
    }
    if (full64) {
      if (xrank >= 44) {
        const int idle = xcc * 20 + (xrank - 44);
        for (int it = 288 + idle; it < 928; it += 160) wt_item(p, l, it, (float*)smem);
      }
    }
    GSYNC();
    {
      constexpr int CD = 64 * NQG_CTX, CC = 2 * 64 * NQG_CTX / 4;
      constexpr int LD = 8 * NQG_LAT, LC = 2 * 8 * NQG_LAT;
      constexpr int E0 = 192, E1 = E0 + LD, E2 = E1 + LC, E3 = E2 + 32, E4 = E3 + CC, E5 = E4 + CD, E6 = E5 + 64;
      unsigned* qc = p.bar + XCD_BAR_WORDS + l * 64;
      const int w0 = full64 ? 928 : 288;
      const int EA = E6 + (1440 - w0), EW = EA + (l < 3 ? 288 : 0);
      for (int it = bid; it < EW; it = nblk + q_next(qc, &xb.st[2])) {
        if (it >= E6) {
          if (it < EA) wt_item(p, l, it - E6 + w0, (float*)smem);
          else wt_item(p, l + 1, it - EA, (float*)smem);
          continue;
        }
        if (it < E0) f1_tile(p, l, it, sm16);
        else if (it < E1) attn_diff_item(p, l, true, it - E0, (float*)smem);
        else if (it < E2) attn_lat_item(p, l, it - E1, (float*)smem);
        else if (it < E3) f2_tile(p, l, it - E2, sm16);
        else if (it < E4) attn_ctx_item(p, l, it - E3);
        else if (it < E5) attn_diff_item(p, l, false, it - E4, (float*)smem);
        else f2_tile(p, l, it - E5 + 32, sm16);
      }
    }
    GSYNC();
    for (int j = 0;; ++j) {
      const int v = LMAP(j, 64, 512); if (v < 0) break;
      if (local) res_tile(p, l, v / 8, 8 * xcc + v % 8, p.cat, p.w_outT + (size_t)l * 1024 * 1024, 1024, 2, sm16, l == 0);
      else res_tile(p, l, v / 64, v % 64, p.cat, p.w_outT + (size_t)l * 1024 * 1024, 1024, 2, sm16, l == 0);
    }
    LSYNC();
    for (int j = 0;; ++j) { const int v = LMAP(j, 48, 384); if (v < 0) break; norm_item(p, l, 1, local ? 48 * xcc + v : v); }
    LSYNC();
    for (int j = 0;; ++j) {
      const int v = LMAP(j, 192, 1536); if (v < 0) break;
      if (local) m1_tile(p, l, v / 6, 6 * xcc + v % 6, sm16); else m1_tile(p, l, v / 48, v % 48, sm16);
    }
    LSYNC();
    for (int j = 0;; ++j) {
      const int v = LMAP(j, 64, 512); if (v < 0) break;
      if (local) res_tile(p, l, v / 8, 8 * xcc + v % 8, p.u, p.w2T + (size_t)l * 1024 * 4096, 4096, 5, sm16);
      else res_tile(p, l, v / 64, v % 64, p.u, p.w2T + (size_t)l * 1024 * 4096, 4096, 5, sm16);
    }
    LSYNC();
  }
  for (int j = 0;; ++j) { const int v = LMAP(j, 48, 384); if (v < 0) break; norm_item(p, 0, 2, local ? 48 * xcc + v : v); }
#undef LSYNC
#undef LMAP
}

extern "C" void kernel_launch(void* const* d_in, const int* in_sizes, int n_in, void* d_out, int out_size, void* d_ws,
                              size_t ws_size, hipStream_t stream) {
  static int grid_blocks = 0;
  if (grid_blocks == 0) {
    int dev = 0, cus = 0, per_cu = 0;
    (void)hipGetDevice(&dev);
    (void)hipDeviceGetAttribute(&cus, hipDeviceAttributeMultiprocessorCount, dev);
    if (hipFuncSetAttribute((const void*)mega, hipFuncAttributeMaxDynamicSharedMemorySize, LDS_BYTES) != hipSuccess) {
      fprintf(stderr, "hipFuncSetAttribute failed\n");
    }
    if (hipOccupancyMaxActiveBlocksPerMultiprocessor(&per_cu, (const void*)mega, 256, LDS_BYTES) != hipSuccess || per_cu < 1) {
      fprintf(stderr, "occupancy query failed (%d)\n", per_cu);
      per_cu = 1;
    }
    if (per_cu > 2) per_cu = 2;
    grid_blocks = cus * per_cu;
    fprintf(stderr, "mega: cus=%d per_cu=%d grid=%d ws=%zu\n", cus, per_cu, grid_blocks, ws_size);
  }
  Params p{};
  const float** pin = (const float**)&p;
  for (int i = 0; i < 27; ++i) pin[i] = (const float*)d_in[i];
  p.out = (float*)d_out;
  unsigned char* ws = (unsigned char*)d_ws;
  size_t off = 0;
  auto take = [&](size_t bytes) { unsigned char* q = ws + off; off += (bytes + 255) & ~(size_t)255; return q; };
  p.xres = (float*)take((size_t)NTOK * 1024 * 4);
  p.mods = (float*)take((size_t)4 * 3 * 6144 * 4);
  p.h = (u16*)take((size_t)NTOK * 1024 * 2);
  p.z = (u16*)take((size_t)NTOK * INW * 2);
  p.vt = (u16*)take((size_t)640 * NTOK * 2);
  p.cat = (u16*)take((size_t)NTOK * 1024 * 2);
  p.u = (u16*)take((size_t)NTOK * 4096 * 2);
  p.uv = (u16*)take((size_t)(16 * 256 * 512 + 2 * 256 * 2048) * 2);
  p.w_inT = (u16*)take((size_t)4 * 2304 * 1024 * 2);
  p.w_outT = (u16*)take((size_t)4 * 1024 * 1024 * 2);
  p.w1T = (u16*)take((size_t)4 * 4096 * 1024 * 2);
  p.w2T = (u16*)take((size_t)4 * 4096 * 1024 * 2);
  p.pqt = (u16*)take((size_t)4 * 512 * 256 * 2);
  p.dft256 = (u16*)take((size_t)256 * 512 * 2);
  p.dft1024 = (u16*)take((size_t)1024 * 2048 * 2);
  p.ck_na = (u16*)take((size_t)2 * 4 * 512 * 256 * 2);
  p.cvt_na = (u16*)take((size_t)2 * 4 * 512 * 256 * 2);
  p.ck_diff = (u16*)take((size_t)2 * 4 * 512 * 256 * 2);
  p.cvt_diff = (u16*)take((size_t)2 * 4 * 512 * 256 * 2);
  p.ck_swa = (u16*)take((size_t)2 * 4 * 512 * 128 * 2);
  p.cvt_swa = (u16*)take((size_t)2 * 4 * 512 * 128 * 2);
  p.kfr = (u16*)take((size_t)10 * 192 * 2048 * 2);
  p.vfr = (u16*)take((size_t)10 * 192 * 2048 * 2);
  p.ropeD = (float*)take(1024 * 4);
  p.ropeS = (float*)take(2048 * 4);
  p.bar = (unsigned*)take(XB_ALL_WORDS * 4);
  if (off > ws_size) { fprintf(stderr, "workspace too small: need %zu have %zu\n", off, ws_size); return; }
  if (hipMemsetAsync(p.bar, 0, XB_ALL_WORDS * 4, stream) != hipSuccess) fprintf(stderr, "memset failed\n");
  void* args[] = {&p};
  hipError_t e = hipLaunchCooperativeKernel((const void*)mega, dim3(grid_blocks), dim3(256), args, LDS_BYTES, stream);
  if (e != hipSuccess) fprintf(stderr, "cooperative launch failed: %s (grid %d)\n", hipGetErrorString(e), grid_blocks);
}
```

```cpp
#include <hip/hip_runtime.h>
#include <hip/hip_cooperative_groups.h>
#include <stdint.h>
#include <stdio.h>
namespace cg = cooperative_groups;

typedef unsigned short u16;
typedef __attribute__((ext_vector_type(8))) short bf16x8;
typedef __attribute__((ext_vector_type(4))) float f32x4;
typedef __attribute__((ext_vector_type(4))) unsigned u32x4;
__device__ __forceinline__ void gload16(u32x4& dst, const void* ptr) {
  asm volatile("global_load_dwordx4 %0, %1, off" : "=v"(dst) : "v"(ptr) : "memory");
}

#define NTOK 6144
#define NPTOK 4096
#define INW 2304
#define LOG2E 1.4426950408889634f
#define LDS_BYTES 73728
#define LSTR 72

#define O_NAK 6291456
#define O_NAV 10485760
#define O_DK 14680064
#define O_DV 18874368
#define O_SK 23068672
#define O_SV 25165824

struct Params {
  const float *x_prompt, *x_sample, *c_na_k, *c_na_v, *c_diff_k, *c_diff_v, *c_swa_k, *c_swa_v, *c, *c_ctx;
  const float *w_ada, *b_ada, *norm1_g, *norm2_g, *w_in, *na_rpb, *lq1, *lk1, *lq2, *lk2, *subln_g, *w_fourier, *swa_sink;
  const float *w_out, *w1, *w2, *final_g;
  float* out;
  float* xres;
  float* mods;
  u16 *h, *z, *vt, *cat, *u, *uv, *w_inT, *w_outT, *w1T, *w2T, *pqt, *dft256, *dft1024;
  u16 *ck_na, *cvt_na, *ck_diff, *cvt_diff, *ck_swa, *cvt_swa;
  float *ropeD, *ropeS;
  u16 *kfr, *vfr;
  unsigned* bar;
  int use_cg_sync;
  int pad_;
};

__device__ __forceinline__ u16 f2bf(float f) {
  unsigned u = __float_as_uint(f);
  u += 0x7fffu + ((u >> 16) & 1u);
  return (u16)(u >> 16);
}
__device__ __forceinline__ int otid() { int t = threadIdx.x; asm volatile("" : "+v"(t)); return t; }
__device__ __forceinline__ float bf2f(u16 h) { return __uint_as_float(((unsigned)h) << 16); }
typedef __attribute__((ext_vector_type(2))) __bf16 hbf16x2;
typedef __attribute__((ext_vector_type(2))) float f32x2;
__device__ __forceinline__ unsigned pack2(float a, float b) {
  f32x2 v = {a, b};
  union { hbf16x2 h; unsigned u; } x;
  x.h = __builtin_convertvector(v, hbf16x2);
  return x.u;
}

__device__ __forceinline__ int kfrag_off(int kk, int d) {
  const int t = (kk >> 2) & 1, r = ((kk >> 3) << 2) | (kk & 3), dc = d >> 5, g = (d >> 3) & 3;
  return ((t * 2 + dc) * 64 + g * 16 + r) * 8 + (d & 7);
}
__device__ __forceinline__ int vfrag_off(int kk, int dv) {
  return (((dv >> 4) * 64) + (kk >> 3) * 16 + (dv & 15)) * 8 + (kk & 7);
}

#define XB_TMO      128
#define XB_XCNT(j)  (256  + 64 * (j))
#define XB_XSUB(j)  (1280 + 64 * (j))
#define XB_XGEN(j)  (2304 + 64 * (j))
#define XB_TOP      3328
#define XB_TOPGEN   3392
#define XCD_BAR_WORDS 3456
#define XB_SPIN_CAP (1u << 22)
#define LAS __attribute__((address_space(3)))
__device__ __forceinline__ unsigned xb_ld(unsigned* p)              { return __hip_atomic_load(p, __ATOMIC_RELAXED, __HIP_MEMORY_SCOPE_AGENT); }
__device__ __forceinline__ unsigned xb_add(unsigned* p, unsigned v) { return __hip_atomic_fetch_add(p, v, __ATOMIC_RELAXED, __HIP_MEMORY_SCOPE_AGENT); }
__device__ __forceinline__ unsigned xb_xcc_id() { return (unsigned)__builtin_amdgcn_s_getreg((3 << 11) | 20) & 0xFu; }
#define XB_SPIN(cond, bar) do { unsigned _sp = 0; while (cond) { __builtin_amdgcn_s_sleep(1); \
    if ((++_sp & 255u) == 0u) { if (xb_ld(&(bar)[XB_TMO])) break; if (_sp > XB_SPIN_CAP) { atomicAdd(&(bar)[XB_TMO], 1u); break; } } } } while (0)
#define XB_LSUB(j)  (XCD_BAR_WORDS + 12 * 64 + 64 * (j))
#define XB_LGEN(j)  (XCD_BAR_WORDS + 12 * 64 + 64 * (16 + (j)))
#define XB_ALL_WORDS (XCD_BAR_WORDS + 12 * 64 + 32 * 64)
struct XcdBarrier { unsigned* bar; unsigned x; volatile LAS unsigned* st; };
__device__ __forceinline__ XcdBarrier xcd_barrier_post(unsigned* bar, volatile LAS unsigned* st) {
  XcdBarrier b; b.bar = bar; b.x = xb_xcc_id(); b.st = st;
  if (threadIdx.x == 0) st[4] = xb_add(&bar[XB_XCNT(b.x)], 1u);
  return b;
}
__device__ __forceinline__ void xcd_barrier_complete(unsigned* bar, unsigned x, unsigned& nloc, unsigned& nx) {
  const unsigned G = gridDim.x * gridDim.y * gridDim.z;
  unsigned sum, cnt, mine, sp = 0u;
  for (;;) {
    sum = 0u; cnt = 0u; mine = 0u;
#pragma unroll
    for (unsigned j = 0; j < 16; ++j) { const unsigned c = xb_ld(&bar[XB_XCNT(j)]); sum += c; cnt += (c > 0u) ? 1u : 0u; mine = (j == x) ? c : mine; }
    if (sum == G) break;
    __builtin_amdgcn_s_sleep(1);
    if ((++sp & 255u) == 0u) { if (xb_ld(&bar[XB_TMO])) break; if (sp > XB_SPIN_CAP) { atomicAdd(&bar[XB_TMO], 1u); break; } }
  }
  nloc = mine > 0u ? mine : 1u; nx = cnt > 0u ? cnt : 1u;
}
__device__ __forceinline__ unsigned xcd_topology(unsigned* bar) {
  const unsigned G = gridDim.x * gridDim.y * gridDim.z;
  unsigned sum8 = 0u, all = 1u, all64 = 1u;
#pragma unroll
  for (unsigned j = 0; j < 8; ++j) { const unsigned c = xb_ld(&bar[XB_XCNT(j)]); sum8 += c; all &= (c > 0u) ? 1u : 0u; all64 &= (c == 64u) ? 1u : 0u; }
  const unsigned ok = (all && sum8 == G) ? 1u : 0u;
  return ok | ((ok && all64) ? 2u : 0u);
}
__device__ __forceinline__ void xcd_barrier(const XcdBarrier& b) {
  asm volatile("s_waitcnt vmcnt(0)" ::: "memory");
  __syncthreads();
  if (threadIdx.x == 0) {
    unsigned* bar = b.bar;
    __builtin_amdgcn_s_waitcnt(0);
    unsigned nloc = b.st[0], nx = b.st[1];
    if (nloc == 0u) { xcd_barrier_complete(bar, b.x, nloc, nx); b.st[0] = nloc; b.st[1] = nx; b.st[5] = xcd_topology(bar); }
    const unsigned old = xb_add(&bar[XB_XSUB(b.x)], 1u);
    const unsigned gen = old / nloc;
    if (old + 1u == (gen + 1u) * nloc) {
      __builtin_amdgcn_fence(__ATOMIC_RELEASE, "agent");
      asm volatile("s_waitcnt vmcnt(0)" ::: "memory");
      const unsigned og = xb_add(&bar[XB_TOP], 1u);
      const unsigned tg = og / nx;
      if (og + 1u == (tg + 1u) * nx) xb_add(&bar[XB_TOPGEN], 1u);
      else XB_SPIN(xb_ld(&bar[XB_TOPGEN]) == tg, bar);
      __builtin_amdgcn_fence(__ATOMIC_ACQUIRE, "agent");
      xb_add(&bar[XB_XGEN(b.x)], 1u);
      asm volatile("s_waitcnt vmcnt(0)" ::: "memory");
    } else {
      XB_SPIN(xb_ld(&bar[XB_XGEN(b.x)]) == gen, bar);
      __builtin_amdgcn_fence(__ATOMIC_ACQUIRE, "agent");
      asm volatile("s_waitcnt vmcnt(0)" ::: "memory");
    }
  }
  __syncthreads();
}

__device__ __forceinline__ void xcd_barrier_local(const XcdBarrier& b) {
  asm volatile("s_waitcnt vmcnt(0)" ::: "memory");
  __syncthreads();
  if (threadIdx.x == 0) {
    unsigned* bar = b.bar;
    __builtin_amdgcn_s_waitcnt(0);
    const unsigned nloc = b.st[0];
    const unsigned old = xb_add(&bar[XB_LSUB(b.x)], 1u);
    const unsigned gen = old / nloc;
    if (old + 1u == (gen + 1u) * nloc) xb_add(&bar[XB_LGEN(b.x)], 1u);
    else XB_SPIN(xb_ld(&bar[XB_LGEN(b.x)]) == gen, bar);
    __builtin_amdgcn_fence(__ATOMIC_ACQUIRE, "agent");
    asm volatile("s_waitcnt vmcnt(0)" ::: "memory");
  }
  __syncthreads();
}

__device__ __forceinline__ void transpose_tile(const float* __restrict__ src, int lds_, u16* __restrict__ dst, int ldd,
                                               int k0, int n0, float* sm, bool fragv = false) {
  const int tid = otid();
  const int c4 = (tid & 15) * 4, r0 = tid >> 4;
  float4 v[8];
#pragma unroll
  for (int i = 0; i < 8; ++i) v[i] = *(const float4*)(src + (size_t)(k0 + r0 + 16 * i) * lds_ + n0 + c4);
#pragma unroll
  for (int i = 0; i < 8; ++i) {
    const int k = r0 + 16 * i;
    sm[(c4 + 0) * 129 + k] = v[i].x; sm[(c4 + 1) * 129 + k] = v[i].y; sm[(c4 + 2) * 129 + k] = v[i].z; sm[(c4 + 3) * 129 + k] = v[i].w;
  }
  __syncthreads();
  const int k8 = (tid & 15) * 8, nn = tid >> 4;
#pragma unroll
  for (int i = 0; i < 4; ++i) {
    const int n = nn + 16 * i;
    const float* row = sm + n * 129 + k8;
    uint4 w;
    w.x = pack2(row[0], row[1]); w.y = pack2(row[2], row[3]); w.z = pack2(row[4], row[5]); w.w = pack2(row[6], row[7]);
    if (fragv) {
      const int col = n0 + n, pos = k0 + k8;
      *(uint4*)(dst + ((size_t)((col >> 6) * 16 + (pos >> 5))) * 2048 + vfrag_off(pos & 31, col & 63)) = w;
    } else {
      *(uint4*)(dst + (size_t)(n0 + n) * ldd + k0 + k8) = w;
    }
  }
  __syncthreads();
}

__device__ __forceinline__ void adaln_item(const Params& p, int it, float* sm) {
  const int l = it / 192, c0 = (it % 192) * 32;
  float* ssil = sm;
  float* red = sm + 3072;
  const int tid = otid();
  for (int i = tid; i < 3072; i += 256) {
    const int cnd = i >> 10, k = i & 1023;
    const float v = cnd == 0 ? p.c_ctx[k] : p.c[(cnd - 1) * 1024 + k];
    ssil[i] = v / (1.f + expf(-v));
  }
  __syncthreads();
  const int cg4 = (tid & 7) * 4, ks = tid >> 3;
  const float* w = p.w_ada + (size_t)l * 1024 * 6144 + c0 + cg4;
  float a0[4] = {0.f, 0.f, 0.f, 0.f}, a1[4] = {0.f, 0.f, 0.f, 0.f}, a2[4] = {0.f, 0.f, 0.f, 0.f};
#pragma unroll 16
  for (int kk = 0; kk < 32; ++kk) {
    const int k = kk * 32 + ks;
    const float4 v = *(const float4*)(w + (size_t)k * 6144);
    const float s0 = ssil[k], s1 = ssil[1024 + k], s2 = ssil[2048 + k];
    a0[0] += s0 * v.x; a0[1] += s0 * v.y; a0[2] += s0 * v.z; a0[3] += s0 * v.w;
    a1[0] += s1 * v.x; a1[1] += s1 * v.y; a1[2] += s1 * v.z; a1[3] += s1 * v.w;
    a2[0] += s2 * v.x; a2[1] += s2 * v.y; a2[2] += s2 * v.z; a2[3] += s2 * v.w;
  }
#pragma unroll
  for (int j = 0; j < 4; ++j) {
    red[(ks * 3 + 0) * 32 + cg4 + j] = a0[j];
    red[(ks * 3 + 1) * 32 + cg4 + j] = a1[j];
    red[(ks * 3 + 2) * 32 + cg4 + j] = a2[j];
  }
  __syncthreads();
  if (tid < 96) {
    const int cnd = tid >> 5, j = tid & 31;
    float s = p.b_ada[l * 6144 + c0 + j];
    for (int q = 0; q < 32; ++q) s += red[(q * 3 + cnd) * 32 + j];
    p.mods[(l * 3 + cnd) * 6144 + c0 + j] = s;
  }
  __syncthreads();
}

__device__ __forceinline__ void cvt_item(const float* __restrict__ src, u16* __restrict__ dst, int it, int W) {
  const int w8 = W >> 3;
#pragma unroll
  for (int i = 0; i < 4; ++i) {
    const int u = it * 1024 + i * 256 + otid();
    const int d8 = u % w8, pos = (u / w8) & 511, bl = u / (w8 * 512);
    const float* sp = src + ((size_t)(bl * 512 + pos) * W + d8 * 8);
    const float4 v0 = *(const float4*)sp, v1 = *(const float4*)(sp + 4);
    uint4 w; w.x = pack2(v0.x, v0.y); w.y = pack2(v0.z, v0.w); w.z = pack2(v1.x, v1.y); w.w = pack2(v1.z, v1.w);
    const int h = d8 >> 3, d = (d8 & 7) * 8;
    *(uint4*)(dst + ((size_t)((bl * (W >> 6) + h) * 16 + (pos >> 5))) * 2048 + kfrag_off(pos & 31, d)) = w;
  }
}

__device__ __forceinline__ void pq_item(const Params& p, int it, float* sm) {
  const int cq = it & 3, it2 = it >> 2;
  const int l = it2 >> 3, which = (it2 >> 2) & 1, g = it2 & 3;
  const int n = otid();
  if (n < 64) sm[n] = which ? sinpif(2.f * (float)n / 64.f) : cospif(2.f * (float)n / 64.f);
  __syncthreads();
  float w[64];
#pragma unroll
  for (int m = 0; m < 64; ++m) w[m] = p.w_fourier[(size_t)l * 65536 + (g * 64 + m) * 256 + n];
  u16* dst = p.pqt + (size_t)l * 512 * 256 + (size_t)(which * 256 + n) * 256 + g * 64;
  for (int c = cq * 16; c < cq * 16 + 16; ++c) {
    float s = 0.f;
#pragma unroll
    for (int m = 0; m < 64; ++m) s += sm[(c * m) & 63] * w[m];
    dst[c] = f2bf(s);
  }
  __syncthreads();
}

__device__ __forceinline__ void dft_item(u16* dst, int L, int it) {
  const int twoL = 2 * L;
  for (int e = otid(); e < 8192; e += 256) {
    const int idx = it * 8192 + e;
    const int k = idx / twoL, j = idx % twoL;
    const int jj = j & (L - 1);
    const int ph = (k * jj) & (L - 1);
    const float a = 2.f * (float)ph / (float)L;
    const float v = (j >= L) ? -sinpif(a) : cospif(a);
    dst[idx] = f2bf(v);
  }
}

#define P0_WT 288
#define P0_ADA 768
#define P0_XC 0
#define P0_CK 320
#define P0_CVT 320
#define P0_PQ 128
#define P0_DFT 272
#define P0_ITEMS (P0_ADA + P0_WT + P0_XC + P0_CK + P0_CVT + P0_PQ + P0_DFT + 1)

__device__ void wt_item(const Params& p, int l, int r, float* sm) {
  if (r < 288) { transpose_tile(p.w_in + (size_t)l * 1024 * 2304, 2304, p.w_inT + (size_t)l * 2304 * 1024, 1024, (r / 36) * 128, (r % 36) * 64, sm); return; }
  r -= 288;
  if (r < 128) { transpose_tile(p.w_out + (size_t)l * 1024 * 1024, 1024, p.w_outT + (size_t)l * 1024 * 1024, 1024, (r / 16) * 128, (r % 16) * 64, sm); return; }
  r -= 128;
  if (r < 512) { transpose_tile(p.w1 + (size_t)l * 1024 * 4096, 4096, p.w1T + (size_t)l * 4096 * 1024, 1024, (r / 64) * 128, (r % 64) * 64, sm); return; }
  r -= 512;
  transpose_tile(p.w2 + (size_t)l * 4096 * 1024, 1024, p.w2T + (size_t)l * 1024 * 4096, 4096, (r / 16) * 128, (r % 16) * 64, sm);
}

__device__ void p0_item(const Params& p, int it, unsigned char* smem) {
  float* sm = (float*)smem;
  if (it < P0_ADA) { adaln_item(p, it, sm); return; }
  it -= P0_ADA;
  if (it < P0_WT) { wt_item(p, 0, it, sm); return; }
  it -= P0_WT;
  if (it < P0_XC) {
    const int row0 = it * 16;
    const float* src = row0 < NPTOK ? p.x_prompt + (size_t)row0 * 1024 : p.x_sample + (size_t)(row0 - NPTOK) * 1024;
    float* dst = p.xres + (size_t)row0 * 1024;
#pragma unroll
    for (int i = 0; i < 16; ++i) {
      const int o = (i * 256 + otid()) * 4;
      *(float4*)(dst + o) = *(const float4*)(src + o);
    }
    return;
  }
  it -= P0_XC;
  if (it < P0_CK) {
    if (it < 128) { cvt_item(p.c_na_k, p.ck_na, it, 256); return; }
    it -= 128;
    if (it < 128) { cvt_item(p.c_diff_k, p.ck_diff, it, 256); return; }
    it -= 128;
    cvt_item(p.c_swa_k, p.ck_swa, it, 128);
    return;
  }
  it -= P0_CK;
  if (it < P0_CVT) {
    if (it < 128) { const int bl = it >> 4, r = it & 15; transpose_tile(p.c_na_v + (size_t)bl * 512 * 256, 256, p.cvt_na + (size_t)bl * 256 * 512, 512, (r >> 2) * 128, (r & 3) * 64, sm, true); return; }
    it -= 128;
    if (it < 128) { const int bl = it >> 4, r = it & 15; transpose_tile(p.c_diff_v + (size_t)bl * 512 * 256, 256, p.cvt_diff + (size_t)bl * 256 * 512, 512, (r >> 2) * 128, (r & 3) * 64, sm, true); return; }
    it -= 128;
    { const int bl = it >> 3, r = it & 7; transpose_tile(p.c_swa_v + (size_t)bl * 512 * 128, 128, p.cvt_swa + (size_t)bl * 128 * 512, 512, (r >> 1) * 128, (r & 1) * 64, sm, true); return; }
  }
  it -= P0_CVT;
  if (it < P0_PQ) { pq_item(p, it, sm); return; }
  it -= P0_PQ;
  if (it < 16) { dft_item(p.dft256, 256, it); return; }
  it -= 16;
  if (it < 256) { dft_item(p.dft1024, 1024, it); return; }
  for (int e = otid(); e < 512 + 1024; e += 256) {
    const bool isD = e < 512;
    const int ee = isD ? e : e - 512;
    const int nf = isD ? 8 : 16;
    const int pos = ee / nf, fi = ee % nf;
    const float inv = exp2f(-(float)fi * (13.287712379549449f / (float)nf));
    float tt = (float)pos * inv * 0.15915494309189535f;
    tt -= rintf(tt);
    float sn, cs;
    sincospif(2.f * tt, &sn, &cs);
    if (isD) { p.ropeD[ee] = cs; p.ropeD[512 + ee] = sn; }
    else { p.ropeS[ee] = cs; p.ropeS[1024 + ee] = sn; }
  }
}

__device__ __forceinline__ void norm_item(const Params& p, int l, int which, int it) {
  const int lane = otid() & 63, wave = otid() >> 6;
  const int row0 = it * 16 + wave * 4;
  const float* xsrc = (which == 0 && l == 0) ? (row0 < NPTOK ? p.x_prompt + (size_t)row0 * 1024 : p.x_sample + (size_t)(row0 - NPTOK) * 1024)
                                             : p.xres + (size_t)row0 * 1024;
  float4 v[4][4];
#pragma unroll
  for (int j = 0; j < 4; ++j)
#pragma unroll
    for (int k = 0; k < 4; ++k) v[j][k] = *(const float4*)(xsrc + (size_t)j * 1024 + (k * 64 + lane) * 4);
  float rs[4];
#pragma unroll
  for (int j = 0; j < 4; ++j) {
    float ss = 0.f;
#pragma unroll
    for (int k = 0; k < 4; ++k) ss += v[j][k].x * v[j][k].x + v[j][k].y * v[j][k].y + v[j][k].z * v[j][k].z + v[j][k].w * v[j][k].w;
#pragma unroll
    for (int o = 32; o >= 1; o >>= 1) ss += __shfl_xor(ss, o);
    rs[j] = rsqrtf(ss * (1.f / 1024.f) + 1e-6f);
  }
  if (which < 2) {
    const int cond = row0 < NPTOK ? 0 : 1 + ((row0 - NPTOK) >> 10);
    const float* gp = (which == 0 ? p.norm1_g : p.norm2_g) + l * 1024;
    const float* shp = p.mods + (size_t)(l * 3 + cond) * 6144 + (which * 3 + 0) * 1024;
    const float* scp = shp + 1024;
#pragma unroll
    for (int k = 0; k < 4; ++k) {
      const int col = (k * 64 + lane) * 4;
      const float4 gg = *(const float4*)(gp + col);
      const float4 sh = *(const float4*)(shp + col);
      const float4 sc = *(const float4*)(scp + col);
      const float mx = gg.x * (1.f + sc.x), my = gg.y * (1.f + sc.y), mz = gg.z * (1.f + sc.z), mw = gg.w * (1.f + sc.w);
#pragma unroll
      for (int j = 0; j < 4; ++j) {
        uint2 w;
        w.x = pack2(v[j][k].x * rs[j] * mx + sh.x, v[j][k].y * rs[j] * my + sh.y);
        w.y = pack2(v[j][k].z * rs[j] * mz + sh.z, v[j][k].w * rs[j] * mw + sh.w);
        *(uint2*)(p.h + (size_t)(row0 + j) * 1024 + col) = w;
      }
    }
  } else {
#pragma unroll
    for (int k = 0; k < 4; ++k) {
      const int col = (k * 64 + lane) * 4;
      const float4 gg = *(const float4*)(p.final_g + col);
#pragma unroll
      for (int j = 0; j < 4; ++j) {
        float4 o;
        o.x = v[j][k].x * rs[j] * gg.x; o.y = v[j][k].y * rs[j] * gg.y; o.z = v[j][k].z * rs[j] * gg.z; o.w = v[j][k].w * rs[j] * gg.w;
        *(float4*)(p.out + (size_t)(row0 + j) * 1024 + col) = o;
      }
    }
  }
}

template <bool ZERO, int YT>
__device__ __forceinline__ void gemm_main_t(const u16* __restrict__ X, int ldx, const u16* __restrict__ Y, int ldy, int K,
                                          u16* smem, f32x4 (&acc)[4][YT]) {
  const int tid = otid(), lane = tid & 63, wave = tid >> 6, wx = wave & 1, wy = wave >> 1, r = lane & 15, g = lane >> 4;
  u16* sX = smem;
  u16* sY = smem + 2 * 128 * 64;
  const int lrow = tid >> 3, lkc = tid & 7;
  const int gsw = (lkc ^ (lrow & 7)) * 8;
  const u16* gx = X + (size_t)lrow * ldx + gsw;
  const u16* gy = Y + (size_t)lrow * ldy + gsw;
  u16* lx = sX + tid * 8;
  u16* ly = sY + tid * 8;
#define GEMM_STAGE(buf, kt_)                                                                                                      \
  {                                                                                                                               \
    _Pragma("unroll") for (int i = 0; i < 4; ++i)                                                                                 \
      __builtin_amdgcn_global_load_lds((const unsigned*)(gx + (size_t)(32 * i) * ldx + (kt_) * 64),                               \
                                       (unsigned*)(lx + (buf) * 8192 + i * 2048), 16, 0, 0);                                      \
    _Pragma("unroll") for (int i = 0; i < YT; ++i)                                                                                \
      __builtin_amdgcn_global_load_lds((const unsigned*)(gy + (size_t)(32 * i) * ldy + (kt_) * 64),                               \
                                       (unsigned*)(ly + (buf) * 8192 + i * 2048), 16, 0, 0);                                      \
  }
  GEMM_STAGE(0, 0);
  if (ZERO) {
#pragma unroll
    for (int a = 0; a < 4; ++a)
#pragma unroll
      for (int b = 0; b < YT; ++b) acc[a][b] = (f32x4){0.f, 0.f, 0.f, 0.f};
  }
  const int nk = K >> 6;
  const int sw = r & 7;
  const u16* cx0 = sX + (wx * 64 + r) * 64;
  const u16* cy0 = sY + (wy * (16 * YT) + r) * 64;
  __syncthreads();
#define GEMM_COMPUTE(cur)                                                                            \
  {                                                                                                  \
    const u16* cx = cx0 + (cur) * 8192;                                                              \
    const u16* cy = cy0 + (cur) * 8192;                                                              \
    _Pragma("unroll") for (int kk = 0; kk < 2; ++kk) {                                               \
      const int pc = ((kk * 4 + g) ^ sw) * 8;                                                        \
      bf16x8 a[4], b[YT];                                                                            \
      _Pragma("unroll") for (int i = 0; i < 4; ++i) a[i] = *(const bf16x8*)(cx + i * 16 * 64 + pc);  \
      _Pragma("unroll") for (int i = 0; i < YT; ++i) b[i] = *(const bf16x8*)(cy + i * 16 * 64 + pc); \
      _Pragma("unroll") for (int xi = 0; xi < 4; ++xi)                                               \
        _Pragma("unroll") for (int yi = 0; yi < YT; ++yi)                                            \
          acc[xi][yi] = __builtin_amdgcn_mfma_f32_16x16x32_bf16(a[xi], b[yi], acc[xi][yi], 0, 0, 0); \
    }                                                                                                \
  }
#pragma unroll 1
  for (int kt = 0; kt < nk - 1; ++kt) {
    const int cur = kt & 1;
    GEMM_STAGE(cur ^ 1, kt + 1);
    GEMM_COMPUTE(cur);
    __syncthreads();
  }
  GEMM_COMPUTE((nk - 1) & 1);
  __syncthreads();
#undef GEMM_COMPUTE
#undef GEMM_STAGE
}

#ifndef REP_GEMM
#define REP_GEMM 0
#endif
#ifndef REP_MIX
#define REP_MIX 0
#endif
#ifndef REP_SYNC
#define REP_SYNC 0
#endif
#ifndef REP_P0
#define REP_P0 0
#endif
template <int YT>
__device__ __forceinline__ void gemm_main(const u16* __restrict__ X, int ldx, const u16* __restrict__ Y, int ldy, int K,
                                          u16* smem, f32x4 (&acc)[4][YT]) {
  gemm_main_t<true, YT>(X, ldx, Y, ldy, K, smem, acc);
#if REP_GEMM
  gemm_main_t<false, YT>(X, ldx, Y, ldy, K, smem, acc);
#pragma unroll
  for (int a = 0; a < 4; ++a)
#pragma unroll
    for (int b = 0; b < YT; ++b) acc[a][b] *= 0.5f;
#endif
}

__device__ __forceinline__ bool tile_map(int j, int ntx, int& tx, int& ty, int nty = 48) {
  const int nblk = gridDim.x, bid = blockIdx.x;
  if (nblk == 512) {
    const int per = nty >> 3, hp = per >> 1;
    const int rank = bid >> 3, q = (rank & 31) + j * 32, mem = rank >> 5;
    if (q >= hp * ntx) return false;
    tx = q / hp; ty = per * (bid & 7) + 2 * (q % hp) + mem;
    return true;
  } else {
    const int it = bid + j * nblk;
    if (it >= nty * ntx) return false;
    tx = it / nty; ty = it % nty;
    return true;
  }
}

__device__ void gin_tile(const Params& p, int l, int tx, int ty, u16* smem) {
  const int n0 = tx * 128, m0 = ty * 128;
  f32x4 acc[4][4];
  gemm_main<4>(p.w_inT + (size_t)l * 2304 * 1024 + (size_t)n0 * 1024, 1024, p.h + (size_t)m0 * 1024, 1024, 1024, smem, acc);
  const int lane = otid() & 63, wave = otid() >> 6, wx = wave & 1, wy = wave >> 1, r = lane & 15, g = lane >> 4;
  const int nw = n0 + wx * 64;
  const bool isS = m0 >= NPTOK;
  int ropeMode = 0;
  if (isS) {
    if (nw >= 768 && nw < 1280) ropeMode = 1;
    else if (nw >= 1792 && nw < 2176) ropeMode = 2;
  }
  float* okv = nullptr; int okv_w = 0, okv_c = 0;
  if (!isS) {
    if (nw >= 256 && nw < 512) { okv = p.out + O_NAK; okv_w = 256; okv_c = nw - 256; }
    else if (nw >= 512 && nw < 768) { okv = p.out + O_NAV; okv_w = 256; okv_c = nw - 512; }
    else if (nw >= 1024 && nw < 1280) { okv = p.out + O_DK; okv_w = 256; okv_c = nw - 1024; }
    else if (nw >= 1280 && nw < 1536) { okv = p.out + O_DV; okv_w = 256; okv_c = nw - 1280; }
    else if (nw >= 2048 && nw < 2176) { okv = p.out + O_SK; okv_w = 128; okv_c = nw - 2048; }
    else if (nw >= 2176) { okv = p.out + O_SV; okv_w = 128; okv_c = nw - 2176; }
  }
  int khh = -1;
  if (nw >= 256 && nw < 512) khh = (nw - 256) >> 6;
  else if (nw >= 1024 && nw < 1280) khh = 4 + ((nw - 1024) >> 6);
  else if (nw >= 2048 && nw < 2176) khh = 8 + ((nw - 2048) >> 6);
  int vrow = -1;
  if (nw >= 512 && nw < 768) vrow = nw - 512;
  else if (nw >= 1280 && nw < 1536) vrow = 256 + nw - 1280;
  else if (nw >= 2176) vrow = 512 + nw - 2176;
#pragma unroll
  for (int yi = 0; yi < 4; ++yi) {
    const int m = m0 + wy * 64 + yi * 16 + r;
    const int t = (m - NPTOK) & 1023;
    const int prow = t >> 6, pcol = t & 63;
#pragma unroll
    for (int xi = 0; xi < 4; ++xi) {
      f32x4 v = acc[xi][yi];
      if (ropeMode == 1) {
        const int pos = (xi & 1) ? pcol : prow;
        const float4 cs = *(const float4*)(p.ropeD + pos * 8 + 4 * (g & 1));
        const float4 sn = *(const float4*)(p.ropeD + 512 + pos * 8 + 4 * (g & 1));
        const float sg = (g >= 2) ? 1.f : -1.f;
        const float o0 = __shfl_xor(v[0], 32), o1 = __shfl_xor(v[1], 32), o2 = __shfl_xor(v[2], 32), o3 = __shfl_xor(v[3], 32);
        v[0] = v[0] * cs.x + sg * o0 * sn.x; v[1] = v[1] * cs.y + sg * o1 * sn.y;
        v[2] = v[2] * cs.z + sg * o2 * sn.z; v[3] = v[3] * cs.w + sg * o3 * sn.w;
      } else if (ropeMode == 2) {
        const int pos = (xi >> 1) ? pcol : prow;
        const float4 cs = *(const float4*)(p.ropeS + pos * 16 + 4 * g);
        const float4 sn = *(const float4*)(p.ropeS + 1024 + pos * 16 + 4 * g);
        const f32x4 o = acc[xi ^ 1][yi];
        const float sg = (xi & 1) ? 1.f : -1.f;
        v[0] = v[0] * cs.x + sg * o[0] * sn.x; v[1] = v[1] * cs.y + sg * o[1] * sn.y;
        v[2] = v[2] * cs.z + sg * o[2] * sn.z; v[3] = v[3] * cs.w + sg * o[3] * sn.w;
      }
      const int nloc = xi * 16 + 4 * g;
      if (okv) {
        const int b = m >> 8, pos = m & 255;
        float4 o4; o4.x = v[0]; o4.y = v[1]; o4.z = v[2]; o4.w = v[3];
        *(float4*)(okv + ((size_t)((b * 4 + l) * 256 + pos)) * okv_w + okv_c + nloc) = o4;
      }
      if (vrow >= 0) {
        u16* vb = p.vfr + ((size_t)((vrow >> 6) * 192 + (m >> 5))) * 2048;
#pragma unroll
        for (int i = 0; i < 4; ++i) vb[vfrag_off(m & 31, nloc + i)] = f2bf(v[i]);
      } else if (khh >= 0) {
        uint2 w; w.x = pack2(v[0], v[1]); w.y = pack2(v[2], v[3]);
        *(uint2*)(p.kfr + ((size_t)(khh * 192 + (m >> 5))) * 2048 + kfrag_off(m & 31, nloc)) = w;
      } else {
        uint2 w; w.x = pack2(v[0], v[1]); w.y = pack2(v[2], v[3]);
        *(uint2*)(p.z + (size_t)m * INW + nw + nloc) = w;
      }
    }
  }
}

__device__ void res_tile(const Params& p, int l, int tx, int ty, const u16* A, const u16* WT, int K, int gi, u16* smem, bool first = false) {
  const int n0 = tx * 128, m0 = ty * 96;
  f32x4 acc[4][3];
  gemm_main<3>(WT + (size_t)n0 * K, K, A + (size_t)m0 * K, K, K, smem, acc);
  const int lane = otid() & 63, wave = otid() >> 6, wx = wave & 1, wy = wave >> 1, r = lane & 15, g = lane >> 4;
#pragma unroll
  for (int yi = 0; yi < 3; ++yi) {
    const int m = m0 + wy * 48 + yi * 16 + r;
    const int cond = m < NPTOK ? 0 : 1 + ((m - NPTOK) >> 10);
    const float* gate = p.mods + (size_t)(l * 3 + cond) * 6144 + gi * 1024;
    float* xrow = p.xres + (size_t)m * 1024;
    const float* xin = first ? (m < NPTOK ? p.x_prompt + (size_t)m * 1024 : p.x_sample + (size_t)(m - NPTOK) * 1024) : xrow;
    float4 xv[4], gt[4];
#pragma unroll
    for (int xi = 0; xi < 4; ++xi) {
      const int n = n0 + wx * 64 + xi * 16 + 4 * g;
      xv[xi] = *(const float4*)(xin + n);
      gt[xi] = *(const float4*)(gate + n);
    }
#pragma unroll
    for (int xi = 0; xi < 4; ++xi) {
      const int n = n0 + wx * 64 + xi * 16 + 4 * g;
      const f32x4 v = acc[xi][yi];
      float4 o = xv[xi];
      o.x += gt[xi].x * v[0]; o.y += gt[xi].y * v[1]; o.z += gt[xi].z * v[2]; o.w += gt[xi].w * v[3];
      *(float4*)(xrow + n) = o;
    }
  }
}

__device__ void m1_tile(const Params& p, int l, int tx, int ty, u16* smem) {
  const int n0 = tx * 128, m0 = ty * 128;
  f32x4 acc[4][4];
  gemm_main<4>(p.w1T + (size_t)l * 4096 * 1024 + (size_t)n0 * 1024, 1024, p.h + (size_t)m0 * 1024, 1024, 1024, smem, acc);
  const int lane = otid() & 63, wave = otid() >> 6, wx = wave & 1, wy = wave >> 1, r = lane & 15, g = lane >> 4;
#pragma unroll
  for (int xi = 0; xi < 4; ++xi) {
    const int n = n0 + wx * 64 + xi * 16 + 4 * g;
#pragma unroll
    for (int yi = 0; yi < 4; ++yi) {
      const int m = m0 + wy * 64 + yi * 16 + r;
      const f32x4 v = acc[xi][yi];
      float a0 = fmaxf(v[0], 0.f), a1 = fmaxf(v[1], 0.f), a2 = fmaxf(v[2], 0.f), a3 = fmaxf(v[3], 0.f);
      uint2 w; w.x = pack2(a0 * a0, a1 * a1); w.y = pack2(a2 * a2, a3 * a3);
      *(uint2*)(p.u + (size_t)m * 4096 + n) = w;
    }
  }
}

__device__ void f1_tile(const Params& p, int l, int it, u16* smem) {
  const int tx = it % 48, ty = it / 48;
  const int x0 = tx * 128, y0 = ty * 128;
  f32x4 acc[4][4];
  gemm_main<4>(p.z + (size_t)x0 * INW + 1536, INW, p.pqt + (size_t)l * 512 * 256 + (size_t)y0 * 256, 256, 256, smem, acc);
  const int lane = otid() & 63, wave = otid() >> 6, wx = wave & 1, wy = wave >> 1, r = lane & 15, g = lane >> 4;
#pragma unroll
  for (int yi = 0; yi < 4; ++yi) {
    const int y = y0 + wy * 64 + yi * 16 + r;
    const int col = y & 255, which = y >> 8;
#pragma unroll
    for (int xi = 0; xi < 4; ++xi) {
      const int tok = x0 + wx * 64 + xi * 16 + 4 * g;
      size_t addr;
      if (tok < NPTOK) {
        const int b = tok >> 8, pos = tok & 255;
        addr = (size_t)b * (256 * 512) + (size_t)col * 512 + which * 256 + pos;
      } else {
        const int b = (tok - NPTOK) >> 10, pos = (tok - NPTOK) & 1023;
        addr = (size_t)16 * 256 * 512 + (size_t)b * (256 * 2048) + (size_t)col * 2048 + which * 1024 + pos;
      }
      const f32x4 v = acc[xi][yi];
      uint2 w; w.x = pack2(v[0], v[1]); w.y = pack2(v[2], v[3]);
      *(uint2*)(p.uv + addr) = w;
    }
  }
  asm volatile("s_waitcnt vmcnt(0)" ::: "memory");
  __syncthreads();
  if (threadIdx.x == 0) {
    __builtin_amdgcn_fence(__ATOMIC_RELEASE, "agent");
    asm volatile("s_waitcnt vmcnt(0)" ::: "memory");
    xb_add(p.bar + XCD_BAR_WORDS + (8 + l) * 64, 1u);
  }
}

__device__ void f2_tile(const Params& p, int l, int it, u16* smem) {
  if (threadIdx.x == 0) {
    unsigned* c = p.bar + XCD_BAR_WORDS + (8 + l) * 64;
    unsigned sp = 0;
    while (xb_ld(c) < 192u) { __builtin_amdgcn_s_sleep(2); if (++sp > (1u << 24)) break; }
    __builtin_amdgcn_fence(__ATOMIC_ACQUIRE, "agent");
    asm volatile("s_waitcnt vmcnt(0)" ::: "memory");
  }
  __syncthreads();
  int L, b, tx, ty, tokbase;
  const u16* uvb; const u16* dft;
  if (it < 32) { L = 1024; b = it >> 4; tx = (it >> 3) & 1; ty = it & 7; uvb = p.uv + (size_t)16 * 256 * 512 + (size_t)b * (256 * 2048); dft = p.dft1024; tokbase = NPTOK + b * 1024; }
  else { it -= 32; L = 256; b = it >> 2; tx = (it >> 1) & 1; ty = it & 1; uvb = p.uv + (size_t)b * (256 * 512); dft = p.dft256; tokbase = b * 256; }
  const int x0 = tx * 128, y0 = ty * 128, K = 2 * L;
  f32x4 acc[4][4];
  gemm_main<4>(uvb + (size_t)x0 * K, K, dft + (size_t)y0 * K, K, K, smem, acc);
  const int lane = otid() & 63, wave = otid() >> 6, wx = wave & 1, wy = wave >> 1, r = lane & 15, g = lane >> 4;
  const float scale = rsqrtf(64.f * (float)L);
#pragma unroll
  for (int yi = 0; yi < 4; ++yi) {
    const int pos = y0 + wy * 64 + yi * 16 + r;
#pragma unroll
    for (int xi = 0; xi < 4; ++xi) {
      const int col = x0 + wx * 64 + xi * 16 + 4 * g;
      const f32x4 v = acc[xi][yi];
      uint2 w; w.x = pack2(v[0] * scale, v[1] * scale); w.y = pack2(v[2] * scale, v[3] * scale);
      *(uint2*)(p.cat + (size_t)(tokbase + pos) * 1024 + 512 + col) = w;
    }
  }
}

struct Seg { const u16* K; const u16* Vt; int ldk, ldv, nblk, pos0, stride; };
#define KLOC(hh, tokb) (p.kfr + ((size_t)((hh) * 192 + ((tokb) >> 5))) * 2048)
#define VLOC(hh, tokb) (p.vfr + ((size_t)((hh) * 192 + ((tokb) >> 5))) * 2048)
template <int QT> struct AState { float m[QT]; float ls[QT]; f32x4 o[QT][4]; };

__device__ __forceinline__ bf16x8 as_bf(u32x4 v) { union { u32x4 u; bf16x8 b; } x; x.u = v; return x.b; }

template <int DC>
__device__ __forceinline__ void issue_blk(const Seg& s0, const Seg& s1, int b, int r, int g, u32x4 (&kf)[2][DC], u32x4 (&vf)[4]) {
  const bool in0 = b < s0.nblk;
  const u16* Kp = in0 ? s0.K : s1.K;
  const u16* Vp = in0 ? s0.Vt : s1.Vt;
  const int pos = in0 ? (s0.pos0 + b * s0.stride) : (s1.pos0 + (b - s0.nblk) * s1.stride);
  const int lane8 = (g * 16 + r) * 8;
  const u16* kp = Kp + (size_t)(pos >> 5) * 2048 + lane8;
  const u16* vp = Vp + (size_t)(pos >> 5) * 2048 + lane8;
#pragma unroll
  for (int t = 0; t < 2; ++t)
#pragma unroll
    for (int dc = 0; dc < DC; ++dc) gload16(kf[t][dc], kp + (t * 2 + dc) * 512);
#pragma unroll
  for (int dv = 0; dv < 4; ++dv) gload16(vf[dv], vp + dv * 512);
}
template <int N>
__device__ __forceinline__ void wait_blk(u32x4 (&kf)[2][1], u32x4 (&vf)[4]) {
  asm volatile("s_waitcnt vmcnt(%6)" : "+v"(kf[0][0]), "+v"(kf[1][0]), "+v"(vf[0]), "+v"(vf[1]), "+v"(vf[2]), "+v"(vf[3]) : "n"(N) : "memory");
}
template <int N>
__device__ __forceinline__ void wait_blk(u32x4 (&kf)[2][2], u32x4 (&vf)[4]) {
  asm volatile("s_waitcnt vmcnt(%8)" : "+v"(kf[0][0]), "+v"(kf[0][1]), "+v"(kf[1][0]), "+v"(kf[1][1]), "+v"(vf[0]), "+v"(vf[1]), "+v"(vf[2]), "+v"(vf[3]) : "n"(N) : "memory");
}

template <int D, int QT, int MODE>
__device__ __forceinline__ void attn_compute(const u32x4 (&kc)[2][D / 32], const u32x4 (&vc)[4], const bf16x8 (&qf)[QT][D / 32], const float sc,
                                             AState<QT>& st, const bool in0, const int pos, const int qpos0, const float* __restrict__ rpb_h,
                                             const int r, const int g) {
  constexpr int DC = D / 32;
#pragma unroll
  for (int q = 0; q < QT; ++q) {
    f32x4 s_[2];
    s_[0] = (f32x4){0.f, 0.f, 0.f, 0.f};
    s_[1] = (f32x4){0.f, 0.f, 0.f, 0.f};
#pragma unroll
    for (int t = 0; t < 2; ++t)
#pragma unroll
      for (int dc = 0; dc < DC; ++dc) s_[t] = __builtin_amdgcn_mfma_f32_16x16x32_bf16(as_bf(kc[t][dc]), qf[q][dc], s_[t], 0, 0, 0);
    float sv[8];
#pragma unroll
    for (int t = 0; t < 2; ++t)
#pragma unroll
      for (int i = 0; i < 4; ++i) {
        float x = s_[t][i] * sc;
        if (MODE == 1) {
          if (!in0) {
            const int qpos = qpos0 + q * 16 + r;
            const int qrow = qpos >> 6, cq = qpos & 63;
            const int kpos = pos + 8 * g + 4 * t + i;
            const int krow = kpos >> 6, ck = kpos & 63;
            const int cs = min(max(cq - 8, 0), 48);
            const bool valid = (ck >= cs) && (ck < cs + 16);
            const int bi = (krow - qrow + 7) * 31 + (ck - cq + 15);
            const float bias = rpb_h[valid ? bi : 0];
            x = valid ? (x + bias) : -1e30f;
          }
        } else if (MODE == 2) {
          if (!in0) {
            const int qpos = qpos0 + q * 16 + r;
            const int kpos = pos + 8 * g + 4 * t + i;
            const int d = qpos - kpos;
            x = (d <= 128 && d >= -128) ? x : -1e30f;
          }
        }
        sv[4 * t + i] = x;
      }
    float mx = fmaxf(fmaxf(fmaxf(sv[0], sv[1]), fmaxf(sv[2], sv[3])), fmaxf(fmaxf(sv[4], sv[5]), fmaxf(sv[6], sv[7])));
    mx = fmaxf(mx, __shfl_xor(mx, 16));
    mx = fmaxf(mx, __shfl_xor(mx, 32));
    const float mnew = fmaxf(st.m[q], mx);
    const float alpha = __builtin_amdgcn_exp2f(st.m[q] - mnew);
    st.m[q] = mnew;
    float ps = 0.f;
#pragma unroll
    for (int j = 0; j < 8; ++j) { sv[j] = __builtin_amdgcn_exp2f(sv[j] - mnew); ps += sv[j]; }
    st.ls[q] = st.ls[q] * alpha + ps;
    union { bf16x8 v; unsigned w[4]; } pf;
    pf.w[0] = pack2(sv[0], sv[1]); pf.w[1] = pack2(sv[2], sv[3]); pf.w[2] = pack2(sv[4], sv[5]); pf.w[3] = pack2(sv[6], sv[7]);
#pragma unroll
    for (int dv = 0; dv < 4; ++dv) {
      f32x4 o = st.o[q][dv];
      o[0] *= alpha; o[1] *= alpha; o[2] *= alpha; o[3] *= alpha;
      st.o[q][dv] = __builtin_amdgcn_mfma_f32_16x16x32_bf16(as_bf(vc[dv]), pf.v, o, 0, 0, 0);
    }
  }
}

template <int D, int QT, int MODE, int NQ = 2>
__device__ __forceinline__ void attn_run(const Seg& s0, const Seg& s1, const bf16x8 (&qf)[QT][D / 32], const float sc,
                                         AState<QT>& st, const int qpos0, const float* __restrict__ rpb_h, const int bb = 0, const int be = -1) {
  constexpr int DC = D / 32;
  constexpr int NL = 2 * DC + 4;
  const int lane = otid() & 63, r = lane & 15, g = lane >> 4;
  const int nb = be < 0 ? s0.nblk + s1.nblk : be;
  u32x4 kq[NQ][2][DC], vq[NQ][4];
#pragma unroll
  for (int q = 0; q < QT; ++q)
#pragma unroll
    for (int dc = 0; dc < DC; ++dc) asm volatile("" ::"v"(qf[q][dc]));
  asm volatile("s_waitcnt vmcnt(0)" ::: "memory");
#pragma unroll 1
  for (int b = bb; b < nb; b += NQ) {
#pragma unroll
    for (int j = 0; j < NQ; ++j) issue_blk<DC>(s0, s1, b + j, r, g, kq[j], vq[j]);
#pragma unroll
    for (int j = 0; j < NQ; ++j) {
      if (j == 0) wait_blk<(NQ - 1) * NL>(kq[j], vq[j]);
      else if (j == 1) wait_blk<(NQ - 2) * NL>(kq[j], vq[j]);
      else if (j == 2) wait_blk<(NQ > 3 ? (NQ - 3) * NL : 0)>(kq[j], vq[j]);
      else wait_blk<0>(kq[j], vq[j]);
      const int bj = b + j;
      const bool in0 = bj < s0.nblk;
      const int pos = in0 ? (s0.pos0 + bj * s0.stride) : (s1.pos0 + (bj - s0.nblk) * s1.stride);
      attn_compute<D, QT, MODE>(kq[j], vq[j], qf, sc, st, in0, pos, qpos0, rpb_h, r, g);
    }
  }
}

template <int QT>
__device__ __forceinline__ void astate_init(AState<QT>& st, float m0, float l0) {
#pragma unroll
  for (int q = 0; q < QT; ++q) {
    st.m[q] = m0; st.ls[q] = l0;
#pragma unroll
    for (int dv = 0; dv < 4; ++dv) st.o[q][dv] = (f32x4){0.f, 0.f, 0.f, 0.f};
  }
}
template <int QT>
__device__ __forceinline__ void astate_finalize(AState<QT>& st) {
#pragma unroll
  for (int q = 0; q < QT; ++q) {
    float l = st.ls[q];
    l += __shfl_xor(l, 16);
    l += __shfl_xor(l, 32);
    const float inv = 1.f / l;
#pragma unroll
    for (int dv = 0; dv < 4; ++dv) { st.o[q][dv][0] *= inv; st.o[q][dv][1] *= inv; st.o[q][dv][2] *= inv; st.o[q][dv][3] *= inv; }
  }
}
template <int DC, int QT>
__device__ __forceinline__ void load_q(const u16* zq  , bf16x8 (&qf)[QT][DC]) {
  const int lane = otid() & 63, r = lane & 15, g = lane >> 4;
#pragma unroll
  for (int q = 0; q < QT; ++q)
#pragma unroll
    for (int dc = 0; dc < DC; ++dc) qf[q][dc] = *(const bf16x8*)(zq + (size_t)(q * 16 + r) * INW + dc * 32 + g * 8);
}
template <int QT>
__device__ __forceinline__ void write_o(const Params& p, const AState<QT>& st, int tok0, int col0) {
  const int lane = otid() & 63, r = lane & 15, g = lane >> 4;
#pragma unroll
  for (int q = 0; q < QT; ++q)
#pragma unroll
    for (int dv = 0; dv < 4; ++dv) {
      const f32x4 v = st.o[q][dv];
      uint2 w; w.x = pack2(v[0], v[1]); w.y = pack2(v[2], v[3]);
      *(uint2*)(p.cat + (size_t)(tok0 + q * 16 + r) * 1024 + col0 + dv * 16 + 4 * g) = w;
    }
}

__device__ __forceinline__ float diff_lambda(const Params& p, int l, float lam_init) {
  const int lane = otid() & 63;
  float a = 0.f, b = 0.f;
  if (lane < 32) { a = p.lq1[l * 32 + lane] * p.lk1[l * 32 + lane]; b = p.lq2[l * 32 + lane] * p.lk2[l * 32 + lane]; }
#pragma unroll
  for (int o = 32; o >= 1; o >>= 1) { a += __shfl_xor(a, o); b += __shfl_xor(b, o); }
  return expf(a) - expf(b) + lam_init;
}

__device__ __forceinline__ void diff_finish_q(const Params& p, int l, float lam, float lam_init, f32x4 (&A)[4], const f32x4 (&B)[4], int tokrow0, int col0) {
  const int lane = otid() & 63, r = lane & 15, g = lane >> 4;
  const float* sg = p.subln_g + l * 64;
  float ss = 0.f;
#pragma unroll
  for (int dv = 0; dv < 4; ++dv)
#pragma unroll
    for (int i = 0; i < 4; ++i) {
      const float v = A[dv][i] - lam * B[dv][i];
      A[dv][i] = v;
      ss += v * v;
    }
  ss += __shfl_xor(ss, 16);
  ss += __shfl_xor(ss, 32);
  const float rs = rsqrtf(ss * (1.f / 64.f) + 1e-6f) * (1.f - lam_init);
#pragma unroll
  for (int dv = 0; dv < 4; ++dv) {
    const float4 gg = *(const float4*)(sg + dv * 16 + 4 * g);
    uint2 w;
    w.x = pack2(A[dv][0] * rs * gg.x, A[dv][1] * rs * gg.y);
    w.y = pack2(A[dv][2] * rs * gg.z, A[dv][3] * rs * gg.w);
    *(uint2*)(p.cat + (size_t)(tokrow0 + r) * 1024 + col0 + dv * 16 + 4 * g) = w;
  }
}

#ifndef AQT
#define AQT 2
#endif
#define QW (16 * AQT)
#define NQG_CTX (256 / QW)
#define NQG_LAT (1024 / QW)
__device__ void attn_diff_item(const Params& p, int l, bool lat, int bi, float* sm) {
  const int wave = otid() >> 6, lane = otid() & 63, r = lane & 15, g = lane >> 4;
  const int ps = wave >> 1, half = wave & 1;
  int b, h, qg, tokb;
  if (lat) { b = bi / (4 * NQG_LAT); h = (bi / NQG_LAT) & 3; qg = bi % NQG_LAT; tokb = NPTOK + b * 1024; }
  else { b = bi / (4 * NQG_CTX); h = (bi / NQG_CTX) & 3; qg = bi % NQG_CTX; tokb = b * 256; }
  const int tok0 = tokb + qg * QW;
  const u16* zb = p.z + (size_t)tokb * INW;
  Seg s0, s1;
  if (lat) {
    const int bl = b * 4 + l;
    s0.K = p.ck_diff + (size_t)((bl * 4 + h) * 16) * 2048 + ps * 512; s0.Vt = p.cvt_diff + (size_t)((bl * 4 + h) * 16) * 2048;
    s0.ldk = 0; s0.ldv = 0; s0.nblk = half ? 0 : 16; s0.pos0 = 0; s0.stride = 32;
    s1.K = KLOC(4 + h, tokb) + ps * 512; s1.Vt = VLOC(4 + h, tokb);
    s1.ldk = 0; s1.ldv = 0; s1.nblk = half ? 24 : 8; s1.pos0 = half ? 256 : 0; s1.stride = 32;
  } else {
    s0.K = KLOC(4 + h, tokb) + ps * 512; s0.Vt = VLOC(4 + h, tokb);
    s0.ldk = 0; s0.ldv = 0; s0.nblk = 4; s0.pos0 = half ? 128 : 0; s0.stride = 32;
    s1 = s0; s1.nblk = 0;
  }
  bf16x8 qf[AQT][1];
  load_q<1, AQT>(p.z + (size_t)tok0 * INW + 768 + h * 64 + ps * 32, qf);
  AState<AQT> st;
  astate_init<AQT>(st, -1e30f, 0.f);
  attn_run<32, AQT, 0, 2>(s0, s1, qf, 0.17677669529663687f * LOG2E, st, 0, nullptr);
  float lt[AQT];
#pragma unroll
  for (int q = 0; q < AQT; ++q) {
    lt[q] = st.ls[q];
    lt[q] += __shfl_xor(lt[q], 16);
    lt[q] += __shfl_xor(lt[q], 32);
  }
  constexpr int WS = 64 * 16 * AQT;
  float* pm = sm + 4 * WS;
  if (wave != 0) {
    float* po = sm + wave * WS + lane * (16 * AQT);
#pragma unroll
    for (int q = 0; q < AQT; ++q) {
#pragma unroll
      for (int dv = 0; dv < 4; ++dv) *(f32x4*)(po + q * 16 + dv * 4) = st.o[q][dv];
      if (g == 0) { pm[wave * QW + q * 16 + r] = st.m[q]; pm[4 * QW + wave * QW + q * 16 + r] = lt[q]; }
    }
  }
  __syncthreads();
  if (wave == 0) {
    const float lam_init = 0.8f - 0.6f * expf(-0.3f * (float)l);
    const float lam = diff_lambda(p, l, lam_init);
#pragma unroll
    for (int q = 0; q < AQT; ++q) {
      f32x4 A[4], B[4];
      {
        const float m1 = pm[QW + q * 16 + r], l1 = pm[4 * QW + QW + q * 16 + r];
        const float M = fmaxf(st.m[q], m1);
        const float a0 = exp2f(st.m[q] - M), a1 = exp2f(m1 - M);
        const float inv = 1.f / (lt[q] * a0 + l1 * a1);
#pragma unroll
        for (int dv = 0; dv < 4; ++dv) {
          const f32x4 o1 = *(const f32x4*)(sm + 1 * WS + lane * (16 * AQT) + q * 16 + dv * 4);
          A[dv] = (st.o[q][dv] * a0 + o1 * a1) * inv;
        }
      }
      {
        const float m2 = pm[2 * QW + q * 16 + r], l2 = pm[4 * QW + 2 * QW + q * 16 + r], m3 = pm[3 * QW + q * 16 + r], l3 = pm[4 * QW + 3 * QW + q * 16 + r];
        const float M = fmaxf(m2, m3);
        const float a2 = exp2f(m2 - M), a3 = exp2f(m3 - M);
        const float inv = 1.f / (l2 * a2 + l3 * a3);
#pragma unroll
        for (int dv = 0; dv < 4; ++dv) {
          const f32x4 o2 = *(const f32x4*)(sm + 2 * WS + lane * (16 * AQT) + q * 16 + dv * 4);
          const f32x4 o3 = *(const f32x4*)(sm + 3 * WS + lane * (16 * AQT) + q * 16 + dv * 4);
          B[dv] = (o2 * a2 + o3 * a3) * inv;
        }
      }
      diff_finish_q(p, l, lam, lam_init, A, B, tok0 + q * 16, 256 + h * 64);
    }
  }
  __syncthreads();
}

__device__ void attn_ctx_item(const Params& p, int l, int bi) {
  const int wave = otid() >> 6, lane = otid() & 63, g = lane >> 4;
  const int w = bi * 4 + wave;
  const int type = w / (64 * NQG_CTX), rem = w % (64 * NQG_CTX);
  const int b = rem / (4 * NQG_CTX), h = (rem / NQG_CTX) & 3, qg = rem % NQG_CTX;
  const int tokb = b * 256, tok0 = tokb + qg * QW;
  const u16* zb = p.z + (size_t)tokb * INW;
  const int kvh = h >> 1;
  const int qcol = type == 0 ? h * 64 : 1792 + h * 64;
  const int kcol = type == 0 ? 256 + h * 64 : 2048 + kvh * 64;
  const int vrow = type == 0 ? h * 64 : 512 + kvh * 64;
  const int ocol = type == 0 ? h * 64 : 768 + h * 64;
  bf16x8 qf[AQT][2];
  load_q<2, AQT>(p.z + (size_t)tok0 * INW + qcol, qf);
  const int hslot = type == 0 ? h : 8 + kvh;
  Seg s0; s0.K = KLOC(hslot, tokb); s0.Vt = VLOC(hslot, tokb); s0.ldk = 0; s0.ldv = 0; s0.nblk = 8; s0.pos0 = 0; s0.stride = 32;
  Seg sN = s0; sN.nblk = 0;
  AState<AQT> st;
  const float sk = type == 0 ? -1e30f : p.swa_sink[l * 4 + h] * LOG2E;
  astate_init<AQT>(st, sk, (type == 1 && g == 0) ? 1.f : 0.f);
  attn_run<64, AQT, 0, 2>(s0, sN, qf, 0.125f * LOG2E, st, 0, nullptr);
  astate_finalize<AQT>(st);
  write_o<AQT>(p, st, tok0, ocol);
}

__device__ void attn_lat_item(const Params& p, int l, int bi, float* sm) {
  const int wave = otid() >> 6, lane = otid() & 63, r = lane & 15, g = lane >> 4;
  const int type = bi / (8 * NQG_LAT), rem = bi % (8 * NQG_LAT);
  const int b = rem / (4 * NQG_LAT), h = (rem / NQG_LAT) & 3, qg = rem % NQG_LAT;
  const int q0 = qg * QW;
  const int tokb = NPTOK + b * 1024, tok0 = tokb + q0;
  const u16* zb = p.z + (size_t)tokb * INW;
  const int bl = b * 4 + l;
  AState<AQT> st;
  int ocol;
  if (type != 0) {
    const float* rp = p.na_rpb + (size_t)(l * 4 + h) * 15 * 31;
    for (int e = otid(); e < 465; e += 256) sm[9000 + e] = rp[e] * LOG2E;
    __syncthreads();
  }
  if (type == 0) {
    const int kvh = h >> 1;
    bf16x8 qf[AQT][2];
    load_q<2, AQT>(p.z + (size_t)tok0 * INW + 1792 + h * 64, qf);
    Seg s0; s0.K = p.ck_swa + (size_t)((bl * 2 + kvh) * 16) * 2048; s0.Vt = p.cvt_swa + (size_t)((bl * 2 + kvh) * 16) * 2048; s0.ldk = 0; s0.ldv = 0; s0.nblk = 16; s0.pos0 = 0; s0.stride = 32;
    const int lo = max(0, q0 - 128) & ~31;
    const int hi = min(1024, ((q0 + QW + 128) + 31) & ~31);
    int lo2 = lo, cnt = (hi - lo) >> 5;
    if (cnt & 1) { if (lo2 > 0) lo2 -= 32; ++cnt; }
    Seg s1; s1.K = KLOC(8 + kvh, tokb); s1.Vt = VLOC(8 + kvh, tokb); s1.ldk = 0; s1.ldv = 0; s1.nblk = cnt; s1.pos0 = lo2; s1.stride = 32;
    const int P = (16 + cnt) >> 1;
    const int pb = (wave * P) >> 2, pe = ((wave + 1) * P) >> 2;
    astate_init<AQT>(st, wave == 0 ? p.swa_sink[l * 4 + h] * LOG2E : -1e30f, (wave == 0 && g == 0) ? 1.f : 0.f);
    attn_run<64, AQT, 2>(s0, s1, qf, 0.125f * LOG2E, st, q0, nullptr, 2 * pb, 2 * pe);
    ocol = 768 + h * 64;
  } else {
    bf16x8 qf[AQT][2];
    load_q<2, AQT>(p.z + (size_t)tok0 * INW + h * 64, qf);
    Seg s0; s0.K = p.ck_na + (size_t)((bl * 4 + h) * 16) * 2048; s0.Vt = p.cvt_na + (size_t)((bl * 4 + h) * 16) * 2048; s0.ldk = 0; s0.ldv = 0; s0.nblk = 16; s0.pos0 = 0; s0.stride = 32;
    const int qrow = q0 >> 6;
    const int rstart = min(max(qrow - 4, 0), 8);
    Seg s1; s1.K = KLOC(h, tokb); s1.Vt = VLOC(h, tokb); s1.ldk = 0; s1.ldv = 0; s1.nblk = 16; s1.pos0 = rstart * 64; s1.stride = 32;
    astate_init<AQT>(st, -1e30f, 0.f);
    attn_run<64, AQT, 1, 2>(s0, s1, qf, 0.125f * LOG2E, st, q0, sm + 9000, 8 * wave, 8 * wave + 8);
    ocol = h * 64;
  }
  float lt[AQT];
#pragma unroll
  for (int q = 0; q < AQT; ++q) {
    lt[q] = st.ls[q];
    lt[q] += __shfl_xor(lt[q], 16);
    lt[q] += __shfl_xor(lt[q], 32);
  }
  constexpr int WS = 64 * 16 * AQT;
  float* pm = sm + 4 * WS;
  if (wave != 0) {
    float* po = sm + wave * WS + lane * (16 * AQT);
#pragma unroll
    for (int q = 0; q < AQT; ++q) {
#pragma unroll
      for (int dv = 0; dv < 4; ++dv) *(f32x4*)(po + q * 16 + dv * 4) = st.o[q][dv];
      if (g == 0) { pm[wave * QW + q * 16 + r] = st.m[q]; pm[4 * QW + wave * QW + q * 16 + r] = lt[q]; }
    }
  }
  __syncthreads();
  if (wave == 0) {
#pragma unroll
    for (int q = 0; q < AQT; ++q) {
      const float m1 = pm[1 * QW + q * 16 + r], m2 = pm[2 * QW + q * 16 + r], m3 = pm[3 * QW + q * 16 + r];
      const float l1 = pm[4 * QW + 1 * QW + q * 16 + r], l2 = pm[4 * QW + 2 * QW + q * 16 + r], l3 = pm[4 * QW + 3 * QW + q * 16 + r];
      const float M = fmaxf(fmaxf(st.m[q], m1), fmaxf(m2, m3));
      const float a0 = __builtin_amdgcn_exp2f(st.m[q] - M), a1 = __builtin_amdgcn_exp2f(m1 - M), a2 = __builtin_amdgcn_exp2f(m2 - M), a3 = __builtin_amdgcn_exp2f(m3 - M);
      const float inv = 1.f / (lt[q] * a0 + l1 * a1 + l2 * a2 + l3 * a3);
#pragma unroll
      for (int dv = 0; dv < 4; ++dv) {
        const f32x4 o1 = *(const f32x4*)(sm + 1 * WS + lane * (16 * AQT) + q * 16 + dv * 4);
        const f32x4 o2 = *(const f32x4*)(sm + 2 * WS + lane * (16 * AQT) + q * 16 + dv * 4);
        const f32x4 o3 = *(const f32x4*)(sm + 3 * WS + lane * (16 * AQT) + q * 16 + dv * 4);
        st.o[q][dv] = (st.o[q][dv] * a0 + o1 * a1 + o2 * a2 + o3 * a3) * inv;
      }
    }
    write_o<AQT>(p, st, tok0, ocol);
  }
  __syncthreads();
}

__device__ __forceinline__ int q_next(unsigned* cnt, volatile LAS unsigned* slot) {
  __syncthreads();
  if (threadIdx.x == 0) *slot = xb_add(cnt, 1u);
  __syncthreads();
  return (int)*slot;
}

#if REP_SYNC
#define GSYNC() do { xcd_barrier(xb); xcd_barrier(xb); } while (0)
#else
#define GSYNC() xcd_barrier(xb)
#endif
__global__ void __launch_bounds__(256, 2) mega(Params p) {
  extern __shared__ __attribute__((aligned(16))) unsigned char smem[];
  cg::grid_group grid = cg::this_grid();
  const int nblk = gridDim.x, bid = blockIdx.x;
  u16* sm16 = (u16*)smem;
  __shared__ uint4 xb_words[2];
  if (threadIdx.x == 0) { xb_words[0] = make_uint4(0u, 0u, 0u, 0u); xb_words[1] = make_uint4(0u, 0u, 0u, 0u); }
  __syncthreads();
  XcdBarrier xb = xcd_barrier_post(p.bar, (volatile LAS unsigned*)&xb_words[0]);

  for (int rep = 0; rep <= REP_P0; ++rep)
    for (int it = bid; it < P0_ITEMS; it += nblk) p0_item(p, it, smem);
  if (p.use_cg_sync) grid.sync();
  GSYNC();

  const int xcc = (int)xb.x;
  const int xrank = __builtin_amdgcn_readfirstlane((int)xb.st[4]), xnloc = __builtin_amdgcn_readfirstlane((int)xb.st[0]);
  const unsigned topo = (unsigned)__builtin_amdgcn_readfirstlane((int)xb.st[5]);
  const bool local = (topo & 1u) != 0u, full64 = (topo & 2u) != 0u;
#define LSYNC() do { if (local) xcd_barrier_local(xb); else GSYNC(); } while (0)
#define LMAP(j, count, total) (local ? ((xrank + (j) * xnloc) < (count) ? (xrank + (j) * xnloc) : -1) : ((bid + (j) * nblk) < (total) ? (bid + (j) * nblk) : -1))

#pragma unroll 1
  for (int l = 0; l < 4; ++l) {
    for (int j = 0;; ++j) { const int v = LMAP(j, 48, 384); if (v < 0) break; norm_item(p, l, 0, local ? 48 * xcc + v : v); }
    LSYNC();
    for (int j = 0;; ++j) {
      const int v = LMAP(j, 108, 864); if (v < 0) break;
      if (local) gin_tile(p, l, v / 6, 6 * xcc + v % 6, sm16); else gin_tile(p, l, v / 48, v % 48, sm16);
    }
    if (full64) {
      if (xrank >= 44) {
        const int idle = xcc * 20 + (xrank - 44);
        for (int it = 288 + idle; it < 928; it += 160) wt_item(p, l, it, (float*)smem);
      }
    }
    GSYNC();
    {
      constexpr int CD = 64 * NQG_CTX, CC = 2 * 64 * NQG_CTX / 4;
      constexpr int LD = 8 * NQG_LAT, LC = 2 * 8 * NQG_LAT;
      constexpr int E0 = 192, E1 = E0 + LD, E2 = E1 + LC, E3 = E2 + 32, E4 = E3 + CC, E5 = E4 + CD, E6 = E5 + 64;
      unsigned* qc = p.bar + XCD_BAR_WORDS + l * 64;
      const int w0 = full64 ? 928 : 288;
      const int EA = E6 + (1440 - w0), EW = EA + (l < 3 ? 288 : 0);
      for (int it = bid; it < EW; it = nblk + q_next(qc, &xb.st[2])) {
        if (it >= E6) {
          if (it < EA) wt_item(p, l, it - E6 + w0, (float*)smem);
          else wt_item(p, l + 1, it - EA, (float*)smem);
          continue;
        }
        if (it < E0) f1_tile(p, l, it, sm16);
        else if (it < E1) attn_diff_item(p, l, true, it - E0, (float*)smem);
        else if (it < E2) attn_lat_item(p, l, it - E1, (float*)smem);
        else if (it < E3) f2_tile(p, l, it - E2, sm16);
        else if (it < E4) attn_ctx_item(p, l, it - E3);
        else if (it < E5) attn_diff_item(p, l, false, it - E4, (float*)smem);
        else f2_tile(p, l, it - E5 + 32, sm16);
      }
    }
    GSYNC();
    for (int j = 0;; ++j) {
      const int v = LMAP(j, 64, 512); if (v < 0) break;
      if (local) res_tile(p, l, v / 8, 8 * xcc + v % 8, p.cat, p.w_outT + (size_t)l * 1024 * 1024, 1024, 2, sm16, l == 0);
      else res_tile(p, l, v / 64, v % 64, p.cat, p.w_outT + (size_t)l * 1024 * 1024, 1024, 2, sm16, l == 0);
    }
    LSYNC();
    for (int j = 0;; ++j) { const int v = LMAP(j, 48, 384); if (v < 0) break; norm_item(p, l, 1, local ? 48 * xcc + v : v); }
    LSYNC();
    for (int j = 0;; ++j) {
      const int v = LMAP(j, 192, 1536); if (v < 0) break;
      if (local) m1_tile(p, l, v / 6, 6 * xcc + v % 6, sm16); else m1_tile(p, l, v / 48, v % 48, sm16);
    }
    LSYNC();
    for (int j = 0;; ++j) {
      const int v = LMAP(j, 64, 512); if (v < 0) break;
      if (local) res_tile(p, l, v / 8, 8 * xcc + v % 8, p.u, p.w2T + (size_t)l * 1024 * 4096, 4096, 5, sm16);
      else res_tile(p, l, v / 64, v % 64, p.u, p.w2T + (size_t)l * 1024 * 4096, 4096, 5, sm16);
    }
    LSYNC();
  }
  for (int j = 0;; ++j) { const int v = LMAP(j, 48, 384); if (v < 0) break; norm_item(p, 0, 2, local ? 48 * xcc + v : v); }
#undef LSYNC
#undef LMAP
}

extern "C" void kernel_launch(void* const* d_in, const int* in_sizes, int n_in, void* d_out, int out_size, void* d_ws,
                              size_t ws_size, hipStream_t stream) {
  static int grid_blocks = 0;
  if (grid_blocks == 0) {
    int dev = 0, cus = 0, per_cu = 0;
    (void)hipGetDevice(&dev);
    (void)hipDeviceGetAttribute(&cus, hipDeviceAttributeMultiprocessorCount, dev);
    if (hipFuncSetAttribute((const void*)mega, hipFuncAttributeMaxDynamicSharedMemorySize, LDS_BYTES) != hipSuccess) {
      fprintf(stderr, "hipFuncSetAttribute failed\n");
    }
    if (hipOccupancyMaxActiveBlocksPerMultiprocessor(&per_cu, (const void*)mega, 256, LDS_BYTES) != hipSuccess || per_cu < 1) {
      fprintf(stderr, "occupancy query failed (%d)\n", per_cu);
      per_cu = 1;
    }
    if (per_cu > 2) per_cu = 2;
    grid_blocks = cus * per_cu;
    fprintf(stderr, "mega: cus=%d per_cu=%d grid=%d ws=%zu\n", cus, per_cu, grid_blocks, ws_size);
  }
  Params p{};
  const float** pin = (const float**)&p;
  for (int i = 0; i < 27; ++i) pin[i] = (const float*)d_in[i];
  p.out = (float*)d_out;
  unsigned char* ws = (unsigned char*)d_ws;
  size_t off = 0;
  auto take = [&](size_t bytes) { unsigned char* q = ws + off; off += (bytes + 255) & ~(size_t)255; return q; };
  p.xres = (float*)take((size_t)NTOK * 1024 * 4);
  p.mods = (float*)take((size_t)4 * 3 * 6144 * 4);
  p.h = (u16*)take((size_t)NTOK * 1024 * 2);
  p.z = (u16*)take((size_t)NTOK * INW * 2);
  p.vt = (u16*)take((size_t)640 * NTOK * 2);
  p.cat = (u16*)take((size_t)NTOK * 1024 * 2);
  p.u = (u16*)take((size_t)NTOK * 4096 * 2);
  p.uv = (u16*)take((size_t)(16 * 256 * 512 + 2 * 256 * 2048) * 2);
  p.w_inT = (u16*)take((size_t)4 * 2304 * 1024 * 2);
  p.w_outT = (u16*)take((size_t)4 * 1024 * 1024 * 2);
  p.w1T = (u16*)take((size_t)4 * 4096 * 1024 * 2);
  p.w2T = (u16*)take((size_t)4 * 4096 * 1024 * 2);
  p.pqt = (u16*)take((size_t)4 * 512 * 256 * 2);
  p.dft256 = (u16*)take((size_t)256 * 512 * 2);
  p.dft1024 = (u16*)take((size_t)1024 * 2048 * 2);
  p.ck_na = (u16*)take((size_t)2 * 4 * 512 * 256 * 2);
  p.cvt_na = (u16*)take((size_t)2 * 4 * 512 * 256 * 2);
  p.ck_diff = (u16*)take((size_t)2 * 4 * 512 * 256 * 2);
  p.cvt_diff = (u16*)take((size_t)2 * 4 * 512 * 256 * 2);
  p.ck_swa = (u16*)take((size_t)2 * 4 * 512 * 128 * 2);
  p.cvt_swa = (u16*)take((size_t)2 * 4 * 512 * 128 * 2);
  p.kfr = (u16*)take((size_t)10 * 192 * 2048 * 2);
  p.vfr = (u16*)take((size_t)10 * 192 * 2048 * 2);
  p.ropeD = (float*)take(1024 * 4);
  p.ropeS = (float*)take(2048 * 4);
  p.bar = (unsigned*)take(XB_ALL_WORDS * 4);
  if (off > ws_size) { fprintf(stderr, "workspace too small: need %zu have %zu\n", off, ws_size); return; }
  if (hipMemsetAsync(p.bar, 0, XB_ALL_WORDS * 4, stream) != hipSuccess) fprintf(stderr, "memset failed\n");
  void* args[] = {&p};
  hipError_t e = hipLaunchCooperativeKernel((const void*)mega, dim3(grid_blocks), dim3(256), args, LDS_BYTES, stream);
  if (e != hipSuccess) fprintf(stderr, "cooperative launch failed: %s (grid %d)\n", hipGetErrorString(e), grid_blocks);
}
```

```cpp
#include <hip/hip_runtime.h>
#include <hip/hip_cooperative_groups.h>
#include <stdint.h>
#include <stdio.h>
namespace cg = cooperative_groups;

typedef unsigned short u16;
typedef __attribute__((ext_vector_type(8))) short bf16x8;
typedef __attribute__((ext_vector_type(4))) float f32x4;
typedef __attribute__((ext_vector_type(4))) unsigned u32x4;
__device__ __forceinline__ void gload16(u32x4& dst, const void* ptr) {
  asm volatile("global_load_dwordx4 %0, %1, off" : "=v"(dst) : "v"(ptr) : "memory");
}

#define NTOK 6144
#define NPTOK 4096
#define INW 2304
#define LOG2E 1.4426950408889634f
#define LDS_BYTES 73728
#define LSTR 72

#define O_NAK 6291456
#define O_NAV 10485760
#define O_DK 14680064
#define O_DV 18874368
#define O_SK 23068672
#define O_SV 25165824

struct Params {
  const float *x_prompt, *x_sample, *c_na_k, *c_na_v, *c_diff_k, *c_diff_v, *c_swa_k, *c_swa_v, *c, *c_ctx;
  const float *w_ada, *b_ada, *norm1_g, *norm2_g, *w_in, *na_rpb, *lq1, *lk1, *lq2, *lk2, *subln_g, *w_fourier, *swa_sink;
  const float *w_out, *w1, *w2, *final_g;
  float* out;
  float* xres;
  float* mods;
  u16 *h, *z, *vt, *cat, *u, *uv, *w_inT, *w_outT, *w1T, *w2T, *pqt, *dft256, *dft1024;
  u16 *ck_na, *cvt_na, *ck_diff, *cvt_diff, *ck_swa, *cvt_swa;
  float *ropeD, *ropeS;
  u16 *kfr, *vfr;
  unsigned* bar;
  int use_cg_sync;
  int pad_;
};

__device__ __forceinline__ u16 f2bf(float f) {
  unsigned u = __float_as_uint(f);
  u += 0x7fffu + ((u >> 16) & 1u);
  return (u16)(u >> 16);
}
__device__ __forceinline__ int otid() { int t = threadIdx.x; asm volatile("" : "+v"(t)); return t; }
__device__ __forceinline__ float bf2f(u16 h) { return __uint_as_float(((unsigned)h) << 16); }
typedef __attribute__((ext_vector_type(2))) __bf16 hbf16x2;
typedef __attribute__((ext_vector_type(2))) float f32x2;
__device__ __forceinline__ unsigned pack2(float a, float b) {
  f32x2 v = {a, b};
  union { hbf16x2 h; unsigned u; } x;
  x.h = __builtin_convertvector(v, hbf16x2);
  return x.u;
}

__device__ __forceinline__ int kfrag_off(int kk, int d) {
  const int t = (kk >> 2) & 1, r = ((kk >> 3) << 2) | (kk & 3), dc = d >> 5, g = (d >> 3) & 3;
  return ((t * 2 + dc) * 64 + g * 16 + r) * 8 + (d & 7);
}
__device__ __forceinline__ int vfrag_off(int kk, int dv) {
  return (((dv >> 4) * 64) + (kk >> 3) * 16 + (dv & 15)) * 8 + (kk & 7);
}

#define XB_TMO      128
#define XB_XCNT(j)  (256  + 64 * (j))
#define XB_XSUB(j)  (1280 + 64 * (j))
#define XB_XGEN(j)  (2304 + 64 * (j))
#define XB_TOP      3328
#define XB_TOPGEN   3392
#define XCD_BAR_WORDS 3456
#define XB_SPIN_CAP (1u << 22)
#define LAS __attribute__((address_space(3)))
__device__ __forceinline__ unsigned xb_ld(unsigned* p)              { return __hip_atomic_load(p, __ATOMIC_RELAXED, __HIP_MEMORY_SCOPE_AGENT); }
__device__ __forceinline__ unsigned xb_add(unsigned* p, unsigned v) { return __hip_atomic_fetch_add(p, v, __ATOMIC_RELAXED, __HIP_MEMORY_SCOPE_AGENT); }
__device__ __forceinline__ unsigned xb_xcc_id() { return (unsigned)__builtin_amdgcn_s_getreg((3 << 11) | 20) & 0xFu; }
#define XB_SPIN(cond, bar) do { unsigned _sp = 0; while (cond) { __builtin_amdgcn_s_sleep(1); \
    if ((++_sp & 255u) == 0u) { if (xb_ld(&(bar)[XB_TMO])) break; if (_sp > XB_SPIN_CAP) { atomicAdd(&(bar)[XB_TMO], 1u); break; } } } } while (0)
#define XB_LSUB(j)  (XCD_BAR_WORDS + 12 * 64 + 64 * (j))
#define XB_LGEN(j)  (XCD_BAR_WORDS + 12 * 64 + 64 * (16 + (j)))
#define XB_ALL_WORDS (XCD_BAR_WORDS + 12 * 64 + 32 * 64)
struct XcdBarrier { unsigned* bar; unsigned x; volatile LAS unsigned* st; };
__device__ __forceinline__ XcdBarrier xcd_barrier_post(unsigned* bar, volatile LAS unsigned* st) {
  XcdBarrier b; b.bar = bar; b.x = xb_xcc_id(); b.st = st;
  if (threadIdx.x == 0) st[4] = xb_add(&bar[XB_XCNT(b.x)], 1u);
  return b;
}
__device__ __forceinline__ void xcd_barrier_complete(unsigned* bar, unsigned x, unsigned& nloc, unsigned& nx) {
  const unsigned G = gridDim.x * gridDim.y * gridDim.z;
  unsigned sum, cnt, mine, sp = 0u;
  for (;;) {
    sum = 0u; cnt = 0u; mine = 0u;
#pragma unroll
    for (unsigned j = 0; j < 16; ++j) { const unsigned c = xb_ld(&bar[XB_XCNT(j)]); sum += c; cnt += (c > 0u) ? 1u : 0u; mine = (j == x) ? c : mine; }
    if (sum == G) break;
    __builtin_amdgcn_s_sleep(1);
    if ((++sp & 255u) == 0u) { if (xb_ld(&bar[XB_TMO])) break; if (sp > XB_SPIN_CAP) { atomicAdd(&bar[XB_TMO], 1u); break; } }
  }
  nloc = mine > 0u ? mine : 1u; nx = cnt > 0u ? cnt : 1u;
}
__device__ __forceinline__ unsigned xcd_topology(unsigned* bar) {
  const unsigned G = gridDim.x * gridDim.y * gridDim.z;
  unsigned sum8 = 0u, all = 1u, all64 = 1u;
#pragma unroll
  for (unsigned j = 0; j < 8; ++j) { const unsigned c = xb_ld(&bar[XB_XCNT(j)]); sum8 += c; all &= (c > 0u) ? 1u : 0u; all64 &= (c == 64u) ? 1u : 0u; }
  const unsigned ok = (all && sum8 == G) ? 1u : 0u;
  return ok | ((ok && all64) ? 2u : 0u);
}
__device__ __forceinline__ void xcd_barrier(const XcdBarrier& b) {
  asm volatile("s_waitcnt vmcnt(0)" ::: "memory");
  __syncthreads();
  if (threadIdx.x == 0) {
    unsigned* bar = b.bar;
    __builtin_amdgcn_s_waitcnt(0);
    unsigned nloc = b.st[0], nx = b.st[1];
    if (nloc == 0u) { xcd_barrier_complete(bar, b.x, nloc, nx); b.st[0] = nloc; b.st[1] = nx; b.st[5] = xcd_topology(bar); }
    const unsigned old = xb_add(&bar[XB_XSUB(b.x)], 1u);
    const unsigned gen = old / nloc;
    if (old + 1u == (gen + 1u) * nloc) {
      __builtin_amdgcn_fence(__ATOMIC_RELEASE, "agent");
      asm volatile("s_waitcnt vmcnt(0)" ::: "memory");
      const unsigned og = xb_add(&bar[XB_TOP], 1u);
      const unsigned tg = og / nx;
      if (og + 1u == (tg + 1u) * nx) xb_add(&bar[XB_TOPGEN], 1u);
      else XB_SPIN(xb_ld(&bar[XB_TOPGEN]) == tg, bar);
      __builtin_amdgcn_fence(__ATOMIC_ACQUIRE, "agent");
      xb_add(&bar[XB_XGEN(b.x)], 1u);
      asm volatile("s_waitcnt vmcnt(0)" ::: "memory");
    } else {
      XB_SPIN(xb_ld(&bar[XB_XGEN(b.x)]) == gen, bar);
      __builtin_amdgcn_fence(__ATOMIC_ACQUIRE, "agent");
      asm volatile("s_waitcnt vmcnt(0)" ::: "memory");
    }
  }
  __syncthreads();
}

__device__ __forceinline__ void xcd_barrier_local(const XcdBarrier& b) {
  asm volatile("s_waitcnt vmcnt(0)" ::: "memory");
  __syncthreads();
  if (threadIdx.x == 0) {
    unsigned* bar = b.bar;
    __builtin_amdgcn_s_waitcnt(0);
    const unsigned nloc = b.st[0];
    const unsigned old = xb_add(&bar[XB_LSUB(b.x)], 1u);
    const unsigned gen = old / nloc;
    if (old + 1u == (gen + 1u) * nloc) xb_add(&bar[XB_LGEN(b.x)], 1u);
    else XB_SPIN(xb_ld(&bar[XB_LGEN(b.x)]) == gen, bar);
    __builtin_amdgcn_fence(__ATOMIC_ACQUIRE, "agent");
    asm volatile("s_waitcnt vmcnt(0)" ::: "memory");
  }
  __syncthreads();
}

__device__ __forceinline__ void transpose_tile(const float* __restrict__ src, int lds_, u16* __restrict__ dst, int ldd,
                                               int k0, int n0, float* sm, bool fragv = false) {
  const int tid = otid();
  const int c4 = (tid & 15) * 4, r0 = tid >> 4;
  float4 v[8];
#pragma unroll
  for (int i = 0; i < 8; ++i) v[i] = *(const float4*)(src + (size_t)(k0 + r0 + 16 * i) * lds_ + n0 + c4);
#pragma unroll
  for (int i = 0; i < 8; ++i) {
    const int k = r0 + 16 * i;
    sm[(c4 + 0) * 129 + k] = v[i].x; sm[(c4 + 1) * 129 + k] = v[i].y; sm[(c4 + 2) * 129 + k] = v[i].z; sm[(c4 + 3) * 129 + k] = v[i].w;
  }
  __syncthreads();
  const int k8 = (tid & 15) * 8, nn = tid >> 4;
#pragma unroll
  for (int i = 0; i < 4; ++i) {
    const int n = nn + 16 * i;
    const float* row = sm + n * 129 + k8;
    uint4 w;
    w.x = pack2(row[0], row[1]); w.y = pack2(row[2], row[3]); w.z = pack2(row[4], row[5]); w.w = pack2(row[6], row[7]);
    if (fragv) {
      const int col = n0 + n, pos = k0 + k8;
      *(uint4*)(dst + ((size_t)((col >> 6) * 16 + (pos >> 5))) * 2048 + vfrag_off(pos & 31, col & 63)) = w;
    } else {
      *(uint4*)(dst + (size_t)(n0 + n) * ldd + k0 + k8) = w;
    }
  }
  __syncthreads();
}

__device__ __forceinline__ void adaln_item(const Params& p, int it, float* sm) {
  const int l = it / 192, c0 = (it % 192) * 32;
  float* ssil = sm;
  float* red = sm + 3072;
  const int tid = otid();
  for (int i = tid; i < 3072; i += 256) {
    const int cnd = i >> 10, k = i & 1023;
    const float v = cnd == 0 ? p.c_ctx[k] : p.c[(cnd - 1) * 1024 + k];
    ssil[i] = v / (1.f + expf(-v));
  }
  __syncthreads();
  const int cg4 = (tid & 7) * 4, ks = tid >> 3;
  const float* w = p.w_ada + (size_t)l * 1024 * 6144 + c0 + cg4;
  float a0[4] = {0.f, 0.f, 0.f, 0.f}, a1[4] = {0.f, 0.f, 0.f, 0.f}, a2[4] = {0.f, 0.f, 0.f, 0.f};
#pragma unroll 16
  for (int kk = 0; kk < 32; ++kk) {
    const int k = kk * 32 + ks;
    const float4 v = *(const float4*)(w + (size_t)k * 6144);
    const float s0 = ssil[k], s1 = ssil[1024 + k], s2 = ssil[2048 + k];
    a0[0] += s0 * v.x; a0[1] += s0 * v.y; a0[2] += s0 * v.z; a0[3] += s0 * v.w;
    a1[0] += s1 * v.x; a1[1] += s1 * v.y; a1[2] += s1 * v.z; a1[3] += s1 * v.w;
    a2[0] += s2 * v.x; a2[1] += s2 * v.y; a2[2] += s2 * v.z; a2[3] += s2 * v.w;
  }
#pragma unroll
  for (int j = 0; j < 4; ++j) {
    red[(ks * 3 + 0) * 32 + cg4 + j] = a0[j];
    red[(ks * 3 + 1) * 32 + cg4 + j] = a1[j];
    red[(ks * 3 + 2) * 32 + cg4 + j] = a2[j];
  }
  __syncthreads();
  if (tid < 96) {
    const int cnd = tid >> 5, j = tid & 31;
    float s = p.b_ada[l * 6144 + c0 + j];
    for (int q = 0; q < 32; ++q) s += red[(q * 3 + cnd) * 32 + j];
    p.mods[(l * 3 + cnd) * 6144 + c0 + j] = s;
  }
  __syncthreads();
}

__device__ __forceinline__ void cvt_item(const float* __restrict__ src, u16* __restrict__ dst, int it, int W) {
  const int w8 = W >> 3;
#pragma unroll
  for (int i = 0; i < 4; ++i) {
    const int u = it * 1024 + i * 256 + otid();
    const int d8 = u % w8, pos = (u / w8) & 511, bl = u / (w8 * 512);
    const float* sp = src + ((size_t)(bl * 512 + pos) * W + d8 * 8);
    const float4 v0 = *(const float4*)sp, v1 = *(const float4*)(sp + 4);
    uint4 w; w.x = pack2(v0.x, v0.y); w.y = pack2(v0.z, v0.w); w.z = pack2(v1.x, v1.y); w.w = pack2(v1.z, v1.w);
    const int h = d8 >> 3, d = (d8 & 7) * 8;
    *(uint4*)(dst + ((size_t)((bl * (W >> 6) + h) * 16 + (pos >> 5))) * 2048 + kfrag_off(pos & 31, d)) = w;
  }
}

__device__ __forceinline__ void pq_item(const Params& p, int it, float* sm) {
  const int cq = it & 3, it2 = it >> 2;
  const int l = it2 >> 3, which = (it2 >> 2) & 1, g = it2 & 3;
  const int n = otid();
  if (n < 64) sm[n] = which ? sinpif(2.f * (float)n / 64.f) : cospif(2.f * (float)n / 64.f);
  __syncthreads();
  float w[64];
#pragma unroll
  for (int m = 0; m < 64; ++m) w[m] = p.w_fourier[(size_t)l * 65536 + (g * 64 + m) * 256 + n];
  u16* dst = p.pqt + (size_t)l * 512 * 256 + (size_t)(which * 256 + n) * 256 + g * 64;
  for (int c = cq * 16; c < cq * 16 + 16; ++c) {
    float s = 0.f;
#pragma unroll
    for (int m = 0; m < 64; ++m) s += sm[(c * m) & 63] * w[m];
    dst[c] = f2bf(s);
  }
  __syncthreads();
}

__device__ __forceinline__ void dft_item(u16* dst, int L, int it) {
  const int twoL = 2 * L;
  for (int e = otid(); e < 8192; e += 256) {
    const int idx = it * 8192 + e;
    const int k = idx / twoL, j = idx % twoL;
    const int jj = j & (L - 1);
    const int ph = (k * jj) & (L - 1);
    const float a = 2.f * (float)ph / (float)L;
    const float v = (j >= L) ? -sinpif(a) : cospif(a);
    dst[idx] = f2bf(v);
  }
}

#define P0_WT 288
#define P0_ADA 768
#define P0_XC 0
#define P0_CK 320
#define P0_CVT 320
#define P0_PQ 128
#define P0_DFT 272
#define P0_ITEMS (P0_ADA + P0_WT + P0_XC + P0_CK + P0_CVT + P0_PQ + P0_DFT + 1)

__device__ void wt_item(const Params& p, int l, int r, float* sm) {
  if (r < 288) { transpose_tile(p.w_in + (size_t)l * 1024 * 2304, 2304, p.w_inT + (size_t)l * 2304 * 1024, 1024, (r / 36) * 128, (r % 36) * 64, sm); return; }
  r -= 288;
  if (r < 128) { transpose_tile(p.w_out + (size_t)l * 1024 * 1024, 1024, p.w_outT + (size_t)l * 1024 * 1024, 1024, (r / 16) * 128, (r % 16) * 64, sm); return; }
  r -= 128;
  if (r < 512) { transpose_tile(p.w1 + (size_t)l * 1024 * 4096, 4096, p.w1T + (size_t)l * 4096 * 1024, 1024, (r / 64) * 128, (r % 64) * 64, sm); return; }
  r -= 512;
  transpose_tile(p.w2 + (size_t)l * 4096 * 1024, 1024, p.w2T + (size_t)l * 1024 * 4096, 4096, (r / 16) * 128, (r % 16) * 64, sm);
}

__device__ void p0_item(const Params& p, int it, unsigned char* smem) {
  float* sm = (float*)smem;
  if (it < P0_ADA) { adaln_item(p, it, sm); return; }
  it -= P0_ADA;
  if (it < P0_WT) { wt_item(p, 0, it, sm); return; }
  it -= P0_WT;
  if (it < P0_XC) {
    const int row0 = it * 16;
    const float* src = row0 < NPTOK ? p.x_prompt + (size_t)row0 * 1024 : p.x_sample + (size_t)(row0 - NPTOK) * 1024;
    float* dst = p.xres + (size_t)row0 * 1024;
#pragma unroll
    for (int i = 0; i < 16; ++i) {
      const int o = (i * 256 + otid()) * 4;
      *(float4*)(dst + o) = *(const float4*)(src + o);
    }
    return;
  }
  it -= P0_XC;
  if (it < P0_CK) {
    if (it < 128) { cvt_item(p.c_na_k, p.ck_na, it, 256); return; }
    it -= 128;
    if (it < 128) { cvt_item(p.c_diff_k, p.ck_diff, it, 256); return; }
    it -= 128;
    cvt_item(p.c_swa_k, p.ck_swa, it, 128);
    return;
  }
  it -= P0_CK;
  if (it < P0_CVT) {
    if (it < 128) { const int bl = it >> 4, r = it & 15; transpose_tile(p.c_na_v + (size_t)bl * 512 * 256, 256, p.cvt_na + (size_t)bl * 256 * 512, 512, (r >> 2) * 128, (r & 3) * 64, sm, true); return; }
    it -= 128;
    if (it < 128) { const int bl = it >> 4, r = it & 15; transpose_tile(p.c_diff_v + (size_t)bl * 512 * 256, 256, p.cvt_diff + (size_t)bl * 256 * 512, 512, (r >> 2) * 128, (r & 3) * 64, sm, true); return; }
    it -= 128;
    { const int bl = it >> 3, r = it & 7; transpose_tile(p.c_swa_v + (size_t)bl * 512 * 128, 128, p.cvt_swa + (size_t)bl * 128 * 512, 512, (r >> 1) * 128, (r & 1) * 64, sm, true); return; }
  }
  it -= P0_CVT;
  if (it < P0_PQ) { pq_item(p, it, sm); return; }
  it -= P0_PQ;
  if (it < 16) { dft_item(p.dft256, 256, it); return; }
  it -= 16;
  if (it < 256) { dft_item(p.dft1024, 1024, it); return; }
  for (int e = otid(); e < 512 + 1024; e += 256) {
    const bool isD = e < 512;
    const int ee = isD ? e : e - 512;
    const int nf = isD ? 8 : 16;
    const int pos = ee / nf, fi = ee % nf;
    const float inv = exp2f(-(float)fi * (13.287712379549449f / (float)nf));
    float tt = (float)pos * inv * 0.15915494309189535f;
    tt -= rintf(tt);
    float sn, cs;
    sincospif(2.f * tt, &sn, &cs);
    if (isD) { p.ropeD[ee] = cs; p.ropeD[512 + ee] = sn; }
    else { p.ropeS[ee] = cs; p.ropeS[1024 + ee] = sn; }
  }
}

__device__ __forceinline__ void norm_item(const Params& p, int l, int which, int it) {
  const int lane = otid() & 63, wave = otid() >> 6;
  const int row0 = it * 16 + wave * 4;
  const float* xsrc = (which == 0 && l == 0) ? (row0 < NPTOK ? p.x_prompt + (size_t)row0 * 1024 : p.x_sample + (size_t)(row0 - NPTOK) * 1024)
                                             : p.xres + (size_t)row0 * 1024;
  float4 v[4][4];
#pragma unroll
  for (int j = 0; j < 4; ++j)
#pragma unroll
    for (int k = 0; k < 4; ++k) v[j][k] = *(const float4*)(xsrc + (size_t)j * 1024 + (k * 64 + lane) * 4);
  float rs[4];
#pragma unroll
  for (int j = 0; j < 4; ++j) {
    float ss = 0.f;
#pragma unroll
    for (int k = 0; k < 4; ++k) ss += v[j][k].x * v[j][k].x + v[j][k].y * v[j][k].y + v[j][k].z * v[j][k].z + v[j][k].w * v[j][k].w;
#pragma unroll
    for (int o = 32; o >= 1; o >>= 1) ss += __shfl_xor(ss, o);
    rs[j] = rsqrtf(ss * (1.f / 1024.f) + 1e-6f);
  }
  if (which < 2) {
    const int cond = row0 < NPTOK ? 0 : 1 + ((row0 - NPTOK) >> 10);
    const float* gp = (which == 0 ? p.norm1_g : p.norm2_g) + l * 1024;
    const float* shp = p.mods + (size_t)(l * 3 + cond) * 6144 + (which * 3 + 0) * 1024;
    const float* scp = shp + 1024;
#pragma unroll
    for (int k = 0; k < 4; ++k) {
      const int col = (k * 64 + lane) * 4;
      const float4 gg = *(const float4*)(gp + col);
      const float4 sh = *(const float4*)(shp + col);
      const float4 sc = *(const float4*)(scp + col);
      const float mx = gg.x * (1.f + sc.x), my = gg.y * (1.f + sc.y), mz = gg.z * (1.f + sc.z), mw = gg.w * (1.f + sc.w);
#pragma unroll
      for (int j = 0; j < 4; ++j) {
        uint2 w;
        w.x = pack2(v[j][k].x * rs[j] * mx + sh.x, v[j][k].y * rs[j] * my + sh.y);
        w.y = pack2(v[j][k].z * rs[j] * mz + sh.z, v[j][k].w * rs[j] * mw + sh.w);
        *(uint2*)(p.h + (size_t)(row0 + j) * 1024 + col) = w;
      }
    }
  } else {
#pragma unroll
    for (int k = 0; k < 4; ++k) {
      const int col = (k * 64 + lane) * 4;
      const float4 gg = *(const float4*)(p.final_g + col);
#pragma unroll
      for (int j = 0; j < 4; ++j) {
        float4 o;
        o.x = v[j][k].x * rs[j] * gg.x; o.y = v[j][k].y * rs[j] * gg.y; o.z = v[j][k].z * rs[j] * gg.z; o.w = v[j][k].w * rs[j] * gg.w;
        *(float4*)(p.out + (size_t)(row0 + j) * 1024 + col) = o;
      }
    }
  }
}

template <bool ZERO, int YT>
__device__ __forceinline__ void gemm_main_t(const u16* __restrict__ X, int ldx, const u16* __restrict__ Y, int ldy, int K,
                                          u16* smem, f32x4 (&acc)[4][YT]) {
  const int tid = otid(), lane = tid & 63, wave = tid >> 6, wx = wave & 1, wy = wave >> 1, r = lane & 15, g = lane >> 4;
  u16* sX = smem;
  u16* sY = smem + 2 * 128 * 64;
  const int lrow = tid >> 3, lkc = tid & 7;
  const int gsw = (lkc ^ (lrow & 7)) * 8;
  const u16* gx = X + (size_t)lrow * ldx + gsw;
  const u16* gy = Y + (size_t)lrow * ldy + gsw;
  u16* lx = sX + tid * 8;
  u16* ly = sY + tid * 8;
#define GEMM_STAGE(buf, kt_)                                                                                                      \
  {                                                                                                                               \
    _Pragma("unroll") for (int i = 0; i < 4; ++i)                                                                                 \
      __builtin_amdgcn_global_load_lds((const unsigned*)(gx + (size_t)(32 * i) * ldx + (kt_) * 64),                               \
                                       (unsigned*)(lx + (buf) * 8192 + i * 2048), 16, 0, 0);                                      \
    _Pragma("unroll") for (int i = 0; i < YT; ++i)                                                                                \
      __builtin_amdgcn_global_load_lds((const unsigned*)(gy + (size_t)(32 * i) * ldy + (kt_) * 64),                               \
                                       (unsigned*)(ly + (buf) * 8192 + i * 2048), 16, 0, 0);                                      \
  }
  GEMM_STAGE(0, 0);
  if (ZERO) {
#pragma unroll
    for (int a = 0; a < 4; ++a)
#pragma unroll
      for (int b = 0; b < YT; ++b) acc[a][b] = (f32x4){0.f, 0.f, 0.f, 0.f};
  }
  const int nk = K >> 6;
  const int sw = r & 7;
  const u16* cx0 = sX + (wx * 64 + r) * 64;
  const u16* cy0 = sY + (wy * (16 * YT) + r) * 64;
  __syncthreads();
#define GEMM_COMPUTE(cur)                                                                            \
  {                                                                                                  \
    const u16* cx = cx0 + (cur) * 8192;                                                              \
    const u16* cy = cy0 + (cur) * 8192;                                                              \
    _Pragma("unroll") for (int kk = 0; kk < 2; ++kk) {                                               \
      const int pc = ((kk * 4 + g) ^ sw) * 8;                                                        \
      bf16x8 a[4], b[YT];                                                                            \
      _Pragma("unroll") for (int i = 0; i < 4; ++i) a[i] = *(const bf16x8*)(cx + i * 16 * 64 + pc);  \
      _Pragma("unroll") for (int i = 0; i < YT; ++i) b[i] = *(const bf16x8*)(cy + i * 16 * 64 + pc); \
      __builtin_amdgcn_s_setprio(1);                                                                 \
      _Pragma("unroll") for (int xi = 0; xi < 4; ++xi)                                               \
        _Pragma("unroll") for (int yi = 0; yi < YT; ++yi)                                            \
          acc[xi][yi] = __builtin_amdgcn_mfma_f32_16x16x32_bf16(a[xi], b[yi], acc[xi][yi], 0, 0, 0); \
      __builtin_amdgcn_s_setprio(0);                                                                 \
    }                                                                                                \
  }
#pragma unroll 1
  for (int kt = 0; kt < nk - 1; ++kt) {
    const int cur = kt & 1;
    GEMM_STAGE(cur ^ 1, kt + 1);
    GEMM_COMPUTE(cur);
    __syncthreads();
  }
  GEMM_COMPUTE((nk - 1) & 1);
  __syncthreads();
#undef GEMM_COMPUTE
#undef GEMM_STAGE
}

#ifndef REP_GEMM
#define REP_GEMM 0
#endif
#ifndef REP_MIX
#define REP_MIX 0
#endif
#ifndef REP_SYNC
#define REP_SYNC 0
#endif
#ifndef REP_P0
#define REP_P0 0
#endif
template <int YT>
__device__ __forceinline__ void gemm_main(const u16* __restrict__ X, int ldx, const u16* __restrict__ Y, int ldy, int K,
                                          u16* smem, f32x4 (&acc)[4][YT]) {
  gemm_main_t<true, YT>(X, ldx, Y, ldy, K, smem, acc);
#if REP_GEMM
  gemm_main_t<false, YT>(X, ldx, Y, ldy, K, smem, acc);
#pragma unroll
  for (int a = 0; a < 4; ++a)
#pragma unroll
    for (int b = 0; b < YT; ++b) acc[a][b] *= 0.5f;
#endif
}

__device__ __forceinline__ bool tile_map(int j, int ntx, int& tx, int& ty, int nty = 48) {
  const int nblk = gridDim.x, bid = blockIdx.x;
  if (nblk == 512) {
    const int per = nty >> 3, hp = per >> 1;
    const int rank = bid >> 3, q = (rank & 31) + j * 32, mem = rank >> 5;
    if (q >= hp * ntx) return false;
    tx = q / hp; ty = per * (bid & 7) + 2 * (q % hp) + mem;
    return true;
  } else {
    const int it = bid + j * nblk;
    if (it >= nty * ntx) return false;
    tx = it / nty; ty = it % nty;
    return true;
  }
}

__device__ void gin_tile(const Params& p, int l, int tx, int ty, u16* smem) {
  const int n0 = tx * 128, m0 = ty * 128;
  f32x4 acc[4][4];
  gemm_main<4>(p.w_inT + (size_t)l * 2304 * 1024 + (size_t)n0 * 1024, 1024, p.h + (size_t)m0 * 1024, 1024, 1024, smem, acc);
  const int lane = otid() & 63, wave = otid() >> 6, wx = wave & 1, wy = wave >> 1, r = lane & 15, g = lane >> 4;
  const int nw = n0 + wx * 64;
  const bool isS = m0 >= NPTOK;
  int ropeMode = 0;
  if (isS) {
    if (nw >= 768 && nw < 1280) ropeMode = 1;
    else if (nw >= 1792 && nw < 2176) ropeMode = 2;
  }
  float* okv = nullptr; int okv_w = 0, okv_c = 0;
  if (!isS) {
    if (nw >= 256 && nw < 512) { okv = p.out + O_NAK; okv_w = 256; okv_c = nw - 256; }
    else if (nw >= 512 && nw < 768) { okv = p.out + O_NAV; okv_w = 256; okv_c = nw - 512; }
    else if (nw >= 1024 && nw < 1280) { okv = p.out + O_DK; okv_w = 256; okv_c = nw - 1024; }
    else if (nw >= 1280 && nw < 1536) { okv = p.out + O_DV; okv_w = 256; okv_c = nw - 1280; }
    else if (nw >= 2048 && nw < 2176) { okv = p.out + O_SK; okv_w = 128; okv_c = nw - 2048; }
    else if (nw >= 2176) { okv = p.out + O_SV; okv_w = 128; okv_c = nw - 2176; }
  }
  int khh = -1;
  if (nw >= 256 && nw < 512) khh = (nw - 256) >> 6;
  else if (nw >= 1024 && nw < 1280) khh = 4 + ((nw - 1024) >> 6);
  else if (nw >= 2048 && nw < 2176) khh = 8 + ((nw - 2048) >> 6);
  int vrow = -1;
  if (nw >= 512 && nw < 768) vrow = nw - 512;
  else if (nw >= 1280 && nw < 1536) vrow = 256 + nw - 1280;
  else if (nw >= 2176) vrow = 512 + nw - 2176;
#pragma unroll
  for (int yi = 0; yi < 4; ++yi) {
    const int m = m0 + wy * 64 + yi * 16 + r;
    const int t = (m - NPTOK) & 1023;
    const int prow = t >> 6, pcol = t & 63;
#pragma unroll
    for (int xi = 0; xi < 4; ++xi) {
      f32x4 v = acc[xi][yi];
      if (ropeMode == 1) {
        const int pos = (xi & 1) ? pcol : prow;
        const float4 cs = *(const float4*)(p.ropeD + pos * 8 + 4 * (g & 1));
        const float4 sn = *(const float4*)(p.ropeD + 512 + pos * 8 + 4 * (g & 1));
        const float sg = (g >= 2) ? 1.f : -1.f;
        const float o0 = __shfl_xor(v[0], 32), o1 = __shfl_xor(v[1], 32), o2 = __shfl_xor(v[2], 32), o3 = __shfl_xor(v[3], 32);
        v[0] = v[0] * cs.x + sg * o0 * sn.x; v[1] = v[1] * cs.y + sg * o1 * sn.y;
        v[2] = v[2] * cs.z + sg * o2 * sn.z; v[3] = v[3] * cs.w + sg * o3 * sn.w;
      } else if (ropeMode == 2) {
        const int pos = (xi >> 1) ? pcol : prow;
        const float4 cs = *(const float4*)(p.ropeS + pos * 16 + 4 * g);
        const float4 sn = *(const float4*)(p.ropeS + 1024 + pos * 16 + 4 * g);
        const f32x4 o = acc[xi ^ 1][yi];
        const float sg = (xi & 1) ? 1.f : -1.f;
        v[0] = v[0] * cs.x + sg * o[0] * sn.x; v[1] = v[1] * cs.y + sg * o[1] * sn.y;
        v[2] = v[2] * cs.z + sg * o[2] * sn.z; v[3] = v[3] * cs.w + sg * o[3] * sn.w;
      }
      const int nloc = xi * 16 + 4 * g;
      if (okv) {
        const int b = m >> 8, pos = m & 255;
        float4 o4; o4.x = v[0]; o4.y = v[1]; o4.z = v[2]; o4.w = v[3];
        *(float4*)(okv + ((size_t)((b * 4 + l) * 256 + pos)) * okv_w + okv_c + nloc) = o4;
      }
      if (vrow >= 0) {
        u16* vb = p.vfr + ((size_t)((vrow >> 6) * 192 + (m >> 5))) * 2048;
#pragma unroll
        for (int i = 0; i < 4; ++i) vb[vfrag_off(m & 31, nloc + i)] = f2bf(v[i]);
      } else if (khh >= 0) {
        uint2 w; w.x = pack2(v[0], v[1]); w.y = pack2(v[2], v[3]);
        *(uint2*)(p.kfr + ((size_t)(khh * 192 + (m >> 5))) * 2048 + kfrag_off(m & 31, nloc)) = w;
      } else {
        uint2 w; w.x = pack2(v[0], v[1]); w.y = pack2(v[2], v[3]);
        *(uint2*)(p.z + (size_t)m * INW + nw + nloc) = w;
      }
    }
  }
}

__device__ void res_tile(const Params& p, int l, int tx, int ty, const u16* A, const u16* WT, int K, int gi, u16* smem, bool first = false) {
  const int n0 = tx * 128, m0 = ty * 96;
  f32x4 acc[4][3];
  gemm_main<3>(WT + (size_t)n0 * K, K, A + (size_t)m0 * K, K, K, smem, acc);
  const int lane = otid() & 63, wave = otid() >> 6, wx = wave & 1, wy = wave >> 1, r = lane & 15, g = lane >> 4;
#pragma unroll
  for (int yi = 0; yi < 3; ++yi) {
    const int m = m0 + wy * 48 + yi * 16 + r;
    const int cond = m < NPTOK ? 0 : 1 + ((m - NPTOK) >> 10);
    const float* gate = p.mods + (size_t)(l * 3 + cond) * 6144 + gi * 1024;
    float* xrow = p.xres + (size_t)m * 1024;
    const float* xin = first ? (m < NPTOK ? p.x_prompt + (size_t)m * 1024 : p.x_sample + (size_t)(m - NPTOK) * 1024) : xrow;
    float4 xv[4], gt[4];
#pragma unroll
    for (int xi = 0; xi < 4; ++xi) {
      const int n = n0 + wx * 64 + xi * 16 + 4 * g;
      xv[xi] = *(const float4*)(xin + n);
      gt[xi] = *(const float4*)(gate + n);
    }
#pragma unroll
    for (int xi = 0; xi < 4; ++xi) {
      const int n = n0 + wx * 64 + xi * 16 + 4 * g;
      const f32x4 v = acc[xi][yi];
      float4 o = xv[xi];
      o.x += gt[xi].x * v[0]; o.y += gt[xi].y * v[1]; o.z += gt[xi].z * v[2]; o.w += gt[xi].w * v[3];
      *(float4*)(xrow + n) = o;
    }
  }
}

__device__ void m1_tile(const Params& p, int l, int tx, int ty, u16* smem) {
  const int n0 = tx * 128, m0 = ty * 128;
  f32x4 acc[4][4];
  gemm_main<4>(p.w1T + (size_t)l * 4096 * 1024 + (size_t)n0 * 1024, 1024, p.h + (size_t)m0 * 1024, 1024, 1024, smem, acc);
  const int lane = otid() & 63, wave = otid() >> 6, wx = wave & 1, wy = wave >> 1, r = lane & 15, g = lane >> 4;
#pragma unroll
  for (int xi = 0; xi < 4; ++xi) {
    const int n = n0 + wx * 64 + xi * 16 + 4 * g;
#pragma unroll
    for (int yi = 0; yi < 4; ++yi) {
      const int m = m0 + wy * 64 + yi * 16 + r;
      const f32x4 v = acc[xi][yi];
      float a0 = fmaxf(v[0], 0.f), a1 = fmaxf(v[1], 0.f), a2 = fmaxf(v[2], 0.f), a3 = fmaxf(v[3], 0.f);
      uint2 w; w.x = pack2(a0 * a0, a1 * a1); w.y = pack2(a2 * a2, a3 * a3);
      *(uint2*)(p.u + (size_t)m * 4096 + n) = w;
    }
  }
}

__device__ void f1_tile(const Params& p, int l, int it, u16* smem) {
  const int tx = it % 48, ty = it / 48;
  const int x0 = tx * 128, y0 = ty * 128;
  f32x4 acc[4][4];
  gemm_main<4>(p.z + (size_t)x0 * INW + 1536, INW, p.pqt + (size_t)l * 512 * 256 + (size_t)y0 * 256, 256, 256, smem, acc);
  const int lane = otid() & 63, wave = otid() >> 6, wx = wave & 1, wy = wave >> 1, r = lane & 15, g = lane >> 4;
#pragma unroll
  for (int yi = 0; yi < 4; ++yi) {
    const int y = y0 + wy * 64 + yi * 16 + r;
    const int col = y & 255, which = y >> 8;
#pragma unroll
    for (int xi = 0; xi < 4; ++xi) {
      const int tok = x0 + wx * 64 + xi * 16 + 4 * g;
      size_t addr;
      if (tok < NPTOK) {
        const int b = tok >> 8, pos = tok & 255;
        addr = (size_t)b * (256 * 512) + (size_t)col * 512 + which * 256 + pos;
      } else {
        const int b = (tok - NPTOK) >> 10, pos = (tok - NPTOK) & 1023;
        addr = (size_t)16 * 256 * 512 + (size_t)b * (256 * 2048) + (size_t)col * 2048 + which * 1024 + pos;
      }
      const f32x4 v = acc[xi][yi];
      uint2 w; w.x = pack2(v[0], v[1]); w.y = pack2(v[2], v[3]);
      *(uint2*)(p.uv + addr) = w;
    }
  }
  asm volatile("s_waitcnt vmcnt(0)" ::: "memory");
  __syncthreads();
  if (threadIdx.x == 0) {
    __builtin_amdgcn_fence(__ATOMIC_RELEASE, "agent");
    asm volatile("s_waitcnt vmcnt(0)" ::: "memory");
    xb_add(p.bar + XCD_BAR_WORDS + (8 + l) * 64, 1u);
  }
}

__device__ void f2_tile(const Params& p, int l, int it, u16* smem) {
  if (threadIdx.x == 0) {
    unsigned* c = p.bar + XCD_BAR_WORDS + (8 + l) * 64;
    unsigned sp = 0;
    while (xb_ld(c) < 192u) { __builtin_amdgcn_s_sleep(2); if (++sp > (1u << 24)) break; }
    __builtin_amdgcn_fence(__ATOMIC_ACQUIRE, "agent");
    asm volatile("s_waitcnt vmcnt(0)" ::: "memory");
  }
  __syncthreads();
  int L, b, tx, ty, tokbase;
  const u16* uvb; const u16* dft;
  if (it < 32) { L = 1024; b = it >> 4; tx = (it >> 3) & 1; ty = it & 7; uvb = p.uv + (size_t)16 * 256 * 512 + (size_t)b * (256 * 2048); dft = p.dft1024; tokbase = NPTOK + b * 1024; }
  else { it -= 32; L = 256; b = it >> 2; tx = (it >> 1) & 1; ty = it & 1; uvb = p.uv + (size_t)b * (256 * 512); dft = p.dft256; tokbase = b * 256; }
  const int x0 = tx * 128, y0 = ty * 128, K = 2 * L;
  f32x4 acc[4][4];
  gemm_main<4>(uvb + (size_t)x0 * K, K, dft + (size_t)y0 * K, K, K, smem, acc);
  const int lane = otid() & 63, wave = otid() >> 6, wx = wave & 1, wy = wave >> 1, r = lane & 15, g = lane >> 4;
  const float scale = rsqrtf(64.f * (float)L);
#pragma unroll
  for (int yi = 0; yi < 4; ++yi) {
    const int pos = y0 + wy * 64 + yi * 16 + r;
#pragma unroll
    for (int xi = 0; xi < 4; ++xi) {
      const int col = x0 + wx * 64 + xi * 16 + 4 * g;
      const f32x4 v = acc[xi][yi];
      uint2 w; w.x = pack2(v[0] * scale, v[1] * scale); w.y = pack2(v[2] * scale, v[3] * scale);
      *(uint2*)(p.cat + (size_t)(tokbase + pos) * 1024 + 512 + col) = w;
    }
  }
}

struct Seg { const u16* K; const u16* Vt; int ldk, ldv, nblk, pos0, stride; };
#define KLOC(hh, tokb) (p.kfr + ((size_t)((hh) * 192 + ((tokb) >> 5))) * 2048)
#define VLOC(hh, tokb) (p.vfr + ((size_t)((hh) * 192 + ((tokb) >> 5))) * 2048)
template <int QT> struct AState { float m[QT]; float ls[QT]; f32x4 o[QT][4]; };

__device__ __forceinline__ bf16x8 as_bf(u32x4 v) { union { u32x4 u; bf16x8 b; } x; x.u = v; return x.b; }

template <int DC>
__device__ __forceinline__ void issue_blk(const Seg& s0, const Seg& s1, int b, int r, int g, u32x4 (&kf)[2][DC], u32x4 (&vf)[4]) {
  const bool in0 = b < s0.nblk;
  const u16* Kp = in0 ? s0.K : s1.K;
  const u16* Vp = in0 ? s0.Vt : s1.Vt;
  const int pos = in0 ? (s0.pos0 + b * s0.stride) : (s1.pos0 + (b - s0.nblk) * s1.stride);
  const int lane8 = (g * 16 + r) * 8;
  const u16* kp = Kp + (size_t)(pos >> 5) * 2048 + lane8;
  const u16* vp = Vp + (size_t)(pos >> 5) * 2048 + lane8;
#pragma unroll
  for (int t = 0; t < 2; ++t)
#pragma unroll
    for (int dc = 0; dc < DC; ++dc) gload16(kf[t][dc], kp + (t * 2 + dc) * 512);
#pragma unroll
  for (int dv = 0; dv < 4; ++dv) gload16(vf[dv], vp + dv * 512);
}
template <int N>
__device__ __forceinline__ void wait_blk(u32x4 (&kf)[2][1], u32x4 (&vf)[4]) {
  asm volatile("s_waitcnt vmcnt(%6)" : "+v"(kf[0][0]), "+v"(kf[1][0]), "+v"(vf[0]), "+v"(vf[1]), "+v"(vf[2]), "+v"(vf[3]) : "n"(N) : "memory");
}
template <int N>
__device__ __forceinline__ void wait_blk(u32x4 (&kf)[2][2], u32x4 (&vf)[4]) {
  asm volatile("s_waitcnt vmcnt(%8)" : "+v"(kf[0][0]), "+v"(kf[0][1]), "+v"(kf[1][0]), "+v"(kf[1][1]), "+v"(vf[0]), "+v"(vf[1]), "+v"(vf[2]), "+v"(vf[3]) : "n"(N) : "memory");
}

template <int D, int QT, int MODE>
__device__ __forceinline__ void attn_compute(const u32x4 (&kc)[2][D / 32], const u32x4 (&vc)[4], const bf16x8 (&qf)[QT][D / 32], const float sc,
                                             AState<QT>& st, const bool in0, const int pos, const int qpos0, const float* __restrict__ rpb_h,
                                             const int r, const int g) {
  constexpr int DC = D / 32;
#pragma unroll
  for (int q = 0; q < QT; ++q) {
    f32x4 s_[2];
    s_[0] = (f32x4){0.f, 0.f, 0.f, 0.f};
    s_[1] = (f32x4){0.f, 0.f, 0.f, 0.f};
#pragma unroll
    for (int t = 0; t < 2; ++t)
#pragma unroll
      for (int dc = 0; dc < DC; ++dc) s_[t] = __builtin_amdgcn_mfma_f32_16x16x32_bf16(as_bf(kc[t][dc]), qf[q][dc], s_[t], 0, 0, 0);
    float sv[8];
#pragma unroll
    for (int t = 0; t < 2; ++t)
#pragma unroll
      for (int i = 0; i < 4; ++i) {
        float x = s_[t][i] * sc;
        if (MODE == 1) {
          if (!in0) {
            const int qpos = qpos0 + q * 16 + r;
            const int qrow = qpos >> 6, cq = qpos & 63;
            const int kpos = pos + 8 * g + 4 * t + i;
            const int krow = kpos >> 6, ck = kpos & 63;
            const int cs = min(max(cq - 8, 0), 48);
            const bool valid = (ck >= cs) && (ck < cs + 16);
            const int bi = (krow - qrow + 7) * 31 + (ck - cq + 15);
            const float bias = rpb_h[valid ? bi : 0];
            x = valid ? (x + bias) : -1e30f;
          }
        } else if (MODE == 2) {
          if (!in0) {
            const int qpos = qpos0 + q * 16 + r;
            const int kpos = pos + 8 * g + 4 * t + i;
            const int d = qpos - kpos;
            x = (d <= 128 && d >= -128) ? x : -1e30f;
          }
        }
        sv[4 * t + i] = x;
      }
    float mx = fmaxf(fmaxf(fmaxf(sv[0], sv[1]), fmaxf(sv[2], sv[3])), fmaxf(fmaxf(sv[4], sv[5]), fmaxf(sv[6], sv[7])));
    mx = fmaxf(mx, __shfl_xor(mx, 16));
    mx = fmaxf(mx, __shfl_xor(mx, 32));
    const float mnew = fmaxf(st.m[q], mx);
    const float alpha = __builtin_amdgcn_exp2f(st.m[q] - mnew);
    st.m[q] = mnew;
    float ps = 0.f;
#pragma unroll
    for (int j = 0; j < 8; ++j) { sv[j] = __builtin_amdgcn_exp2f(sv[j] - mnew); ps += sv[j]; }
    st.ls[q] = st.ls[q] * alpha + ps;
    union { bf16x8 v; unsigned w[4]; } pf;
    pf.w[0] = pack2(sv[0], sv[1]); pf.w[1] = pack2(sv[2], sv[3]); pf.w[2] = pack2(sv[4], sv[5]); pf.w[3] = pack2(sv[6], sv[7]);
#pragma unroll
    for (int dv = 0; dv < 4; ++dv) {
      f32x4 o = st.o[q][dv];
      o[0] *= alpha; o[1] *= alpha; o[2] *= alpha; o[3] *= alpha;
      st.o[q][dv] = __builtin_amdgcn_mfma_f32_16x16x32_bf16(as_bf(vc[dv]), pf.v, o, 0, 0, 0);
    }
  }
}

template <int D, int QT, int MODE, int NQ = 2>
__device__ __forceinline__ void attn_run(const Seg& s0, const Seg& s1, const bf16x8 (&qf)[QT][D / 32], const float sc,
                                         AState<QT>& st, const int qpos0, const float* __restrict__ rpb_h, const int bb = 0, const int be = -1) {
  constexpr int DC = D / 32;
  constexpr int NL = 2 * DC + 4;
  const int lane = otid() & 63, r = lane & 15, g = lane >> 4;
  const int nb = be < 0 ? s0.nblk + s1.nblk : be;
  u32x4 kq[NQ][2][DC], vq[NQ][4];
#pragma unroll
  for (int q = 0; q < QT; ++q)
#pragma unroll
    for (int dc = 0; dc < DC; ++dc) asm volatile("" ::"v"(qf[q][dc]));
  asm volatile("s_waitcnt vmcnt(0)" ::: "memory");
#pragma unroll 1
  for (int b = bb; b < nb; b += NQ) {
#pragma unroll
    for (int j = 0; j < NQ; ++j) issue_blk<DC>(s0, s1, b + j, r, g, kq[j], vq[j]);
#pragma unroll
    for (int j = 0; j < NQ; ++j) {
      if (j == 0) wait_blk<(NQ - 1) * NL>(kq[j], vq[j]);
      else if (j == 1) wait_blk<(NQ - 2) * NL>(kq[j], vq[j]);
      else if (j == 2) wait_blk<(NQ > 3 ? (NQ - 3) * NL : 0)>(kq[j], vq[j]);
      else wait_blk<0>(kq[j], vq[j]);
      const int bj = b + j;
      const bool in0 = bj < s0.nblk;
      const int pos = in0 ? (s0.pos0 + bj * s0.stride) : (s1.pos0 + (bj - s0.nblk) * s1.stride);
      attn_compute<D, QT, MODE>(kq[j], vq[j], qf, sc, st, in0, pos, qpos0, rpb_h, r, g);
    }
  }
}

template <int QT>
__device__ __forceinline__ void astate_init(AState<QT>& st, float m0, float l0) {
#pragma unroll
  for (int q = 0; q < QT; ++q) {
    st.m[q] = m0; st.ls[q] = l0;
#pragma unroll
    for (int dv = 0; dv < 4; ++dv) st.o[q][dv] = (f32x4){0.f, 0.f, 0.f, 0.f};
  }
}
template <int QT>
__device__ __forceinline__ void astate_finalize(AState<QT>& st) {
#pragma unroll
  for (int q = 0; q < QT; ++q) {
    float l = st.ls[q];
    l += __shfl_xor(l, 16);
    l += __shfl_xor(l, 32);
    const float inv = 1.f / l;
#pragma unroll
    for (int dv = 0; dv < 4; ++dv) { st.o[q][dv][0] *= inv; st.o[q][dv][1] *= inv; st.o[q][dv][2] *= inv; st.o[q][dv][3] *= inv; }
  }
}
template <int DC, int QT>
__device__ __forceinline__ void load_q(const u16* zq  , bf16x8 (&qf)[QT][DC]) {
  const int lane = otid() & 63, r = lane & 15, g = lane >> 4;
#pragma unroll
  for (int q = 0; q < QT; ++q)
#pragma unroll
    for (int dc = 0; dc < DC; ++dc) qf[q][dc] = *(const bf16x8*)(zq + (size_t)(q * 16 + r) * INW + dc * 32 + g * 8);
}
template <int QT>
__device__ __forceinline__ void write_o(const Params& p, const AState<QT>& st, int tok0, int col0) {
  const int lane = otid() & 63, r = lane & 15, g = lane >> 4;
#pragma unroll
  for (int q = 0; q < QT; ++q)
#pragma unroll
    for (int dv = 0; dv < 4; ++dv) {
      const f32x4 v = st.o[q][dv];
      uint2 w; w.x = pack2(v[0], v[1]); w.y = pack2(v[2], v[3]);
      *(uint2*)(p.cat + (size_t)(tok0 + q * 16 + r) * 1024 + col0 + dv * 16 + 4 * g) = w;
    }
}

__device__ __forceinline__ float diff_lambda(const Params& p, int l, float lam_init) {
  const int lane = otid() & 63;
  float a = 0.f, b = 0.f;
  if (lane < 32) { a = p.lq1[l * 32 + lane] * p.lk1[l * 32 + lane]; b = p.lq2[l * 32 + lane] * p.lk2[l * 32 + lane]; }
#pragma unroll
  for (int o = 32; o >= 1; o >>= 1) { a += __shfl_xor(a, o); b += __shfl_xor(b, o); }
  return expf(a) - expf(b) + lam_init;
}

__device__ __forceinline__ void diff_finish_q(const Params& p, int l, float lam, float lam_init, f32x4 (&A)[4], const f32x4 (&B)[4], int tokrow0, int col0) {
  const int lane = otid() & 63, r = lane & 15, g = lane >> 4;
  const float* sg = p.subln_g + l * 64;
  float ss = 0.f;
#pragma unroll
  for (int dv = 0; dv < 4; ++dv)
#pragma unroll
    for (int i = 0; i < 4; ++i) {
      const float v = A[dv][i] - lam * B[dv][i];
      A[dv][i] = v;
      ss += v * v;
    }
  ss += __shfl_xor(ss, 16);
  ss += __shfl_xor(ss, 32);
  const float rs = rsqrtf(ss * (1.f / 64.f) + 1e-6f) * (1.f - lam_init);
#pragma unroll
  for (int dv = 0; dv < 4; ++dv) {
    const float4 gg = *(const float4*)(sg + dv * 16 + 4 * g);
    uint2 w;
    w.x = pack2(A[dv][0] * rs * gg.x, A[dv][1] * rs * gg.y);
    w.y = pack2(A[dv][2] * rs * gg.z, A[dv][3] * rs * gg.w);
    *(uint2*)(p.cat + (size_t)(tokrow0 + r) * 1024 + col0 + dv * 16 + 4 * g) = w;
  }
}

#ifndef AQT
#define AQT 2
#endif
#define QW (16 * AQT)
#define NQG_CTX (256 / QW)
#define NQG_LAT (1024 / QW)
__device__ void attn_diff_item(const Params& p, int l, bool lat, int bi, float* sm) {
  const int wave = otid() >> 6, lane = otid() & 63, r = lane & 15, g = lane >> 4;
  const int ps = wave >> 1, half = wave & 1;
  int b, h, qg, tokb;
  if (lat) { b = bi / (4 * NQG_LAT); h = (bi / NQG_LAT) & 3; qg = bi % NQG_LAT; tokb = NPTOK + b * 1024; }
  else { b = bi / (4 * NQG_CTX); h = (bi / NQG_CTX) & 3; qg = bi % NQG_CTX; tokb = b * 256; }
  const int tok0 = tokb + qg * QW;
  const u16* zb = p.z + (size_t)tokb * INW;
  Seg s0, s1;
  if (lat) {
    const int bl = b * 4 + l;
    s0.K = p.ck_diff + (size_t)((bl * 4 + h) * 16) * 2048 + ps * 512; s0.Vt = p.cvt_diff + (size_t)((bl * 4 + h) * 16) * 2048;
    s0.ldk = 0; s0.ldv = 0; s0.nblk = half ? 0 : 16; s0.pos0 = 0; s0.stride = 32;
    s1.K = KLOC(4 + h, tokb) + ps * 512; s1.Vt = VLOC(4 + h, tokb);
    s1.ldk = 0; s1.ldv = 0; s1.nblk = half ? 24 : 8; s1.pos0 = half ? 256 : 0; s1.stride = 32;
  } else {
    s0.K = KLOC(4 + h, tokb) + ps * 512; s0.Vt = VLOC(4 + h, tokb);
    s0.ldk = 0; s0.ldv = 0; s0.nblk = 4; s0.pos0 = half ? 128 : 0; s0.stride = 32;
    s1 = s0; s1.nblk = 0;
  }
  bf16x8 qf[AQT][1];
  load_q<1, AQT>(p.z + (size_t)tok0 * INW + 768 + h * 64 + ps * 32, qf);
  AState<AQT> st;
  astate_init<AQT>(st, -1e30f, 0.f);
  attn_run<32, AQT, 0, 2>(s0, s1, qf, 0.17677669529663687f * LOG2E, st, 0, nullptr);
  float lt[AQT];
#pragma unroll
  for (int q = 0; q < AQT; ++q) {
    lt[q] = st.ls[q];
    lt[q] += __shfl_xor(lt[q], 16);
    lt[q] += __shfl_xor(lt[q], 32);
  }
  constexpr int WS = 64 * 16 * AQT;
  float* pm = sm + 4 * WS;
  if (wave != 0) {
    float* po = sm + wave * WS + lane * (16 * AQT);
#pragma unroll
    for (int q = 0; q < AQT; ++q) {
#pragma unroll
      for (int dv = 0; dv < 4; ++dv) *(f32x4*)(po + q * 16 + dv * 4) = st.o[q][dv];
      if (g == 0) { pm[wave * QW + q * 16 + r] = st.m[q]; pm[4 * QW + wave * QW + q * 16 + r] = lt[q]; }
    }
  }
  __syncthreads();
  if (wave == 0) {
    const float lam_init = 0.8f - 0.6f * expf(-0.3f * (float)l);
    const float lam = diff_lambda(p, l, lam_init);
#pragma unroll
    for (int q = 0; q < AQT; ++q) {
      f32x4 A[4], B[4];
      {
        const float m1 = pm[QW + q * 16 + r], l1 = pm[4 * QW + QW + q * 16 + r];
        const float M = fmaxf(st.m[q], m1);
        const float a0 = exp2f(st.m[q] - M), a1 = exp2f(m1 - M);
        const float inv = 1.f / (lt[q] * a0 + l1 * a1);
#pragma unroll
        for (int dv = 0; dv < 4; ++dv) {
          const f32x4 o1 = *(const f32x4*)(sm + 1 * WS + lane * (16 * AQT) + q * 16 + dv * 4);
          A[dv] = (st.o[q][dv] * a0 + o1 * a1) * inv;
        }
      }
      {
        const float m2 = pm[2 * QW + q * 16 + r], l2 = pm[4 * QW + 2 * QW + q * 16 + r], m3 = pm[3 * QW + q * 16 + r], l3 = pm[4 * QW + 3 * QW + q * 16 + r];
        const float M = fmaxf(m2, m3);
        const float a2 = exp2f(m2 - M), a3 = exp2f(m3 - M);
        const float inv = 1.f / (l2 * a2 + l3 * a3);
#pragma unroll
        for (int dv = 0; dv < 4; ++dv) {
          const f32x4 o2 = *(const f32x4*)(sm + 2 * WS + lane * (16 * AQT) + q * 16 + dv * 4);
          const f32x4 o3 = *(const f32x4*)(sm + 3 * WS + lane * (16 * AQT) + q * 16 + dv * 4);
          B[dv] = (o2 * a2 + o3 * a3) * inv;
        }
      }
      diff_finish_q(p, l, lam, lam_init, A, B, tok0 + q * 16, 256 + h * 64);
    }
  }
  __syncthreads();
}

__device__ void attn_ctx_item(const Params& p, int l, int bi) {
  const int wave = otid() >> 6, lane = otid() & 63, g = lane >> 4;
  const int w = bi * 4 + wave;
  const int type = w / (64 * NQG_CTX), rem = w % (64 * NQG_CTX);
  const int b = rem / (4 * NQG_CTX), h = (rem / NQG_CTX) & 3, qg = rem % NQG_CTX;
  const int tokb = b * 256, tok0 = tokb + qg * QW;
  const u16* zb = p.z + (size_t)tokb * INW;
  const int kvh = h >> 1;
  const int qcol = type == 0 ? h * 64 : 1792 + h * 64;
  const int kcol = type == 0 ? 256 + h * 64 : 2048 + kvh * 64;
  const int vrow = type == 0 ? h * 64 : 512 + kvh * 64;
  const int ocol = type == 0 ? h * 64 : 768 + h * 64;
  bf16x8 qf[AQT][2];
  load_q<2, AQT>(p.z + (size_t)tok0 * INW + qcol, qf);
  const int hslot = type == 0 ? h : 8 + kvh;
  Seg s0; s0.K = KLOC(hslot, tokb); s0.Vt = VLOC(hslot, tokb); s0.ldk = 0; s0.ldv = 0; s0.nblk = 8; s0.pos0 = 0; s0.stride = 32;
  Seg sN = s0; sN.nblk = 0;
  AState<AQT> st;
  const float sk = type == 0 ? -1e30f : p.swa_sink[l * 4 + h] * LOG2E;
  astate_init<AQT>(st, sk, (type == 1 && g == 0) ? 1.f : 0.f);
  attn_run<64, AQT, 0, 2>(s0, sN, qf, 0.125f * LOG2E, st, 0, nullptr);
  astate_finalize<AQT>(st);
  write_o<AQT>(p, st, tok0, ocol);
}

__device__ void attn_lat_item(const Params& p, int l, int bi, float* sm) {
  const int wave = otid() >> 6, lane = otid() & 63, r = lane & 15, g = lane >> 4;
  const int type = bi / (8 * NQG_LAT), rem = bi % (8 * NQG_LAT);
  const int b = rem / (4 * NQG_LAT), h = (rem / NQG_LAT) & 3, qg = rem % NQG_LAT;
  const int q0 = qg * QW;
  const int tokb = NPTOK + b * 1024, tok0 = tokb + q0;
  const u16* zb = p.z + (size_t)tokb * INW;
  const int bl = b * 4 + l;
  AState<AQT> st;
  int ocol;
  if (type != 0) {
    const float* rp = p.na_rpb + (size_t)(l * 4 + h) * 15 * 31;
    for (int e = otid(); e < 465; e += 256) sm[9000 + e] = rp[e] * LOG2E;
    __syncthreads();
  }
  if (type == 0) {
    const int kvh = h >> 1;
    bf16x8 qf[AQT][2];
    load_q<2, AQT>(p.z + (size_t)tok0 * INW + 1792 + h * 64, qf);
    Seg s0; s0.K = p.ck_swa + (size_t)((bl * 2 + kvh) * 16) * 2048; s0.Vt = p.cvt_swa + (size_t)((bl * 2 + kvh) * 16) * 2048; s0.ldk = 0; s0.ldv = 0; s0.nblk = 16; s0.pos0 = 0; s0.stride = 32;
    const int lo = max(0, q0 - 128) & ~31;
    const int hi = min(1024, ((q0 + QW + 128) + 31) & ~31);
    int lo2 = lo, cnt = (hi - lo) >> 5;
    if (cnt & 1) { if (lo2 > 0) lo2 -= 32; ++cnt; }
    Seg s1; s1.K = KLOC(8 + kvh, tokb); s1.Vt = VLOC(8 + kvh, tokb); s1.ldk = 0; s1.ldv = 0; s1.nblk = cnt; s1.pos0 = lo2; s1.stride = 32;
    const int P = (16 + cnt) >> 1;
    const int pb = (wave * P) >> 2, pe = ((wave + 1) * P) >> 2;
    astate_init<AQT>(st, wave == 0 ? p.swa_sink[l * 4 + h] * LOG2E : -1e30f, (wave == 0 && g == 0) ? 1.f : 0.f);
    attn_run<64, AQT, 2>(s0, s1, qf, 0.125f * LOG2E, st, q0, nullptr, 2 * pb, 2 * pe);
    ocol = 768 + h * 64;
  } else {
    bf16x8 qf[AQT][2];
    load_q<2, AQT>(p.z + (size_t)tok0 * INW + h * 64, qf);
    Seg s0; s0.K = p.ck_na + (size_t)((bl * 4 + h) * 16) * 2048; s0.Vt = p.cvt_na + (size_t)((bl * 4 + h) * 16) * 2048; s0.ldk = 0; s0.ldv = 0; s0.nblk = 16; s0.pos0 = 0; s0.stride = 32;
    const int qrow = q0 >> 6;
    const int rstart = min(max(qrow - 4, 0), 8);
    Seg s1; s1.K = KLOC(h, tokb); s1.Vt = VLOC(h, tokb); s1.ldk = 0; s1.ldv = 0; s1.nblk = 16; s1.pos0 = rstart * 64; s1.stride = 32;
    astate_init<AQT>(st, -1e30f, 0.f);
    attn_run<64, AQT, 1, 2>(s0, s1, qf, 0.125f * LOG2E, st, q0, sm + 9000, 8 * wave, 8 * wave + 8);
    ocol = h * 64;
  }
  float lt[AQT];
#pragma unroll
  for (int q = 0; q < AQT; ++q) {
    lt[q] = st.ls[q];
    lt[q] += __shfl_xor(lt[q], 16);
    lt[q] += __shfl_xor(lt[q], 32);
  }
  constexpr int WS = 64 * 16 * AQT;
  float* pm = sm + 4 * WS;
  if (wave != 0) {
    float* po = sm + wave * WS + lane * (16 * AQT);
#pragma unroll
    for (int q = 0; q < AQT; ++q) {
#pragma unroll
      for (int dv = 0; dv < 4; ++dv) *(f32x4*)(po + q * 16 + dv * 4) = st.o[q][dv];
      if (g == 0) { pm[wave * QW + q * 16 + r] = st.m[q]; pm[4 * QW + wave * QW + q * 16 + r] = lt[q]; }
    }
  }
  __syncthreads();
  if (wave == 0) {
#pragma unroll
    for (int q = 0; q < AQT; ++q) {
      const float m1 = pm[1 * QW + q * 16 + r], m2 = pm[2 * QW + q * 16 + r], m3 = pm[3 * QW + q * 16 + r];
      const float l1 = pm[4 * QW + 1 * QW + q * 16 + r], l2 = pm[4 * QW + 2 * QW + q * 16 + r], l3 = pm[4 * QW + 3 * QW + q * 16 + r];
      const float M = fmaxf(fmaxf(st.m[q], m1), fmaxf(m2, m3));
      const float a0 = __builtin_amdgcn_exp2f(st.m[q] - M), a1 = __builtin_amdgcn_exp2f(m1 - M), a2 = __builtin_amdgcn_exp2f(m2 - M), a3 = __builtin_amdgcn_exp2f(m3 - M);
      const float inv = 1.f / (lt[q] * a0 + l1 * a1 + l2 * a2 + l3 * a3);
#pragma unroll
      for (int dv = 0; dv < 4; ++dv) {
        const f32x4 o1 = *(const f32x4*)(sm + 1 * WS + lane * (16 * AQT) + q * 16 + dv * 4);
        const f32x4 o2 = *(const f32x4*)(sm + 2 * WS + lane * (16 * AQT) + q * 16 + dv * 4);
        const f32x4 o3 = *(const f32x4*)(sm + 3 * WS + lane * (16 * AQT) + q * 16 + dv * 4);
        st.o[q][dv] = (st.o[q][dv] * a0 + o1 * a1 + o2 * a2 + o3 * a3) * inv;
      }
    }
    write_o<AQT>(p, st, tok0, ocol);
  }
  __syncthreads();
}

__device__ __forceinline__ int q_next(unsigned* cnt, volatile LAS unsigned* slot) {
  __syncthreads();
  if (threadIdx.x == 0) *slot = xb_add(cnt, 1u);
  __syncthreads();
  return (int)*slot;
}

#if REP_SYNC
#define GSYNC() do { xcd_barrier(xb); xcd_barrier(xb); } while (0)
#else
#define GSYNC() xcd_barrier(xb)
#endif
__global__ void __launch_bounds__(256, 2) mega(Params p) {
  extern __shared__ __attribute__((aligned(16))) unsigned char smem[];
  cg::grid_group grid = cg::this_grid();
  const int nblk = gridDim.x, bid = blockIdx.x;
  u16* sm16 = (u16*)smem;
  __shared__ uint4 xb_words[2];
  if (threadIdx.x == 0) { xb_words[0] = make_uint4(0u, 0u, 0u, 0u); xb_words[1] = make_uint4(0u, 0u, 0u, 0u); }
  __syncthreads();
  XcdBarrier xb = xcd_barrier_post(p.bar, (volatile LAS unsigned*)&xb_words[0]);

  for (int rep = 0; rep <= REP_P0; ++rep)
    for (int it = bid; it < P0_ITEMS; it += nblk) p0_item(p, it, smem);
  if (p.use_cg_sync) grid.sync();
  GSYNC();

  const int xcc = (int)xb.x;
  const int xrank = __builtin_amdgcn_readfirstlane((int)xb.st[4]), xnloc = __builtin_amdgcn_readfirstlane((int)xb.st[0]);
  const unsigned topo = (unsigned)__builtin_amdgcn_readfirstlane((int)xb.st[5]);
  const bool local = (topo & 1u) != 0u, full64 = (topo & 2u) != 0u;
#define LSYNC() do { if (local) xcd_barrier_local(xb); else GSYNC(); } while (0)
#define LMAP(j, count, total) (local ? ((xrank + (j) * xnloc) < (count) ? (xrank + (j) * xnloc) : -1) : ((bid + (j) * nblk) < (total) ? (bid + (j) * nblk) : -1))

#pragma unroll 1
  for (int l = 0; l < 4; ++l) {
    for (int j = 0;; ++j) { const int v = LMAP(j, 48, 384); if (v < 0) break; norm_item(p, l, 0, local ? 48 * xcc + v : v); }
    LSYNC();
    for (int j = 0;; ++j) {
      const int v = LMAP(j, 108, 864); if (v < 0) break;
      if (local) gin_tile(p, l, v / 6, 6 * xcc + v % 6, sm16); else gin_tile(p, l, v / 48, v % 48, sm16);
    }
    if (full64) {
      if (xrank >= 44) {
        const int idle = xcc * 20 + (xrank - 44);
        for (int it = 288 + idle; it < 928; it += 160) wt_item(p, l, it, (float*)smem);
      }
    }
    GSYNC();
    {
      constexpr int CD = 64 * NQG_CTX, CC = 2 * 64 * NQG_CTX / 4;
      constexpr int LD = 8 * NQG_LAT, LC = 2 * 8 * NQG_LAT;
      constexpr int E0 = 192, E1 = E0 + LD, E2 = E1 + LC, E3 = E2 + 32, E4 = E3 + CC, E5 = E4 + CD, E6 = E5 + 64;
      unsigned* qc = p.bar + XCD_BAR_WORDS + l * 64;
      const int w0 = full64 ? 928 : 288;
      const int EA = E6 + (1440 - w0), EW = EA + (l < 3 ? 288 : 0);
      for (int it = bid; it < EW; it = nblk + q_next(qc, &xb.st[2])) {
        if (it >= E6) {
          if (it < EA) wt_item(p, l, it - E6 + w0, (float*)smem);
          else wt_item(p, l + 1, it - EA, (float*)smem);
          continue;
        }
        if (it < E0) f1_tile(p, l, it, sm16);
        else if (it < E1) attn_diff_item(p, l, true, it - E0, (float*)smem);
        else if (it < E2) attn_lat_item(p, l, it - E1, (float*)smem);
        else if (it < E3) f2_tile(p, l, it - E2, sm16);
        else if (it < E4) attn_ctx_item(p, l, it - E3);
        else if (it < E5) attn_diff_item(p, l, false, it - E4, (float*)smem);
        else f2_tile(p, l, it - E5 + 32, sm16);
      }
    }
    GSYNC();
    for (int j = 0;; ++j) {
      const int v = LMAP(j, 64, 512); if (v < 0) break;
      if (local) res_tile(p, l, v / 8, 8 * xcc + v % 8, p.cat, p.w_outT + (size_t)l * 1024 * 1024, 1024, 2, sm16, l == 0);
      else res_tile(p, l, v / 64, v % 64, p.cat, p.w_outT + (size_t)l * 1024 * 1024, 1024, 2, sm16, l == 0);
    }
    LSYNC();
    for (int j = 0;; ++j) { const int v = LMAP(j, 48, 384); if (v < 0) break; norm_item(p, l, 1, local ? 48 * xcc + v : v); }
    LSYNC();
    for (int j = 0;; ++j) {
      const int v = LMAP(j, 192, 1536); if (v < 0) break;
      if (local) m1_tile(p, l, v / 6, 6 * xcc + v % 6, sm16); else m1_tile(p, l, v / 48, v % 48, sm16);
    }
    LSYNC();
    for (int j = 0;; ++j) {
      const int v = LMAP(j, 64, 512); if (v < 0) break;
      if (local) res_tile(p, l, v / 8, 8 * xcc + v % 8, p.u, p.w2T + (size_t)l * 1024 * 4096, 4096, 5, sm16);
      else res_tile(p, l, v / 64, v % 64, p.u, p.w2T + (size_t)l * 1024 * 4096, 4096, 5, sm16);
    }
    LSYNC();
  }
  for (int j = 0;; ++j) { const int v = LMAP(j, 48, 384); if (v < 0) break; norm_item(p, 0, 2, local ? 48 * xcc + v : v); }
#undef LSYNC
#undef LMAP
}

extern "C" void kernel_launch(void* const* d_in, const int* in_sizes, int n_in, void* d_out, int out_size, void* d_ws,
                              size_t ws_size, hipStream_t stream) {
  static int grid_blocks = 0;
  if (grid_blocks == 0) {
    int dev = 0, cus = 0, per_cu = 0;
    (void)hipGetDevice(&dev);
    (void)hipDeviceGetAttribute(&cus, hipDeviceAttributeMultiprocessorCount, dev);
    if (hipFuncSetAttribute((const void*)mega, hipFuncAttributeMaxDynamicSharedMemorySize, LDS_BYTES) != hipSuccess) {
      fprintf(stderr, "hipFuncSetAttribute failed\n");
    }
    if (hipOccupancyMaxActiveBlocksPerMultiprocessor(&per_cu, (const void*)mega, 256, LDS_BYTES) != hipSuccess || per_cu < 1) {
      fprintf(stderr, "occupancy query failed (%d)\n", per_cu);
      per_cu = 1;
    }
    if (per_cu > 2) per_cu = 2;
    grid_blocks = cus * per_cu;
    fprintf(stderr, "mega: cus=%d per_cu=%d grid=%d ws=%zu\n", cus, per_cu, grid_blocks, ws_size);
  }
  Params p{};
  const float** pin = (const float**)&p;
  for (int i = 0; i < 27; ++i) pin[i] = (const float*)d_in[i];
  p.out = (float*)d_out;
  unsigned char* ws = (unsigned char*)d_ws;
  size_t off = 0;
  auto take = [&](size_t bytes) { unsigned char* q = ws + off; off += (bytes + 255) & ~(size_t)255; return q; };
  p.xres = (float*)take((size_t)NTOK * 1024 * 4);
  p.mods = (float*)take((size_t)4 * 3 * 6144 * 4);
  p.h = (u16*)take((size_t)NTOK * 1024 * 2);
  p.z = (u16*)take((size_t)NTOK * INW * 2);
  p.vt = (u16*)take((size_t)640 * NTOK * 2);
  p.cat = (u16*)take((size_t)NTOK * 1024 * 2);
  p.u = (u16*)take((size_t)NTOK * 4096 * 2);
  p.uv = (u16*)take((size_t)(16 * 256 * 512 + 2 * 256 * 2048) * 2);
  p.w_inT = (u16*)take((size_t)4 * 2304 * 1024 * 2);
  p.w_outT = (u16*)take((size_t)4 * 1024 * 1024 * 2);
  p.w1T = (u16*)take((size_t)4 * 4096 * 1024 * 2);
  p.w2T = (u16*)take((size_t)4 * 4096 * 1024 * 2);
  p.pqt = (u16*)take((size_t)4 * 512 * 256 * 2);
  p.dft256 = (u16*)take((size_t)256 * 512 * 2);
  p.dft1024 = (u16*)take((size_t)1024 * 2048 * 2);
  p.ck_na = (u16*)take((size_t)2 * 4 * 512 * 256 * 2);
  p.cvt_na = (u16*)take((size_t)2 * 4 * 512 * 256 * 2);
  p.ck_diff = (u16*)take((size_t)2 * 4 * 512 * 256 * 2);
  p.cvt_diff = (u16*)take((size_t)2 * 4 * 512 * 256 * 2);
  p.ck_swa = (u16*)take((size_t)2 * 4 * 512 * 128 * 2);
  p.cvt_swa = (u16*)take((size_t)2 * 4 * 512 * 128 * 2);
  p.kfr = (u16*)take((size_t)10 * 192 * 2048 * 2);
  p.vfr = (u16*)take((size_t)10 * 192 * 2048 * 2);
  p.ropeD = (float*)take(1024 * 4);
  p.ropeS = (float*)take(2048 * 4);
  p.bar = (unsigned*)take(XB_ALL_WORDS * 4);
  if (off > ws_size) { fprintf(stderr, "workspace too small: need %zu have %zu\n", off, ws_size); return; }
  if (hipMemsetAsync(p.bar, 0, XB_ALL_WORDS * 4, stream) != hipSuccess) fprintf(stderr, "memset failed\n");
  void* args[] = {&p};
  hipError_t e = hipLaunchCooperativeKernel((const void*)mega, dim3(grid_blocks), dim3(256), args, LDS_BYTES, stream);
  if (e != hipSuccess) fprintf(stderr, "cooperative launch failed: %s (grid %d)\n", hipGetErrorString(e), grid_blocks);
}
```

```cpp
#include <hip/hip_runtime.h>
#include <hip/hip_cooperative_groups.h>
#include <stdint.h>
#include <stdio.h>
namespace cg = cooperative_groups;

typedef unsigned short u16;
typedef __attribute__((ext_vector_type(8))) short bf16x8;
typedef __attribute__((ext_vector_type(4))) float f32x4;
typedef __attribute__((ext_vector_type(4))) unsigned u32x4;
__device__ __forceinline__ void gload16(u32x4& dst, const void* ptr) {
  asm volatile("global_load_dwordx4 %0, %1, off" : "=v"(dst) : "v"(ptr) : "memory");
}

#define NTOK 6144
#define NPTOK 4096
#define INW 2304
#define LOG2E 1.4426950408889634f
#define LDS_BYTES 73728
#define LSTR 72

#define O_NAK 6291456
#define O_NAV 10485760
#define O_DK 14680064
#define O_DV 18874368
#define O_SK 23068672
#define O_SV 25165824

struct Params {
  const float *x_prompt, *x_sample, *c_na_k, *c_na_v, *c_diff_k, *c_diff_v, *c_swa_k, *c_swa_v, *c, *c_ctx;
  const float *w_ada, *b_ada, *norm1_g, *norm2_g, *w_in, *na_rpb, *lq1, *lk1, *lq2, *lk2, *subln_g, *w_fourier, *swa_sink;
  const float *w_out, *w1, *w2, *final_g;
  float* out;
  float* xres;
  float* mods;
  u16 *h, *z, *vt, *cat, *u, *uv, *w_inT, *w_outT, *w1T, *w2T, *pqt, *dft256, *dft1024;
  u16 *ck_na, *cvt_na, *ck_diff, *cvt_diff, *ck_swa, *cvt_swa;
  float *ropeD, *ropeS;
  u16 *kfr, *vfr;
  unsigned* bar;
  int use_cg_sync;
  int pad_;
};

__device__ __forceinline__ u16 f2bf(float f) {
  unsigned u = __float_as_uint(f);
  u += 0x7fffu + ((u >> 16) & 1u);
  return (u16)(u >> 16);
}
__device__ __forceinline__ int otid() { int t = threadIdx.x; asm volatile("" : "+v"(t)); return t; }
__device__ __forceinline__ float bf2f(u16 h) { return __uint_as_float(((unsigned)h) << 16); }
typedef __attribute__((ext_vector_type(2))) __bf16 hbf16x2;
typedef __attribute__((ext_vector_type(2))) float f32x2;
__device__ __forceinline__ unsigned pack2(float a, float b) {
  f32x2 v = {a, b};
  union { hbf16x2 h; unsigned u; } x;
  x.h = __builtin_convertvector(v, hbf16x2);
  return x.u;
}

__device__ __forceinline__ int kfrag_off(int kk, int d) {
  const int t = (kk >> 2) & 1, r = ((kk >> 3) << 2) | (kk & 3), dc = d >> 5, g = (d >> 3) & 3;
  return ((t * 2 + dc) * 64 + g * 16 + r) * 8 + (d & 7);
}
__device__ __forceinline__ int vfrag_off(int kk, int dv) {
  return (((dv >> 4) * 64) + (kk >> 3) * 16 + (dv & 15)) * 8 + (kk & 7);
}

#define XB_TMO      128
#define XB_XCNT(j)  (256  + 64 * (j))
#define XB_XSUB(j)  (1280 + 64 * (j))
#define XB_XGEN(j)  (2304 + 64 * (j))
#define XB_TOP      3328
#define XB_TOPGEN   3392
#define XCD_BAR_WORDS 3456
#define XB_SPIN_CAP (1u << 22)
#define LAS __attribute__((address_space(3)))
__device__ __forceinline__ unsigned xb_ld(unsigned* p)              { return __hip_atomic_load(p, __ATOMIC_RELAXED, __HIP_MEMORY_SCOPE_AGENT); }
__device__ __forceinline__ unsigned xb_add(unsigned* p, unsigned v) { return __hip_atomic_fetch_add(p, v, __ATOMIC_RELAXED, __HIP_MEMORY_SCOPE_AGENT); }
__device__ __forceinline__ unsigned xb_xcc_id() { return (unsigned)__builtin_amdgcn_s_getreg((3 << 11) | 20) & 0xFu; }
#define XB_SPIN(cond, bar) do { unsigned _sp = 0; while (cond) { __builtin_amdgcn_s_sleep(1); \
    if ((++_sp & 255u) == 0u) { if (xb_ld(&(bar)[XB_TMO])) break; if (_sp > XB_SPIN_CAP) { atomicAdd(&(bar)[XB_TMO], 1u); break; } } } } while (0)
#define XB_LSUB(j)  (XCD_BAR_WORDS + 12 * 64 + 64 * (j))
#define XB_LGEN(j)  (XCD_BAR_WORDS + 12 * 64 + 64 * (16 + (j)))
#define XB_ALL_WORDS (XCD_BAR_WORDS + 12 * 64 + 32 * 64)
struct XcdBarrier { unsigned* bar; unsigned x; volatile LAS unsigned* st; };
__device__ __forceinline__ XcdBarrier xcd_barrier_post(unsigned* bar, volatile LAS unsigned* st) {
  XcdBarrier b; b.bar = bar; b.x = xb_xcc_id(); b.st = st;
  if (threadIdx.x == 0) st[4] = xb_add(&bar[XB_XCNT(b.x)], 1u);
  return b;
}
__device__ __forceinline__ void xcd_barrier_complete(unsigned* bar, unsigned x, unsigned& nloc, unsigned& nx) {
  const unsigned G = gridDim.x * gridDim.y * gridDim.z;
  unsigned sum, cnt, mine, sp = 0u;
  for (;;) {
    sum = 0u; cnt = 0u; mine = 0u;
#pragma unroll
    for (unsigned j = 0; j < 16; ++j) { const unsigned c = xb_ld(&bar[XB_XCNT(j)]); sum += c; cnt += (c > 0u) ? 1u : 0u; mine = (j == x) ? c : mine; }
    if (sum == G) break;
    __builtin_amdgcn_s_sleep(1);
    if ((++sp & 255u) == 0u) { if (xb_ld(&bar[XB_TMO])) break; if (sp > XB_SPIN_CAP) { atomicAdd(&bar[XB_TMO], 1u); break; } }
  }
  nloc = mine > 0u ? mine : 1u; nx = cnt > 0u ? cnt : 1u;
}
__device__ __forceinline__ unsigned xcd_topology(unsigned* bar) {
  const unsigned G = gridDim.x * gridDim.y * gridDim.z;
  unsigned sum8 = 0u, all = 1u, all64 = 1u;
#pragma unroll
  for (unsigned j = 0; j < 8; ++j) { const unsigned c = xb_ld(&bar[XB_XCNT(j)]); sum8 += c; all &= (c > 0u) ? 1u : 0u; all64 &= (c == 64u) ? 1u : 0u; }
  const unsigned ok = (all && sum8 == G) ? 1u : 0u;
  return ok | ((ok && all64) ? 2u : 0u);
}
__device__ __forceinline__ void xcd_barrier(const XcdBarrier& b) {
  asm volatile("s_waitcnt vmcnt(0)" ::: "memory");
  __syncthreads();
  if (threadIdx.x == 0) {
    unsigned* bar = b.bar;
    __builtin_amdgcn_s_waitcnt(0);
    unsigned nloc = b.st[0], nx = b.st[1];
    if (nloc == 0u) { xcd_barrier_complete(bar, b.x, nloc, nx); b.st[0] = nloc; b.st[1] = nx; b.st[5] = xcd_topology(bar); }
    const unsigned old = xb_add(&bar[XB_XSUB(b.x)], 1u);
    const unsigned gen = old / nloc;
    if (old + 1u == (gen + 1u) * nloc) {
      __builtin_amdgcn_fence(__ATOMIC_RELEASE, "agent");
      asm volatile("s_waitcnt vmcnt(0)" ::: "memory");
      const unsigned og = xb_add(&bar[XB_TOP], 1u);
      const unsigned tg = og / nx;
      if (og + 1u == (tg + 1u) * nx) xb_add(&bar[XB_TOPGEN], 1u);
      else XB_SPIN(xb_ld(&bar[XB_TOPGEN]) == tg, bar);
      __builtin_amdgcn_fence(__ATOMIC_ACQUIRE, "agent");
      xb_add(&bar[XB_XGEN(b.x)], 1u);
      asm volatile("s_waitcnt vmcnt(0)" ::: "memory");
    } else {
      XB_SPIN(xb_ld(&bar[XB_XGEN(b.x)]) == gen, bar);
      __builtin_amdgcn_fence(__ATOMIC_ACQUIRE, "agent");
      asm volatile("s_waitcnt vmcnt(0)" ::: "memory");
    }
  }
  __syncthreads();
}

__device__ __forceinline__ void xcd_barrier_local(const XcdBarrier& b) {
  asm volatile("s_waitcnt vmcnt(0)" ::: "memory");
  __syncthreads();
  if (threadIdx.x == 0) {
    unsigned* bar = b.bar;
    __builtin_amdgcn_s_waitcnt(0);
    const unsigned nloc = b.st[0];
    const unsigned old = xb_add(&bar[XB_LSUB(b.x)], 1u);
    const unsigned gen = old / nloc;
    if (old + 1u == (gen + 1u) * nloc) xb_add(&bar[XB_LGEN(b.x)], 1u);
    else XB_SPIN(xb_ld(&bar[XB_LGEN(b.x)]) == gen, bar);
    __builtin_amdgcn_fence(__ATOMIC_ACQUIRE, "agent");
    asm volatile("s_waitcnt vmcnt(0)" ::: "memory");
  }
  __syncthreads();
}

__device__ __forceinline__ void transpose_tile(const float* __restrict__ src, int lds_, u16* __restrict__ dst, int ldd,
                                               int k0, int n0, float* sm, bool fragv = false) {
  const int tid = otid();
  const int c4 = (tid & 15) * 4, r0 = tid >> 4;
  float4 v[8];
#pragma unroll
  for (int i = 0; i < 8; ++i) v[i] = *(const float4*)(src + (size_t)(k0 + r0 + 16 * i) * lds_ + n0 + c4);
#pragma unroll
  for (int i = 0; i < 8; ++i) {
    const int k = r0 + 16 * i;
    sm[(c4 + 0) * 129 + k] = v[i].x; sm[(c4 + 1) * 129 + k] = v[i].y; sm[(c4 + 2) * 129 + k] = v[i].z; sm[(c4 + 3) * 129 + k] = v[i].w;
  }
  __syncthreads();
  const int k8 = (tid & 15) * 8, nn = tid >> 4;
#pragma unroll
  for (int i = 0; i < 4; ++i) {
    const int n = nn + 16 * i;
    const float* row = sm + n * 129 + k8;
    uint4 w;
    w.x = pack2(row[0], row[1]); w.y = pack2(row[2], row[3]); w.z = pack2(row[4], row[5]); w.w = pack2(row[6], row[7]);
    if (fragv) {
      const int col = n0 + n, pos = k0 + k8;
      *(uint4*)(dst + ((size_t)((col >> 6) * 16 + (pos >> 5))) * 2048 + vfrag_off(pos & 31, col & 63)) = w;
    } else {
      *(uint4*)(dst + (size_t)(n0 + n) * ldd + k0 + k8) = w;
    }
  }
  __syncthreads();
}

__device__ __forceinline__ void adaln_item(const Params& p, int it, float* sm) {
  const int l = it / 192, c0 = (it % 192) * 32;
  float* ssil = sm;
  float* red = sm + 3072;
  const int tid = otid();
  for (int i = tid; i < 3072; i += 256) {
    const int cnd = i >> 10, k = i & 1023;
    const float v = cnd == 0 ? p.c_ctx[k] : p.c[(cnd - 1) * 1024 + k];
    ssil[i] = v / (1.f + expf(-v));
  }
  __syncthreads();
  const int cg4 = (tid & 7) * 4, ks = tid >> 3;
  const float* w = p.w_ada + (size_t)l * 1024 * 6144 + c0 + cg4;
  float a0[4] = {0.f, 0.f, 0.f, 0.f}, a1[4] = {0.f, 0.f, 0.f, 0.f}, a2[4] = {0.f, 0.f, 0.f, 0.f};
#pragma unroll 16
  for (int kk = 0; kk < 32; ++kk) {
    const int k = kk * 32 + ks;
    const float4 v = *(const float4*)(w + (size_t)k * 6144);
    const float s0 = ssil[k], s1 = ssil[1024 + k], s2 = ssil[2048 + k];
    a0[0] += s0 * v.x; a0[1] += s0 * v.y; a0[2] += s0 * v.z; a0[3] += s0 * v.w;
    a1[0] += s1 * v.x; a1[1] += s1 * v.y; a1[2] += s1 * v.z; a1[3] += s1 * v.w;
    a2[0] += s2 * v.x; a2[1] += s2 * v.y; a2[2] += s2 * v.z; a2[3] += s2 * v.w;
  }
#pragma unroll
  for (int j = 0; j < 4; ++j) {
    red[(ks * 3 + 0) * 32 + cg4 + j] = a0[j];
    red[(ks * 3 + 1) * 32 + cg4 + j] = a1[j];
    red[(ks * 3 + 2) * 32 + cg4 + j] = a2[j];
  }
  __syncthreads();
  if (tid < 96) {
    const int cnd = tid >> 5, j = tid & 31;
    float s = p.b_ada[l * 6144 + c0 + j];
    for (int q = 0; q < 32; ++q) s += red[(q * 3 + cnd) * 32 + j];
    p.mods[(l * 3 + cnd) * 6144 + c0 + j] = s;
  }
  __syncthreads();
}

__device__ __forceinline__ void cvt_item(const float* __restrict__ src, u16* __restrict__ dst, int it, int W) {
  const int w8 = W >> 3;
#pragma unroll
  for (int i = 0; i < 4; ++i) {
    const int u = it * 1024 + i * 256 + otid();
    const int d8 = u % w8, pos = (u / w8) & 511, bl = u / (w8 * 512);
    const float* sp = src + ((size_t)(bl * 512 + pos) * W + d8 * 8);
    const float4 v0 = *(const float4*)sp, v1 = *(const float4*)(sp + 4);
    uint4 w; w.x = pack2(v0.x, v0.y); w.y = pack2(v0.z, v0.w); w.z = pack2(v1.x, v1.y); w.w = pack2(v1.z, v1.w);
    const int h = d8 >> 3, d = (d8 & 7) * 8;
    *(uint4*)(dst + ((size_t)((bl * (W >> 6) + h) * 16 + (pos >> 5))) * 2048 + kfrag_off(pos & 31, d)) = w;
  }
}

__device__ __forceinline__ void pq_item(const Params& p, int it, float* sm) {
  const int cq = it & 3, it2 = it >> 2;
  const int l = it2 >> 3, which = (it2 >> 2) & 1, g = it2 & 3;
  const int n = otid();
  if (n < 64) sm[n] = which ? sinpif(2.f * (float)n / 64.f) : cospif(2.f * (float)n / 64.f);
  __syncthreads();
  float w[64];
#pragma unroll
  for (int m = 0; m < 64; ++m) w[m] = p.w_fourier[(size_t)l * 65536 + (g * 64 + m) * 256 + n];
  u16* dst = p.pqt + (size_t)l * 512 * 256 + (size_t)(which * 256 + n) * 256 + g * 64;
  for (int c = cq * 16; c < cq * 16 + 16; ++c) {
    float s = 0.f;
#pragma unroll
    for (int m = 0; m < 64; ++m) s += sm[(c * m) & 63] * w[m];
    dst[c] = f2bf(s);
  }
  __syncthreads();
}

__device__ __forceinline__ void dft_item(u16* dst, int L, int it) {
  const int twoL = 2 * L;
  for (int e = otid(); e < 8192; e += 256) {
    const int idx = it * 8192 + e;
    const int k = idx / twoL, j = idx % twoL;
    const int jj = j & (L - 1);
    const int ph = (k * jj) & (L - 1);
    const float a = 2.f * (float)ph / (float)L;
    const float v = (j >= L) ? -sinpif(a) : cospif(a);
    dst[idx] = f2bf(v);
  }
}

#define P0_WT 288
#define P0_ADA 768
#define P0_XC 0
#define P0_CK 320
#define P0_CVT 320
#define P0_PQ 128
#define P0_DFT 272
#define P0_ITEMS (P0_ADA + P0_WT + P0_XC + P0_CK + P0_CVT + P0_PQ + P0_DFT + 1)

__device__ void wt_item(const Params& p, int l, int r, float* sm) {
  if (r < 288) { transpose_tile(p.w_in + (size_t)l * 1024 * 2304, 2304, p.w_inT + (size_t)l * 2304 * 1024, 1024, (r / 36) * 128, (r % 36) * 64, sm); return; }
  r -= 288;
  if (r < 128) { transpose_tile(p.w_out + (size_t)l * 1024 * 1024, 1024, p.w_outT + (size_t)l * 1024 * 1024, 1024, (r / 16) * 128, (r % 16) * 64, sm); return; }
  r -= 128;
  if (r < 512) { transpose_tile(p.w1 + (size_t)l * 1024 * 4096, 4096, p.w1T + (size_t)l * 4096 * 1024, 1024, (r / 64) * 128, (r % 64) * 64, sm); return; }
  r -= 512;
  transpose_tile(p.w2 + (size_t)l * 4096 * 1024, 1024, p.w2T + (size_t)l * 1024 * 4096, 4096, (r / 16) * 128, (r % 16) * 64, sm);
}

__device__ void p0_item(const Params& p, int it, unsigned char* smem) {
  float* sm = (float*)smem;
  if (it < P0_ADA) { adaln_item(p, it, sm); return; }
  it -= P0_ADA;
  if (it < P0_WT) { wt_item(p, 0, it, sm); return; }
  it -= P0_WT;
  if (it < P0_XC) {
    const int row0 = it * 16;
    const float* src = row0 < NPTOK ? p.x_prompt + (size_t)row0 * 1024 : p.x_sample + (size_t)(row0 - NPTOK) * 1024;
    float* dst = p.xres + (size_t)row0 * 1024;
#pragma unroll
    for (int i = 0; i < 16; ++i) {
      const int o = (i * 256 + otid()) * 4;
      *(float4*)(dst + o) = *(const float4*)(src + o);
    }
    return;
  }
  it -= P0_XC;
  if (it < P0_CK) {
    if (it < 128) { cvt_item(p.c_na_k, p.ck_na, it, 256); return; }
    it -= 128;
    if (it < 128) { cvt_item(p.c_diff_k, p.ck_diff, it, 256); return; }
    it -= 128;
    cvt_item(p.c_swa_k, p.ck_swa, it, 128);
    return;
  }
  it -= P0_CK;
  if (it < P0_CVT) {
    if (it < 128) { const int bl = it >> 4, r = it & 15; transpose_tile(p.c_na_v + (size_t)bl * 512 * 256, 256, p.cvt_na + (size_t)bl * 256 * 512, 512, (r >> 2) * 128, (r & 3) * 64, sm, true); return; }
    it -= 128;
    if (it < 128) { const int bl = it >> 4, r = it & 15; transpose_tile(p.c_diff_v + (size_t)bl * 512 * 256, 256, p.cvt_diff + (size_t)bl * 256 * 512, 512, (r >> 2) * 128, (r & 3) * 64, sm, true); return; }
    it -= 128;
    { const int bl = it >> 3, r = it & 7; transpose_tile(p.c_swa_v + (size_t)bl * 512 * 128, 128, p.cvt_swa + (size_t)bl * 128 * 512, 512, (r >> 1) * 128, (r & 1) * 64, sm, true); return; }
  }
  it -= P0_CVT;
  if (it < P0_PQ) { pq_item(p, it, sm); return; }
  it -= P0_PQ;
  if (it < 16) { dft_item(p.dft256, 256, it); return; }
  it -= 16;
  if (it < 256) { dft_item(p.dft1024, 1024, it); return; }
  for (int e = otid(); e < 512 + 1024; e += 256) {
    const bool isD = e < 512;
    const int ee = isD ? e : e - 512;
    const int nf = isD ? 8 : 16;
    const int pos = ee / nf, fi = ee % nf;
    const float inv = exp2f(-(float)fi * (13.287712379549449f / (float)nf));
    float tt = (float)pos * inv * 0.15915494309189535f;
    tt -= rintf(tt);
    float sn, cs;
    sincospif(2.f * tt, &sn, &cs);
    if (isD) { p.ropeD[ee] = cs; p.ropeD[512 + ee] = sn; }
    else { p.ropeS[ee] = cs; p.ropeS[1024 + ee] = sn; }
  }
}

__device__ __forceinline__ void norm_item(const Params& p, int l, int which, int it) {
  const int lane = otid() & 63, wave = otid() >> 6;
  const int row0 = it * 16 + wave * 4;
  const float* xsrc = (which == 0 && l == 0) ? (row0 < NPTOK ? p.x_prompt + (size_t)row0 * 1024 : p.x_sample + (size_t)(row0 - NPTOK) * 1024)
                                             : p.xres + (size_t)row0 * 1024;
  float4 v[4][4];
#pragma unroll
  for (int j = 0; j < 4; ++j)
#pragma unroll
    for (int k = 0; k < 4; ++k) v[j][k] = *(const float4*)(xsrc + (size_t)j * 1024 + (k * 64 + lane) * 4);
  float rs[4];
#pragma unroll
  for (int j = 0; j < 4; ++j) {
    float ss = 0.f;
#pragma unroll
    for (int k = 0; k < 4; ++k) ss += v[j][k].x * v[j][k].x + v[j][k].y * v[j][k].y + v[j][k].z * v[j][k].z + v[j][k].w * v[j][k].w;
#pragma unroll
    for (int o = 32; o >= 1; o >>= 1) ss += __shfl_xor(ss, o);
    rs[j] = rsqrtf(ss * (1.f / 1024.f) + 1e-6f);
  }
  if (which < 2) {
    const int cond = row0 < NPTOK ? 0 : 1 + ((row0 - NPTOK) >> 10);
    const float* gp = (which == 0 ? p.norm1_g : p.norm2_g) + l * 1024;
    const float* shp = p.mods + (size_t)(l * 3 + cond) * 6144 + (which * 3 + 0) * 1024;
    const float* scp = shp + 1024;
#pragma unroll
    for (int k = 0; k < 4; ++k) {
      const int col = (k * 64 + lane) * 4;
      const float4 gg = *(const float4*)(gp + col);
      const float4 sh = *(const float4*)(shp + col);
      const float4 sc = *(const float4*)(scp + col);
      const float mx = gg.x * (1.f + sc.x), my = gg.y * (1.f + sc.y), mz = gg.z * (1.f + sc.z), mw = gg.w * (1.f + sc.w);
#pragma unroll
      for (int j = 0; j < 4; ++j) {
        uint2 w;
        w.x = pack2(v[j][k].x * rs[j] * mx + sh.x, v[j][k].y * rs[j] * my + sh.y);
        w.y = pack2(v[j][k].z * rs[j] * mz + sh.z, v[j][k].w * rs[j] * mw + sh.w);
        *(uint2*)(p.h + (size_t)(row0 + j) * 1024 + col) = w;
      }
    }
  } else {
#pragma unroll
    for (int k = 0; k < 4; ++k) {
      const int col = (k * 64 + lane) * 4;
      const float4 gg = *(const float4*)(p.final_g + col);
#pragma unroll
      for (int j = 0; j < 4; ++j) {
        float4 o;
        o.x = v[j][k].x * rs[j] * gg.x; o.y = v[j][k].y * rs[j] * gg.y; o.z = v[j][k].z * rs[j] * gg.z; o.w = v[j][k].w * rs[j] * gg.w;
        *(float4*)(p.out + (size_t)(row0 + j) * 1024 + col) = o;
      }
    }
  }
}

template <bool ZERO, int YT>
__device__ __forceinline__ void gemm_main_t(const u16* __restrict__ X, int ldx, const u16* __restrict__ Y, int ldy, int K,
                                          u16* smem, f32x4 (&acc)[4][YT]) {
  const int tid = otid(), lane = tid & 63, wave = tid >> 6, wx = wave & 1, wy = wave >> 1, r = lane & 15, g = lane >> 4;
  u16* sX = smem;
  u16* sY = smem + 2 * 128 * 64;
  const int lrow = tid >> 3, lkc = tid & 7;
  const int gsw = (lkc ^ (lrow & 7)) * 8;
  const u16* gx = X + (size_t)lrow * ldx + gsw;
  const u16* gy = Y + (size_t)lrow * ldy + gsw;
  u16* lx = sX + tid * 8;
  u16* ly = sY + tid * 8;
#define GEMM_STAGE(buf, kt_)                                                                                                      \
  {                                                                                                                               \
    _Pragma("unroll") for (int i = 0; i < 4; ++i)                                                                                 \
      __builtin_amdgcn_global_load_lds((const unsigned*)(gx + (size_t)(32 * i) * ldx + (kt_) * 64),                               \
                                       (unsigned*)(lx + (buf) * 8192 + i * 2048), 16, 0, 0);                                      \
    _Pragma("unroll") for (int i = 0; i < YT; ++i)                                                                                \
      __builtin_amdgcn_global_load_lds((const unsigned*)(gy + (size_t)(32 * i) * ldy + (kt_) * 64),                               \
                                       (unsigned*)(ly + (buf) * 8192 + i * 2048), 16, 0, 0);                                      \
  }
  GEMM_STAGE(0, 0);
  if (ZERO) {
#pragma unroll
    for (int a = 0; a < 4; ++a)
#pragma unroll
      for (int b = 0; b < YT; ++b) acc[a][b] = (f32x4){0.f, 0.f, 0.f, 0.f};
  }
  const int nk = K >> 6;
  const int sw = r & 7;
  const u16* cx0 = sX + (wx * 64 + r) * 64;
  const u16* cy0 = sY + (wy * (16 * YT) + r) * 64;
  __syncthreads();
#define GEMM_COMPUTE(cur)                                                                            \
  {                                                                                                  \
    const u16* cx = cx0 + (cur) * 8192;                                                              \
    const u16* cy = cy0 + (cur) * 8192;                                                              \
    const int pc0 = (g ^ sw) * 8, pc1 = ((4 + g) ^ sw) * 8;                                          \
    bf16x8 a0[4], b0[YT], a1[4], b1[YT];                                                             \
    _Pragma("unroll") for (int i = 0; i < 4; ++i) a0[i] = *(const bf16x8*)(cx + i * 16 * 64 + pc0);  \
    _Pragma("unroll") for (int i = 0; i < YT; ++i) b0[i] = *(const bf16x8*)(cy + i * 16 * 64 + pc0); \
    _Pragma("unroll") for (int i = 0; i < 4; ++i) a1[i] = *(const bf16x8*)(cx + i * 16 * 64 + pc1);  \
    _Pragma("unroll") for (int i = 0; i < YT; ++i) b1[i] = *(const bf16x8*)(cy + i * 16 * 64 + pc1); \
    __builtin_amdgcn_s_setprio(1);                                                                   \
    _Pragma("unroll") for (int xi = 0; xi < 4; ++xi)                                                 \
      _Pragma("unroll") for (int yi = 0; yi < YT; ++yi)                                              \
        acc[xi][yi] = __builtin_amdgcn_mfma_f32_16x16x32_bf16(a0[xi], b0[yi], acc[xi][yi], 0, 0, 0); \
    _Pragma("unroll") for (int xi = 0; xi < 4; ++xi)                                                 \
      _Pragma("unroll") for (int yi = 0; yi < YT; ++yi)                                              \
        acc[xi][yi] = __builtin_amdgcn_mfma_f32_16x16x32_bf16(a1[xi], b1[yi], acc[xi][yi], 0, 0, 0); \
    __builtin_amdgcn_s_setprio(0);                                                                   \
  }
#pragma unroll 1
  for (int kt = 0; kt < nk - 1; ++kt) {
    const int cur = kt & 1;
    GEMM_STAGE(cur ^ 1, kt + 1);
    GEMM_COMPUTE(cur);
    __syncthreads();
  }
  GEMM_COMPUTE((nk - 1) & 1);
  __syncthreads();
#undef GEMM_COMPUTE
#undef GEMM_STAGE
}

#ifndef REP_GEMM
#define REP_GEMM 0
#endif
#ifndef REP_MIX
#define REP_MIX 0
#endif
#ifndef REP_SYNC
#define REP_SYNC 0
#endif
#ifndef REP_P0
#define REP_P0 0
#endif
template <int YT>
__device__ __forceinline__ void gemm_main(const u16* __restrict__ X, int ldx, const u16* __restrict__ Y, int ldy, int K,
                                          u16* smem, f32x4 (&acc)[4][YT]) {
  gemm_main_t<true, YT>(X, ldx, Y, ldy, K, smem, acc);
#if REP_GEMM
  gemm_main_t<false, YT>(X, ldx, Y, ldy, K, smem, acc);
#pragma unroll
  for (int a = 0; a < 4; ++a)
#pragma unroll
    for (int b = 0; b < YT; ++b) acc[a][b] *= 0.5f;
#endif
}

__device__ __forceinline__ bool tile_map(int j, int ntx, int& tx, int& ty, int nty = 48) {
  const int nblk = gridDim.x, bid = blockIdx.x;
  if (nblk == 512) {
    const int per = nty >> 3, hp = per >> 1;
    const int rank = bid >> 3, q = (rank & 31) + j * 32, mem = rank >> 5;
    if (q >= hp * ntx) return false;
    tx = q / hp; ty = per * (bid & 7) + 2 * (q % hp) + mem;
    return true;
  } else {
    const int it = bid + j * nblk;
    if (it >= nty * ntx) return false;
    tx = it / nty; ty = it % nty;
    return true;
  }
}

__device__ void gin_tile(const Params& p, int l, int tx, int ty, u16* smem) {
  const int n0 = tx * 128, m0 = ty * 128;
  f32x4 acc[4][4];
  gemm_main<4>(p.w_inT + (size_t)l * 2304 * 1024 + (size_t)n0 * 1024, 1024, p.h + (size_t)m0 * 1024, 1024, 1024, smem, acc);
  const int lane = otid() & 63, wave = otid() >> 6, wx = wave & 1, wy = wave >> 1, r = lane & 15, g = lane >> 4;
  const int nw = n0 + wx * 64;
  const bool isS = m0 >= NPTOK;
  int ropeMode = 0;
  if (isS) {
    if (nw >= 768 && nw < 1280) ropeMode = 1;
    else if (nw >= 1792 && nw < 2176) ropeMode = 2;
  }
  float* okv = nullptr; int okv_w = 0, okv_c = 0;
  if (!isS) {
    if (nw >= 256 && nw < 512) { okv = p.out + O_NAK; okv_w = 256; okv_c = nw - 256; }
    else if (nw >= 512 && nw < 768) { okv = p.out + O_NAV; okv_w = 256; okv_c = nw - 512; }
    else if (nw >= 1024 && nw < 1280) { okv = p.out + O_DK; okv_w = 256; okv_c = nw - 1024; }
    else if (nw >= 1280 && nw < 1536) { okv = p.out + O_DV; okv_w = 256; okv_c = nw - 1280; }
    else if (nw >= 2048 && nw < 2176) { okv = p.out + O_SK; okv_w = 128; okv_c = nw - 2048; }
    else if (nw >= 2176) { okv = p.out + O_SV; okv_w = 128; okv_c = nw - 2176; }
  }
  int khh = -1;
  if (nw >= 256 && nw < 512) khh = (nw - 256) >> 6;
  else if (nw >= 1024 && nw < 1280) khh = 4 + ((nw - 1024) >> 6);
  else if (nw >= 2048 && nw < 2176) khh = 8 + ((nw - 2048) >> 6);
  int vrow = -1;
  if (nw >= 512 && nw < 768) vrow = nw - 512;
  else if (nw >= 1280 && nw < 1536) vrow = 256 + nw - 1280;
  else if (nw >= 2176) vrow = 512 + nw - 2176;
#pragma unroll
  for (int yi = 0; yi < 4; ++yi) {
    const int m = m0 + wy * 64 + yi * 16 + r;
    const int t = (m - NPTOK) & 1023;
    const int prow = t >> 6, pcol = t & 63;
#pragma unroll
    for (int xi = 0; xi < 4; ++xi) {
      f32x4 v = acc[xi][yi];
      if (ropeMode == 1) {
        const int pos = (xi & 1) ? pcol : prow;
        const float4 cs = *(const float4*)(p.ropeD + pos * 8 + 4 * (g & 1));
        const float4 sn = *(const float4*)(p.ropeD + 512 + pos * 8 + 4 * (g & 1));
        const float sg = (g >= 2) ? 1.f : -1.f;
        const float o0 = __shfl_xor(v[0], 32), o1 = __shfl_xor(v[1], 32), o2 = __shfl_xor(v[2], 32), o3 = __shfl_xor(v[3], 32);
        v[0] = v[0] * cs.x + sg * o0 * sn.x; v[1] = v[1] * cs.y + sg * o1 * sn.y;
        v[2] = v[2] * cs.z + sg * o2 * sn.z; v[3] = v[3] * cs.w + sg * o3 * sn.w;
      } else if (ropeMode == 2) {
        const int pos = (xi >> 1) ? pcol : prow;
        const float4 cs = *(const float4*)(p.ropeS + pos * 16 + 4 * g);
        const float4 sn = *(const float4*)(p.ropeS + 1024 + pos * 16 + 4 * g);
        const f32x4 o = acc[xi ^ 1][yi];
        const float sg = (xi & 1) ? 1.f : -1.f;
        v[0] = v[0] * cs.x + sg * o[0] * sn.x; v[1] = v[1] * cs.y + sg * o[1] * sn.y;
        v[2] = v[2] * cs.z + sg * o[2] * sn.z; v[3] = v[3] * cs.w + sg * o[3] * sn.w;
      }
      const int nloc = xi * 16 + 4 * g;
      if (okv) {
        const int b = m >> 8, pos = m & 255;
        float4 o4; o4.x = v[0]; o4.y = v[1]; o4.z = v[2]; o4.w = v[3];
        *(float4*)(okv + ((size_t)((b * 4 + l) * 256 + pos)) * okv_w + okv_c + nloc) = o4;
      }
      if (vrow >= 0) {
        u16* vb = p.vfr + ((size_t)((vrow >> 6) * 192 + (m >> 5))) * 2048;
#pragma unroll
        for (int i = 0; i < 4; ++i) vb[vfrag_off(m & 31, nloc + i)] = f2bf(v[i]);
      } else if (khh >= 0) {
        uint2 w; w.x = pack2(v[0], v[1]); w.y = pack2(v[2], v[3]);
        *(uint2*)(p.kfr + ((size_t)(khh * 192 + (m >> 5))) * 2048 + kfrag_off(m & 31, nloc)) = w;
      } else {
        uint2 w; w.x = pack2(v[0], v[1]); w.y = pack2(v[2], v[3]);
        *(uint2*)(p.z + (size_t)m * INW + nw + nloc) = w;
      }
    }
  }
}

__device__ void res_tile(const Params& p, int l, int tx, int ty, const u16* A, const u16* WT, int K, int gi, u16* smem, bool first = false) {
  const int n0 = tx * 128, m0 = ty * 96;
  f32x4 acc[4][3];
  gemm_main<3>(WT + (size_t)n0 * K, K, A + (size_t)m0 * K, K, K, smem, acc);
  const int lane = otid() & 63, wave = otid() >> 6, wx = wave & 1, wy = wave >> 1, r = lane & 15, g = lane >> 4;
#pragma unroll
  for (int yi = 0; yi < 3; ++yi) {
    const int m = m0 + wy * 48 + yi * 16 + r;
    const int cond = m < NPTOK ? 0 : 1 + ((m - NPTOK) >> 10);
    const float* gate = p.mods + (size_t)(l * 3 + cond) * 6144 + gi * 1024;
    float* xrow = p.xres + (size_t)m * 1024;
    const float* xin = first ? (m < NPTOK ? p.x_prompt + (size_t)m * 1024 : p.x_sample + (size_t)(m - NPTOK) * 1024) : xrow;
    float4 xv[4], gt[4];
#pragma unroll
    for (int xi = 0; xi < 4; ++xi) {
      const int n = n0 + wx * 64 + xi * 16 + 4 * g;
      xv[xi] = *(const float4*)(xin + n);
      gt[xi] = *(const float4*)(gate + n);
    }
#pragma unroll
    for (int xi = 0; xi < 4; ++xi) {
      const int n = n0 + wx * 64 + xi * 16 + 4 * g;
      const f32x4 v = acc[xi][yi];
      float4 o = xv[xi];
      o.x += gt[xi].x * v[0]; o.y += gt[xi].y * v[1]; o.z += gt[xi].z * v[2]; o.w += gt[xi].w * v[3];
      *(float4*)(xrow + n) = o;
    }
  }
}

__device__ void m1_tile(const Params& p, int l, int tx, int ty, u16* smem) {
  const int n0 = tx * 128, m0 = ty * 128;
  f32x4 acc[4][4];
  gemm_main<4>(p.w1T + (size_t)l * 4096 * 1024 + (size_t)n0 * 1024, 1024, p.h + (size_t)m0 * 1024, 1024, 1024, smem, acc);
  const int lane = otid() & 63, wave = otid() >> 6, wx = wave & 1, wy = wave >> 1, r = lane & 15, g = lane >> 4;
#pragma unroll
  for (int xi = 0; xi < 4; ++xi) {
    const int n = n0 + wx * 64 + xi * 16 + 4 * g;
#pragma unroll
    for (int yi = 0; yi < 4; ++yi) {
      const int m = m0 + wy * 64 + yi * 16 + r;
      const f32x4 v = acc[xi][yi];
      float a0 = fmaxf(v[0], 0.f), a1 = fmaxf(v[1], 0.f), a2 = fmaxf(v[2], 0.f), a3 = fmaxf(v[3], 0.f);
      uint2 w; w.x = pack2(a0 * a0, a1 * a1); w.y = pack2(a2 * a2, a3 * a3);
      *(uint2*)(p.u + (size_t)m * 4096 + n) = w;
    }
  }
}

__device__ void f1_tile(const Params& p, int l, int it, u16* smem) {
  const int tx = it % 48, ty = it / 48;
  const int x0 = tx * 128, y0 = ty * 128;
  f32x4 acc[4][4];
  gemm_main<4>(p.z + (size_t)x0 * INW + 1536, INW, p.pqt + (size_t)l * 512 * 256 + (size_t)y0 * 256, 256, 256, smem, acc);
  const int lane = otid() & 63, wave = otid() >> 6, wx = wave & 1, wy = wave >> 1, r = lane & 15, g = lane >> 4;
#pragma unroll
  for (int yi = 0; yi < 4; ++yi) {
    const int y = y0 + wy * 64 + yi * 16 + r;
    const int col = y & 255, which = y >> 8;
#pragma unroll
    for (int xi = 0; xi < 4; ++xi) {
      const int tok = x0 + wx * 64 + xi * 16 + 4 * g;
      size_t addr;
      if (tok < NPTOK) {
        const int b = tok >> 8, pos = tok & 255;
        addr = (size_t)b * (256 * 512) + (size_t)col * 512 + which * 256 + pos;
      } else {
        const int b = (tok - NPTOK) >> 10, pos = (tok - NPTOK) & 1023;
        addr = (size_t)16 * 256 * 512 + (size_t)b * (256 * 2048) + (size_t)col * 2048 + which * 1024 + pos;
      }
      const f32x4 v = acc[xi][yi];
      uint2 w; w.x = pack2(v[0], v[1]); w.y = pack2(v[2], v[3]);
      *(uint2*)(p.uv + addr) = w;
    }
  }
  asm volatile("s_waitcnt vmcnt(0)" ::: "memory");
  __syncthreads();
  if (threadIdx.x == 0) {
    __builtin_amdgcn_fence(__ATOMIC_RELEASE, "agent");
    asm volatile("s_waitcnt vmcnt(0)" ::: "memory");
    xb_add(p.bar + XCD_BAR_WORDS + (8 + l) * 64, 1u);
  }
}

__device__ void f2_tile(const Params& p, int l, int it, u16* smem) {
  if (threadIdx.x == 0) {
    unsigned* c = p.bar + XCD_BAR_WORDS + (8 + l) * 64;
    unsigned sp = 0;
    while (xb_ld(c) < 192u) { __builtin_amdgcn_s_sleep(2); if (++sp > (1u << 24)) break; }
    __builtin_amdgcn_fence(__ATOMIC_ACQUIRE, "agent");
    asm volatile("s_waitcnt vmcnt(0)" ::: "memory");
  }
  __syncthreads();
  int L, b, tx, ty, tokbase;
  const u16* uvb; const u16* dft;
  if (it < 32) { L = 1024; b = it >> 4; tx = (it >> 3) & 1; ty = it & 7; uvb = p.uv + (size_t)16 * 256 * 512 + (size_t)b * (256 * 2048); dft = p.dft1024; tokbase = NPTOK + b * 1024; }
  else { it -= 32; L = 256; b = it >> 2; tx = (it >> 1) & 1; ty = it & 1; uvb = p.uv + (size_t)b * (256 * 512); dft = p.dft256; tokbase = b * 256; }
  const int x0 = tx * 128, y0 = ty * 128, K = 2 * L;
  f32x4 acc[4][4];
  gemm_main<4>(uvb + (size_t)x0 * K, K, dft + (size_t)y0 * K, K, K, smem, acc);
  const int lane = otid() & 63, wave = otid() >> 6, wx = wave & 1, wy = wave >> 1, r = lane & 15, g = lane >> 4;
  const float scale = rsqrtf(64.f * (float)L);
#pragma unroll
  for (int yi = 0; yi < 4; ++yi) {
    const int pos = y0 + wy * 64 + yi * 16 + r;
#pragma unroll
    for (int xi = 0; xi < 4; ++xi) {
      const int col = x0 + wx * 64 + xi * 16 + 4 * g;
      const f32x4 v = acc[xi][yi];
      uint2 w; w.x = pack2(v[0] * scale, v[1] * scale); w.y = pack2(v[2] * scale, v[3] * scale);
      *(uint2*)(p.cat + (size_t)(tokbase + pos) * 1024 + 512 + col) = w;
    }
  }
}

struct Seg { const u16* K; const u16* Vt; int ldk, ldv, nblk, pos0, stride; };
#define KLOC(hh, tokb) (p.kfr + ((size_t)((hh) * 192 + ((tokb) >> 5))) * 2048)
#define VLOC(hh, tokb) (p.vfr + ((size_t)((hh) * 192 + ((tokb) >> 5))) * 2048)
template <int QT> struct AState { float m[QT]; float ls[QT]; f32x4 o[QT][4]; };

__device__ __forceinline__ bf16x8 as_bf(u32x4 v) { union { u32x4 u; bf16x8 b; } x; x.u = v; return x.b; }

template <int DC>
__device__ __forceinline__ void issue_blk(const Seg& s0, const Seg& s1, int b, int r, int g, u32x4 (&kf)[2][DC], u32x4 (&vf)[4]) {
  const bool in0 = b < s0.nblk;
  const u16* Kp = in0 ? s0.K : s1.K;
  const u16* Vp = in0 ? s0.Vt : s1.Vt;
  const int pos = in0 ? (s0.pos0 + b * s0.stride) : (s1.pos0 + (b - s0.nblk) * s1.stride);
  const int lane8 = (g * 16 + r) * 8;
  const u16* kp = Kp + (size_t)(pos >> 5) * 2048 + lane8;
  const u16* vp = Vp + (size_t)(pos >> 5) * 2048 + lane8;
#pragma unroll
  for (int t = 0; t < 2; ++t)
#pragma unroll
    for (int dc = 0; dc < DC; ++dc) gload16(kf[t][dc], kp + (t * 2 + dc) * 512);
#pragma unroll
  for (int dv = 0; dv < 4; ++dv) gload16(vf[dv], vp + dv * 512);
}
template <int N>
__device__ __forceinline__ void wait_blk(u32x4 (&kf)[2][1], u32x4 (&vf)[4]) {
  asm volatile("s_waitcnt vmcnt(%6)" : "+v"(kf[0][0]), "+v"(kf[1][0]), "+v"(vf[0]), "+v"(vf[1]), "+v"(vf[2]), "+v"(vf[3]) : "n"(N) : "memory");
}
template <int N>
__device__ __forceinline__ void wait_blk(u32x4 (&kf)[2][2], u32x4 (&vf)[4]) {
  asm volatile("s_waitcnt vmcnt(%8)" : "+v"(kf[0][0]), "+v"(kf[0][1]), "+v"(kf[1][0]), "+v"(kf[1][1]), "+v"(vf[0]), "+v"(vf[1]), "+v"(vf[2]), "+v"(vf[3]) : "n"(N) : "memory");
}

template <int D, int QT, int MODE>
__device__ __forceinline__ void attn_compute(const u32x4 (&kc)[2][D / 32], const u32x4 (&vc)[4], const bf16x8 (&qf)[QT][D / 32], const float sc,
                                             AState<QT>& st, const bool in0, const int pos, const int qpos0, const float* __restrict__ rpb_h,
                                             const int r, const int g) {
  constexpr int DC = D / 32;
#pragma unroll
  for (int q = 0; q < QT; ++q) {
    f32x4 s_[2];
    s_[0] = (f32x4){0.f, 0.f, 0.f, 0.f};
    s_[1] = (f32x4){0.f, 0.f, 0.f, 0.f};
#pragma unroll
    for (int t = 0; t < 2; ++t)
#pragma unroll
      for (int dc = 0; dc < DC; ++dc) s_[t] = __builtin_amdgcn_mfma_f32_16x16x32_bf16(as_bf(kc[t][dc]), qf[q][dc], s_[t], 0, 0, 0);
    float sv[8];
#pragma unroll
    for (int t = 0; t < 2; ++t)
#pragma unroll
      for (int i = 0; i < 4; ++i) {
        float x = s_[t][i] * sc;
        if (MODE == 1) {
          if (!in0) {
            const int qpos = qpos0 + q * 16 + r;
            const int qrow = qpos >> 6, cq = qpos & 63;
            const int kpos = pos + 8 * g + 4 * t + i;
            const int krow = kpos >> 6, ck = kpos & 63;
            const int cs = min(max(cq - 8, 0), 48);
            const bool valid = (ck >= cs) && (ck < cs + 16);
            const int bi = (krow - qrow + 7) * 31 + (ck - cq + 15);
            const float bias = rpb_h[valid ? bi : 0];
            x = valid ? (x + bias) : -1e30f;
          }
        } else if (MODE == 2) {
          if (!in0) {
            const int qpos = qpos0 + q * 16 + r;
            const int kpos = pos + 8 * g + 4 * t + i;
            const int d = qpos - kpos;
            x = (d <= 128 && d >= -128) ? x : -1e30f;
          }
        }
        sv[4 * t + i] = x;
      }
    float mx = fmaxf(fmaxf(fmaxf(sv[0], sv[1]), fmaxf(sv[2], sv[3])), fmaxf(fmaxf(sv[4], sv[5]), fmaxf(sv[6], sv[7])));
    mx = fmaxf(mx, __shfl_xor(mx, 16));
    mx = fmaxf(mx, __shfl_xor(mx, 32));
    const float mnew = fmaxf(st.m[q], mx);
    const float alpha = __builtin_amdgcn_exp2f(st.m[q] - mnew);
    st.m[q] = mnew;
    float ps = 0.f;
#pragma unroll
    for (int j = 0; j < 8; ++j) { sv[j] = __builtin_amdgcn_exp2f(sv[j] - mnew); ps += sv[j]; }
    st.ls[q] = st.ls[q] * alpha + ps;
    union { bf16x8 v; unsigned w[4]; } pf;
    pf.w[0] = pack2(sv[0], sv[1]); pf.w[1] = pack2(sv[2], sv[3]); pf.w[2] = pack2(sv[4], sv[5]); pf.w[3] = pack2(sv[6], sv[7]);
#pragma unroll
    for (int dv = 0; dv < 4; ++dv) {
      f32x4 o = st.o[q][dv];
      o[0] *= alpha; o[1] *= alpha; o[2] *= alpha; o[3] *= alpha;
      st.o[q][dv] = __builtin_amdgcn_mfma_f32_16x16x32_bf16(as_bf(vc[dv]), pf.v, o, 0, 0, 0);
    }
  }
}

template <int D, int QT, int MODE, int NQ = 2>
__device__ __forceinline__ void attn_run(const Seg& s0, const Seg& s1, const bf16x8 (&qf)[QT][D / 32], const float sc,
                                         AState<QT>& st, const int qpos0, const float* __restrict__ rpb_h, const int bb = 0, const int be = -1) {
  constexpr int DC = D / 32;
  constexpr int NL = 2 * DC + 4;
  const int lane = otid() & 63, r = lane & 15, g = lane >> 4;
  const int nb = be < 0 ? s0.nblk + s1.nblk : be;
  u32x4 kq[NQ][2][DC], vq[NQ][4];
#pragma unroll
  for (int q = 0; q < QT; ++q)
#pragma unroll
    for (int dc = 0; dc < DC; ++dc) asm volatile("" ::"v"(qf[q][dc]));
  asm volatile("s_waitcnt vmcnt(0)" ::: "memory");
#pragma unroll 1
  for (int b = bb; b < nb; b += NQ) {
#pragma unroll
    for (int j = 0; j < NQ; ++j) issue_blk<DC>(s0, s1, b + j, r, g, kq[j], vq[j]);
#pragma unroll
    for (int j = 0; j < NQ; ++j) {
      if (j == 0) wait_blk<(NQ - 1) * NL>(kq[j], vq[j]);
      else if (j == 1) wait_blk<(NQ - 2) * NL>(kq[j], vq[j]);
      else if (j == 2) wait_blk<(NQ > 3 ? (NQ - 3) * NL : 0)>(kq[j], vq[j]);
      else wait_blk<0>(kq[j], vq[j]);
      const int bj = b + j;
      const bool in0 = bj < s0.nblk;
      const int pos = in0 ? (s0.pos0 + bj * s0.stride) : (s1.pos0 + (bj - s0.nblk) * s1.stride);
      attn_compute<D, QT, MODE>(kq[j], vq[j], qf, sc, st, in0, pos, qpos0, rpb_h, r, g);
    }
  }
}

template <int QT>
__device__ __forceinline__ void astate_init(AState<QT>& st, float m0, float l0) {
#pragma unroll
  for (int q = 0; q < QT; ++q) {
    st.m[q] = m0; st.ls[q] = l0;
#pragma unroll
    for (int dv = 0; dv < 4; ++dv) st.o[q][dv] = (f32x4){0.f, 0.f, 0.f, 0.f};
  }
}
template <int QT>
__device__ __forceinline__ void astate_finalize(AState<QT>& st) {
#pragma unroll
  for (int q = 0; q < QT; ++q) {
    float l = st.ls[q];
    l += __shfl_xor(l, 16);
    l += __shfl_xor(l, 32);
    const float inv = 1.f / l;
#pragma unroll
    for (int dv = 0; dv < 4; ++dv) { st.o[q][dv][0] *= inv; st.o[q][dv][1] *= inv; st.o[q][dv][2] *= inv; st.o[q][dv][3] *= inv; }
  }
}
template <int DC, int QT>
__device__ __forceinline__ void load_q(const u16* zq  , bf16x8 (&qf)[QT][DC]) {
  const int lane = otid() & 63, r = lane & 15, g = lane >> 4;
#pragma unroll
  for (int q = 0; q < QT; ++q)
#pragma unroll
    for (int dc = 0; dc < DC; ++dc) qf[q][dc] = *(const bf16x8*)(zq + (size_t)(q * 16 + r) * INW + dc * 32 + g * 8);
}
template <int QT>
__device__ __forceinline__ void write_o(const Params& p, const AState<QT>& st, int tok0, int col0) {
  const int lane = otid() & 63, r = lane & 15, g = lane >> 4;
#pragma unroll
  for (int q = 0; q < QT; ++q)
#pragma unroll
    for (int dv = 0; dv < 4; ++dv) {
      const f32x4 v = st.o[q][dv];
      uint2 w; w.x = pack2(v[0], v[1]); w.y = pack2(v[2], v[3]);
      *(uint2*)(p.cat + (size_t)(tok0 + q * 16 + r) * 1024 + col0 + dv * 16 + 4 * g) = w;
    }
}

__device__ __forceinline__ float diff_lambda(const Params& p, int l, float lam_init) {
  const int lane = otid() & 63;
  float a = 0.f, b = 0.f;
  if (lane < 32) { a = p.lq1[l * 32 + lane] * p.lk1[l * 32 + lane]; b = p.lq2[l * 32 + lane] * p.lk2[l * 32 + lane]; }
#pragma unroll
  for (int o = 32; o >= 1; o >>= 1) { a += __shfl_xor(a, o); b += __shfl_xor(b, o); }
  return expf(a) - expf(b) + lam_init;
}

__device__ __forceinline__ void diff_finish_q(const Params& p, int l, float lam, float lam_init, f32x4 (&A)[4], const f32x4 (&B)[4], int tokrow0, int col0) {
  const int lane = otid() & 63, r = lane & 15, g = lane >> 4;
  const float* sg = p.subln_g + l * 64;
  float ss = 0.f;
#pragma unroll
  for (int dv = 0; dv < 4; ++dv)
#pragma unroll
    for (int i = 0; i < 4; ++i) {
      const float v = A[dv][i] - lam * B[dv][i];
      A[dv][i] = v;
      ss += v * v;
    }
  ss += __shfl_xor(ss, 16);
  ss += __shfl_xor(ss, 32);
  const float rs = rsqrtf(ss * (1.f / 64.f) + 1e-6f) * (1.f - lam_init);
#pragma unroll
  for (int dv = 0; dv < 4; ++dv) {
    const float4 gg = *(const float4*)(sg + dv * 16 + 4 * g);
    uint2 w;
    w.x = pack2(A[dv][0] * rs * gg.x, A[dv][1] * rs * gg.y);
    w.y = pack2(A[dv][2] * rs * gg.z, A[dv][3] * rs * gg.w);
    *(uint2*)(p.cat + (size_t)(tokrow0 + r) * 1024 + col0 + dv * 16 + 4 * g) = w;
  }
}

#ifndef AQT
#define AQT 2
#endif
#define QW (16 * AQT)
#define NQG_CTX (256 / QW)
#define NQG_LAT (1024 / QW)
__device__ void attn_diff_item(const Params& p, int l, bool lat, int bi, float* sm) {
  const int wave = otid() >> 6, lane = otid() & 63, r = lane & 15, g = lane >> 4;
  const int ps = wave >> 1, half = wave & 1;
  int b, h, qg, tokb;
  if (lat) { b = bi / (4 * NQG_LAT); h = (bi / NQG_LAT) & 3; qg = bi % NQG_LAT; tokb = NPTOK + b * 1024; }
  else { b = bi / (4 * NQG_CTX); h = (bi / NQG_CTX) & 3; qg = bi % NQG_CTX; tokb = b * 256; }
  const int tok0 = tokb + qg * QW;
  const u16* zb = p.z + (size_t)tokb * INW;
  Seg s0, s1;
  if (lat) {
    const int bl = b * 4 + l;
    s0.K = p.ck_diff + (size_t)((bl * 4 + h) * 16) * 2048 + ps * 512; s0.Vt = p.cvt_diff + (size_t)((bl * 4 + h) * 16) * 2048;
    s0.ldk = 0; s0.ldv = 0; s0.nblk = half ? 0 : 16; s0.pos0 = 0; s0.stride = 32;
    s1.K = KLOC(4 + h, tokb) + ps * 512; s1.Vt = VLOC(4 + h, tokb);
    s1.ldk = 0; s1.ldv = 0; s1.nblk = half ? 24 : 8; s1.pos0 = half ? 256 : 0; s1.stride = 32;
  } else {
    s0.K = KLOC(4 + h, tokb) + ps * 512; s0.Vt = VLOC(4 + h, tokb);
    s0.ldk = 0; s0.ldv = 0; s0.nblk = 4; s0.pos0 = half ? 128 : 0; s0.stride = 32;
    s1 = s0; s1.nblk = 0;
  }
  bf16x8 qf[AQT][1];
  load_q<1, AQT>(p.z + (size_t)tok0 * INW + 768 + h * 64 + ps * 32, qf);
  AState<AQT> st;
  astate_init<AQT>(st, -1e30f, 0.f);
  attn_run<32, AQT, 0, 2>(s0, s1, qf, 0.17677669529663687f * LOG2E, st, 0, nullptr);
  float lt[AQT];
#pragma unroll
  for (int q = 0; q < AQT; ++q) {
    lt[q] = st.ls[q];
    lt[q] += __shfl_xor(lt[q], 16);
    lt[q] += __shfl_xor(lt[q], 32);
  }
  constexpr int WS = 64 * 16 * AQT;
  float* pm = sm + 4 * WS;
  if (wave != 0) {
    float* po = sm + wave * WS + lane * (16 * AQT);
#pragma unroll
    for (int q = 0; q < AQT; ++q) {
#pragma unroll
      for (int dv = 0; dv < 4; ++dv) *(f32x4*)(po + q * 16 + dv * 4) = st.o[q][dv];
      if (g == 0) { pm[wave * QW + q * 16 + r] = st.m[q]; pm[4 * QW + wave * QW + q * 16 + r] = lt[q]; }
    }
  }
  __syncthreads();
  if (wave == 0) {
    const float lam_init = 0.8f - 0.6f * expf(-0.3f * (float)l);
    const float lam = diff_lambda(p, l, lam_init);
#pragma unroll
    for (int q = 0; q < AQT; ++q) {
      f32x4 A[4], B[4];
      {
        const float m1 = pm[QW + q * 16 + r], l1 = pm[4 * QW + QW + q * 16 + r];
        const float M = fmaxf(st.m[q], m1);
        const float a0 = exp2f(st.m[q] - M), a1 = exp2f(m1 - M);
        const float inv = 1.f / (lt[q] * a0 + l1 * a1);
#pragma unroll
        for (int dv = 0; dv < 4; ++dv) {
          const f32x4 o1 = *(const f32x4*)(sm + 1 * WS + lane * (16 * AQT) + q * 16 + dv * 4);
          A[dv] = (st.o[q][dv] * a0 + o1 * a1) * inv;
        }
      }
      {
        const float m2 = pm[2 * QW + q * 16 + r], l2 = pm[4 * QW + 2 * QW + q * 16 + r], m3 = pm[3 * QW + q * 16 + r], l3 = pm[4 * QW + 3 * QW + q * 16 + r];
        const float M = fmaxf(m2, m3);
        const float a2 = exp2f(m2 - M), a3 = exp2f(m3 - M);
        const float inv = 1.f / (l2 * a2 + l3 * a3);
#pragma unroll
        for (int dv = 0; dv < 4; ++dv) {
          const f32x4 o2 = *(const f32x4*)(sm + 2 * WS + lane * (16 * AQT) + q * 16 + dv * 4);
          const f32x4 o3 = *(const f32x4*)(sm + 3 * WS + lane * (16 * AQT) + q * 16 + dv * 4);
          B[dv] = (o2 * a2 + o3 * a3) * inv;
        }
      }
      diff_finish_q(p, l, lam, lam_init, A, B, tok0 + q * 16, 256 + h * 64);
    }
  }
  __syncthreads();
}

__device__ void attn_ctx_item(const Params& p, int l, int bi) {
  const int wave = otid() >> 6, lane = otid() & 63, g = lane >> 4;
  const int w = bi * 4 + wave;
  const int type = w / (64 * NQG_CTX), rem = w % (64 * NQG_CTX);
  const int b = rem / (4 * NQG_CTX), h = (rem / NQG_CTX) & 3, qg = rem % NQG_CTX;
  const int tokb = b * 256, tok0 = tokb + qg * QW;
  const u16* zb = p.z + (size_t)tokb * INW;
  const int kvh = h >> 1;
  const int qcol = type == 0 ? h * 64 : 1792 + h * 64;
  const int kcol = type == 0 ? 256 + h * 64 : 2048 + kvh * 64;
  const int vrow = type == 0 ? h * 64 : 512 + kvh * 64;
  const int ocol = type == 0 ? h * 64 : 768 + h * 64;
  bf16x8 qf[AQT][2];
  load_q<2, AQT>(p.z + (size_t)tok0 * INW + qcol, qf);
  const int hslot = type == 0 ? h : 8 + kvh;
  Seg s0; s0.K = KLOC(hslot, tokb); s0.Vt = VLOC(hslot, tokb); s0.ldk = 0; s0.ldv = 0; s0.nblk = 8; s0.pos0 = 0; s0.stride = 32;
  Seg sN = s0; sN.nblk = 0;
  AState<AQT> st;
  const float sk = type == 0 ? -1e30f : p.swa_sink[l * 4 + h] * LOG2E;
  astate_init<AQT>(st, sk, (type == 1 && g == 0) ? 1.f : 0.f);
  attn_run<64, AQT, 0, 2>(s0, sN, qf, 0.125f * LOG2E, st, 0, nullptr);
  astate_finalize<AQT>(st);
  write_o<AQT>(p, st, tok0, ocol);
}

__device__ void attn_lat_item(const Params& p, int l, int bi, float* sm) {
  const int wave = otid() >> 6, lane = otid() & 63, r = lane & 15, g = lane >> 4;
  const int type = bi / (8 * NQG_LAT), rem = bi % (8 * NQG_LAT);
  const int b = rem / (4 * NQG_LAT), h = (rem / NQG_LAT) & 3, qg = rem % NQG_LAT;
  const int q0 = qg * QW;
  const int tokb = NPTOK + b * 1024, tok0 = tokb + q0;
  const u16* zb = p.z + (size_t)tokb * INW;
  const int bl = b * 4 + l;
  AState<AQT> st;
  int ocol;
  if (type != 0) {
    const float* rp = p.na_rpb + (size_t)(l * 4 + h) * 15 * 31;
    for (int e = otid(); e < 465; e += 256) sm[9000 + e] = rp[e] * LOG2E;
    __syncthreads();
  }
  if (type == 0) {
    const int kvh = h >> 1;
    bf16x8 qf[AQT][2];
    load_q<2, AQT>(p.z + (size_t)tok0 * INW + 1792 + h * 64, qf);
    Seg s0; s0.K = p.ck_swa + (size_t)((bl * 2 + kvh) * 16) * 2048; s0.Vt = p.cvt_swa + (size_t)((bl * 2 + kvh) * 16) * 2048; s0.ldk = 0; s0.ldv = 0; s0.nblk = 16; s0.pos0 = 0; s0.stride = 32;
    const int lo = max(0, q0 - 128) & ~31;
    const int hi = min(1024, ((q0 + QW + 128) + 31) & ~31);
    int lo2 = lo, cnt = (hi - lo) >> 5;
    if (cnt & 1) { if (lo2 > 0) lo2 -= 32; ++cnt; }
    Seg s1; s1.K = KLOC(8 + kvh, tokb); s1.Vt = VLOC(8 + kvh, tokb); s1.ldk = 0; s1.ldv = 0; s1.nblk = cnt; s1.pos0 = lo2; s1.stride = 32;
    const int P = (16 + cnt) >> 1;
    const int pb = (wave * P) >> 2, pe = ((wave + 1) * P) >> 2;
    astate_init<AQT>(st, wave == 0 ? p.swa_sink[l * 4 + h] * LOG2E : -1e30f, (wave == 0 && g == 0) ? 1.f : 0.f);
    attn_run<64, AQT, 2>(s0, s1, qf, 0.125f * LOG2E, st, q0, nullptr, 2 * pb, 2 * pe);
    ocol = 768 + h * 64;
  } else {
    bf16x8 qf[AQT][2];
    load_q<2, AQT>(p.z + (size_t)tok0 * INW + h * 64, qf);
    Seg s0; s0.K = p.ck_na + (size_t)((bl * 4 + h) * 16) * 2048; s0.Vt = p.cvt_na + (size_t)((bl * 4 + h) * 16) * 2048; s0.ldk = 0; s0.ldv = 0; s0.nblk = 16; s0.pos0 = 0; s0.stride = 32;
    const int qrow = q0 >> 6;
    const int rstart = min(max(qrow - 4, 0), 8);
    Seg s1; s1.K = KLOC(h, tokb); s1.Vt = VLOC(h, tokb); s1.ldk = 0; s1.ldv = 0; s1.nblk = 16; s1.pos0 = rstart * 64; s1.stride = 32;
    astate_init<AQT>(st, -1e30f, 0.f);
    attn_run<64, AQT, 1, 2>(s0, s1, qf, 0.125f * LOG2E, st, q0, sm + 9000, 8 * wave, 8 * wave + 8);
    ocol = h * 64;
  }
  float lt[AQT];
#pragma unroll
  for (int q = 0; q < AQT; ++q) {
    lt[q] = st.ls[q];
    lt[q] += __shfl_xor(lt[q], 16);
    lt[q] += __shfl_xor(lt[q], 32);
  }
  constexpr int WS = 64 * 16 * AQT;
  float* pm = sm + 4 * WS;
  if (wave != 0) {
    float* po = sm + wave * WS + lane * (16 * AQT);
#pragma unroll
    for (int q = 0; q < AQT; ++q) {
#pragma unroll
      for (int dv = 0; dv < 4; ++dv) *(f32x4*)(po + q * 16 + dv * 4) = st.o[q][dv];
      if (g == 0) { pm[wave * QW + q * 16 + r] = st.m[q]; pm[4 * QW + wave * QW + q * 16 + r] = lt[q]; }
    }
  }
  __syncthreads();
  if (wave == 0) {
#pragma unroll
    for (int q = 0; q < AQT; ++q) {
      const float m1 = pm[1 * QW + q * 16 + r], m2 = pm[2 * QW + q * 16 + r], m3 = pm[3 * QW + q * 16 + r];
      const float l1 = pm[4 * QW + 1 * QW + q * 16 + r], l2 = pm[4 * QW + 2 * QW + q * 16 + r], l3 = pm[4 * QW + 3 * QW + q * 16 + r];
      const float M = fmaxf(fmaxf(st.m[q], m1), fmaxf(m2, m3));
      const float a0 = __builtin_amdgcn_exp2f(st.m[q] - M), a1 = __builtin_amdgcn_exp2f(m1 - M), a2 = __builtin_amdgcn_exp2f(m2 - M), a3 = __builtin_amdgcn_exp2f(m3 - M);
      const float inv = 1.f / (lt[q] * a0 + l1 * a1 + l2 * a2 + l3 * a3);
#pragma unroll
      for (int dv = 0; dv < 4; ++dv) {
        const f32x4 o1 = *(const f32x4*)(sm + 1 * WS + lane * (16 * AQT) + q * 16 + dv * 4);
        const f32x4 o2 = *(const f32x4*)(sm + 2 * WS + lane * (16 * AQT) + q * 16 + dv * 4);
        const f32x4 o3 = *(const f32x4*)(sm + 3 * WS + lane * (16 * AQT) + q * 16 + dv * 4);
        st.o[q][dv] = (st.o[q][dv] * a0 + o1 * a1 + o2 * a2 + o3 * a3) * inv;
      }
    }
    write_o<AQT>(p, st, tok0, ocol);
  }
  __syncthreads();
}

__device__ __forceinline__ int q_next(unsigned* cnt, volatile LAS unsigned* slot) {
  __syncthreads();
  if (threadIdx.x == 0) *slot = xb_add(cnt, 1u);
  __syncthreads();
  return (int)*slot;
}

#if REP_SYNC
#define GSYNC() do { xcd_barrier(xb); xcd_barrier(xb); } while (0)
#else
#define GSYNC() xcd_barrier(xb)
#endif
__global__ void __launch_bounds__(256, 2) mega(Params p) {
  extern __shared__ __attribute__((aligned(16))) unsigned char smem[];
  cg::grid_group grid = cg::this_grid();
  const int nblk = gridDim.x, bid = blockIdx.x;
  u16* sm16 = (u16*)smem;
  __shared__ uint4 xb_words[2];
  if (threadIdx.x == 0) { xb_words[0] = make_uint4(0u, 0u, 0u, 0u); xb_words[1] = make_uint4(0u, 0u, 0u, 0u); }
  __syncthreads();
  XcdBarrier xb = xcd_barrier_post(p.bar, (volatile LAS unsigned*)&xb_words[0]);

  for (int rep = 0; rep <= REP_P0; ++rep)
    for (int it = bid; it < P0_ITEMS; it += nblk) p0_item(p, it, smem);
  if (p.use_cg_sync) grid.sync();
  GSYNC();

  const int xcc = (int)xb.x;
  const int xrank = __builtin_amdgcn_readfirstlane((int)xb.st[4]), xnloc = __builtin_amdgcn_readfirstlane((int)xb.st[0]);
  const unsigned topo = (unsigned)__builtin_amdgcn_readfirstlane((int)xb.st[5]);
  const bool local = (topo & 1u) != 0u, full64 = (topo & 2u) != 0u;
#define LSYNC() do { if (local) xcd_barrier_local(xb); else GSYNC(); } while (0)
#define LMAP(j, count, total) (local ? ((xrank + (j) * xnloc) < (count) ? (xrank + (j) * xnloc) : -1) : ((bid + (j) * nblk) < (total) ? (bid + (j) * nblk) : -1))

#pragma unroll 1
  for (int l = 0; l < 4; ++l) {
    for (int j = 0;; ++j) { const int v = LMAP(j, 48, 384); if (v < 0) break; norm_item(p, l, 0, local ? 48 * xcc + v : v); }
    LSYNC();
    for (int j = 0;; ++j) {
      const int v = LMAP(j, 108, 864); if (v < 0) break;
      if (local) gin_tile(p, l, v / 6, 6 * xcc + v % 6, sm16); else gin_tile(p, l, v / 48, v % 48, sm16);
    }
    if (full64) {
      if (xrank >= 44) {
        const int idle = xcc * 20 + (xrank - 44);
        for (int it = 288 + idle; it < 928; it += 160) wt_item(p, l, it, (float*)smem);
      }
    }
    GSYNC();
    {
      constexpr int CD = 64 * NQG_CTX, CC = 2 * 64 * NQG_CTX / 4;
      constexpr int LD = 8 * NQG_LAT, LC = 2 * 8 * NQG_LAT;
      constexpr int E0 = 192, E1 = E0 + LD, E2 = E1 + LC, E3 = E2 + 32, E4 = E3 + CC, E5 = E4 + CD, E6 = E5 + 64;
      unsigned* qc = p.bar + XCD_BAR_WORDS + l * 64;
      const int w0 = full64 ? 928 : 288;
      const int EA = E6 + (1440 - w0), EW = EA + (l < 3 ? 288 : 0);
      for (int it = bid; it < EW; it = nblk + q_next(qc, &xb.st[2])) {
        if (it >= E6) {
          if (it < EA) wt_item(p, l, it - E6 + w0, (float*)smem);
          else wt_item(p, l + 1, it - EA, (float*)smem);
          continue;
        }
        if (it < E0) f1_tile(p, l, it, sm16);
        else if (it < E1) attn_diff_item(p, l, true, it - E0, (float*)smem);
        else if (it < E2) attn_lat_item(p, l, it - E1, (float*)smem);
        else if (it < E3) f2_tile(p, l, it - E2, sm16);
        else if (it < E4) attn_ctx_item(p, l, it - E3);
        else if (it < E5) attn_diff_item(p, l, false, it - E4, (float*)smem);
        else f2_tile(p, l, it - E5 + 32, sm16);
      }
    }
    GSYNC();
    for (int j = 0;; ++j) {
      const int v = LMAP(j, 64, 512); if (v < 0) break;
      if (local) res_tile(p, l, v / 8, 8 * xcc + v % 8, p.cat, p.w_outT + (size_t)l * 1024 * 1024, 1024, 2, sm16, l == 0);
      else res_tile(p, l, v / 64, v % 64, p.cat, p.w_outT + (size_t)l * 1024 * 1024, 1024, 2, sm16, l == 0);
    }
    LSYNC();
    for (int j = 0;; ++j) { const int v = LMAP(j, 48, 384); if (v < 0) break; norm_item(p, l, 1, local ? 48 * xcc + v : v); }
    LSYNC();
    for (int j = 0;; ++j) {
      const int v = LMAP(j, 192, 1536); if (v < 0) break;
      if (local) m1_tile(p, l, v / 6, 6 * xcc + v % 6, sm16); else m1_tile(p, l, v / 48, v % 48, sm16);
    }
    LSYNC();
    for (int j = 0;; ++j) {
      const int v = LMAP(j, 64, 512); if (v < 0) break;
      if (local) res_tile(p, l, v / 8, 8 * xcc + v % 8, p.u, p.w2T + (size_t)l * 1024 * 4096, 4096, 5, sm16);
      else res_tile(p, l, v / 64, v % 64, p.u, p.w2T + (size_t)l * 1024 * 4096, 4096, 5, sm16);
    }
    LSYNC();
  }
  for (int j = 0;; ++j) { const int v = LMAP(j, 48, 384); if (v < 0) break; norm_item(p, 0, 2, local ? 48 * xcc + v : v); }
#undef LSYNC
#undef LMAP
}

extern "C" void kernel_launch(void* const* d_in, const int* in_sizes, int n_in, void* d_out, int out_size, void* d_ws,
                              size_t ws_size, hipStream_t stream) {
  static int grid_blocks = 0;
  if (grid_blocks == 0) {
    int dev = 0, cus = 0, per_cu = 0;
    (void)hipGetDevice(&dev);
    (void)hipDeviceGetAttribute(&cus, hipDeviceAttributeMultiprocessorCount, dev);
    if (hipFuncSetAttribute((const void*)mega, hipFuncAttributeMaxDynamicSharedMemorySize, LDS_BYTES) != hipSuccess) {
      fprintf(stderr, "hipFuncSetAttribute failed\n");
    }
    if (hipOccupancyMaxActiveBlocksPerMultiprocessor(&per_cu, (const void*)mega, 256, LDS_BYTES) != hipSuccess || per_cu < 1) {
      fprintf(stderr, "occupancy query failed (%d)\n", per_cu);
      per_cu = 1;
    }
    if (per_cu > 2) per_cu = 2;
    grid_blocks = cus * per_cu;
    fprintf(stderr, "mega: cus=%d per_cu=%d grid=%d ws=%zu\n", cus, per_cu, grid_blocks, ws_size);
  }
  Params p{};
  const float** pin = (const float**)&p;
  for (int i = 0; i < 27; ++i) pin[i] = (const float*)d_in[i];
  p.out = (float*)d_out;
  unsigned char* ws = (unsigned char*)d_ws;
  size_t off = 0;
  auto take = [&](size_t bytes) { unsigned char* q = ws + off; off += (bytes + 255) & ~(size_t)255; return q; };
  p.xres = (float*)take((size_t)NTOK * 1024 * 4);
  p.mods = (float*)take((size_t)4 * 3 * 6144 * 4);
  p.h = (u16*)take((size_t)NTOK * 1024 * 2);
  p.z = (u16*)take((size_t)NTOK * INW * 2);
  p.vt = (u16*)take((size_t)640 * NTOK * 2);
  p.cat = (u16*)take((size_t)NTOK * 1024 * 2);
  p.u = (u16*)take((size_t)NTOK * 4096 * 2);
  p.uv = (u16*)take((size_t)(16 * 256 * 512 + 2 * 256 * 2048) * 2);
  p.w_inT = (u16*)take((size_t)4 * 2304 * 1024 * 2);
  p.w_outT = (u16*)take((size_t)4 * 1024 * 1024 * 2);
  p.w1T = (u16*)take((size_t)4 * 4096 * 1024 * 2);
  p.w2T = (u16*)take((size_t)4 * 4096 * 1024 * 2);
  p.pqt = (u16*)take((size_t)4 * 512 * 256 * 2);
  p.dft256 = (u16*)take((size_t)256 * 512 * 2);
  p.dft1024 = (u16*)take((size_t)1024 * 2048 * 2);
  p.ck_na = (u16*)take((size_t)2 * 4 * 512 * 256 * 2);
  p.cvt_na = (u16*)take((size_t)2 * 4 * 512 * 256 * 2);
  p.ck_diff = (u16*)take((size_t)2 * 4 * 512 * 256 * 2);
  p.cvt_diff = (u16*)take((size_t)2 * 4 * 512 * 256 * 2);
  p.ck_swa = (u16*)take((size_t)2 * 4 * 512 * 128 * 2);
  p.cvt_swa = (u16*)take((size_t)2 * 4 * 512 * 128 * 2);
  p.kfr = (u16*)take((size_t)10 * 192 * 2048 * 2);
  p.vfr = (u16*)take((size_t)10 * 192 * 2048 * 2);
  p.ropeD = (float*)take(1024 * 4);
  p.ropeS = (float*)take(2048 * 4);
  p.bar = (unsigned*)take(XB_ALL_WORDS * 4);
  if (off > ws_size) { fprintf(stderr, "workspace too small: need %zu have %zu\n", off, ws_size); return; }
  if (hipMemsetAsync(p.bar, 0, XB_ALL_WORDS * 4, stream) != hipSuccess) fprintf(stderr, "memset failed\n");
  void* args[] = {&p};
  hipError_t e = hipLaunchCooperativeKernel((const void*)mega, dim3(grid_blocks), dim3(256), args, LDS_BYTES, stream);
  if (e != hipSuccess) fprintf(stderr, "cooperative launch failed: %s (grid %d)\n", hipGetErrorString(e), grid_blocks);
}
```

```cpp
#include <hip/hip_runtime.h>
#include <hip/hip_cooperative_groups.h>
#include <stdint.h>
#include <stdio.h>
namespace cg = cooperative_groups;

typedef unsigned short u16;
typedef __attribute__((ext_vector_type(8))) short bf16x8;
typedef __attribute__((ext_vector_type(4))) float f32x4;
typedef __attribute__((ext_vector_type(4))) unsigned u32x4;
__device__ __forceinline__ void gload16(u32x4& dst, const void* ptr) {
  asm volatile("global_load_dwordx4 %0, %1, off" : "=v"(dst) : "v"(ptr) : "memory");
}

#define NTOK 6144
#define NPTOK 4096
#define INW 2304
#define LOG2E 1.4426950408889634f
#define LDS_BYTES 73728
#define LSTR 72

#define O_NAK 6291456
#define O_NAV 10485760
#define O_DK 14680064
#define O_DV 18874368
#define O_SK 23068672
#define O_SV 25165824

struct Params {
  const float *x_prompt, *x_sample, *c_na_k, *c_na_v, *c_diff_k, *c_diff_v, *c_swa_k, *c_swa_v, *c, *c_ctx;
  const float *w_ada, *b_ada, *norm1_g, *norm2_g, *w_in, *na_rpb, *lq1, *lk1, *lq2, *lk2, *subln_g, *w_fourier, *swa_sink;
  const float *w_out, *w1, *w2, *final_g;
  float* out;
  float* xres;
  float* mods;
  u16 *h, *z, *vt, *cat, *u, *uv, *w_inT, *w_outT, *w1T, *w2T, *pqt, *dft256, *dft1024;
  u16 *ck_na, *cvt_na, *ck_diff, *cvt_diff, *ck_swa, *cvt_swa;
  float *ropeD, *ropeS;
  u16 *kfr, *vfr;
  unsigned* bar;
  int use_cg_sync;
  int pad_;
};

__device__ __forceinline__ u16 f2bf(float f) {
  unsigned u = __float_as_uint(f);
  u += 0x7fffu + ((u >> 16) & 1u);
  return (u16)(u >> 16);
}
__device__ __forceinline__ int otid() { int t = threadIdx.x; asm volatile("" : "+v"(t)); return t; }
__device__ __forceinline__ float bf2f(u16 h) { return __uint_as_float(((unsigned)h) << 16); }
typedef __attribute__((ext_vector_type(2))) __bf16 hbf16x2;
typedef __attribute__((ext_vector_type(2))) float f32x2;
__device__ __forceinline__ unsigned pack2(float a, float b) {
  f32x2 v = {a, b};
  union { hbf16x2 h; unsigned u; } x;
  x.h = __builtin_convertvector(v, hbf16x2);
  return x.u;
}

__device__ __forceinline__ int kfrag_off(int kk, int d) {
  const int t = (kk >> 2) & 1, r = ((kk >> 3) << 2) | (kk & 3), dc = d >> 5, g = (d >> 3) & 3;
  return ((t * 2 + dc) * 64 + g * 16 + r) * 8 + (d & 7);
}
__device__ __forceinline__ int vfrag_off(int kk, int dv) {
  return (((dv >> 4) * 64) + (kk >> 3) * 16 + (dv & 15)) * 8 + (kk & 7);
}

#define XB_TMO      128
#define XB_XCNT(j)  (256  + 64 * (j))
#define XB_XSUB(j)  (1280 + 64 * (j))
#define XB_XGEN(j)  (2304 + 64 * (j))
#define XB_TOP      3328
#define XB_TOPGEN   3392
#define XCD_BAR_WORDS 3456
#define XB_SPIN_CAP (1u << 22)
#define LAS __attribute__((address_space(3)))
__device__ __forceinline__ unsigned xb_ld(unsigned* p)              { return __hip_atomic_load(p, __ATOMIC_RELAXED, __HIP_MEMORY_SCOPE_AGENT); }
__device__ __forceinline__ unsigned xb_add(unsigned* p, unsigned v) { return __hip_atomic_fetch_add(p, v, __ATOMIC_RELAXED, __HIP_MEMORY_SCOPE_AGENT); }
__device__ __forceinline__ unsigned xb_xcc_id() { return (unsigned)__builtin_amdgcn_s_getreg((3 << 11) | 20) & 0xFu; }
#define XB_SPIN(cond, bar) do { unsigned _sp = 0; while (cond) { __builtin_amdgcn_s_sleep(1); \
    if ((++_sp & 255u) == 0u) { if (xb_ld(&(bar)[XB_TMO])) break; if (_sp > XB_SPIN_CAP) { atomicAdd(&(bar)[XB_TMO], 1u); break; } } } } while (0)
#define XB_LSUB(j)  (XCD_BAR_WORDS + 12 * 64 + 64 * (j))
#define XB_LGEN(j)  (XCD_BAR_WORDS + 12 * 64 + 64 * (16 + (j)))
#define XB_ALL_WORDS (XCD_BAR_WORDS + 12 * 64 + 32 * 64)
struct XcdBarrier { unsigned* bar; unsigned x; volatile LAS unsigned* st; };
__device__ __forceinline__ XcdBarrier xcd_barrier_post(unsigned* bar, volatile LAS unsigned* st) {
  XcdBarrier b; b.bar = bar; b.x = xb_xcc_id(); b.st = st;
  if (threadIdx.x == 0) st[4] = xb_add(&bar[XB_XCNT(b.x)], 1u);
  return b;
}
__device__ __forceinline__ void xcd_barrier_complete(unsigned* bar, unsigned x, unsigned& nloc, unsigned& nx) {
  const unsigned G = gridDim.x * gridDim.y * gridDim.z;
  unsigned sum, cnt, mine, sp = 0u;
  for (;;) {
    sum = 0u; cnt = 0u; mine = 0u;
#pragma unroll
    for (unsigned j = 0; j < 16; ++j) { const unsigned c = xb_ld(&bar[XB_XCNT(j)]); sum += c; cnt += (c > 0u) ? 1u : 0u; mine = (j == x) ? c : mine; }
    if (sum == G) break;
    __builtin_amdgcn_s_sleep(1);
    if ((++sp & 255u) == 0u) { if (xb_ld(&bar[XB_TMO])) break; if (sp > XB_SPIN_CAP) { atomicAdd(&bar[XB_TMO], 1u); break; } }
  }
  nloc = mine > 0u ? mine : 1u; nx = cnt > 0u ? cnt : 1u;
}
__device__ __forceinline__ unsigned xcd_topology(unsigned* bar) {
  const unsigned G = gridDim.x * gridDim.y * gridDim.z;
  unsigned sum8 = 0u, all = 1u, all64 = 1u;
#pragma unroll
  for (unsigned j = 0; j < 8; ++j) { const unsigned c = xb_ld(&bar[XB_XCNT(j)]); sum8 += c; all &= (c > 0u) ? 1u : 0u; all64 &= (c == 64u) ? 1u : 0u; }
  const unsigned ok = (all && sum8 == G) ? 1u : 0u;
  return ok | ((ok && all64) ? 2u : 0u);
}
__device__ __forceinline__ void xcd_barrier(const XcdBarrier& b) {
  asm volatile("s_waitcnt vmcnt(0)" ::: "memory");
  __syncthreads();
  if (threadIdx.x == 0) {
    unsigned* bar = b.bar;
    __builtin_amdgcn_s_waitcnt(0);
    unsigned nloc = b.st[0], nx = b.st[1];
    if (nloc == 0u) { xcd_barrier_complete(bar, b.x, nloc, nx); b.st[0] = nloc; b.st[1] = nx; b.st[5] = xcd_topology(bar); }
    const unsigned old = xb_add(&bar[XB_XSUB(b.x)], 1u);
    const unsigned gen = old / nloc;
    if (old + 1u == (gen + 1u) * nloc) {
      __builtin_amdgcn_fence(__ATOMIC_RELEASE, "agent");
      asm volatile("s_waitcnt vmcnt(0)" ::: "memory");
      const unsigned og = xb_add(&bar[XB_TOP], 1u);
      const unsigned tg = og / nx;
      if (og + 1u == (tg + 1u) * nx) xb_add(&bar[XB_TOPGEN], 1u);
      else XB_SPIN(xb_ld(&bar[XB_TOPGEN]) == tg, bar);
      __builtin_amdgcn_fence(__ATOMIC_ACQUIRE, "agent");
      xb_add(&bar[XB_XGEN(b.x)], 1u);
      asm volatile("s_waitcnt vmcnt(0)" ::: "memory");
    } else {
      XB_SPIN(xb_ld(&bar[XB_XGEN(b.x)]) == gen, bar);
      __builtin_amdgcn_fence(__ATOMIC_ACQUIRE, "agent");
      asm volatile("s_waitcnt vmcnt(0)" ::: "memory");
    }
  }
  __syncthreads();
}

__device__ __forceinline__ void xcd_barrier_local(const XcdBarrier& b) {
  asm volatile("s_waitcnt vmcnt(0)" ::: "memory");
  __syncthreads();
  if (threadIdx.x == 0) {
    unsigned* bar = b.bar;
    __builtin_amdgcn_s_waitcnt(0);
    const unsigned nloc = b.st[0];
    const unsigned old = xb_add(&bar[XB_LSUB(b.x)], 1u);
    const unsigned gen = old / nloc;
    if (old + 1u == (gen + 1u) * nloc) xb_add(&bar[XB_LGEN(b.x)], 1u);
    else XB_SPIN(xb_ld(&bar[XB_LGEN(b.x)]) == gen, bar);
    __builtin_amdgcn_fence(__ATOMIC_ACQUIRE, "agent");
    asm volatile("s_waitcnt vmcnt(0)" ::: "memory");
  }
  __syncthreads();
}

__device__ __forceinline__ void transpose_tile(const float* __restrict__ src, int lds_, u16* __restrict__ dst, int ldd,
                                               int k0, int n0, float* sm, bool fragv = false) {
  const int tid = otid();
  const int c4 = (tid & 15) * 4, r0 = tid >> 4;
  float4 v[8];
#pragma unroll
  for (int i = 0; i < 8; ++i) { const f32x4 t = __builtin_nontemporal_load((const f32x4*)(src + (size_t)(k0 + r0 + 16 * i) * lds_ + n0 + c4)); v[i] = make_float4(t[0], t[1], t[2], t[3]); }
#pragma unroll
  for (int i = 0; i < 8; ++i) {
    const int k = r0 + 16 * i;
    sm[(c4 + 0) * 129 + k] = v[i].x; sm[(c4 + 1) * 129 + k] = v[i].y; sm[(c4 + 2) * 129 + k] = v[i].z; sm[(c4 + 3) * 129 + k] = v[i].w;
  }
  __syncthreads();
  const int k8 = (tid & 15) * 8, nn = tid >> 4;
#pragma unroll
  for (int i = 0; i < 4; ++i) {
    const int n = nn + 16 * i;
    const float* row = sm + n * 129 + k8;
    uint4 w;
    w.x = pack2(row[0], row[1]); w.y = pack2(row[2], row[3]); w.z = pack2(row[4], row[5]); w.w = pack2(row[6], row[7]);
    if (fragv) {
      const int col = n0 + n, pos = k0 + k8;
      *(uint4*)(dst + ((size_t)((col >> 6) * 16 + (pos >> 5))) * 2048 + vfrag_off(pos & 31, col & 63)) = w;
    } else {
      *(uint4*)(dst + (size_t)(n0 + n) * ldd + k0 + k8) = w;
    }
  }
  __syncthreads();
}

__device__ __forceinline__ void adaln_item(const Params& p, int it, float* sm) {
  const int l = it / 192, c0 = (it % 192) * 32;
  float* ssil = sm;
  float* red = sm + 3072;
  const int tid = otid();
  for (int i = tid; i < 3072; i += 256) {
    const int cnd = i >> 10, k = i & 1023;
    const float v = cnd == 0 ? p.c_ctx[k] : p.c[(cnd - 1) * 1024 + k];
    ssil[i] = v / (1.f + expf(-v));
  }
  __syncthreads();
  const int cg4 = (tid & 7) * 4, ks = tid >> 3;
  const float* w = p.w_ada + (size_t)l * 1024 * 6144 + c0 + cg4;
  float a0[4] = {0.f, 0.f, 0.f, 0.f}, a1[4] = {0.f, 0.f, 0.f, 0.f}, a2[4] = {0.f, 0.f, 0.f, 0.f};
#pragma unroll 16
  for (int kk = 0; kk < 32; ++kk) {
    const int k = kk * 32 + ks;
    const f32x4 tv = __builtin_nontemporal_load((const f32x4*)(w + (size_t)k * 6144));
    const float4 v = make_float4(tv[0], tv[1], tv[2], tv[3]);
    const float s0 = ssil[k], s1 = ssil[1024 + k], s2 = ssil[2048 + k];
    a0[0] += s0 * v.x; a0[1] += s0 * v.y; a0[2] += s0 * v.z; a0[3] += s0 * v.w;
    a1[0] += s1 * v.x; a1[1] += s1 * v.y; a1[2] += s1 * v.z; a1[3] += s1 * v.w;
    a2[0] += s2 * v.x; a2[1] += s2 * v.y; a2[2] += s2 * v.z; a2[3] += s2 * v.w;
  }
#pragma unroll
  for (int j = 0; j < 4; ++j) {
    red[(ks * 3 + 0) * 32 + cg4 + j] = a0[j];
    red[(ks * 3 + 1) * 32 + cg4 + j] = a1[j];
    red[(ks * 3 + 2) * 32 + cg4 + j] = a2[j];
  }
  __syncthreads();
  if (tid < 96) {
    const int cnd = tid >> 5, j = tid & 31;
    float s = p.b_ada[l * 6144 + c0 + j];
    for (int q = 0; q < 32; ++q) s += red[(q * 3 + cnd) * 32 + j];
    p.mods[(l * 3 + cnd) * 6144 + c0 + j] = s;
  }
  __syncthreads();
}

__device__ __forceinline__ void cvt_item(const float* __restrict__ src, u16* __restrict__ dst, int it, int W) {
  const int w8 = W >> 3;
#pragma unroll
  for (int i = 0; i < 4; ++i) {
    const int u = it * 1024 + i * 256 + otid();
    const int d8 = u % w8, pos = (u / w8) & 511, bl = u / (w8 * 512);
    const float* sp = src + ((size_t)(bl * 512 + pos) * W + d8 * 8);
    const f32x4 t0 = __builtin_nontemporal_load((const f32x4*)sp), t1 = __builtin_nontemporal_load((const f32x4*)(sp + 4));
    const float4 v0 = make_float4(t0[0], t0[1], t0[2], t0[3]), v1 = make_float4(t1[0], t1[1], t1[2], t1[3]);
    uint4 w; w.x = pack2(v0.x, v0.y); w.y = pack2(v0.z, v0.w); w.z = pack2(v1.x, v1.y); w.w = pack2(v1.z, v1.w);
    const int h = d8 >> 3, d = (d8 & 7) * 8;
    *(uint4*)(dst + ((size_t)((bl * (W >> 6) + h) * 16 + (pos >> 5))) * 2048 + kfrag_off(pos & 31, d)) = w;
  }
}

__device__ __forceinline__ void pq_item(const Params& p, int it, float* sm) {
  const int cq = it & 3, it2 = it >> 2;
  const int l = it2 >> 3, which = (it2 >> 2) & 1, g = it2 & 3;
  const int n = otid();
  if (n < 64) sm[n] = which ? sinpif(2.f * (float)n / 64.f) : cospif(2.f * (float)n / 64.f);
  __syncthreads();
  float w[64];
#pragma unroll
  for (int m = 0; m < 64; ++m) w[m] = p.w_fourier[(size_t)l * 65536 + (g * 64 + m) * 256 + n];
  u16* dst = p.pqt + (size_t)l * 512 * 256 + (size_t)(which * 256 + n) * 256 + g * 64;
  for (int c = cq * 16; c < cq * 16 + 16; ++c) {
    float s = 0.f;
#pragma unroll
    for (int m = 0; m < 64; ++m) s += sm[(c * m) & 63] * w[m];
    dst[c] = f2bf(s);
  }
  __syncthreads();
}

__device__ __forceinline__ void dft_item(u16* dst, int L, int it) {
  const int twoL = 2 * L;
  for (int e = otid(); e < 8192; e += 256) {
    const int idx = it * 8192 + e;
    const int k = idx / twoL, j = idx % twoL;
    const int jj = j & (L - 1);
    const int ph = (k * jj) & (L - 1);
    const float a = 2.f * (float)ph / (float)L;
    const float v = (j >= L) ? -sinpif(a) : cospif(a);
    dst[idx] = f2bf(v);
  }
}

#define P0_WT 288
#define P0_ADA 768
#define P0_XC 0
#define P0_CK 320
#define P0_CVT 320
#define P0_PQ 128
#define P0_DFT 272
#define P0_ITEMS (P0_ADA + P0_WT + P0_XC + P0_CK + P0_CVT + P0_PQ + P0_DFT + 1)

__device__ void wt_item(const Params& p, int l, int r, float* sm) {
  if (r < 288) { transpose_tile(p.w_in + (size_t)l * 1024 * 2304, 2304, p.w_inT + (size_t)l * 2304 * 1024, 1024, (r / 36) * 128, (r % 36) * 64, sm); return; }
  r -= 288;
  if (r < 128) { transpose_tile(p.w_out + (size_t)l * 1024 * 1024, 1024, p.w_outT + (size_t)l * 1024 * 1024, 1024, (r / 16) * 128, (r % 16) * 64, sm); return; }
  r -= 128;
  if (r < 512) { transpose_tile(p.w1 + (size_t)l * 1024 * 4096, 4096, p.w1T + (size_t)l * 4096 * 1024, 1024, (r / 64) * 128, (r % 64) * 64, sm); return; }
  r -= 512;
  transpose_tile(p.w2 + (size_t)l * 4096 * 1024, 1024, p.w2T + (size_t)l * 1024 * 4096, 4096, (r / 16) * 128, (r % 16) * 64, sm);
}

__device__ void p0_item(const Params& p, int it, unsigned char* smem) {
  float* sm = (float*)smem;
  if (it < P0_ADA) { adaln_item(p, it, sm); return; }
  it -= P0_ADA;
  if (it < P0_WT) { wt_item(p, 0, it, sm); return; }
  it -= P0_WT;
  if (it < P0_XC) {
    const int row0 = it * 16;
    const float* src = row0 < NPTOK ? p.x_prompt + (size_t)row0 * 1024 : p.x_sample + (size_t)(row0 - NPTOK) * 1024;
    float* dst = p.xres + (size_t)row0 * 1024;
#pragma unroll
    for (int i = 0; i < 16; ++i) {
      const int o = (i * 256 + otid()) * 4;
      *(float4*)(dst + o) = *(const float4*)(src + o);
    }
    return;
  }
  it -= P0_XC;
  if (it < P0_CK) {
    if (it < 128) { cvt_item(p.c_na_k, p.ck_na, it, 256); return; }
    it -= 128;
    if (it < 128) { cvt_item(p.c_diff_k, p.ck_diff, it, 256); return; }
    it -= 128;
    cvt_item(p.c_swa_k, p.ck_swa, it, 128);
    return;
  }
  it -= P0_CK;
  if (it < P0_CVT) {
    if (it < 128) { const int bl = it >> 4, r = it & 15; transpose_tile(p.c_na_v + (size_t)bl * 512 * 256, 256, p.cvt_na + (size_t)bl * 256 * 512, 512, (r >> 2) * 128, (r & 3) * 64, sm, true); return; }
    it -= 128;
    if (it < 128) { const int bl = it >> 4, r = it & 15; transpose_tile(p.c_diff_v + (size_t)bl * 512 * 256, 256, p.cvt_diff + (size_t)bl * 256 * 512, 512, (r >> 2) * 128, (r & 3) * 64, sm, true); return; }
    it -= 128;
    { const int bl = it >> 3, r = it & 7; transpose_tile(p.c_swa_v + (size_t)bl * 512 * 128, 128, p.cvt_swa + (size_t)bl * 128 * 512, 512, (r >> 1) * 128, (r & 1) * 64, sm, true); return; }
  }
  it -= P0_CVT;
  if (it < P0_PQ) { pq_item(p, it, sm); return; }
  it -= P0_PQ;
  if (it < 16) { dft_item(p.dft256, 256, it); return; }
  it -= 16;
  if (it < 256) { dft_item(p.dft1024, 1024, it); return; }
  for (int e = otid(); e < 512 + 1024; e += 256) {
    const bool isD = e < 512;
    const int ee = isD ? e : e - 512;
    const int nf = isD ? 8 : 16;
    const int pos = ee / nf, fi = ee % nf;
    const float inv = exp2f(-(float)fi * (13.287712379549449f / (float)nf));
    float tt = (float)pos * inv * 0.15915494309189535f;
    tt -= rintf(tt);
    float sn, cs;
    sincospif(2.f * tt, &sn, &cs);
    if (isD) { p.ropeD[ee] = cs; p.ropeD[512 + ee] = sn; }
    else { p.ropeS[ee] = cs; p.ropeS[1024 + ee] = sn; }
  }
}

__device__ __forceinline__ void norm_item(const Params& p, int l, int which, int it) {
  const int lane = otid() & 63, wave = otid() >> 6;
  const int row0 = it * 16 + wave * 4;
  const float* xsrc = (which == 0 && l == 0) ? (row0 < NPTOK ? p.x_prompt + (size_t)row0 * 1024 : p.x_sample + (size_t)(row0 - NPTOK) * 1024)
                                             : p.xres + (size_t)row0 * 1024;
  float4 v[4][4];
#pragma unroll
  for (int j = 0; j < 4; ++j)
#pragma unroll
    for (int k = 0; k < 4; ++k) v[j][k] = *(const float4*)(xsrc + (size_t)j * 1024 + (k * 64 + lane) * 4);
  float rs[4];
#pragma unroll
  for (int j = 0; j < 4; ++j) {
    float ss = 0.f;
#pragma unroll
    for (int k = 0; k < 4; ++k) ss += v[j][k].x * v[j][k].x + v[j][k].y * v[j][k].y + v[j][k].z * v[j][k].z + v[j][k].w * v[j][k].w;
#pragma unroll
    for (int o = 32; o >= 1; o >>= 1) ss += __shfl_xor(ss, o);
    rs[j] = rsqrtf(ss * (1.f / 1024.f) + 1e-6f);
  }
  if (which < 2) {
    const int cond = row0 < NPTOK ? 0 : 1 + ((row0 - NPTOK) >> 10);
    const float* gp = (which == 0 ? p.norm1_g : p.norm2_g) + l * 1024;
    const float* shp = p.mods + (size_t)(l * 3 + cond) * 6144 + (which * 3 + 0) * 1024;
    const float* scp = shp + 1024;
#pragma unroll
    for (int k = 0; k < 4; ++k) {
      const int col = (k * 64 + lane) * 4;
      const float4 gg = *(const float4*)(gp + col);
      const float4 sh = *(const float4*)(shp + col);
      const float4 sc = *(const float4*)(scp + col);
      const float mx = gg.x * (1.f + sc.x), my = gg.y * (1.f + sc.y), mz = gg.z * (1.f + sc.z), mw = gg.w * (1.f + sc.w);
#pragma unroll
      for (int j = 0; j < 4; ++j) {
        uint2 w;
        w.x = pack2(v[j][k].x * rs[j] * mx + sh.x, v[j][k].y * rs[j] * my + sh.y);
        w.y = pack2(v[j][k].z * rs[j] * mz + sh.z, v[j][k].w * rs[j] * mw + sh.w);
        *(uint2*)(p.h + (size_t)(row0 + j) * 1024 + col) = w;
      }
    }
  } else {
#pragma unroll
    for (int k = 0; k < 4; ++k) {
      const int col = (k * 64 + lane) * 4;
      const float4 gg = *(const float4*)(p.final_g + col);
#pragma unroll
      for (int j = 0; j < 4; ++j) {
        float4 o;
        o.x = v[j][k].x * rs[j] * gg.x; o.y = v[j][k].y * rs[j] * gg.y; o.z = v[j][k].z * rs[j] * gg.z; o.w = v[j][k].w * rs[j] * gg.w;
        { f32x4 ov = {o.x, o.y, o.z, o.w}; __builtin_nontemporal_store(ov, (f32x4*)(p.out + (size_t)(row0 + j) * 1024 + col)); }
      }
    }
  }
}

template <bool ZERO, int YT>
__device__ __forceinline__ void gemm_main_t(const u16* __restrict__ X, int ldx, const u16* __restrict__ Y, int ldy, int K,
                                          u16* smem, f32x4 (&acc)[4][YT]) {
  const int tid = otid(), lane = tid & 63, wave = tid >> 6, wx = wave & 1, wy = wave >> 1, r = lane & 15, g = lane >> 4;
  u16* sX = smem;
  u16* sY = smem + 2 * 128 * 64;
  const int lrow = tid >> 3, lkc = tid & 7;
  const int gsw = (lkc ^ (lrow & 7)) * 8;
  const u16* gx = X + (size_t)lrow * ldx + gsw;
  const u16* gy = Y + (size_t)lrow * ldy + gsw;
  u16* lx = sX + tid * 8;
  u16* ly = sY + tid * 8;
#define GEMM_STAGE(buf, kt_)                                                                                                      \
  {                                                                                                                               \
    _Pragma("unroll") for (int i = 0; i < 4; ++i)                                                                                 \
      __builtin_amdgcn_global_load_lds((const unsigned*)(gx + (size_t)(32 * i) * ldx + (kt_) * 64),                               \
                                       (unsigned*)(lx + (buf) * 8192 + i * 2048), 16, 0, 0);                                      \
    _Pragma("unroll") for (int i = 0; i < YT; ++i)                                                                                \
      __builtin_amdgcn_global_load_lds((const unsigned*)(gy + (size_t)(32 * i) * ldy + (kt_) * 64),                               \
                                       (unsigned*)(ly + (buf) * 8192 + i * 2048), 16, 0, 0);                                      \
  }
  GEMM_STAGE(0, 0);
  if (ZERO) {
#pragma unroll
    for (int a = 0; a < 4; ++a)
#pragma unroll
      for (int b = 0; b < YT; ++b) acc[a][b] = (f32x4){0.f, 0.f, 0.f, 0.f};
  }
  const int nk = K >> 6;
  const int sw = r & 7;
  const u16* cx0 = sX + (wx * 64 + r) * 64;
  const u16* cy0 = sY + (wy * (16 * YT) + r) * 64;
  __syncthreads();
#define GEMM_COMPUTE(cur)                                                                            \
  {                                                                                                  \
    const u16* cx = cx0 + (cur) * 8192;                                                              \
    const u16* cy = cy0 + (cur) * 8192;                                                              \
    const int pc0 = (g ^ sw) * 8, pc1 = ((4 + g) ^ sw) * 8;                                          \
    bf16x8 a0[4], b0[YT], a1[4], b1[YT];                                                             \
    _Pragma("unroll") for (int i = 0; i < 4; ++i) a0[i] = *(const bf16x8*)(cx + i * 16 * 64 + pc0);  \
    _Pragma("unroll") for (int i = 0; i < YT; ++i) b0[i] = *(const bf16x8*)(cy + i * 16 * 64 + pc0); \
    _Pragma("unroll") for (int i = 0; i < 4; ++i) a1[i] = *(const bf16x8*)(cx + i * 16 * 64 + pc1);  \
    _Pragma("unroll") for (int i = 0; i < YT; ++i) b1[i] = *(const bf16x8*)(cy + i * 16 * 64 + pc1); \
    __builtin_amdgcn_s_setprio(1);                                                                   \
    _Pragma("unroll") for (int xi = 0; xi < 4; ++xi)                                                 \
      _Pragma("unroll") for (int yi = 0; yi < YT; ++yi)                                              \
        acc[xi][yi] = __builtin_amdgcn_mfma_f32_16x16x32_bf16(a0[xi], b0[yi], acc[xi][yi], 0, 0, 0); \
    _Pragma("unroll") for (int xi = 0; xi < 4; ++xi)                                                 \
      _Pragma("unroll") for (int yi = 0; yi < YT; ++yi)                                              \
        acc[xi][yi] = __builtin_amdgcn_mfma_f32_16x16x32_bf16(a1[xi], b1[yi], acc[xi][yi], 0, 0, 0); \
    __builtin_amdgcn_s_setprio(0);                                                                   \
  }
#pragma unroll 1
  for (int kt = 0; kt < nk - 1; ++kt) {
    const int cur = kt & 1;
    GEMM_STAGE(cur ^ 1, kt + 1);
    GEMM_COMPUTE(cur);
    __syncthreads();
  }
  GEMM_COMPUTE((nk - 1) & 1);
  __syncthreads();
#undef GEMM_COMPUTE
#undef GEMM_STAGE
}

#ifndef REP_GEMM
#define REP_GEMM 0
#endif
#ifndef REP_MIX
#define REP_MIX 0
#endif
#ifndef REP_SYNC
#define REP_SYNC 0
#endif
#ifndef REP_P0
#define REP_P0 0
#endif
template <int YT>
__device__ __forceinline__ void gemm_main(const u16* __restrict__ X, int ldx, const u16* __restrict__ Y, int ldy, int K,
                                          u16* smem, f32x4 (&acc)[4][YT]) {
  gemm_main_t<true, YT>(X, ldx, Y, ldy, K, smem, acc);
#if REP_GEMM
  gemm_main_t<false, YT>(X, ldx, Y, ldy, K, smem, acc);
#pragma unroll
  for (int a = 0; a < 4; ++a)
#pragma unroll
    for (int b = 0; b < YT; ++b) acc[a][b] *= 0.5f;
#endif
}

__device__ __forceinline__ bool tile_map(int j, int ntx, int& tx, int& ty, int nty = 48) {
  const int nblk = gridDim.x, bid = blockIdx.x;
  if (nblk == 512) {
    const int per = nty >> 3, hp = per >> 1;
    const int rank = bid >> 3, q = (rank & 31) + j * 32, mem = rank >> 5;
    if (q >= hp * ntx) return false;
    tx = q / hp; ty = per * (bid & 7) + 2 * (q % hp) + mem;
    return true;
  } else {
    const int it = bid + j * nblk;
    if (it >= nty * ntx) return false;
    tx = it / nty; ty = it % nty;
    return true;
  }
}

__device__ void gin_tile(const Params& p, int l, int tx, int ty, u16* smem) {
  const int n0 = tx * 128, m0 = ty * 128;
  f32x4 acc[4][4];
  gemm_main<4>(p.w_inT + (size_t)l * 2304 * 1024 + (size_t)n0 * 1024, 1024, p.h + (size_t)m0 * 1024, 1024, 1024, smem, acc);
  const int lane = otid() & 63, wave = otid() >> 6, wx = wave & 1, wy = wave >> 1, r = lane & 15, g = lane >> 4;
  const int nw = n0 + wx * 64;
  const bool isS = m0 >= NPTOK;
  int ropeMode = 0;
  if (isS) {
    if (nw >= 768 && nw < 1280) ropeMode = 1;
    else if (nw >= 1792 && nw < 2176) ropeMode = 2;
  }
  float* okv = nullptr; int okv_w = 0, okv_c = 0;
  if (!isS) {
    if (nw >= 256 && nw < 512) { okv = p.out + O_NAK; okv_w = 256; okv_c = nw - 256; }
    else if (nw >= 512 && nw < 768) { okv = p.out + O_NAV; okv_w = 256; okv_c = nw - 512; }
    else if (nw >= 1024 && nw < 1280) { okv = p.out + O_DK; okv_w = 256; okv_c = nw - 1024; }
    else if (nw >= 1280 && nw < 1536) { okv = p.out + O_DV; okv_w = 256; okv_c = nw - 1280; }
    else if (nw >= 2048 && nw < 2176) { okv = p.out + O_SK; okv_w = 128; okv_c = nw - 2048; }
    else if (nw >= 2176) { okv = p.out + O_SV; okv_w = 128; okv_c = nw - 2176; }
  }
  int khh = -1;
  if (nw >= 256 && nw < 512) khh = (nw - 256) >> 6;
  else if (nw >= 1024 && nw < 1280) khh = 4 + ((nw - 1024) >> 6);
  else if (nw >= 2048 && nw < 2176) khh = 8 + ((nw - 2048) >> 6);
  int vrow = -1;
  if (nw >= 512 && nw < 768) vrow = nw - 512;
  else if (nw >= 1280 && nw < 1536) vrow = 256 + nw - 1280;
  else if (nw >= 2176) vrow = 512 + nw - 2176;
#pragma unroll
  for (int yi = 0; yi < 4; ++yi) {
    const int m = m0 + wy * 64 + yi * 16 + r;
    const int t = (m - NPTOK) & 1023;
    const int prow = t >> 6, pcol = t & 63;
#pragma unroll
    for (int xi = 0; xi < 4; ++xi) {
      f32x4 v = acc[xi][yi];
      if (ropeMode == 1) {
        const int pos = (xi & 1) ? pcol : prow;
        const float4 cs = *(const float4*)(p.ropeD + pos * 8 + 4 * (g & 1));
        const float4 sn = *(const float4*)(p.ropeD + 512 + pos * 8 + 4 * (g & 1));
        const float sg = (g >= 2) ? 1.f : -1.f;
        const float o0 = __shfl_xor(v[0], 32), o1 = __shfl_xor(v[1], 32), o2 = __shfl_xor(v[2], 32), o3 = __shfl_xor(v[3], 32);
        v[0] = v[0] * cs.x + sg * o0 * sn.x; v[1] = v[1] * cs.y + sg * o1 * sn.y;
        v[2] = v[2] * cs.z + sg * o2 * sn.z; v[3] = v[3] * cs.w + sg * o3 * sn.w;
      } else if (ropeMode == 2) {
        const int pos = (xi >> 1) ? pcol : prow;
        const float4 cs = *(const float4*)(p.ropeS + pos * 16 + 4 * g);
        const float4 sn = *(const float4*)(p.ropeS + 1024 + pos * 16 + 4 * g);
        const f32x4 o = acc[xi ^ 1][yi];
        const float sg = (xi & 1) ? 1.f : -1.f;
        v[0] = v[0] * cs.x + sg * o[0] * sn.x; v[1] = v[1] * cs.y + sg * o[1] * sn.y;
        v[2] = v[2] * cs.z + sg * o[2] * sn.z; v[3] = v[3] * cs.w + sg * o[3] * sn.w;
      }
      const int nloc = xi * 16 + 4 * g;
      if (okv) {
        const int b = m >> 8, pos = m & 255;
        float4 o4; o4.x = v[0]; o4.y = v[1]; o4.z = v[2]; o4.w = v[3];
        __builtin_nontemporal_store(v, (f32x4*)(okv + ((size_t)((b * 4 + l) * 256 + pos)) * okv_w + okv_c + nloc));
      }
      if (vrow >= 0) {
        u16* vb = p.vfr + ((size_t)((vrow >> 6) * 192 + (m >> 5))) * 2048;
#pragma unroll
        for (int i = 0; i < 4; ++i) vb[vfrag_off(m & 31, nloc + i)] = f2bf(v[i]);
      } else if (khh >= 0) {
        uint2 w; w.x = pack2(v[0], v[1]); w.y = pack2(v[2], v[3]);
        *(uint2*)(p.kfr + ((size_t)(khh * 192 + (m >> 5))) * 2048 + kfrag_off(m & 31, nloc)) = w;
      } else {
        uint2 w; w.x = pack2(v[0], v[1]); w.y = pack2(v[2], v[3]);
        *(uint2*)(p.z + (size_t)m * INW + nw + nloc) = w;
      }
    }
  }
}

__device__ void res_tile(const Params& p, int l, int tx, int ty, const u16* A, const u16* WT, int K, int gi, u16* smem, bool first = false) {
  const int n0 = tx * 128, m0 = ty * 96;
  f32x4 acc[4][3];
  gemm_main<3>(WT + (size_t)n0 * K, K, A + (size_t)m0 * K, K, K, smem, acc);
  const int lane = otid() & 63, wave = otid() >> 6, wx = wave & 1, wy = wave >> 1, r = lane & 15, g = lane >> 4;
#pragma unroll
  for (int yi = 0; yi < 3; ++yi) {
    const int m = m0 + wy * 48 + yi * 16 + r;
    const int cond = m < NPTOK ? 0 : 1 + ((m - NPTOK) >> 10);
    const float* gate = p.mods + (size_t)(l * 3 + cond) * 6144 + gi * 1024;
    float* xrow = p.xres + (size_t)m * 1024;
    const float* xin = first ? (m < NPTOK ? p.x_prompt + (size_t)m * 1024 : p.x_sample + (size_t)(m - NPTOK) * 1024) : xrow;
    float4 xv[4], gt[4];
#pragma unroll
    for (int xi = 0; xi < 4; ++xi) {
      const int n = n0 + wx * 64 + xi * 16 + 4 * g;
      xv[xi] = *(const float4*)(xin + n);
      gt[xi] = *(const float4*)(gate + n);
    }
#pragma unroll
    for (int xi = 0; xi < 4; ++xi) {
      const int n = n0 + wx * 64 + xi * 16 + 4 * g;
      const f32x4 v = acc[xi][yi];
      float4 o = xv[xi];
      o.x += gt[xi].x * v[0]; o.y += gt[xi].y * v[1]; o.z += gt[xi].z * v[2]; o.w += gt[xi].w * v[3];
      *(float4*)(xrow + n) = o;
    }
  }
}

__device__ void m1_tile(const Params& p, int l, int tx, int ty, u16* smem) {
  const int n0 = tx * 128, m0 = ty * 128;
  f32x4 acc[4][4];
  gemm_main<4>(p.w1T + (size_t)l * 4096 * 1024 + (size_t)n0 * 1024, 1024, p.h + (size_t)m0 * 1024, 1024, 1024, smem, acc);
  const int lane = otid() & 63, wave = otid() >> 6, wx = wave & 1, wy = wave >> 1, r = lane & 15, g = lane >> 4;
#pragma unroll
  for (int xi = 0; xi < 4; ++xi) {
    const int n = n0 + wx * 64 + xi * 16 + 4 * g;
#pragma unroll
    for (int yi = 0; yi < 4; ++yi) {
      const int m = m0 + wy * 64 + yi * 16 + r;
      const f32x4 v = acc[xi][yi];
      float a0 = fmaxf(v[0], 0.f), a1 = fmaxf(v[1], 0.f), a2 = fmaxf(v[2], 0.f), a3 = fmaxf(v[3], 0.f);
      uint2 w; w.x = pack2(a0 * a0, a1 * a1); w.y = pack2(a2 * a2, a3 * a3);
      *(uint2*)(p.u + (size_t)m * 4096 + n) = w;
    }
  }
}

__device__ void f1_tile(const Params& p, int l, int it, u16* smem) {
  const int tx = it % 48, ty = it / 48;
  const int x0 = tx * 128, y0 = ty * 128;
  f32x4 acc[4][4];
  gemm_main<4>(p.z + (size_t)x0 * INW + 1536, INW, p.pqt + (size_t)l * 512 * 256 + (size_t)y0 * 256, 256, 256, smem, acc);
  const int lane = otid() & 63, wave = otid() >> 6, wx = wave & 1, wy = wave >> 1, r = lane & 15, g = lane >> 4;
#pragma unroll
  for (int yi = 0; yi < 4; ++yi) {
    const int y = y0 + wy * 64 + yi * 16 + r;
    const int col = y & 255, which = y >> 8;
#pragma unroll
    for (int xi = 0; xi < 4; ++xi) {
      const int tok = x0 + wx * 64 + xi * 16 + 4 * g;
      size_t addr;
      if (tok < NPTOK) {
        const int b = tok >> 8, pos = tok & 255;
        addr = (size_t)b * (256 * 512) + (size_t)col * 512 + which * 256 + pos;
      } else {
        const int b = (tok - NPTOK) >> 10, pos = (tok - NPTOK) & 1023;
        addr = (size_t)16 * 256 * 512 + (size_t)b * (256 * 2048) + (size_t)col * 2048 + which * 1024 + pos;
      }
      const f32x4 v = acc[xi][yi];
      uint2 w; w.x = pack2(v[0], v[1]); w.y = pack2(v[2], v[3]);
      *(uint2*)(p.uv + addr) = w;
    }
  }
  asm volatile("s_waitcnt vmcnt(0)" ::: "memory");
  __syncthreads();
  if (threadIdx.x == 0) {
    __builtin_amdgcn_fence(__ATOMIC_RELEASE, "agent");
    asm volatile("s_waitcnt vmcnt(0)" ::: "memory");
    xb_add(p.bar + XCD_BAR_WORDS + (8 + l) * 64, 1u);
  }
}

__device__ void f2_tile(const Params& p, int l, int it, u16* smem) {
  if (threadIdx.x == 0) {
    unsigned* c = p.bar + XCD_BAR_WORDS + (8 + l) * 64;
    unsigned sp = 0;
    while (xb_ld(c) < 192u) { __builtin_amdgcn_s_sleep(2); if (++sp > (1u << 24)) break; }
    __builtin_amdgcn_fence(__ATOMIC_ACQUIRE, "agent");
    asm volatile("s_waitcnt vmcnt(0)" ::: "memory");
  }
  __syncthreads();
  int L, b, tx, ty, tokbase;
  const u16* uvb; const u16* dft;
  if (it < 32) { L = 1024; b = it >> 4; tx = (it >> 3) & 1; ty = it & 7; uvb = p.uv + (size_t)16 * 256 * 512 + (size_t)b * (256 * 2048); dft = p.dft1024; tokbase = NPTOK + b * 1024; }
  else { it -= 32; L = 256; b = it >> 2; tx = (it >> 1) & 1; ty = it & 1; uvb = p.uv + (size_t)b * (256 * 512); dft = p.dft256; tokbase = b * 256; }
  const int x0 = tx * 128, y0 = ty * 128, K = 2 * L;
  f32x4 acc[4][4];
  gemm_main<4>(uvb + (size_t)x0 * K, K, dft + (size_t)y0 * K, K, K, smem, acc);
  const int lane = otid() & 63, wave = otid() >> 6, wx = wave & 1, wy = wave >> 1, r = lane & 15, g = lane >> 4;
  const float scale = rsqrtf(64.f * (float)L);
#pragma unroll
  for (int yi = 0; yi < 4; ++yi) {
    const int pos = y0 + wy * 64 + yi * 16 + r;
#pragma unroll
    for (int xi = 0; xi < 4; ++xi) {
      const int col = x0 + wx * 64 + xi * 16 + 4 * g;
      const f32x4 v = acc[xi][yi];
      uint2 w; w.x = pack2(v[0] * scale, v[1] * scale); w.y = pack2(v[2] * scale, v[3] * scale);
      *(uint2*)(p.cat + (size_t)(tokbase + pos) * 1024 + 512 + col) = w;
    }
  }
}

struct Seg { const u16* K; const u16* Vt; int ldk, ldv, nblk, pos0, stride; };
#define KLOC(hh, tokb) (p.kfr + ((size_t)((hh) * 192 + ((tokb) >> 5))) * 2048)
#define VLOC(hh, tokb) (p.vfr + ((size_t)((hh) * 192 + ((tokb) >> 5))) * 2048)
template <int QT> struct AState { float m[QT]; float ls[QT]; f32x4 o[QT][4]; };

__device__ __forceinline__ bf16x8 as_bf(u32x4 v) { union { u32x4 u; bf16x8 b; } x; x.u = v; return x.b; }

template <int DC>
__device__ __forceinline__ void issue_blk(const Seg& s0, const Seg& s1, int b, int r, int g, u32x4 (&kf)[2][DC], u32x4 (&vf)[4]) {
  const bool in0 = b < s0.nblk;
  const u16* Kp = in0 ? s0.K : s1.K;
  const u16* Vp = in0 ? s0.Vt : s1.Vt;
  const int pos = in0 ? (s0.pos0 + b * s0.stride) : (s1.pos0 + (b - s0.nblk) * s1.stride);
  const int lane8 = (g * 16 + r) * 8;
  const u16* kp = Kp + (size_t)(pos >> 5) * 2048 + lane8;
  const u16* vp = Vp + (size_t)(pos >> 5) * 2048 + lane8;
#pragma unroll
  for (int t = 0; t < 2; ++t)
#pragma unroll
    for (int dc = 0; dc < DC; ++dc) gload16(kf[t][dc], kp + (t * 2 + dc) * 512);
#pragma unroll
  for (int dv = 0; dv < 4; ++dv) gload16(vf[dv], vp + dv * 512);
}
template <int N>
__device__ __forceinline__ void wait_blk(u32x4 (&kf)[2][1], u32x4 (&vf)[4]) {
  asm volatile("s_waitcnt vmcnt(%6)" : "+v"(kf[0][0]), "+v"(kf[1][0]), "+v"(vf[0]), "+v"(vf[1]), "+v"(vf[2]), "+v"(vf[3]) : "n"(N) : "memory");
}
template <int N>
__device__ __forceinline__ void wait_blk(u32x4 (&kf)[2][2], u32x4 (&vf)[4]) {
  asm volatile("s_waitcnt vmcnt(%8)" : "+v"(kf[0][0]), "+v"(kf[0][1]), "+v"(kf[1][0]), "+v"(kf[1][1]), "+v"(vf[0]), "+v"(vf[1]), "+v"(vf[2]), "+v"(vf[3]) : "n"(N) : "memory");
}

template <int D, int QT, int MODE>
__device__ __forceinline__ void attn_compute(const u32x4 (&kc)[2][D / 32], const u32x4 (&vc)[4], const bf16x8 (&qf)[QT][D / 32], const float sc,
                                             AState<QT>& st, const bool in0, const int pos, const int qpos0, const float* __restrict__ rpb_h,
                                             const int r, const int g) {
  constexpr int DC = D / 32;
#pragma unroll
  for (int q = 0; q < QT; ++q) {
    f32x4 s_[2];
    s_[0] = (f32x4){0.f, 0.f, 0.f, 0.f};
    s_[1] = (f32x4){0.f, 0.f, 0.f, 0.f};
#pragma unroll
    for (int t = 0; t < 2; ++t)
#pragma unroll
      for (int dc = 0; dc < DC; ++dc) s_[t] = __builtin_amdgcn_mfma_f32_16x16x32_bf16(as_bf(kc[t][dc]), qf[q][dc], s_[t], 0, 0, 0);
    float sv[8];
#pragma unroll
    for (int t = 0; t < 2; ++t)
#pragma unroll
      for (int i = 0; i < 4; ++i) {
        float x = s_[t][i] * sc;
        if (MODE == 1) {
          if (!in0) {
            const int qpos = qpos0 + q * 16 + r;
            const int qrow = qpos >> 6, cq = qpos & 63;
            const int kpos = pos + 8 * g + 4 * t + i;
            const int krow = kpos >> 6, ck = kpos & 63;
            const int cs = min(max(cq - 8, 0), 48);
            const bool valid = (ck >= cs) && (ck < cs + 16);
            const int bi = (krow - qrow + 7) * 31 + (ck - cq + 15);
            const float bias = rpb_h[valid ? bi : 0];
            x = valid ? (x + bias) : -1e30f;
          }
        } else if (MODE == 2) {
          if (!in0) {
            const int qpos = qpos0 + q * 16 + r;
            const int kpos = pos + 8 * g + 4 * t + i;
            const int d = qpos - kpos;
            x = (d <= 128 && d >= -128) ? x : -1e30f;
          }
        }
        sv[4 * t + i] = x;
      }
    float mx = fmaxf(fmaxf(fmaxf(sv[0], sv[1]), fmaxf(sv[2], sv[3])), fmaxf(fmaxf(sv[4], sv[5]), fmaxf(sv[6], sv[7])));
    mx = fmaxf(mx, __shfl_xor(mx, 16));
    mx = fmaxf(mx, __shfl_xor(mx, 32));
    const float mnew = fmaxf(st.m[q], mx);
    const float alpha = __builtin_amdgcn_exp2f(st.m[q] - mnew);
    st.m[q] = mnew;
    float ps = 0.f;
#pragma unroll
    for (int j = 0; j < 8; ++j) { sv[j] = __builtin_amdgcn_exp2f(sv[j] - mnew); ps += sv[j]; }
    st.ls[q] = st.ls[q] * alpha + ps;
    union { bf16x8 v; unsigned w[4]; } pf;
    pf.w[0] = pack2(sv[0], sv[1]); pf.w[1] = pack2(sv[2], sv[3]); pf.w[2] = pack2(sv[4], sv[5]); pf.w[3] = pack2(sv[6], sv[7]);
#pragma unroll
    for (int dv = 0; dv < 4; ++dv) {
      f32x4 o = st.o[q][dv];
      o[0] *= alpha; o[1] *= alpha; o[2] *= alpha; o[3] *= alpha;
      st.o[q][dv] = __builtin_amdgcn_mfma_f32_16x16x32_bf16(as_bf(vc[dv]), pf.v, o, 0, 0, 0);
    }
  }
}

template <int D, int QT, int MODE, int NQ = 2>
__device__ __forceinline__ void attn_run(const Seg& s0, const Seg& s1, const bf16x8 (&qf)[QT][D / 32], const float sc,
                                         AState<QT>& st, const int qpos0, const float* __restrict__ rpb_h, const int bb = 0, const int be = -1) {
  constexpr int DC = D / 32;
  constexpr int NL = 2 * DC + 4;
  const int lane = otid() & 63, r = lane & 15, g = lane >> 4;
  const int nb = be < 0 ? s0.nblk + s1.nblk : be;
  u32x4 kq[NQ][2][DC], vq[NQ][4];
#pragma unroll
  for (int q = 0; q < QT; ++q)
#pragma unroll
    for (int dc = 0; dc < DC; ++dc) asm volatile("" ::"v"(qf[q][dc]));
  asm volatile("s_waitcnt vmcnt(0)" ::: "memory");
#pragma unroll 1
  for (int b = bb; b < nb; b += NQ) {
#pragma unroll
    for (int j = 0; j < NQ; ++j) issue_blk<DC>(s0, s1, b + j, r, g, kq[j], vq[j]);
#pragma unroll
    for (int j = 0; j < NQ; ++j) {
      if (j == 0) wait_blk<(NQ - 1) * NL>(kq[j], vq[j]);
      else if (j == 1) wait_blk<(NQ - 2) * NL>(kq[j], vq[j]);
      else if (j == 2) wait_blk<(NQ > 3 ? (NQ - 3) * NL : 0)>(kq[j], vq[j]);
      else wait_blk<0>(kq[j], vq[j]);
      const int bj = b + j;
      const bool in0 = bj < s0.nblk;
      const int pos = in0 ? (s0.pos0 + bj * s0.stride) : (s1.pos0 + (bj - s0.nblk) * s1.stride);
      attn_compute<D, QT, MODE>(kq[j], vq[j], qf, sc, st, in0, pos, qpos0, rpb_h, r, g);
    }
  }
}

template <int QT>
__device__ __forceinline__ void astate_init(AState<QT>& st, float m0, float l0) {
#pragma unroll
  for (int q = 0; q < QT; ++q) {
    st.m[q] = m0; st.ls[q] = l0;
#pragma unroll
    for (int dv = 0; dv < 4; ++dv) st.o[q][dv] = (f32x4){0.f, 0.f, 0.f, 0.f};
  }
}
template <int QT>
__device__ __forceinline__ void astate_finalize(AState<QT>& st) {
#pragma unroll
  for (int q = 0; q < QT; ++q) {
    float l = st.ls[q];
    l += __shfl_xor(l, 16);
    l += __shfl_xor(l, 32);
    const float inv = 1.f / l;
#pragma unroll
    for (int dv = 0; dv < 4; ++dv) { st.o[q][dv][0] *= inv; st.o[q][dv][1] *= inv; st.o[q][dv][2] *= inv; st.o[q][dv][3] *= inv; }
  }
}
template <int DC, int QT>
__device__ __forceinline__ void load_q(const u16* zq  , bf16x8 (&qf)[QT][DC]) {
  const int lane = otid() & 63, r = lane & 15, g = lane >> 4;
#pragma unroll
  for (int q = 0; q < QT; ++q)
#pragma unroll
    for (int dc = 0; dc < DC; ++dc) qf[q][dc] = *(const bf16x8*)(zq + (size_t)(q * 16 + r) * INW + dc * 32 + g * 8);
}
template <int QT>
__device__ __forceinline__ void write_o(const Params& p, const AState<QT>& st, int tok0, int col0) {
  const int lane = otid() & 63, r = lane & 15, g = lane >> 4;
#pragma unroll
  for (int q = 0; q < QT; ++q)
#pragma unroll
    for (int dv = 0; dv < 4; ++dv) {
      const f32x4 v = st.o[q][dv];
      uint2 w; w.x = pack2(v[0], v[1]); w.y = pack2(v[2], v[3]);
      *(uint2*)(p.cat + (size_t)(tok0 + q * 16 + r) * 1024 + col0 + dv * 16 + 4 * g) = w;
    }
}

__device__ __forceinline__ float diff_lambda(const Params& p, int l, float lam_init) {
  const int lane = otid() & 63;
  float a = 0.f, b = 0.f;
  if (lane < 32) { a = p.lq1[l * 32 + lane] * p.lk1[l * 32 + lane]; b = p.lq2[l * 32 + lane] * p.lk2[l * 32 + lane]; }
#pragma unroll
  for (int o = 32; o >= 1; o >>= 1) { a += __shfl_xor(a, o); b += __shfl_xor(b, o); }
  return expf(a) - expf(b) + lam_init;
}

__device__ __forceinline__ void diff_finish_q(const Params& p, int l, float lam, float lam_init, f32x4 (&A)[4], const f32x4 (&B)[4], int tokrow0, int col0) {
  const int lane = otid() & 63, r = lane & 15, g = lane >> 4;
  const float* sg = p.subln_g + l * 64;
  float ss = 0.f;
#pragma unroll
  for (int dv = 0; dv < 4; ++dv)
#pragma unroll
    for (int i = 0; i < 4; ++i) {
      const float v = A[dv][i] - lam * B[dv][i];
      A[dv][i] = v;
      ss += v * v;
    }
  ss += __shfl_xor(ss, 16);
  ss += __shfl_xor(ss, 32);
  const float rs = rsqrtf(ss * (1.f / 64.f) + 1e-6f) * (1.f - lam_init);
#pragma unroll
  for (int dv = 0; dv < 4; ++dv) {
    const float4 gg = *(const float4*)(sg + dv * 16 + 4 * g);
    uint2 w;
    w.x = pack2(A[dv][0] * rs * gg.x, A[dv][1] * rs * gg.y);
    w.y = pack2(A[dv][2] * rs * gg.z, A[dv][3] * rs * gg.w);
    *(uint2*)(p.cat + (size_t)(tokrow0 + r) * 1024 + col0 + dv * 16 + 4 * g) = w;
  }
}

#ifndef AQT
#define AQT 2
#endif
#define QW (16 * AQT)
#define NQG_CTX (256 / QW)
#define NQG_LAT (1024 / QW)
__device__ void attn_diff_item(const Params& p, int l, bool lat, int bi, float* sm) {
  const int wave = otid() >> 6, lane = otid() & 63, r = lane & 15, g = lane >> 4;
  const int ps = wave >> 1, half = wave & 1;
  int b, h, qg, tokb;
  if (lat) { b = bi / (4 * NQG_LAT); h = (bi / NQG_LAT) & 3; qg = bi % NQG_LAT; tokb = NPTOK + b * 1024; }
  else { b = bi / (4 * NQG_CTX); h = (bi / NQG_CTX) & 3; qg = bi % NQG_CTX; tokb = b * 256; }
  const int tok0 = tokb + qg * QW;
  const u16* zb = p.z + (size_t)tokb * INW;
  Seg s0, s1;
  if (lat) {
    const int bl = b * 4 + l;
    s0.K = p.ck_diff + (size_t)((bl * 4 + h) * 16) * 2048 + ps * 512; s0.Vt = p.cvt_diff + (size_t)((bl * 4 + h) * 16) * 2048;
    s0.ldk = 0; s0.ldv = 0; s0.nblk = half ? 0 : 16; s0.pos0 = 0; s0.stride = 32;
    s1.K = KLOC(4 + h, tokb) + ps * 512; s1.Vt = VLOC(4 + h, tokb);
    s1.ldk = 0; s1.ldv = 0; s1.nblk = half ? 24 : 8; s1.pos0 = half ? 256 : 0; s1.stride = 32;
  } else {
    s0.K = KLOC(4 + h, tokb) + ps * 512; s0.Vt = VLOC(4 + h, tokb);
    s0.ldk = 0; s0.ldv = 0; s0.nblk = 4; s0.pos0 = half ? 128 : 0; s0.stride = 32;
    s1 = s0; s1.nblk = 0;
  }
  bf16x8 qf[AQT][1];
  load_q<1, AQT>(p.z + (size_t)tok0 * INW + 768 + h * 64 + ps * 32, qf);
  AState<AQT> st;
  astate_init<AQT>(st, -1e30f, 0.f);
  attn_run<32, AQT, 0, 2>(s0, s1, qf, 0.17677669529663687f * LOG2E, st, 0, nullptr);
  float lt[AQT];
#pragma unroll
  for (int q = 0; q < AQT; ++q) {
    lt[q] = st.ls[q];
    lt[q] += __shfl_xor(lt[q], 16);
    lt[q] += __shfl_xor(lt[q], 32);
  }
  constexpr int WS = 64 * 16 * AQT;
  float* pm = sm + 4 * WS;
  if (wave != 0) {
    float* po = sm + wave * WS + lane * (16 * AQT);
#pragma unroll
    for (int q = 0; q < AQT; ++q) {
#pragma unroll
      for (int dv = 0; dv < 4; ++dv) *(f32x4*)(po + q * 16 + dv * 4) = st.o[q][dv];
      if (g == 0) { pm[wave * QW + q * 16 + r] = st.m[q]; pm[4 * QW + wave * QW + q * 16 + r] = lt[q]; }
    }
  }
  __syncthreads();
  if (wave == 0) {
    const float lam_init = 0.8f - 0.6f * expf(-0.3f * (float)l);
    const float lam = diff_lambda(p, l, lam_init);
#pragma unroll
    for (int q = 0; q < AQT; ++q) {
      f32x4 A[4], B[4];
      {
        const float m1 = pm[QW + q * 16 + r], l1 = pm[4 * QW + QW + q * 16 + r];
        const float M = fmaxf(st.m[q], m1);
        const float a0 = exp2f(st.m[q] - M), a1 = exp2f(m1 - M);
        const float inv = 1.f / (lt[q] * a0 + l1 * a1);
#pragma unroll
        for (int dv = 0; dv < 4; ++dv) {
          const f32x4 o1 = *(const f32x4*)(sm + 1 * WS + lane * (16 * AQT) + q * 16 + dv * 4);
          A[dv] = (st.o[q][dv] * a0 + o1 * a1) * inv;
        }
      }
      {
        const float m2 = pm[2 * QW + q * 16 + r], l2 = pm[4 * QW + 2 * QW + q * 16 + r], m3 = pm[3 * QW + q * 16 + r], l3 = pm[4 * QW + 3 * QW + q * 16 + r];
        const float M = fmaxf(m2, m3);
        const float a2 = exp2f(m2 - M), a3 = exp2f(m3 - M);
        const float inv = 1.f / (l2 * a2 + l3 * a3);
#pragma unroll
        for (int dv = 0; dv < 4; ++dv) {
          const f32x4 o2 = *(const f32x4*)(sm + 2 * WS + lane * (16 * AQT) + q * 16 + dv * 4);
          const f32x4 o3 = *(const f32x4*)(sm + 3 * WS + lane * (16 * AQT) + q * 16 + dv * 4);
          B[dv] = (o2 * a2 + o3 * a3) * inv;
        }
      }
      diff_finish_q(p, l, lam, lam_init, A, B, tok0 + q * 16, 256 + h * 64);
    }
  }
  __syncthreads();
}

__device__ void attn_ctx_item(const Params& p, int l, int bi) {
  const int wave = otid() >> 6, lane = otid() & 63, g = lane >> 4;
  const int w = bi * 4 + wave;
  const int type = w / (64 * NQG_CTX), rem = w % (64 * NQG_CTX);
  const int b = rem / (4 * NQG_CTX), h = (rem / NQG_CTX) & 3, qg = rem % NQG_CTX;
  const int tokb = b * 256, tok0 = tokb + qg * QW;
  const u16* zb = p.z + (size_t)tokb * INW;
  const int kvh = h >> 1;
  const int qcol = type == 0 ? h * 64 : 1792 + h * 64;
  const int kcol = type == 0 ? 256 + h * 64 : 2048 + kvh * 64;
  const int vrow = type == 0 ? h * 64 : 512 + kvh * 64;
  const int ocol = type == 0 ? h * 64 : 768 + h * 64;
  bf16x8 qf[AQT][2];
  load_q<2, AQT>(p.z + (size_t)tok0 * INW + qcol, qf);
  const int hslot = type == 0 ? h : 8 + kvh;
  Seg s0; s0.K = KLOC(hslot, tokb); s0.Vt = VLOC(hslot, tokb); s0.ldk = 0; s0.ldv = 0; s0.nblk = 8; s0.pos0 = 0; s0.stride = 32;
  Seg sN = s0; sN.nblk = 0;
  AState<AQT> st;
  const float sk = type == 0 ? -1e30f : p.swa_sink[l * 4 + h] * LOG2E;
  astate_init<AQT>(st, sk, (type == 1 && g == 0) ? 1.f : 0.f);
  attn_run<64, AQT, 0, 2>(s0, sN, qf, 0.125f * LOG2E, st, 0, nullptr);
  astate_finalize<AQT>(st);
  write_o<AQT>(p, st, tok0, ocol);
}

__device__ void attn_lat_item(const Params& p, int l, int bi, float* sm) {
  const int wave = otid() >> 6, lane = otid() & 63, r = lane & 15, g = lane >> 4;
  const int type = bi / (8 * NQG_LAT), rem = bi % (8 * NQG_LAT);
  const int b = rem / (4 * NQG_LAT), h = (rem / NQG_LAT) & 3, qg = rem % NQG_LAT;
  const int q0 = qg * QW;
  const int tokb = NPTOK + b * 1024, tok0 = tokb + q0;
  const u16* zb = p.z + (size_t)tokb * INW;
  const int bl = b * 4 + l;
  AState<AQT> st;
  int ocol;
  if (type != 0) {
    const float* rp = p.na_rpb + (size_t)(l * 4 + h) * 15 * 31;
    for (int e = otid(); e < 465; e += 256) sm[9000 + e] = rp[e] * LOG2E;
    __syncthreads();
  }
  if (type == 0) {
    const int kvh = h >> 1;
    bf16x8 qf[AQT][2];
    load_q<2, AQT>(p.z + (size_t)tok0 * INW + 1792 + h * 64, qf);
    Seg s0; s0.K = p.ck_swa + (size_t)((bl * 2 + kvh) * 16) * 2048; s0.Vt = p.cvt_swa + (size_t)((bl * 2 + kvh) * 16) * 2048; s0.ldk = 0; s0.ldv = 0; s0.nblk = 16; s0.pos0 = 0; s0.stride = 32;
    const int lo = max(0, q0 - 128) & ~31;
    const int hi = min(1024, ((q0 + QW + 128) + 31) & ~31);
    int lo2 = lo, cnt = (hi - lo) >> 5;
    if (cnt & 1) { if (lo2 > 0) lo2 -= 32; ++cnt; }
    Seg s1; s1.K = KLOC(8 + kvh, tokb); s1.Vt = VLOC(8 + kvh, tokb); s1.ldk = 0; s1.ldv = 0; s1.nblk = cnt; s1.pos0 = lo2; s1.stride = 32;
    const int P = (16 + cnt) >> 1;
    const int pb = (wave * P) >> 2, pe = ((wave + 1) * P) >> 2;
    astate_init<AQT>(st, wave == 0 ? p.swa_sink[l * 4 + h] * LOG2E : -1e30f, (wave == 0 && g == 0) ? 1.f : 0.f);
    attn_run<64, AQT, 2>(s0, s1, qf, 0.125f * LOG2E, st, q0, nullptr, 2 * pb, 2 * pe);
    ocol = 768 + h * 64;
  } else {
    bf16x8 qf[AQT][2];
    load_q<2, AQT>(p.z + (size_t)tok0 * INW + h * 64, qf);
    Seg s0; s0.K = p.ck_na + (size_t)((bl * 4 + h) * 16) * 2048; s0.Vt = p.cvt_na + (size_t)((bl * 4 + h) * 16) * 2048; s0.ldk = 0; s0.ldv = 0; s0.nblk = 16; s0.pos0 = 0; s0.stride = 32;
    const int qrow = q0 >> 6;
    const int rstart = min(max(qrow - 4, 0), 8);
    Seg s1; s1.K = KLOC(h, tokb); s1.Vt = VLOC(h, tokb); s1.ldk = 0; s1.ldv = 0; s1.nblk = 16; s1.pos0 = rstart * 64; s1.stride = 32;
    astate_init<AQT>(st, -1e30f, 0.f);
    attn_run<64, AQT, 1, 2>(s0, s1, qf, 0.125f * LOG2E, st, q0, sm + 9000, 8 * wave, 8 * wave + 8);
    ocol = h * 64;
  }
  float lt[AQT];
#pragma unroll
  for (int q = 0; q < AQT; ++q) {
    lt[q] = st.ls[q];
    lt[q] += __shfl_xor(lt[q], 16);
    lt[q] += __shfl_xor(lt[q], 32);
  }
  constexpr int WS = 64 * 16 * AQT;
  float* pm = sm + 4 * WS;
  if (wave != 0) {
    float* po = sm + wave * WS + lane * (16 * AQT);
#pragma unroll
    for (int q = 0; q < AQT; ++q) {
#pragma unroll
      for (int dv = 0; dv < 4; ++dv) *(f32x4*)(po + q * 16 + dv * 4) = st.o[q][dv];
      if (g == 0) { pm[wave * QW + q * 16 + r] = st.m[q]; pm[4 * QW + wave * QW + q * 16 + r] = lt[q]; }
    }
  }
  __syncthreads();
  if (wave == 0) {
#pragma unroll
    for (int q = 0; q < AQT; ++q) {
      const float m1 = pm[1 * QW + q * 16 + r], m2 = pm[2 * QW + q * 16 + r], m3 = pm[3 * QW + q * 16 + r];
      const float l1 = pm[4 * QW + 1 * QW + q * 16 + r], l2 = pm[4 * QW + 2 * QW + q * 16 + r], l3 = pm[4 * QW + 3 * QW + q * 16 + r];
      const float M = fmaxf(fmaxf(st.m[q], m1), fmaxf(m2, m3));
      const float a0 = __builtin_amdgcn_exp2f(st.m[q] - M), a1 = __builtin_amdgcn_exp2f(m1 - M), a2 = __builtin_amdgcn_exp2f(m2 - M), a3 = __builtin_amdgcn_exp2f(m3 - M);
      const float inv = 1.f / (lt[q] * a0 + l1 * a1 + l2 * a2 + l3 * a3);
#pragma unroll
      for (int dv = 0; dv < 4; ++dv) {
        const f32x4 o1 = *(const f32x4*)(sm + 1 * WS + lane * (16 * AQT) + q * 16 + dv * 4);
        const f32x4 o2 = *(const f32x4*)(sm + 2 * WS + lane * (16 * AQT) + q * 16 + dv * 4);
        const f32x4 o3 = *(const f32x4*)(sm + 3 * WS + lane * (16 * AQT) + q * 16 + dv * 4);
        st.o[q][dv] = (st.o[q][dv] * a0 + o1 * a1 + o2 * a2 + o3 * a3) * inv;
      }
    }
    write_o<AQT>(p, st, tok0, ocol);
  }
  __syncthreads();
}

__device__ __forceinline__ int q_next(unsigned* cnt, volatile LAS unsigned* slot) {
  __syncthreads();
  if (threadIdx.x == 0) *slot = xb_add(cnt, 1u);
  __syncthreads();
  return (int)*slot;
}

#if REP_SYNC
#define GSYNC() do { xcd_barrier(xb); xcd_barrier(xb); } while (0)
#else
#define GSYNC() xcd_barrier(xb)
#endif
__global__ void __launch_bounds__(256, 2) mega(Params p) {
  extern __shared__ __attribute__((aligned(16))) unsigned char smem[];
  cg::grid_group grid = cg::this_grid();
  const int nblk = gridDim.x, bid = blockIdx.x;
  u16* sm16 = (u16*)smem;
  __shared__ uint4 xb_words[2];
  if (threadIdx.x == 0) { xb_words[0] = make_uint4(0u, 0u, 0u, 0u); xb_words[1] = make_uint4(0u, 0u, 0u, 0u); }
  __syncthreads();
  XcdBarrier xb = xcd_barrier_post(p.bar, (volatile LAS unsigned*)&xb_words[0]);

  for (int rep = 0; rep <= REP_P0; ++rep)
    for (int it = bid; it < P0_ITEMS; it += nblk) p0_item(p, it, smem);
  if (p.use_cg_sync) grid.sync();
  GSYNC();

  const int xcc = (int)xb.x;
  const int xrank = __builtin_amdgcn_readfirstlane((int)xb.st[4]), xnloc = __builtin_amdgcn_readfirstlane((int)xb.st[0]);
  const unsigned topo = (unsigned)__builtin_amdgcn_readfirstlane((int)xb.st[5]);
  const bool local = (topo & 1u) != 0u, full64 = (topo & 2u) != 0u;
#define LSYNC() do { if (local) xcd_barrier_local(xb); else GSYNC(); } while (0)
#define LMAP(j, count, total) (local ? ((xrank + (j) * xnloc) < (count) ? (xrank + (j) * xnloc) : -1) : ((bid + (j) * nblk) < (total) ? (bid + (j) * nblk) : -1))

#pragma unroll 1
  for (int l = 0; l < 4; ++l) {
    for (int j = 0;; ++j) { const int v = LMAP(j, 48, 384); if (v < 0) break; norm_item(p, l, 0, local ? 48 * xcc + v : v); }
    LSYNC();
    for (int j = 0;; ++j) {
      const int v = LMAP(j, 108, 864); if (v < 0) break;
      if (local) gin_tile(p, l, v / 6, 6 * xcc + v % 6, sm16); else gin_tile(p, l, v / 48, v % 48, sm16);
    }
    if (full64) {
      if (xrank >= 44) {
        const int idle = xcc * 20 + (xrank - 44);
        for (int it = 288 + idle; it < 928; it += 160) wt_item(p, l, it, (float*)smem);
      }
    }
    GSYNC();
    {
      constexpr int CD = 64 * NQG_CTX, CC = 2 * 64 * NQG_CTX / 4;
      constexpr int LD = 8 * NQG_LAT, LC = 2 * 8 * NQG_LAT;
      constexpr int E0 = 192, E1 = E0 + LD, E2 = E1 + LC, E3 = E2 + 32, E4 = E3 + CC, E5 = E4 + CD, E6 = E5 + 64;
      unsigned* qc = p.bar + XCD_BAR_WORDS + l * 64;
      const int w0 = full64 ? 928 : 288;
      const int EA = E6 + (1440 - w0), EW = EA + (l < 3 ? 288 : 0);
      for (int it = bid; it < EW; it = nblk + q_next(qc, &xb.st[2])) {
        if (it >= E6) {
          if (it < EA) wt_item(p, l, it - E6 + w0, (float*)smem);
          else wt_item(p, l + 1, it - EA, (float*)smem);
          continue;
        }
        if (it < E0) f1_tile(p, l, it, sm16);
        else if (it < E1) attn_diff_item(p, l, true, it - E0, (float*)smem);
        else if (it < E2) attn_lat_item(p, l, it - E1, (float*)smem);
        else if (it < E3) f2_tile(p, l, it - E2, sm16);
        else if (it < E4) attn_ctx_item(p, l, it - E3);
        else if (it < E5) attn_diff_item(p, l, false, it - E4, (float*)smem);
        else f2_tile(p, l, it - E5 + 32, sm16);
      }
    }
    GSYNC();
    for (int j = 0;; ++j) {
      const int v = LMAP(j, 64, 512); if (v < 0) break;
      if (local) res_tile(p, l, v / 8, 8 * xcc + v % 8, p.cat, p.w_outT + (size_t)l * 1024 * 1024, 1024, 2, sm16, l == 0);
      else res_tile(p, l, v / 64, v % 64, p.cat, p.w_outT + (size_t)l * 1024 * 1024, 1024, 2, sm16, l == 0);
    }
    LSYNC();
    for (int j = 0;; ++j) { const int v = LMAP(j, 48, 384); if (v < 0) break; norm_item(p, l, 1, local ? 48 * xcc + v : v); }
    LSYNC();
    for (int j = 0;; ++j) {
      const int v = LMAP(j, 192, 1536); if (v < 0) break;
      if (local) m1_tile(p, l, v / 6, 6 * xcc + v % 6, sm16); else m1_tile(p, l, v / 48, v % 48, sm16);
    }
    LSYNC();
    for (int j = 0;; ++j) {
      const int v = LMAP(j, 64, 512); if (v < 0) break;
      if (local) res_tile(p, l, v / 8, 8 * xcc + v % 8, p.u, p.w2T + (size_t)l * 1024 * 4096, 4096, 5, sm16);
      else res_tile(p, l, v / 64, v % 64, p.u, p.w2T + (size_t)l * 1024 * 4096, 4096, 5, sm16);
    }
    LSYNC();
  }
  for (int j = 0;; ++j) { const int v = LMAP(j, 48, 384); if (v < 0) break; norm_item(p, 0, 2, local ? 48 * xcc + v : v); }
#undef LSYNC
#undef LMAP
}

extern "C" void kernel_launch(void* const* d_in, const int* in_sizes, int n_in, void* d_out, int out_size, void* d_ws,
                              size_t ws_size, hipStream_t stream) {
  static int grid_blocks = 0;
  if (grid_blocks == 0) {
    int dev = 0, cus = 0, per_cu = 0;
    (void)hipGetDevice(&dev);
    (void)hipDeviceGetAttribute(&cus, hipDeviceAttributeMultiprocessorCount, dev);
    if (hipFuncSetAttribute((const void*)mega, hipFuncAttributeMaxDynamicSharedMemorySize, LDS_BYTES) != hipSuccess) {
      fprintf(stderr, "hipFuncSetAttribute failed\n");
    }
    if (hipOccupancyMaxActiveBlocksPerMultiprocessor(&per_cu, (const void*)mega, 256, LDS_BYTES) != hipSuccess || per_cu < 1) {
      fprintf(stderr, "occupancy query failed (%d)\n", per_cu);
      per_cu = 1;
    }
    if (per_cu > 2) per_cu = 2;
    grid_blocks = cus * per_cu;
    fprintf(stderr, "mega: cus=%d per_cu=%d grid=%d ws=%zu\n", cus, per_cu, grid_blocks, ws_size);
  }
  Params p{};
  const float** pin = (const float**)&p;
  for (int i = 0; i < 27; ++i) pin[i] = (const float*)d_in[i];
  p.out = (float*)d_out;
  unsigned char* ws = (unsigned char*)d_ws;
  size_t off = 0;
  auto take = [&](size_t bytes) { unsigned char* q = ws + off; off += (bytes + 255) & ~(size_t)255; return q; };
  p.xres = (float*)take((size_t)NTOK * 1024 * 4);
  p.mods = (float*)take((size_t)4 * 3 * 6144 * 4);
  p.h = (u16*)take((size_t)NTOK * 1024 * 2);
  p.z = (u16*)take((size_t)NTOK * INW * 2);
  p.vt = (u16*)take((size_t)640 * NTOK * 2);
  p.cat = (u16*)take((size_t)NTOK * 1024 * 2);
  p.u = (u16*)take((size_t)NTOK * 4096 * 2);
  p.uv = (u16*)take((size_t)(16 * 256 * 512 + 2 * 256 * 2048) * 2);
  p.w_inT = (u16*)take((size_t)4 * 2304 * 1024 * 2);
  p.w_outT = (u16*)take((size_t)4 * 1024 * 1024 * 2);
  p.w1T = (u16*)take((size_t)4 * 4096 * 1024 * 2);
  p.w2T = (u16*)take((size_t)4 * 4096 * 1024 * 2);
  p.pqt = (u16*)take((size_t)4 * 512 * 256 * 2);
  p.dft256 = (u16*)take((size_t)256 * 512 * 2);
  p.dft1024 = (u16*)take((size_t)1024 * 2048 * 2);
  p.ck_na = (u16*)take((size_t)2 * 4 * 512 * 256 * 2);
  p.cvt_na = (u16*)take((size_t)2 * 4 * 512 * 256 * 2);
  p.ck_diff = (u16*)take((size_t)2 * 4 * 512 * 256 * 2);
  p.cvt_diff = (u16*)take((size_t)2 * 4 * 512 * 256 * 2);
  p.ck_swa = (u16*)take((size_t)2 * 4 * 512 * 128 * 2);
  p.cvt_swa = (u16*)take((size_t)2 * 4 * 512 * 128 * 2);
  p.kfr = (u16*)take((size_t)10 * 192 * 2048 * 2);
  p.vfr = (u16*)take((size_t)10 * 192 * 2048 * 2);
  p.ropeD = (float*)take(1024 * 4);
  p.ropeS = (float*)take(2048 * 4);
  p.bar = (unsigned*)take(XB_ALL_WORDS * 4);
  if (off > ws_size) { fprintf(stderr, "workspace too small: need %zu have %zu\n", off, ws_size); return; }
  if (hipMemsetAsync(p.bar, 0, XB_ALL_WORDS * 4, stream) != hipSuccess) fprintf(stderr, "memset failed\n");
  void* args[] = {&p};
  hipError_t e = hipLaunchCooperativeKernel((const void*)mega, dim3(grid_blocks), dim3(256), args, LDS_BYTES, stream);
  if (e != hipSuccess) fprintf(stderr, "cooperative launch failed: %s (grid %d)\n", hipGetErrorString(e), grid_blocks);
}
```

```cpp
#include <hip/hip_runtime.h>
#include <hip/hip_cooperative_groups.h>
#include <stdint.h>
#include <stdio.h>
namespace cg = cooperative_groups;

typedef unsigned short u16;
typedef __attribute__((ext_vector_type(8))) short bf16x8;
typedef __attribute__((ext_vector_type(4))) float f32x4;
typedef __attribute__((ext_vector_type(4))) unsigned u32x4;
__device__ __forceinline__ void gload16(u32x4& dst, const void* ptr) {
  asm volatile("global_load_dwordx4 %0, %1, off" : "=v"(dst) : "v"(ptr) : "memory");
}

#define NTOK 6144
#define NPTOK 4096
#define INW 2304
#define LOG2E 1.4426950408889634f
#define LDS_BYTES 73728
#define LSTR 72

#define O_NAK 6291456
#define O_NAV 10485760
#define O_DK 14680064
#define O_DV 18874368
#define O_SK 23068672
#define O_SV 25165824

struct Params {
  const float *x_prompt, *x_sample, *c_na_k, *c_na_v, *c_diff_k, *c_diff_v, *c_swa_k, *c_swa_v, *c, *c_ctx;
  const float *w_ada, *b_ada, *norm1_g, *norm2_g, *w_in, *na_rpb, *lq1, *lk1, *lq2, *lk2, *subln_g, *w_fourier, *swa_sink;
  const float *w_out, *w1, *w2, *final_g;
  float* out;
  float* xres;
  float* mods;
  u16 *h, *z, *vt, *cat, *u, *uv, *w_inT, *w_outT, *w1T, *w2T, *pqt, *dft256, *dft1024;
  u16 *ck_na, *cvt_na, *ck_diff, *cvt_diff, *ck_swa, *cvt_swa;
  float *ropeD, *ropeS;
  u16 *kfr, *vfr;
  unsigned* bar;
  int use_cg_sync;
  int pad_;
};

__device__ __forceinline__ u16 f2bf(float f) {
  unsigned u = __float_as_uint(f);
  u += 0x7fffu + ((u >> 16) & 1u);
  return (u16)(u >> 16);
}
__device__ __forceinline__ int otid() { int t = threadIdx.x; asm volatile("" : "+v"(t)); return t; }
__device__ __forceinline__ float bf2f(u16 h) { return __uint_as_float(((unsigned)h) << 16); }
typedef __attribute__((ext_vector_type(2))) __bf16 hbf16x2;
typedef __attribute__((ext_vector_type(2))) float f32x2;
__device__ __forceinline__ unsigned pack2(float a, float b) {
  f32x2 v = {a, b};
  union { hbf16x2 h; unsigned u; } x;
  x.h = __builtin_convertvector(v, hbf16x2);
  return x.u;
}

__device__ __forceinline__ int kfrag_off(int kk, int d) {
  const int t = (kk >> 2) & 1, r = ((kk >> 3) << 2) | (kk & 3), dc = d >> 5, g = (d >> 3) & 3;
  return ((t * 2 + dc) * 64 + g * 16 + r) * 8 + (d & 7);
}
__device__ __forceinline__ int vfrag_off(int kk, int dv) {
  return (((dv >> 4) * 64) + (kk >> 3) * 16 + (dv & 15)) * 8 + (kk & 7);
}

#define XB_TMO      128
#define XB_XCNT(j)  (256  + 64 * (j))
#define XB_XSUB(j)  (1280 + 64 * (j))
#define XB_XGEN(j)  (2304 + 64 * (j))
#define XB_TOP      3328
#define XB_TOPGEN   3392
#define XCD_BAR_WORDS 3456
#define XB_SPIN_CAP (1u << 22)
#define LAS __attribute__((address_space(3)))
__device__ __forceinline__ unsigned xb_ld(unsigned* p)              { return __hip_atomic_load(p, __ATOMIC_RELAXED, __HIP_MEMORY_SCOPE_AGENT); }
__device__ __forceinline__ unsigned xb_add(unsigned* p, unsigned v) { return __hip_atomic_fetch_add(p, v, __ATOMIC_RELAXED, __HIP_MEMORY_SCOPE_AGENT); }
__device__ __forceinline__ unsigned xb_xcc_id() { return (unsigned)__builtin_amdgcn_s_getreg((3 << 11) | 20) & 0xFu; }
#define XB_SPIN(cond, bar) do { unsigned _sp = 0; while (cond) { __builtin_amdgcn_s_sleep(1); \
    if ((++_sp & 255u) == 0u) { if (xb_ld(&(bar)[XB_TMO])) break; if (_sp > XB_SPIN_CAP) { atomicAdd(&(bar)[XB_TMO], 1u); break; } } } } while (0)
#define XB_LSUB(j)  (XCD_BAR_WORDS + 12 * 64 + 64 * (j))
#define XB_LGEN(j)  (XCD_BAR_WORDS + 12 * 64 + 64 * (16 + (j)))
#define XB_ALL_WORDS (XCD_BAR_WORDS + 12 * 64 + 32 * 64)
struct XcdBarrier { unsigned* bar; unsigned x; volatile LAS unsigned* st; };
__device__ __forceinline__ XcdBarrier xcd_barrier_post(unsigned* bar, volatile LAS unsigned* st) {
  XcdBarrier b; b.bar = bar; b.x = xb_xcc_id(); b.st = st;
  if (threadIdx.x == 0) st[4] = xb_add(&bar[XB_XCNT(b.x)], 1u);
  return b;
}
__device__ __forceinline__ void xcd_barrier_complete(unsigned* bar, unsigned x, unsigned& nloc, unsigned& nx) {
  const unsigned G = gridDim.x * gridDim.y * gridDim.z;
  unsigned sum, cnt, mine, sp = 0u;
  for (;;) {
    sum = 0u; cnt = 0u; mine = 0u;
#pragma unroll
    for (unsigned j = 0; j < 16; ++j) { const unsigned c = xb_ld(&bar[XB_XCNT(j)]); sum += c; cnt += (c > 0u) ? 1u : 0u; mine = (j == x) ? c : mine; }
    if (sum == G) break;
    __builtin_amdgcn_s_sleep(1);
    if ((++sp & 255u) == 0u) { if (xb_ld(&bar[XB_TMO])) break; if (sp > XB_SPIN_CAP) { atomicAdd(&bar[XB_TMO], 1u); break; } }
  }
  nloc = mine > 0u ? mine : 1u; nx = cnt > 0u ? cnt : 1u;
}
__device__ __forceinline__ unsigned xcd_topology(unsigned* bar) {
  const unsigned G = gridDim.x * gridDim.y * gridDim.z;
  unsigned sum8 = 0u, all = 1u, all64 = 1u;
#pragma unroll
  for (unsigned j = 0; j < 8; ++j) { const unsigned c = xb_ld(&bar[XB_XCNT(j)]); sum8 += c; all &= (c > 0u) ? 1u : 0u; all64 &= (c == 64u) ? 1u : 0u; }
  const unsigned ok = (all && sum8 == G) ? 1u : 0u;
  return ok | ((ok && all64) ? 2u : 0u);
}
__device__ __forceinline__ void xcd_barrier(const XcdBarrier& b) {
  asm volatile("s_waitcnt vmcnt(0)" ::: "memory");
  __syncthreads();
  if (threadIdx.x == 0) {
    unsigned* bar = b.bar;
    __builtin_amdgcn_s_waitcnt(0);
    unsigned nloc = b.st[0], nx = b.st[1];
    if (nloc == 0u) { xcd_barrier_complete(bar, b.x, nloc, nx); b.st[0] = nloc; b.st[1] = nx; b.st[5] = xcd_topology(bar); }
    const unsigned old = xb_add(&bar[XB_XSUB(b.x)], 1u);
    const unsigned gen = old / nloc;
    if (old + 1u == (gen + 1u) * nloc) {
      __builtin_amdgcn_fence(__ATOMIC_RELEASE, "agent");
      asm volatile("s_waitcnt vmcnt(0)" ::: "memory");
      const unsigned og = xb_add(&bar[XB_TOP], 1u);
      const unsigned tg = og / nx;
      if (og + 1u == (tg + 1u) * nx) xb_add(&bar[XB_TOPGEN], 1u);
      else XB_SPIN(xb_ld(&bar[XB_TOPGEN]) == tg, bar);
      __builtin_amdgcn_fence(__ATOMIC_ACQUIRE, "agent");
      xb_add(&bar[XB_XGEN(b.x)], 1u);
      asm volatile("s_waitcnt vmcnt(0)" ::: "memory");
    } else {
      XB_SPIN(xb_ld(&bar[XB_XGEN(b.x)]) == gen, bar);
      __builtin_amdgcn_fence(__ATOMIC_ACQUIRE, "agent");
      asm volatile("s_waitcnt vmcnt(0)" ::: "memory");
    }
  }
  __syncthreads();
}

__device__ __forceinline__ void xcd_barrier_local(const XcdBarrier& b) {
  asm volatile("s_waitcnt vmcnt(0)" ::: "memory");
  __syncthreads();
  if (threadIdx.x == 0) {
    unsigned* bar = b.bar;
    __builtin_amdgcn_s_waitcnt(0);
    const unsigned nloc = b.st[0];
    const unsigned old = xb_add(&bar[XB_LSUB(b.x)], 1u);
    const unsigned gen = old / nloc;
    if (old + 1u == (gen + 1u) * nloc) xb_add(&bar[XB_LGEN(b.x)], 1u);
    else XB_SPIN(xb_ld(&bar[XB_LGEN(b.x)]) == gen, bar);
    __builtin_amdgcn_fence(__ATOMIC_ACQUIRE, "agent");
    asm volatile("s_waitcnt vmcnt(0)" ::: "memory");
  }
  __syncthreads();
}

__device__ __forceinline__ void transpose_tile(const float* __restrict__ src, int lds_, u16* __restrict__ dst, int ldd,
                                               int k0, int n0, float* sm, bool fragv = false) {
  const int tid = otid();
  const int c4 = (tid & 15) * 4, r0 = tid >> 4;
  float4 v[8];
#pragma unroll
  for (int i = 0; i < 8; ++i) { const f32x4 t = __builtin_nontemporal_load((const f32x4*)(src + (size_t)(k0 + r0 + 16 * i) * lds_ + n0 + c4)); v[i] = make_float4(t[0], t[1], t[2], t[3]); }
#pragma unroll
  for (int i = 0; i < 8; ++i) {
    const int k = r0 + 16 * i;
    sm[(c4 + 0) * 129 + k] = v[i].x; sm[(c4 + 1) * 129 + k] = v[i].y; sm[(c4 + 2) * 129 + k] = v[i].z; sm[(c4 + 3) * 129 + k] = v[i].w;
  }
  __syncthreads();
  const int k8 = (tid & 15) * 8, nn = tid >> 4;
#pragma unroll
  for (int i = 0; i < 4; ++i) {
    const int n = nn + 16 * i;
    const float* row = sm + n * 129 + k8;
    uint4 w;
    w.x = pack2(row[0], row[1]); w.y = pack2(row[2], row[3]); w.z = pack2(row[4], row[5]); w.w = pack2(row[6], row[7]);
    if (fragv) {
      const int col = n0 + n, pos = k0 + k8;
      *(uint4*)(dst + ((size_t)((col >> 6) * 16 + (pos >> 5))) * 2048 + vfrag_off(pos & 31, col & 63)) = w;
    } else {
      *(uint4*)(dst + (size_t)(n0 + n) * ldd + k0 + k8) = w;
    }
  }
  __syncthreads();
}

__device__ __forceinline__ void adaln_item(const Params& p, int it, float* sm) {
  const int l = it / 192, c0 = (it % 192) * 32;
  float* ssil = sm;
  float* red = sm + 3072;
  const int tid = otid();
  for (int i = tid; i < 3072; i += 256) {
    const int cnd = i >> 10, k = i & 1023;
    const float v = cnd == 0 ? p.c_ctx[k] : p.c[(cnd - 1) * 1024 + k];
    ssil[i] = v / (1.f + expf(-v));
  }
  __syncthreads();
  const int cg4 = (tid & 7) * 4, ks = tid >> 3;
  const float* w = p.w_ada + (size_t)l * 1024 * 6144 + c0 + cg4;
  float a0[4] = {0.f, 0.f, 0.f, 0.f}, a1[4] = {0.f, 0.f, 0.f, 0.f}, a2[4] = {0.f, 0.f, 0.f, 0.f};
#pragma unroll 16
  for (int kk = 0; kk < 32; ++kk) {
    const int k = kk * 32 + ks;
    const f32x4 tv = __builtin_nontemporal_load((const f32x4*)(w + (size_t)k * 6144));
    const float4 v = make_float4(tv[0], tv[1], tv[2], tv[3]);
    const float s0 = ssil[k], s1 = ssil[1024 + k], s2 = ssil[2048 + k];
    a0[0] += s0 * v.x; a0[1] += s0 * v.y; a0[2] += s0 * v.z; a0[3] += s0 * v.w;
    a1[0] += s1 * v.x; a1[1] += s1 * v.y; a1[2] += s1 * v.z; a1[3] += s1 * v.w;
    a2[0] += s2 * v.x; a2[1] += s2 * v.y; a2[2] += s2 * v.z; a2[3] += s2 * v.w;
  }
#pragma unroll
  for (int j = 0; j < 4; ++j) {
    red[(ks * 3 + 0) * 32 + cg4 + j] = a0[j];
    red[(ks * 3 + 1) * 32 + cg4 + j] = a1[j];
    red[(ks * 3 + 2) * 32 + cg4 + j] = a2[j];
  }
  __syncthreads();
  if (tid < 96) {
    const int cnd = tid >> 5, j = tid & 31;
    float s = p.b_ada[l * 6144 + c0 + j];
    for (int q = 0; q < 32; ++q) s += red[(q * 3 + cnd) * 32 + j];
    p.mods[(l * 3 + cnd) * 6144 + c0 + j] = s;
  }
  __syncthreads();
}

__device__ __forceinline__ void cvt_item(const float* __restrict__ src, u16* __restrict__ dst, int it, int W) {
  const int w8 = W >> 3;
#pragma unroll
  for (int i = 0; i < 4; ++i) {
    const int u = it * 1024 + i * 256 + otid();
    const int d8 = u % w8, pos = (u / w8) & 511, bl = u / (w8 * 512);
    const float* sp = src + ((size_t)(bl * 512 + pos) * W + d8 * 8);
    const f32x4 t0 = __builtin_nontemporal_load((const f32x4*)sp), t1 = __builtin_nontemporal_load((const f32x4*)(sp + 4));
    const float4 v0 = make_float4(t0[0], t0[1], t0[2], t0[3]), v1 = make_float4(t1[0], t1[1], t1[2], t1[3]);
    uint4 w; w.x = pack2(v0.x, v0.y); w.y = pack2(v0.z, v0.w); w.z = pack2(v1.x, v1.y); w.w = pack2(v1.z, v1.w);
    const int h = d8 >> 3, d = (d8 & 7) * 8;
    *(uint4*)(dst + ((size_t)((bl * (W >> 6) + h) * 16 + (pos >> 5))) * 2048 + kfrag_off(pos & 31, d)) = w;
  }
}

__device__ __forceinline__ void pq_item(const Params& p, int it, float* sm) {
  const int cq = it & 3, it2 = it >> 2;
  const int l = it2 >> 3, which = (it2 >> 2) & 1, g = it2 & 3;
  const int n = otid();
  if (n < 64) sm[n] = which ? sinpif(2.f * (float)n / 64.f) : cospif(2.f * (float)n / 64.f);
  __syncthreads();
  float w[64];
#pragma unroll
  for (int m = 0; m < 64; ++m) w[m] = p.w_fourier[(size_t)l * 65536 + (g * 64 + m) * 256 + n];
  u16* dst = p.pqt + (size_t)l * 512 * 256 + (size_t)(which * 256 + n) * 256 + g * 64;
  for (int c = cq * 16; c < cq * 16 + 16; ++c) {
    float s = 0.f;
#pragma unroll
    for (int m = 0; m < 64; ++m) s += sm[(c * m) & 63] * w[m];
    dst[c] = f2bf(s);
  }
  __syncthreads();
}

__device__ __forceinline__ void dft_item(u16* dst, int L, int it) {
  const int twoL = 2 * L;
  for (int e = otid(); e < 8192; e += 256) {
    const int idx = it * 8192 + e;
    const int k = idx / twoL, j = idx % twoL;
    const int jj = j & (L - 1);
    const int ph = (k * jj) & (L - 1);
    const float a = 2.f * (float)ph / (float)L;
    const float v = (j >= L) ? -sinpif(a) : cospif(a);
    dst[idx] = f2bf(v);
  }
}

#define P0_WT 288
#define P0_ADA 768
#define P0_XC 0
#define P0_CK 320
#define P0_CVT 320
#define P0_PQ 128
#define P0_DFT 272
#define P0_ITEMS (P0_ADA + P0_WT + P0_XC + P0_CK + P0_CVT + P0_PQ + P0_DFT + 1)

__device__ void wt_item(const Params& p, int l, int r, float* sm) {
  if (r < 288) { transpose_tile(p.w_in + (size_t)l * 1024 * 2304, 2304, p.w_inT + (size_t)l * 2304 * 1024, 1024, (r / 36) * 128, (r % 36) * 64, sm); return; }
  r -= 288;
  if (r < 128) { transpose_tile(p.w_out + (size_t)l * 1024 * 1024, 1024, p.w_outT + (size_t)l * 1024 * 1024, 1024, (r / 16) * 128, (r % 16) * 64, sm); return; }
  r -= 128;
  if (r < 512) { transpose_tile(p.w1 + (size_t)l * 1024 * 4096, 4096, p.w1T + (size_t)l * 4096 * 1024, 1024, (r / 64) * 128, (r % 64) * 64, sm); return; }
  r -= 512;
  transpose_tile(p.w2 + (size_t)l * 4096 * 1024, 1024, p.w2T + (size_t)l * 1024 * 4096, 4096, (r / 16) * 128, (r % 16) * 64, sm);
}

__device__ void p0_item(const Params& p, int it, unsigned char* smem) {
  float* sm = (float*)smem;
  if (it < P0_ADA) { adaln_item(p, it, sm); return; }
  it -= P0_ADA;
  if (it < P0_WT) { wt_item(p, 0, it, sm); return; }
  it -= P0_WT;
  if (it < P0_XC) {
    const int row0 = it * 16;
    const float* src = row0 < NPTOK ? p.x_prompt + (size_t)row0 * 1024 : p.x_sample + (size_t)(row0 - NPTOK) * 1024;
    float* dst = p.xres + (size_t)row0 * 1024;
#pragma unroll
    for (int i = 0; i < 16; ++i) {
      const int o = (i * 256 + otid()) * 4;
      *(float4*)(dst + o) = *(const float4*)(src + o);
    }
    return;
  }
  it -= P0_XC;
  if (it < P0_CK) {
    if (it < 128) { cvt_item(p.c_na_k, p.ck_na, it, 256); return; }
    it -= 128;
    if (it < 128) { cvt_item(p.c_diff_k, p.ck_diff, it, 256); return; }
    it -= 128;
    cvt_item(p.c_swa_k, p.ck_swa, it, 128);
    return;
  }
  it -= P0_CK;
  if (it < P0_CVT) {
    if (it < 128) { const int bl = it >> 4, r = it & 15; transpose_tile(p.c_na_v + (size_t)bl * 512 * 256, 256, p.cvt_na + (size_t)bl * 256 * 512, 512, (r >> 2) * 128, (r & 3) * 64, sm, true); return; }
    it -= 128;
    if (it < 128) { const int bl = it >> 4, r = it & 15; transpose_tile(p.c_diff_v + (size_t)bl * 512 * 256, 256, p.cvt_diff + (size_t)bl * 256 * 512, 512, (r >> 2) * 128, (r & 3) * 64, sm, true); return; }
    it -= 128;
    { const int bl = it >> 3, r = it & 7; transpose_tile(p.c_swa_v + (size_t)bl * 512 * 128, 128, p.cvt_swa + (size_t)bl * 128 * 512, 512, (r >> 1) * 128, (r & 1) * 64, sm, true); return; }
  }
  it -= P0_CVT;
  if (it < P0_PQ) { pq_item(p, it, sm); return; }
  it -= P0_PQ;
  if (it < 16) { dft_item(p.dft256, 256, it); return; }
  it -= 16;
  if (it < 256) { dft_item(p.dft1024, 1024, it); return; }
  for (int e = otid(); e < 512 + 1024; e += 256) {
    const bool isD = e < 512;
    const int ee = isD ? e : e - 512;
    const int nf = isD ? 8 : 16;
    const int pos = ee / nf, fi = ee % nf;
    const float inv = exp2f(-(float)fi * (13.287712379549449f / (float)nf));
    float tt = (float)pos * inv * 0.15915494309189535f;
    tt -= rintf(tt);
    float sn, cs;
    sincospif(2.f * tt, &sn, &cs);
    if (isD) { p.ropeD[ee] = cs; p.ropeD[512 + ee] = sn; }
    else { p.ropeS[ee] = cs; p.ropeS[1024 + ee] = sn; }
  }
}

__device__ __forceinline__ void norm_item(const Params& p, int l, int which, int it) {
  const int lane = otid() & 63, wave = otid() >> 6;
  const int row0 = it * 16 + wave * 4;
  const float* xsrc = (which == 0 && l == 0) ? (row0 < NPTOK ? p.x_prompt + (size_t)row0 * 1024 : p.x_sample + (size_t)(row0 - NPTOK) * 1024)
                                             : p.xres + (size_t)row0 * 1024;
  float4 v[4][4];
#pragma unroll
  for (int j = 0; j < 4; ++j)
#pragma unroll
    for (int k = 0; k < 4; ++k) v[j][k] = *(const float4*)(xsrc + (size_t)j * 1024 + (k * 64 + lane) * 4);
  float rs[4];
#pragma unroll
  for (int j = 0; j < 4; ++j) {
    float ss = 0.f;
#pragma unroll
    for (int k = 0; k < 4; ++k) ss += v[j][k].x * v[j][k].x + v[j][k].y * v[j][k].y + v[j][k].z * v[j][k].z + v[j][k].w * v[j][k].w;
#pragma unroll
    for (int o = 32; o >= 1; o >>= 1) ss += __shfl_xor(ss, o);
    rs[j] = rsqrtf(ss * (1.f / 1024.f) + 1e-6f);
  }
  if (which < 2) {
    const int cond = row0 < NPTOK ? 0 : 1 + ((row0 - NPTOK) >> 10);
    const float* gp = (which == 0 ? p.norm1_g : p.norm2_g) + l * 1024;
    const float* shp = p.mods + (size_t)(l * 3 + cond) * 6144 + (which * 3 + 0) * 1024;
    const float* scp = shp + 1024;
#pragma unroll
    for (int k = 0; k < 4; ++k) {
      const int col = (k * 64 + lane) * 4;
      const float4 gg = *(const float4*)(gp + col);
      const float4 sh = *(const float4*)(shp + col);
      const float4 sc = *(const float4*)(scp + col);
      const float mx = gg.x * (1.f + sc.x), my = gg.y * (1.f + sc.y), mz = gg.z * (1.f + sc.z), mw = gg.w * (1.f + sc.w);
#pragma unroll
      for (int j = 0; j < 4; ++j) {
        uint2 w;
        w.x = pack2(v[j][k].x * rs[j] * mx + sh.x, v[j][k].y * rs[j] * my + sh.y);
        w.y = pack2(v[j][k].z * rs[j] * mz + sh.z, v[j][k].w * rs[j] * mw + sh.w);
        *(uint2*)(p.h + (size_t)(row0 + j) * 1024 + col) = w;
      }
    }
  } else {
#pragma unroll
    for (int k = 0; k < 4; ++k) {
      const int col = (k * 64 + lane) * 4;
      const float4 gg = *(const float4*)(p.final_g + col);
#pragma unroll
      for (int j = 0; j < 4; ++j) {
        float4 o;
        o.x = v[j][k].x * rs[j] * gg.x; o.y = v[j][k].y * rs[j] * gg.y; o.z = v[j][k].z * rs[j] * gg.z; o.w = v[j][k].w * rs[j] * gg.w;
        { f32x4 ov = {o.x, o.y, o.z, o.w}; __builtin_nontemporal_store(ov, (f32x4*)(p.out + (size_t)(row0 + j) * 1024 + col)); }
      }
    }
  }
}

template <bool ZERO, int YT>
__device__ __forceinline__ void gemm_main_t(const u16* __restrict__ X, int ldx, const u16* __restrict__ Y, int ldy, int K,
                                          u16* smem, f32x4 (&acc)[4][YT]) {
  const int tid = otid(), lane = tid & 63, wave = tid >> 6, wx = wave & 1, wy = wave >> 1, r = lane & 15, g = lane >> 4;
  u16* sX = smem;
  u16* sY = smem + 2 * 128 * 64;
  const int lrow = tid >> 3, lkc = tid & 7;
  const int gsw = (lkc ^ (lrow & 7)) * 8;
  const u16* gx = X + (size_t)lrow * ldx + gsw;
  const u16* gy = Y + (size_t)lrow * ldy + gsw;
  u16* lx = sX + tid * 8;
  u16* ly = sY + tid * 8;
#define GEMM_STAGE(buf, kt_)                                                                                                      \
  {                                                                                                                               \
    _Pragma("unroll") for (int i = 0; i < 4; ++i)                                                                                 \
      __builtin_amdgcn_global_load_lds((const unsigned*)(gx + (size_t)(32 * i) * ldx + (kt_) * 64),                               \
                                       (unsigned*)(lx + (buf) * 8192 + i * 2048), 16, 0, 0);                                      \
    _Pragma("unroll") for (int i = 0; i < YT; ++i)                                                                                \
      __builtin_amdgcn_global_load_lds((const unsigned*)(gy + (size_t)(32 * i) * ldy + (kt_) * 64),                               \
                                       (unsigned*)(ly + (buf) * 8192 + i * 2048), 16, 0, 0);                                      \
  }
  GEMM_STAGE(0, 0);
  if (ZERO) {
#pragma unroll
    for (int a = 0; a < 4; ++a)
#pragma unroll
      for (int b = 0; b < YT; ++b) acc[a][b] = (f32x4){0.f, 0.f, 0.f, 0.f};
  }
  const int nk = K >> 6;
  const int sw = r & 7;
  const u16* cx0 = sX + (wx * 64 + r) * 64;
  const u16* cy0 = sY + (wy * (16 * YT) + r) * 64;
  __syncthreads();
#define GEMM_COMPUTE(cur)                                                                            \
  {                                                                                                  \
    const u16* cx = cx0 + (cur) * 8192;                                                              \
    const u16* cy = cy0 + (cur) * 8192;                                                              \
    const int pc0 = (g ^ sw) * 8, pc1 = ((4 + g) ^ sw) * 8;                                          \
    bf16x8 a0[4], b0[YT], a1[4], b1[YT];                                                             \
    _Pragma("unroll") for (int i = 0; i < 4; ++i) a0[i] = *(const bf16x8*)(cx + i * 16 * 64 + pc0);  \
    _Pragma("unroll") for (int i = 0; i < YT; ++i) b0[i] = *(const bf16x8*)(cy + i * 16 * 64 + pc0); \
    _Pragma("unroll") for (int i = 0; i < 4; ++i) a1[i] = *(const bf16x8*)(cx + i * 16 * 64 + pc1);  \
    _Pragma("unroll") for (int i = 0; i < YT; ++i) b1[i] = *(const bf16x8*)(cy + i * 16 * 64 + pc1); \
    __builtin_amdgcn_s_setprio(1);                                                                   \
    _Pragma("unroll") for (int xi = 0; xi < 4; ++xi)                                                 \
      _Pragma("unroll") for (int yi = 0; yi < YT; ++yi)                                              \
        acc[xi][yi] = __builtin_amdgcn_mfma_f32_16x16x32_bf16(a0[xi], b0[yi], acc[xi][yi], 0, 0, 0); \
    _Pragma("unroll") for (int xi = 0; xi < 4; ++xi)                                                 \
      _Pragma("unroll") for (int yi = 0; yi < YT; ++yi)                                              \
        acc[xi][yi] = __builtin_amdgcn_mfma_f32_16x16x32_bf16(a1[xi], b1[yi], acc[xi][yi], 0, 0, 0); \
    __builtin_amdgcn_s_setprio(0);                                                                   \
  }
#pragma unroll 1
  for (int kt = 0; kt < nk - 1; ++kt) {
    const int cur = kt & 1;
    GEMM_STAGE(cur ^ 1, kt + 1);
    GEMM_COMPUTE(cur);
    __syncthreads();
  }
  GEMM_COMPUTE((nk - 1) & 1);
  __syncthreads();
#undef GEMM_COMPUTE
#undef GEMM_STAGE
}

#ifndef REP_GEMM
#define REP_GEMM 0
#endif
#ifndef REP_MIX
#define REP_MIX 0
#endif
#ifndef REP_SYNC
#define REP_SYNC 0
#endif
#ifndef REP_P0
#define REP_P0 0
#endif
template <int YT>
__device__ __forceinline__ void gemm_main(const u16* __restrict__ X, int ldx, const u16* __restrict__ Y, int ldy, int K,
                                          u16* smem, f32x4 (&acc)[4][YT]) {
  gemm_main_t<true, YT>(X, ldx, Y, ldy, K, smem, acc);
#if REP_GEMM
  gemm_main_t<false, YT>(X, ldx, Y, ldy, K, smem, acc);
#pragma unroll
  for (int a = 0; a < 4; ++a)
#pragma unroll
    for (int b = 0; b < YT; ++b) acc[a][b] *= 0.5f;
#endif
}

__device__ __forceinline__ bool tile_map(int j, int ntx, int& tx, int& ty, int nty = 48) {
  const int nblk = gridDim.x, bid = blockIdx.x;
  if (nblk == 512) {
    const int per = nty >> 3, hp = per >> 1;
    const int rank = bid >> 3, q = (rank & 31) + j * 32, mem = rank >> 5;
    if (q >= hp * ntx) return false;
    tx = q / hp; ty = per * (bid & 7) + 2 * (q % hp) + mem;
    return true;
  } else {
    const int it = bid + j * nblk;
    if (it >= nty * ntx) return false;
    tx = it / nty; ty = it % nty;
    return true;
  }
}

__device__ void gin_tile(const Params& p, int l, int tx, int ty, u16* smem) {
  const int n0 = tx * 128, m0 = ty * 128;
  f32x4 acc[4][4];
  gemm_main<4>(p.w_inT + (size_t)l * 2304 * 1024 + (size_t)n0 * 1024, 1024, p.h + (size_t)m0 * 1024, 1024, 1024, smem, acc);
  const int lane = otid() & 63, wave = otid() >> 6, wx = wave & 1, wy = wave >> 1, r = lane & 15, g = lane >> 4;
  const int nw = n0 + wx * 64;
  const bool isS = m0 >= NPTOK;
  int ropeMode = 0;
  if (isS) {
    if (nw >= 768 && nw < 1280) ropeMode = 1;
    else if (nw >= 1792 && nw < 2176) ropeMode = 2;
  }
  float* okv = nullptr; int okv_w = 0, okv_c = 0;
  if (!isS) {
    if (nw >= 256 && nw < 512) { okv = p.out + O_NAK; okv_w = 256; okv_c = nw - 256; }
    else if (nw >= 512 && nw < 768) { okv = p.out + O_NAV; okv_w = 256; okv_c = nw - 512; }
    else if (nw >= 1024 && nw < 1280) { okv = p.out + O_DK; okv_w = 256; okv_c = nw - 1024; }
    else if (nw >= 1280 && nw < 1536) { okv = p.out + O_DV; okv_w = 256; okv_c = nw - 1280; }
    else if (nw >= 2048 && nw < 2176) { okv = p.out + O_SK; okv_w = 128; okv_c = nw - 2048; }
    else if (nw >= 2176) { okv = p.out + O_SV; okv_w = 128; okv_c = nw - 2176; }
  }
  int khh = -1;
  if (nw >= 256 && nw < 512) khh = (nw - 256) >> 6;
  else if (nw >= 1024 && nw < 1280) khh = 4 + ((nw - 1024) >> 6);
  else if (nw >= 2048 && nw < 2176) khh = 8 + ((nw - 2048) >> 6);
  int vrow = -1;
  if (nw >= 512 && nw < 768) vrow = nw - 512;
  else if (nw >= 1280 && nw < 1536) vrow = 256 + nw - 1280;
  else if (nw >= 2176) vrow = 512 + nw - 2176;
#pragma unroll
  for (int yi = 0; yi < 4; ++yi) {
    const int m = m0 + wy * 64 + yi * 16 + r;
    const int t = (m - NPTOK) & 1023;
    const int prow = t >> 6, pcol = t & 63;
#pragma unroll
    for (int xi = 0; xi < 4; ++xi) {
      f32x4 v = acc[xi][yi];
      if (ropeMode == 1) {
        const int pos = (xi & 1) ? pcol : prow;
        const float4 cs = *(const float4*)(p.ropeD + pos * 8 + 4 * (g & 1));
        const float4 sn = *(const float4*)(p.ropeD + 512 + pos * 8 + 4 * (g & 1));
        const float sg = (g >= 2) ? 1.f : -1.f;
        const float o0 = __shfl_xor(v[0], 32), o1 = __shfl_xor(v[1], 32), o2 = __shfl_xor(v[2], 32), o3 = __shfl_xor(v[3], 32);
        v[0] = v[0] * cs.x + sg * o0 * sn.x; v[1] = v[1] * cs.y + sg * o1 * sn.y;
        v[2] = v[2] * cs.z + sg * o2 * sn.z; v[3] = v[3] * cs.w + sg * o3 * sn.w;
      } else if (ropeMode == 2) {
        const int pos = (xi >> 1) ? pcol : prow;
        const float4 cs = *(const float4*)(p.ropeS + pos * 16 + 4 * g);
        const float4 sn = *(const float4*)(p.ropeS + 1024 + pos * 16 + 4 * g);
        const f32x4 o = acc[xi ^ 1][yi];
        const float sg = (xi & 1) ? 1.f : -1.f;
        v[0] = v[0] * cs.x + sg * o[0] * sn.x; v[1] = v[1] * cs.y + sg * o[1] * sn.y;
        v[2] = v[2] * cs.z + sg * o[2] * sn.z; v[3] = v[3] * cs.w + sg * o[3] * sn.w;
      }
      const int nloc = xi * 16 + 4 * g;
      if (okv) {
        const int b = m >> 8, pos = m & 255;
        float4 o4; o4.x = v[0]; o4.y = v[1]; o4.z = v[2]; o4.w = v[3];
        __builtin_nontemporal_store(v, (f32x4*)(okv + ((size_t)((b * 4 + l) * 256 + pos)) * okv_w + okv_c + nloc));
      }
      if (vrow >= 0) {
        u16* vb = p.vfr + ((size_t)((vrow >> 6) * 192 + (m >> 5))) * 2048;
#pragma unroll
        for (int i = 0; i < 4; ++i) vb[vfrag_off(m & 31, nloc + i)] = f2bf(v[i]);
      } else if (khh >= 0) {
        uint2 w; w.x = pack2(v[0], v[1]); w.y = pack2(v[2], v[3]);
        *(uint2*)(p.kfr + ((size_t)(khh * 192 + (m >> 5))) * 2048 + kfrag_off(m & 31, nloc)) = w;
      } else {
        uint2 w; w.x = pack2(v[0], v[1]); w.y = pack2(v[2], v[3]);
        *(uint2*)(p.z + (size_t)m * INW + nw + nloc) = w;
      }
    }
  }
}

__device__ void res_tile(const Params& p, int l, int tx, int ty, const u16* A, const u16* WT, int K, int gi, u16* smem, bool first = false) {
  const int n0 = tx * 128, m0 = ty * 96;
  f32x4 acc[4][3];
  gemm_main<3>(WT + (size_t)n0 * K, K, A + (size_t)m0 * K, K, K, smem, acc);
  const int lane = otid() & 63, wave = otid() >> 6, wx = wave & 1, wy = wave >> 1, r = lane & 15, g = lane >> 4;
#pragma unroll
  for (int yi = 0; yi < 3; ++yi) {
    const int m = m0 + wy * 48 + yi * 16 + r;
    const int cond = m < NPTOK ? 0 : 1 + ((m - NPTOK) >> 10);
    const float* gate = p.mods + (size_t)(l * 3 + cond) * 6144 + gi * 1024;
    float* xrow = p.xres + (size_t)m * 1024;
    const float* xin = first ? (m < NPTOK ? p.x_prompt + (size_t)m * 1024 : p.x_sample + (size_t)(m - NPTOK) * 1024) : xrow;
    float4 xv[4], gt[4];
#pragma unroll
    for (int xi = 0; xi < 4; ++xi) {
      const int n = n0 + wx * 64 + xi * 16 + 4 * g;
      xv[xi] = *(const float4*)(xin + n);
      gt[xi] = *(const float4*)(gate + n);
    }
#pragma unroll
    for (int xi = 0; xi < 4; ++xi) {
      const int n = n0 + wx * 64 + xi * 16 + 4 * g;
      const f32x4 v = acc[xi][yi];
      float4 o = xv[xi];
      o.x += gt[xi].x * v[0]; o.y += gt[xi].y * v[1]; o.z += gt[xi].z * v[2]; o.w += gt[xi].w * v[3];
      *(float4*)(xrow + n) = o;
    }
  }
}

__device__ void m1_tile(const Params& p, int l, int tx, int ty, u16* smem) {
  const int n0 = tx * 128, m0 = ty * 128;
  f32x4 acc[4][4];
  gemm_main<4>(p.w1T + (size_t)l * 4096 * 1024 + (size_t)n0 * 1024, 1024, p.h + (size_t)m0 * 1024, 1024, 1024, smem, acc);
  const int lane = otid() & 63, wave = otid() >> 6, wx = wave & 1, wy = wave >> 1, r = lane & 15, g = lane >> 4;
#pragma unroll
  for (int xi = 0; xi < 4; ++xi) {
    const int n = n0 + wx * 64 + xi * 16 + 4 * g;
#pragma unroll
    for (int yi = 0; yi < 4; ++yi) {
      const int m = m0 + wy * 64 + yi * 16 + r;
      const f32x4 v = acc[xi][yi];
      float a0 = fmaxf(v[0], 0.f), a1 = fmaxf(v[1], 0.f), a2 = fmaxf(v[2], 0.f), a3 = fmaxf(v[3], 0.f);
      uint2 w; w.x = pack2(a0 * a0, a1 * a1); w.y = pack2(a2 * a2, a3 * a3);
      *(uint2*)(p.u + (size_t)m * 4096 + n) = w;
    }
  }
}

__device__ void f1_tile(const Params& p, int l, int it, u16* smem) {
  const int tx = it % 48, ty = it / 48;
  const int x0 = tx * 128, y0 = ty * 128;
  f32x4 acc[4][4];
  gemm_main<4>(p.z + (size_t)x0 * INW + 1536, INW, p.pqt + (size_t)l * 512 * 256 + (size_t)y0 * 256, 256, 256, smem, acc);
  const int lane = otid() & 63, wave = otid() >> 6, wx = wave & 1, wy = wave >> 1, r = lane & 15, g = lane >> 4;
#pragma unroll
  for (int yi = 0; yi < 4; ++yi) {
    const int y = y0 + wy * 64 + yi * 16 + r;
    const int col = y & 255, which = y >> 8;
#pragma unroll
    for (int xi = 0; xi < 4; ++xi) {
      const int tok = x0 + wx * 64 + xi * 16 + 4 * g;
      size_t addr;
      if (tok < NPTOK) {
        const int b = tok >> 8, pos = tok & 255;
        addr = (size_t)b * (256 * 512) + (size_t)col * 512 + which * 256 + pos;
      } else {
        const int b = (tok - NPTOK) >> 10, pos = (tok - NPTOK) & 1023;
        addr = (size_t)16 * 256 * 512 + (size_t)b * (256 * 2048) + (size_t)col * 2048 + which * 1024 + pos;
      }
      const f32x4 v = acc[xi][yi];
      uint2 w; w.x = pack2(v[0], v[1]); w.y = pack2(v[2], v[3]);
      *(uint2*)(p.uv + addr) = w;
    }
  }
  asm volatile("s_waitcnt vmcnt(0)" ::: "memory");
  __syncthreads();
  if (threadIdx.x == 0) {
    __builtin_amdgcn_fence(__ATOMIC_RELEASE, "agent");
    asm volatile("s_waitcnt vmcnt(0)" ::: "memory");
    xb_add(p.bar + XCD_BAR_WORDS + (8 + l) * 64, 1u);
  }
}

__device__ void f2_tile(const Params& p, int l, int it, u16* smem) {
  if (threadIdx.x == 0) {
    unsigned* c = p.bar + XCD_BAR_WORDS + (8 + l) * 64;
    unsigned sp = 0;
    while (xb_ld(c) < 192u) { __builtin_amdgcn_s_sleep(2); if (++sp > (1u << 24)) break; }
    __builtin_amdgcn_fence(__ATOMIC_ACQUIRE, "agent");
    asm volatile("s_waitcnt vmcnt(0)" ::: "memory");
  }
  __syncthreads();
  int L, b, tx, ty, tokbase;
  const u16* uvb; const u16* dft;
  if (it < 32) { L = 1024; b = it >> 4; tx = (it >> 3) & 1; ty = it & 7; uvb = p.uv + (size_t)16 * 256 * 512 + (size_t)b * (256 * 2048); dft = p.dft1024; tokbase = NPTOK + b * 1024; }
  else { it -= 32; L = 256; b = it >> 2; tx = (it >> 1) & 1; ty = it & 1; uvb = p.uv + (size_t)b * (256 * 512); dft = p.dft256; tokbase = b * 256; }
  const int x0 = tx * 128, y0 = ty * 128, K = 2 * L;
  f32x4 acc[4][4];
  gemm_main<4>(uvb + (size_t)x0 * K, K, dft + (size_t)y0 * K, K, K, smem, acc);
  const int lane = otid() & 63, wave = otid() >> 6, wx = wave & 1, wy = wave >> 1, r = lane & 15, g = lane >> 4;
  const float scale = rsqrtf(64.f * (float)L);
#pragma unroll
  for (int yi = 0; yi < 4; ++yi) {
    const int pos = y0 + wy * 64 + yi * 16 + r;
#pragma unroll
    for (int xi = 0; xi < 4; ++xi) {
      const int col = x0 + wx * 64 + xi * 16 + 4 * g;
      const f32x4 v = acc[xi][yi];
      uint2 w; w.x = pack2(v[0] * scale, v[1] * scale); w.y = pack2(v[2] * scale, v[3] * scale);
      *(uint2*)(p.cat + (size_t)(tokbase + pos) * 1024 + 512 + col) = w;
    }
  }
}

struct Seg { const u16* K; const u16* Vt; int ldk, ldv, nblk, pos0, stride; };
#define KLOC(hh, tokb) (p.kfr + ((size_t)((hh) * 192 + ((tokb) >> 5))) * 2048)
#define VLOC(hh, tokb) (p.vfr + ((size_t)((hh) * 192 + ((tokb) >> 5))) * 2048)
template <int QT> struct AState { float m[QT]; float ls[QT]; f32x4 o[QT][4]; };

__device__ __forceinline__ bf16x8 as_bf(u32x4 v) { union { u32x4 u; bf16x8 b; } x; x.u = v; return x.b; }

template <int DC>
__device__ __forceinline__ void issue_blk(const Seg& s0, const Seg& s1, int b, int r, int g, u32x4 (&kf)[2][DC], u32x4 (&vf)[4]) {
  const bool in0 = b < s0.nblk;
  const u16* Kp = in0 ? s0.K : s1.K;
  const u16* Vp = in0 ? s0.Vt : s1.Vt;
  const int pos = in0 ? (s0.pos0 + b * s0.stride) : (s1.pos0 + (b - s0.nblk) * s1.stride);
  const int lane8 = (g * 16 + r) * 8;
  const u16* kp = Kp + (size_t)(pos >> 5) * 2048 + lane8;
  const u16* vp = Vp + (size_t)(pos >> 5) * 2048 + lane8;
#pragma unroll
  for (int t = 0; t < 2; ++t)
#pragma unroll
    for (int dc = 0; dc < DC; ++dc) gload16(kf[t][dc], kp + (t * 2 + dc) * 512);
#pragma unroll
  for (int dv = 0; dv < 4; ++dv) gload16(vf[dv], vp + dv * 512);
}
template <int N>
__device__ __forceinline__ void wait_blk(u32x4 (&kf)[2][1], u32x4 (&vf)[4]) {
  asm volatile("s_waitcnt vmcnt(%6)" : "+v"(kf[0][0]), "+v"(kf[1][0]), "+v"(vf[0]), "+v"(vf[1]), "+v"(vf[2]), "+v"(vf[3]) : "n"(N) : "memory");
}
template <int N>
__device__ __forceinline__ void wait_blk(u32x4 (&kf)[2][2], u32x4 (&vf)[4]) {
  asm volatile("s_waitcnt vmcnt(%8)" : "+v"(kf[0][0]), "+v"(kf[0][1]), "+v"(kf[1][0]), "+v"(kf[1][1]), "+v"(vf[0]), "+v"(vf[1]), "+v"(vf[2]), "+v"(vf[3]) : "n"(N) : "memory");
}

template <int D, int QT, int MODE>
__device__ __forceinline__ void attn_compute(const u32x4 (&kc)[2][D / 32], const u32x4 (&vc)[4], const bf16x8 (&qf)[QT][D / 32], const float sc,
                                             AState<QT>& st, const bool in0, const int pos, const int qpos0, const float* __restrict__ rpb_h,
                                             const int r, const int g) {
  constexpr int DC = D / 32;
#pragma unroll
  for (int q = 0; q < QT; ++q) {
    f32x4 s_[2];
    s_[0] = (f32x4){0.f, 0.f, 0.f, 0.f};
    s_[1] = (f32x4){0.f, 0.f, 0.f, 0.f};
#pragma unroll
    for (int t = 0; t < 2; ++t)
#pragma unroll
      for (int dc = 0; dc < DC; ++dc) s_[t] = __builtin_amdgcn_mfma_f32_16x16x32_bf16(as_bf(kc[t][dc]), qf[q][dc], s_[t], 0, 0, 0);
    float sv[8];
#pragma unroll
    for (int t = 0; t < 2; ++t)
#pragma unroll
      for (int i = 0; i < 4; ++i) {
        float x = s_[t][i] * sc;
        if (MODE == 1) {
          if (!in0) {
            const int qpos = qpos0 + q * 16 + r;
            const int qrow = qpos >> 6, cq = qpos & 63;
            const int kpos = pos + 8 * g + 4 * t + i;
            const int krow = kpos >> 6, ck = kpos & 63;
            const int cs = min(max(cq - 8, 0), 48);
            const bool valid = (ck >= cs) && (ck < cs + 16);
            const int bi = (krow - qrow + 7) * 31 + (ck - cq + 15);
            const float bias = rpb_h[valid ? bi : 0];
            x = valid ? (x + bias) : -1e30f;
          }
        } else if (MODE == 2) {
          if (!in0) {
            const int qpos = qpos0 + q * 16 + r;
            const int kpos = pos + 8 * g + 4 * t + i;
            const int d = qpos - kpos;
            x = (d <= 128 && d >= -128) ? x : -1e30f;
          }
        }
        sv[4 * t + i] = x;
      }
    float mx = fmaxf(fmaxf(fmaxf(sv[0], sv[1]), fmaxf(sv[2], sv[3])), fmaxf(fmaxf(sv[4], sv[5]), fmaxf(sv[6], sv[7])));
    mx = fmaxf(mx, __shfl_xor(mx, 16));
    mx = fmaxf(mx, __shfl_xor(mx, 32));
    const float mnew = fmaxf(st.m[q], mx);
    const float alpha = __builtin_amdgcn_exp2f(st.m[q] - mnew);
    st.m[q] = mnew;
    float ps = 0.f;
#pragma unroll
    for (int j = 0; j < 8; ++j) { sv[j] = __builtin_amdgcn_exp2f(sv[j] - mnew); ps += sv[j]; }
    st.ls[q] = st.ls[q] * alpha + ps;
    union { bf16x8 v; unsigned w[4]; } pf;
    pf.w[0] = pack2(sv[0], sv[1]); pf.w[1] = pack2(sv[2], sv[3]); pf.w[2] = pack2(sv[4], sv[5]); pf.w[3] = pack2(sv[6], sv[7]);
#pragma unroll
    for (int dv = 0; dv < 4; ++dv) {
      f32x4 o = st.o[q][dv];
      o[0] *= alpha; o[1] *= alpha; o[2] *= alpha; o[3] *= alpha;
      st.o[q][dv] = __builtin_amdgcn_mfma_f32_16x16x32_bf16(as_bf(vc[dv]), pf.v, o, 0, 0, 0);
    }
  }
}

template <int D, int QT, int MODE, int NQ = 2>
__device__ __forceinline__ void attn_run(const Seg& s0, const Seg& s1, const bf16x8 (&qf)[QT][D / 32], const float sc,
                                         AState<QT>& st, const int qpos0, const float* __restrict__ rpb_h, const int bb = 0, const int be = -1) {
  constexpr int DC = D / 32;
  constexpr int NL = 2 * DC + 4;
  const int lane = otid() & 63, r = lane & 15, g = lane >> 4;
  const int nb = be < 0 ? s0.nblk + s1.nblk : be;
  u32x4 kq[NQ][2][DC], vq[NQ][4];
#pragma unroll
  for (int q = 0; q < QT; ++q)
#pragma unroll
    for (int dc = 0; dc < DC; ++dc) asm volatile("" ::"v"(qf[q][dc]));
  asm volatile("s_waitcnt vmcnt(0)" ::: "memory");
#pragma unroll 1
  for (int b = bb; b < nb; b += NQ) {
#pragma unroll
    for (int j = 0; j < NQ; ++j) issue_blk<DC>(s0, s1, b + j, r, g, kq[j], vq[j]);
#pragma unroll
    for (int j = 0; j < NQ; ++j) {
      if (j == 0) wait_blk<(NQ - 1) * NL>(kq[j], vq[j]);
      else if (j == 1) wait_blk<(NQ - 2) * NL>(kq[j], vq[j]);
      else if (j == 2) wait_blk<(NQ > 3 ? (NQ - 3) * NL : 0)>(kq[j], vq[j]);
      else wait_blk<0>(kq[j], vq[j]);
      const int bj = b + j;
      const bool in0 = bj < s0.nblk;
      const int pos = in0 ? (s0.pos0 + bj * s0.stride) : (s1.pos0 + (bj - s0.nblk) * s1.stride);
      attn_compute<D, QT, MODE>(kq[j], vq[j], qf, sc, st, in0, pos, qpos0, rpb_h, r, g);
    }
  }
}

template <int QT>
__device__ __forceinline__ void astate_init(AState<QT>& st, float m0, float l0) {
#pragma unroll
  for (int q = 0; q < QT; ++q) {
    st.m[q] = m0; st.ls[q] = l0;
#pragma unroll
    for (int dv = 0; dv < 4; ++dv) st.o[q][dv] = (f32x4){0.f, 0.f, 0.f, 0.f};
  }
}
template <int QT>
__device__ __forceinline__ void astate_finalize(AState<QT>& st) {
#pragma unroll
  for (int q = 0; q < QT; ++q) {
    float l = st.ls[q];
    l += __shfl_xor(l, 16);
    l += __shfl_xor(l, 32);
    const float inv = 1.f / l;
#pragma unroll
    for (int dv = 0; dv < 4; ++dv) { st.o[q][dv][0] *= inv; st.o[q][dv][1] *= inv; st.o[q][dv][2] *= inv; st.o[q][dv][3] *= inv; }
  }
}
template <int DC, int QT>
__device__ __forceinline__ void load_q(const u16* zq  , bf16x8 (&qf)[QT][DC]) {
  const int lane = otid() & 63, r = lane & 15, g = lane >> 4;
#pragma unroll
  for (int q = 0; q < QT; ++q)
#pragma unroll
    for (int dc = 0; dc < DC; ++dc) qf[q][dc] = *(const bf16x8*)(zq + (size_t)(q * 16 + r) * INW + dc * 32 + g * 8);
}
template <int QT>
__device__ __forceinline__ void write_o(const Params& p, const AState<QT>& st, int tok0, int col0) {
  const int lane = otid() & 63, r = lane & 15, g = lane >> 4;
#pragma unroll
  for (int q = 0; q < QT; ++q)
#pragma unroll
    for (int dv = 0; dv < 4; ++dv) {
      const f32x4 v = st.o[q][dv];
      uint2 w; w.x = pack2(v[0], v[1]); w.y = pack2(v[2], v[3]);
      *(uint2*)(p.cat + (size_t)(tok0 + q * 16 + r) * 1024 + col0 + dv * 16 + 4 * g) = w;
    }
}

__device__ __forceinline__ float diff_lambda(const Params& p, int l, float lam_init) {
  const int lane = otid() & 63;
  float a = 0.f, b = 0.f;
  if (lane < 32) { a = p.lq1[l * 32 + lane] * p.lk1[l * 32 + lane]; b = p.lq2[l * 32 + lane] * p.lk2[l * 32 + lane]; }
#pragma unroll
  for (int o = 32; o >= 1; o >>= 1) { a += __shfl_xor(a, o); b += __shfl_xor(b, o); }
  return expf(a) - expf(b) + lam_init;
}

__device__ __forceinline__ void diff_finish_q(const Params& p, int l, float lam, float lam_init, f32x4 (&A)[4], const f32x4 (&B)[4], int tokrow0, int col0) {
  const int lane = otid() & 63, r = lane & 15, g = lane >> 4;
  const float* sg = p.subln_g + l * 64;
  float ss = 0.f;
#pragma unroll
  for (int dv = 0; dv < 4; ++dv)
#pragma unroll
    for (int i = 0; i < 4; ++i) {
      const float v = A[dv][i] - lam * B[dv][i];
      A[dv][i] = v;
      ss += v * v;
    }
  ss += __shfl_xor(ss, 16);
  ss += __shfl_xor(ss, 32);
  const float rs = rsqrtf(ss * (1.f / 64.f) + 1e-6f) * (1.f - lam_init);
#pragma unroll
  for (int dv = 0; dv < 4; ++dv) {
    const float4 gg = *(const float4*)(sg + dv * 16 + 4 * g);
    uint2 w;
    w.x = pack2(A[dv][0] * rs * gg.x, A[dv][1] * rs * gg.y);
    w.y = pack2(A[dv][2] * rs * gg.z, A[dv][3] * rs * gg.w);
    *(uint2*)(p.cat + (size_t)(tokrow0 + r) * 1024 + col0 + dv * 16 + 4 * g) = w;
  }
}

#ifndef AQT
#define AQT 2
#endif
#define QW (16 * AQT)
#define NQG_CTX (256 / QW)
#define NQG_LAT (1024 / QW)
__device__ void attn_diff_item(const Params& p, int l, bool lat, int bi, float* sm) {
  const int wave = otid() >> 6, lane = otid() & 63, r = lane & 15, g = lane >> 4;
  const int ps = wave >> 1, half = wave & 1;
  int b, h, qg, tokb;
  if (lat) { b = bi / (4 * NQG_LAT); h = (bi / NQG_LAT) & 3; qg = bi % NQG_LAT; tokb = NPTOK + b * 1024; }
  else { b = bi / (4 * NQG_CTX); h = (bi / NQG_CTX) & 3; qg = bi % NQG_CTX; tokb = b * 256; }
  const int tok0 = tokb + qg * QW;
  const u16* zb = p.z + (size_t)tokb * INW;
  Seg s0, s1;
  if (lat) {
    const int bl = b * 4 + l;
    s0.K = p.ck_diff + (size_t)((bl * 4 + h) * 16) * 2048 + ps * 512; s0.Vt = p.cvt_diff + (size_t)((bl * 4 + h) * 16) * 2048;
    s0.ldk = 0; s0.ldv = 0; s0.nblk = half ? 0 : 16; s0.pos0 = 0; s0.stride = 32;
    s1.K = KLOC(4 + h, tokb) + ps * 512; s1.Vt = VLOC(4 + h, tokb);
    s1.ldk = 0; s1.ldv = 0; s1.nblk = half ? 24 : 8; s1.pos0 = half ? 256 : 0; s1.stride = 32;
  } else {
    s0.K = KLOC(4 + h, tokb) + ps * 512; s0.Vt = VLOC(4 + h, tokb);
    s0.ldk = 0; s0.ldv = 0; s0.nblk = 4; s0.pos0 = half ? 128 : 0; s0.stride = 32;
    s1 = s0; s1.nblk = 0;
  }
  bf16x8 qf[AQT][1];
  load_q<1, AQT>(p.z + (size_t)tok0 * INW + 768 + h * 64 + ps * 32, qf);
  AState<AQT> st;
  astate_init<AQT>(st, -1e30f, 0.f);
  attn_run<32, AQT, 0, 2>(s0, s1, qf, 0.17677669529663687f * LOG2E, st, 0, nullptr);
  float lt[AQT];
#pragma unroll
  for (int q = 0; q < AQT; ++q) {
    lt[q] = st.ls[q];
    lt[q] += __shfl_xor(lt[q], 16);
    lt[q] += __shfl_xor(lt[q], 32);
  }
  constexpr int WS = 64 * 16 * AQT;
  float* pm = sm + 4 * WS;
  if (wave != 0) {
    float* po = sm + wave * WS + lane * (16 * AQT);
#pragma unroll
    for (int q = 0; q < AQT; ++q) {
#pragma unroll
      for (int dv = 0; dv < 4; ++dv) *(f32x4*)(po + q * 16 + dv * 4) = st.o[q][dv];
      if (g == 0) { pm[wave * QW + q * 16 + r] = st.m[q]; pm[4 * QW + wave * QW + q * 16 + r] = lt[q]; }
    }
  }
  __syncthreads();
  if (wave == 0) {
    const float lam_init = 0.8f - 0.6f * expf(-0.3f * (float)l);
    const float lam = diff_lambda(p, l, lam_init);
#pragma unroll
    for (int q = 0; q < AQT; ++q) {
      f32x4 A[4], B[4];
      {
        const float m1 = pm[QW + q * 16 + r], l1 = pm[4 * QW + QW + q * 16 + r];
        const float M = fmaxf(st.m[q], m1);
        const float a0 = exp2f(st.m[q] - M), a1 = exp2f(m1 - M);
        const float inv = 1.f / (lt[q] * a0 + l1 * a1);
#pragma unroll
        for (int dv = 0; dv < 4; ++dv) {
          const f32x4 o1 = *(const f32x4*)(sm + 1 * WS + lane * (16 * AQT) + q * 16 + dv * 4);
          A[dv] = (st.o[q][dv] * a0 + o1 * a1) * inv;
        }
      }
      {
        const float m2 = pm[2 * QW + q * 16 + r], l2 = pm[4 * QW + 2 * QW + q * 16 + r], m3 = pm[3 * QW + q * 16 + r], l3 = pm[4 * QW + 3 * QW + q * 16 + r];
        const float M = fmaxf(m2, m3);
        const float a2 = exp2f(m2 - M), a3 = exp2f(m3 - M);
        const float inv = 1.f / (l2 * a2 + l3 * a3);
#pragma unroll
        for (int dv = 0; dv < 4; ++dv) {
          const f32x4 o2 = *(const f32x4*)(sm + 2 * WS + lane * (16 * AQT) + q * 16 + dv * 4);
          const f32x4 o3 = *(const f32x4*)(sm + 3 * WS + lane * (16 * AQT) + q * 16 + dv * 4);
          B[dv] = (o2 * a2 + o3 * a3) * inv;
        }
      }
      diff_finish_q(p, l, lam, lam_init, A, B, tok0 + q * 16, 256 + h * 64);
    }
  }
  __syncthreads();
}

__device__ void attn_ctx_item(const Params& p, int l, int bi) {
  const int wave = otid() >> 6, lane = otid() & 63, g = lane >> 4;
  const int w = bi * 4 + wave;
  const int type = w / (64 * NQG_CTX), rem = w % (64 * NQG_CTX);
  const int b = rem / (4 * NQG_CTX), h = (rem / NQG_CTX) & 3, qg = rem % NQG_CTX;
  const int tokb = b * 256, tok0 = tokb + qg * QW;
  const u16* zb = p.z + (size_t)tokb * INW;
  const int kvh = h >> 1;
  const int qcol = type == 0 ? h * 64 : 1792 + h * 64;
  const int kcol = type == 0 ? 256 + h * 64 : 2048 + kvh * 64;
  const int vrow = type == 0 ? h * 64 : 512 + kvh * 64;
  const int ocol = type == 0 ? h * 64 : 768 + h * 64;
  bf16x8 qf[AQT][2];
  load_q<2, AQT>(p.z + (size_t)tok0 * INW + qcol, qf);
  const int hslot = type == 0 ? h : 8 + kvh;
  Seg s0; s0.K = KLOC(hslot, tokb); s0.Vt = VLOC(hslot, tokb); s0.ldk = 0; s0.ldv = 0; s0.nblk = 8; s0.pos0 = 0; s0.stride = 32;
  Seg sN = s0; sN.nblk = 0;
  AState<AQT> st;
  const float sk = type == 0 ? -1e30f : p.swa_sink[l * 4 + h] * LOG2E;
  astate_init<AQT>(st, sk, (type == 1 && g == 0) ? 1.f : 0.f);
  attn_run<64, AQT, 0, 2>(s0, sN, qf, 0.125f * LOG2E, st, 0, nullptr);
  astate_finalize<AQT>(st);
  write_o<AQT>(p, st, tok0, ocol);
}

__device__ void attn_lat_item(const Params& p, int l, int bi, float* sm) {
  const int wave = otid() >> 6, lane = otid() & 63, r = lane & 15, g = lane >> 4;
  const int type = bi / (8 * NQG_LAT), rem = bi % (8 * NQG_LAT);
  const int b = rem / (4 * NQG_LAT), h = (rem / NQG_LAT) & 3, qg = rem % NQG_LAT;
  const int q0 = qg * QW;
  const int tokb = NPTOK + b * 1024, tok0 = tokb + q0;
  const u16* zb = p.z + (size_t)tokb * INW;
  const int bl = b * 4 + l;
  AState<AQT> st;
  int ocol;
  if (type == 0) {
    const int kvh = h >> 1;
    bf16x8 qf[AQT][2];
    load_q<2, AQT>(p.z + (size_t)tok0 * INW + 1792 + h * 64, qf);
    Seg s0; s0.K = p.ck_swa + (size_t)((bl * 2 + kvh) * 16) * 2048; s0.Vt = p.cvt_swa + (size_t)((bl * 2 + kvh) * 16) * 2048; s0.ldk = 0; s0.ldv = 0; s0.nblk = 16; s0.pos0 = 0; s0.stride = 32;
    const int lo = max(0, q0 - 128) & ~31;
    const int hi = min(1024, ((q0 + QW + 128) + 31) & ~31);
    int lo2 = lo, cnt = (hi - lo) >> 5;
    if (cnt & 1) { if (lo2 > 0) lo2 -= 32; ++cnt; }
    Seg s1; s1.K = KLOC(8 + kvh, tokb); s1.Vt = VLOC(8 + kvh, tokb); s1.ldk = 0; s1.ldv = 0; s1.nblk = cnt; s1.pos0 = lo2; s1.stride = 32;
    const int P = (16 + cnt) >> 1;
    const int pb = (wave * P) >> 2, pe = ((wave + 1) * P) >> 2;
    astate_init<AQT>(st, wave == 0 ? p.swa_sink[l * 4 + h] * LOG2E : -1e30f, (wave == 0 && g == 0) ? 1.f : 0.f);
    attn_run<64, AQT, 2>(s0, s1, qf, 0.125f * LOG2E, st, q0, nullptr, 2 * pb, 2 * pe);
    ocol = 768 + h * 64;
  } else {
    bf16x8 qf[AQT][2];
    load_q<2, AQT>(p.z + (size_t)tok0 * INW + h * 64, qf);
    {
      const float* rp = p.na_rpb + (size_t)(l * 4 + h) * 15 * 31;
      for (int e = otid(); e < 465; e += 256) sm[9000 + e] = rp[e] * LOG2E;
      __syncthreads();
    }
    Seg s0; s0.K = p.ck_na + (size_t)((bl * 4 + h) * 16) * 2048; s0.Vt = p.cvt_na + (size_t)((bl * 4 + h) * 16) * 2048; s0.ldk = 0; s0.ldv = 0; s0.nblk = 16; s0.pos0 = 0; s0.stride = 32;
    const int qrow = q0 >> 6;
    const int rstart = min(max(qrow - 4, 0), 8);
    Seg s1; s1.K = KLOC(h, tokb); s1.Vt = VLOC(h, tokb); s1.ldk = 0; s1.ldv = 0; s1.nblk = 16; s1.pos0 = rstart * 64; s1.stride = 32;
    astate_init<AQT>(st, -1e30f, 0.f);
    attn_run<64, AQT, 1, 2>(s0, s1, qf, 0.125f * LOG2E, st, q0, sm + 9000, 8 * wave, 8 * wave + 8);
    ocol = h * 64;
  }
  float lt[AQT];
#pragma unroll
  for (int q = 0; q < AQT; ++q) {
    lt[q] = st.ls[q];
    lt[q] += __shfl_xor(lt[q], 16);
    lt[q] += __shfl_xor(lt[q], 32);
  }
  constexpr int WS = 64 * 16 * AQT;
  float* pm = sm + 4 * WS;
  if (wave != 0) {
    float* po = sm + wave * WS + lane * (16 * AQT);
#pragma unroll
    for (int q = 0; q < AQT; ++q) {
#pragma unroll
      for (int dv = 0; dv < 4; ++dv) *(f32x4*)(po + q * 16 + dv * 4) = st.o[q][dv];
      if (g == 0) { pm[wave * QW + q * 16 + r] = st.m[q]; pm[4 * QW + wave * QW + q * 16 + r] = lt[q]; }
    }
  }
  __syncthreads();
  if (wave == 0) {
#pragma unroll
    for (int q = 0; q < AQT; ++q) {
      const float m1 = pm[1 * QW + q * 16 + r], m2 = pm[2 * QW + q * 16 + r], m3 = pm[3 * QW + q * 16 + r];
      const float l1 = pm[4 * QW + 1 * QW + q * 16 + r], l2 = pm[4 * QW + 2 * QW + q * 16 + r], l3 = pm[4 * QW + 3 * QW + q * 16 + r];
      const float M = fmaxf(fmaxf(st.m[q], m1), fmaxf(m2, m3));
      const float a0 = __builtin_amdgcn_exp2f(st.m[q] - M), a1 = __builtin_amdgcn_exp2f(m1 - M), a2 = __builtin_amdgcn_exp2f(m2 - M), a3 = __builtin_amdgcn_exp2f(m3 - M);
      const float inv = 1.f / (lt[q] * a0 + l1 * a1 + l2 * a2 + l3 * a3);
#pragma unroll
      for (int dv = 0; dv < 4; ++dv) {
        const f32x4 o1 = *(const f32x4*)(sm + 1 * WS + lane * (16 * AQT) + q * 16 + dv * 4);
        const f32x4 o2 = *(const f32x4*)(sm + 2 * WS + lane * (16 * AQT) + q * 16 + dv * 4);
        const f32x4 o3 = *(const f32x4*)(sm + 3 * WS + lane * (16 * AQT) + q * 16 + dv * 4);
        st.o[q][dv] = (st.o[q][dv] * a0 + o1 * a1 + o2 * a2 + o3 * a3) * inv;
      }
    }
    write_o<AQT>(p, st, tok0, ocol);
  }
  __syncthreads();
}

__device__ __forceinline__ int q_next(unsigned* cnt, volatile LAS unsigned* slot) {
  __syncthreads();
  if (threadIdx.x == 0) *slot = xb_add(cnt, 1u);
  __syncthreads();
  return (int)*slot;
}

#if REP_SYNC
#define GSYNC() do { xcd_barrier(xb); xcd_barrier(xb); } while (0)
#else
#define GSYNC() xcd_barrier(xb)
#endif
__global__ void __launch_bounds__(256, 2) mega(Params p) {
  extern __shared__ __attribute__((aligned(16))) unsigned char smem[];
  cg::grid_group grid = cg::this_grid();
  const int nblk = gridDim.x, bid = blockIdx.x;
  u16* sm16 = (u16*)smem;
  __shared__ uint4 xb_words[2];
  if (threadIdx.x == 0) { xb_words[0] = make_uint4(0u, 0u, 0u, 0u); xb_words[1] = make_uint4(0u, 0u, 0u, 0u); }
  __syncthreads();
  XcdBarrier xb = xcd_barrier_post(p.bar, (volatile LAS unsigned*)&xb_words[0]);

  for (int rep = 0; rep <= REP_P0; ++rep)
    for (int it = bid; it < P0_ITEMS; it += nblk) p0_item(p, it, smem);
  if (p.use_cg_sync) grid.sync();
  GSYNC();

  const int xcc = (int)xb.x;
  const int xrank = __builtin_amdgcn_readfirstlane((int)xb.st[4]), xnloc = __builtin_amdgcn_readfirstlane((int)xb.st[0]);
  const unsigned topo = (unsigned)__builtin_amdgcn_readfirstlane((int)xb.st[5]);
  const bool local = (topo & 1u) != 0u, full64 = (topo & 2u) != 0u;
#define LSYNC() do { if (local) xcd_barrier_local(xb); else GSYNC(); } while (0)
#define LMAP(j, count, total) (local ? ((xrank + (j) * xnloc) < (count) ? (xrank + (j) * xnloc) : -1) : ((bid + (j) * nblk) < (total) ? (bid + (j) * nblk) : -1))

#pragma unroll 1
  for (int l = 0; l < 4; ++l) {
    for (int j = 0;; ++j) { const int v = LMAP(j, 48, 384); if (v < 0) break; norm_item(p, l, 0, local ? 48 * xcc + v : v); }
    LSYNC();
    for (int j = 0;; ++j) {
      const int v = LMAP(j, 108, 864); if (v < 0) break;
      if (local) gin_tile(p, l, v / 6, 6 * xcc + v % 6, sm16); else gin_tile(p, l, v / 48, v % 48, sm16);
    }
    if (full64) {
      if (xrank >= 44) {
        const int idle = xcc * 20 + (xrank - 44);
        for (int it = 288 + idle; it < 928; it += 160) wt_item(p, l, it, (float*)smem);
      }
    }
    GSYNC();
    {
      constexpr int CD = 64 * NQG_CTX, CC = 2 * 64 * NQG_CTX / 4;
      constexpr int LD = 8 * NQG_LAT, LC = 2 * 8 * NQG_LAT;
      constexpr int E0 = 192, E1 = E0 + LD, E2 = E1 + LC, E3 = E2 + 32, E4 = E3 + CC, E5 = E4 + CD, E6 = E5 + 64;
      unsigned* qc = p.bar + XCD_BAR_WORDS + l * 64;
      const int w0 = full64 ? 928 : 288;
      const int EA = E6 + (1440 - w0), EW = EA + (l < 3 ? 288 : 0);
      for (int it = bid; it < EW; it = nblk + q_next(qc, &xb.st[2])) {
        if (it >= E6) {
          if (it < EA) wt_item(p, l, it - E6 + w0, (float*)smem);
          else wt_item(p, l + 1, it - EA, (float*)smem);
          continue;
        }
        if (it < E0) f1_tile(p, l, it, sm16);
        else if (it < E1) attn_diff_item(p, l, true, it - E0, (float*)smem);
        else if (it < E2) attn_lat_item(p, l, it - E1, (float*)smem);
        else if (it < E3) f2_tile(p, l, it - E2, sm16);
        else if (it < E4) attn_ctx_item(p, l, it - E3);
        else if (it < E5) attn_diff_item(p, l, false, it - E4, (float*)smem);
        else f2_tile(p, l, it - E5 + 32, sm16);
      }
    }
    GSYNC();
    for (int j = 0;; ++j) {
      const int v = LMAP(j, 64, 512); if (v < 0) break;
      if (local) res_tile(p, l, v / 8, 8 * xcc + v % 8, p.cat, p.w_outT + (size_t)l * 1024 * 1024, 1024, 2, sm16, l == 0);
      else res_tile(p, l, v / 64, v % 64, p.cat, p.w_outT + (size_t)l * 1024 * 1024, 1024, 2, sm16, l == 0);
    }
    LSYNC();
    for (int j = 0;; ++j) { const int v = LMAP(j, 48, 384); if (v < 0) break; norm_item(p, l, 1, local ? 48 * xcc + v : v); }
    LSYNC();
    for (int j = 0;; ++j) {
      const int v = LMAP(j, 192, 1536); if (v < 0) break;
      if (local) m1_tile(p, l, v / 6, 6 * xcc + v % 6, sm16); else m1_tile(p, l, v / 48, v % 48, sm16);
    }
    LSYNC();
    for (int j = 0;; ++j) {
      const int v = LMAP(j, 64, 512); if (v < 0) break;
      if (local) res_tile(p, l, v / 8, 8 * xcc + v % 8, p.u, p.w2T + (size_t)l * 1024 * 4096, 4096, 5, sm16);
      else res_tile(p, l, v / 64, v % 64, p.u, p.w2T + (size_t)l * 1024 * 4096, 4096, 5, sm16);
    }
    LSYNC();
  }
  for (int j = 0;; ++j) { const int v = LMAP(j, 48, 384); if (v < 0) break; norm_item(p, 0, 2, local ? 48 * xcc + v : v); }
#undef LSYNC
#undef LMAP
}

extern "C" void kernel_launch(void* const* d_in, const int* in_sizes, int n_in, void* d_out, int out_size, void* d_ws,
                              size_t ws_size, hipStream_t stream) {
  static int grid_blocks = 0;
  if (grid_blocks == 0) {
    int dev = 0, cus = 0, per_cu = 0;
    (void)hipGetDevice(&dev);
    (void)hipDeviceGetAttribute(&cus, hipDeviceAttributeMultiprocessorCount, dev);
    if (hipFuncSetAttribute((const void*)mega, hipFuncAttributeMaxDynamicSharedMemorySize, LDS_BYTES) != hipSuccess) {
      fprintf(stderr, "hipFuncSetAttribute failed\n");
    }
    if (hipOccupancyMaxActiveBlocksPerMultiprocessor(&per_cu, (const void*)mega, 256, LDS_BYTES) != hipSuccess || per_cu < 1) {
      fprintf(stderr, "occupancy query failed (%d)\n", per_cu);
      per_cu = 1;
    }
    if (per_cu > 2) per_cu = 2;
    grid_blocks = cus * per_cu;
    fprintf(stderr, "mega: cus=%d per_cu=%d grid=%d ws=%zu\n", cus, per_cu, grid_blocks, ws_size);
  }
  Params p{};
  const float** pin = (const float**)&p;
  for (int i = 0; i < 27; ++i) pin[i] = (const float*)d_in[i];
  p.out = (float*)d_out;
  unsigned char* ws = (unsigned char*)d_ws;
  size_t off = 0;
  auto take = [&](size_t bytes) { unsigned char* q = ws + off; off += (bytes + 255) & ~(size_t)255; return q; };
  p.xres = (float*)take((size_t)NTOK * 1024 * 4);
  p.mods = (float*)take((size_t)4 * 3 * 6144 * 4);
  p.h = (u16*)take((size_t)NTOK * 1024 * 2);
  p.z = (u16*)take((size_t)NTOK * INW * 2);
  p.vt = (u16*)take((size_t)640 * NTOK * 2);
  p.cat = (u16*)take((size_t)NTOK * 1024 * 2);
  p.u = (u16*)take((size_t)NTOK * 4096 * 2);
  p.uv = (u16*)take((size_t)(16 * 256 * 512 + 2 * 256 * 2048) * 2);
  p.w_inT = (u16*)take((size_t)4 * 2304 * 1024 * 2);
  p.w_outT = (u16*)take((size_t)4 * 1024 * 1024 * 2);
  p.w1T = (u16*)take((size_t)4 * 4096 * 1024 * 2);
  p.w2T = (u16*)take((size_t)4 * 4096 * 1024 * 2);
  p.pqt = (u16*)take((size_t)4 * 512 * 256 * 2);
  p.dft256 = (u16*)take((size_t)256 * 512 * 2);
  p.dft1024 = (u16*)take((size_t)1024 * 2048 * 2);
  p.ck_na = (u16*)take((size_t)2 * 4 * 512 * 256 * 2);
  p.cvt_na = (u16*)take((size_t)2 * 4 * 512 * 256 * 2);
  p.ck_diff = (u16*)take((size_t)2 * 4 * 512 * 256 * 2);
  p.cvt_diff = (u16*)take((size_t)2 * 4 * 512 * 256 * 2);
  p.ck_swa = (u16*)take((size_t)2 * 4 * 512 * 128 * 2);
  p.cvt_swa = (u16*)take((size_t)2 * 4 * 512 * 128 * 2);
  p.kfr = (u16*)take((size_t)10 * 192 * 2048 * 2);
  p.vfr = (u16*)take((size_t)10 * 192 * 2048 * 2);
  p.ropeD = (float*)take(1024 * 4);
  p.ropeS = (float*)take(2048 * 4);
  p.bar = (unsigned*)take(XB_ALL_WORDS * 4);
  if (off > ws_size) { fprintf(stderr, "workspace too small: need %zu have %zu\n", off, ws_size); return; }
  if (hipMemsetAsync(p.bar, 0, XB_ALL_WORDS * 4, stream) != hipSuccess) fprintf(stderr, "memset failed\n");
  void* args[] = {&p};
  hipError_t e = hipLaunchCooperativeKernel((const void*)mega, dim3(grid_blocks), dim3(256), args, LDS_BYTES, stream);
  if (e != hipSuccess) fprintf(stderr, "cooperative launch failed: %s (grid %d)\n", hipGetErrorString(e), grid_blocks);
}
```

```cpp
#include <hip/hip_runtime.h>
#include <hip/hip_cooperative_groups.h>
#include <stdint.h>
#include <stdio.h>
namespace cg = cooperative_groups;

typedef unsigned short u16;
typedef __attribute__((ext_vector_type(8))) short bf16x8;
typedef __attribute__((ext_vector_type(4))) float f32x4;
typedef __attribute__((ext_vector_type(4))) unsigned u32x4;
__device__ __forceinline__ void gload16(u32x4& dst, const void* ptr) {
  asm volatile("global_load_dwordx4 %0, %1, off" : "=v"(dst) : "v"(ptr) : "memory");
}

#define NTOK 6144
#define NPTOK 4096
#define INW 2304
#define LOG2E 1.4426950408889634f
#define LDS_BYTES 73728
#define LSTR 72

#define O_NAK 6291456
#define O_NAV 10485760
#define O_DK 14680064
#define O_DV 18874368
#define O_SK 23068672
#define O_SV 25165824

struct Params {
  const float *x_prompt, *x_sample, *c_na_k, *c_na_v, *c_diff_k, *c_diff_v, *c_swa_k, *c_swa_v, *c, *c_ctx;
  const float *w_ada, *b_ada, *norm1_g, *norm2_g, *w_in, *na_rpb, *lq1, *lk1, *lq2, *lk2, *subln_g, *w_fourier, *swa_sink;
  const float *w_out, *w1, *w2, *final_g;
  float* out;
  float* xres;
  float* mods;
  u16 *h, *z, *vt, *cat, *u, *uv, *w_inT, *w_outT, *w1T, *w2T, *pqt, *dft256, *dft1024;
  u16 *ck_na, *cvt_na, *ck_diff, *cvt_diff, *ck_swa, *cvt_swa;
  float *ropeD, *ropeS;
  u16 *kfr, *vfr;
  unsigned* bar;
  int use_cg_sync;
  int pad_;
};

__device__ __forceinline__ u16 f2bf(float f) {
  unsigned u = __float_as_uint(f);
  u += 0x7fffu + ((u >> 16) & 1u);
  return (u16)(u >> 16);
}
__device__ __forceinline__ int otid() { int t = threadIdx.x; asm volatile("" : "+v"(t)); return t; }
__device__ __forceinline__ float bf2f(u16 h) { return __uint_as_float(((unsigned)h) << 16); }
typedef __attribute__((ext_vector_type(2))) __bf16 hbf16x2;
typedef __attribute__((ext_vector_type(2))) float f32x2;
__device__ __forceinline__ unsigned pack2(float a, float b) {
  f32x2 v = {a, b};
  union { hbf16x2 h; unsigned u; } x;
  x.h = __builtin_convertvector(v, hbf16x2);
  return x.u;
}

__device__ __forceinline__ int kfrag_off(int kk, int d) {
  const int t = (kk >> 2) & 1, r = ((kk >> 3) << 2) | (kk & 3), dc = d >> 5, g = (d >> 3) & 3;
  return ((t * 2 + dc) * 64 + g * 16 + r) * 8 + (d & 7);
}
__device__ __forceinline__ int vfrag_off(int kk, int dv) {
  return (((dv >> 4) * 64) + (kk >> 3) * 16 + (dv & 15)) * 8 + (kk & 7);
}

#define XB_TMO      128
#define XB_XCNT(j)  (256  + 64 * (j))
#define XB_XSUB(j)  (1280 + 64 * (j))
#define XB_XGEN(j)  (2304 + 64 * (j))
#define XB_TOP      3328
#define XB_TOPGEN   3392
#define XCD_BAR_WORDS 3456
#define XB_SPIN_CAP (1u << 22)
#define LAS __attribute__((address_space(3)))
__device__ __forceinline__ unsigned xb_ld(unsigned* p)              { return __hip_atomic_load(p, __ATOMIC_RELAXED, __HIP_MEMORY_SCOPE_AGENT); }
__device__ __forceinline__ unsigned xb_add(unsigned* p, unsigned v) { return __hip_atomic_fetch_add(p, v, __ATOMIC_RELAXED, __HIP_MEMORY_SCOPE_AGENT); }
__device__ __forceinline__ unsigned xb_xcc_id() { return (unsigned)__builtin_amdgcn_s_getreg((3 << 11) | 20) & 0xFu; }
#define XB_SPIN(cond, bar) do { unsigned _sp = 0; while (cond) { __builtin_amdgcn_s_sleep(1); \
    if ((++_sp & 255u) == 0u) { if (xb_ld(&(bar)[XB_TMO])) break; if (_sp > XB_SPIN_CAP) { atomicAdd(&(bar)[XB_TMO], 1u); break; } } } } while (0)
#define XB_LSUB(j)  (XCD_BAR_WORDS + 12 * 64 + 64 * (j))
#define XB_LGEN(j)  (XCD_BAR_WORDS + 12 * 64 + 64 * (16 + (j)))
#define XB_ALL_WORDS (XCD_BAR_WORDS + 12 * 64 + 32 * 64)
struct XcdBarrier { unsigned* bar; unsigned x; volatile LAS unsigned* st; };
__device__ __forceinline__ XcdBarrier xcd_barrier_post(unsigned* bar, volatile LAS unsigned* st) {
  XcdBarrier b; b.bar = bar; b.x = xb_xcc_id(); b.st = st;
  if (threadIdx.x == 0) st[4] = xb_add(&bar[XB_XCNT(b.x)], 1u);
  return b;
}
__device__ __forceinline__ void xcd_barrier_complete(unsigned* bar, unsigned x, unsigned& nloc, unsigned& nx) {
  const unsigned G = gridDim.x * gridDim.y * gridDim.z;
  unsigned sum, cnt, mine, sp = 0u;
  for (;;) {
    sum = 0u; cnt = 0u; mine = 0u;
#pragma unroll
    for (unsigned j = 0; j < 16; ++j) { const unsigned c = xb_ld(&bar[XB_XCNT(j)]); sum += c; cnt += (c > 0u) ? 1u : 0u; mine = (j == x) ? c : mine; }
    if (sum == G) break;
    __builtin_amdgcn_s_sleep(1);
    if ((++sp & 255u) == 0u) { if (xb_ld(&bar[XB_TMO])) break; if (sp > XB_SPIN_CAP) { atomicAdd(&bar[XB_TMO], 1u); break; } }
  }
  nloc = mine > 0u ? mine : 1u; nx = cnt > 0u ? cnt : 1u;
}
__device__ __forceinline__ unsigned xcd_topology(unsigned* bar) {
  const unsigned G = gridDim.x * gridDim.y * gridDim.z;
  unsigned sum8 = 0u, all = 1u, all64 = 1u;
#pragma unroll
  for (unsigned j = 0; j < 8; ++j) { const unsigned c = xb_ld(&bar[XB_XCNT(j)]); sum8 += c; all &= (c > 0u) ? 1u : 0u; all64 &= (c == 64u) ? 1u : 0u; }
  const unsigned ok = (all && sum8 == G) ? 1u : 0u;
  return ok | ((ok && all64) ? 2u : 0u);
}
__device__ __forceinline__ void xcd_barrier(const XcdBarrier& b) {
  asm volatile("s_waitcnt vmcnt(0)" ::: "memory");
  __syncthreads();
  if (threadIdx.x == 0) {
    unsigned* bar = b.bar;
    __builtin_amdgcn_s_waitcnt(0);
    unsigned nloc = b.st[0], nx = b.st[1];
    if (nloc == 0u) { xcd_barrier_complete(bar, b.x, nloc, nx); b.st[0] = nloc; b.st[1] = nx; b.st[5] = xcd_topology(bar); }
    const unsigned old = xb_add(&bar[XB_XSUB(b.x)], 1u);
    const unsigned gen = old / nloc;
    if (old + 1u == (gen + 1u) * nloc) {
      __builtin_amdgcn_fence(__ATOMIC_RELEASE, "agent");
      asm volatile("s_waitcnt vmcnt(0)" ::: "memory");
      const unsigned og = xb_add(&bar[XB_TOP], 1u);
      const unsigned tg = og / nx;
      if (og + 1u == (tg + 1u) * nx) xb_add(&bar[XB_TOPGEN], 1u);
      else XB_SPIN(xb_ld(&bar[XB_TOPGEN]) == tg, bar);
      __builtin_amdgcn_fence(__ATOMIC_ACQUIRE, "agent");
      xb_add(&bar[XB_XGEN(b.x)], 1u);
      asm volatile("s_waitcnt vmcnt(0)" ::: "memory");
    } else {
      XB_SPIN(xb_ld(&bar[XB_XGEN(b.x)]) == gen, bar);
      __builtin_amdgcn_fence(__ATOMIC_ACQUIRE, "agent");
      asm volatile("s_waitcnt vmcnt(0)" ::: "memory");
    }
  }
  __syncthreads();
}

__device__ __forceinline__ void xcd_barrier_local(const XcdBarrier& b) {
  asm volatile("s_waitcnt vmcnt(0)" ::: "memory");
  __syncthreads();
  if (threadIdx.x == 0) {
    unsigned* bar = b.bar;
    __builtin_amdgcn_s_waitcnt(0);
    const unsigned nloc = b.st[0];
    const unsigned old = xb_add(&bar[XB_LSUB(b.x)], 1u);
    const unsigned gen = old / nloc;
    if (old + 1u == (gen + 1u) * nloc) xb_add(&bar[XB_LGEN(b.x)], 1u);
    else XB_SPIN(xb_ld(&bar[XB_LGEN(b.x)]) == gen, bar);
    __builtin_amdgcn_fence(__ATOMIC_ACQUIRE, "agent");
    asm volatile("s_waitcnt vmcnt(0)" ::: "memory");
  }
  __syncthreads();
}

__device__ __forceinline__ void transpose_tile(const float* __restrict__ src, int lds_, u16* __restrict__ dst, int ldd,
                                               int k0, int n0, float* sm, bool fragv = false) {
  const int tid = otid();
  const int c4 = (tid & 15) * 4, r0 = tid >> 4;
  float4 v[8];
#pragma unroll
  for (int i = 0; i < 8; ++i) { const f32x4 t = __builtin_nontemporal_load((const f32x4*)(src + (size_t)(k0 + r0 + 16 * i) * lds_ + n0 + c4)); v[i] = make_float4(t[0], t[1], t[2], t[3]); }
#pragma unroll
  for (int i = 0; i < 8; ++i) {
    const int k = r0 + 16 * i;
    sm[(c4 + 0) * 129 + k] = v[i].x; sm[(c4 + 1) * 129 + k] = v[i].y; sm[(c4 + 2) * 129 + k] = v[i].z; sm[(c4 + 3) * 129 + k] = v[i].w;
  }
  __syncthreads();
  const int k8 = (tid & 15) * 8, nn = tid >> 4;
#pragma unroll
  for (int i = 0; i < 4; ++i) {
    const int n = nn + 16 * i;
    const float* row = sm + n * 129 + k8;
    uint4 w;
    w.x = pack2(row[0], row[1]); w.y = pack2(row[2], row[3]); w.z = pack2(row[4], row[5]); w.w = pack2(row[6], row[7]);
    if (fragv) {
      const int col = n0 + n, pos = k0 + k8;
      *(uint4*)(dst + ((size_t)((col >> 6) * 16 + (pos >> 5))) * 2048 + vfrag_off(pos & 31, col & 63)) = w;
    } else {
      *(uint4*)(dst + (size_t)(n0 + n) * ldd + k0 + k8) = w;
    }
  }
  __syncthreads();
}

__device__ __forceinline__ void adaln_item(const Params& p, int it, float* sm) {
  const int l = it / 192, c0 = (it % 192) * 32;
  float* ssil = sm;
  float* red = sm + 3072;
  const int tid = otid();
  for (int i = tid; i < 3072; i += 256) {
    const int cnd = i >> 10, k = i & 1023;
    const float v = cnd == 0 ? p.c_ctx[k] : p.c[(cnd - 1) * 1024 + k];
    ssil[i] = v / (1.f + expf(-v));
  }
  __syncthreads();
  const int cg4 = (tid & 7) * 4, ks = tid >> 3;
  const float* w = p.w_ada + (size_t)l * 1024 * 6144 + c0 + cg4;
  float a0[4] = {0.f, 0.f, 0.f, 0.f}, a1[4] = {0.f, 0.f, 0.f, 0.f}, a2[4] = {0.f, 0.f, 0.f, 0.f};
#pragma unroll 16
  for (int kk = 0; kk < 32; ++kk) {
    const int k = kk * 32 + ks;
    const f32x4 tv = __builtin_nontemporal_load((const f32x4*)(w + (size_t)k * 6144));
    const float4 v = make_float4(tv[0], tv[1], tv[2], tv[3]);
    const float s0 = ssil[k], s1 = ssil[1024 + k], s2 = ssil[2048 + k];
    a0[0] += s0 * v.x; a0[1] += s0 * v.y; a0[2] += s0 * v.z; a0[3] += s0 * v.w;
    a1[0] += s1 * v.x; a1[1] += s1 * v.y; a1[2] += s1 * v.z; a1[3] += s1 * v.w;
    a2[0] += s2 * v.x; a2[1] += s2 * v.y; a2[2] += s2 * v.z; a2[3] += s2 * v.w;
  }
#pragma unroll
  for (int j = 0; j < 4; ++j) {
    red[(ks * 3 + 0) * 32 + cg4 + j] = a0[j];
    red[(ks * 3 + 1) * 32 + cg4 + j] = a1[j];
    red[(ks * 3 + 2) * 32 + cg4 + j] = a2[j];
  }
  __syncthreads();
  if (tid < 96) {
    const int cnd = tid >> 5, j = tid & 31;
    float s = p.b_ada[l * 6144 + c0 + j];
    for (int q = 0; q < 32; ++q) s += red[(q * 3 + cnd) * 32 + j];
    p.mods[(l * 3 + cnd) * 6144 + c0 + j] = s;
  }
  __syncthreads();
}

__device__ __forceinline__ void cvt_item(const float* __restrict__ src, u16* __restrict__ dst, int it, int W) {
  const int w8 = W >> 3;
#pragma unroll
  for (int i = 0; i < 4; ++i) {
    const int u = it * 1024 + i * 256 + otid();
    const int d8 = u % w8, pos = (u / w8) & 511, bl = u / (w8 * 512);
    const float* sp = src + ((size_t)(bl * 512 + pos) * W + d8 * 8);
    const f32x4 t0 = __builtin_nontemporal_load((const f32x4*)sp), t1 = __builtin_nontemporal_load((const f32x4*)(sp + 4));
    const float4 v0 = make_float4(t0[0], t0[1], t0[2], t0[3]), v1 = make_float4(t1[0], t1[1], t1[2], t1[3]);
    uint4 w; w.x = pack2(v0.x, v0.y); w.y = pack2(v0.z, v0.w); w.z = pack2(v1.x, v1.y); w.w = pack2(v1.z, v1.w);
    const int h = d8 >> 3, d = (d8 & 7) * 8;
    *(uint4*)(dst + ((size_t)((bl * (W >> 6) + h) * 16 + (pos >> 5))) * 2048 + kfrag_off(pos & 31, d)) = w;
  }
}

__device__ __forceinline__ void pq_item(const Params& p, int it, float* sm) {
  const int cq = it & 3, it2 = it >> 2;
  const int l = it2 >> 3, which = (it2 >> 2) & 1, g = it2 & 3;
  const int n = otid();
  if (n < 64) sm[n] = which ? sinpif(2.f * (float)n / 64.f) : cospif(2.f * (float)n / 64.f);
  __syncthreads();
  float w[64];
#pragma unroll
  for (int m = 0; m < 64; ++m) w[m] = p.w_fourier[(size_t)l * 65536 + (g * 64 + m) * 256 + n];
  u16* dst = p.pqt + (size_t)l * 512 * 256 + (size_t)(which * 256 + n) * 256 + g * 64;
  for (int c = cq * 16; c < cq * 16 + 16; ++c) {
    float s = 0.f;
#pragma unroll
    for (int m = 0; m < 64; ++m) s += sm[(c * m) & 63] * w[m];
    dst[c] = f2bf(s);
  }
  __syncthreads();
}

__device__ __forceinline__ void dft_item(u16* dst, int L, int it) {
  const int twoL = 2 * L;
  for (int e = otid(); e < 8192; e += 256) {
    const int idx = it * 8192 + e;
    const int k = idx / twoL, j = idx % twoL;
    const int jj = j & (L - 1);
    const int ph = (k * jj) & (L - 1);
    const float a = 2.f * (float)ph / (float)L;
    const float v = (j >= L) ? -sinpif(a) : cospif(a);
    dst[idx] = f2bf(v);
  }
}

#define P0_WT 288
#define P0_ADA 768
#define P0_XC 0
#define P0_CK 320
#define P0_CVT 320
#define P0_PQ 128
#define P0_DFT 272
#define P0_ITEMS (P0_ADA + P0_WT + P0_XC + P0_CK + P0_CVT + P0_PQ + P0_DFT + 1)

__device__ void wt_item(const Params& p, int l, int r, float* sm) {
  if (r < 288) { transpose_tile(p.w_in + (size_t)l * 1024 * 2304, 2304, p.w_inT + (size_t)l * 2304 * 1024, 1024, (r / 36) * 128, (r % 36) * 64, sm); return; }
  r -= 288;
  if (r < 128) { transpose_tile(p.w_out + (size_t)l * 1024 * 1024, 1024, p.w_outT + (size_t)l * 1024 * 1024, 1024, (r / 16) * 128, (r % 16) * 64, sm); return; }
  r -= 128;
  if (r < 512) { transpose_tile(p.w1 + (size_t)l * 1024 * 4096, 4096, p.w1T + (size_t)l * 4096 * 1024, 1024, (r / 64) * 128, (r % 64) * 64, sm); return; }
  r -= 512;
  transpose_tile(p.w2 + (size_t)l * 4096 * 1024, 1024, p.w2T + (size_t)l * 1024 * 4096, 4096, (r / 16) * 128, (r % 16) * 64, sm);
}

__device__ void p0_item(const Params& p, int it, unsigned char* smem) {
  float* sm = (float*)smem;
  if (it < P0_ADA) { adaln_item(p, it, sm); return; }
  it -= P0_ADA;
  if (it < P0_WT) { wt_item(p, 0, it, sm); return; }
  it -= P0_WT;
  if (it < P0_XC) {
    const int row0 = it * 16;
    const float* src = row0 < NPTOK ? p.x_prompt + (size_t)row0 * 1024 : p.x_sample + (size_t)(row0 - NPTOK) * 1024;
    float* dst = p.xres + (size_t)row0 * 1024;
#pragma unroll
    for (int i = 0; i < 16; ++i) {
      const int o = (i * 256 + otid()) * 4;
      *(float4*)(dst + o) = *(const float4*)(src + o);
    }
    return;
  }
  it -= P0_XC;
  if (it < P0_CK) {
    if (it < 128) { cvt_item(p.c_na_k, p.ck_na, it, 256); return; }
    it -= 128;
    if (it < 128) { cvt_item(p.c_diff_k, p.ck_diff, it, 256); return; }
    it -= 128;
    cvt_item(p.c_swa_k, p.ck_swa, it, 128);
    return;
  }
  it -= P0_CK;
  if (it < P0_CVT) {
    if (it < 128) { const int bl = it >> 4, r = it & 15; transpose_tile(p.c_na_v + (size_t)bl * 512 * 256, 256, p.cvt_na + (size_t)bl * 256 * 512, 512, (r >> 2) * 128, (r & 3) * 64, sm, true); return; }
    it -= 128;
    if (it < 128) { const int bl = it >> 4, r = it & 15; transpose_tile(p.c_diff_v + (size_t)bl * 512 * 256, 256, p.cvt_diff + (size_t)bl * 256 * 512, 512, (r >> 2) * 128, (r & 3) * 64, sm, true); return; }
    it -= 128;
    { const int bl = it >> 3, r = it & 7; transpose_tile(p.c_swa_v + (size_t)bl * 512 * 128, 128, p.cvt_swa + (size_t)bl * 128 * 512, 512, (r >> 1) * 128, (r & 1) * 64, sm, true); return; }
  }
  it -= P0_CVT;
  if (it < P0_PQ) { pq_item(p, it, sm); return; }
  it -= P0_PQ;
  if (it < 16) { dft_item(p.dft256, 256, it); return; }
  it -= 16;
  if (it < 256) { dft_item(p.dft1024, 1024, it); return; }
  for (int e = otid(); e < 512 + 1024; e += 256) {
    const bool isD = e < 512;
    const int ee = isD ? e : e - 512;
    const int nf = isD ? 8 : 16;
    const int pos = ee / nf, fi = ee % nf;
    const float inv = exp2f(-(float)fi * (13.287712379549449f / (float)nf));
    float tt = (float)pos * inv * 0.15915494309189535f;
    tt -= rintf(tt);
    float sn, cs;
    sincospif(2.f * tt, &sn, &cs);
    if (isD) { p.ropeD[ee] = cs; p.ropeD[512 + ee] = sn; }
    else { p.ropeS[ee] = cs; p.ropeS[1024 + ee] = sn; }
  }
}

__device__ __forceinline__ void norm_item(const Params& p, int l, int which, int it) {
  const int lane = otid() & 63, wave = otid() >> 6;
  const int row0 = it * 16 + wave * 4;
  const float* xsrc = (which == 0 && l == 0) ? (row0 < NPTOK ? p.x_prompt + (size_t)row0 * 1024 : p.x_sample + (size_t)(row0 - NPTOK) * 1024)
                                             : p.xres + (size_t)row0 * 1024;
  float4 v[4][4];
#pragma unroll
  for (int j = 0; j < 4; ++j)
#pragma unroll
    for (int k = 0; k < 4; ++k) v[j][k] = *(const float4*)(xsrc + (size_t)j * 1024 + (k * 64 + lane) * 4);
  float rs[4];
#pragma unroll
  for (int j = 0; j < 4; ++j) {
    float ss = 0.f;
#pragma unroll
    for (int k = 0; k < 4; ++k) ss += v[j][k].x * v[j][k].x + v[j][k].y * v[j][k].y + v[j][k].z * v[j][k].z + v[j][k].w * v[j][k].w;
#pragma unroll
    for (int o = 32; o >= 1; o >>= 1) ss += __shfl_xor(ss, o);
    rs[j] = rsqrtf(ss * (1.f / 1024.f) + 1e-6f);
  }
  if (which < 2) {
    const int cond = row0 < NPTOK ? 0 : 1 + ((row0 - NPTOK) >> 10);
    const float* gp = (which == 0 ? p.norm1_g : p.norm2_g) + l * 1024;
    const float* shp = p.mods + (size_t)(l * 3 + cond) * 6144 + (which * 3 + 0) * 1024;
    const float* scp = shp + 1024;
#pragma unroll
    for (int k = 0; k < 4; ++k) {
      const int col = (k * 64 + lane) * 4;
      const float4 gg = *(const float4*)(gp + col);
      const float4 sh = *(const float4*)(shp + col);
      const float4 sc = *(const float4*)(scp + col);
      const float mx = gg.x * (1.f + sc.x), my = gg.y * (1.f + sc.y), mz = gg.z * (1.f + sc.z), mw = gg.w * (1.f + sc.w);
#pragma unroll
      for (int j = 0; j < 4; ++j) {
        uint2 w;
        w.x = pack2(v[j][k].x * rs[j] * mx + sh.x, v[j][k].y * rs[j] * my + sh.y);
        w.y = pack2(v[j][k].z * rs[j] * mz + sh.z, v[j][k].w * rs[j] * mw + sh.w);
        *(uint2*)(p.h + (size_t)(row0 + j) * 1024 + col) = w;
      }
    }
  } else {
#pragma unroll
    for (int k = 0; k < 4; ++k) {
      const int col = (k * 64 + lane) * 4;
      const float4 gg = *(const float4*)(p.final_g + col);
#pragma unroll
      for (int j = 0; j < 4; ++j) {
        float4 o;
        o.x = v[j][k].x * rs[j] * gg.x; o.y = v[j][k].y * rs[j] * gg.y; o.z = v[j][k].z * rs[j] * gg.z; o.w = v[j][k].w * rs[j] * gg.w;
        { f32x4 ov = {o.x, o.y, o.z, o.w}; __builtin_nontemporal_store(ov, (f32x4*)(p.out + (size_t)(row0 + j) * 1024 + col)); }
      }
    }
  }
}

template <bool ZERO, int YT>
__device__ __forceinline__ void gemm_main_t(const u16* __restrict__ X, int ldx, const u16* __restrict__ Y, int ldy, int K,
                                          u16* smem, f32x4 (&acc)[4][YT]) {
  const int tid = otid(), lane = tid & 63, wave = tid >> 6, wx = wave & 1, wy = wave >> 1, r = lane & 15, g = lane >> 4;
  u16* sX = smem;
  u16* sY = smem + 2 * 128 * 64;
  const int lrow = tid >> 3, lkc = tid & 7;
  const int gsw = (lkc ^ (lrow & 7)) * 8;
  const u16* gx = X + (size_t)lrow * ldx + gsw;
  const u16* gy = Y + (size_t)lrow * ldy + gsw;
  u16* lx = sX + tid * 8;
  u16* ly = sY + tid * 8;
#define GEMM_STAGE(buf, kt_)                                                                                                      \
  {                                                                                                                               \
    _Pragma("unroll") for (int i = 0; i < 4; ++i)                                                                                 \
      __builtin_amdgcn_global_load_lds((const unsigned*)(gx + (size_t)(32 * i) * ldx + (kt_) * 64),                               \
                                       (unsigned*)(lx + (buf) * 8192 + i * 2048), 16, 0, 0);                                      \
    _Pragma("unroll") for (int i = 0; i < YT; ++i)                                                                                \
      __builtin_amdgcn_global_load_lds((const unsigned*)(gy + (size_t)(32 * i) * ldy + (kt_) * 64),                               \
                                       (unsigned*)(ly + (buf) * 8192 + i * 2048), 16, 0, 0);                                      \
  }
  GEMM_STAGE(0, 0);
  if (ZERO) {
#pragma unroll
    for (int a = 0; a < 4; ++a)
#pragma unroll
      for (int b = 0; b < YT; ++b) acc[a][b] = (f32x4){0.f, 0.f, 0.f, 0.f};
  }
  const int nk = K >> 6;
  const int sw = r & 7;
  const u16* cx0 = sX + (wx * 64 + r) * 64;
  const u16* cy0 = sY + (wy * (16 * YT) + r) * 64;
  __syncthreads();
#define GEMM_COMPUTE(cur)                                                                            \
  {                                                                                                  \
    const u16* cx = cx0 + (cur) * 8192;                                                              \
    const u16* cy = cy0 + (cur) * 8192;                                                              \
    const int pc0 = (g ^ sw) * 8, pc1 = ((4 + g) ^ sw) * 8;                                          \
    bf16x8 a0[4], b0[YT], a1[4], b1[YT];                                                             \
    _Pragma("unroll") for (int i = 0; i < 4; ++i) a0[i] = *(const bf16x8*)(cx + i * 16 * 64 + pc0);  \
    _Pragma("unroll") for (int i = 0; i < YT; ++i) b0[i] = *(const bf16x8*)(cy + i * 16 * 64 + pc0); \
    _Pragma("unroll") for (int i = 0; i < 4; ++i) a1[i] = *(const bf16x8*)(cx + i * 16 * 64 + pc1);  \
    _Pragma("unroll") for (int i = 0; i < YT; ++i) b1[i] = *(const bf16x8*)(cy + i * 16 * 64 + pc1); \
    __builtin_amdgcn_s_setprio(1);                                                                   \
    _Pragma("unroll") for (int xi = 0; xi < 4; ++xi)                                                 \
      _Pragma("unroll") for (int yi = 0; yi < YT; ++yi)                                              \
        acc[xi][yi] = __builtin_amdgcn_mfma_f32_16x16x32_bf16(a0[xi], b0[yi], acc[xi][yi], 0, 0, 0); \
    _Pragma("unroll") for (int xi = 0; xi < 4; ++xi)                                                 \
      _Pragma("unroll") for (int yi = 0; yi < YT; ++yi)                                              \
        acc[xi][yi] = __builtin_amdgcn_mfma_f32_16x16x32_bf16(a1[xi], b1[yi], acc[xi][yi], 0, 0, 0); \
    __builtin_amdgcn_s_setprio(0);                                                                   \
  }
#pragma unroll 1
  for (int kt = 0; kt < nk - 1; ++kt) {
    const int cur = kt & 1;
    GEMM_STAGE(cur ^ 1, kt + 1);
    GEMM_COMPUTE(cur);
    __syncthreads();
  }
  GEMM_COMPUTE((nk - 1) & 1);
  __syncthreads();
#undef GEMM_COMPUTE
#undef GEMM_STAGE
}

#ifndef REP_GEMM
#define REP_GEMM 0
#endif
#ifndef REP_MIX
#define REP_MIX 0
#endif
#ifndef REP_SYNC
#define REP_SYNC 0
#endif
#ifndef REP_P0
#define REP_P0 0
#endif
template <int YT>
__device__ __forceinline__ void gemm_main(const u16* __restrict__ X, int ldx, const u16* __restrict__ Y, int ldy, int K,
                                          u16* smem, f32x4 (&acc)[4][YT]) {
  gemm_main_t<true, YT>(X, ldx, Y, ldy, K, smem, acc);
#if REP_GEMM
  gemm_main_t<false, YT>(X, ldx, Y, ldy, K, smem, acc);
#pragma unroll
  for (int a = 0; a < 4; ++a)
#pragma unroll
    for (int b = 0; b < YT; ++b) acc[a][b] *= 0.5f;
#endif
}

__device__ __forceinline__ bool tile_map(int j, int ntx, int& tx, int& ty, int nty = 48) {
  const int nblk = gridDim.x, bid = blockIdx.x;
  if (nblk == 512) {
    const int per = nty >> 3, hp = per >> 1;
    const int rank = bid >> 3, q = (rank & 31) + j * 32, mem = rank >> 5;
    if (q >= hp * ntx) return false;
    tx = q / hp; ty = per * (bid & 7) + 2 * (q % hp) + mem;
    return true;
  } else {
    const int it = bid + j * nblk;
    if (it >= nty * ntx) return false;
    tx = it / nty; ty = it % nty;
    return true;
  }
}

__device__ void gin_tile(const Params& p, int l, int tx, int ty, u16* smem) {
  const int n0 = tx * 128, m0 = ty * 128;
  f32x4 acc[4][4];
  gemm_main<4>(p.w_inT + (size_t)l * 2304 * 1024 + (size_t)n0 * 1024, 1024, p.h + (size_t)m0 * 1024, 1024, 1024, smem, acc);
  const int lane = otid() & 63, wave = otid() >> 6, wx = wave & 1, wy = wave >> 1, r = lane & 15, g = lane >> 4;
  const int nw = n0 + wx * 64;
  const bool isS = m0 >= NPTOK;
  int ropeMode = 0;
  if (isS) {
    if (nw >= 768 && nw < 1280) ropeMode = 1;
    else if (nw >= 1792 && nw < 2176) ropeMode = 2;
  }
  float* okv = nullptr; int okv_w = 0, okv_c = 0;
  if (!isS) {
    if (nw >= 256 && nw < 512) { okv = p.out + O_NAK; okv_w = 256; okv_c = nw - 256; }
    else if (nw >= 512 && nw < 768) { okv = p.out + O_NAV; okv_w = 256; okv_c = nw - 512; }
    else if (nw >= 1024 && nw < 1280) { okv = p.out + O_DK; okv_w = 256; okv_c = nw - 1024; }
    else if (nw >= 1280 && nw < 1536) { okv = p.out + O_DV; okv_w = 256; okv_c = nw - 1280; }
    else if (nw >= 2048 && nw < 2176) { okv = p.out + O_SK; okv_w = 128; okv_c = nw - 2048; }
    else if (nw >= 2176) { okv = p.out + O_SV; okv_w = 128; okv_c = nw - 2176; }
  }
  int khh = -1;
  if (nw >= 256 && nw < 512) khh = (nw - 256) >> 6;
  else if (nw >= 1024 && nw < 1280) khh = 4 + ((nw - 1024) >> 6);
  else if (nw >= 2048 && nw < 2176) khh = 8 + ((nw - 2048) >> 6);
  int vrow = -1;
  if (nw >= 512 && nw < 768) vrow = nw - 512;
  else if (nw >= 1280 && nw < 1536) vrow = 256 + nw - 1280;
  else if (nw >= 2176) vrow = 512 + nw - 2176;
#pragma unroll
  for (int yi = 0; yi < 4; ++yi) {
    const int m = m0 + wy * 64 + yi * 16 + r;
    const int t = (m - NPTOK) & 1023;
    const int prow = t >> 6, pcol = t & 63;
#pragma unroll
    for (int xi = 0; xi < 4; ++xi) {
      f32x4 v = acc[xi][yi];
      if (ropeMode == 1) {
        const int pos = (xi & 1) ? pcol : prow;
        const float4 cs = *(const float4*)(p.ropeD + pos * 8 + 4 * (g & 1));
        const float4 sn = *(const float4*)(p.ropeD + 512 + pos * 8 + 4 * (g & 1));
        const float sg = (g >= 2) ? 1.f : -1.f;
        const float o0 = __shfl_xor(v[0], 32), o1 = __shfl_xor(v[1], 32), o2 = __shfl_xor(v[2], 32), o3 = __shfl_xor(v[3], 32);
        v[0] = v[0] * cs.x + sg * o0 * sn.x; v[1] = v[1] * cs.y + sg * o1 * sn.y;
        v[2] = v[2] * cs.z + sg * o2 * sn.z; v[3] = v[3] * cs.w + sg * o3 * sn.w;
      } else if (ropeMode == 2) {
        const int pos = (xi >> 1) ? pcol : prow;
        const float4 cs = *(const float4*)(p.ropeS + pos * 16 + 4 * g);
        const float4 sn = *(const float4*)(p.ropeS + 1024 + pos * 16 + 4 * g);
        const f32x4 o = acc[xi ^ 1][yi];
        const float sg = (xi & 1) ? 1.f : -1.f;
        v[0] = v[0] * cs.x + sg * o[0] * sn.x; v[1] = v[1] * cs.y + sg * o[1] * sn.y;
        v[2] = v[2] * cs.z + sg * o[2] * sn.z; v[3] = v[3] * cs.w + sg * o[3] * sn.w;
      }
      const int nloc = xi * 16 + 4 * g;
      if (okv) {
        const int b = m >> 8, pos = m & 255;
        float4 o4; o4.x = v[0]; o4.y = v[1]; o4.z = v[2]; o4.w = v[3];
        __builtin_nontemporal_store(v, (f32x4*)(okv + ((size_t)((b * 4 + l) * 256 + pos)) * okv_w + okv_c + nloc));
      }
      if (vrow >= 0) {
        u16* vb = p.vfr + ((size_t)((vrow >> 6) * 192 + (m >> 5))) * 2048;
#pragma unroll
        for (int i = 0; i < 4; ++i) vb[vfrag_off(m & 31, nloc + i)] = f2bf(v[i]);
      } else if (khh >= 0) {
        uint2 w; w.x = pack2(v[0], v[1]); w.y = pack2(v[2], v[3]);
        *(uint2*)(p.kfr + ((size_t)(khh * 192 + (m >> 5))) * 2048 + kfrag_off(m & 31, nloc)) = w;
      } else {
        uint2 w; w.x = pack2(v[0], v[1]); w.y = pack2(v[2], v[3]);
        *(uint2*)(p.z + (size_t)m * INW + nw + nloc) = w;
      }
    }
  }
}

__device__ void res_tile(const Params& p, int l, int tx, int ty, const u16* A, const u16* WT, int K, int gi, u16* smem, bool first = false) {
  const int n0 = tx * 128, m0 = ty * 96;
  f32x4 acc[4][3];
  gemm_main<3>(WT + (size_t)n0 * K, K, A + (size_t)m0 * K, K, K, smem, acc);
  const int lane = otid() & 63, wave = otid() >> 6, wx = wave & 1, wy = wave >> 1, r = lane & 15, g = lane >> 4;
#pragma unroll
  for (int yi = 0; yi < 3; ++yi) {
    const int m = m0 + wy * 48 + yi * 16 + r;
    const int cond = m < NPTOK ? 0 : 1 + ((m - NPTOK) >> 10);
    const float* gate = p.mods + (size_t)(l * 3 + cond) * 6144 + gi * 1024;
    float* xrow = p.xres + (size_t)m * 1024;
    const float* xin = first ? (m < NPTOK ? p.x_prompt + (size_t)m * 1024 : p.x_sample + (size_t)(m - NPTOK) * 1024) : xrow;
    float4 xv[4], gt[4];
#pragma unroll
    for (int xi = 0; xi < 4; ++xi) {
      const int n = n0 + wx * 64 + xi * 16 + 4 * g;
      xv[xi] = *(const float4*)(xin + n);
      gt[xi] = *(const float4*)(gate + n);
    }
#pragma unroll
    for (int xi = 0; xi < 4; ++xi) {
      const int n = n0 + wx * 64 + xi * 16 + 4 * g;
      const f32x4 v = acc[xi][yi];
      float4 o = xv[xi];
      o.x += gt[xi].x * v[0]; o.y += gt[xi].y * v[1]; o.z += gt[xi].z * v[2]; o.w += gt[xi].w * v[3];
      *(float4*)(xrow + n) = o;
    }
  }
}

__device__ void m1_tile(const Params& p, int l, int tx, int ty, u16* smem) {
  const int n0 = tx * 128, m0 = ty * 128;
  f32x4 acc[4][4];
  gemm_main<4>(p.w1T + (size_t)l * 4096 * 1024 + (size_t)n0 * 1024, 1024, p.h + (size_t)m0 * 1024, 1024, 1024, smem, acc);
  const int lane = otid() & 63, wave = otid() >> 6, wx = wave & 1, wy = wave >> 1, r = lane & 15, g = lane >> 4;
#pragma unroll
  for (int xi = 0; xi < 4; ++xi) {
    const int n = n0 + wx * 64 + xi * 16 + 4 * g;
#pragma unroll
    for (int yi = 0; yi < 4; ++yi) {
      const int m = m0 + wy * 64 + yi * 16 + r;
      const f32x4 v = acc[xi][yi];
      float a0 = fmaxf(v[0], 0.f), a1 = fmaxf(v[1], 0.f), a2 = fmaxf(v[2], 0.f), a3 = fmaxf(v[3], 0.f);
      uint2 w; w.x = pack2(a0 * a0, a1 * a1); w.y = pack2(a2 * a2, a3 * a3);
      *(uint2*)(p.u + (size_t)m * 4096 + n) = w;
    }
  }
}

__device__ void f1_tile(const Params& p, int l, int it, u16* smem) {
  const int tx = it % 48, ty = it / 48;
  const int x0 = tx * 128, y0 = ty * 128;
  f32x4 acc[4][4];
  gemm_main<4>(p.z + (size_t)x0 * INW + 1536, INW, p.pqt + (size_t)l * 512 * 256 + (size_t)y0 * 256, 256, 256, smem, acc);
  const int lane = otid() & 63, wave = otid() >> 6, wx = wave & 1, wy = wave >> 1, r = lane & 15, g = lane >> 4;
#pragma unroll
  for (int yi = 0; yi < 4; ++yi) {
    const int y = y0 + wy * 64 + yi * 16 + r;
    const int col = y & 255, which = y >> 8;
#pragma unroll
    for (int xi = 0; xi < 4; ++xi) {
      const int tok = x0 + wx * 64 + xi * 16 + 4 * g;
      size_t addr;
      if (tok < NPTOK) {
        const int b = tok >> 8, pos = tok & 255;
        addr = (size_t)b * (256 * 512) + (size_t)col * 512 + which * 256 + pos;
      } else {
        const int b = (tok - NPTOK) >> 10, pos = (tok - NPTOK) & 1023;
        addr = (size_t)16 * 256 * 512 + (size_t)b * (256 * 2048) + (size_t)col * 2048 + which * 1024 + pos;
      }
      const f32x4 v = acc[xi][yi];
      uint2 w; w.x = pack2(v[0], v[1]); w.y = pack2(v[2], v[3]);
      *(uint2*)(p.uv + addr) = w;
    }
  }
  asm volatile("s_waitcnt vmcnt(0)" ::: "memory");
  __syncthreads();
  if (threadIdx.x == 0) {
    __builtin_amdgcn_fence(__ATOMIC_RELEASE, "agent");
    asm volatile("s_waitcnt vmcnt(0)" ::: "memory");
    xb_add(p.bar + XCD_BAR_WORDS + (8 + l) * 64, 1u);
  }
}

__device__ void f2_tile(const Params& p, int l, int it, u16* smem) {
  if (threadIdx.x == 0) {
    unsigned* c = p.bar + XCD_BAR_WORDS + (8 + l) * 64;
    unsigned sp = 0;
    while (xb_ld(c) < 192u) { __builtin_amdgcn_s_sleep(2); if (++sp > (1u << 24)) break; }
    __builtin_amdgcn_fence(__ATOMIC_ACQUIRE, "agent");
    asm volatile("s_waitcnt vmcnt(0)" ::: "memory");
  }
  __syncthreads();
  int L, b, tx, ty, tokbase;
  const u16* uvb; const u16* dft;
  if (it < 32) { L = 1024; b = it >> 4; tx = (it >> 3) & 1; ty = it & 7; uvb = p.uv + (size_t)16 * 256 * 512 + (size_t)b * (256 * 2048); dft = p.dft1024; tokbase = NPTOK + b * 1024; }
  else { it -= 32; L = 256; b = it >> 2; tx = (it >> 1) & 1; ty = it & 1; uvb = p.uv + (size_t)b * (256 * 512); dft = p.dft256; tokbase = b * 256; }
  const int x0 = tx * 128, y0 = ty * 128, K = 2 * L;
  f32x4 acc[4][4];
  gemm_main<4>(uvb + (size_t)x0 * K, K, dft + (size_t)y0 * K, K, K, smem, acc);
  const int lane = otid() & 63, wave = otid() >> 6, wx = wave & 1, wy = wave >> 1, r = lane & 15, g = lane >> 4;
  const float scale = rsqrtf(64.f * (float)L);
#pragma unroll
  for (int yi = 0; yi < 4; ++yi) {
    const int pos = y0 + wy * 64 + yi * 16 + r;
#pragma unroll
    for (int xi = 0; xi < 4; ++xi) {
      const int col = x0 + wx * 64 + xi * 16 + 4 * g;
      const f32x4 v = acc[xi][yi];
      uint2 w; w.x = pack2(v[0] * scale, v[1] * scale); w.y = pack2(v[2] * scale, v[3] * scale);
      *(uint2*)(p.cat + (size_t)(tokbase + pos) * 1024 + 512 + col) = w;
    }
  }
}

struct Seg { const u16* K; const u16* Vt; int ldk, ldv, nblk, pos0, stride; };
#define KLOC(hh, tokb) (p.kfr + ((size_t)((hh) * 192 + ((tokb) >> 5))) * 2048)
#define VLOC(hh, tokb) (p.vfr + ((size_t)((hh) * 192 + ((tokb) >> 5))) * 2048)
template <int QT> struct AState { float m[QT]; float ls[QT]; f32x4 o[QT][4]; };

__device__ __forceinline__ bf16x8 as_bf(u32x4 v) { union { u32x4 u; bf16x8 b; } x; x.u = v; return x.b; }

template <int DC>
__device__ __forceinline__ void issue_blk(const Seg& s0, const Seg& s1, int b, int r, int g, u32x4 (&kf)[2][DC], u32x4 (&vf)[4]) {
  const bool in0 = b < s0.nblk;
  const u16* Kp = in0 ? s0.K : s1.K;
  const u16* Vp = in0 ? s0.Vt : s1.Vt;
  const int pos = in0 ? (s0.pos0 + b * s0.stride) : (s1.pos0 + (b - s0.nblk) * s1.stride);
  const int lane8 = (g * 16 + r) * 8;
  const u16* kp = Kp + (size_t)(pos >> 5) * 2048 + lane8;
  const u16* vp = Vp + (size_t)(pos >> 5) * 2048 + lane8;
#pragma unroll
  for (int t = 0; t < 2; ++t)
#pragma unroll
    for (int dc = 0; dc < DC; ++dc) gload16(kf[t][dc], kp + (t * 2 + dc) * 512);
#pragma unroll
  for (int dv = 0; dv < 4; ++dv) gload16(vf[dv], vp + dv * 512);
}
template <int N>
__device__ __forceinline__ void wait_blk(u32x4 (&kf)[2][1], u32x4 (&vf)[4]) {
  asm volatile("s_waitcnt vmcnt(%6)" : "+v"(kf[0][0]), "+v"(kf[1][0]), "+v"(vf[0]), "+v"(vf[1]), "+v"(vf[2]), "+v"(vf[3]) : "n"(N) : "memory");
}
template <int N>
__device__ __forceinline__ void wait_blk(u32x4 (&kf)[2][2], u32x4 (&vf)[4]) {
  asm volatile("s_waitcnt vmcnt(%8)" : "+v"(kf[0][0]), "+v"(kf[0][1]), "+v"(kf[1][0]), "+v"(kf[1][1]), "+v"(vf[0]), "+v"(vf[1]), "+v"(vf[2]), "+v"(vf[3]) : "n"(N) : "memory");
}

template <int D, int QT, int MODE>
__device__ __forceinline__ void attn_compute(const u32x4 (&kc)[2][D / 32], const u32x4 (&vc)[4], const bf16x8 (&qf)[QT][D / 32], const float sc,
                                             AState<QT>& st, const bool in0, const int pos, const int qpos0, const float* __restrict__ rpb_h,
                                             const int r, const int g) {
  constexpr int DC = D / 32;
#pragma unroll
  for (int q = 0; q < QT; ++q) {
    f32x4 s_[2];
    s_[0] = (f32x4){0.f, 0.f, 0.f, 0.f};
    s_[1] = (f32x4){0.f, 0.f, 0.f, 0.f};
#pragma unroll
    for (int t = 0; t < 2; ++t)
#pragma unroll
      for (int dc = 0; dc < DC; ++dc) s_[t] = __builtin_amdgcn_mfma_f32_16x16x32_bf16(as_bf(kc[t][dc]), qf[q][dc], s_[t], 0, 0, 0);
    float sv[8];
#pragma unroll
    for (int t = 0; t < 2; ++t)
#pragma unroll
      for (int i = 0; i < 4; ++i) {
        float x = s_[t][i] * sc;
        if (MODE == 1) {
          if (!in0) {
            const int qpos = qpos0 + q * 16 + r;
            const int qrow = qpos >> 6, cq = qpos & 63;
            const int kpos = pos + 8 * g + 4 * t + i;
            const int krow = kpos >> 6, ck = kpos & 63;
            const int cs = min(max(cq - 8, 0), 48);
            const bool valid = (ck >= cs) && (ck < cs + 16);
            const int bi = (krow - qrow + 7) * 31 + (ck - cq + 15);
            const float bias = rpb_h[valid ? bi : 0];
            x = valid ? (x + bias) : -1e30f;
          }
        } else if (MODE == 2) {
          if (!in0) {
            const int qpos = qpos0 + q * 16 + r;
            const int kpos = pos + 8 * g + 4 * t + i;
            const int d = qpos - kpos;
            x = (d <= 128 && d >= -128) ? x : -1e30f;
          }
        }
        sv[4 * t + i] = x;
      }
    float mx = fmaxf(fmaxf(fmaxf(sv[0], sv[1]), fmaxf(sv[2], sv[3])), fmaxf(fmaxf(sv[4], sv[5]), fmaxf(sv[6], sv[7])));
    mx = fmaxf(mx, __shfl_xor(mx, 16));
    mx = fmaxf(mx, __shfl_xor(mx, 32));
    const float mnew = fmaxf(st.m[q], mx);
    const float alpha = __builtin_amdgcn_exp2f(st.m[q] - mnew);
    st.m[q] = mnew;
    float ps = 0.f;
#pragma unroll
    for (int j = 0; j < 8; ++j) { sv[j] = __builtin_amdgcn_exp2f(sv[j] - mnew); ps += sv[j]; }
    st.ls[q] = st.ls[q] * alpha + ps;
    union { bf16x8 v; unsigned w[4]; } pf;
    pf.w[0] = pack2(sv[0], sv[1]); pf.w[1] = pack2(sv[2], sv[3]); pf.w[2] = pack2(sv[4], sv[5]); pf.w[3] = pack2(sv[6], sv[7]);
#pragma unroll
    for (int dv = 0; dv < 4; ++dv) {
      f32x4 o = st.o[q][dv];
      o[0] *= alpha; o[1] *= alpha; o[2] *= alpha; o[3] *= alpha;
      st.o[q][dv] = __builtin_amdgcn_mfma_f32_16x16x32_bf16(as_bf(vc[dv]), pf.v, o, 0, 0, 0);
    }
  }
}

template <int D, int QT, int MODE, int NQ = 2>
__device__ __forceinline__ void attn_run(const Seg& s0, const Seg& s1, const bf16x8 (&qf)[QT][D / 32], const float sc,
                                         AState<QT>& st, const int qpos0, const float* __restrict__ rpb_h, const int bb = 0, const int be = -1) {
  constexpr int DC = D / 32;
  constexpr int NL = 2 * DC + 4;
  const int lane = otid() & 63, r = lane & 15, g = lane >> 4;
  const int nb = be < 0 ? s0.nblk + s1.nblk : be;
  u32x4 kq[NQ][2][DC], vq[NQ][4];
#pragma unroll
  for (int q = 0; q < QT; ++q)
#pragma unroll
    for (int dc = 0; dc < DC; ++dc) asm volatile("" ::"v"(qf[q][dc]));
  asm volatile("s_waitcnt vmcnt(0)" ::: "memory");
#pragma unroll 1
  for (int b = bb; b < nb; b += NQ) {
#pragma unroll
    for (int j = 0; j < NQ; ++j) issue_blk<DC>(s0, s1, b + j, r, g, kq[j], vq[j]);
#pragma unroll
    for (int j = 0; j < NQ; ++j) {
      if (j == 0) wait_blk<(NQ - 1) * NL>(kq[j], vq[j]);
      else if (j == 1) wait_blk<(NQ - 2) * NL>(kq[j], vq[j]);
      else if (j == 2) wait_blk<(NQ > 3 ? (NQ - 3) * NL : 0)>(kq[j], vq[j]);
      else wait_blk<0>(kq[j], vq[j]);
      const int bj = b + j;
      const bool in0 = bj < s0.nblk;
      const int pos = in0 ? (s0.pos0 + bj * s0.stride) : (s1.pos0 + (bj - s0.nblk) * s1.stride);
      attn_compute<D, QT, MODE>(kq[j], vq[j], qf, sc, st, in0, pos, qpos0, rpb_h, r, g);
    }
  }
}

template <int QT>
__device__ __forceinline__ void astate_init(AState<QT>& st, float m0, float l0) {
#pragma unroll
  for (int q = 0; q < QT; ++q) {
    st.m[q] = m0; st.ls[q] = l0;
#pragma unroll
    for (int dv = 0; dv < 4; ++dv) st.o[q][dv] = (f32x4){0.f, 0.f, 0.f, 0.f};
  }
}
template <int QT>
__device__ __forceinline__ void astate_finalize(AState<QT>& st) {
#pragma unroll
  for (int q = 0; q < QT; ++q) {
    float l = st.ls[q];
    l += __shfl_xor(l, 16);
    l += __shfl_xor(l, 32);
    const float inv = 1.f / l;
#pragma unroll
    for (int dv = 0; dv < 4; ++dv) { st.o[q][dv][0] *= inv; st.o[q][dv][1] *= inv; st.o[q][dv][2] *= inv; st.o[q][dv][3] *= inv; }
  }
}
template <int DC, int QT>
__device__ __forceinline__ void load_q(const u16* zq  , bf16x8 (&qf)[QT][DC]) {
  const int lane = otid() & 63, r = lane & 15, g = lane >> 4;
#pragma unroll
  for (int q = 0; q < QT; ++q)
#pragma unroll
    for (int dc = 0; dc < DC; ++dc) qf[q][dc] = *(const bf16x8*)(zq + (size_t)(q * 16 + r) * INW + dc * 32 + g * 8);
}
template <int QT>
__device__ __forceinline__ void write_o(const Params& p, const AState<QT>& st, int tok0, int col0) {
  const int lane = otid() & 63, r = lane & 15, g = lane >> 4;
#pragma unroll
  for (int q = 0; q < QT; ++q)
#pragma unroll
    for (int dv = 0; dv < 4; ++dv) {
      const f32x4 v = st.o[q][dv];
      uint2 w; w.x = pack2(v[0], v[1]); w.y = pack2(v[2], v[3]);
      *(uint2*)(p.cat + (size_t)(tok0 + q * 16 + r) * 1024 + col0 + dv * 16 + 4 * g) = w;
    }
}

__device__ __forceinline__ float diff_lambda(const Params& p, int l, float lam_init) {
  const int lane = otid() & 63;
  float a = 0.f, b = 0.f;
  if (lane < 32) { a = p.lq1[l * 32 + lane] * p.lk1[l * 32 + lane]; b = p.lq2[l * 32 + lane] * p.lk2[l * 32 + lane]; }
#pragma unroll
  for (int o = 32; o >= 1; o >>= 1) { a += __shfl_xor(a, o); b += __shfl_xor(b, o); }
  return expf(a) - expf(b) + lam_init;
}

__device__ __forceinline__ void diff_finish_q(const Params& p, int l, float lam, float lam_init, f32x4 (&A)[4], const f32x4 (&B)[4], int tokrow0, int col0) {
  const int lane = otid() & 63, r = lane & 15, g = lane >> 4;
  const float* sg = p.subln_g + l * 64;
  float ss = 0.f;
#pragma unroll
  for (int dv = 0; dv < 4; ++dv)
#pragma unroll
    for (int i = 0; i < 4; ++i) {
      const float v = A[dv][i] - lam * B[dv][i];
      A[dv][i] = v;
      ss += v * v;
    }
  ss += __shfl_xor(ss, 16);
  ss += __shfl_xor(ss, 32);
  const float rs = rsqrtf(ss * (1.f / 64.f) + 1e-6f) * (1.f - lam_init);
#pragma unroll
  for (int dv = 0; dv < 4; ++dv) {
    const float4 gg = *(const float4*)(sg + dv * 16 + 4 * g);
    uint2 w;
    w.x = pack2(A[dv][0] * rs * gg.x, A[dv][1] * rs * gg.y);
    w.y = pack2(A[dv][2] * rs * gg.z, A[dv][3] * rs * gg.w);
    *(uint2*)(p.cat + (size_t)(tokrow0 + r) * 1024 + col0 + dv * 16 + 4 * g) = w;
  }
}

#ifndef AQT
#define AQT 2
#endif
#define QW (16 * AQT)
#define NQG_CTX (256 / QW)
#define NQG_LAT (1024 / QW)
__device__ void attn_diff_item(const Params& p, int l, bool lat, int bi, float* sm) {
  const int wave = otid() >> 6, lane = otid() & 63, r = lane & 15, g = lane >> 4;
  const int ps = wave >> 1, half = wave & 1;
  int b, h, qg, tokb;
  if (lat) { b = bi / (4 * NQG_LAT); h = (bi / NQG_LAT) & 3; qg = bi % NQG_LAT; tokb = NPTOK + b * 1024; }
  else { b = bi / (4 * NQG_CTX); h = (bi / NQG_CTX) & 3; qg = bi % NQG_CTX; tokb = b * 256; }
  const int tok0 = tokb + qg * QW;
  const u16* zb = p.z + (size_t)tokb * INW;
  Seg s0, s1;
  if (lat) {
    const int bl = b * 4 + l;
    s0.K = p.ck_diff + (size_t)((bl * 4 + h) * 16) * 2048 + ps * 512; s0.Vt = p.cvt_diff + (size_t)((bl * 4 + h) * 16) * 2048;
    s0.ldk = 0; s0.ldv = 0; s0.nblk = half ? 0 : 16; s0.pos0 = 0; s0.stride = 32;
    s1.K = KLOC(4 + h, tokb) + ps * 512; s1.Vt = VLOC(4 + h, tokb);
    s1.ldk = 0; s1.ldv = 0; s1.nblk = half ? 24 : 8; s1.pos0 = half ? 256 : 0; s1.stride = 32;
  } else {
    s0.K = KLOC(4 + h, tokb) + ps * 512; s0.Vt = VLOC(4 + h, tokb);
    s0.ldk = 0; s0.ldv = 0; s0.nblk = 4; s0.pos0 = half ? 128 : 0; s0.stride = 32;
    s1 = s0; s1.nblk = 0;
  }
  bf16x8 qf[AQT][1];
  load_q<1, AQT>(p.z + (size_t)tok0 * INW + 768 + h * 64 + ps * 32, qf);
  AState<AQT> st;
  astate_init<AQT>(st, -1e30f, 0.f);
  attn_run<32, AQT, 0, 2>(s0, s1, qf, 0.17677669529663687f * LOG2E, st, 0, nullptr);
  float lt[AQT];
#pragma unroll
  for (int q = 0; q < AQT; ++q) {
    lt[q] = st.ls[q];
    lt[q] += __shfl_xor(lt[q], 16);
    lt[q] += __shfl_xor(lt[q], 32);
  }
  constexpr int WS = 64 * 16 * AQT;
  float* pm = sm + 4 * WS;
  if (wave != 0) {
    float* po = sm + wave * WS + lane * (16 * AQT);
#pragma unroll
    for (int q = 0; q < AQT; ++q) {
#pragma unroll
      for (int dv = 0; dv < 4; ++dv) *(f32x4*)(po + q * 16 + dv * 4) = st.o[q][dv];
      if (g == 0) { pm[wave * QW + q * 16 + r] = st.m[q]; pm[4 * QW + wave * QW + q * 16 + r] = lt[q]; }
    }
  }
  __syncthreads();
  if (wave == 0) {
    const float lam_init = 0.8f - 0.6f * expf(-0.3f * (float)l);
    const float lam = diff_lambda(p, l, lam_init);
#pragma unroll
    for (int q = 0; q < AQT; ++q) {
      f32x4 A[4], B[4];
      {
        const float m1 = pm[QW + q * 16 + r], l1 = pm[4 * QW + QW + q * 16 + r];
        const float M = fmaxf(st.m[q], m1);
        const float a0 = exp2f(st.m[q] - M), a1 = exp2f(m1 - M);
        const float inv = 1.f / (lt[q] * a0 + l1 * a1);
#pragma unroll
        for (int dv = 0; dv < 4; ++dv) {
          const f32x4 o1 = *(const f32x4*)(sm + 1 * WS + lane * (16 * AQT) + q * 16 + dv * 4);
          A[dv] = (st.o[q][dv] * a0 + o1 * a1) * inv;
        }
      }
      {
        const float m2 = pm[2 * QW + q * 16 + r], l2 = pm[4 * QW + 2 * QW + q * 16 + r], m3 = pm[3 * QW + q * 16 + r], l3 = pm[4 * QW + 3 * QW + q * 16 + r];
        const float M = fmaxf(m2, m3);
        const float a2 = exp2f(m2 - M), a3 = exp2f(m3 - M);
        const float inv = 1.f / (l2 * a2 + l3 * a3);
#pragma unroll
        for (int dv = 0; dv < 4; ++dv) {
          const f32x4 o2 = *(const f32x4*)(sm + 2 * WS + lane * (16 * AQT) + q * 16 + dv * 4);
          const f32x4 o3 = *(const f32x4*)(sm + 3 * WS + lane * (16 * AQT) + q * 16 + dv * 4);
          B[dv] = (o2 * a2 + o3 * a3) * inv;
        }
      }
      diff_finish_q(p, l, lam, lam_init, A, B, tok0 + q * 16, 256 + h * 64);
    }
  }
  __syncthreads();
}

__device__ void attn_ctx_item(const Params& p, int l, int bi) {
  const int wave = otid() >> 6, lane = otid() & 63, g = lane >> 4;
  const int w = bi * 4 + wave;
  const int type = w / (64 * NQG_CTX), rem = w % (64 * NQG_CTX);
  const int b = rem / (4 * NQG_CTX), h = (rem / NQG_CTX) & 3, qg = rem % NQG_CTX;
  const int tokb = b * 256, tok0 = tokb + qg * QW;
  const u16* zb = p.z + (size_t)tokb * INW;
  const int kvh = h >> 1;
  const int qcol = type == 0 ? h * 64 : 1792 + h * 64;
  const int kcol = type == 0 ? 256 + h * 64 : 2048 + kvh * 64;
  const int vrow = type == 0 ? h * 64 : 512 + kvh * 64;
  const int ocol = type == 0 ? h * 64 : 768 + h * 64;
  bf16x8 qf[AQT][2];
  load_q<2, AQT>(p.z + (size_t)tok0 * INW + qcol, qf);
  const int hslot = type == 0 ? h : 8 + kvh;
  Seg s0; s0.K = KLOC(hslot, tokb); s0.Vt = VLOC(hslot, tokb); s0.ldk = 0; s0.ldv = 0; s0.nblk = 8; s0.pos0 = 0; s0.stride = 32;
  Seg sN = s0; sN.nblk = 0;
  AState<AQT> st;
  const float sk = type == 0 ? -1e30f : p.swa_sink[l * 4 + h] * LOG2E;
  astate_init<AQT>(st, sk, (type == 1 && g == 0) ? 1.f : 0.f);
  attn_run<64, AQT, 0, 2>(s0, sN, qf, 0.125f * LOG2E, st, 0, nullptr);
  astate_finalize<AQT>(st);
  write_o<AQT>(p, st, tok0, ocol);
}

__device__ void attn_lat_item(const Params& p, int l, int bi, float* sm) {
  const int wave = otid() >> 6, lane = otid() & 63, r = lane & 15, g = lane >> 4;
  const int type = bi / (8 * NQG_LAT), rem = bi % (8 * NQG_LAT);
  const int b = rem / (4 * NQG_LAT), h = (rem / NQG_LAT) & 3, qg = rem % NQG_LAT;
  const int q0 = qg * QW;
  const int tokb = NPTOK + b * 1024, tok0 = tokb + q0;
  const u16* zb = p.z + (size_t)tokb * INW;
  const int bl = b * 4 + l;
  AState<AQT> st;
  int ocol;
  if (type != 0) {
    const float* rp = p.na_rpb + (size_t)(l * 4 + h) * 15 * 31;
    for (int e = otid(); e < 465; e += 256) sm[9000 + e] = rp[e] * LOG2E;
    __syncthreads();
  }
  if (type == 0) {
    const int kvh = h >> 1;
    bf16x8 qf[AQT][2];
    load_q<2, AQT>(p.z + (size_t)tok0 * INW + 1792 + h * 64, qf);
    Seg s0; s0.K = p.ck_swa + (size_t)((bl * 2 + kvh) * 16) * 2048; s0.Vt = p.cvt_swa + (size_t)((bl * 2 + kvh) * 16) * 2048; s0.ldk = 0; s0.ldv = 0; s0.nblk = 16; s0.pos0 = 0; s0.stride = 32;
    const int lo = max(0, q0 - 128) & ~31;
    const int hi = min(1024, ((q0 + QW + 128) + 31) & ~31);
    int lo2 = lo, cnt = (hi - lo) >> 5;
    if (cnt & 1) { if (lo2 > 0) lo2 -= 32; ++cnt; }
    Seg s1; s1.K = KLOC(8 + kvh, tokb); s1.Vt = VLOC(8 + kvh, tokb); s1.ldk = 0; s1.ldv = 0; s1.nblk = cnt; s1.pos0 = lo2; s1.stride = 32;
    const int P = (16 + cnt) >> 1;
    const int pb = (wave * P) >> 2, pe = ((wave + 1) * P) >> 2;
    astate_init<AQT>(st, wave == 0 ? p.swa_sink[l * 4 + h] * LOG2E : -1e30f, (wave == 0 && g == 0) ? 1.f : 0.f);
    attn_run<64, AQT, 2>(s0, s1, qf, 0.125f * LOG2E, st, q0, nullptr, 2 * pb, 2 * pe);
    ocol = 768 + h * 64;
  } else {
    bf16x8 qf[AQT][2];
    load_q<2, AQT>(p.z + (size_t)tok0 * INW + h * 64, qf);
    Seg s0; s0.K = p.ck_na + (size_t)((bl * 4 + h) * 16) * 2048; s0.Vt = p.cvt_na + (size_t)((bl * 4 + h) * 16) * 2048; s0.ldk = 0; s0.ldv = 0; s0.nblk = 16; s0.pos0 = 0; s0.stride = 32;
    const int qrow = q0 >> 6;
    const int rstart = min(max(qrow - 4, 0), 8);
    Seg s1; s1.K = KLOC(h, tokb); s1.Vt = VLOC(h, tokb); s1.ldk = 0; s1.ldv = 0; s1.nblk = 16; s1.pos0 = rstart * 64; s1.stride = 32;
    astate_init<AQT>(st, -1e30f, 0.f);
    attn_run<64, AQT, 1, 2>(s0, s1, qf, 0.125f * LOG2E, st, q0, sm + 9000, 8 * wave, 8 * wave + 8);
    ocol = h * 64;
  }
  float lt[AQT];
#pragma unroll
  for (int q = 0; q < AQT; ++q) {
    lt[q] = st.ls[q];
    lt[q] += __shfl_xor(lt[q], 16);
    lt[q] += __shfl_xor(lt[q], 32);
  }
  constexpr int WS = 64 * 16 * AQT;
  float* pm = sm + 4 * WS;
  if (wave != 0) {
    float* po = sm + wave * WS + lane * (16 * AQT);
#pragma unroll
    for (int q = 0; q < AQT; ++q) {
#pragma unroll
      for (int dv = 0; dv < 4; ++dv) *(f32x4*)(po + q * 16 + dv * 4) = st.o[q][dv];
      if (g == 0) { pm[wave * QW + q * 16 + r] = st.m[q]; pm[4 * QW + wave * QW + q * 16 + r] = lt[q]; }
    }
  }
  __syncthreads();
  if (wave == 0) {
#pragma unroll
    for (int q = 0; q < AQT; ++q) {
      const float m1 = pm[1 * QW + q * 16 + r], m2 = pm[2 * QW + q * 16 + r], m3 = pm[3 * QW + q * 16 + r];
      const float l1 = pm[4 * QW + 1 * QW + q * 16 + r], l2 = pm[4 * QW + 2 * QW + q * 16 + r], l3 = pm[4 * QW + 3 * QW + q * 16 + r];
      const float M = fmaxf(fmaxf(st.m[q], m1), fmaxf(m2, m3));
      const float a0 = __builtin_amdgcn_exp2f(st.m[q] - M), a1 = __builtin_amdgcn_exp2f(m1 - M), a2 = __builtin_amdgcn_exp2f(m2 - M), a3 = __builtin_amdgcn_exp2f(m3 - M);
      const float inv = 1.f / (lt[q] * a0 + l1 * a1 + l2 * a2 + l3 * a3);
#pragma unroll
      for (int dv = 0; dv < 4; ++dv) {
        const f32x4 o1 = *(const f32x4*)(sm + 1 * WS + lane * (16 * AQT) + q * 16 + dv * 4);
        const f32x4 o2 = *(const f32x4*)(sm + 2 * WS + lane * (16 * AQT) + q * 16 + dv * 4);
        const f32x4 o3 = *(const f32x4*)(sm + 3 * WS + lane * (16 * AQT) + q * 16 + dv * 4);
        st.o[q][dv] = (st.o[q][dv] * a0 + o1 * a1 + o2 * a2 + o3 * a3) * inv;
      }
    }
    write_o<AQT>(p, st, tok0, ocol);
  }
  __syncthreads();
}

__device__ __forceinline__ int q_next(unsigned* cnt, volatile LAS unsigned* slot) {
  __syncthreads();
  if (threadIdx.x == 0) *slot = xb_add(cnt, 1u);
  __syncthreads();
  return (int)*slot;
}

#if REP_SYNC
#define GSYNC() do { xcd_barrier(xb); xcd_barrier(xb); } while (0)
#else
#define GSYNC() xcd_barrier(xb)
#endif
__global__ void __launch_bounds__(256, 2) mega(Params p) {
  extern __shared__ __attribute__((aligned(16))) unsigned char smem[];
  cg::grid_group grid = cg::this_grid();
  const int nblk = gridDim.x, bid = blockIdx.x;
  u16* sm16 = (u16*)smem;
  __shared__ uint4 xb_words[2];
  if (threadIdx.x == 0) { xb_words[0] = make_uint4(0u, 0u, 0u, 0u); xb_words[1] = make_uint4(0u, 0u, 0u, 0u); }
  __syncthreads();
  XcdBarrier xb = xcd_barrier_post(p.bar, (volatile LAS unsigned*)&xb_words[0]);

  for (int rep = 0; rep <= REP_P0; ++rep)
    for (int it = bid; it < P0_ITEMS; it += nblk) p0_item(p, it, smem);
  if (p.use_cg_sync) grid.sync();
  GSYNC();

  const int xcc = (int)xb.x;
  const int xrank = __builtin_amdgcn_readfirstlane((int)xb.st[4]), xnloc = __builtin_amdgcn_readfirstlane((int)xb.st[0]);
  const unsigned topo = (unsigned)__builtin_amdgcn_readfirstlane((int)xb.st[5]);
  const bool local = (topo & 1u) != 0u, full64 = (topo & 2u) != 0u;
#define LSYNC() do { if (local) xcd_barrier_local(xb); else GSYNC(); } while (0)
#define LMAP(j, count, total) (local ? ((xrank + (j) * xnloc) < (count) ? (xrank + (j) * xnloc) : -1) : ((bid + (j) * nblk) < (total) ? (bid + (j) * nblk) : -1))

#pragma unroll 1
  for (int l = 0; l < 4; ++l) {
    for (int j = 0;; ++j) { const int v = LMAP(j, 48, 384); if (v < 0) break; norm_item(p, l, 0, local ? 48 * xcc + v : v); }
    LSYNC();
    for (int j = 0;; ++j) {
      const int v = LMAP(j, 108, 864); if (v < 0) break;
      if (local) gin_tile(p, l, v / 6, 6 * xcc + v % 6, sm16); else gin_tile(p, l, v / 48, v % 48, sm16);
    }
    if (full64) {
      if (xrank >= 44) {
        const int idle = xcc * 20 + (xrank - 44);
        for (int it = 288 + idle; it < 928; it += 160) wt_item(p, l, it, (float*)smem);
      }
    }
    GSYNC();
    {
      constexpr int CD = 64 * NQG_CTX, CC = 2 * 64 * NQG_CTX / 4;
      constexpr int LD = 8 * NQG_LAT, LC = 2 * 8 * NQG_LAT;
      constexpr int E0 = 192, E1 = E0 + LD, E2 = E1 + LC, E3 = E2 + 32, E4 = E3 + CC, E5 = E4 + CD, E6 = E5 + 64;
      unsigned* qc = p.bar + XCD_BAR_WORDS + l * 64;
      const int w0 = full64 ? 928 : 288;
      const int EA = E6 + (1440 - w0), EW = EA + (l < 3 ? 288 : 0);
      for (int it = bid; it < EW; it = nblk + q_next(qc, &xb.st[2])) {
        if (it >= E6) {
          if (it < EA) wt_item(p, l, it - E6 + w0, (float*)smem);
          else wt_item(p, l + 1, it - EA, (float*)smem);
          continue;
        }
        if (it < E0) f1_tile(p, l, it, sm16);
        else if (it < E0 + LC) attn_lat_item(p, l, it - E0, (float*)smem);
        else if (it < E2) attn_diff_item(p, l, true, it - E0 - LC, (float*)smem);
        else if (it < E3) f2_tile(p, l, it - E2, sm16);
        else if (it < E4) attn_ctx_item(p, l, it - E3);
        else if (it < E5) attn_diff_item(p, l, false, it - E4, (float*)smem);
        else f2_tile(p, l, it - E5 + 32, sm16);
      }
    }
    GSYNC();
    for (int j = 0;; ++j) {
      const int v = LMAP(j, 64, 512); if (v < 0) break;
      if (local) res_tile(p, l, v / 8, 8 * xcc + v % 8, p.cat, p.w_outT + (size_t)l * 1024 * 1024, 1024, 2, sm16, l == 0);
      else res_tile(p, l, v / 64, v % 64, p.cat, p.w_outT + (size_t)l * 1024 * 1024, 1024, 2, sm16, l == 0);
    }
    LSYNC();
    for (int j = 0;; ++j) { const int v = LMAP(j, 48, 384); if (v < 0) break; norm_item(p, l, 1, local ? 48 * xcc + v : v); }
    LSYNC();
    for (int j = 0;; ++j) {
      const int v = LMAP(j, 192, 1536); if (v < 0) break;
      if (local) m1_tile(p, l, v / 6, 6 * xcc + v % 6, sm16); else m1_tile(p, l, v / 48, v % 48, sm16);
    }
    LSYNC();
    for (int j = 0;; ++j) {
      const int v = LMAP(j, 64, 512); if (v < 0) break;
      if (local) res_tile(p, l, v / 8, 8 * xcc + v % 8, p.u, p.w2T + (size_t)l * 1024 * 4096, 4096, 5, sm16);
      else res_tile(p, l, v / 64, v % 64, p.u, p.w2T + (size_t)l * 1024 * 4096, 4096, 5, sm16);
    }
    LSYNC();
  }
  for (int j = 0;; ++j) { const int v = LMAP(j, 48, 384); if (v < 0) break; norm_item(p, 0, 2, local ? 48 * xcc + v : v); }
#undef LSYNC
#undef LMAP
}

extern "C" void kernel_launch(void* const* d_in, const int* in_sizes, int n_in, void* d_out, int out_size, void* d_ws,
                              size_t ws_size, hipStream_t stream) {
  static int grid_blocks = 0;
  if (grid_blocks == 0) {
    int dev = 0, cus = 0, per_cu = 0;
    (void)hipGetDevice(&dev);
    (void)hipDeviceGetAttribute(&cus, hipDeviceAttributeMultiprocessorCount, dev);
    if (hipFuncSetAttribute((const void*)mega, hipFuncAttributeMaxDynamicSharedMemorySize, LDS_BYTES) != hipSuccess) {
      fprintf(stderr, "hipFuncSetAttribute failed\n");
    }
    if (hipOccupancyMaxActiveBlocksPerMultiprocessor(&per_cu, (const void*)mega, 256, LDS_BYTES) != hipSuccess || per_cu < 1) {
      fprintf(stderr, "occupancy query failed (%d)\n", per_cu);
      per_cu = 1;
    }
    if (per_cu > 2) per_cu = 2;
    grid_blocks = cus * per_cu;
    fprintf(stderr, "mega: cus=%d per_cu=%d grid=%d ws=%zu\n", cus, per_cu, grid_blocks, ws_size);
  }
  Params p{};
  const float** pin = (const float**)&p;
  for (int i = 0; i < 27; ++i) pin[i] = (const float*)d_in[i];
  p.out = (float*)d_out;
  unsigned char* ws = (unsigned char*)d_ws;
  size_t off = 0;
  auto take = [&](size_t bytes) { unsigned char* q = ws + off; off += (bytes + 255) & ~(size_t)255; return q; };
  p.xres = (float*)take((size_t)NTOK * 1024 * 4);
  p.mods = (float*)take((size_t)4 * 3 * 6144 * 4);
  p.h = (u16*)take((size_t)NTOK * 1024 * 2);
  p.z = (u16*)take((size_t)NTOK * INW * 2);
  p.vt = (u16*)take((size_t)640 * NTOK * 2);
  p.cat = (u16*)take((size_t)NTOK * 1024 * 2);
  p.u = (u16*)take((size_t)NTOK * 4096 * 2);
  p.uv = (u16*)take((size_t)(16 * 256 * 512 + 2 * 256 * 2048) * 2);
  p.w_inT = (u16*)take((size_t)4 * 2304 * 1024 * 2);
  p.w_outT = (u16*)take((size_t)4 * 1024 * 1024 * 2);
  p.w1T = (u16*)take((size_t)4 * 4096 * 1024 * 2);
  p.w2T = (u16*)take((size_t)4 * 4096 * 1024 * 2);
  p.pqt = (u16*)take((size_t)4 * 512 * 256 * 2);
  p.dft256 = (u16*)take((size_t)256 * 512 * 2);
  p.dft1024 = (u16*)take((size_t)1024 * 2048 * 2);
  p.ck_na = (u16*)take((size_t)2 * 4 * 512 * 256 * 2);
  p.cvt_na = (u16*)take((size_t)2 * 4 * 512 * 256 * 2);
  p.ck_diff = (u16*)take((size_t)2 * 4 * 512 * 256 * 2);
  p.cvt_diff = (u16*)take((size_t)2 * 4 * 512 * 256 * 2);
  p.ck_swa = (u16*)take((size_t)2 * 4 * 512 * 128 * 2);
  p.cvt_swa = (u16*)take((size_t)2 * 4 * 512 * 128 * 2);
  p.kfr = (u16*)take((size_t)10 * 192 * 2048 * 2);
  p.vfr = (u16*)take((size_t)10 * 192 * 2048 * 2);
  p.ropeD = (float*)take(1024 * 4);
  p.ropeS = (float*)take(2048 * 4);
  p.bar = (unsigned*)take(XB_ALL_WORDS * 4);
  if (off > ws_size) { fprintf(stderr, "workspace too small: need %zu have %zu\n", off, ws_size); return; }
  if (hipMemsetAsync(p.bar, 0, XB_ALL_WORDS * 4, stream) != hipSuccess) fprintf(stderr, "memset failed\n");
  void* args[] = {&p};
  hipError_t e = hipLaunchCooperativeKernel((const void*)mega, dim3(grid_blocks), dim3(256), args, LDS_BYTES, stream);
  if (e != hipSuccess) fprintf(stderr, "cooperative launch failed: %s (grid %d)\n", hipGetErrorString(e), grid_blocks);
}
```

```cpp
#include <hip/hip_runtime.h>
#include <hip/hip_cooperative_groups.h>
#include <stdint.h>
#include <stdio.h>
namespace cg = cooperative_groups;

typedef unsigned short u16;
typedef __attribute__((ext_vector_type(8))) short bf16x8;
typedef __attribute__((ext_vector_type(4))) float f32x4;
typedef __attribute__((ext_vector_type(4))) unsigned u32x4;
__device__ __forceinline__ void gload16(u32x4& dst, const void* ptr) {
  asm volatile("global_load_dwordx4 %0, %1, off" : "=v"(dst) : "v"(ptr) : "memory");
}

#define NTOK 6144
#define NPTOK 4096
#define INW 2304
#define LOG2E 1.4426950408889634f
#define LDS_BYTES 73728
#define LSTR 72

#define O_NAK 6291456
#define O_NAV 10485760
#define O_DK 14680064
#define O_DV 18874368
#define O_SK 23068672
#define O_SV 25165824

struct Params {
  const float *x_prompt, *x_sample, *c_na_k, *c_na_v, *c_diff_k, *c_diff_v, *c_swa_k, *c_swa_v, *c, *c_ctx;
  const float *w_ada, *b_ada, *norm1_g, *norm2_g, *w_in, *na_rpb, *lq1, *lk1, *lq2, *lk2, *subln_g, *w_fourier, *swa_sink;
  const float *w_out, *w1, *w2, *final_g;
  float* out;
  float* xres;
  float* mods;
  u16 *h, *z, *vt, *cat, *u, *uv, *w_inT, *w_outT, *w1T, *w2T, *pqt, *dft256, *dft1024;
  u16 *ck_na, *cvt_na, *ck_diff, *cvt_diff, *ck_swa, *cvt_swa;
  float *ropeD, *ropeS;
  u16 *kfr, *vfr;
  unsigned* bar;
  int use_cg_sync;
  int pad_;
};

__device__ __forceinline__ u16 f2bf(float f) {
  unsigned u = __float_as_uint(f);
  u += 0x7fffu + ((u >> 16) & 1u);
  return (u16)(u >> 16);
}
__device__ __forceinline__ int otid() { int t = threadIdx.x; asm volatile("" : "+v"(t)); return t; }
__device__ __forceinline__ float bf2f(u16 h) { return __uint_as_float(((unsigned)h) << 16); }
typedef __attribute__((ext_vector_type(2))) __bf16 hbf16x2;
typedef __attribute__((ext_vector_type(2))) float f32x2;
__device__ __forceinline__ unsigned pack2(float a, float b) {
  f32x2 v = {a, b};
  union { hbf16x2 h; unsigned u; } x;
  x.h = __builtin_convertvector(v, hbf16x2);
  return x.u;
}

__device__ __forceinline__ int kfrag_off(int kk, int d) {
  const int t = (kk >> 2) & 1, r = ((kk >> 3) << 2) | (kk & 3), dc = d >> 5, g = (d >> 3) & 3;
  return ((t * 2 + dc) * 64 + g * 16 + r) * 8 + (d & 7);
}
__device__ __forceinline__ int vfrag_off(int kk, int dv) {
  return (((dv >> 4) * 64) + (kk >> 3) * 16 + (dv & 15)) * 8 + (kk & 7);
}

#define XB_TMO      128
#define XB_XCNT(j)  (256  + 64 * (j))
#define XB_XSUB(j)  (1280 + 64 * (j))
#define XB_XGEN(j)  (2304 + 64 * (j))
#define XB_TOP      3328
#define XB_TOPGEN   3392
#define XCD_BAR_WORDS 3456
#define XB_SPIN_CAP (1u << 22)
#define LAS __attribute__((address_space(3)))
__device__ __forceinline__ unsigned xb_ld(unsigned* p)              { return __hip_atomic_load(p, __ATOMIC_RELAXED, __HIP_MEMORY_SCOPE_AGENT); }
__device__ __forceinline__ unsigned xb_add(unsigned* p, unsigned v) { return __hip_atomic_fetch_add(p, v, __ATOMIC_RELAXED, __HIP_MEMORY_SCOPE_AGENT); }
__device__ __forceinline__ unsigned xb_xcc_id() { return (unsigned)__builtin_amdgcn_s_getreg((3 << 11) | 20) & 0xFu; }
#define XB_SPIN(cond, bar) do { unsigned _sp = 0; while (cond) { __builtin_amdgcn_s_sleep(1); \
    if ((++_sp & 255u) == 0u) { if (xb_ld(&(bar)[XB_TMO])) break; if (_sp > XB_SPIN_CAP) { atomicAdd(&(bar)[XB_TMO], 1u); break; } } } } while (0)
#define XB_LSUB(j)  (XCD_BAR_WORDS + 12 * 64 + 64 * (j))
#define XB_LGEN(j)  (XCD_BAR_WORDS + 12 * 64 + 64 * (16 + (j)))
#define XB_ALL_WORDS (XCD_BAR_WORDS + 12 * 64 + 32 * 64)
struct XcdBarrier { unsigned* bar; unsigned x; volatile LAS unsigned* st; };
__device__ __forceinline__ XcdBarrier xcd_barrier_post(unsigned* bar, volatile LAS unsigned* st) {
  XcdBarrier b; b.bar = bar; b.x = xb_xcc_id(); b.st = st;
  if (threadIdx.x == 0) st[4] = xb_add(&bar[XB_XCNT(b.x)], 1u);
  return b;
}
__device__ __forceinline__ void xcd_barrier_complete(unsigned* bar, unsigned x, unsigned& nloc, unsigned& nx) {
  const unsigned G = gridDim.x * gridDim.y * gridDim.z;
  unsigned sum, cnt, mine, sp = 0u;
  for (;;) {
    sum = 0u; cnt = 0u; mine = 0u;
#pragma unroll
    for (unsigned j = 0; j < 16; ++j) { const unsigned c = xb_ld(&bar[XB_XCNT(j)]); sum += c; cnt += (c > 0u) ? 1u : 0u; mine = (j == x) ? c : mine; }
    if (sum == G) break;
    __builtin_amdgcn_s_sleep(1);
    if ((++sp & 255u) == 0u) { if (xb_ld(&bar[XB_TMO])) break; if (sp > XB_SPIN_CAP) { atomicAdd(&bar[XB_TMO], 1u); break; } }
  }
  nloc = mine > 0u ? mine : 1u; nx = cnt > 0u ? cnt : 1u;
}
__device__ __forceinline__ unsigned xcd_topology(unsigned* bar) {
  const unsigned G = gridDim.x * gridDim.y * gridDim.z;
  unsigned sum8 = 0u, all = 1u, all64 = 1u;
#pragma unroll
  for (unsigned j = 0; j < 8; ++j) { const unsigned c = xb_ld(&bar[XB_XCNT(j)]); sum8 += c; all &= (c > 0u) ? 1u : 0u; all64 &= (c == 64u) ? 1u : 0u; }
  const unsigned ok = (all && sum8 == G) ? 1u : 0u;
  return ok | ((ok && all64) ? 2u : 0u);
}
__device__ __forceinline__ void xcd_barrier(const XcdBarrier& b) {
  asm volatile("s_waitcnt vmcnt(0)" ::: "memory");
  __syncthreads();
  if (threadIdx.x == 0) {
    unsigned* bar = b.bar;
    __builtin_amdgcn_s_waitcnt(0);
    unsigned nloc = b.st[0], nx = b.st[1];
    if (nloc == 0u) { xcd_barrier_complete(bar, b.x, nloc, nx); b.st[0] = nloc; b.st[1] = nx; b.st[5] = xcd_topology(bar); }
    const unsigned old = xb_add(&bar[XB_XSUB(b.x)], 1u);
    const unsigned gen = old / nloc;
    if (old + 1u == (gen + 1u) * nloc) {
      __builtin_amdgcn_fence(__ATOMIC_RELEASE, "agent");
      asm volatile("s_waitcnt vmcnt(0)" ::: "memory");
      const unsigned og = xb_add(&bar[XB_TOP], 1u);
      const unsigned tg = og / nx;
      if (og + 1u == (tg + 1u) * nx) xb_add(&bar[XB_TOPGEN], 1u);
      else XB_SPIN(xb_ld(&bar[XB_TOPGEN]) == tg, bar);
      __builtin_amdgcn_fence(__ATOMIC_ACQUIRE, "agent");
      xb_add(&bar[XB_XGEN(b.x)], 1u);
      asm volatile("s_waitcnt vmcnt(0)" ::: "memory");
    } else {
      XB_SPIN(xb_ld(&bar[XB_XGEN(b.x)]) == gen, bar);
      __builtin_amdgcn_fence(__ATOMIC_ACQUIRE, "agent");
      asm volatile("s_waitcnt vmcnt(0)" ::: "memory");
    }
  }
  __syncthreads();
}

__device__ __forceinline__ void xcd_barrier_local(const XcdBarrier& b) {
  asm volatile("s_waitcnt vmcnt(0)" ::: "memory");
  __syncthreads();
  if (threadIdx.x == 0) {
    unsigned* bar = b.bar;
    __builtin_amdgcn_s_waitcnt(0);
    const unsigned nloc = b.st[0];
    const unsigned old = xb_add(&bar[XB_LSUB(b.x)], 1u);
    const unsigned gen = old / nloc;
    if (old + 1u == (gen + 1u) * nloc) xb_add(&bar[XB_LGEN(b.x)], 1u);
    else XB_SPIN(xb_ld(&bar[XB_LGEN(b.x)]) == gen, bar);
    __builtin_amdgcn_fence(__ATOMIC_ACQUIRE, "agent");
    asm volatile("s_waitcnt vmcnt(0)" ::: "memory");
  }
  __syncthreads();
}

__device__ __forceinline__ void transpose_tile(const float* __restrict__ src, int lds_, u16* __restrict__ dst, int ldd,
                                               int k0, int n0, float* sm, bool fragv = false) {
  const int tid = otid();
  const int c4 = (tid & 15) * 4, r0 = tid >> 4;
  float4 v[8];
#pragma unroll
  for (int i = 0; i < 8; ++i) { const f32x4 t = __builtin_nontemporal_load((const f32x4*)(src + (size_t)(k0 + r0 + 16 * i) * lds_ + n0 + c4)); v[i] = make_float4(t[0], t[1], t[2], t[3]); }
#pragma unroll
  for (int i = 0; i < 8; ++i) {
    const int k = r0 + 16 * i;
    sm[(c4 + 0) * 129 + k] = v[i].x; sm[(c4 + 1) * 129 + k] = v[i].y; sm[(c4 + 2) * 129 + k] = v[i].z; sm[(c4 + 3) * 129 + k] = v[i].w;
  }
  __syncthreads();
  const int k8 = (tid & 15) * 8, nn = tid >> 4;
#pragma unroll
  for (int i = 0; i < 4; ++i) {
    const int n = nn + 16 * i;
    const float* row = sm + n * 129 + k8;
    uint4 w;
    w.x = pack2(row[0], row[1]); w.y = pack2(row[2], row[3]); w.z = pack2(row[4], row[5]); w.w = pack2(row[6], row[7]);
    if (fragv) {
      const int col = n0 + n, pos = k0 + k8;
      *(uint4*)(dst + ((size_t)((col >> 6) * 16 + (pos >> 5))) * 2048 + vfrag_off(pos & 31, col & 63)) = w;
    } else {
      *(uint4*)(dst + (size_t)(n0 + n) * ldd + k0 + k8) = w;
    }
  }
  __syncthreads();
}

__device__ __forceinline__ void adaln_item(const Params& p, int it, float* sm) {
  const int l = it / 192, c0 = (it % 192) * 32;
  float* ssil = sm;
  float* red = sm + 3072;
  const int tid = otid();
  for (int i = tid; i < 3072; i += 256) {
    const int cnd = i >> 10, k = i & 1023;
    const float v = cnd == 0 ? p.c_ctx[k] : p.c[(cnd - 1) * 1024 + k];
    ssil[i] = v / (1.f + expf(-v));
  }
  __syncthreads();
  const int cg4 = (tid & 7) * 4, ks = tid >> 3;
  const float* w = p.w_ada + (size_t)l * 1024 * 6144 + c0 + cg4;
  float a0[4] = {0.f, 0.f, 0.f, 0.f}, a1[4] = {0.f, 0.f, 0.f, 0.f}, a2[4] = {0.f, 0.f, 0.f, 0.f};
#pragma unroll 16
  for (int kk = 0; kk < 32; ++kk) {
    const int k = kk * 32 + ks;
    const f32x4 tv = __builtin_nontemporal_load((const f32x4*)(w + (size_t)k * 6144));
    const float4 v = make_float4(tv[0], tv[1], tv[2], tv[3]);
    const float s0 = ssil[k], s1 = ssil[1024 + k], s2 = ssil[2048 + k];
    a0[0] += s0 * v.x; a0[1] += s0 * v.y; a0[2] += s0 * v.z; a0[3] += s0 * v.w;
    a1[0] += s1 * v.x; a1[1] += s1 * v.y; a1[2] += s1 * v.z; a1[3] += s1 * v.w;
    a2[0] += s2 * v.x; a2[1] += s2 * v.y; a2[2] += s2 * v.z; a2[3] += s2 * v.w;
  }
#pragma unroll
  for (int j = 0; j < 4; ++j) {
    red[(ks * 3 + 0) * 32 + cg4 + j] = a0[j];
    red[(ks * 3 + 1) * 32 + cg4 + j] = a1[j];
    red[(ks * 3 + 2) * 32 + cg4 + j] = a2[j];
  }
  __syncthreads();
  if (tid < 96) {
    const int cnd = tid >> 5, j = tid & 31;
    float s = p.b_ada[l * 6144 + c0 + j];
    for (int q = 0; q < 32; ++q) s += red[(q * 3 + cnd) * 32 + j];
    p.mods[(l * 3 + cnd) * 6144 + c0 + j] = s;
  }
  __syncthreads();
}

__device__ __forceinline__ void cvt_item(const float* __restrict__ src, u16* __restrict__ dst, int it, int W) {
  const int w8 = W >> 3;
#pragma unroll
  for (int i = 0; i < 4; ++i) {
    const int u = it * 1024 + i * 256 + otid();
    const int d8 = u % w8, pos = (u / w8) & 511, bl = u / (w8 * 512);
    const float* sp = src + ((size_t)(bl * 512 + pos) * W + d8 * 8);
    const f32x4 t0 = __builtin_nontemporal_load((const f32x4*)sp), t1 = __builtin_nontemporal_load((const f32x4*)(sp + 4));
    const float4 v0 = make_float4(t0[0], t0[1], t0[2], t0[3]), v1 = make_float4(t1[0], t1[1], t1[2], t1[3]);
    uint4 w; w.x = pack2(v0.x, v0.y); w.y = pack2(v0.z, v0.w); w.z = pack2(v1.x, v1.y); w.w = pack2(v1.z, v1.w);
    const int h = d8 >> 3, d = (d8 & 7) * 8;
    *(uint4*)(dst + ((size_t)((bl * (W >> 6) + h) * 16 + (pos >> 5))) * 2048 + kfrag_off(pos & 31, d)) = w;
  }
}

__device__ __forceinline__ void pq_item(const Params& p, int it, float* sm) {
  const int cq = it & 3, it2 = it >> 2;
  const int l = it2 >> 3, which = (it2 >> 2) & 1, g = it2 & 3;
  const int n = otid();
  if (n < 64) sm[n] = which ? sinpif(2.f * (float)n / 64.f) : cospif(2.f * (float)n / 64.f);
  __syncthreads();
  float w[64];
#pragma unroll
  for (int m = 0; m < 64; ++m) w[m] = p.w_fourier[(size_t)l * 65536 + (g * 64 + m) * 256 + n];
  u16* dst = p.pqt + (size_t)l * 512 * 256 + (size_t)(which * 256 + n) * 256 + g * 64;
  for (int c = cq * 16; c < cq * 16 + 16; ++c) {
    float s = 0.f;
#pragma unroll
    for (int m = 0; m < 64; ++m) s += sm[(c * m) & 63] * w[m];
    dst[c] = f2bf(s);
  }
  __syncthreads();
}

__device__ __forceinline__ void dft_item(u16* dst, int L, int it) {
  const int twoL = 2 * L;
  for (int e = otid(); e < 8192; e += 256) {
    const int idx = it * 8192 + e;
    const int k = idx / twoL, j = idx % twoL;
    const int jj = j & (L - 1);
    const int ph = (k * jj) & (L - 1);
    const float a = 2.f * (float)ph / (float)L;
    const float v = (j >= L) ? -sinpif(a) : cospif(a);
    dst[idx] = f2bf(v);
  }
}

#define P0_WT 288
#define P0_ADA 768
#define P0_XC 0
#define P0_CK 320
#define P0_CVT 320
#define P0_PQ 128
#define P0_DFT 272
#define P0_ITEMS (P0_ADA + P0_WT + P0_XC + P0_CK + P0_CVT + P0_PQ + P0_DFT + 1)

__device__ void wt_item(const Params& p, int l, int r, float* sm) {
  if (r < 288) { transpose_tile(p.w_in + (size_t)l * 1024 * 2304, 2304, p.w_inT + (size_t)l * 2304 * 1024, 1024, (r / 36) * 128, (r % 36) * 64, sm); return; }
  r -= 288;
  if (r < 128) { transpose_tile(p.w_out + (size_t)l * 1024 * 1024, 1024, p.w_outT + (size_t)l * 1024 * 1024, 1024, (r / 16) * 128, (r % 16) * 64, sm); return; }
  r -= 128;
  if (r < 512) { transpose_tile(p.w1 + (size_t)l * 1024 * 4096, 4096, p.w1T + (size_t)l * 4096 * 1024, 1024, (r / 64) * 128, (r % 64) * 64, sm); return; }
  r -= 512;
  transpose_tile(p.w2 + (size_t)l * 4096 * 1024, 1024, p.w2T + (size_t)l * 1024 * 4096, 4096, (r / 16) * 128, (r % 16) * 64, sm);
}

__device__ void p0_item(const Params& p, int it, unsigned char* smem) {
  float* sm = (float*)smem;
  if (it < P0_ADA) { adaln_item(p, it, sm); return; }
  it -= P0_ADA;
  if (it < P0_WT) { wt_item(p, 0, it, sm); return; }
  it -= P0_WT;
  if (it < P0_XC) {
    const int row0 = it * 16;
    const float* src = row0 < NPTOK ? p.x_prompt + (size_t)row0 * 1024 : p.x_sample + (size_t)(row0 - NPTOK) * 1024;
    float* dst = p.xres + (size_t)row0 * 1024;
#pragma unroll
    for (int i = 0; i < 16; ++i) {
      const int o = (i * 256 + otid()) * 4;
      *(float4*)(dst + o) = *(const float4*)(src + o);
    }
    return;
  }
  it -= P0_XC;
  if (it < P0_CK) {
    if (it < 128) { cvt_item(p.c_na_k, p.ck_na, it, 256); return; }
    it -= 128;
    if (it < 128) { cvt_item(p.c_diff_k, p.ck_diff, it, 256); return; }
    it -= 128;
    cvt_item(p.c_swa_k, p.ck_swa, it, 128);
    return;
  }
  it -= P0_CK;
  if (it < P0_CVT) {
    if (it < 128) { const int bl = it >> 4, r = it & 15; transpose_tile(p.c_na_v + (size_t)bl * 512 * 256, 256, p.cvt_na + (size_t)bl * 256 * 512, 512, (r >> 2) * 128, (r & 3) * 64, sm, true); return; }
    it -= 128;
    if (it < 128) { const int bl = it >> 4, r = it & 15; transpose_tile(p.c_diff_v + (size_t)bl * 512 * 256, 256, p.cvt_diff + (size_t)bl * 256 * 512, 512, (r >> 2) * 128, (r & 3) * 64, sm, true); return; }
    it -= 128;
    { const int bl = it >> 3, r = it & 7; transpose_tile(p.c_swa_v + (size_t)bl * 512 * 128, 128, p.cvt_swa + (size_t)bl * 128 * 512, 512, (r >> 1) * 128, (r & 1) * 64, sm, true); return; }
  }
  it -= P0_CVT;
  if (it < P0_PQ) { pq_item(p, it, sm); return; }
  it -= P0_PQ;
  if (it < 16) { dft_item(p.dft256, 256, it); return; }
  it -= 16;
  if (it < 256) { dft_item(p.dft1024, 1024, it); return; }
  for (int e = otid(); e < 512 + 1024; e += 256) {
    const bool isD = e < 512;
    const int ee = isD ? e : e - 512;
    const int nf = isD ? 8 : 16;
    const int pos = ee / nf, fi = ee % nf;
    const float inv = exp2f(-(float)fi * (13.287712379549449f / (float)nf));
    float tt = (float)pos * inv * 0.15915494309189535f;
    tt -= rintf(tt);
    float sn, cs;
    sincospif(2.f * tt, &sn, &cs);
    if (isD) { p.ropeD[ee] = cs; p.ropeD[512 + ee] = sn; }
    else { p.ropeS[ee] = cs; p.ropeS[1024 + ee] = sn; }
  }
}

__device__ __forceinline__ void norm_item(const Params& p, int l, int which, int it) {
  const int lane = otid() & 63, wave = otid() >> 6;
  const int row0 = it * 16 + wave * 4;
  const float* xsrc = (which == 0 && l == 0) ? (row0 < NPTOK ? p.x_prompt + (size_t)row0 * 1024 : p.x_sample + (size_t)(row0 - NPTOK) * 1024)
                                             : p.xres + (size_t)row0 * 1024;
  float4 v[4][4];
#pragma unroll
  for (int j = 0; j < 4; ++j)
#pragma unroll
    for (int k = 0; k < 4; ++k) v[j][k] = *(const float4*)(xsrc + (size_t)j * 1024 + (k * 64 + lane) * 4);
  float rs[4];
#pragma unroll
  for (int j = 0; j < 4; ++j) {
    float ss = 0.f;
#pragma unroll
    for (int k = 0; k < 4; ++k) ss += v[j][k].x * v[j][k].x + v[j][k].y * v[j][k].y + v[j][k].z * v[j][k].z + v[j][k].w * v[j][k].w;
#pragma unroll
    for (int o = 32; o >= 1; o >>= 1) ss += __shfl_xor(ss, o);
    rs[j] = rsqrtf(ss * (1.f / 1024.f) + 1e-6f);
  }
  if (which < 2) {
    const int cond = row0 < NPTOK ? 0 : 1 + ((row0 - NPTOK) >> 10);
    const float* gp = (which == 0 ? p.norm1_g : p.norm2_g) + l * 1024;
    const float* shp = p.mods + (size_t)(l * 3 + cond) * 6144 + (which * 3 + 0) * 1024;
    const float* scp = shp + 1024;
#pragma unroll
    for (int k = 0; k < 4; ++k) {
      const int col = (k * 64 + lane) * 4;
      const float4 gg = *(const float4*)(gp + col);
      const float4 sh = *(const float4*)(shp + col);
      const float4 sc = *(const float4*)(scp + col);
      const float mx = gg.x * (1.f + sc.x), my = gg.y * (1.f + sc.y), mz = gg.z * (1.f + sc.z), mw = gg.w * (1.f + sc.w);
#pragma unroll
      for (int j = 0; j < 4; ++j) {
        uint2 w;
        w.x = pack2(v[j][k].x * rs[j] * mx + sh.x, v[j][k].y * rs[j] * my + sh.y);
        w.y = pack2(v[j][k].z * rs[j] * mz + sh.z, v[j][k].w * rs[j] * mw + sh.w);
        *(uint2*)(p.h + (size_t)(row0 + j) * 1024 + col) = w;
      }
    }
  } else {
#pragma unroll
    for (int k = 0; k < 4; ++k) {
      const int col = (k * 64 + lane) * 4;
      const float4 gg = *(const float4*)(p.final_g + col);
#pragma unroll
      for (int j = 0; j < 4; ++j) {
        float4 o;
        o.x = v[j][k].x * rs[j] * gg.x; o.y = v[j][k].y * rs[j] * gg.y; o.z = v[j][k].z * rs[j] * gg.z; o.w = v[j][k].w * rs[j] * gg.w;
        { f32x4 ov = {o.x, o.y, o.z, o.w}; __builtin_nontemporal_store(ov, (f32x4*)(p.out + (size_t)(row0 + j) * 1024 + col)); }
      }
    }
  }
}

template <bool ZERO, int YT>
__device__ __forceinline__ void gemm_main_t(const u16* __restrict__ X, int ldx, const u16* __restrict__ Y, int ldy, int K,
                                          u16* smem, f32x4 (&acc)[4][YT]) {
  const int tid = otid(), lane = tid & 63, wave = tid >> 6, wx = wave & 1, wy = wave >> 1, r = lane & 15, g = lane >> 4;
  u16* sX = smem;
  u16* sY = smem + 2 * 128 * 64;
  const int lrow = tid >> 3, lkc = tid & 7;
  const int gsw = (lkc ^ (lrow & 7)) * 8;
  const u16* gx = X + (size_t)lrow * ldx + gsw;
  const u16* gy = Y + (size_t)lrow * ldy + gsw;
  u16* lx = sX + tid * 8;
  u16* ly = sY + tid * 8;
#define GEMM_STAGE(buf, kt_)                                                                                                      \
  {                                                                                                                               \
    _Pragma("unroll") for (int i = 0; i < 4; ++i)                                                                                 \
      __builtin_amdgcn_global_load_lds((const unsigned*)(gx + (size_t)(32 * i) * ldx + (kt_) * 64),                               \
                                       (unsigned*)(lx + (buf) * 8192 + i * 2048), 16, 0, 0);                                      \
    _Pragma("unroll") for (int i = 0; i < YT; ++i)                                                                                \
      __builtin_amdgcn_global_load_lds((const unsigned*)(gy + (size_t)(32 * i) * ldy + (kt_) * 64),                               \
                                       (unsigned*)(ly + (buf) * 8192 + i * 2048), 16, 0, 0);                                      \
  }
  GEMM_STAGE(0, 0);
  if (ZERO) {
#pragma unroll
    for (int a = 0; a < 4; ++a)
#pragma unroll
      for (int b = 0; b < YT; ++b) acc[a][b] = (f32x4){0.f, 0.f, 0.f, 0.f};
  }
  const int nk = K >> 6;
  const int sw = r & 7;
  const u16* cx0 = sX + (wx * 64 + r) * 64;
  const u16* cy0 = sY + (wy * (16 * YT) + r) * 64;
  __syncthreads();
#define GEMM_COMPUTE(cur)                                                                            \
  {                                                                                                  \
    const u16* cx = cx0 + (cur) * 8192;                                                              \
    const u16* cy = cy0 + (cur) * 8192;                                                              \
    const int pc0 = (g ^ sw) * 8, pc1 = ((4 + g) ^ sw) * 8;                                          \
    bf16x8 a0[4], b0[YT], a1[4], b1[YT];                                                             \
    _Pragma("unroll") for (int i = 0; i < 4; ++i) a0[i] = *(const bf16x8*)(cx + i * 16 * 64 + pc0);  \
    _Pragma("unroll") for (int i = 0; i < YT; ++i) b0[i] = *(const bf16x8*)(cy + i * 16 * 64 + pc0); \
    _Pragma("unroll") for (int i = 0; i < 4; ++i) a1[i] = *(const bf16x8*)(cx + i * 16 * 64 + pc1);  \
    _Pragma("unroll") for (int i = 0; i < YT; ++i) b1[i] = *(const bf16x8*)(cy + i * 16 * 64 + pc1); \
    __builtin_amdgcn_s_setprio(1);                                                                   \
    _Pragma("unroll") for (int xi = 0; xi < 4; ++xi)                                                 \
      _Pragma("unroll") for (int yi = 0; yi < YT; ++yi)                                              \
        acc[xi][yi] = __builtin_amdgcn_mfma_f32_16x16x32_bf16(a0[xi], b0[yi], acc[xi][yi], 0, 0, 0); \
    _Pragma("unroll") for (int xi = 0; xi < 4; ++xi)                                                 \
      _Pragma("unroll") for (int yi = 0; yi < YT; ++yi)                                              \
        acc[xi][yi] = __builtin_amdgcn_mfma_f32_16x16x32_bf16(a1[xi], b1[yi], acc[xi][yi], 0, 0, 0); \
    __builtin_amdgcn_s_setprio(0);                                                                   \
  }
#pragma unroll 1
  for (int kt = 0; kt < nk - 1; ++kt) {
    const int cur = kt & 1;
    GEMM_STAGE(cur ^ 1, kt + 1);
    GEMM_COMPUTE(cur);
    __syncthreads();
  }
  GEMM_COMPUTE((nk - 1) & 1);
  __syncthreads();
#undef GEMM_COMPUTE
#undef GEMM_STAGE
}

#ifndef REP_GEMM
#define REP_GEMM 0
#endif
#ifndef REP_MIX
#define REP_MIX 0
#endif
#ifndef REP_SYNC
#define REP_SYNC 0
#endif
#ifndef REP_P0
#define REP_P0 0
#endif
template <int YT>
__device__ __forceinline__ void gemm_main(const u16* __restrict__ X, int ldx, const u16* __restrict__ Y, int ldy, int K,
                                          u16* smem, f32x4 (&acc)[4][YT]) {
  gemm_main_t<true, YT>(X, ldx, Y, ldy, K, smem, acc);
#if REP_GEMM
  gemm_main_t<false, YT>(X, ldx, Y, ldy, K, smem, acc);
#pragma unroll
  for (int a = 0; a < 4; ++a)
#pragma unroll
    for (int b = 0; b < YT; ++b) acc[a][b] *= 0.5f;
#endif
}

__device__ __forceinline__ bool tile_map(int j, int ntx, int& tx, int& ty, int nty = 48) {
  const int nblk = gridDim.x, bid = blockIdx.x;
  if (nblk == 512) {
    const int per = nty >> 3, hp = per >> 1;
    const int rank = bid >> 3, q = (rank & 31) + j * 32, mem = rank >> 5;
    if (q >= hp * ntx) return false;
    tx = q / hp; ty = per * (bid & 7) + 2 * (q % hp) + mem;
    return true;
  } else {
    const int it = bid + j * nblk;
    if (it >= nty * ntx) return false;
    tx = it / nty; ty = it % nty;
    return true;
  }
}

__device__ void gin_tile(const Params& p, int l, int tx, int ty, u16* smem) {
  const int n0 = tx * 128, m0 = ty * 128;
  f32x4 acc[4][4];
  gemm_main<4>(p.w_inT + (size_t)l * 2304 * 1024 + (size_t)n0 * 1024, 1024, p.h + (size_t)m0 * 1024, 1024, 1024, smem, acc);
  const int lane = otid() & 63, wave = otid() >> 6, wx = wave & 1, wy = wave >> 1, r = lane & 15, g = lane >> 4;
  const int nw = n0 + wx * 64;
  const bool isS = m0 >= NPTOK;
  int ropeMode = 0;
  if (isS) {
    if (nw >= 768 && nw < 1280) ropeMode = 1;
    else if (nw >= 1792 && nw < 2176) ropeMode = 2;
  }
  float* okv = nullptr; int okv_w = 0, okv_c = 0;
  if (!isS) {
    if (nw >= 256 && nw < 512) { okv = p.out + O_NAK; okv_w = 256; okv_c = nw - 256; }
    else if (nw >= 512 && nw < 768) { okv = p.out + O_NAV; okv_w = 256; okv_c = nw - 512; }
    else if (nw >= 1024 && nw < 1280) { okv = p.out + O_DK; okv_w = 256; okv_c = nw - 1024; }
    else if (nw >= 1280 && nw < 1536) { okv = p.out + O_DV; okv_w = 256; okv_c = nw - 1280; }
    else if (nw >= 2048 && nw < 2176) { okv = p.out + O_SK; okv_w = 128; okv_c = nw - 2048; }
    else if (nw >= 2176) { okv = p.out + O_SV; okv_w = 128; okv_c = nw - 2176; }
  }
  int khh = -1;
  if (nw >= 256 && nw < 512) khh = (nw - 256) >> 6;
  else if (nw >= 1024 && nw < 1280) khh = 4 + ((nw - 1024) >> 6);
  else if (nw >= 2048 && nw < 2176) khh = 8 + ((nw - 2048) >> 6);
  int vrow = -1;
  if (nw >= 512 && nw < 768) vrow = nw - 512;
  else if (nw >= 1280 && nw < 1536) vrow = 256 + nw - 1280;
  else if (nw >= 2176) vrow = 512 + nw - 2176;
#pragma unroll
  for (int yi = 0; yi < 4; ++yi) {
    const int m = m0 + wy * 64 + yi * 16 + r;
    const int t = (m - NPTOK) & 1023;
    const int prow = t >> 6, pcol = t & 63;
#pragma unroll
    for (int xi = 0; xi < 4; ++xi) {
      f32x4 v = acc[xi][yi];
      if (ropeMode == 1) {
        const int pos = (xi & 1) ? pcol : prow;
        const float4 cs = *(const float4*)(p.ropeD + pos * 8 + 4 * (g & 1));
        const float4 sn = *(const float4*)(p.ropeD + 512 + pos * 8 + 4 * (g & 1));
        const float sg = (g >= 2) ? 1.f : -1.f;
        const float o0 = __shfl_xor(v[0], 32), o1 = __shfl_xor(v[1], 32), o2 = __shfl_xor(v[2], 32), o3 = __shfl_xor(v[3], 32);
        v[0] = v[0] * cs.x + sg * o0 * sn.x; v[1] = v[1] * cs.y + sg * o1 * sn.y;
        v[2] = v[2] * cs.z + sg * o2 * sn.z; v[3] = v[3] * cs.w + sg * o3 * sn.w;
      } else if (ropeMode == 2) {
        const int pos = (xi >> 1) ? pcol : prow;
        const float4 cs = *(const float4*)(p.ropeS + pos * 16 + 4 * g);
        const float4 sn = *(const float4*)(p.ropeS + 1024 + pos * 16 + 4 * g);
        const f32x4 o = acc[xi ^ 1][yi];
        const float sg = (xi & 1) ? 1.f : -1.f;
        v[0] = v[0] * cs.x + sg * o[0] * sn.x; v[1] = v[1] * cs.y + sg * o[1] * sn.y;
        v[2] = v[2] * cs.z + sg * o[2] * sn.z; v[3] = v[3] * cs.w + sg * o[3] * sn.w;
      }
      const int nloc = xi * 16 + 4 * g;
      if (okv) {
        const int b = m >> 8, pos = m & 255;
        float4 o4; o4.x = v[0]; o4.y = v[1]; o4.z = v[2]; o4.w = v[3];
        __builtin_nontemporal_store(v, (f32x4*)(okv + ((size_t)((b * 4 + l) * 256 + pos)) * okv_w + okv_c + nloc));
      }
      if (vrow >= 0) {
        u16* vb = p.vfr + ((size_t)((vrow >> 6) * 192 + (m >> 5))) * 2048;
#pragma unroll
        for (int i = 0; i < 4; ++i) vb[vfrag_off(m & 31, nloc + i)] = f2bf(v[i]);
      } else if (khh >= 0) {
        uint2 w; w.x = pack2(v[0], v[1]); w.y = pack2(v[2], v[3]);
        *(uint2*)(p.kfr + ((size_t)(khh * 192 + (m >> 5))) * 2048 + kfrag_off(m & 31, nloc)) = w;
      } else {
        uint2 w; w.x = pack2(v[0], v[1]); w.y = pack2(v[2], v[3]);
        *(uint2*)(p.z + (size_t)m * INW + nw + nloc) = w;
      }
    }
  }
}

__device__ void res_tile(const Params& p, int l, int tx, int ty, const u16* A, const u16* WT, int K, int gi, u16* smem, bool first = false) {
  const int n0 = tx * 128, m0 = ty * 96;
  f32x4 acc[4][3];
  gemm_main<3>(WT + (size_t)n0 * K, K, A + (size_t)m0 * K, K, K, smem, acc);
  const int lane = otid() & 63, wave = otid() >> 6, wx = wave & 1, wy = wave >> 1, r = lane & 15, g = lane >> 4;
#pragma unroll
  for (int yi = 0; yi < 3; ++yi) {
    const int m = m0 + wy * 48 + yi * 16 + r;
    const int cond = m < NPTOK ? 0 : 1 + ((m - NPTOK) >> 10);
    const float* gate = p.mods + (size_t)(l * 3 + cond) * 6144 + gi * 1024;
    float* xrow = p.xres + (size_t)m * 1024;
    const float* xin = first ? (m < NPTOK ? p.x_prompt + (size_t)m * 1024 : p.x_sample + (size_t)(m - NPTOK) * 1024) : xrow;
    float4 xv[4], gt[4];
#pragma unroll
    for (int xi = 0; xi < 4; ++xi) {
      const int n = n0 + wx * 64 + xi * 16 + 4 * g;
      xv[xi] = *(const float4*)(xin + n);
      gt[xi] = *(const float4*)(gate + n);
    }
#pragma unroll
    for (int xi = 0; xi < 4; ++xi) {
      const int n = n0 + wx * 64 + xi * 16 + 4 * g;
      const f32x4 v = acc[xi][yi];
      float4 o = xv[xi];
      o.x += gt[xi].x * v[0]; o.y += gt[xi].y * v[1]; o.z += gt[xi].z * v[2]; o.w += gt[xi].w * v[3];
      *(float4*)(xrow + n) = o;
    }
  }
}

__device__ void m1_tile(const Params& p, int l, int tx, int ty, u16* smem) {
  const int n0 = tx * 128, m0 = ty * 128;
  f32x4 acc[4][4];
  gemm_main<4>(p.w1T + (size_t)l * 4096 * 1024 + (size_t)n0 * 1024, 1024, p.h + (size_t)m0 * 1024, 1024, 1024, smem, acc);
  const int lane = otid() & 63, wave = otid() >> 6, wx = wave & 1, wy = wave >> 1, r = lane & 15, g = lane >> 4;
#pragma unroll
  for (int xi = 0; xi < 4; ++xi) {
    const int n = n0 + wx * 64 + xi * 16 + 4 * g;
#pragma unroll
    for (int yi = 0; yi < 4; ++yi) {
      const int m = m0 + wy * 64 + yi * 16 + r;
      const f32x4 v = acc[xi][yi];
      float a0 = fmaxf(v[0], 0.f), a1 = fmaxf(v[1], 0.f), a2 = fmaxf(v[2], 0.f), a3 = fmaxf(v[3], 0.f);
      uint2 w; w.x = pack2(a0 * a0, a1 * a1); w.y = pack2(a2 * a2, a3 * a3);
      *(uint2*)(p.u + (size_t)m * 4096 + n) = w;
    }
  }
}

__device__ void f1_tile(const Params& p, int l, int it, u16* smem) {
  const int tx = it % 48, ty = it / 48;
  const int x0 = tx * 128, y0 = ty * 128;
  f32x4 acc[4][4];
  gemm_main<4>(p.z + (size_t)x0 * INW + 1536, INW, p.pqt + (size_t)l * 512 * 256 + (size_t)y0 * 256, 256, 256, smem, acc);
  const int lane = otid() & 63, wave = otid() >> 6, wx = wave & 1, wy = wave >> 1, r = lane & 15, g = lane >> 4;
#pragma unroll
  for (int yi = 0; yi < 4; ++yi) {
    const int y = y0 + wy * 64 + yi * 16 + r;
    const int col = y & 255, which = y >> 8;
#pragma unroll
    for (int xi = 0; xi < 4; ++xi) {
      const int tok = x0 + wx * 64 + xi * 16 + 4 * g;
      size_t addr;
      if (tok < NPTOK) {
        const int b = tok >> 8, pos = tok & 255;
        addr = (size_t)b * (256 * 512) + (size_t)col * 512 + which * 256 + pos;
      } else {
        const int b = (tok - NPTOK) >> 10, pos = (tok - NPTOK) & 1023;
        addr = (size_t)16 * 256 * 512 + (size_t)b * (256 * 2048) + (size_t)col * 2048 + which * 1024 + pos;
      }
      const f32x4 v = acc[xi][yi];
      uint2 w; w.x = pack2(v[0], v[1]); w.y = pack2(v[2], v[3]);
      *(uint2*)(p.uv + addr) = w;
    }
  }
  asm volatile("s_waitcnt vmcnt(0)" ::: "memory");
  __syncthreads();
  if (threadIdx.x == 0) {
    __builtin_amdgcn_fence(__ATOMIC_RELEASE, "agent");
    asm volatile("s_waitcnt vmcnt(0)" ::: "memory");
    xb_add(p.bar + XCD_BAR_WORDS + (8 + l) * 64, 1u);
  }
}

__device__ void f2_tile(const Params& p, int l, int it, u16* smem) {
  if (threadIdx.x == 0) {
    unsigned* c = p.bar + XCD_BAR_WORDS + (8 + l) * 64;
    unsigned sp = 0;
    while (xb_ld(c) < 192u) { __builtin_amdgcn_s_sleep(2); if (++sp > (1u << 24)) break; }
    __builtin_amdgcn_fence(__ATOMIC_ACQUIRE, "agent");
    asm volatile("s_waitcnt vmcnt(0)" ::: "memory");
  }
  __syncthreads();
  int L, b, tx, ty, tokbase;
  const u16* uvb; const u16* dft;
  if (it < 32) { L = 1024; b = it >> 4; tx = (it >> 3) & 1; ty = it & 7; uvb = p.uv + (size_t)16 * 256 * 512 + (size_t)b * (256 * 2048); dft = p.dft1024; tokbase = NPTOK + b * 1024; }
  else { it -= 32; L = 256; b = it >> 2; tx = (it >> 1) & 1; ty = it & 1; uvb = p.uv + (size_t)b * (256 * 512); dft = p.dft256; tokbase = b * 256; }
  const int x0 = tx * 128, y0 = ty * 128, K = 2 * L;
  f32x4 acc[4][4];
  gemm_main<4>(uvb + (size_t)x0 * K, K, dft + (size_t)y0 * K, K, K, smem, acc);
  const int lane = otid() & 63, wave = otid() >> 6, wx = wave & 1, wy = wave >> 1, r = lane & 15, g = lane >> 4;
  const float scale = rsqrtf(64.f * (float)L);
#pragma unroll
  for (int yi = 0; yi < 4; ++yi) {
    const int pos = y0 + wy * 64 + yi * 16 + r;
#pragma unroll
    for (int xi = 0; xi < 4; ++xi) {
      const int col = x0 + wx * 64 + xi * 16 + 4 * g;
      const f32x4 v = acc[xi][yi];
      uint2 w; w.x = pack2(v[0] * scale, v[1] * scale); w.y = pack2(v[2] * scale, v[3] * scale);
      *(uint2*)(p.cat + (size_t)(tokbase + pos) * 1024 + 512 + col) = w;
    }
  }
}

struct Seg { const u16* K; const u16* Vt; int ldk, ldv, nblk, pos0, stride; };
#define KLOC(hh, tokb) (p.kfr + ((size_t)((hh) * 192 + ((tokb) >> 5))) * 2048)
#define VLOC(hh, tokb) (p.vfr + ((size_t)((hh) * 192 + ((tokb) >> 5))) * 2048)
template <int QT> struct AState { float m[QT]; float ls[QT]; f32x4 o[QT][4]; };

__device__ __forceinline__ bf16x8 as_bf(u32x4 v) { union { u32x4 u; bf16x8 b; } x; x.u = v; return x.b; }

template <int DC>
__device__ __forceinline__ void issue_blk(const Seg& s0, const Seg& s1, int b, int r, int g, u32x4 (&kf)[2][DC], u32x4 (&vf)[4]) {
  const bool in0 = b < s0.nblk;
  const u16* Kp = in0 ? s0.K : s1.K;
  const u16* Vp = in0 ? s0.Vt : s1.Vt;
  const int pos = in0 ? (s0.pos0 + b * s0.stride) : (s1.pos0 + (b - s0.nblk) * s1.stride);
  const int lane8 = (g * 16 + r) * 8;
  const u16* kp = Kp + (size_t)(pos >> 5) * 2048 + lane8;
  const u16* vp = Vp + (size_t)(pos >> 5) * 2048 + lane8;
#pragma unroll
  for (int t = 0; t < 2; ++t)
#pragma unroll
    for (int dc = 0; dc < DC; ++dc) gload16(kf[t][dc], kp + (t * 2 + dc) * 512);
#pragma unroll
  for (int dv = 0; dv < 4; ++dv) gload16(vf[dv], vp + dv * 512);
}
template <int N>
__device__ __forceinline__ void wait_blk(u32x4 (&kf)[2][1], u32x4 (&vf)[4]) {
  asm volatile("s_waitcnt vmcnt(%6)" : "+v"(kf[0][0]), "+v"(kf[1][0]), "+v"(vf[0]), "+v"(vf[1]), "+v"(vf[2]), "+v"(vf[3]) : "n"(N) : "memory");
}
template <int N>
__device__ __forceinline__ void wait_blk(u32x4 (&kf)[2][2], u32x4 (&vf)[4]) {
  asm volatile("s_waitcnt vmcnt(%8)" : "+v"(kf[0][0]), "+v"(kf[0][1]), "+v"(kf[1][0]), "+v"(kf[1][1]), "+v"(vf[0]), "+v"(vf[1]), "+v"(vf[2]), "+v"(vf[3]) : "n"(N) : "memory");
}

template <int D, int QT, int MODE>
__device__ __forceinline__ void attn_compute(const u32x4 (&kc)[2][D / 32], const u32x4 (&vc)[4], const bf16x8 (&qf)[QT][D / 32], const float sc,
                                             AState<QT>& st, const bool in0, const int pos, const int qpos0, const float* __restrict__ rpb_h,
                                             const int r, const int g) {
  constexpr int DC = D / 32;
#pragma unroll
  for (int q = 0; q < QT; ++q) {
    f32x4 s_[2];
    s_[0] = (f32x4){0.f, 0.f, 0.f, 0.f};
    s_[1] = (f32x4){0.f, 0.f, 0.f, 0.f};
#pragma unroll
    for (int t = 0; t < 2; ++t)
#pragma unroll
      for (int dc = 0; dc < DC; ++dc) s_[t] = __builtin_amdgcn_mfma_f32_16x16x32_bf16(as_bf(kc[t][dc]), qf[q][dc], s_[t], 0, 0, 0);
    float sv[8];
#pragma unroll
    for (int t = 0; t < 2; ++t)
#pragma unroll
      for (int i = 0; i < 4; ++i) {
        float x = s_[t][i] * sc;
        if (MODE == 1) {
          if (!in0) {
            const int qpos = qpos0 + q * 16 + r;
            const int qrow = qpos >> 6, cq = qpos & 63;
            const int kpos = pos + 8 * g + 4 * t + i;
            const int krow = kpos >> 6, ck = kpos & 63;
            const int cs = min(max(cq - 8, 0), 48);
            const bool valid = (ck >= cs) && (ck < cs + 16);
            const int bi = (krow - qrow + 7) * 31 + (ck - cq + 15);
            const float bias = rpb_h[valid ? bi : 0];
            x = valid ? (x + bias) : -1e30f;
          }
        } else if (MODE == 2) {
          if (!in0) {
            const int qpos = qpos0 + q * 16 + r;
            const int kpos = pos + 8 * g + 4 * t + i;
            const int d = qpos - kpos;
            x = (d <= 128 && d >= -128) ? x : -1e30f;
          }
        }
        sv[4 * t + i] = x;
      }
    float mx = fmaxf(fmaxf(fmaxf(sv[0], sv[1]), fmaxf(sv[2], sv[3])), fmaxf(fmaxf(sv[4], sv[5]), fmaxf(sv[6], sv[7])));
    mx = fmaxf(mx, __shfl_xor(mx, 16));
    mx = fmaxf(mx, __shfl_xor(mx, 32));
    const float mnew = fmaxf(st.m[q], mx);
    const float alpha = __builtin_amdgcn_exp2f(st.m[q] - mnew);
    st.m[q] = mnew;
    float ps = 0.f;
#pragma unroll
    for (int j = 0; j < 8; ++j) { sv[j] = __builtin_amdgcn_exp2f(sv[j] - mnew); ps += sv[j]; }
    st.ls[q] = st.ls[q] * alpha + ps;
    union { bf16x8 v; unsigned w[4]; } pf;
    pf.w[0] = pack2(sv[0], sv[1]); pf.w[1] = pack2(sv[2], sv[3]); pf.w[2] = pack2(sv[4], sv[5]); pf.w[3] = pack2(sv[6], sv[7]);
#pragma unroll
    for (int dv = 0; dv < 4; ++dv) {
      f32x4 o = st.o[q][dv];
      o[0] *= alpha; o[1] *= alpha; o[2] *= alpha; o[3] *= alpha;
      st.o[q][dv] = __builtin_amdgcn_mfma_f32_16x16x32_bf16(as_bf(vc[dv]), pf.v, o, 0, 0, 0);
    }
  }
}

template <int D, int QT, int MODE, int NQ = 2>
__device__ __forceinline__ void attn_run(const Seg& s0, const Seg& s1, const bf16x8 (&qf)[QT][D / 32], const float sc,
                                         AState<QT>& st, const int qpos0, const float* __restrict__ rpb_h, const int bb = 0, const int be = -1, const int lo2 = -1) {
  constexpr int DC = D / 32;
  constexpr int NL = 2 * DC + 4;
  const int lane = otid() & 63, r = lane & 15, g = lane >> 4;
  const int nb = be < 0 ? s0.nblk + s1.nblk : be;
  u32x4 kq[NQ][2][DC], vq[NQ][4];
#pragma unroll
  for (int q = 0; q < QT; ++q)
#pragma unroll
    for (int dc = 0; dc < DC; ++dc) asm volatile("" ::"v"(qf[q][dc]));
  asm volatile("s_waitcnt vmcnt(0)" ::: "memory");
#pragma unroll 1
  for (int b = bb; b < nb; b += NQ) {
#pragma unroll
    for (int j = 0; j < NQ; ++j) issue_blk<DC>(s0, s1, (lo2 >= 0 && b + j >= bb + 4) ? lo2 + (b + j - bb - 4) : b + j, r, g, kq[j], vq[j]);
#pragma unroll
    for (int j = 0; j < NQ; ++j) {
      if (j == 0) wait_blk<(NQ - 1) * NL>(kq[j], vq[j]);
      else if (j == 1) wait_blk<(NQ - 2) * NL>(kq[j], vq[j]);
      else if (j == 2) wait_blk<(NQ > 3 ? (NQ - 3) * NL : 0)>(kq[j], vq[j]);
      else wait_blk<0>(kq[j], vq[j]);
      const int bj = (lo2 >= 0 && b + j >= bb + 4) ? lo2 + (b + j - bb - 4) : b + j;
      const bool in0 = bj < s0.nblk;
      const int pos = in0 ? (s0.pos0 + bj * s0.stride) : (s1.pos0 + (bj - s0.nblk) * s1.stride);
      attn_compute<D, QT, MODE>(kq[j], vq[j], qf, sc, st, in0, pos, qpos0, rpb_h, r, g);
    }
  }
}

template <int QT>
__device__ __forceinline__ void astate_init(AState<QT>& st, float m0, float l0) {
#pragma unroll
  for (int q = 0; q < QT; ++q) {
    st.m[q] = m0; st.ls[q] = l0;
#pragma unroll
    for (int dv = 0; dv < 4; ++dv) st.o[q][dv] = (f32x4){0.f, 0.f, 0.f, 0.f};
  }
}
template <int QT>
__device__ __forceinline__ void astate_finalize(AState<QT>& st) {
#pragma unroll
  for (int q = 0; q < QT; ++q) {
    float l = st.ls[q];
    l += __shfl_xor(l, 16);
    l += __shfl_xor(l, 32);
    const float inv = 1.f / l;
#pragma unroll
    for (int dv = 0; dv < 4; ++dv) { st.o[q][dv][0] *= inv; st.o[q][dv][1] *= inv; st.o[q][dv][2] *= inv; st.o[q][dv][3] *= inv; }
  }
}
template <int DC, int QT>
__device__ __forceinline__ void load_q(const u16* zq  , bf16x8 (&qf)[QT][DC]) {
  const int lane = otid() & 63, r = lane & 15, g = lane >> 4;
#pragma unroll
  for (int q = 0; q < QT; ++q)
#pragma unroll
    for (int dc = 0; dc < DC; ++dc) qf[q][dc] = *(const bf16x8*)(zq + (size_t)(q * 16 + r) * INW + dc * 32 + g * 8);
}
template <int QT>
__device__ __forceinline__ void write_o(const Params& p, const AState<QT>& st, int tok0, int col0) {
  const int lane = otid() & 63, r = lane & 15, g = lane >> 4;
#pragma unroll
  for (int q = 0; q < QT; ++q)
#pragma unroll
    for (int dv = 0; dv < 4; ++dv) {
      const f32x4 v = st.o[q][dv];
      uint2 w; w.x = pack2(v[0], v[1]); w.y = pack2(v[2], v[3]);
      *(uint2*)(p.cat + (size_t)(tok0 + q * 16 + r) * 1024 + col0 + dv * 16 + 4 * g) = w;
    }
}

__device__ __forceinline__ float diff_lambda(const Params& p, int l, float lam_init) {
  const int lane = otid() & 63;
  float a = 0.f, b = 0.f;
  if (lane < 32) { a = p.lq1[l * 32 + lane] * p.lk1[l * 32 + lane]; b = p.lq2[l * 32 + lane] * p.lk2[l * 32 + lane]; }
#pragma unroll
  for (int o = 32; o >= 1; o >>= 1) { a += __shfl_xor(a, o); b += __shfl_xor(b, o); }
  return expf(a) - expf(b) + lam_init;
}

__device__ __forceinline__ void diff_finish_q(const Params& p, int l, float lam, float lam_init, f32x4 (&A)[4], const f32x4 (&B)[4], int tokrow0, int col0) {
  const int lane = otid() & 63, r = lane & 15, g = lane >> 4;
  const float* sg = p.subln_g + l * 64;
  float ss = 0.f;
#pragma unroll
  for (int dv = 0; dv < 4; ++dv)
#pragma unroll
    for (int i = 0; i < 4; ++i) {
      const float v = A[dv][i] - lam * B[dv][i];
      A[dv][i] = v;
      ss += v * v;
    }
  ss += __shfl_xor(ss, 16);
  ss += __shfl_xor(ss, 32);
  const float rs = rsqrtf(ss * (1.f / 64.f) + 1e-6f) * (1.f - lam_init);
#pragma unroll
  for (int dv = 0; dv < 4; ++dv) {
    const float4 gg = *(const float4*)(sg + dv * 16 + 4 * g);
    uint2 w;
    w.x = pack2(A[dv][0] * rs * gg.x, A[dv][1] * rs * gg.y);
    w.y = pack2(A[dv][2] * rs * gg.z, A[dv][3] * rs * gg.w);
    *(uint2*)(p.cat + (size_t)(tokrow0 + r) * 1024 + col0 + dv * 16 + 4 * g) = w;
  }
}

#ifndef AQT
#define AQT 2
#endif
#define QW (16 * AQT)
#define NQG_CTX (256 / QW)
#define NQG_LAT (1024 / QW)
__device__ void attn_diff_item(const Params& p, int l, bool lat, int bi, float* sm) {
  const int wave = otid() >> 6, lane = otid() & 63, r = lane & 15, g = lane >> 4;
  const int ps = wave >> 1, half = wave & 1;
  int b, h, qg, tokb;
  if (lat) { b = bi / (4 * NQG_LAT); h = (bi / NQG_LAT) & 3; qg = bi % NQG_LAT; tokb = NPTOK + b * 1024; }
  else { b = bi / (4 * NQG_CTX); h = (bi / NQG_CTX) & 3; qg = bi % NQG_CTX; tokb = b * 256; }
  const int tok0 = tokb + qg * QW;
  const u16* zb = p.z + (size_t)tokb * INW;
  Seg s0, s1;
  if (lat) {
    const int bl = b * 4 + l;
    s0.K = p.ck_diff + (size_t)((bl * 4 + h) * 16) * 2048 + ps * 512; s0.Vt = p.cvt_diff + (size_t)((bl * 4 + h) * 16) * 2048;
    s0.ldk = 0; s0.ldv = 0; s0.nblk = half ? 0 : 16; s0.pos0 = 0; s0.stride = 32;
    s1.K = KLOC(4 + h, tokb) + ps * 512; s1.Vt = VLOC(4 + h, tokb);
    s1.ldk = 0; s1.ldv = 0; s1.nblk = half ? 24 : 8; s1.pos0 = half ? 256 : 0; s1.stride = 32;
  } else {
    s0.K = KLOC(4 + h, tokb) + ps * 512; s0.Vt = VLOC(4 + h, tokb);
    s0.ldk = 0; s0.ldv = 0; s0.nblk = 4; s0.pos0 = half ? 128 : 0; s0.stride = 32;
    s1 = s0; s1.nblk = 0;
  }
  bf16x8 qf[AQT][1];
  load_q<1, AQT>(p.z + (size_t)tok0 * INW + 768 + h * 64 + ps * 32, qf);
  AState<AQT> st;
  astate_init<AQT>(st, -1e30f, 0.f);
  attn_run<32, AQT, 0, 2>(s0, s1, qf, 0.17677669529663687f * LOG2E, st, 0, nullptr);
  float lt[AQT];
#pragma unroll
  for (int q = 0; q < AQT; ++q) {
    lt[q] = st.ls[q];
    lt[q] += __shfl_xor(lt[q], 16);
    lt[q] += __shfl_xor(lt[q], 32);
  }
  constexpr int WS = 64 * 16 * AQT;
  float* pm = sm + 4 * WS;
  if (wave != 0) {
    float* po = sm + wave * WS + lane * (16 * AQT);
#pragma unroll
    for (int q = 0; q < AQT; ++q) {
#pragma unroll
      for (int dv = 0; dv < 4; ++dv) *(f32x4*)(po + q * 16 + dv * 4) = st.o[q][dv];
      if (g == 0) { pm[wave * QW + q * 16 + r] = st.m[q]; pm[4 * QW + wave * QW + q * 16 + r] = lt[q]; }
    }
  }
  __syncthreads();
  if (wave == 0) {
    const float lam_init = 0.8f - 0.6f * expf(-0.3f * (float)l);
    const float lam = diff_lambda(p, l, lam_init);
#pragma unroll
    for (int q = 0; q < AQT; ++q) {
      f32x4 A[4], B[4];
      {
        const float m1 = pm[QW + q * 16 + r], l1 = pm[4 * QW + QW + q * 16 + r];
        const float M = fmaxf(st.m[q], m1);
        const float a0 = exp2f(st.m[q] - M), a1 = exp2f(m1 - M);
        const float inv = 1.f / (lt[q] * a0 + l1 * a1);
#pragma unroll
        for (int dv = 0; dv < 4; ++dv) {
          const f32x4 o1 = *(const f32x4*)(sm + 1 * WS + lane * (16 * AQT) + q * 16 + dv * 4);
          A[dv] = (st.o[q][dv] * a0 + o1 * a1) * inv;
        }
      }
      {
        const float m2 = pm[2 * QW + q * 16 + r], l2 = pm[4 * QW + 2 * QW + q * 16 + r], m3 = pm[3 * QW + q * 16 + r], l3 = pm[4 * QW + 3 * QW + q * 16 + r];
        const float M = fmaxf(m2, m3);
        const float a2 = exp2f(m2 - M), a3 = exp2f(m3 - M);
        const float inv = 1.f / (l2 * a2 + l3 * a3);
#pragma unroll
        for (int dv = 0; dv < 4; ++dv) {
          const f32x4 o2 = *(const f32x4*)(sm + 2 * WS + lane * (16 * AQT) + q * 16 + dv * 4);
          const f32x4 o3 = *(const f32x4*)(sm + 3 * WS + lane * (16 * AQT) + q * 16 + dv * 4);
          B[dv] = (o2 * a2 + o3 * a3) * inv;
        }
      }
      diff_finish_q(p, l, lam, lam_init, A, B, tok0 + q * 16, 256 + h * 64);
    }
  }
  __syncthreads();
}

__device__ void attn_ctx_item(const Params& p, int l, int bi) {
  const int wave = otid() >> 6, lane = otid() & 63, g = lane >> 4;
  const int w = bi * 4 + wave;
  const int type = w / (64 * NQG_CTX), rem = w % (64 * NQG_CTX);
  const int b = rem / (4 * NQG_CTX), h = (rem / NQG_CTX) & 3, qg = rem % NQG_CTX;
  const int tokb = b * 256, tok0 = tokb + qg * QW;
  const u16* zb = p.z + (size_t)tokb * INW;
  const int kvh = h >> 1;
  const int qcol = type == 0 ? h * 64 : 1792 + h * 64;
  const int kcol = type == 0 ? 256 + h * 64 : 2048 + kvh * 64;
  const int vrow = type == 0 ? h * 64 : 512 + kvh * 64;
  const int ocol = type == 0 ? h * 64 : 768 + h * 64;
  bf16x8 qf[AQT][2];
  load_q<2, AQT>(p.z + (size_t)tok0 * INW + qcol, qf);
  const int hslot = type == 0 ? h : 8 + kvh;
  Seg s0; s0.K = KLOC(hslot, tokb); s0.Vt = VLOC(hslot, tokb); s0.ldk = 0; s0.ldv = 0; s0.nblk = 8; s0.pos0 = 0; s0.stride = 32;
  Seg sN = s0; sN.nblk = 0;
  AState<AQT> st;
  const float sk = type == 0 ? -1e30f : p.swa_sink[l * 4 + h] * LOG2E;
  astate_init<AQT>(st, sk, (type == 1 && g == 0) ? 1.f : 0.f);
  attn_run<64, AQT, 0, 2>(s0, sN, qf, 0.125f * LOG2E, st, 0, nullptr);
  astate_finalize<AQT>(st);
  write_o<AQT>(p, st, tok0, ocol);
}

__device__ void attn_lat_item(const Params& p, int l, int bi, float* sm) {
  const int wave = otid() >> 6, lane = otid() & 63, r = lane & 15, g = lane >> 4;
  const int type = bi / (8 * NQG_LAT), rem = bi % (8 * NQG_LAT);
  const int b = rem / (4 * NQG_LAT), h = (rem / NQG_LAT) & 3, qg = rem % NQG_LAT;
  const int q0 = qg * QW;
  const int tokb = NPTOK + b * 1024, tok0 = tokb + q0;
  const u16* zb = p.z + (size_t)tokb * INW;
  const int bl = b * 4 + l;
  AState<AQT> st;
  int ocol;
  if (type != 0) {
    const float* rp = p.na_rpb + (size_t)(l * 4 + h) * 15 * 31;
    for (int e = otid(); e < 465; e += 256) sm[9000 + e] = rp[e] * LOG2E;
    __syncthreads();
  }
  if (type == 0) {
    const int kvh = h >> 1;
    bf16x8 qf[AQT][2];
    load_q<2, AQT>(p.z + (size_t)tok0 * INW + 1792 + h * 64, qf);
    Seg s0; s0.K = p.ck_swa + (size_t)((bl * 2 + kvh) * 16) * 2048; s0.Vt = p.cvt_swa + (size_t)((bl * 2 + kvh) * 16) * 2048; s0.ldk = 0; s0.ldv = 0; s0.nblk = 16; s0.pos0 = 0; s0.stride = 32;
    const int lo = max(0, q0 - 128) & ~31;
    const int hi = min(1024, ((q0 + QW + 128) + 31) & ~31);
    int lo2 = lo, cnt = (hi - lo) >> 5;
    if (cnt & 1) { if (lo2 > 0) lo2 -= 32; ++cnt; }
    Seg s1; s1.K = KLOC(8 + kvh, tokb); s1.Vt = VLOC(8 + kvh, tokb); s1.ldk = 0; s1.ldv = 0; s1.nblk = cnt; s1.pos0 = lo2; s1.stride = 32;
    const int P = (16 + cnt) >> 1;
    const int pb = (wave * P) >> 2, pe = ((wave + 1) * P) >> 2;
    astate_init<AQT>(st, wave == 0 ? p.swa_sink[l * 4 + h] * LOG2E : -1e30f, (wave == 0 && g == 0) ? 1.f : 0.f);
    attn_run<64, AQT, 2>(s0, s1, qf, 0.125f * LOG2E, st, q0, nullptr, 2 * pb, 2 * pe);
    ocol = 768 + h * 64;
  } else {
    bf16x8 qf[AQT][2];
    load_q<2, AQT>(p.z + (size_t)tok0 * INW + h * 64, qf);
    Seg s0; s0.K = p.ck_na + (size_t)((bl * 4 + h) * 16) * 2048; s0.Vt = p.cvt_na + (size_t)((bl * 4 + h) * 16) * 2048; s0.ldk = 0; s0.ldv = 0; s0.nblk = 16; s0.pos0 = 0; s0.stride = 32;
    const int qrow = q0 >> 6;
    const int rstart = min(max(qrow - 4, 0), 8);
    Seg s1; s1.K = KLOC(h, tokb); s1.Vt = VLOC(h, tokb); s1.ldk = 0; s1.ldv = 0; s1.nblk = 16; s1.pos0 = rstart * 64; s1.stride = 32;
    astate_init<AQT>(st, -1e30f, 0.f);
    attn_run<64, AQT, 1, 2>(s0, s1, qf, 0.125f * LOG2E, st, q0, sm + 9000, 4 * wave, 4 * wave + 8, 16 + 4 * wave);
    ocol = h * 64;
  }
  float lt[AQT];
#pragma unroll
  for (int q = 0; q < AQT; ++q) {
    lt[q] = st.ls[q];
    lt[q] += __shfl_xor(lt[q], 16);
    lt[q] += __shfl_xor(lt[q], 32);
  }
  constexpr int WS = 64 * 16 * AQT;
  float* pm = sm + 4 * WS;
  if (wave != 0) {
    float* po = sm + wave * WS + lane * (16 * AQT);
#pragma unroll
    for (int q = 0; q < AQT; ++q) {
#pragma unroll
      for (int dv = 0; dv < 4; ++dv) *(f32x4*)(po + q * 16 + dv * 4) = st.o[q][dv];
      if (g == 0) { pm[wave * QW + q * 16 + r] = st.m[q]; pm[4 * QW + wave * QW + q * 16 + r] = lt[q]; }
    }
  }
  __syncthreads();
  if (wave == 0) {
#pragma unroll
    for (int q = 0; q < AQT; ++q) {
      const float m1 = pm[1 * QW + q * 16 + r], m2 = pm[2 * QW + q * 16 + r], m3 = pm[3 * QW + q * 16 + r];
      const float l1 = pm[4 * QW + 1 * QW + q * 16 + r], l2 = pm[4 * QW + 2 * QW + q * 16 + r], l3 = pm[4 * QW + 3 * QW + q * 16 + r];
      const float M = fmaxf(fmaxf(st.m[q], m1), fmaxf(m2, m3));
      const float a0 = __builtin_amdgcn_exp2f(st.m[q] - M), a1 = __builtin_amdgcn_exp2f(m1 - M), a2 = __builtin_amdgcn_exp2f(m2 - M), a3 = __builtin_amdgcn_exp2f(m3 - M);
      const float inv = 1.f / (lt[q] * a0 + l1 * a1 + l2 * a2 + l3 * a3);
#pragma unroll
      for (int dv = 0; dv < 4; ++dv) {
        const f32x4 o1 = *(const f32x4*)(sm + 1 * WS + lane * (16 * AQT) + q * 16 + dv * 4);
        const f32x4 o2 = *(const f32x4*)(sm + 2 * WS + lane * (16 * AQT) + q * 16 + dv * 4);
        const f32x4 o3 = *(const f32x4*)(sm + 3 * WS + lane * (16 * AQT) + q * 16 + dv * 4);
        st.o[q][dv] = (st.o[q][dv] * a0 + o1 * a1 + o2 * a2 + o3 * a3) * inv;
      }
    }
    write_o<AQT>(p, st, tok0, ocol);
  }
  __syncthreads();
}

__device__ __forceinline__ int q_next(unsigned* cnt, volatile LAS unsigned* slot) {
  __syncthreads();
  if (threadIdx.x == 0) *slot = xb_add(cnt, 1u);
  __syncthreads();
  return (int)*slot;
}

#if REP_SYNC
#define GSYNC() do { xcd_barrier(xb); xcd_barrier(xb); } while (0)
#else
#define GSYNC() xcd_barrier(xb)
#endif
__global__ void __launch_bounds__(256, 2) mega(Params p) {
  extern __shared__ __attribute__((aligned(16))) unsigned char smem[];
  cg::grid_group grid = cg::this_grid();
  const int nblk = gridDim.x, bid = blockIdx.x;
  u16* sm16 = (u16*)smem;
  __shared__ uint4 xb_words[2];
  if (threadIdx.x == 0) { xb_words[0] = make_uint4(0u, 0u, 0u, 0u); xb_words[1] = make_uint4(0u, 0u, 0u, 0u); }
  __syncthreads();
  XcdBarrier xb = xcd_barrier_post(p.bar, (volatile LAS unsigned*)&xb_words[0]);

  for (int rep = 0; rep <= REP_P0; ++rep)
    for (int it = bid; it < P0_ITEMS; it += nblk) p0_item(p, it, smem);
  if (p.use_cg_sync) grid.sync();
  GSYNC();

  const int xcc = (int)xb.x;
  const int xrank = __builtin_amdgcn_readfirstlane((int)xb.st[4]), xnloc = __builtin_amdgcn_readfirstlane((int)xb.st[0]);
  const unsigned topo = (unsigned)__builtin_amdgcn_readfirstlane((int)xb.st[5]);
  const bool local = (topo & 1u) != 0u, full64 = (topo & 2u) != 0u;
#define LSYNC() do { if (local) xcd_barrier_local(xb); else GSYNC(); } while (0)
#define LMAP(j, count, total) (local ? ((xrank + (j) * xnloc) < (count) ? (xrank + (j) * xnloc) : -1) : ((bid + (j) * nblk) < (total) ? (bid + (j) * nblk) : -1))

#pragma unroll 1
  for (int l = 0; l < 4; ++l) {
    for (int j = 0;; ++j) { const int v = LMAP(j, 48, 384); if (v < 0) break; norm_item(p, l, 0, local ? 48 * xcc + v : v); }
    LSYNC();
    for (int j = 0;; ++j) {
      const int v = LMAP(j, 108, 864); if (v < 0) break;
      if (local) gin_tile(p, l, v / 6, 6 * xcc + v % 6, sm16); else gin_tile(p, l, v / 48, v % 48, sm16);
    }
    if (full64) {
      if (xrank >= 44) {
        const int idle = xcc * 20 + (xrank - 44);
        for (int it = 288 + idle; it < 1184; it += 160) wt_item(p, l, it, (float*)smem);
      }
    }
    GSYNC();
    {
      constexpr int CD = 64 * NQG_CTX, CC = 2 * 64 * NQG_CTX / 4;
      constexpr int LD = 8 * NQG_LAT, LC = 2 * 8 * NQG_LAT;
      constexpr int E0 = 192, E1 = E0 + LD, E2 = E1 + LC, E3 = E2 + 32, E4 = E3 + CC, E5 = E4 + CD, E6 = E5 + 64;
      unsigned* qc = p.bar + XCD_BAR_WORDS + l * 64;
      const int w0 = full64 ? 1184 : 288;
      const int EA = E6 + (1440 - w0), EW = EA + (l < 3 ? 288 : 0);
      for (int it = bid; it < EW; it = nblk + q_next(qc, &xb.st[2])) {
        if (it >= E6) {
          if (it < EA) wt_item(p, l, it - E6 + w0, (float*)smem);
          else wt_item(p, l + 1, it - EA, (float*)smem);
          continue;
        }
        if (it < E0) f1_tile(p, l, it, sm16);
        else if (it < E0 + LC) attn_lat_item(p, l, it - E0, (float*)smem);
        else if (it < E2) attn_diff_item(p, l, true, it - E0 - LC, (float*)smem);
        else if (it < E3) f2_tile(p, l, it - E2, sm16);
        else if (it < E4) attn_ctx_item(p, l, it - E3);
        else if (it < E5) attn_diff_item(p, l, false, it - E4, (float*)smem);
        else f2_tile(p, l, it - E5 + 32, sm16);
      }
    }
    GSYNC();
    for (int j = 0;; ++j) {
      const int v = LMAP(j, 64, 512); if (v < 0) break;
      if (local) res_tile(p, l, v / 8, 8 * xcc + v % 8, p.cat, p.w_outT + (size_t)l * 1024 * 1024, 1024, 2, sm16, l == 0);
      else res_tile(p, l, v / 64, v % 64, p.cat, p.w_outT + (size_t)l * 1024 * 1024, 1024, 2, sm16, l == 0);
    }
    LSYNC();
    for (int j = 0;; ++j) { const int v = LMAP(j, 48, 384); if (v < 0) break; norm_item(p, l, 1, local ? 48 * xcc + v : v); }
    LSYNC();
    for (int j = 0;; ++j) {
      const int v = LMAP(j, 192, 1536); if (v < 0) break;
      if (local) m1_tile(p, l, v / 6, 6 * xcc + v % 6, sm16); else m1_tile(p, l, v / 48, v % 48, sm16);
    }
    LSYNC();
    for (int j = 0;; ++j) {
      const int v = LMAP(j, 64, 512); if (v < 0) break;
      if (local) res_tile(p, l, v / 8, 8 * xcc + v % 8, p.u, p.w2T + (size_t)l * 1024 * 4096, 4096, 5, sm16);
      else res_tile(p, l, v / 64, v % 64, p.u, p.w2T + (size_t)l * 1024 * 4096, 4096, 5, sm16);
    }
    LSYNC();
  }
  for (int j = 0;; ++j) { const int v = LMAP(j, 48, 384); if (v < 0) break; norm_item(p, 0, 2, local ? 48 * xcc + v : v); }
#undef LSYNC
#undef LMAP
}

extern "C" void kernel_launch(void* const* d_in, const int* in_sizes, int n_in, void* d_out, int out_size, void* d_ws,
                              size_t ws_size, hipStream_t stream) {
  static int grid_blocks = 0;
  if (grid_blocks == 0) {
    int dev = 0, cus = 0, per_cu = 0;
    (void)hipGetDevice(&dev);
    (void)hipDeviceGetAttribute(&cus, hipDeviceAttributeMultiprocessorCount, dev);
    if (hipFuncSetAttribute((const void*)mega, hipFuncAttributeMaxDynamicSharedMemorySize, LDS_BYTES) != hipSuccess) {
      fprintf(stderr, "hipFuncSetAttribute failed\n");
    }
    if (hipOccupancyMaxActiveBlocksPerMultiprocessor(&per_cu, (const void*)mega, 256, LDS_BYTES) != hipSuccess || per_cu < 1) {
      fprintf(stderr, "occupancy query failed (%d)\n", per_cu);
      per_cu = 1;
    }
    if (per_cu > 2) per_cu = 2;
    grid_blocks = cus * per_cu;
    fprintf(stderr, "mega: cus=%d per_cu=%d grid=%d ws=%zu\n", cus, per_cu, grid_blocks, ws_size);
  }
  Params p{};
  const float** pin = (const float**)&p;
  for (int i = 0; i < 27; ++i) pin[i] = (const float*)d_in[i];
  p.out = (float*)d_out;
  unsigned char* ws = (unsigned char*)d_ws;
  size_t off = 0;
  auto take = [&](size_t bytes) { unsigned char* q = ws + off; off += (bytes + 255) & ~(size_t)255; return q; };
  p.xres = (float*)take((size_t)NTOK * 1024 * 4);
  p.mods = (float*)take((size_t)4 * 3 * 6144 * 4);
  p.h = (u16*)take((size_t)NTOK * 1024 * 2);
  p.z = (u16*)take((size_t)NTOK * INW * 2);
  p.vt = (u16*)take((size_t)640 * NTOK * 2);
  p.cat = (u16*)take((size_t)NTOK * 1024 * 2);
  p.u = (u16*)take((size_t)NTOK * 4096 * 2);
  p.uv = (u16*)take((size_t)(16 * 256 * 512 + 2 * 256 * 2048) * 2);
  p.w_inT = (u16*)take((size_t)4 * 2304 * 1024 * 2);
  p.w_outT = (u16*)take((size_t)4 * 1024 * 1024 * 2);
  p.w1T = (u16*)take((size_t)4 * 4096 * 1024 * 2);
  p.w2T = (u16*)take((size_t)4 * 4096 * 1024 * 2);
  p.pqt = (u16*)take((size_t)4 * 512 * 256 * 2);
  p.dft256 = (u16*)take((size_t)256 * 512 * 2);
  p.dft1024 = (u16*)take((size_t)1024 * 2048 * 2);
  p.ck_na = (u16*)take((size_t)2 * 4 * 512 * 256 * 2);
  p.cvt_na = (u16*)take((size_t)2 * 4 * 512 * 256 * 2);
  p.ck_diff = (u16*)take((size_t)2 * 4 * 512 * 256 * 2);
  p.cvt_diff = (u16*)take((size_t)2 * 4 * 512 * 256 * 2);
  p.ck_swa = (u16*)take((size_t)2 * 4 * 512 * 128 * 2);
  p.cvt_swa = (u16*)take((size_t)2 * 4 * 512 * 128 * 2);
  p.kfr = (u16*)take((size_t)10 * 192 * 2048 * 2);
  p.vfr = (u16*)take((size_t)10 * 192 * 2048 * 2);
  p.ropeD = (float*)take(1024 * 4);
  p.ropeS = (float*)take(2048 * 4);
  p.bar = (unsigned*)take(XB_ALL_WORDS * 4);
  if (off > ws_size) { fprintf(stderr, "workspace too small: need %zu have %zu\n", off, ws_size); return; }
  if (hipMemsetAsync(p.bar, 0, XB_ALL_WORDS * 4, stream) != hipSuccess) fprintf(stderr, "memset failed\n");
  void* args[] = {&p};
  hipError_t e = hipLaunchCooperativeKernel((const void*)mega, dim3(grid_blocks), dim3(256), args, LDS_BYTES, stream);
  if (e != hipSuccess) fprintf(stderr, "cooperative launch failed: %s (grid %d)\n", hipGetErrorString(e), grid_blocks);
}
```

```cpp
#include <hip/hip_runtime.h>
#include <hip/hip_cooperative_groups.h>
#include <stdint.h>
#include <stdio.h>
namespace cg = cooperative_groups;

typedef unsigned short u16;
typedef __attribute__((ext_vector_type(8))) short bf16x8;
typedef __attribute__((ext_vector_type(4))) float f32x4;
typedef __attribute__((ext_vector_type(4))) unsigned u32x4;
__device__ __forceinline__ void gload16(u32x4& dst, const void* ptr) {
  asm volatile("global_load_dwordx4 %0, %1, off" : "=v"(dst) : "v"(ptr) : "memory");
}

#define NTOK 6144
#define NPTOK 4096
#define INW 2304
#define LOG2E 1.4426950408889634f
#define LDS_BYTES 73728
#define LSTR 72

#define O_NAK 6291456
#define O_NAV 10485760
#define O_DK 14680064
#define O_DV 18874368
#define O_SK 23068672
#define O_SV 25165824

struct Params {
  const float *x_prompt, *x_sample, *c_na_k, *c_na_v, *c_diff_k, *c_diff_v, *c_swa_k, *c_swa_v, *c, *c_ctx;
  const float *w_ada, *b_ada, *norm1_g, *norm2_g, *w_in, *na_rpb, *lq1, *lk1, *lq2, *lk2, *subln_g, *w_fourier, *swa_sink;
  const float *w_out, *w1, *w2, *final_g;
  float* out;
  float* xres;
  float* mods;
  u16 *h, *z, *vt, *cat, *u, *uv, *w_inT, *w_outT, *w1T, *w2T, *pqt, *dft256, *dft1024;
  u16 *ck_na, *cvt_na, *ck_diff, *cvt_diff, *ck_swa, *cvt_swa;
  float *ropeD, *ropeS;
  u16 *kfr, *vfr;
  unsigned* bar;
  int use_cg_sync;
  int pad_;
};

__device__ __forceinline__ u16 f2bf(float f) {
  unsigned u = __float_as_uint(f);
  u += 0x7fffu + ((u >> 16) & 1u);
  return (u16)(u >> 16);
}
__device__ __forceinline__ int otid() { int t = threadIdx.x; asm volatile("" : "+v"(t)); return t; }
__device__ __forceinline__ float bf2f(u16 h) { return __uint_as_float(((unsigned)h) << 16); }
typedef __attribute__((ext_vector_type(2))) __bf16 hbf16x2;
typedef __attribute__((ext_vector_type(2))) float f32x2;
__device__ __forceinline__ unsigned pack2(float a, float b) {
  f32x2 v = {a, b};
  union { hbf16x2 h; unsigned u; } x;
  x.h = __builtin_convertvector(v, hbf16x2);
  return x.u;
}

__device__ __forceinline__ int kfrag_off(int kk, int d) {
  const int t = (kk >> 2) & 1, r = ((kk >> 3) << 2) | (kk & 3), dc = d >> 5, g = (d >> 3) & 3;
  return ((t * 2 + dc) * 64 + g * 16 + r) * 8 + (d & 7);
}
__device__ __forceinline__ int vfrag_off(int kk, int dv) {
  return (((dv >> 4) * 64) + (kk >> 3) * 16 + (dv & 15)) * 8 + (kk & 7);
}

#define XB_TMO      128
#define XB_XCNT(j)  (256  + 64 * (j))
#define XB_XSUB(j)  (1280 + 64 * (j))
#define XB_XGEN(j)  (2304 + 64 * (j))
#define XB_TOP      3328
#define XB_TOPGEN   3392
#define XCD_BAR_WORDS 3456
#define XB_SPIN_CAP (1u << 22)
#define LAS __attribute__((address_space(3)))
__device__ __forceinline__ unsigned xb_ld(unsigned* p)              { return __hip_atomic_load(p, __ATOMIC_RELAXED, __HIP_MEMORY_SCOPE_AGENT); }
__device__ __forceinline__ unsigned xb_add(unsigned* p, unsigned v) { return __hip_atomic_fetch_add(p, v, __ATOMIC_RELAXED, __HIP_MEMORY_SCOPE_AGENT); }
__device__ __forceinline__ unsigned xb_xcc_id() { return (unsigned)__builtin_amdgcn_s_getreg((3 << 11) | 20) & 0xFu; }
#define XB_SPIN(cond, bar) do { unsigned _sp = 0; while (cond) { __builtin_amdgcn_s_sleep(1); \
    if ((++_sp & 255u) == 0u) { if (xb_ld(&(bar)[XB_TMO])) break; if (_sp > XB_SPIN_CAP) { atomicAdd(&(bar)[XB_TMO], 1u); break; } } } } while (0)
#define XB_LSUB(j)  (XCD_BAR_WORDS + 12 * 64 + 64 * (j))
#define XB_LGEN(j)  (XCD_BAR_WORDS + 12 * 64 + 64 * (16 + (j)))
#define XB_ALL_WORDS (XCD_BAR_WORDS + 12 * 64 + 32 * 64)
struct XcdBarrier { unsigned* bar; unsigned x; volatile LAS unsigned* st; };
__device__ __forceinline__ XcdBarrier xcd_barrier_post(unsigned* bar, volatile LAS unsigned* st) {
  XcdBarrier b; b.bar = bar; b.x = xb_xcc_id(); b.st = st;
  if (threadIdx.x == 0) st[4] = xb_add(&bar[XB_XCNT(b.x)], 1u);
  return b;
}
__device__ __forceinline__ void xcd_barrier_complete(unsigned* bar, unsigned x, unsigned& nloc, unsigned& nx) {
  const unsigned G = gridDim.x * gridDim.y * gridDim.z;
  unsigned sum, cnt, mine, sp = 0u;
  for (;;) {
    sum = 0u; cnt = 0u; mine = 0u;
#pragma unroll
    for (unsigned j = 0; j < 16; ++j) { const unsigned c = xb_ld(&bar[XB_XCNT(j)]); sum += c; cnt += (c > 0u) ? 1u : 0u; mine = (j == x) ? c : mine; }
    if (sum == G) break;
    __builtin_amdgcn_s_sleep(1);
    if ((++sp & 255u) == 0u) { if (xb_ld(&bar[XB_TMO])) break; if (sp > XB_SPIN_CAP) { atomicAdd(&bar[XB_TMO], 1u); break; } }
  }
  nloc = mine > 0u ? mine : 1u; nx = cnt > 0u ? cnt : 1u;
}
__device__ __forceinline__ unsigned xcd_topology(unsigned* bar) {
  const unsigned G = gridDim.x * gridDim.y * gridDim.z;
  unsigned sum8 = 0u, all = 1u, all64 = 1u;
#pragma unroll
  for (unsigned j = 0; j < 8; ++j) { const unsigned c = xb_ld(&bar[XB_XCNT(j)]); sum8 += c; all &= (c > 0u) ? 1u : 0u; all64 &= (c == 64u) ? 1u : 0u; }
  const unsigned ok = (all && sum8 == G) ? 1u : 0u;
  return ok | ((ok && all64) ? 2u : 0u);
}
__device__ __forceinline__ void xcd_barrier(const XcdBarrier& b) {
  asm volatile("s_waitcnt vmcnt(0)" ::: "memory");
  __syncthreads();
  if (threadIdx.x == 0) {
    unsigned* bar = b.bar;
    __builtin_amdgcn_s_waitcnt(0);
    unsigned nloc = b.st[0], nx = b.st[1];
    if (nloc == 0u) { xcd_barrier_complete(bar, b.x, nloc, nx); b.st[0] = nloc; b.st[1] = nx; b.st[5] = xcd_topology(bar); }
    const unsigned old = xb_add(&bar[XB_XSUB(b.x)], 1u);
    const unsigned gen = old / nloc;
    if (old + 1u == (gen + 1u) * nloc) {
      __builtin_amdgcn_fence(__ATOMIC_RELEASE, "agent");
      asm volatile("s_waitcnt vmcnt(0)" ::: "memory");
      const unsigned og = xb_add(&bar[XB_TOP], 1u);
      const unsigned tg = og / nx;
      if (og + 1u == (tg + 1u) * nx) xb_add(&bar[XB_TOPGEN], 1u);
      else XB_SPIN(xb_ld(&bar[XB_TOPGEN]) == tg, bar);
      __builtin_amdgcn_fence(__ATOMIC_ACQUIRE, "agent");
      xb_add(&bar[XB_XGEN(b.x)], 1u);
      asm volatile("s_waitcnt vmcnt(0)" ::: "memory");
    } else {
      XB_SPIN(xb_ld(&bar[XB_XGEN(b.x)]) == gen, bar);
      __builtin_amdgcn_fence(__ATOMIC_ACQUIRE, "agent");
      asm volatile("s_waitcnt vmcnt(0)" ::: "memory");
    }
  }
  __syncthreads();
}

__device__ __forceinline__ void xcd_barrier_local(const XcdBarrier& b) {
  asm volatile("s_waitcnt vmcnt(0)" ::: "memory");
  __syncthreads();
  if (threadIdx.x == 0) {
    unsigned* bar = b.bar;
    __builtin_amdgcn_s_waitcnt(0);
    const unsigned nloc = b.st[0];
    const unsigned old = xb_add(&bar[XB_LSUB(b.x)], 1u);
    const unsigned gen = old / nloc;
    if (old + 1u == (gen + 1u) * nloc) xb_add(&bar[XB_LGEN(b.x)], 1u);
    else XB_SPIN(xb_ld(&bar[XB_LGEN(b.x)]) == gen, bar);
    __builtin_amdgcn_fence(__ATOMIC_ACQUIRE, "agent");
    asm volatile("s_waitcnt vmcnt(0)" ::: "memory");
  }
  __syncthreads();
}

__device__ __forceinline__ void transpose_tile(const float* __restrict__ src, int lds_, u16* __restrict__ dst, int ldd,
                                               int k0, int n0, float* sm, bool fragv = false) {
  const int tid = otid();
  const int c4 = (tid & 15) * 4, r0 = tid >> 4;
  float4 v[8];
#pragma unroll
  for (int i = 0; i < 8; ++i) { const f32x4 t = __builtin_nontemporal_load((const f32x4*)(src + (size_t)(k0 + r0 + 16 * i) * lds_ + n0 + c4)); v[i] = make_float4(t[0], t[1], t[2], t[3]); }
#pragma unroll
  for (int i = 0; i < 8; ++i) {
    const int k = r0 + 16 * i;
    sm[(c4 + 0) * 129 + k] = v[i].x; sm[(c4 + 1) * 129 + k] = v[i].y; sm[(c4 + 2) * 129 + k] = v[i].z; sm[(c4 + 3) * 129 + k] = v[i].w;
  }
  __syncthreads();
  const int k8 = (tid & 15) * 8, nn = tid >> 4;
#pragma unroll
  for (int i = 0; i < 4; ++i) {
    const int n = nn + 16 * i;
    const float* row = sm + n * 129 + k8;
    uint4 w;
    w.x = pack2(row[0], row[1]); w.y = pack2(row[2], row[3]); w.z = pack2(row[4], row[5]); w.w = pack2(row[6], row[7]);
    if (fragv) {
      const int col = n0 + n, pos = k0 + k8;
      *(uint4*)(dst + ((size_t)((col >> 6) * 16 + (pos >> 5))) * 2048 + vfrag_off(pos & 31, col & 63)) = w;
    } else {
      *(uint4*)(dst + (size_t)(n0 + n) * ldd + k0 + k8) = w;
    }
  }
  __syncthreads();
}

__device__ __forceinline__ void adaln_item(const Params& p, int it, float* sm) {
  const int l = it / 192, c0 = (it % 192) * 32;
  float* ssil = sm;
  float* red = sm + 3072;
  const int tid = otid();
  for (int i = tid; i < 3072; i += 256) {
    const int cnd = i >> 10, k = i & 1023;
    const float v = cnd == 0 ? p.c_ctx[k] : p.c[(cnd - 1) * 1024 + k];
    ssil[i] = v / (1.f + expf(-v));
  }
  __syncthreads();
  const int cg4 = (tid & 7) * 4, ks = tid >> 3;
  const float* w = p.w_ada + (size_t)l * 1024 * 6144 + c0 + cg4;
  float a0[4] = {0.f, 0.f, 0.f, 0.f}, a1[4] = {0.f, 0.f, 0.f, 0.f}, a2[4] = {0.f, 0.f, 0.f, 0.f};
#pragma unroll 16
  for (int kk = 0; kk < 32; ++kk) {
    const int k = kk * 32 + ks;
    const f32x4 tv = __builtin_nontemporal_load((const f32x4*)(w + (size_t)k * 6144));
    const float4 v = make_float4(tv[0], tv[1], tv[2], tv[3]);
    const float s0 = ssil[k], s1 = ssil[1024 + k], s2 = ssil[2048 + k];
    a0[0] += s0 * v.x; a0[1] += s0 * v.y; a0[2] += s0 * v.z; a0[3] += s0 * v.w;
    a1[0] += s1 * v.x; a1[1] += s1 * v.y; a1[2] += s1 * v.z; a1[3] += s1 * v.w;
    a2[0] += s2 * v.x; a2[1] += s2 * v.y; a2[2] += s2 * v.z; a2[3] += s2 * v.w;
  }
#pragma unroll
  for (int j = 0; j < 4; ++j) {
    red[(ks * 3 + 0) * 32 + cg4 + j] = a0[j];
    red[(ks * 3 + 1) * 32 + cg4 + j] = a1[j];
    red[(ks * 3 + 2) * 32 + cg4 + j] = a2[j];
  }
  __syncthreads();
  if (tid < 96) {
    const int cnd = tid >> 5, j = tid & 31;
    float s = p.b_ada[l * 6144 + c0 + j];
    for (int q = 0; q < 32; ++q) s += red[(q * 3 + cnd) * 32 + j];
    p.mods[(l * 3 + cnd) * 6144 + c0 + j] = s;
  }
  __syncthreads();
}

__device__ __forceinline__ void cvt_item(const float* __restrict__ src, u16* __restrict__ dst, int it, int W) {
  const int w8 = W >> 3;
#pragma unroll
  for (int i = 0; i < 4; ++i) {
    const int u = it * 1024 + i * 256 + otid();
    const int d8 = u % w8, pos = (u / w8) & 511, bl = u / (w8 * 512);
    const float* sp = src + ((size_t)(bl * 512 + pos) * W + d8 * 8);
    const f32x4 t0 = __builtin_nontemporal_load((const f32x4*)sp), t1 = __builtin_nontemporal_load((const f32x4*)(sp + 4));
    const float4 v0 = make_float4(t0[0], t0[1], t0[2], t0[3]), v1 = make_float4(t1[0], t1[1], t1[2], t1[3]);
    uint4 w; w.x = pack2(v0.x, v0.y); w.y = pack2(v0.z, v0.w); w.z = pack2(v1.x, v1.y); w.w = pack2(v1.z, v1.w);
    const int h = d8 >> 3, d = (d8 & 7) * 8;
    *(uint4*)(dst + ((size_t)((bl * (W >> 6) + h) * 16 + (pos >> 5))) * 2048 + kfrag_off(pos & 31, d)) = w;
  }
}

__device__ __forceinline__ void pq_item(const Params& p, int it, float* sm) {
  const int cq = it & 3, it2 = it >> 2;
  const int l = it2 >> 3, which = (it2 >> 2) & 1, g = it2 & 3;
  const int n = otid();
  if (n < 64) sm[n] = which ? sinpif(2.f * (float)n / 64.f) : cospif(2.f * (float)n / 64.f);
  __syncthreads();
  float w[64];
#pragma unroll
  for (int m = 0; m < 64; ++m) w[m] = p.w_fourier[(size_t)l * 65536 + (g * 64 + m) * 256 + n];
  u16* dst = p.pqt + (size_t)l * 512 * 256 + (size_t)(which * 256 + n) * 256 + g * 64;
  for (int c = cq * 16; c < cq * 16 + 16; ++c) {
    float s = 0.f;
#pragma unroll
    for (int m = 0; m < 64; ++m) s += sm[(c * m) & 63] * w[m];
    dst[c] = f2bf(s);
  }
  __syncthreads();
}

__device__ __forceinline__ void dft_item(u16* dst, int L, int it) {
  const int twoL = 2 * L;
  for (int e = otid(); e < 8192; e += 256) {
    const int idx = it * 8192 + e;
    const int k = idx / twoL, j = idx % twoL;
    const int jj = j & (L - 1);
    const int ph = (k * jj) & (L - 1);
    const float a = 2.f * (float)ph / (float)L;
    const float v = (j >= L) ? -sinpif(a) : cospif(a);
    dst[idx] = f2bf(v);
  }
}

#define P0_WT 288
#define P0_ADA 768
#define P0_XC 0
#define P0_CK 320
#define P0_CVT 320
#define P0_PQ 128
#define P0_DFT 272
#define P0_ITEMS (P0_ADA + P0_WT + P0_XC + P0_CK + P0_CVT + P0_PQ + P0_DFT + 1)

__device__ void wt_item(const Params& p, int l, int r, float* sm) {
  if (r < 288) { transpose_tile(p.w_in + (size_t)l * 1024 * 2304, 2304, p.w_inT + (size_t)l * 2304 * 1024, 1024, (r / 36) * 128, (r % 36) * 64, sm); return; }
  r -= 288;
  if (r < 128) { transpose_tile(p.w_out + (size_t)l * 1024 * 1024, 1024, p.w_outT + (size_t)l * 1024 * 1024, 1024, (r / 16) * 128, (r % 16) * 64, sm); return; }
  r -= 128;
  if (r < 512) { transpose_tile(p.w1 + (size_t)l * 1024 * 4096, 4096, p.w1T + (size_t)l * 4096 * 1024, 1024, (r / 64) * 128, (r % 64) * 64, sm); return; }
  r -= 512;
  transpose_tile(p.w2 + (size_t)l * 4096 * 1024, 1024, p.w2T + (size_t)l * 1024 * 4096, 4096, (r / 16) * 128, (r % 16) * 64, sm);
}

__device__ void p0_item(const Params& p, int it, unsigned char* smem) {
  float* sm = (float*)smem;
  if (it < P0_ADA) { adaln_item(p, it, sm); return; }
  it -= P0_ADA;
  if (it < P0_WT) { wt_item(p, 0, it, sm); return; }
  it -= P0_WT;
  if (it < P0_XC) {
    const int row0 = it * 16;
    const float* src = row0 < NPTOK ? p.x_prompt + (size_t)row0 * 1024 : p.x_sample + (size_t)(row0 - NPTOK) * 1024;
    float* dst = p.xres + (size_t)row0 * 1024;
#pragma unroll
    for (int i = 0; i < 16; ++i) {
      const int o = (i * 256 + otid()) * 4;
      *(float4*)(dst + o) = *(const float4*)(src + o);
    }
    return;
  }
  it -= P0_XC;
  if (it < P0_CK) {
    if (it < 128) { cvt_item(p.c_na_k, p.ck_na, it, 256); return; }
    it -= 128;
    if (it < 128) { cvt_item(p.c_diff_k, p.ck_diff, it, 256); return; }
    it -= 128;
    cvt_item(p.c_swa_k, p.ck_swa, it, 128);
    return;
  }
  it -= P0_CK;
  if (it < P0_CVT) {
    if (it < 128) { const int bl = it >> 4, r = it & 15; transpose_tile(p.c_na_v + (size_t)bl * 512 * 256, 256, p.cvt_na + (size_t)bl * 256 * 512, 512, (r >> 2) * 128, (r & 3) * 64, sm, true); return; }
    it -= 128;
    if (it < 128) { const int bl = it >> 4, r = it & 15; transpose_tile(p.c_diff_v + (size_t)bl * 512 * 256, 256, p.cvt_diff + (size_t)bl * 256 * 512, 512, (r >> 2) * 128, (r & 3) * 64, sm, true); return; }
    it -= 128;
    { const int bl = it >> 3, r = it & 7; transpose_tile(p.c_swa_v + (size_t)bl * 512 * 128, 128, p.cvt_swa + (size_t)bl * 128 * 512, 512, (r >> 1) * 128, (r & 1) * 64, sm, true); return; }
  }
  it -= P0_CVT;
  if (it < P0_PQ) { pq_item(p, it, sm); return; }
  it -= P0_PQ;
  if (it < 16) { dft_item(p.dft256, 256, it); return; }
  it -= 16;
  if (it < 256) { dft_item(p.dft1024, 1024, it); return; }
  for (int e = otid(); e < 512 + 1024; e += 256) {
    const bool isD = e < 512;
    const int ee = isD ? e : e - 512;
    const int nf = isD ? 8 : 16;
    const int pos = ee / nf, fi = ee % nf;
    const float inv = exp2f(-(float)fi * (13.287712379549449f / (float)nf));
    float tt = (float)pos * inv * 0.15915494309189535f;
    tt -= rintf(tt);
    float sn, cs;
    sincospif(2.f * tt, &sn, &cs);
    if (isD) { p.ropeD[ee] = cs; p.ropeD[512 + ee] = sn; }
    else { p.ropeS[ee] = cs; p.ropeS[1024 + ee] = sn; }
  }
}

__device__ __forceinline__ void norm_item(const Params& p, int l, int which, int it) {
  const int lane = otid() & 63, wave = otid() >> 6;
  const int row0 = it * 16 + wave * 4;
  const float* xsrc = (which == 0 && l == 0) ? (row0 < NPTOK ? p.x_prompt + (size_t)row0 * 1024 : p.x_sample + (size_t)(row0 - NPTOK) * 1024)
                                             : p.xres + (size_t)row0 * 1024;
  float4 v[4][4];
#pragma unroll
  for (int j = 0; j < 4; ++j)
#pragma unroll
    for (int k = 0; k < 4; ++k) v[j][k] = *(const float4*)(xsrc + (size_t)j * 1024 + (k * 64 + lane) * 4);
  float rs[4];
#pragma unroll
  for (int j = 0; j < 4; ++j) {
    float ss = 0.f;
#pragma unroll
    for (int k = 0; k < 4; ++k) ss += v[j][k].x * v[j][k].x + v[j][k].y * v[j][k].y + v[j][k].z * v[j][k].z + v[j][k].w * v[j][k].w;
#pragma unroll
    for (int o = 32; o >= 1; o >>= 1) ss += __shfl_xor(ss, o);
    rs[j] = rsqrtf(ss * (1.f / 1024.f) + 1e-6f);
  }
  if (which < 2) {
    const int cond = row0 < NPTOK ? 0 : 1 + ((row0 - NPTOK) >> 10);
    const float* gp = (which == 0 ? p.norm1_g : p.norm2_g) + l * 1024;
    const float* shp = p.mods + (size_t)(l * 3 + cond) * 6144 + (which * 3 + 0) * 1024;
    const float* scp = shp + 1024;
#pragma unroll
    for (int k = 0; k < 4; ++k) {
      const int col = (k * 64 + lane) * 4;
      const float4 gg = *(const float4*)(gp + col);
      const float4 sh = *(const float4*)(shp + col);
      const float4 sc = *(const float4*)(scp + col);
      const float mx = gg.x * (1.f + sc.x), my = gg.y * (1.f + sc.y), mz = gg.z * (1.f + sc.z), mw = gg.w * (1.f + sc.w);
#pragma unroll
      for (int j = 0; j < 4; ++j) {
        uint2 w;
        w.x = pack2(v[j][k].x * rs[j] * mx + sh.x, v[j][k].y * rs[j] * my + sh.y);
        w.y = pack2(v[j][k].z * rs[j] * mz + sh.z, v[j][k].w * rs[j] * mw + sh.w);
        *(uint2*)(p.h + (size_t)(row0 + j) * 1024 + col) = w;
      }
    }
  } else {
#pragma unroll
    for (int k = 0; k < 4; ++k) {
      const int col = (k * 64 + lane) * 4;
      const float4 gg = *(const float4*)(p.final_g + col);
#pragma unroll
      for (int j = 0; j < 4; ++j) {
        float4 o;
        o.x = v[j][k].x * rs[j] * gg.x; o.y = v[j][k].y * rs[j] * gg.y; o.z = v[j][k].z * rs[j] * gg.z; o.w = v[j][k].w * rs[j] * gg.w;
        { f32x4 ov = {o.x, o.y, o.z, o.w}; __builtin_nontemporal_store(ov, (f32x4*)(p.out + (size_t)(row0 + j) * 1024 + col)); }
      }
    }
  }
}

template <bool ZERO, int YT>
__device__ __forceinline__ void gemm_main_t(const u16* __restrict__ X, int ldx, const u16* __restrict__ Y, int ldy, int K,
                                          u16* smem, f32x4 (&acc)[4][YT]) {
  const int tid = otid(), lane = tid & 63, wave = tid >> 6, wx = wave & 1, wy = wave >> 1, r = lane & 15, g = lane >> 4;
  u16* sX = smem;
  u16* sY = smem + 2 * 128 * 64;
  const int lrow = tid >> 3, lkc = tid & 7;
  const int gsw = (lkc ^ (lrow & 7)) * 8;
  const u16* gx = X + (size_t)lrow * ldx + gsw;
  const u16* gy = Y + (size_t)lrow * ldy + gsw;
  u16* lx = sX + tid * 8;
  u16* ly = sY + tid * 8;
#define GEMM_STAGE(buf, kt_)                                                                                                      \
  {                                                                                                                               \
    _Pragma("unroll") for (int i = 0; i < 4; ++i)                                                                                 \
      __builtin_amdgcn_global_load_lds((const unsigned*)(gx + (size_t)(32 * i) * ldx + (kt_) * 64),                               \
                                       (unsigned*)(lx + (buf) * 8192 + i * 2048), 16, 0, 0);                                      \
    _Pragma("unroll") for (int i = 0; i < YT; ++i)                                                                                \
      __builtin_amdgcn_global_load_lds((const unsigned*)(gy + (size_t)(32 * i) * ldy + (kt_) * 64),                               \
                                       (unsigned*)(ly + (buf) * 8192 + i * 2048), 16, 0, 0);                                      \
  }
  GEMM_STAGE(0, 0);
  if (ZERO) {
#pragma unroll
    for (int a = 0; a < 4; ++a)
#pragma unroll
      for (int b = 0; b < YT; ++b) acc[a][b] = (f32x4){0.f, 0.f, 0.f, 0.f};
  }
  const int nk = K >> 6;
  const int sw = r & 7;
  const u16* cx0 = sX + (wx * 64 + r) * 64;
  const u16* cy0 = sY + (wy * (16 * YT) + r) * 64;
  __syncthreads();
#define GEMM_COMPUTE(cur)                                                                            \
  {                                                                                                  \
    const u16* cx = cx0 + (cur) * 8192;                                                              \
    const u16* cy = cy0 + (cur) * 8192;                                                              \
    const int pc0 = (g ^ sw) * 8, pc1 = ((4 + g) ^ sw) * 8;                                          \
    bf16x8 a0[4], b0[YT], a1[4], b1[YT];                                                             \
    _Pragma("unroll") for (int i = 0; i < 4; ++i) a0[i] = *(const bf16x8*)(cx + i * 16 * 64 + pc0);  \
    _Pragma("unroll") for (int i = 0; i < YT; ++i) b0[i] = *(const bf16x8*)(cy + i * 16 * 64 + pc0); \
    _Pragma("unroll") for (int i = 0; i < 4; ++i) a1[i] = *(const bf16x8*)(cx + i * 16 * 64 + pc1);  \
    _Pragma("unroll") for (int i = 0; i < YT; ++i) b1[i] = *(const bf16x8*)(cy + i * 16 * 64 + pc1); \
    __builtin_amdgcn_s_setprio(1);                                                                   \
    _Pragma("unroll") for (int xi = 0; xi < 4; ++xi)                                                 \
      _Pragma("unroll") for (int yi = 0; yi < YT; ++yi)                                              \
        acc[xi][yi] = __builtin_amdgcn_mfma_f32_16x16x32_bf16(a0[xi], b0[yi], acc[xi][yi], 0, 0, 0); \
    _Pragma("unroll") for (int xi = 0; xi < 4; ++xi)                                                 \
      _Pragma("unroll") for (int yi = 0; yi < YT; ++yi)                                              \
        acc[xi][yi] = __builtin_amdgcn_mfma_f32_16x16x32_bf16(a1[xi], b1[yi], acc[xi][yi], 0, 0, 0); \
    __builtin_amdgcn_s_setprio(0);                                                                   \
  }
#pragma unroll 1
  for (int kt = 0; kt < nk - 1; ++kt) {
    const int cur = kt & 1;
    GEMM_STAGE(cur ^ 1, kt + 1);
    GEMM_COMPUTE(cur);
    __syncthreads();
  }
  GEMM_COMPUTE((nk - 1) & 1);
  __syncthreads();
#undef GEMM_COMPUTE
#undef GEMM_STAGE
}

#ifndef REP_GEMM
#define REP_GEMM 0
#endif
#ifndef REP_MIX
#define REP_MIX 0
#endif
#ifndef REP_SYNC
#define REP_SYNC 0
#endif
#ifndef REP_P0
#define REP_P0 0
#endif
template <int YT>
__device__ __forceinline__ void gemm_main(const u16* __restrict__ X, int ldx, const u16* __restrict__ Y, int ldy, int K,
                                          u16* smem, f32x4 (&acc)[4][YT]) {
  gemm_main_t<true, YT>(X, ldx, Y, ldy, K, smem, acc);
#if REP_GEMM
  gemm_main_t<false, YT>(X, ldx, Y, ldy, K, smem, acc);
#pragma unroll
  for (int a = 0; a < 4; ++a)
#pragma unroll
    for (int b = 0; b < YT; ++b) acc[a][b] *= 0.5f;
#endif
}

__device__ __forceinline__ bool tile_map(int j, int ntx, int& tx, int& ty, int nty = 48) {
  const int nblk = gridDim.x, bid = blockIdx.x;
  if (nblk == 512) {
    const int per = nty >> 3, hp = per >> 1;
    const int rank = bid >> 3, q = (rank & 31) + j * 32, mem = rank >> 5;
    if (q >= hp * ntx) return false;
    tx = q / hp; ty = per * (bid & 7) + 2 * (q % hp) + mem;
    return true;
  } else {
    const int it = bid + j * nblk;
    if (it >= nty * ntx) return false;
    tx = it / nty; ty = it % nty;
    return true;
  }
}

__device__ void gin_tile(const Params& p, int l, int tx, int ty, u16* smem) {
  const int n0 = tx * 128, m0 = ty * 128;
  f32x4 acc[4][4];
  gemm_main<4>(p.w_inT + (size_t)l * 2304 * 1024 + (size_t)n0 * 1024, 1024, p.h + (size_t)m0 * 1024, 1024, 1024, smem, acc);
  const int lane = otid() & 63, wave = otid() >> 6, wx = wave & 1, wy = wave >> 1, r = lane & 15, g = lane >> 4;
  const int nw = n0 + wx * 64;
  const bool isS = m0 >= NPTOK;
  int ropeMode = 0;
  if (isS) {
    if (nw >= 768 && nw < 1280) ropeMode = 1;
    else if (nw >= 1792 && nw < 2176) ropeMode = 2;
  }
  float* okv = nullptr; int okv_w = 0, okv_c = 0;
  if (!isS) {
    if (nw >= 256 && nw < 512) { okv = p.out + O_NAK; okv_w = 256; okv_c = nw - 256; }
    else if (nw >= 512 && nw < 768) { okv = p.out + O_NAV; okv_w = 256; okv_c = nw - 512; }
    else if (nw >= 1024 && nw < 1280) { okv = p.out + O_DK; okv_w = 256; okv_c = nw - 1024; }
    else if (nw >= 1280 && nw < 1536) { okv = p.out + O_DV; okv_w = 256; okv_c = nw - 1280; }
    else if (nw >= 2048 && nw < 2176) { okv = p.out + O_SK; okv_w = 128; okv_c = nw - 2048; }
    else if (nw >= 2176) { okv = p.out + O_SV; okv_w = 128; okv_c = nw - 2176; }
  }
  int khh = -1;
  if (nw >= 256 && nw < 512) khh = (nw - 256) >> 6;
  else if (nw >= 1024 && nw < 1280) khh = 4 + ((nw - 1024) >> 6);
  else if (nw >= 2048 && nw < 2176) khh = 8 + ((nw - 2048) >> 6);
  int vrow = -1;
  if (nw >= 512 && nw < 768) vrow = nw - 512;
  else if (nw >= 1280 && nw < 1536) vrow = 256 + nw - 1280;
  else if (nw >= 2176) vrow = 512 + nw - 2176;
#pragma unroll
  for (int yi = 0; yi < 4; ++yi) {
    const int m = m0 + wy * 64 + yi * 16 + r;
    const int t = (m - NPTOK) & 1023;
    const int prow = t >> 6, pcol = t & 63;
#pragma unroll
    for (int xi = 0; xi < 4; ++xi) {
      f32x4 v = acc[xi][yi];
      if (ropeMode == 1) {
        const int pos = (xi & 1) ? pcol : prow;
        const float4 cs = *(const float4*)(p.ropeD + pos * 8 + 4 * (g & 1));
        const float4 sn = *(const float4*)(p.ropeD + 512 + pos * 8 + 4 * (g & 1));
        const float sg = (g >= 2) ? 1.f : -1.f;
        const float o0 = __shfl_xor(v[0], 32), o1 = __shfl_xor(v[1], 32), o2 = __shfl_xor(v[2], 32), o3 = __shfl_xor(v[3], 32);
        v[0] = v[0] * cs.x + sg * o0 * sn.x; v[1] = v[1] * cs.y + sg * o1 * sn.y;
        v[2] = v[2] * cs.z + sg * o2 * sn.z; v[3] = v[3] * cs.w + sg * o3 * sn.w;
      } else if (ropeMode == 2) {
        const int pos = (xi >> 1) ? pcol : prow;
        const float4 cs = *(const float4*)(p.ropeS + pos * 16 + 4 * g);
        const float4 sn = *(const float4*)(p.ropeS + 1024 + pos * 16 + 4 * g);
        const f32x4 o = acc[xi ^ 1][yi];
        const float sg = (xi & 1) ? 1.f : -1.f;
        v[0] = v[0] * cs.x + sg * o[0] * sn.x; v[1] = v[1] * cs.y + sg * o[1] * sn.y;
        v[2] = v[2] * cs.z + sg * o[2] * sn.z; v[3] = v[3] * cs.w + sg * o[3] * sn.w;
      }
      const int nloc = xi * 16 + 4 * g;
      if (okv) {
        const int b = m >> 8, pos = m & 255;
        float4 o4; o4.x = v[0]; o4.y = v[1]; o4.z = v[2]; o4.w = v[3];
        __builtin_nontemporal_store(v, (f32x4*)(okv + ((size_t)((b * 4 + l) * 256 + pos)) * okv_w + okv_c + nloc));
      }
      if (vrow >= 0) {
        u16* vb = p.vfr + ((size_t)((vrow >> 6) * 192 + (m >> 5))) * 2048;
#pragma unroll
        for (int i = 0; i < 4; ++i) vb[vfrag_off(m & 31, nloc + i)] = f2bf(v[i]);
      } else if (khh >= 0) {
        uint2 w; w.x = pack2(v[0], v[1]); w.y = pack2(v[2], v[3]);
        *(uint2*)(p.kfr + ((size_t)(khh * 192 + (m >> 5))) * 2048 + kfrag_off(m & 31, nloc)) = w;
      } else {
        uint2 w; w.x = pack2(v[0], v[1]); w.y = pack2(v[2], v[3]);
        *(uint2*)(p.z + (size_t)m * INW + nw + nloc) = w;
      }
    }
  }
}

__device__ void res_tile(const Params& p, int l, int tx, int ty, const u16* A, const u16* WT, int K, int gi, u16* smem, bool first = false) {
  const int n0 = tx * 128, m0 = ty * 96;
  f32x4 acc[4][3];
  gemm_main<3>(WT + (size_t)n0 * K, K, A + (size_t)m0 * K, K, K, smem, acc);
  const int lane = otid() & 63, wave = otid() >> 6, wx = wave & 1, wy = wave >> 1, r = lane & 15, g = lane >> 4;
#pragma unroll
  for (int yi = 0; yi < 3; ++yi) {
    const int m = m0 + wy * 48 + yi * 16 + r;
    const int cond = m < NPTOK ? 0 : 1 + ((m - NPTOK) >> 10);
    const float* gate = p.mods + (size_t)(l * 3 + cond) * 6144 + gi * 1024;
    float* xrow = p.xres + (size_t)m * 1024;
    const float* xin = first ? (m < NPTOK ? p.x_prompt + (size_t)m * 1024 : p.x_sample + (size_t)(m - NPTOK) * 1024) : xrow;
    float4 xv[4], gt[4];
#pragma unroll
    for (int xi = 0; xi < 4; ++xi) {
      const int n = n0 + wx * 64 + xi * 16 + 4 * g;
      xv[xi] = *(const float4*)(xin + n);
      gt[xi] = *(const float4*)(gate + n);
    }
#pragma unroll
    for (int xi = 0; xi < 4; ++xi) {
      const int n = n0 + wx * 64 + xi * 16 + 4 * g;
      const f32x4 v = acc[xi][yi];
      float4 o = xv[xi];
      o.x += gt[xi].x * v[0]; o.y += gt[xi].y * v[1]; o.z += gt[xi].z * v[2]; o.w += gt[xi].w * v[3];
      *(float4*)(xrow + n) = o;
    }
  }
}

__device__ void m1_tile(const Params& p, int l, int tx, int ty, u16* smem) {
  const int n0 = tx * 128, m0 = ty * 128;
  f32x4 acc[4][4];
  gemm_main<4>(p.w1T + (size_t)l * 4096 * 1024 + (size_t)n0 * 1024, 1024, p.h + (size_t)m0 * 1024, 1024, 1024, smem, acc);
  const int lane = otid() & 63, wave = otid() >> 6, wx = wave & 1, wy = wave >> 1, r = lane & 15, g = lane >> 4;
#pragma unroll
  for (int xi = 0; xi < 4; ++xi) {
    const int n = n0 + wx * 64 + xi * 16 + 4 * g;
#pragma unroll
    for (int yi = 0; yi < 4; ++yi) {
      const int m = m0 + wy * 64 + yi * 16 + r;
      const f32x4 v = acc[xi][yi];
      float a0 = fmaxf(v[0], 0.f), a1 = fmaxf(v[1], 0.f), a2 = fmaxf(v[2], 0.f), a3 = fmaxf(v[3], 0.f);
      uint2 w; w.x = pack2(a0 * a0, a1 * a1); w.y = pack2(a2 * a2, a3 * a3);
      *(uint2*)(p.u + (size_t)m * 4096 + n) = w;
    }
  }
}

__device__ void f1_tile(const Params& p, int l, int it, u16* smem) {
  const int tx = it % 48, ty = it / 48;
  const int x0 = tx * 128, y0 = ty * 128;
  f32x4 acc[4][4];
  gemm_main<4>(p.z + (size_t)x0 * INW + 1536, INW, p.pqt + (size_t)l * 512 * 256 + (size_t)y0 * 256, 256, 256, smem, acc);
  const int lane = otid() & 63, wave = otid() >> 6, wx = wave & 1, wy = wave >> 1, r = lane & 15, g = lane >> 4;
#pragma unroll
  for (int yi = 0; yi < 4; ++yi) {
    const int y = y0 + wy * 64 + yi * 16 + r;
    const int col = y & 255, which = y >> 8;
#pragma unroll
    for (int xi = 0; xi < 4; ++xi) {
      const int tok = x0 + wx * 64 + xi * 16 + 4 * g;
      size_t addr;
      if (tok < NPTOK) {
        const int b = tok >> 8, pos = tok & 255;
        addr = (size_t)b * (256 * 512) + (size_t)col * 512 + which * 256 + pos;
      } else {
        const int b = (tok - NPTOK) >> 10, pos = (tok - NPTOK) & 1023;
        addr = (size_t)16 * 256 * 512 + (size_t)b * (256 * 2048) + (size_t)col * 2048 + which * 1024 + pos;
      }
      const f32x4 v = acc[xi][yi];
      uint2 w; w.x = pack2(v[0], v[1]); w.y = pack2(v[2], v[3]);
      *(uint2*)(p.uv + addr) = w;
    }
  }
  asm volatile("s_waitcnt vmcnt(0)" ::: "memory");
  __syncthreads();
  if (threadIdx.x == 0) {
    __builtin_amdgcn_fence(__ATOMIC_RELEASE, "agent");
    asm volatile("s_waitcnt vmcnt(0)" ::: "memory");
    xb_add(p.bar + XCD_BAR_WORDS + (8 + l) * 64, 1u);
  }
}

__device__ void f2_tile(const Params& p, int l, int it, u16* smem) {
  if (threadIdx.x == 0) {
    unsigned* c = p.bar + XCD_BAR_WORDS + (8 + l) * 64;
    unsigned sp = 0;
    while (xb_ld(c) < 192u) { __builtin_amdgcn_s_sleep(2); if (++sp > (1u << 24)) break; }
    __builtin_amdgcn_fence(__ATOMIC_ACQUIRE, "agent");
    asm volatile("s_waitcnt vmcnt(0)" ::: "memory");
  }
  __syncthreads();
  int L, b, tx, ty, tokbase;
  const u16* uvb; const u16* dft;
  if (it < 32) { L = 1024; b = it >> 4; tx = (it >> 3) & 1; ty = it & 7; uvb = p.uv + (size_t)16 * 256 * 512 + (size_t)b * (256 * 2048); dft = p.dft1024; tokbase = NPTOK + b * 1024; }
  else { it -= 32; L = 256; b = it >> 2; tx = (it >> 1) & 1; ty = it & 1; uvb = p.uv + (size_t)b * (256 * 512); dft = p.dft256; tokbase = b * 256; }
  const int x0 = tx * 128, y0 = ty * 128, K = 2 * L;
  f32x4 acc[4][4];
  gemm_main<4>(uvb + (size_t)x0 * K, K, dft + (size_t)y0 * K, K, K, smem, acc);
  const int lane = otid() & 63, wave = otid() >> 6, wx = wave & 1, wy = wave >> 1, r = lane & 15, g = lane >> 4;
  const float scale = rsqrtf(64.f * (float)L);
#pragma unroll
  for (int yi = 0; yi < 4; ++yi) {
    const int pos = y0 + wy * 64 + yi * 16 + r;
#pragma unroll
    for (int xi = 0; xi < 4; ++xi) {
      const int col = x0 + wx * 64 + xi * 16 + 4 * g;
      const f32x4 v = acc[xi][yi];
      uint2 w; w.x = pack2(v[0] * scale, v[1] * scale); w.y = pack2(v[2] * scale, v[3] * scale);
      *(uint2*)(p.cat + (size_t)(tokbase + pos) * 1024 + 512 + col) = w;
    }
  }
}

struct Seg { const u16* K; const u16* Vt; int ldk, ldv, nblk, pos0, stride; };
#define KLOC(hh, tokb) (p.kfr + ((size_t)((hh) * 192 + ((tokb) >> 5))) * 2048)
#define VLOC(hh, tokb) (p.vfr + ((size_t)((hh) * 192 + ((tokb) >> 5))) * 2048)
template <int QT> struct AState { float m[QT]; float ls[QT]; f32x4 o[QT][4]; };

__device__ __forceinline__ bf16x8 as_bf(u32x4 v) { union { u32x4 u; bf16x8 b; } x; x.u = v; return x.b; }

template <int DC>
__device__ __forceinline__ void issue_blk(const Seg& s0, const Seg& s1, int b, int r, int g, u32x4 (&kf)[2][DC], u32x4 (&vf)[4]) {
  const bool in0 = b < s0.nblk;
  const u16* Kp = in0 ? s0.K : s1.K;
  const u16* Vp = in0 ? s0.Vt : s1.Vt;
  const int pos = in0 ? (s0.pos0 + b * s0.stride) : (s1.pos0 + (b - s0.nblk) * s1.stride);
  const int lane8 = (g * 16 + r) * 8;
  const u16* kp = Kp + (size_t)(pos >> 5) * 2048 + lane8;
  const u16* vp = Vp + (size_t)(pos >> 5) * 2048 + lane8;
#pragma unroll
  for (int t = 0; t < 2; ++t)
#pragma unroll
    for (int dc = 0; dc < DC; ++dc) gload16(kf[t][dc], kp + (t * 2 + dc) * 512);
#pragma unroll
  for (int dv = 0; dv < 4; ++dv) gload16(vf[dv], vp + dv * 512);
}
template <int N>
__device__ __forceinline__ void wait_blk(u32x4 (&kf)[2][1], u32x4 (&vf)[4]) {
  asm volatile("s_waitcnt vmcnt(%6)" : "+v"(kf[0][0]), "+v"(kf[1][0]), "+v"(vf[0]), "+v"(vf[1]), "+v"(vf[2]), "+v"(vf[3]) : "n"(N) : "memory");
}
template <int N>
__device__ __forceinline__ void wait_blk(u32x4 (&kf)[2][2], u32x4 (&vf)[4]) {
  asm volatile("s_waitcnt vmcnt(%8)" : "+v"(kf[0][0]), "+v"(kf[0][1]), "+v"(kf[1][0]), "+v"(kf[1][1]), "+v"(vf[0]), "+v"(vf[1]), "+v"(vf[2]), "+v"(vf[3]) : "n"(N) : "memory");
}

template <int D, int QT, int MODE>
__device__ __forceinline__ void attn_compute(const u32x4 (&kc)[2][D / 32], const u32x4 (&vc)[4], const bf16x8 (&qf)[QT][D / 32], const float sc,
                                             AState<QT>& st, const bool in0, const int pos, const int qpos0, const float* __restrict__ rpb_h,
                                             const int r, const int g) {
  constexpr int DC = D / 32;
#pragma unroll
  for (int q = 0; q < QT; ++q) {
    if (MODE == 1 && !in0) {
      const int cq0 = (qpos0 + q * 16) & 63, cb = pos & 63;
      const int lo = min(max(cq0 - 8, 0), 48), hi = min(max(cq0 + 7, 0), 48) + 16;
      if (hi <= cb || lo >= cb + 32) continue;
    }
    if (MODE == 2 && !in0) {
      const int qp = qpos0 + q * 16;
      if (pos > qp + 15 + 128 || pos + 31 < qp - 128) continue;
    }
    f32x4 s_[2];
    s_[0] = (f32x4){0.f, 0.f, 0.f, 0.f};
    s_[1] = (f32x4){0.f, 0.f, 0.f, 0.f};
#pragma unroll
    for (int t = 0; t < 2; ++t)
#pragma unroll
      for (int dc = 0; dc < DC; ++dc) s_[t] = __builtin_amdgcn_mfma_f32_16x16x32_bf16(as_bf(kc[t][dc]), qf[q][dc], s_[t], 0, 0, 0);
    float sv[8];
#pragma unroll
    for (int t = 0; t < 2; ++t)
#pragma unroll
      for (int i = 0; i < 4; ++i) {
        float x = s_[t][i] * sc;
        if (MODE == 1) {
          if (!in0) {
            const int qpos = qpos0 + q * 16 + r;
            const int qrow = qpos >> 6, cq = qpos & 63;
            const int kpos = pos + 8 * g + 4 * t + i;
            const int krow = kpos >> 6, ck = kpos & 63;
            const int cs = min(max(cq - 8, 0), 48);
            const bool valid = (ck >= cs) && (ck < cs + 16);
            const int bi = (krow - qrow + 7) * 31 + (ck - cq + 15);
            const float bias = rpb_h[valid ? bi : 0];
            x = valid ? (x + bias) : -1e30f;
          }
        } else if (MODE == 2) {
          if (!in0) {
            const int qpos = qpos0 + q * 16 + r;
            const int kpos = pos + 8 * g + 4 * t + i;
            const int d = qpos - kpos;
            x = (d <= 128 && d >= -128) ? x : -1e30f;
          }
        }
        sv[4 * t + i] = x;
      }
    float mx = fmaxf(fmaxf(fmaxf(sv[0], sv[1]), fmaxf(sv[2], sv[3])), fmaxf(fmaxf(sv[4], sv[5]), fmaxf(sv[6], sv[7])));
    mx = fmaxf(mx, __shfl_xor(mx, 16));
    mx = fmaxf(mx, __shfl_xor(mx, 32));
    const float mnew = fmaxf(st.m[q], mx);
    const float alpha = __builtin_amdgcn_exp2f(st.m[q] - mnew);
    st.m[q] = mnew;
    float ps = 0.f;
#pragma unroll
    for (int j = 0; j < 8; ++j) { sv[j] = __builtin_amdgcn_exp2f(sv[j] - mnew); ps += sv[j]; }
    st.ls[q] = st.ls[q] * alpha + ps;
    union { bf16x8 v; unsigned w[4]; } pf;
    pf.w[0] = pack2(sv[0], sv[1]); pf.w[1] = pack2(sv[2], sv[3]); pf.w[2] = pack2(sv[4], sv[5]); pf.w[3] = pack2(sv[6], sv[7]);
#pragma unroll
    for (int dv = 0; dv < 4; ++dv) {
      f32x4 o = st.o[q][dv];
      o[0] *= alpha; o[1] *= alpha; o[2] *= alpha; o[3] *= alpha;
      st.o[q][dv] = __builtin_amdgcn_mfma_f32_16x16x32_bf16(as_bf(vc[dv]), pf.v, o, 0, 0, 0);
    }
  }
}

template <int D, int QT, int MODE, int NQ = 2>
__device__ __forceinline__ void attn_run(const Seg& s0, const Seg& s1, const bf16x8 (&qf)[QT][D / 32], const float sc,
                                         AState<QT>& st, const int qpos0, const float* __restrict__ rpb_h, const int bb = 0, const int be = -1, const int lo2 = -1) {
  constexpr int DC = D / 32;
  constexpr int NL = 2 * DC + 4;
  const int lane = otid() & 63, r = lane & 15, g = lane >> 4;
  const int nb = be < 0 ? s0.nblk + s1.nblk : be;
  u32x4 kq[NQ][2][DC], vq[NQ][4];
#pragma unroll
  for (int q = 0; q < QT; ++q)
#pragma unroll
    for (int dc = 0; dc < DC; ++dc) asm volatile("" ::"v"(qf[q][dc]));
  asm volatile("s_waitcnt vmcnt(0)" ::: "memory");
#pragma unroll 1
  for (int b = bb; b < nb; b += NQ) {
#pragma unroll
    for (int j = 0; j < NQ; ++j) issue_blk<DC>(s0, s1, (lo2 >= 0 && b + j >= bb + 4) ? lo2 + (b + j - bb - 4) : b + j, r, g, kq[j], vq[j]);
#pragma unroll
    for (int j = 0; j < NQ; ++j) {
      if (j == 0) wait_blk<(NQ - 1) * NL>(kq[j], vq[j]);
      else if (j == 1) wait_blk<(NQ - 2) * NL>(kq[j], vq[j]);
      else if (j == 2) wait_blk<(NQ > 3 ? (NQ - 3) * NL : 0)>(kq[j], vq[j]);
      else wait_blk<0>(kq[j], vq[j]);
      const int bj = (lo2 >= 0 && b + j >= bb + 4) ? lo2 + (b + j - bb - 4) : b + j;
      const bool in0 = bj < s0.nblk;
      const int pos = in0 ? (s0.pos0 + bj * s0.stride) : (s1.pos0 + (bj - s0.nblk) * s1.stride);
      attn_compute<D, QT, MODE>(kq[j], vq[j], qf, sc, st, in0, pos, qpos0, rpb_h, r, g);
    }
  }
}

template <int QT>
__device__ __forceinline__ void astate_init(AState<QT>& st, float m0, float l0) {
#pragma unroll
  for (int q = 0; q < QT; ++q) {
    st.m[q] = m0; st.ls[q] = l0;
#pragma unroll
    for (int dv = 0; dv < 4; ++dv) st.o[q][dv] = (f32x4){0.f, 0.f, 0.f, 0.f};
  }
}
template <int QT>
__device__ __forceinline__ void astate_finalize(AState<QT>& st) {
#pragma unroll
  for (int q = 0; q < QT; ++q) {
    float l = st.ls[q];
    l += __shfl_xor(l, 16);
    l += __shfl_xor(l, 32);
    const float inv = 1.f / l;
#pragma unroll
    for (int dv = 0; dv < 4; ++dv) { st.o[q][dv][0] *= inv; st.o[q][dv][1] *= inv; st.o[q][dv][2] *= inv; st.o[q][dv][3] *= inv; }
  }
}
template <int DC, int QT>
__device__ __forceinline__ void load_q(const u16* zq  , bf16x8 (&qf)[QT][DC]) {
  const int lane = otid() & 63, r = lane & 15, g = lane >> 4;
#pragma unroll
  for (int q = 0; q < QT; ++q)
#pragma unroll
    for (int dc = 0; dc < DC; ++dc) qf[q][dc] = *(const bf16x8*)(zq + (size_t)(q * 16 + r) * INW + dc * 32 + g * 8);
}
template <int QT>
__device__ __forceinline__ void write_o(const Params& p, const AState<QT>& st, int tok0, int col0) {
  const int lane = otid() & 63, r = lane & 15, g = lane >> 4;
#pragma unroll
  for (int q = 0; q < QT; ++q)
#pragma unroll
    for (int dv = 0; dv < 4; ++dv) {
      const f32x4 v = st.o[q][dv];
      uint2 w; w.x = pack2(v[0], v[1]); w.y = pack2(v[2], v[3]);
      *(uint2*)(p.cat + (size_t)(tok0 + q * 16 + r) * 1024 + col0 + dv * 16 + 4 * g) = w;
    }
}

__device__ __forceinline__ float diff_lambda(const Params& p, int l, float lam_init) {
  const int lane = otid() & 63;
  float a = 0.f, b = 0.f;
  if (lane < 32) { a = p.lq1[l * 32 + lane] * p.lk1[l * 32 + lane]; b = p.lq2[l * 32 + lane] * p.lk2[l * 32 + lane]; }
#pragma unroll
  for (int o = 32; o >= 1; o >>= 1) { a += __shfl_xor(a, o); b += __shfl_xor(b, o); }
  return expf(a) - expf(b) + lam_init;
}

__device__ __forceinline__ void diff_finish_q(const Params& p, int l, float lam, float lam_init, f32x4 (&A)[4], const f32x4 (&B)[4], int tokrow0, int col0) {
  const int lane = otid() & 63, r = lane & 15, g = lane >> 4;
  const float* sg = p.subln_g + l * 64;
  float ss = 0.f;
#pragma unroll
  for (int dv = 0; dv < 4; ++dv)
#pragma unroll
    for (int i = 0; i < 4; ++i) {
      const float v = A[dv][i] - lam * B[dv][i];
      A[dv][i] = v;
      ss += v * v;
    }
  ss += __shfl_xor(ss, 16);
  ss += __shfl_xor(ss, 32);
  const float rs = rsqrtf(ss * (1.f / 64.f) + 1e-6f) * (1.f - lam_init);
#pragma unroll
  for (int dv = 0; dv < 4; ++dv) {
    const float4 gg = *(const float4*)(sg + dv * 16 + 4 * g);
    uint2 w;
    w.x = pack2(A[dv][0] * rs * gg.x, A[dv][1] * rs * gg.y);
    w.y = pack2(A[dv][2] * rs * gg.z, A[dv][3] * rs * gg.w);
    *(uint2*)(p.cat + (size_t)(tokrow0 + r) * 1024 + col0 + dv * 16 + 4 * g) = w;
  }
}

#ifndef AQT
#define AQT 2
#endif
#define QW (16 * AQT)
#define NQG_CTX (256 / QW)
#define NQG_LAT (1024 / QW)
__device__ void attn_diff_item(const Params& p, int l, bool lat, int bi, float* sm) {
  const int wave = otid() >> 6, lane = otid() & 63, r = lane & 15, g = lane >> 4;
  const int ps = wave >> 1, half = wave & 1;
  int b, h, qg, tokb;
  if (lat) { b = bi / (4 * NQG_LAT); h = (bi / NQG_LAT) & 3; qg = bi % NQG_LAT; tokb = NPTOK + b * 1024; }
  else { b = bi / (4 * NQG_CTX); h = (bi / NQG_CTX) & 3; qg = bi % NQG_CTX; tokb = b * 256; }
  const int tok0 = tokb + qg * QW;
  const u16* zb = p.z + (size_t)tokb * INW;
  Seg s0, s1;
  if (lat) {
    const int bl = b * 4 + l;
    s0.K = p.ck_diff + (size_t)((bl * 4 + h) * 16) * 2048 + ps * 512; s0.Vt = p.cvt_diff + (size_t)((bl * 4 + h) * 16) * 2048;
    s0.ldk = 0; s0.ldv = 0; s0.nblk = half ? 0 : 16; s0.pos0 = 0; s0.stride = 32;
    s1.K = KLOC(4 + h, tokb) + ps * 512; s1.Vt = VLOC(4 + h, tokb);
    s1.ldk = 0; s1.ldv = 0; s1.nblk = half ? 24 : 8; s1.pos0 = half ? 256 : 0; s1.stride = 32;
  } else {
    s0.K = KLOC(4 + h, tokb) + ps * 512; s0.Vt = VLOC(4 + h, tokb);
    s0.ldk = 0; s0.ldv = 0; s0.nblk = 4; s0.pos0 = half ? 128 : 0; s0.stride = 32;
    s1 = s0; s1.nblk = 0;
  }
  bf16x8 qf[AQT][1];
  load_q<1, AQT>(p.z + (size_t)tok0 * INW + 768 + h * 64 + ps * 32, qf);
  AState<AQT> st;
  astate_init<AQT>(st, -1e30f, 0.f);
  attn_run<32, AQT, 0, 2>(s0, s1, qf, 0.17677669529663687f * LOG2E, st, 0, nullptr);
  float lt[AQT];
#pragma unroll
  for (int q = 0; q < AQT; ++q) {
    lt[q] = st.ls[q];
    lt[q] += __shfl_xor(lt[q], 16);
    lt[q] += __shfl_xor(lt[q], 32);
  }
  constexpr int WS = 64 * 16 * AQT;
  float* pm = sm + 4 * WS;
  if (wave != 0) {
    float* po = sm + wave * WS + lane * (16 * AQT);
#pragma unroll
    for (int q = 0; q < AQT; ++q) {
#pragma unroll
      for (int dv = 0; dv < 4; ++dv) *(f32x4*)(po + q * 16 + dv * 4) = st.o[q][dv];
      if (g == 0) { pm[wave * QW + q * 16 + r] = st.m[q]; pm[4 * QW + wave * QW + q * 16 + r] = lt[q]; }
    }
  }
  __syncthreads();
  if (wave == 0) {
    const float lam_init = 0.8f - 0.6f * expf(-0.3f * (float)l);
    const float lam = diff_lambda(p, l, lam_init);
#pragma unroll
    for (int q = 0; q < AQT; ++q) {
      f32x4 A[4], B[4];
      {
        const float m1 = pm[QW + q * 16 + r], l1 = pm[4 * QW + QW + q * 16 + r];
        const float M = fmaxf(st.m[q], m1);
        const float a0 = exp2f(st.m[q] - M), a1 = exp2f(m1 - M);
        const float inv = 1.f / (lt[q] * a0 + l1 * a1);
#pragma unroll
        for (int dv = 0; dv < 4; ++dv) {
          const f32x4 o1 = *(const f32x4*)(sm + 1 * WS + lane * (16 * AQT) + q * 16 + dv * 4);
          A[dv] = (st.o[q][dv] * a0 + o1 * a1) * inv;
        }
      }
      {
        const float m2 = pm[2 * QW + q * 16 + r], l2 = pm[4 * QW + 2 * QW + q * 16 + r], m3 = pm[3 * QW + q * 16 + r], l3 = pm[4 * QW + 3 * QW + q * 16 + r];
        const float M = fmaxf(m2, m3);
        const float a2 = exp2f(m2 - M), a3 = exp2f(m3 - M);
        const float inv = 1.f / (l2 * a2 + l3 * a3);
#pragma unroll
        for (int dv = 0; dv < 4; ++dv) {
          const f32x4 o2 = *(const f32x4*)(sm + 2 * WS + lane * (16 * AQT) + q * 16 + dv * 4);
          const f32x4 o3 = *(const f32x4*)(sm + 3 * WS + lane * (16 * AQT) + q * 16 + dv * 4);
          B[dv] = (o2 * a2 + o3 * a3) * inv;
        }
      }
      diff_finish_q(p, l, lam, lam_init, A, B, tok0 + q * 16, 256 + h * 64);
    }
  }
  __syncthreads();
}

__device__ void attn_ctx_item(const Params& p, int l, int bi) {
  const int wave = otid() >> 6, lane = otid() & 63, g = lane >> 4;
  const int w = bi * 4 + wave;
  const int type = w / (64 * NQG_CTX), rem = w % (64 * NQG_CTX);
  const int b = rem / (4 * NQG_CTX), h = (rem / NQG_CTX) & 3, qg = rem % NQG_CTX;
  const int tokb = b * 256, tok0 = tokb + qg * QW;
  const u16* zb = p.z + (size_t)tokb * INW;
  const int kvh = h >> 1;
  const int qcol = type == 0 ? h * 64 : 1792 + h * 64;
  const int kcol = type == 0 ? 256 + h * 64 : 2048 + kvh * 64;
  const int vrow = type == 0 ? h * 64 : 512 + kvh * 64;
  const int ocol = type == 0 ? h * 64 : 768 + h * 64;
  bf16x8 qf[AQT][2];
  load_q<2, AQT>(p.z + (size_t)tok0 * INW + qcol, qf);
  const int hslot = type == 0 ? h : 8 + kvh;
  Seg s0; s0.K = KLOC(hslot, tokb); s0.Vt = VLOC(hslot, tokb); s0.ldk = 0; s0.ldv = 0; s0.nblk = 8; s0.pos0 = 0; s0.stride = 32;
  Seg sN = s0; sN.nblk = 0;
  AState<AQT> st;
  const float sk = type == 0 ? -1e30f : p.swa_sink[l * 4 + h] * LOG2E;
  astate_init<AQT>(st, sk, (type == 1 && g == 0) ? 1.f : 0.f);
  attn_run<64, AQT, 0, 2>(s0, sN, qf, 0.125f * LOG2E, st, 0, nullptr);
  astate_finalize<AQT>(st);
  write_o<AQT>(p, st, tok0, ocol);
}

__device__ void attn_lat_item(const Params& p, int l, int bi, float* sm) {
  const int wave = otid() >> 6, lane = otid() & 63, r = lane & 15, g = lane >> 4;
  const int type = bi / (8 * NQG_LAT), rem = bi % (8 * NQG_LAT);
  const int b = rem / (4 * NQG_LAT), h = (rem / NQG_LAT) & 3, qg = rem % NQG_LAT;
  const int q0 = qg * QW;
  const int tokb = NPTOK + b * 1024, tok0 = tokb + q0;
  const u16* zb = p.z + (size_t)tokb * INW;
  const int bl = b * 4 + l;
  AState<AQT> st;
  int ocol;
  if (type != 0) {
    const float* rp = p.na_rpb + (size_t)(l * 4 + h) * 15 * 31;
    for (int e = otid(); e < 465; e += 256) sm[9000 + e] = rp[e] * LOG2E;
    __syncthreads();
  }
  if (type == 0) {
    const int kvh = h >> 1;
    bf16x8 qf[AQT][2];
    load_q<2, AQT>(p.z + (size_t)tok0 * INW + 1792 + h * 64, qf);
    Seg s0; s0.K = p.ck_swa + (size_t)((bl * 2 + kvh) * 16) * 2048; s0.Vt = p.cvt_swa + (size_t)((bl * 2 + kvh) * 16) * 2048; s0.ldk = 0; s0.ldv = 0; s0.nblk = 16; s0.pos0 = 0; s0.stride = 32;
    const int lo = max(0, q0 - 128) & ~31;
    const int hi = min(1024, ((q0 + QW + 128) + 31) & ~31);
    int lo2 = lo, cnt = (hi - lo) >> 5;
    if (cnt & 1) { if (lo2 > 0) lo2 -= 32; ++cnt; }
    Seg s1; s1.K = KLOC(8 + kvh, tokb); s1.Vt = VLOC(8 + kvh, tokb); s1.ldk = 0; s1.ldv = 0; s1.nblk = cnt; s1.pos0 = lo2; s1.stride = 32;
    const int P = (16 + cnt) >> 1;
    const int pb = (wave * P) >> 2, pe = ((wave + 1) * P) >> 2;
    astate_init<AQT>(st, wave == 0 ? p.swa_sink[l * 4 + h] * LOG2E : -1e30f, (wave == 0 && g == 0) ? 1.f : 0.f);
    attn_run<64, AQT, 2>(s0, s1, qf, 0.125f * LOG2E, st, q0, nullptr, 2 * pb, 2 * pe);
    ocol = 768 + h * 64;
  } else {
    bf16x8 qf[AQT][2];
    load_q<2, AQT>(p.z + (size_t)tok0 * INW + h * 64, qf);
    Seg s0; s0.K = p.ck_na + (size_t)((bl * 4 + h) * 16) * 2048; s0.Vt = p.cvt_na + (size_t)((bl * 4 + h) * 16) * 2048; s0.ldk = 0; s0.ldv = 0; s0.nblk = 16; s0.pos0 = 0; s0.stride = 32;
    const int qrow = q0 >> 6;
    const int rstart = min(max(qrow - 4, 0), 8);
    Seg s1; s1.K = KLOC(h, tokb); s1.Vt = VLOC(h, tokb); s1.ldk = 0; s1.ldv = 0; s1.nblk = 16; s1.pos0 = rstart * 64; s1.stride = 32;
    astate_init<AQT>(st, -1e30f, 0.f);
    attn_run<64, AQT, 1, 2>(s0, s1, qf, 0.125f * LOG2E, st, q0, sm + 9000, 4 * wave, 4 * wave + 8, 16 + 4 * wave);
    ocol = h * 64;
  }
  float lt[AQT];
#pragma unroll
  for (int q = 0; q < AQT; ++q) {
    lt[q] = st.ls[q];
    lt[q] += __shfl_xor(lt[q], 16);
    lt[q] += __shfl_xor(lt[q], 32);
  }
  constexpr int WS = 64 * 16 * AQT;
  float* pm = sm + 4 * WS;
  if (wave != 0) {
    float* po = sm + wave * WS + lane * (16 * AQT);
#pragma unroll
    for (int q = 0; q < AQT; ++q) {
#pragma unroll
      for (int dv = 0; dv < 4; ++dv) *(f32x4*)(po + q * 16 + dv * 4) = st.o[q][dv];
      if (g == 0) { pm[wave * QW + q * 16 + r] = st.m[q]; pm[4 * QW + wave * QW + q * 16 + r] = lt[q]; }
    }
  }
  __syncthreads();
  if (wave == 0) {
#pragma unroll
    for (int q = 0; q < AQT; ++q) {
      const float m1 = pm[1 * QW + q * 16 + r], m2 = pm[2 * QW + q * 16 + r], m3 = pm[3 * QW + q * 16 + r];
      const float l1 = pm[4 * QW + 1 * QW + q * 16 + r], l2 = pm[4 * QW + 2 * QW + q * 16 + r], l3 = pm[4 * QW + 3 * QW + q * 16 + r];
      const float M = fmaxf(fmaxf(st.m[q], m1), fmaxf(m2, m3));
      const float a0 = __builtin_amdgcn_exp2f(st.m[q] - M), a1 = __builtin_amdgcn_exp2f(m1 - M), a2 = __builtin_amdgcn_exp2f(m2 - M), a3 = __builtin_amdgcn_exp2f(m3 - M);
      const float inv = 1.f / (lt[q] * a0 + l1 * a1 + l2 * a2 + l3 * a3);
#pragma unroll
      for (int dv = 0; dv < 4; ++dv) {
        const f32x4 o1 = *(const f32x4*)(sm + 1 * WS + lane * (16 * AQT) + q * 16 + dv * 4);
        const f32x4 o2 = *(const f32x4*)(sm + 2 * WS + lane * (16 * AQT) + q * 16 + dv * 4);
        const f32x4 o3 = *(const f32x4*)(sm + 3 * WS + lane * (16 * AQT) + q * 16 + dv * 4);
        st.o[q][dv] = (st.o[q][dv] * a0 + o1 * a1 + o2 * a2 + o3 * a3) * inv;
      }
    }
    write_o<AQT>(p, st, tok0, ocol);
  }
  __syncthreads();
}

__device__ __forceinline__ int q_next(unsigned* cnt, volatile LAS unsigned* slot) {
  __syncthreads();
  if (threadIdx.x == 0) *slot = xb_add(cnt, 1u);
  __syncthreads();
  return (int)*slot;
}

#if REP_SYNC
#define GSYNC() do { xcd_barrier(xb); xcd_barrier(xb); } while (0)
#else
#define GSYNC() xcd_barrier(xb)
#endif
__global__ void __launch_bounds__(256, 2) mega(Params p) {
  extern __shared__ __attribute__((aligned(16))) unsigned char smem[];
  cg::grid_group grid = cg::this_grid();
  const int nblk = gridDim.x, bid = blockIdx.x;
  u16* sm16 = (u16*)smem;
  __shared__ uint4 xb_words[2];
  if (threadIdx.x == 0) { xb_words[0] = make_uint4(0u, 0u, 0u, 0u); xb_words[1] = make_uint4(0u, 0u, 0u, 0u); }
  __syncthreads();
  XcdBarrier xb = xcd_barrier_post(p.bar, (volatile LAS unsigned*)&xb_words[0]);

  for (int rep = 0; rep <= REP_P0; ++rep)
    for (int it = bid; it < P0_ITEMS; it += nblk) p0_item(p, it, smem);
  if (p.use_cg_sync) grid.sync();
  GSYNC();

  const int xcc = (int)xb.x;
  const int xrank = __builtin_amdgcn_readfirstlane((int)xb.st[4]), xnloc = __builtin_amdgcn_readfirstlane((int)xb.st[0]);
  const unsigned topo = (unsigned)__builtin_amdgcn_readfirstlane((int)xb.st[5]);
  const bool local = (topo & 1u) != 0u, full64 = (topo & 2u) != 0u;
#define LSYNC() do { if (local) xcd_barrier_local(xb); else GSYNC(); } while (0)
#define LMAP(j, count, total) (local ? ((xrank + (j) * xnloc) < (count) ? (xrank + (j) * xnloc) : -1) : ((bid + (j) * nblk) < (total) ? (bid + (j) * nblk) : -1))

#pragma unroll 1
  for (int l = 0; l < 4; ++l) {
    for (int j = 0;; ++j) { const int v = LMAP(j, 48, 384); if (v < 0) break; norm_item(p, l, 0, local ? 48 * xcc + v : v); }
    LSYNC();
    for (int j = 0;; ++j) {
      const int v = LMAP(j, 108, 864); if (v < 0) break;
      if (local) gin_tile(p, l, v / 6, 6 * xcc + v % 6, sm16); else gin_tile(p, l, v / 48, v % 48, sm16);
    }
    if (full64) {
      if (xrank >= 44) {
        const int idle = xcc * 20 + (xrank - 44);
        for (int it = 288 + idle; it < 1184; it += 160) wt_item(p, l, it, (float*)smem);
      }
    }
    GSYNC();
    {
      constexpr int CD = 64 * NQG_CTX, CC = 2 * 64 * NQG_CTX / 4;
      constexpr int LD = 8 * NQG_LAT, LC = 2 * 8 * NQG_LAT;
      constexpr int E0 = 192, E1 = E0 + LD, E2 = E1 + LC, E3 = E2 + 32, E4 = E3 + CC, E5 = E4 + CD, E6 = E5 + 64;
      unsigned* qc = p.bar + XCD_BAR_WORDS + l * 64;
      const int w0 = full64 ? 1184 : 288;
      const int EA = E6 + (1440 - w0), EW = EA + (l < 3 ? 288 : 0);
      for (int it = bid; it < EW; it = nblk + q_next(qc, &xb.st[2])) {
        if (it >= E6) {
          if (it < EA) wt_item(p, l, it - E6 + w0, (float*)smem);
          else wt_item(p, l + 1, it - EA, (float*)smem);
          continue;
        }
        if (it < E0) f1_tile(p, l, it, sm16);
        else if (it < E0 + LC) attn_lat_item(p, l, it - E0, (float*)smem);
        else if (it < E2) attn_diff_item(p, l, true, it - E0 - LC, (float*)smem);
        else if (it < E3) f2_tile(p, l, it - E2, sm16);
        else if (it < E4) attn_ctx_item(p, l, it - E3);
        else if (it < E5) attn_diff_item(p, l, false, it - E4, (float*)smem);
        else f2_tile(p, l, it - E5 + 32, sm16);
      }
    }
    GSYNC();
    for (int j = 0;; ++j) {
      const int v = LMAP(j, 64, 512); if (v < 0) break;
      if (local) res_tile(p, l, v / 8, 8 * xcc + v % 8, p.cat, p.w_outT + (size_t)l * 1024 * 1024, 1024, 2, sm16, l == 0);
      else res_tile(p, l, v / 64, v % 64, p.cat, p.w_outT + (size_t)l * 1024 * 1024, 1024, 2, sm16, l == 0);
    }
    LSYNC();
    for (int j = 0;; ++j) { const int v = LMAP(j, 48, 384); if (v < 0) break; norm_item(p, l, 1, local ? 48 * xcc + v : v); }
    LSYNC();
    for (int j = 0;; ++j) {
      const int v = LMAP(j, 192, 1536); if (v < 0) break;
      if (local) m1_tile(p, l, v / 6, 6 * xcc + v % 6, sm16); else m1_tile(p, l, v / 48, v % 48, sm16);
    }
    LSYNC();
    for (int j = 0;; ++j) {
      const int v = LMAP(j, 64, 512); if (v < 0) break;
      if (local) res_tile(p, l, v / 8, 8 * xcc + v % 8, p.u, p.w2T + (size_t)l * 1024 * 4096, 4096, 5, sm16);
      else res_tile(p, l, v / 64, v % 64, p.u, p.w2T + (size_t)l * 1024 * 4096, 4096, 5, sm16);
    }
    LSYNC();
  }
  for (int j = 0;; ++j) { const int v = LMAP(j, 48, 384); if (v < 0) break; norm_item(p, 0, 2, local ? 48 * xcc + v : v); }
#undef LSYNC
#undef LMAP
}

extern "C" void kernel_launch(void* const* d_in, const int* in_sizes, int n_in, void* d_out, int out_size, void* d_ws,
                              size_t ws_size, hipStream_t stream) {
  static int grid_blocks = 0;
  if (grid_blocks == 0) {
    int dev = 0, cus = 0, per_cu = 0;
    (void)hipGetDevice(&dev);
    (void)hipDeviceGetAttribute(&cus, hipDeviceAttributeMultiprocessorCount, dev);
    if (hipFuncSetAttribute((const void*)mega, hipFuncAttributeMaxDynamicSharedMemorySize, LDS_BYTES) != hipSuccess) {
      fprintf(stderr, "hipFuncSetAttribute failed\n");
    }
    if (hipOccupancyMaxActiveBlocksPerMultiprocessor(&per_cu, (const void*)mega, 256, LDS_BYTES) != hipSuccess || per_cu < 1) {
      fprintf(stderr, "occupancy query failed (%d)\n", per_cu);
      per_cu = 1;
    }
    if (per_cu > 2) per_cu = 2;
    grid_blocks = cus * per_cu;
    fprintf(stderr, "mega: cus=%d per_cu=%d grid=%d ws=%zu\n", cus, per_cu, grid_blocks, ws_size);
  }
  Params p{};
  const float** pin = (const float**)&p;
  for (int i = 0; i < 27; ++i) pin[i] = (const float*)d_in[i];
  p.out = (float*)d_out;
  unsigned char* ws = (unsigned char*)d_ws;
  size_t off = 0;
  auto take = [&](size_t bytes) { unsigned char* q = ws + off; off += (bytes + 255) & ~(size_t)255; return q; };
  p.xres = (float*)take((size_t)NTOK * 1024 * 4);
  p.mods = (float*)take((size_t)4 * 3 * 6144 * 4);
  p.h = (u16*)take((size_t)NTOK * 1024 * 2);
  p.z = (u16*)take((size_t)NTOK * INW * 2);
  p.vt = (u16*)take((size_t)640 * NTOK * 2);
  p.cat = (u16*)take((size_t)NTOK * 1024 * 2);
  p.u = (u16*)take((size_t)NTOK * 4096 * 2);
  p.uv = (u16*)take((size_t)(16 * 256 * 512 + 2 * 256 * 2048) * 2);
  p.w_inT = (u16*)take((size_t)4 * 2304 * 1024 * 2);
  p.w_outT = (u16*)take((size_t)4 * 1024 * 1024 * 2);
  p.w1T = (u16*)take((size_t)4 * 4096 * 1024 * 2);
  p.w2T = (u16*)take((size_t)4 * 4096 * 1024 * 2);
  p.pqt = (u16*)take((size_t)4 * 512 * 256 * 2);
  p.dft256 = (u16*)take((size_t)256 * 512 * 2);
  p.dft1024 = (u16*)take((size_t)1024 * 2048 * 2);
  p.ck_na = (u16*)take((size_t)2 * 4 * 512 * 256 * 2);
  p.cvt_na = (u16*)take((size_t)2 * 4 * 512 * 256 * 2);
  p.ck_diff = (u16*)take((size_t)2 * 4 * 512 * 256 * 2);
  p.cvt_diff = (u16*)take((size_t)2 * 4 * 512 * 256 * 2);
  p.ck_swa = (u16*)take((size_t)2 * 4 * 512 * 128 * 2);
  p.cvt_swa = (u16*)take((size_t)2 * 4 * 512 * 128 * 2);
  p.kfr = (u16*)take((size_t)10 * 192 * 2048 * 2);
  p.vfr = (u16*)take((size_t)10 * 192 * 2048 * 2);
  p.ropeD = (float*)take(1024 * 4);
  p.ropeS = (float*)take(2048 * 4);
  p.bar = (unsigned*)take(XB_ALL_WORDS * 4);
  if (off > ws_size) { fprintf(stderr, "workspace too small: need %zu have %zu\n", off, ws_size); return; }
  if (hipMemsetAsync(p.bar, 0, XB_ALL_WORDS * 4, stream) != hipSuccess) fprintf(stderr, "memset failed\n");
  void* args[] = {&p};
  hipError_t e = hipLaunchCooperativeKernel((const void*)mega, dim3(grid_blocks), dim3(256), args, LDS_BYTES, stream);
  if (e != hipSuccess) fprintf(stderr, "cooperative launch failed: %s (grid %d)\n", hipGetErrorString(e), grid_blocks);
}
```

```cpp
#include <hip/hip_runtime.h>
#include <hip/hip_cooperative_groups.h>
#include <stdint.h>
#include <stdio.h>
namespace cg = cooperative_groups;

typedef unsigned short u16;
typedef __attribute__((ext_vector_type(8))) short bf16x8;
typedef __attribute__((ext_vector_type(4))) float f32x4;
typedef __attribute__((ext_vector_type(4))) unsigned u32x4;
__device__ __forceinline__ void gload16(u32x4& dst, const void* ptr) {
  asm volatile("global_load_dwordx4 %0, %1, off" : "=v"(dst) : "v"(ptr) : "memory");
}

#define NTOK 6144
#define NPTOK 4096
#define INW 2304
#define LOG2E 1.4426950408889634f
#define LDS_BYTES 73728
#define LSTR 72

#define O_NAK 6291456
#define O_NAV 10485760
#define O_DK 14680064
#define O_DV 18874368
#define O_SK 23068672
#define O_SV 25165824

struct Params {
  const float *x_prompt, *x_sample, *c_na_k, *c_na_v, *c_diff_k, *c_diff_v, *c_swa_k, *c_swa_v, *c, *c_ctx;
  const float *w_ada, *b_ada, *norm1_g, *norm2_g, *w_in, *na_rpb, *lq1, *lk1, *lq2, *lk2, *subln_g, *w_fourier, *swa_sink;
  const float *w_out, *w1, *w2, *final_g;
  float* out;
  float* xres;
  float* mods;
  u16 *h, *z, *vt, *cat, *u, *uv, *w_inT, *w_outT, *w1T, *w2T, *pqt, *dft256, *dft1024;
  u16 *ck_na, *cvt_na, *ck_diff, *cvt_diff, *ck_swa, *cvt_swa;
  float *ropeD, *ropeS;
  u16 *kfr, *vfr;
  unsigned* bar;
  int use_cg_sync;
  int pad_;
};

__device__ __forceinline__ u16 f2bf(float f) {
  unsigned u = __float_as_uint(f);
  u += 0x7fffu + ((u >> 16) & 1u);
  return (u16)(u >> 16);
}
__device__ __forceinline__ int otid() { int t = threadIdx.x; asm volatile("" : "+v"(t)); return t; }
__device__ __forceinline__ float bf2f(u16 h) { return __uint_as_float(((unsigned)h) << 16); }
typedef __attribute__((ext_vector_type(2))) __bf16 hbf16x2;
typedef __attribute__((ext_vector_type(2))) float f32x2;
__device__ __forceinline__ unsigned pack2(float a, float b) {
  f32x2 v = {a, b};
  union { hbf16x2 h; unsigned u; } x;
  x.h = __builtin_convertvector(v, hbf16x2);
  return x.u;
}

__device__ __forceinline__ int kfrag_off(int kk, int d) {
  const int t = (kk >> 2) & 1, r = ((kk >> 3) << 2) | (kk & 3), dc = d >> 5, g = (d >> 3) & 3;
  return ((t * 2 + dc) * 64 + g * 16 + r) * 8 + (d & 7);
}
__device__ __forceinline__ int vfrag_off(int kk, int dv) {
  return (((dv >> 4) * 64) + (kk >> 3) * 16 + (dv & 15)) * 8 + (kk & 7);
}

#define XB_TMO      128
#define XB_XCNT(j)  (256  + 64 * (j))
#define XB_XSUB(j)  (1280 + 64 * (j))
#define XB_XGEN(j)  (2304 + 64 * (j))
#define XB_TOP      3328
#define XB_TOPGEN   3392
#define XCD_BAR_WORDS 3456
#define XB_SPIN_CAP (1u << 22)
#define LAS __attribute__((address_space(3)))
__device__ __forceinline__ unsigned xb_ld(unsigned* p)              { return __hip_atomic_load(p, __ATOMIC_RELAXED, __HIP_MEMORY_SCOPE_AGENT); }
__device__ __forceinline__ unsigned xb_add(unsigned* p, unsigned v) { return __hip_atomic_fetch_add(p, v, __ATOMIC_RELAXED, __HIP_MEMORY_SCOPE_AGENT); }
__device__ __forceinline__ unsigned xb_xcc_id() { return (unsigned)__builtin_amdgcn_s_getreg((3 << 11) | 20) & 0xFu; }
#define XB_SPIN(cond, bar) do { unsigned _sp = 0; while (cond) { __builtin_amdgcn_s_sleep(1); \
    if ((++_sp & 255u) == 0u) { if (xb_ld(&(bar)[XB_TMO])) break; if (_sp > XB_SPIN_CAP) { atomicAdd(&(bar)[XB_TMO], 1u); break; } } } } while (0)
#define XB_LSUB(j)  (XCD_BAR_WORDS + 12 * 64 + 64 * (j))
#define XB_LGEN(j)  (XCD_BAR_WORDS + 12 * 64 + 64 * (16 + (j)))
#define XB_ALL_WORDS (XCD_BAR_WORDS + 12 * 64 + 32 * 64)
struct XcdBarrier { unsigned* bar; unsigned x; volatile LAS unsigned* st; };
__device__ __forceinline__ XcdBarrier xcd_barrier_post(unsigned* bar, volatile LAS unsigned* st) {
  XcdBarrier b; b.bar = bar; b.x = xb_xcc_id(); b.st = st;
  if (threadIdx.x == 0) st[4] = xb_add(&bar[XB_XCNT(b.x)], 1u);
  return b;
}
__device__ __forceinline__ void xcd_barrier_complete(unsigned* bar, unsigned x, unsigned& nloc, unsigned& nx) {
  const unsigned G = gridDim.x * gridDim.y * gridDim.z;
  unsigned sum, cnt, mine, sp = 0u;
  for (;;) {
    sum = 0u; cnt = 0u; mine = 0u;
#pragma unroll
    for (unsigned j = 0; j < 16; ++j) { const unsigned c = xb_ld(&bar[XB_XCNT(j)]); sum += c; cnt += (c > 0u) ? 1u : 0u; mine = (j == x) ? c : mine; }
    if (sum == G) break;
    __builtin_amdgcn_s_sleep(1);
    if ((++sp & 255u) == 0u) { if (xb_ld(&bar[XB_TMO])) break; if (sp > XB_SPIN_CAP) { atomicAdd(&bar[XB_TMO], 1u); break; } }
  }
  nloc = mine > 0u ? mine : 1u; nx = cnt > 0u ? cnt : 1u;
}
__device__ __forceinline__ unsigned xcd_topology(unsigned* bar) {
  const unsigned G = gridDim.x * gridDim.y * gridDim.z;
  unsigned sum8 = 0u, all = 1u, all64 = 1u;
#pragma unroll
  for (unsigned j = 0; j < 8; ++j) { const unsigned c = xb_ld(&bar[XB_XCNT(j)]); sum8 += c; all &= (c > 0u) ? 1u : 0u; all64 &= (c == 64u) ? 1u : 0u; }
  const unsigned ok = (all && sum8 == G) ? 1u : 0u;
  return ok | ((ok && all64) ? 2u : 0u);
}
__device__ __forceinline__ void xcd_barrier(const XcdBarrier& b) {
  asm volatile("s_waitcnt vmcnt(0)" ::: "memory");
  __syncthreads();
  if (threadIdx.x == 0) {
    unsigned* bar = b.bar;
    __builtin_amdgcn_s_waitcnt(0);
    unsigned nloc = b.st[0], nx = b.st[1];
    if (nloc == 0u) { xcd_barrier_complete(bar, b.x, nloc, nx); b.st[0] = nloc; b.st[1] = nx; b.st[5] = xcd_topology(bar); }
    const unsigned old = xb_add(&bar[XB_XSUB(b.x)], 1u);
    const unsigned gen = old / nloc;
    if (old + 1u == (gen + 1u) * nloc) {
      __builtin_amdgcn_fence(__ATOMIC_RELEASE, "agent");
      asm volatile("s_waitcnt vmcnt(0)" ::: "memory");
      const unsigned og = xb_add(&bar[XB_TOP], 1u);
      const unsigned tg = og / nx;
      if (og + 1u == (tg + 1u) * nx) xb_add(&bar[XB_TOPGEN], 1u);
      else XB_SPIN(xb_ld(&bar[XB_TOPGEN]) == tg, bar);
      __builtin_amdgcn_fence(__ATOMIC_ACQUIRE, "agent");
      xb_add(&bar[XB_XGEN(b.x)], 1u);
      asm volatile("s_waitcnt vmcnt(0)" ::: "memory");
    } else {
      XB_SPIN(xb_ld(&bar[XB_XGEN(b.x)]) == gen, bar);
      __builtin_amdgcn_fence(__ATOMIC_ACQUIRE, "agent");
      asm volatile("s_waitcnt vmcnt(0)" ::: "memory");
    }
  }
  __syncthreads();
}

__device__ __forceinline__ void xcd_barrier_local(const XcdBarrier& b) {
  asm volatile("s_waitcnt vmcnt(0)" ::: "memory");
  __syncthreads();
  if (threadIdx.x == 0) {
    unsigned* bar = b.bar;
    __builtin_amdgcn_s_waitcnt(0);
    const unsigned nloc = b.st[0];
    const unsigned old = xb_add(&bar[XB_LSUB(b.x)], 1u);
    const unsigned gen = old / nloc;
    if (old + 1u == (gen + 1u) * nloc) xb_add(&bar[XB_LGEN(b.x)], 1u);
    else XB_SPIN(xb_ld(&bar[XB_LGEN(b.x)]) == gen, bar);
    __builtin_amdgcn_fence(__ATOMIC_ACQUIRE, "agent");
    asm volatile("s_waitcnt vmcnt(0)" ::: "memory");
  }
  __syncthreads();
}

__device__ __forceinline__ void transpose_tile(const float* __restrict__ src, int lds_, u16* __restrict__ dst, int ldd,
                                               int k0, int n0, float* sm, bool fragv = false) {
  const int tid = otid();
  const int c4 = (tid & 15) * 4, r0 = tid >> 4;
  float4 v[8];
#pragma unroll
  for (int i = 0; i < 8; ++i) { const f32x4 t = __builtin_nontemporal_load((const f32x4*)(src + (size_t)(k0 + r0 + 16 * i) * lds_ + n0 + c4)); v[i] = make_float4(t[0], t[1], t[2], t[3]); }
#pragma unroll
  for (int i = 0; i < 8; ++i) {
    const int k = r0 + 16 * i;
    sm[(c4 + 0) * 129 + k] = v[i].x; sm[(c4 + 1) * 129 + k] = v[i].y; sm[(c4 + 2) * 129 + k] = v[i].z; sm[(c4 + 3) * 129 + k] = v[i].w;
  }
  __syncthreads();
  const int k8 = (tid & 15) * 8, nn = tid >> 4;
#pragma unroll
  for (int i = 0; i < 4; ++i) {
    const int n = nn + 16 * i;
    const float* row = sm + n * 129 + k8;
    uint4 w;
    w.x = pack2(row[0], row[1]); w.y = pack2(row[2], row[3]); w.z = pack2(row[4], row[5]); w.w = pack2(row[6], row[7]);
    if (fragv) {
      const int col = n0 + n, pos = k0 + k8;
      *(uint4*)(dst + ((size_t)((col >> 6) * 16 + (pos >> 5))) * 2048 + vfrag_off(pos & 31, col & 63)) = w;
    } else {
      *(uint4*)(dst + (size_t)(n0 + n) * ldd + k0 + k8) = w;
    }
  }
  __syncthreads();
}

__device__ __forceinline__ void adaln_item(const Params& p, int it, float* sm) {
  const int l = it / 192, c0 = (it % 192) * 32;
  float* ssil = sm;
  float* red = sm + 3072;
  const int tid = otid();
  for (int i = tid; i < 3072; i += 256) {
    const int cnd = i >> 10, k = i & 1023;
    const float v = cnd == 0 ? p.c_ctx[k] : p.c[(cnd - 1) * 1024 + k];
    ssil[i] = v / (1.f + expf(-v));
  }
  __syncthreads();
  const int cg4 = (tid & 7) * 4, ks = tid >> 3;
  const float* w = p.w_ada + (size_t)l * 1024 * 6144 + c0 + cg4;
  float a0[4] = {0.f, 0.f, 0.f, 0.f}, a1[4] = {0.f, 0.f, 0.f, 0.f}, a2[4] = {0.f, 0.f, 0.f, 0.f};
#pragma unroll 16
  for (int kk = 0; kk < 32; ++kk) {
    const int k = kk * 32 + ks;
    const f32x4 tv = __builtin_nontemporal_load((const f32x4*)(w + (size_t)k * 6144));
    const float4 v = make_float4(tv[0], tv[1], tv[2], tv[3]);
    const float s0 = ssil[k], s1 = ssil[1024 + k], s2 = ssil[2048 + k];
    a0[0] += s0 * v.x; a0[1] += s0 * v.y; a0[2] += s0 * v.z; a0[3] += s0 * v.w;
    a1[0] += s1 * v.x; a1[1] += s1 * v.y; a1[2] += s1 * v.z; a1[3] += s1 * v.w;
    a2[0] += s2 * v.x; a2[1] += s2 * v.y; a2[2] += s2 * v.z; a2[3] += s2 * v.w;
  }
#pragma unroll
  for (int j = 0; j < 4; ++j) {
    red[(ks * 3 + 0) * 32 + cg4 + j] = a0[j];
    red[(ks * 3 + 1) * 32 + cg4 + j] = a1[j];
    red[(ks * 3 + 2) * 32 + cg4 + j] = a2[j];
  }
  __syncthreads();
  if (tid < 96) {
    const int cnd = tid >> 5, j = tid & 31;
    float s = p.b_ada[l * 6144 + c0 + j];
    for (int q = 0; q < 32; ++q) s += red[(q * 3 + cnd) * 32 + j];
    p.mods[(l * 3 + cnd) * 6144 + c0 + j] = s;
  }
  __syncthreads();
}

__device__ __forceinline__ void cvt_item(const float* __restrict__ src, u16* __restrict__ dst, int it, int W) {
  const int w8 = W >> 3;
#pragma unroll
  for (int i = 0; i < 4; ++i) {
    const int u = it * 1024 + i * 256 + otid();
    const int d8 = u % w8, pos = (u / w8) & 511, bl = u / (w8 * 512);
    const float* sp = src + ((size_t)(bl * 512 + pos) * W + d8 * 8);
    const f32x4 t0 = __builtin_nontemporal_load((const f32x4*)sp), t1 = __builtin_nontemporal_load((const f32x4*)(sp + 4));
    const float4 v0 = make_float4(t0[0], t0[1], t0[2], t0[3]), v1 = make_float4(t1[0], t1[1], t1[2], t1[3]);
    uint4 w; w.x = pack2(v0.x, v0.y); w.y = pack2(v0.z, v0.w); w.z = pack2(v1.x, v1.y); w.w = pack2(v1.z, v1.w);
    const int h = d8 >> 3, d = (d8 & 7) * 8;
    *(uint4*)(dst + ((size_t)((bl * (W >> 6) + h) * 16 + (pos >> 5))) * 2048 + kfrag_off(pos & 31, d)) = w;
  }
}

__device__ __forceinline__ void pq_item(const Params& p, int it, float* sm) {
  const int cq = it & 3, it2 = it >> 2;
  const int l = it2 >> 3, which = (it2 >> 2) & 1, g = it2 & 3;
  const int n = otid();
  if (n < 64) sm[n] = which ? sinpif(2.f * (float)n / 64.f) : cospif(2.f * (float)n / 64.f);
  __syncthreads();
  float w[64];
#pragma unroll
  for (int m = 0; m < 64; ++m) w[m] = p.w_fourier[(size_t)l * 65536 + (g * 64 + m) * 256 + n];
  u16* dst = p.pqt + (size_t)l * 512 * 256 + (size_t)(which * 256 + n) * 256 + g * 64;
  for (int c = cq * 16; c < cq * 16 + 16; ++c) {
    float s = 0.f;
#pragma unroll
    for (int m = 0; m < 64; ++m) s += sm[(c * m) & 63] * w[m];
    dst[c] = f2bf(s);
  }
  __syncthreads();
}

__device__ __forceinline__ void dft_item(u16* dst, int L, int it) {
  const int twoL = 2 * L;
  for (int e = otid(); e < 8192; e += 256) {
    const int idx = it * 8192 + e;
    const int k = idx / twoL, j = idx % twoL;
    const int jj = j & (L - 1);
    const int ph = (k * jj) & (L - 1);
    const float a = 2.f * (float)ph / (float)L;
    const float v = (j >= L) ? -sinpif(a) : cospif(a);
    dst[idx] = f2bf(v);
  }
}

#define P0_WT 288
#define P0_ADA 768
#define P0_XC 0
#define P0_CK 320
#define P0_CVT 320
#define P0_PQ 128
#define P0_DFT 272
#define P0_ITEMS (P0_ADA + P0_WT + P0_XC + P0_CK + P0_CVT + P0_PQ + P0_DFT + 1)

__device__ void wt_item(const Params& p, int l, int r, float* sm) {
  if (r < 288) { transpose_tile(p.w_in + (size_t)l * 1024 * 2304, 2304, p.w_inT + (size_t)l * 2304 * 1024, 1024, (r / 36) * 128, (r % 36) * 64, sm); return; }
  r -= 288;
  if (r < 128) { transpose_tile(p.w_out + (size_t)l * 1024 * 1024, 1024, p.w_outT + (size_t)l * 1024 * 1024, 1024, (r / 16) * 128, (r % 16) * 64, sm); return; }
  r -= 128;
  if (r < 512) { transpose_tile(p.w1 + (size_t)l * 1024 * 4096, 4096, p.w1T + (size_t)l * 4096 * 1024, 1024, (r / 64) * 128, (r % 64) * 64, sm); return; }
  r -= 512;
  transpose_tile(p.w2 + (size_t)l * 4096 * 1024, 1024, p.w2T + (size_t)l * 1024 * 4096, 4096, (r / 16) * 128, (r % 16) * 64, sm);
}

__device__ void p0_item(const Params& p, int it, unsigned char* smem) {
  float* sm = (float*)smem;
  if (it < P0_ADA) { adaln_item(p, it, sm); return; }
  it -= P0_ADA;
  if (it < P0_WT) { wt_item(p, 0, it, sm); return; }
  it -= P0_WT;
  if (it < P0_XC) {
    const int row0 = it * 16;
    const float* src = row0 < NPTOK ? p.x_prompt + (size_t)row0 * 1024 : p.x_sample + (size_t)(row0 - NPTOK) * 1024;
    float* dst = p.xres + (size_t)row0 * 1024;
#pragma unroll
    for (int i = 0; i < 16; ++i) {
      const int o = (i * 256 + otid()) * 4;
      *(float4*)(dst + o) = *(const float4*)(src + o);
    }
    return;
  }
  it -= P0_XC;
  if (it < P0_CK) {
    if (it < 128) { cvt_item(p.c_na_k, p.ck_na, it, 256); return; }
    it -= 128;
    if (it < 128) { cvt_item(p.c_diff_k, p.ck_diff, it, 256); return; }
    it -= 128;
    cvt_item(p.c_swa_k, p.ck_swa, it, 128);
    return;
  }
  it -= P0_CK;
  if (it < P0_CVT) {
    if (it < 128) { const int bl = it >> 4, r = it & 15; transpose_tile(p.c_na_v + (size_t)bl * 512 * 256, 256, p.cvt_na + (size_t)bl * 256 * 512, 512, (r >> 2) * 128, (r & 3) * 64, sm, true); return; }
    it -= 128;
    if (it < 128) { const int bl = it >> 4, r = it & 15; transpose_tile(p.c_diff_v + (size_t)bl * 512 * 256, 256, p.cvt_diff + (size_t)bl * 256 * 512, 512, (r >> 2) * 128, (r & 3) * 64, sm, true); return; }
    it -= 128;
    { const int bl = it >> 3, r = it & 7; transpose_tile(p.c_swa_v + (size_t)bl * 512 * 128, 128, p.cvt_swa + (size_t)bl * 128 * 512, 512, (r >> 1) * 128, (r & 1) * 64, sm, true); return; }
  }
  it -= P0_CVT;
  if (it < P0_PQ) { pq_item(p, it, sm); return; }
  it -= P0_PQ;
  if (it < 16) { dft_item(p.dft256, 256, it); return; }
  it -= 16;
  if (it < 256) { dft_item(p.dft1024, 1024, it); return; }
  for (int e = otid(); e < 512 + 1024; e += 256) {
    const bool isD = e < 512;
    const int ee = isD ? e : e - 512;
    const int nf = isD ? 8 : 16;
    const int pos = ee / nf, fi = ee % nf;
    const float inv = exp2f(-(float)fi * (13.287712379549449f / (float)nf));
    float tt = (float)pos * inv * 0.15915494309189535f;
    tt -= rintf(tt);
    float sn, cs;
    sincospif(2.f * tt, &sn, &cs);
    if (isD) { p.ropeD[ee] = cs; p.ropeD[512 + ee] = sn; }
    else { p.ropeS[ee] = cs; p.ropeS[1024 + ee] = sn; }
  }
}

__device__ __forceinline__ void norm_item(const Params& p, int l, int which, int it) {
  const int lane = otid() & 63, wave = otid() >> 6;
  const int row0 = it * 16 + wave * 4;
  const float* xsrc = (which == 0 && l == 0) ? (row0 < NPTOK ? p.x_prompt + (size_t)row0 * 1024 : p.x_sample + (size_t)(row0 - NPTOK) * 1024)
                                             : p.xres + (size_t)row0 * 1024;
  float4 v[4][4];
#pragma unroll
  for (int j = 0; j < 4; ++j)
#pragma unroll
    for (int k = 0; k < 4; ++k) v[j][k] = *(const float4*)(xsrc + (size_t)j * 1024 + (k * 64 + lane) * 4);
  float rs[4];
#pragma unroll
  for (int j = 0; j < 4; ++j) {
    float ss = 0.f;
#pragma unroll
    for (int k = 0; k < 4; ++k) ss += v[j][k].x * v[j][k].x + v[j][k].y * v[j][k].y + v[j][k].z * v[j][k].z + v[j][k].w * v[j][k].w;
#pragma unroll
    for (int o = 32; o >= 1; o >>= 1) ss += __shfl_xor(ss, o);
    rs[j] = rsqrtf(ss * (1.f / 1024.f) + 1e-6f);
  }
  if (which < 2) {
    const int cond = row0 < NPTOK ? 0 : 1 + ((row0 - NPTOK) >> 10);
    const float* gp = (which == 0 ? p.norm1_g : p.norm2_g) + l * 1024;
    const float* shp = p.mods + (size_t)(l * 3 + cond) * 6144 + (which * 3 + 0) * 1024;
    const float* scp = shp + 1024;
#pragma unroll
    for (int k = 0; k < 4; ++k) {
      const int col = (k * 64 + lane) * 4;
      const float4 gg = *(const float4*)(gp + col);
      const float4 sh = *(const float4*)(shp + col);
      const float4 sc = *(const float4*)(scp + col);
      const float mx = gg.x * (1.f + sc.x), my = gg.y * (1.f + sc.y), mz = gg.z * (1.f + sc.z), mw = gg.w * (1.f + sc.w);
#pragma unroll
      for (int j = 0; j < 4; ++j) {
        uint2 w;
        w.x = pack2(v[j][k].x * rs[j] * mx + sh.x, v[j][k].y * rs[j] * my + sh.y);
        w.y = pack2(v[j][k].z * rs[j] * mz + sh.z, v[j][k].w * rs[j] * mw + sh.w);
        *(uint2*)(p.h + (size_t)(row0 + j) * 1024 + col) = w;
      }
    }
  } else {
#pragma unroll
    for (int k = 0; k < 4; ++k) {
      const int col = (k * 64 + lane) * 4;
      const float4 gg = *(const float4*)(p.final_g + col);
#pragma unroll
      for (int j = 0; j < 4; ++j) {
        float4 o;
        o.x = v[j][k].x * rs[j] * gg.x; o.y = v[j][k].y * rs[j] * gg.y; o.z = v[j][k].z * rs[j] * gg.z; o.w = v[j][k].w * rs[j] * gg.w;
        { f32x4 ov = {o.x, o.y, o.z, o.w}; __builtin_nontemporal_store(ov, (f32x4*)(p.out + (size_t)(row0 + j) * 1024 + col)); }
      }
    }
  }
}

template <bool ZERO, int YT>
__device__ __forceinline__ void gemm_main_t(const u16* __restrict__ X, int ldx, const u16* __restrict__ Y, int ldy, int K,
                                          u16* smem, f32x4 (&acc)[4][YT]) {
  const int tid = otid(), lane = tid & 63, wave = tid >> 6, wx = wave & 1, wy = wave >> 1, r = lane & 15, g = lane >> 4;
  u16* sX = smem;
  u16* sY = smem + 2 * 128 * 64;
  const int lrow = tid >> 3, lkc = tid & 7;
  const int gsw = (lkc ^ (lrow & 7)) * 8;
  const u16* gx = X + (size_t)lrow * ldx + gsw;
  const u16* gy = Y + (size_t)lrow * ldy + gsw;
  u16* lx = sX + tid * 8;
  u16* ly = sY + tid * 8;
#define GEMM_STAGE(buf, kt_)                                                                                                      \
  {                                                                                                                               \
    _Pragma("unroll") for (int i = 0; i < 4; ++i)                                                                                 \
      __builtin_amdgcn_global_load_lds((const unsigned*)(gx + (size_t)(32 * i) * ldx + (kt_) * 64),                               \
                                       (unsigned*)(lx + (buf) * 8192 + i * 2048), 16, 0, 0);                                      \
    _Pragma("unroll") for (int i = 0; i < YT; ++i)                                                                                \
      __builtin_amdgcn_global_load_lds((const unsigned*)(gy + (size_t)(32 * i) * ldy + (kt_) * 64),                               \
                                       (unsigned*)(ly + (buf) * 8192 + i * 2048), 16, 0, 0);                                      \
  }
  GEMM_STAGE(0, 0);
  if (ZERO) {
#pragma unroll
    for (int a = 0; a < 4; ++a)
#pragma unroll
      for (int b = 0; b < YT; ++b) acc[a][b] = (f32x4){0.f, 0.f, 0.f, 0.f};
  }
  const int nk = K >> 6;
  const int sw = r & 7;
  const u16* cx0 = sX + (wx * 64 + r) * 64;
  const u16* cy0 = sY + (wy * (16 * YT) + r) * 64;
  __syncthreads();
#define GEMM_COMPUTE(cur)                                                                            \
  {                                                                                                  \
    const u16* cx = cx0 + (cur) * 8192;                                                              \
    const u16* cy = cy0 + (cur) * 8192;                                                              \
    const int pc0 = (g ^ sw) * 8, pc1 = ((4 + g) ^ sw) * 8;                                          \
    bf16x8 a0[4], b0[YT], a1[4], b1[YT];                                                             \
    _Pragma("unroll") for (int i = 0; i < 4; ++i) a0[i] = *(const bf16x8*)(cx + i * 16 * 64 + pc0);  \
    _Pragma("unroll") for (int i = 0; i < YT; ++i) b0[i] = *(const bf16x8*)(cy + i * 16 * 64 + pc0); \
    _Pragma("unroll") for (int i = 0; i < 4; ++i) a1[i] = *(const bf16x8*)(cx + i * 16 * 64 + pc1);  \
    _Pragma("unroll") for (int i = 0; i < YT; ++i) b1[i] = *(const bf16x8*)(cy + i * 16 * 64 + pc1); \
    __builtin_amdgcn_s_setprio(1);                                                                   \
    _Pragma("unroll") for (int xi = 0; xi < 4; ++xi)                                                 \
      _Pragma("unroll") for (int yi = 0; yi < YT; ++yi)                                              \
        acc[xi][yi] = __builtin_amdgcn_mfma_f32_16x16x32_bf16(a0[xi], b0[yi], acc[xi][yi], 0, 0, 0); \
    _Pragma("unroll") for (int xi = 0; xi < 4; ++xi)                                                 \
      _Pragma("unroll") for (int yi = 0; yi < YT; ++yi)                                              \
        acc[xi][yi] = __builtin_amdgcn_mfma_f32_16x16x32_bf16(a1[xi], b1[yi], acc[xi][yi], 0, 0, 0); \
    __builtin_amdgcn_s_setprio(0);                                                                   \
  }
#pragma unroll 1
  for (int kt = 0; kt < nk - 1; ++kt) {
    const int cur = kt & 1;
    GEMM_STAGE(cur ^ 1, kt + 1);
    GEMM_COMPUTE(cur);
    __syncthreads();
  }
  GEMM_COMPUTE((nk - 1) & 1);
  __syncthreads();
#undef GEMM_COMPUTE
#undef GEMM_STAGE
}

#ifndef REP_GEMM
#define REP_GEMM 0
#endif
#ifndef REP_MIX
#define REP_MIX 0
#endif
#ifndef REP_SYNC
#define REP_SYNC 0
#endif
#ifndef REP_P0
#define REP_P0 0
#endif
template <int YT>
__device__ __forceinline__ void gemm_main(const u16* __restrict__ X, int ldx, const u16* __restrict__ Y, int ldy, int K,
                                          u16* smem, f32x4 (&acc)[4][YT]) {
  gemm_main_t<true, YT>(X, ldx, Y, ldy, K, smem, acc);
#if REP_GEMM
  gemm_main_t<false, YT>(X, ldx, Y, ldy, K, smem, acc);
#pragma unroll
  for (int a = 0; a < 4; ++a)
#pragma unroll
    for (int b = 0; b < YT; ++b) acc[a][b] *= 0.5f;
#endif
}

__device__ __forceinline__ bool tile_map(int j, int ntx, int& tx, int& ty, int nty = 48) {
  const int nblk = gridDim.x, bid = blockIdx.x;
  if (nblk == 512) {
    const int per = nty >> 3, hp = per >> 1;
    const int rank = bid >> 3, q = (rank & 31) + j * 32, mem = rank >> 5;
    if (q >= hp * ntx) return false;
    tx = q / hp; ty = per * (bid & 7) + 2 * (q % hp) + mem;
    return true;
  } else {
    const int it = bid + j * nblk;
    if (it >= nty * ntx) return false;
    tx = it / nty; ty = it % nty;
    return true;
  }
}

__device__ void gin_tile(const Params& p, int l, int tx, int ty, u16* smem) {
  const int n0 = tx * 128, m0 = ty * 128;
  f32x4 acc[4][4];
  gemm_main<4>(p.w_inT + (size_t)l * 2304 * 1024 + (size_t)n0 * 1024, 1024, p.h + (size_t)m0 * 1024, 1024, 1024, smem, acc);
  const int lane = otid() & 63, wave = otid() >> 6, wx = wave & 1, wy = wave >> 1, r = lane & 15, g = lane >> 4;
  const int nw = n0 + wx * 64;
  const bool isS = m0 >= NPTOK;
  int ropeMode = 0;
  if (isS) {
    if (nw >= 768 && nw < 1280) ropeMode = 1;
    else if (nw >= 1792 && nw < 2176) ropeMode = 2;
  }
  float* okv = nullptr; int okv_w = 0, okv_c = 0;
  if (!isS) {
    if (nw >= 256 && nw < 512) { okv = p.out + O_NAK; okv_w = 256; okv_c = nw - 256; }
    else if (nw >= 512 && nw < 768) { okv = p.out + O_NAV; okv_w = 256; okv_c = nw - 512; }
    else if (nw >= 1024 && nw < 1280) { okv = p.out + O_DK; okv_w = 256; okv_c = nw - 1024; }
    else if (nw >= 1280 && nw < 1536) { okv = p.out + O_DV; okv_w = 256; okv_c = nw - 1280; }
    else if (nw >= 2048 && nw < 2176) { okv = p.out + O_SK; okv_w = 128; okv_c = nw - 2048; }
    else if (nw >= 2176) { okv = p.out + O_SV; okv_w = 128; okv_c = nw - 2176; }
  }
  int khh = -1;
  if (nw >= 256 && nw < 512) khh = (nw - 256) >> 6;
  else if (nw >= 1024 && nw < 1280) khh = 4 + ((nw - 1024) >> 6);
  else if (nw >= 2048 && nw < 2176) khh = 8 + ((nw - 2048) >> 6);
  int vrow = -1;
  if (nw >= 512 && nw < 768) vrow = nw - 512;
  else if (nw >= 1280 && nw < 1536) vrow = 256 + nw - 1280;
  else if (nw >= 2176) vrow = 512 + nw - 2176;
#pragma unroll
  for (int yi = 0; yi < 4; ++yi) {
    const int m = m0 + wy * 64 + yi * 16 + r;
    const int t = (m - NPTOK) & 1023;
    const int prow = t >> 6, pcol = t & 63;
#pragma unroll
    for (int xi = 0; xi < 4; ++xi) {
      f32x4 v = acc[xi][yi];
      if (ropeMode == 1) {
        const int pos = (xi & 1) ? pcol : prow;
        const float4 cs = *(const float4*)(p.ropeD + pos * 8 + 4 * (g & 1));
        const float4 sn = *(const float4*)(p.ropeD + 512 + pos * 8 + 4 * (g & 1));
        const float sg = (g >= 2) ? 1.f : -1.f;
        const float o0 = __shfl_xor(v[0], 32), o1 = __shfl_xor(v[1], 32), o2 = __shfl_xor(v[2], 32), o3 = __shfl_xor(v[3], 32);
        v[0] = v[0] * cs.x + sg * o0 * sn.x; v[1] = v[1] * cs.y + sg * o1 * sn.y;
        v[2] = v[2] * cs.z + sg * o2 * sn.z; v[3] = v[3] * cs.w + sg * o3 * sn.w;
      } else if (ropeMode == 2) {
        const int pos = (xi >> 1) ? pcol : prow;
        const float4 cs = *(const float4*)(p.ropeS + pos * 16 + 4 * g);
        const float4 sn = *(const float4*)(p.ropeS + 1024 + pos * 16 + 4 * g);
        const f32x4 o = acc[xi ^ 1][yi];
        const float sg = (xi & 1) ? 1.f : -1.f;
        v[0] = v[0] * cs.x + sg * o[0] * sn.x; v[1] = v[1] * cs.y + sg * o[1] * sn.y;
        v[2] = v[2] * cs.z + sg * o[2] * sn.z; v[3] = v[3] * cs.w + sg * o[3] * sn.w;
      }
      const int nloc = xi * 16 + 4 * g;
      if (okv) {
        const int b = m >> 8, pos = m & 255;
        float4 o4; o4.x = v[0]; o4.y = v[1]; o4.z = v[2]; o4.w = v[3];
        __builtin_nontemporal_store(v, (f32x4*)(okv + ((size_t)((b * 4 + l) * 256 + pos)) * okv_w + okv_c + nloc));
      }
      if (vrow >= 0) {
        u16* vb = p.vfr + ((size_t)((vrow >> 6) * 192 + (m >> 5))) * 2048;
        const unsigned w01 = pack2(v[0], v[1]), w23 = pack2(v[2], v[3]);
        vb[vfrag_off(m & 31, nloc + 0)] = (u16)(w01 & 0xffffu); vb[vfrag_off(m & 31, nloc + 1)] = (u16)(w01 >> 16);
        vb[vfrag_off(m & 31, nloc + 2)] = (u16)(w23 & 0xffffu); vb[vfrag_off(m & 31, nloc + 3)] = (u16)(w23 >> 16);
      } else if (khh >= 0) {
        uint2 w; w.x = pack2(v[0], v[1]); w.y = pack2(v[2], v[3]);
        *(uint2*)(p.kfr + ((size_t)(khh * 192 + (m >> 5))) * 2048 + kfrag_off(m & 31, nloc)) = w;
      } else {
        uint2 w; w.x = pack2(v[0], v[1]); w.y = pack2(v[2], v[3]);
        *(uint2*)(p.z + (size_t)m * INW + nw + nloc) = w;
      }
    }
  }
}

__device__ void res_tile(const Params& p, int l, int tx, int ty, const u16* A, const u16* WT, int K, int gi, u16* smem, bool first = false) {
  const int n0 = tx * 128, m0 = ty * 96;
  f32x4 acc[4][3];
  gemm_main<3>(WT + (size_t)n0 * K, K, A + (size_t)m0 * K, K, K, smem, acc);
  const int lane = otid() & 63, wave = otid() >> 6, wx = wave & 1, wy = wave >> 1, r = lane & 15, g = lane >> 4;
#pragma unroll
  for (int yi = 0; yi < 3; ++yi) {
    const int m = m0 + wy * 48 + yi * 16 + r;
    const int cond = m < NPTOK ? 0 : 1 + ((m - NPTOK) >> 10);
    const float* gate = p.mods + (size_t)(l * 3 + cond) * 6144 + gi * 1024;
    float* xrow = p.xres + (size_t)m * 1024;
    const float* xin = first ? (m < NPTOK ? p.x_prompt + (size_t)m * 1024 : p.x_sample + (size_t)(m - NPTOK) * 1024) : xrow;
    float4 xv[4], gt[4];
#pragma unroll
    for (int xi = 0; xi < 4; ++xi) {
      const int n = n0 + wx * 64 + xi * 16 + 4 * g;
      xv[xi] = *(const float4*)(xin + n);
      gt[xi] = *(const float4*)(gate + n);
    }
#pragma unroll
    for (int xi = 0; xi < 4; ++xi) {
      const int n = n0 + wx * 64 + xi * 16 + 4 * g;
      const f32x4 v = acc[xi][yi];
      float4 o = xv[xi];
      o.x += gt[xi].x * v[0]; o.y += gt[xi].y * v[1]; o.z += gt[xi].z * v[2]; o.w += gt[xi].w * v[3];
      *(float4*)(xrow + n) = o;
    }
  }
}

__device__ void m1_tile(const Params& p, int l, int tx, int ty, u16* smem) {
  const int n0 = tx * 128, m0 = ty * 128;
  f32x4 acc[4][4];
  gemm_main<4>(p.w1T + (size_t)l * 4096 * 1024 + (size_t)n0 * 1024, 1024, p.h + (size_t)m0 * 1024, 1024, 1024, smem, acc);
  const int lane = otid() & 63, wave = otid() >> 6, wx = wave & 1, wy = wave >> 1, r = lane & 15, g = lane >> 4;
#pragma unroll
  for (int xi = 0; xi < 4; ++xi) {
    const int n = n0 + wx * 64 + xi * 16 + 4 * g;
#pragma unroll
    for (int yi = 0; yi < 4; ++yi) {
      const int m = m0 + wy * 64 + yi * 16 + r;
      const f32x4 v = acc[xi][yi];
      float a0 = fmaxf(v[0], 0.f), a1 = fmaxf(v[1], 0.f), a2 = fmaxf(v[2], 0.f), a3 = fmaxf(v[3], 0.f);
      uint2 w; w.x = pack2(a0 * a0, a1 * a1); w.y = pack2(a2 * a2, a3 * a3);
      *(uint2*)(p.u + (size_t)m * 4096 + n) = w;
    }
  }
}

__device__ void f1_tile(const Params& p, int l, int it, u16* smem) {
  const int tx = it % 48, ty = it / 48;
  const int x0 = tx * 128, y0 = ty * 128;
  f32x4 acc[4][4];
  gemm_main<4>(p.z + (size_t)x0 * INW + 1536, INW, p.pqt + (size_t)l * 512 * 256 + (size_t)y0 * 256, 256, 256, smem, acc);
  const int lane = otid() & 63, wave = otid() >> 6, wx = wave & 1, wy = wave >> 1, r = lane & 15, g = lane >> 4;
#pragma unroll
  for (int yi = 0; yi < 4; ++yi) {
    const int y = y0 + wy * 64 + yi * 16 + r;
    const int col = y & 255, which = y >> 8;
#pragma unroll
    for (int xi = 0; xi < 4; ++xi) {
      const int tok = x0 + wx * 64 + xi * 16 + 4 * g;
      size_t addr;
      if (tok < NPTOK) {
        const int b = tok >> 8, pos = tok & 255;
        addr = (size_t)b * (256 * 512) + (size_t)col * 512 + which * 256 + pos;
      } else {
        const int b = (tok - NPTOK) >> 10, pos = (tok - NPTOK) & 1023;
        addr = (size_t)16 * 256 * 512 + (size_t)b * (256 * 2048) + (size_t)col * 2048 + which * 1024 + pos;
      }
      const f32x4 v = acc[xi][yi];
      uint2 w; w.x = pack2(v[0], v[1]); w.y = pack2(v[2], v[3]);
      *(uint2*)(p.uv + addr) = w;
    }
  }
  asm volatile("s_waitcnt vmcnt(0)" ::: "memory");
  __syncthreads();
  if (threadIdx.x == 0) {
    __builtin_amdgcn_fence(__ATOMIC_RELEASE, "agent");
    asm volatile("s_waitcnt vmcnt(0)" ::: "memory");
    xb_add(p.bar + XCD_BAR_WORDS + (8 + l) * 64, 1u);
  }
}

__device__ void f2_tile(const Params& p, int l, int it, u16* smem) {
  if (threadIdx.x == 0) {
    unsigned* c = p.bar + XCD_BAR_WORDS + (8 + l) * 64;
    unsigned sp = 0;
    while (xb_ld(c) < 192u) { __builtin_amdgcn_s_sleep(2); if (++sp > (1u << 24)) break; }
    __builtin_amdgcn_fence(__ATOMIC_ACQUIRE, "agent");
    asm volatile("s_waitcnt vmcnt(0)" ::: "memory");
  }
  __syncthreads();
  int L, b, tx, ty, tokbase;
  const u16* uvb; const u16* dft;
  if (it < 32) { L = 1024; b = it >> 4; tx = (it >> 3) & 1; ty = it & 7; uvb = p.uv + (size_t)16 * 256 * 512 + (size_t)b * (256 * 2048); dft = p.dft1024; tokbase = NPTOK + b * 1024; }
  else { it -= 32; L = 256; b = it >> 2; tx = (it >> 1) & 1; ty = it & 1; uvb = p.uv + (size_t)b * (256 * 512); dft = p.dft256; tokbase = b * 256; }
  const int x0 = tx * 128, y0 = ty * 128, K = 2 * L;
  f32x4 acc[4][4];
  gemm_main<4>(uvb + (size_t)x0 * K, K, dft + (size_t)y0 * K, K, K, smem, acc);
  const int lane = otid() & 63, wave = otid() >> 6, wx = wave & 1, wy = wave >> 1, r = lane & 15, g = lane >> 4;
  const float scale = rsqrtf(64.f * (float)L);
#pragma unroll
  for (int yi = 0; yi < 4; ++yi) {
    const int pos = y0 + wy * 64 + yi * 16 + r;
#pragma unroll
    for (int xi = 0; xi < 4; ++xi) {
      const int col = x0 + wx * 64 + xi * 16 + 4 * g;
      const f32x4 v = acc[xi][yi];
      uint2 w; w.x = pack2(v[0] * scale, v[1] * scale); w.y = pack2(v[2] * scale, v[3] * scale);
      *(uint2*)(p.cat + (size_t)(tokbase + pos) * 1024 + 512 + col) = w;
    }
  }
}

struct Seg { const u16* K; const u16* Vt; int ldk, ldv, nblk, pos0, stride; };
#define KLOC(hh, tokb) (p.kfr + ((size_t)((hh) * 192 + ((tokb) >> 5))) * 2048)
#define VLOC(hh, tokb) (p.vfr + ((size_t)((hh) * 192 + ((tokb) >> 5))) * 2048)
template <int QT> struct AState { float m[QT]; float ls[QT]; f32x4 o[QT][4]; };

__device__ __forceinline__ bf16x8 as_bf(u32x4 v) { union { u32x4 u; bf16x8 b; } x; x.u = v; return x.b; }

template <int DC>
__device__ __forceinline__ void issue_blk(const Seg& s0, const Seg& s1, int b, int r, int g, u32x4 (&kf)[2][DC], u32x4 (&vf)[4]) {
  const bool in0 = b < s0.nblk;
  const u16* Kp = in0 ? s0.K : s1.K;
  const u16* Vp = in0 ? s0.Vt : s1.Vt;
  const int pos = in0 ? (s0.pos0 + b * s0.stride) : (s1.pos0 + (b - s0.nblk) * s1.stride);
  const int lane8 = (g * 16 + r) * 8;
  const u16* kp = Kp + (size_t)(pos >> 5) * 2048 + lane8;
  const u16* vp = Vp + (size_t)(pos >> 5) * 2048 + lane8;
#pragma unroll
  for (int t = 0; t < 2; ++t)
#pragma unroll
    for (int dc = 0; dc < DC; ++dc) gload16(kf[t][dc], kp + (t * 2 + dc) * 512);
#pragma unroll
  for (int dv = 0; dv < 4; ++dv) gload16(vf[dv], vp + dv * 512);
}
template <int N>
__device__ __forceinline__ void wait_blk(u32x4 (&kf)[2][1], u32x4 (&vf)[4]) {
  asm volatile("s_waitcnt vmcnt(%6)" : "+v"(kf[0][0]), "+v"(kf[1][0]), "+v"(vf[0]), "+v"(vf[1]), "+v"(vf[2]), "+v"(vf[3]) : "n"(N) : "memory");
}
template <int N>
__device__ __forceinline__ void wait_blk(u32x4 (&kf)[2][2], u32x4 (&vf)[4]) {
  asm volatile("s_waitcnt vmcnt(%8)" : "+v"(kf[0][0]), "+v"(kf[0][1]), "+v"(kf[1][0]), "+v"(kf[1][1]), "+v"(vf[0]), "+v"(vf[1]), "+v"(vf[2]), "+v"(vf[3]) : "n"(N) : "memory");
}

template <int D, int QT, int MODE>
__device__ __forceinline__ void attn_compute(const u32x4 (&kc)[2][D / 32], const u32x4 (&vc)[4], const bf16x8 (&qf)[QT][D / 32], const float sc,
                                             AState<QT>& st, const bool in0, const int pos, const int qpos0, const float* __restrict__ rpb_h,
                                             const int r, const int g) {
  constexpr int DC = D / 32;
#pragma unroll
  for (int q = 0; q < QT; ++q) {
    if (MODE == 1 && !in0) {
      const int cq0 = (qpos0 + q * 16) & 63, cb = pos & 63;
      const int lo = min(max(cq0 - 8, 0), 48), hi = min(max(cq0 + 7, 0), 48) + 16;
      if (hi <= cb || lo >= cb + 32) continue;
    }
    if (MODE == 2 && !in0) {
      const int qp = qpos0 + q * 16;
      if (pos > qp + 15 + 128 || pos + 31 < qp - 128) continue;
    }
    f32x4 s_[2];
    s_[0] = (f32x4){0.f, 0.f, 0.f, 0.f};
    s_[1] = (f32x4){0.f, 0.f, 0.f, 0.f};
#pragma unroll
    for (int t = 0; t < 2; ++t)
#pragma unroll
      for (int dc = 0; dc < DC; ++dc) s_[t] = __builtin_amdgcn_mfma_f32_16x16x32_bf16(as_bf(kc[t][dc]), qf[q][dc], s_[t], 0, 0, 0);
    float sv[8];
#pragma unroll
    for (int t = 0; t < 2; ++t)
#pragma unroll
      for (int i = 0; i < 4; ++i) {
        float x = s_[t][i] * sc;
        if (MODE == 1) {
          if (!in0) {
            const int qpos = qpos0 + q * 16 + r;
            const int qrow = qpos >> 6, cq = qpos & 63;
            const int kpos = pos + 8 * g + 4 * t + i;
            const int krow = kpos >> 6, ck = kpos & 63;
            const int cs = min(max(cq - 8, 0), 48);
            const bool valid = (ck >= cs) && (ck < cs + 16);
            const int bi = (krow - qrow + 7) * 31 + (ck - cq + 15);
            const float bias = rpb_h[valid ? bi : 0];
            x = valid ? (x + bias) : -1e30f;
          }
        } else if (MODE == 2) {
          if (!in0) {
            const int qpos = qpos0 + q * 16 + r;
            const int kpos = pos + 8 * g + 4 * t + i;
            const int d = qpos - kpos;
            x = (d <= 128 && d >= -128) ? x : -1e30f;
          }
        }
        sv[4 * t + i] = x;
      }
    float mx = fmaxf(fmaxf(fmaxf(sv[0], sv[1]), fmaxf(sv[2], sv[3])), fmaxf(fmaxf(sv[4], sv[5]), fmaxf(sv[6], sv[7])));
    mx = fmaxf(mx, __shfl_xor(mx, 16));
    mx = fmaxf(mx, __shfl_xor(mx, 32));
    const float mnew = fmaxf(st.m[q], mx);
    const float alpha = __builtin_amdgcn_exp2f(st.m[q] - mnew);
    st.m[q] = mnew;
    float ps = 0.f;
#pragma unroll
    for (int j = 0; j < 8; ++j) { sv[j] = __builtin_amdgcn_exp2f(sv[j] - mnew); ps += sv[j]; }
    st.ls[q] = st.ls[q] * alpha + ps;
    union { bf16x8 v; unsigned w[4]; } pf;
    pf.w[0] = pack2(sv[0], sv[1]); pf.w[1] = pack2(sv[2], sv[3]); pf.w[2] = pack2(sv[4], sv[5]); pf.w[3] = pack2(sv[6], sv[7]);
#pragma unroll
    for (int dv = 0; dv < 4; ++dv) {
      f32x4 o = st.o[q][dv];
      o[0] *= alpha; o[1] *= alpha; o[2] *= alpha; o[3] *= alpha;
      st.o[q][dv] = __builtin_amdgcn_mfma_f32_16x16x32_bf16(as_bf(vc[dv]), pf.v, o, 0, 0, 0);
    }
  }
}

template <int D, int QT, int MODE, int NQ = 2>
__device__ __forceinline__ void attn_run(const Seg& s0, const Seg& s1, const bf16x8 (&qf)[QT][D / 32], const float sc,
                                         AState<QT>& st, const int qpos0, const float* __restrict__ rpb_h, const int bb = 0, const int be = -1, const int lo2 = -1) {
  constexpr int DC = D / 32;
  constexpr int NL = 2 * DC + 4;
  const int lane = otid() & 63, r = lane & 15, g = lane >> 4;
  const int nb = be < 0 ? s0.nblk + s1.nblk : be;
  u32x4 kq[NQ][2][DC], vq[NQ][4];
#pragma unroll
  for (int q = 0; q < QT; ++q)
#pragma unroll
    for (int dc = 0; dc < DC; ++dc) asm volatile("" ::"v"(qf[q][dc]));
  asm volatile("s_waitcnt vmcnt(0)" ::: "memory");
#pragma unroll 1
  for (int b = bb; b < nb; b += NQ) {
#pragma unroll
    for (int j = 0; j < NQ; ++j) issue_blk<DC>(s0, s1, (lo2 >= 0 && b + j >= bb + 4) ? lo2 + (b + j - bb - 4) : b + j, r, g, kq[j], vq[j]);
#pragma unroll
    for (int j = 0; j < NQ; ++j) {
      if (j == 0) wait_blk<(NQ - 1) * NL>(kq[j], vq[j]);
      else if (j == 1) wait_blk<(NQ - 2) * NL>(kq[j], vq[j]);
      else if (j == 2) wait_blk<(NQ > 3 ? (NQ - 3) * NL : 0)>(kq[j], vq[j]);
      else wait_blk<0>(kq[j], vq[j]);
      const int bj = (lo2 >= 0 && b + j >= bb + 4) ? lo2 + (b + j - bb - 4) : b + j;
      const bool in0 = bj < s0.nblk;
      const int pos = in0 ? (s0.pos0 + bj * s0.stride) : (s1.pos0 + (bj - s0.nblk) * s1.stride);
      attn_compute<D, QT, MODE>(kq[j], vq[j], qf, sc, st, in0, pos, qpos0, rpb_h, r, g);
    }
  }
}

template <int QT>
__device__ __forceinline__ void astate_init(AState<QT>& st, float m0, float l0) {
#pragma unroll
  for (int q = 0; q < QT; ++q) {
    st.m[q] = m0; st.ls[q] = l0;
#pragma unroll
    for (int dv = 0; dv < 4; ++dv) st.o[q][dv] = (f32x4){0.f, 0.f, 0.f, 0.f};
  }
}
template <int QT>
__device__ __forceinline__ void astate_finalize(AState<QT>& st) {
#pragma unroll
  for (int q = 0; q < QT; ++q) {
    float l = st.ls[q];
    l += __shfl_xor(l, 16);
    l += __shfl_xor(l, 32);
    const float inv = 1.f / l;
#pragma unroll
    for (int dv = 0; dv < 4; ++dv) { st.o[q][dv][0] *= inv; st.o[q][dv][1] *= inv; st.o[q][dv][2] *= inv; st.o[q][dv][3] *= inv; }
  }
}
template <int DC, int QT>
__device__ __forceinline__ void load_q(const u16* zq  , bf16x8 (&qf)[QT][DC]) {
  const int lane = otid() & 63, r = lane & 15, g = lane >> 4;
#pragma unroll
  for (int q = 0; q < QT; ++q)
#pragma unroll
    for (int dc = 0; dc < DC; ++dc) qf[q][dc] = *(const bf16x8*)(zq + (size_t)(q * 16 + r) * INW + dc * 32 + g * 8);
}
template <int QT>
__device__ __forceinline__ void write_o(const Params& p, const AState<QT>& st, int tok0, int col0) {
  const int lane = otid() & 63, r = lane & 15, g = lane >> 4;
#pragma unroll
  for (int q = 0; q < QT; ++q)
#pragma unroll
    for (int dv = 0; dv < 4; ++dv) {
      const f32x4 v = st.o[q][dv];
      uint2 w; w.x = pack2(v[0], v[1]); w.y = pack2(v[2], v[3]);
      *(uint2*)(p.cat + (size_t)(tok0 + q * 16 + r) * 1024 + col0 + dv * 16 + 4 * g) = w;
    }
}

__device__ __forceinline__ float diff_lambda(const Params& p, int l, float lam_init) {
  const int lane = otid() & 63;
  float a = 0.f, b = 0.f;
  if (lane < 32) { a = p.lq1[l * 32 + lane] * p.lk1[l * 32 + lane]; b = p.lq2[l * 32 + lane] * p.lk2[l * 32 + lane]; }
#pragma unroll
  for (int o = 32; o >= 1; o >>= 1) { a += __shfl_xor(a, o); b += __shfl_xor(b, o); }
  return expf(a) - expf(b) + lam_init;
}

__device__ __forceinline__ void diff_finish_q(const Params& p, int l, float lam, float lam_init, f32x4 (&A)[4], const f32x4 (&B)[4], int tokrow0, int col0) {
  const int lane = otid() & 63, r = lane & 15, g = lane >> 4;
  const float* sg = p.subln_g + l * 64;
  float ss = 0.f;
#pragma unroll
  for (int dv = 0; dv < 4; ++dv)
#pragma unroll
    for (int i = 0; i < 4; ++i) {
      const float v = A[dv][i] - lam * B[dv][i];
      A[dv][i] = v;
      ss += v * v;
    }
  ss += __shfl_xor(ss, 16);
  ss += __shfl_xor(ss, 32);
  const float rs = rsqrtf(ss * (1.f / 64.f) + 1e-6f) * (1.f - lam_init);
#pragma unroll
  for (int dv = 0; dv < 4; ++dv) {
    const float4 gg = *(const float4*)(sg + dv * 16 + 4 * g);
    uint2 w;
    w.x = pack2(A[dv][0] * rs * gg.x, A[dv][1] * rs * gg.y);
    w.y = pack2(A[dv][2] * rs * gg.z, A[dv][3] * rs * gg.w);
    *(uint2*)(p.cat + (size_t)(tokrow0 + r) * 1024 + col0 + dv * 16 + 4 * g) = w;
  }
}

#ifndef AQT
#define AQT 2
#endif
#define QW (16 * AQT)
#define NQG_CTX (256 / QW)
#define NQG_LAT (1024 / QW)
__device__ void attn_diff_item(const Params& p, int l, bool lat, int bi, float* sm) {
  const int wave = otid() >> 6, lane = otid() & 63, r = lane & 15, g = lane >> 4;
  const int ps = wave >> 1, half = wave & 1;
  int b, h, qg, tokb;
  if (lat) { b = bi / (4 * NQG_LAT); h = (bi / NQG_LAT) & 3; qg = bi % NQG_LAT; tokb = NPTOK + b * 1024; }
  else { b = bi / (4 * NQG_CTX); h = (bi / NQG_CTX) & 3; qg = bi % NQG_CTX; tokb = b * 256; }
  const int tok0 = tokb + qg * QW;
  const u16* zb = p.z + (size_t)tokb * INW;
  Seg s0, s1;
  if (lat) {
    const int bl = b * 4 + l;
    s0.K = p.ck_diff + (size_t)((bl * 4 + h) * 16) * 2048 + ps * 512; s0.Vt = p.cvt_diff + (size_t)((bl * 4 + h) * 16) * 2048;
    s0.ldk = 0; s0.ldv = 0; s0.nblk = half ? 0 : 16; s0.pos0 = 0; s0.stride = 32;
    s1.K = KLOC(4 + h, tokb) + ps * 512; s1.Vt = VLOC(4 + h, tokb);
    s1.ldk = 0; s1.ldv = 0; s1.nblk = half ? 24 : 8; s1.pos0 = half ? 256 : 0; s1.stride = 32;
  } else {
    s0.K = KLOC(4 + h, tokb) + ps * 512; s0.Vt = VLOC(4 + h, tokb);
    s0.ldk = 0; s0.ldv = 0; s0.nblk = 4; s0.pos0 = half ? 128 : 0; s0.stride = 32;
    s1 = s0; s1.nblk = 0;
  }
  bf16x8 qf[AQT][1];
  load_q<1, AQT>(p.z + (size_t)tok0 * INW + 768 + h * 64 + ps * 32, qf);
  AState<AQT> st;
  astate_init<AQT>(st, -1e30f, 0.f);
  attn_run<32, AQT, 0, 2>(s0, s1, qf, 0.17677669529663687f * LOG2E, st, 0, nullptr);
  float lt[AQT];
#pragma unroll
  for (int q = 0; q < AQT; ++q) {
    lt[q] = st.ls[q];
    lt[q] += __shfl_xor(lt[q], 16);
    lt[q] += __shfl_xor(lt[q], 32);
  }
  constexpr int WS = 64 * 16 * AQT;
  float* pm = sm + 4 * WS;
  if (wave != 0) {
    float* po = sm + wave * WS + lane * (16 * AQT);
#pragma unroll
    for (int q = 0; q < AQT; ++q) {
#pragma unroll
      for (int dv = 0; dv < 4; ++dv) *(f32x4*)(po + q * 16 + dv * 4) = st.o[q][dv];
      if (g == 0) { pm[wave * QW + q * 16 + r] = st.m[q]; pm[4 * QW + wave * QW + q * 16 + r] = lt[q]; }
    }
  }
  __syncthreads();
  if (wave == 0) {
    const float lam_init = 0.8f - 0.6f * expf(-0.3f * (float)l);
    const float lam = diff_lambda(p, l, lam_init);
#pragma unroll
    for (int q = 0; q < AQT; ++q) {
      f32x4 A[4], B[4];
      {
        const float m1 = pm[QW + q * 16 + r], l1 = pm[4 * QW + QW + q * 16 + r];
        const float M = fmaxf(st.m[q], m1);
        const float a0 = exp2f(st.m[q] - M), a1 = exp2f(m1 - M);
        const float inv = 1.f / (lt[q] * a0 + l1 * a1);
#pragma unroll
        for (int dv = 0; dv < 4; ++dv) {
          const f32x4 o1 = *(const f32x4*)(sm + 1 * WS + lane * (16 * AQT) + q * 16 + dv * 4);
          A[dv] = (st.o[q][dv] * a0 + o1 * a1) * inv;
        }
      }
      {
        const float m2 = pm[2 * QW + q * 16 + r], l2 = pm[4 * QW + 2 * QW + q * 16 + r], m3 = pm[3 * QW + q * 16 + r], l3 = pm[4 * QW + 3 * QW + q * 16 + r];
        const float M = fmaxf(m2, m3);
        const float a2 = exp2f(m2 - M), a3 = exp2f(m3 - M);
        const float inv = 1.f / (l2 * a2 + l3 * a3);
#pragma unroll
        for (int dv = 0; dv < 4; ++dv) {
          const f32x4 o2 = *(const f32x4*)(sm + 2 * WS + lane * (16 * AQT) + q * 16 + dv * 4);
          const f32x4 o3 = *(const f32x4*)(sm + 3 * WS + lane * (16 * AQT) + q * 16 + dv * 4);
          B[dv] = (o2 * a2 + o3 * a3) * inv;
        }
      }
      diff_finish_q(p, l, lam, lam_init, A, B, tok0 + q * 16, 256 + h * 64);
    }
  }
  __syncthreads();
}

__device__ void attn_ctx_item(const Params& p, int l, int bi) {
  const int wave = otid() >> 6, lane = otid() & 63, g = lane >> 4;
  const int w = bi * 4 + wave;
  const int type = w / (64 * NQG_CTX), rem = w % (64 * NQG_CTX);
  const int b = rem / (4 * NQG_CTX), h = (rem / NQG_CTX) & 3, qg = rem % NQG_CTX;
  const int tokb = b * 256, tok0 = tokb + qg * QW;
  const u16* zb = p.z + (size_t)tokb * INW;
  const int kvh = h >> 1;
  const int qcol = type == 0 ? h * 64 : 1792 + h * 64;
  const int kcol = type == 0 ? 256 + h * 64 : 2048 + kvh * 64;
  const int vrow = type == 0 ? h * 64 : 512 + kvh * 64;
  const int ocol = type == 0 ? h * 64 : 768 + h * 64;
  bf16x8 qf[AQT][2];
  load_q<2, AQT>(p.z + (size_t)tok0 * INW + qcol, qf);
  const int hslot = type == 0 ? h : 8 + kvh;
  Seg s0; s0.K = KLOC(hslot, tokb); s0.Vt = VLOC(hslot, tokb); s0.ldk = 0; s0.ldv = 0; s0.nblk = 8; s0.pos0 = 0; s0.stride = 32;
  Seg sN = s0; sN.nblk = 0;
  AState<AQT> st;
  const float sk = type == 0 ? -1e30f : p.swa_sink[l * 4 + h] * LOG2E;
  astate_init<AQT>(st, sk, (type == 1 && g == 0) ? 1.f : 0.f);
  attn_run<64, AQT, 0, 2>(s0, sN, qf, 0.125f * LOG2E, st, 0, nullptr);
  astate_finalize<AQT>(st);
  write_o<AQT>(p, st, tok0, ocol);
}

__device__ void attn_lat_item(const Params& p, int l, int bi, float* sm) {
  const int wave = otid() >> 6, lane = otid() & 63, r = lane & 15, g = lane >> 4;
  const int type = bi / (8 * NQG_LAT), rem = bi % (8 * NQG_LAT);
  const int b = rem / (4 * NQG_LAT), h = (rem / NQG_LAT) & 3, qg = rem % NQG_LAT;
  const int q0 = qg * QW;
  const int tokb = NPTOK + b * 1024, tok0 = tokb + q0;
  const u16* zb = p.z + (size_t)tokb * INW;
  const int bl = b * 4 + l;
  AState<AQT> st;
  int ocol;
  if (type != 0) {
    const float* rp = p.na_rpb + (size_t)(l * 4 + h) * 15 * 31;
    for (int e = otid(); e < 465; e += 256) sm[9000 + e] = rp[e] * LOG2E;
    __syncthreads();
  }
  if (type == 0) {
    const int kvh = h >> 1;
    bf16x8 qf[AQT][2];
    load_q<2, AQT>(p.z + (size_t)tok0 * INW + 1792 + h * 64, qf);
    Seg s0; s0.K = p.ck_swa + (size_t)((bl * 2 + kvh) * 16) * 2048; s0.Vt = p.cvt_swa + (size_t)((bl * 2 + kvh) * 16) * 2048; s0.ldk = 0; s0.ldv = 0; s0.nblk = 16; s0.pos0 = 0; s0.stride = 32;
    const int lo = max(0, q0 - 128) & ~31;
    const int hi = min(1024, ((q0 + QW + 128) + 31) & ~31);
    int lo2 = lo, cnt = (hi - lo) >> 5;
    if (cnt & 1) { if (lo2 > 0) lo2 -= 32; ++cnt; }
    Seg s1; s1.K = KLOC(8 + kvh, tokb); s1.Vt = VLOC(8 + kvh, tokb); s1.ldk = 0; s1.ldv = 0; s1.nblk = cnt; s1.pos0 = lo2; s1.stride = 32;
    const int P = (16 + cnt) >> 1;
    const int pb = (wave * P) >> 2, pe = ((wave + 1) * P) >> 2;
    astate_init<AQT>(st, wave == 0 ? p.swa_sink[l * 4 + h] * LOG2E : -1e30f, (wave == 0 && g == 0) ? 1.f : 0.f);
    attn_run<64, AQT, 2>(s0, s1, qf, 0.125f * LOG2E, st, q0, nullptr, 2 * pb, 2 * pe);
    ocol = 768 + h * 64;
  } else {
    bf16x8 qf[AQT][2];
    load_q<2, AQT>(p.z + (size_t)tok0 * INW + h * 64, qf);
    Seg s0; s0.K = p.ck_na + (size_t)((bl * 4 + h) * 16) * 2048; s0.Vt = p.cvt_na + (size_t)((bl * 4 + h) * 16) * 2048; s0.ldk = 0; s0.ldv = 0; s0.nblk = 16; s0.pos0 = 0; s0.stride = 32;
    const int qrow = q0 >> 6;
    const int rstart = min(max(qrow - 4, 0), 8);
    Seg s1; s1.K = KLOC(h, tokb); s1.Vt = VLOC(h, tokb); s1.ldk = 0; s1.ldv = 0; s1.nblk = 16; s1.pos0 = rstart * 64; s1.stride = 32;
    astate_init<AQT>(st, -1e30f, 0.f);
    attn_run<64, AQT, 1, 2>(s0, s1, qf, 0.125f * LOG2E, st, q0, sm + 9000, 4 * wave, 4 * wave + 8, 16 + 4 * wave);
    ocol = h * 64;
  }
  float lt[AQT];
#pragma unroll
  for (int q = 0; q < AQT; ++q) {
    lt[q] = st.ls[q];
    lt[q] += __shfl_xor(lt[q], 16);
    lt[q] += __shfl_xor(lt[q], 32);
  }
  constexpr int WS = 64 * 16 * AQT;
  float* pm = sm + 4 * WS;
  if (wave != 0) {
    float* po = sm + wave * WS + lane * (16 * AQT);
#pragma unroll
    for (int q = 0; q < AQT; ++q) {
#pragma unroll
      for (int dv = 0; dv < 4; ++dv) *(f32x4*)(po + q * 16 + dv * 4) = st.o[q][dv];
      if (g == 0) { pm[wave * QW + q * 16 + r] = st.m[q]; pm[4 * QW + wave * QW + q * 16 + r] = lt[q]; }
    }
  }
  __syncthreads();
  if (wave == 0) {
#pragma unroll
    for (int q = 0; q < AQT; ++q) {
      const float m1 = pm[1 * QW + q * 16 + r], m2 = pm[2 * QW + q * 16 + r], m3 = pm[3 * QW + q * 16 + r];
      const float l1 = pm[4 * QW + 1 * QW + q * 16 + r], l2 = pm[4 * QW + 2 * QW + q * 16 + r], l3 = pm[4 * QW + 3 * QW + q * 16 + r];
      const float M = fmaxf(fmaxf(st.m[q], m1), fmaxf(m2, m3));
      const float a0 = __builtin_amdgcn_exp2f(st.m[q] - M), a1 = __builtin_amdgcn_exp2f(m1 - M), a2 = __builtin_amdgcn_exp2f(m2 - M), a3 = __builtin_amdgcn_exp2f(m3 - M);
      const float inv = 1.f / (lt[q] * a0 + l1 * a1 + l2 * a2 + l3 * a3);
#pragma unroll
      for (int dv = 0; dv < 4; ++dv) {
        const f32x4 o1 = *(const f32x4*)(sm + 1 * WS + lane * (16 * AQT) + q * 16 + dv * 4);
        const f32x4 o2 = *(const f32x4*)(sm + 2 * WS + lane * (16 * AQT) + q * 16 + dv * 4);
        const f32x4 o3 = *(const f32x4*)(sm + 3 * WS + lane * (16 * AQT) + q * 16 + dv * 4);
        st.o[q][dv] = (st.o[q][dv] * a0 + o1 * a1 + o2 * a2 + o3 * a3) * inv;
      }
    }
    write_o<AQT>(p, st, tok0, ocol);
  }
  __syncthreads();
}

__device__ __forceinline__ int q_next(unsigned* cnt, volatile LAS unsigned* slot) {
  __syncthreads();
  if (threadIdx.x == 0) *slot = xb_add(cnt, 1u);
  __syncthreads();
  return (int)*slot;
}

#if REP_SYNC
#define GSYNC() do { xcd_barrier(xb); xcd_barrier(xb); } while (0)
#else
#define GSYNC() xcd_barrier(xb)
#endif
__global__ void __launch_bounds__(256, 2) mega(Params p) {
  extern __shared__ __attribute__((aligned(16))) unsigned char smem[];
  cg::grid_group grid = cg::this_grid();
  const int nblk = gridDim.x, bid = blockIdx.x;
  u16* sm16 = (u16*)smem;
  __shared__ uint4 xb_words[2];
  if (threadIdx.x == 0) { xb_words[0] = make_uint4(0u, 0u, 0u, 0u); xb_words[1] = make_uint4(0u, 0u, 0u, 0u); }
  __syncthreads();
  XcdBarrier xb = xcd_barrier_post(p.bar, (volatile LAS unsigned*)&xb_words[0]);

  for (int rep = 0; rep <= REP_P0; ++rep)
    for (int it = bid; it < P0_ITEMS; it += nblk) p0_item(p, it, smem);
  if (p.use_cg_sync) grid.sync();
  GSYNC();

  const int xcc = (int)xb.x;
  const int xrank = __builtin_amdgcn_readfirstlane((int)xb.st[4]), xnloc = __builtin_amdgcn_readfirstlane((int)xb.st[0]);
  const unsigned topo = (unsigned)__builtin_amdgcn_readfirstlane((int)xb.st[5]);
  const bool local = (topo & 1u) != 0u, full64 = (topo & 2u) != 0u;
#define LSYNC() do { if (local) xcd_barrier_local(xb); else GSYNC(); } while (0)
#define LMAP(j, count, total) (local ? ((xrank + (j) * xnloc) < (count) ? (xrank + (j) * xnloc) : -1) : ((bid + (j) * nblk) < (total) ? (bid + (j) * nblk) : -1))

#pragma unroll 1
  for (int l = 0; l < 4; ++l) {
    for (int j = 0;; ++j) { const int v = LMAP(j, 48, 384); if (v < 0) break; norm_item(p, l, 0, local ? 48 * xcc + v : v); }
    LSYNC();
    for (int j = 0;; ++j) {
      const int v = LMAP(j, 108, 864); if (v < 0) break;
      if (local) gin_tile(p, l, v / 6, 6 * xcc + v % 6, sm16); else gin_tile(p, l, v / 48, v % 48, sm16);
    }
    if (full64) {
      if (xrank >= 44) {
        const int idle = xcc * 20 + (xrank - 44);
        for (int it = 288 + idle; it < 1184; it += 160) wt_item(p, l, it, (float*)smem);
      }
    }
    GSYNC();
    {
      constexpr int CD = 64 * NQG_CTX, CC = 2 * 64 * NQG_CTX / 4;
      constexpr int LD = 8 * NQG_LAT, LC = 2 * 8 * NQG_LAT;
      constexpr int E0 = 192, E1 = E0 + LD, E2 = E1 + LC, E3 = E2 + 32, E4 = E3 + CC, E5 = E4 + CD, E6 = E5 + 64;
      unsigned* qc = p.bar + XCD_BAR_WORDS + l * 64;
      const int w0 = full64 ? 1184 : 288;
      const int EA = E6 + (1440 - w0), EW = EA + (l < 3 ? 288 : 0);
      for (int it = bid; it < EW; it = nblk + q_next(qc, &xb.st[2])) {
        if (it >= E6) {
          if (it < EA) wt_item(p, l, it - E6 + w0, (float*)smem);
          else wt_item(p, l + 1, it - EA, (float*)smem);
          continue;
        }
        if (it < E0) f1_tile(p, l, it, sm16);
        else if (it < E0 + LC) attn_lat_item(p, l, it - E0, (float*)smem);
        else if (it < E2) attn_diff_item(p, l, true, it - E0 - LC, (float*)smem);
        else if (it < E3) f2_tile(p, l, it - E2, sm16);
        else if (it < E4) attn_ctx_item(p, l, it - E3);
        else if (it < E5) attn_diff_item(p, l, false, it - E4, (float*)smem);
        else f2_tile(p, l, it - E5 + 32, sm16);
      }
    }
    GSYNC();
    for (int j = 0;; ++j) {
      const int v = LMAP(j, 64, 512); if (v < 0) break;
      if (local) res_tile(p, l, v / 8, 8 * xcc + v % 8, p.cat, p.w_outT + (size_t)l * 1024 * 1024, 1024, 2, sm16, l == 0);
      else res_tile(p, l, v / 64, v % 64, p.cat, p.w_outT + (size_t)l * 1024 * 1024, 1024, 2, sm16, l == 0);
    }
    LSYNC();
    for (int j = 0;; ++j) { const int v = LMAP(j, 48, 384); if (v < 0) break; norm_item(p, l, 1, local ? 48 * xcc + v : v); }
    LSYNC();
    for (int j = 0;; ++j) {
      const int v = LMAP(j, 192, 1536); if (v < 0) break;
      if (local) m1_tile(p, l, v / 6, 6 * xcc + v % 6, sm16); else m1_tile(p, l, v / 48, v % 48, sm16);
    }
    LSYNC();
    for (int j = 0;; ++j) {
      const int v = LMAP(j, 64, 512); if (v < 0) break;
      if (local) res_tile(p, l, v / 8, 8 * xcc + v % 8, p.u, p.w2T + (size_t)l * 1024 * 4096, 4096, 5, sm16);
      else res_tile(p, l, v / 64, v % 64, p.u, p.w2T + (size_t)l * 1024 * 4096, 4096, 5, sm16);
    }
    LSYNC();
  }
  for (int j = 0;; ++j) { const int v = LMAP(j, 48, 384); if (v < 0) break; norm_item(p, 0, 2, local ? 48 * xcc + v : v); }
#undef LSYNC
#undef LMAP
}

extern "C" void kernel_launch(void* const* d_in, const int* in_sizes, int n_in, void* d_out, int out_size, void* d_ws,
                              size_t ws_size, hipStream_t stream) {
  static int grid_blocks = 0;
  if (grid_blocks == 0) {
    int dev = 0, cus = 0, per_cu = 0;
    (void)hipGetDevice(&dev);
    (void)hipDeviceGetAttribute(&cus, hipDeviceAttributeMultiprocessorCount, dev);
    if (hipFuncSetAttribute((const void*)mega, hipFuncAttributeMaxDynamicSharedMemorySize, LDS_BYTES) != hipSuccess) {
      fprintf(stderr, "hipFuncSetAttribute failed\n");
    }
    if (hipOccupancyMaxActiveBlocksPerMultiprocessor(&per_cu, (const void*)mega, 256, LDS_BYTES) != hipSuccess || per_cu < 1) {
      fprintf(stderr, "occupancy query failed (%d)\n", per_cu);
      per_cu = 1;
    }
    if (per_cu > 2) per_cu = 2;
    grid_blocks = cus * per_cu;
    fprintf(stderr, "mega: cus=%d per_cu=%d grid=%d ws=%zu\n", cus, per_cu, grid_blocks, ws_size);
  }
  Params p{};
  const float** pin = (const float**)&p;
  for (int i = 0; i < 27; ++i) pin[i] = (const float*)d_in[i];
  p.out = (float*)d_out;
  unsigned char* ws = (unsigned char*)d_ws;
  size_t off = 0;
  auto take = [&](size_t bytes) { unsigned char* q = ws + off; off += (bytes + 255) & ~(size_t)255; return q; };
  p.xres = (float*)take((size_t)NTOK * 1024 * 4);
  p.mods = (float*)take((size_t)4 * 3 * 6144 * 4);
  p.h = (u16*)take((size_t)NTOK * 1024 * 2);
  p.z = (u16*)take((size_t)NTOK * INW * 2);
  p.vt = (u16*)take((size_t)640 * NTOK * 2);
  p.cat = (u16*)take((size_t)NTOK * 1024 * 2);
  p.u = (u16*)take((size_t)NTOK * 4096 * 2);
  p.uv = (u16*)take((size_t)(16 * 256 * 512 + 2 * 256 * 2048) * 2);
  p.w_inT = (u16*)take((size_t)4 * 2304 * 1024 * 2);
  p.w_outT = (u16*)take((size_t)4 * 1024 * 1024 * 2);
  p.w1T = (u16*)take((size_t)4 * 4096 * 1024 * 2);
  p.w2T = (u16*)take((size_t)4 * 4096 * 1024 * 2);
  p.pqt = (u16*)take((size_t)4 * 512 * 256 * 2);
  p.dft256 = (u16*)take((size_t)256 * 512 * 2);
  p.dft1024 = (u16*)take((size_t)1024 * 2048 * 2);
  p.ck_na = (u16*)take((size_t)2 * 4 * 512 * 256 * 2);
  p.cvt_na = (u16*)take((size_t)2 * 4 * 512 * 256 * 2);
  p.ck_diff = (u16*)take((size_t)2 * 4 * 512 * 256 * 2);
  p.cvt_diff = (u16*)take((size_t)2 * 4 * 512 * 256 * 2);
  p.ck_swa = (u16*)take((size_t)2 * 4 * 512 * 128 * 2);
  p.cvt_swa = (u16*)take((size_t)2 * 4 * 512 * 128 * 2);
  p.kfr = (u16*)take((size_t)10 * 192 * 2048 * 2);
  p.vfr = (u16*)take((size_t)10 * 192 * 2048 * 2);
  p.ropeD = (float*)take(1024 * 4);
  p.ropeS = (float*)take(2048 * 4);
  p.bar = (unsigned*)take(XB_ALL_WORDS * 4);
  if (off > ws_size) { fprintf(stderr, "workspace too small: need %zu have %zu\n", off, ws_size); return; }
  if (hipMemsetAsync(p.bar, 0, XB_ALL_WORDS * 4, stream) != hipSuccess) fprintf(stderr, "memset failed\n");
  void* args[] = {&p};
  hipError_t e = hipLaunchCooperativeKernel((const void*)mega, dim3(grid_blocks), dim3(256), args, LDS_BYTES, stream);
  if (e != hipSuccess) fprintf(stderr, "cooperative launch failed: %s (grid %d)\n", hipGetErrorString(e), grid_blocks);
}
```
